# Optimizing an MI355X kernel written in HIP

```python
import jax, jax.numpy as jnp
from jax import lax
import numpy as np


D_MODEL = 1024
BATCH = 16
SEQ = 2048
DEPTH = 4

RWKV_HEADS = 8
RWKV_HEAD_DIM = 64
RWKV_WIDTH = RWKV_HEADS * RWKV_HEAD_DIM
DECAY_LORA = 32
ICLR_LORA = 32
VRES_LORA = 32
GATE_LORA = 96
SGU_GROUPS = 4
SGU_WIDTH = 256
SGU_CHUNK = 128
CONV_WIDTH = 256
CONV_KERNEL = 31
N_BRANCHES = 3

OFF_R = 0
OFF_K = OFF_R + RWKV_WIDTH
OFF_V = OFF_K + RWKV_WIDTH
OFF_WL = OFF_V + RWKV_WIDTH
OFF_AL = OFF_WL + DECAY_LORA
OFF_GL = OFF_AL + ICLR_LORA
RWKV_COLS = OFF_GL + GATE_LORA
OFF_SGU = RWKV_COLS
OFF_CONV = OFF_SGU + 2 * SGU_WIDTH
OFF_GATE = OFF_CONV + 2 * CONV_WIDTH
IN_COLS = OFF_GATE + N_BRANCHES * D_MODEL
OFF_VRES = IN_COLS

N_EXPERTS = 32
N_GROUPS = 4
EXPERTS_PER_GROUP = N_EXPERTS // N_GROUPS
TOP_K = 2
D_EXPERT = 512
EXPERT_BLOCK = 256

ALPHA = (2 * DEPTH) ** 0.25
BETA = (8 * DEPTH) ** -0.25
LN_EPS = 1e-5
GN_EPS = 64e-5

kernel_name = 'hybrid_rwkv7_sgu_conformer_grouped_moe'


def layer_norm(x, g, b):
    xf = x.astype(jnp.float32)
    mu = jnp.mean(xf, axis=-1, keepdims=True)
    var = jnp.mean(jnp.square(xf - mu), axis=-1, keepdims=True)
    return ((xf - mu) * lax.rsqrt(var + LN_EPS)).astype(x.dtype) * g + b


def token_shift_mix(p, mu):
    prev = jnp.pad(p, ((0, 0), (1, 0), (0, 0)))[:, :-1]
    return p + (prev - p) * mu


def wkv7_scan(r, decay, k, v, a, b):
    bsz, _, h, n = r.shape

    def step(state, inp):
        r_t, w_t, k_t, v_t, a_t, b_t = inp
        sa = jnp.einsum('bhvk,bhk->bhv', state, a_t)
        state = (state * w_t[:, :, None, :] + sa[..., None] * b_t[:, :, None, :]
                 + v_t[..., None] * k_t[:, :, None, :])
        return state, jnp.einsum('bhvk,bhk->bhv', state, r_t)

    xs = tuple(jnp.moveaxis(t, 1, 0) for t in (r, decay, k, v, a, b))
    _, y = lax.scan(step, jnp.zeros((bsz, h, n, n), jnp.float32), xs)
    return jnp.moveaxis(y, 0, 1)


def rwkv7_branch(r, k, v, wl, al, gl, w0, w_up, a0, a_up, g_up, k_k, k_a, r_k, gn_g, gn_b, w_o):
    f32 = jnp.float32
    bsz, seq, _ = r.shape

    def heads(t):
        return t.astype(f32).reshape(bsz, seq, RWKV_HEADS, RWKV_HEAD_DIM)

    w_log = -jax.nn.softplus(-(w0 + jnp.tanh(wl) @ w_up)) - 0.5
    decay = jnp.exp(-jnp.exp(heads(w_log)))
    iclr = jax.nn.sigmoid(a0 + al @ a_up)
    gate = jax.nn.sigmoid(gl) @ g_up
    kk = heads(k * k_k)
    kk = kk / jnp.maximum(jnp.sqrt(jnp.sum(kk * kk, axis=-1, keepdims=True)), 1e-12)
    kh = heads(k * (1 + (iclr - 1) * k_a))
    rh, vh, ah = heads(r), heads(v), heads(iclr)
    y = wkv7_scan(rh, decay, kh, vh, -kk, kk * ah)
    mu = jnp.mean(y, axis=-1, keepdims=True)
    var = jnp.mean(jnp.square(y - mu), axis=-1, keepdims=True)
    hn = (RWKV_HEADS, RWKV_HEAD_DIM)
    yn = (y - mu) * lax.rsqrt(var + GN_EPS) * gn_g.astype(f32).reshape(hn) + gn_b.astype(f32).reshape(hn)
    bonus = jnp.sum(rh * kh * r_k.astype(f32), axis=-1, keepdims=True) * vh
    out = (yn + bonus).reshape(bsz, seq, RWKV_WIDTH).astype(r.dtype) * gate
    return out @ w_o


def sgu_branch(pb, ln_g, ln_b, w_s, b_s, w_o):
    z = jax.nn.gelu(pb, approximate=False)
    u, v = z[..., :SGU_WIDTH], z[..., SGU_WIDTH:]
    v = layer_norm(v, ln_g, ln_b)
    bsz, seq, _ = v.shape
    vg = v.reshape(bsz, seq // SGU_CHUNK, SGU_CHUNK, SGU_GROUPS, SGU_WIDTH // SGU_GROUPS)
    causal = jnp.tril(jnp.ones((SGU_CHUNK, SGU_CHUNK), dtype=bool))
    w_c = jnp.where(causal, w_s, 0)
    mixed = jnp.einsum('gpq,bcqgd->bcpgd', w_c, vg) + jnp.transpose(b_s)[:, :, None]
    return (u * mixed.reshape(bsz, seq, SGU_WIDTH)) @ w_o


def conv_branch(pc, dw_kernel, dw_bias, ln_g, ln_b, w_o):
    h = pc[..., :CONV_WIDTH] * jax.nn.sigmoid(pc[..., CONV_WIDTH:])
    h = lax.conv_general_dilated(
        h, dw_kernel[:, None, :], window_strides=(1,), padding=[(CONV_KERNEL - 1, 0)],
        dimension_numbers=('NWC', 'WIO', 'NWC'), feature_group_count=CONV_WIDTH) + dw_bias
    h = jax.nn.silu(layer_norm(h, ln_g, ln_b))
    return h @ w_o


def grouped_moe(x, router_w, router_b, w_gate, w_up, w_down):
    bsz, seq, d = x.shape
    t = bsz * seq
    xf = x.reshape(t, d)
    scores = jax.nn.sigmoid((xf @ router_w).astype(jnp.float32))
    sel = (scores + router_b.astype(jnp.float32)).reshape(t, N_GROUPS, EXPERTS_PER_GROUP)
    group_score = jnp.sum(lax.top_k(sel, TOP_K)[0], axis=-1)
    grp = jnp.argmax(group_score, axis=-1)
    sel_in = jnp.take_along_axis(sel, grp[:, None, None], axis=1)[:, 0]
    _, local = lax.top_k(sel_in, TOP_K)
    expert = grp[:, None] * EXPERTS_PER_GROUP + local
    gate = jnp.take_along_axis(scores, expert, axis=1)
    gate = gate / jnp.sum(gate, axis=-1, keepdims=True)
    tk = t * TOP_K
    flat_e = expert.reshape(tk)
    flat_tok = jnp.repeat(jnp.arange(t, dtype=jnp.int32), TOP_K)
    flat_g = gate.reshape(tk)
    order = jnp.argsort(flat_e)
    e_sorted = flat_e[order]
    counts = jnp.bincount(flat_e, length=N_EXPERTS)
    padded = (counts + EXPERT_BLOCK - 1) // EXPERT_BLOCK * EXPERT_BLOCK
    pad_end = jnp.cumsum(padded)
    pad_start = pad_end - padded
    start = jnp.cumsum(counts) - counts
    dest = pad_start[e_sorted] + jnp.arange(tk, dtype=jnp.int32) - start[e_sorted]
    n_blocks = (tk + EXPERT_BLOCK - 1) // EXPERT_BLOCK + N_EXPERTS
    rows = n_blocks * EXPERT_BLOCK
    buf_tok = jnp.full((rows,), t, jnp.int32).at[dest].set(flat_tok[order])
    buf_gate = jnp.zeros((rows,), jnp.float32).at[dest].set(flat_g[order])
    block_expert = jnp.clip(
        jnp.searchsorted(pad_end, jnp.arange(n_blocks, dtype=jnp.int32) * EXPERT_BLOCK, side='right'),
        0, N_EXPERTS - 1)
    xb = jnp.take(xf, buf_tok, axis=0, mode='fill', fill_value=0).reshape(n_blocks, EXPERT_BLOCK, d)

    def expert_block(args):
        xblk, e = args
        h = jax.nn.silu(xblk @ w_gate[e]) * (xblk @ w_up[e])
        return h @ w_down[e]

    yb = lax.map(expert_block, (xb, block_expert)).reshape(rows, d)
    y = jnp.zeros((t, d), yb.dtype).at[buf_tok].add(yb * buf_gate[:, None].astype(yb.dtype), mode='drop')
    return y.reshape(bsz, seq, d)


def setup_inputs(seed: int = 0) -> dict:
    key = jax.random.key(seed)
    ks = iter(jax.random.split(key, 48))

    def nrm(shape, scale):
        return jax.random.normal(next(ks), shape, jnp.float32) * scale

    def uni(shape, lo, hi):
        return jax.random.uniform(next(ks), shape, jnp.float32, lo, hi)

    d, L = D_MODEL, DEPTH
    return {
        'x': nrm((BATCH, SEQ, d), 1.0),
        'w_in_first': nrm((d, IN_COLS), d ** -0.5),
        'w_in_rest': nrm((L - 1, d, IN_COLS + VRES_LORA), d ** -0.5),
        'rwkv_mu': uni((L, RWKV_COLS), 0.0, 1.0),
        'rwkv_mu_vres': uni((L - 1, VRES_LORA), 0.0, 1.0),
        'rwkv_w0': uni((L, RWKV_WIDTH), -5.0, 0.0),
        'rwkv_w_up': nrm((L, DECAY_LORA, RWKV_WIDTH), 0.5 * DECAY_LORA ** -0.5),
        'rwkv_a0': nrm((L, RWKV_WIDTH), 0.5),
        'rwkv_a_up': nrm((L, ICLR_LORA, RWKV_WIDTH), 0.5 * ICLR_LORA ** -0.5),
        'rwkv_g_up': nrm((L, GATE_LORA, RWKV_WIDTH), GATE_LORA ** -0.5),
        'rwkv_v0': nrm((L - 1, RWKV_WIDTH), 0.5),
        'rwkv_v_up': nrm((L - 1, VRES_LORA, RWKV_WIDTH), 0.5 * VRES_LORA ** -0.5),
        'rwkv_k_k': 0.85 + nrm((L, RWKV_WIDTH), 0.1),
        'rwkv_k_a': 1.0 + nrm((L, RWKV_WIDTH), 0.1),
        'rwkv_r_k': nrm((L, RWKV_HEADS, RWKV_HEAD_DIM), 0.1),
        'rwkv_gn_g': 1.0 + nrm((L, RWKV_WIDTH), 0.1),
        'rwkv_gn_b': nrm((L, RWKV_WIDTH), 0.01),
        'rwkv_w_o': nrm((L, RWKV_WIDTH, d), BETA * RWKV_WIDTH ** -0.5),
        'sgu_ln_g': 1.0 + nrm((L, SGU_WIDTH), 0.1),
        'sgu_ln_b': nrm((L, SGU_WIDTH), 0.01),
        'sgu_w': nrm((L, SGU_GROUPS, SGU_CHUNK, SGU_CHUNK), SGU_CHUNK ** -0.5),
        'sgu_b': 1.0 + nrm((L, SGU_GROUPS, SGU_CHUNK), 0.1),
        'sgu_w_o': nrm((L, SGU_WIDTH, d), BETA * SGU_WIDTH ** -0.5),
        'conv_dw': nrm((L, CONV_KERNEL, CONV_WIDTH), CONV_KERNEL ** -0.5),
        'conv_db': nrm((L, CONV_WIDTH), 0.01),
        'conv_ln_g': 1.0 + nrm((L, CONV_WIDTH), 0.1),
        'conv_ln_b': nrm((L, CONV_WIDTH), 0.01),
        'conv_w_o': nrm((L, CONV_WIDTH, d), BETA * CONV_WIDTH ** -0.5),
        'w_out': nrm((L, d, d), BETA * d ** -0.5),
        'ln1_g': 1.0 + nrm((L, d), 0.1),
        'ln1_b': nrm((L, d), 0.01),
        'router_w': nrm((d, N_EXPERTS), d ** -0.5),
        'router_b': nrm((N_EXPERTS,), 0.01),
        'moe_w_gate': nrm((L, N_EXPERTS, d, D_EXPERT), d ** -0.5),
        'moe_w_up': nrm((L, N_EXPERTS, d, D_EXPERT), d ** -0.5),
        'moe_w_down': nrm((L, N_EXPERTS, D_EXPERT, d), BETA * D_EXPERT ** -0.5),
        'ln2_g': 1.0 + nrm((L, d), 0.1),
        'ln2_b': nrm((L, d), 0.01),
    }


def reference(x, w_in_first, w_in_rest, rwkv_mu, rwkv_mu_vres, rwkv_w0, rwkv_w_up, rwkv_a0, rwkv_a_up,
              rwkv_g_up, rwkv_v0, rwkv_v_up, rwkv_k_k, rwkv_k_a, rwkv_r_k, rwkv_gn_g, rwkv_gn_b, rwkv_w_o,
              sgu_ln_g, sgu_ln_b, sgu_w, sgu_b, sgu_w_o, conv_dw, conv_db, conv_ln_g, conv_ln_b, conv_w_o,
              w_out, ln1_g, ln1_b, router_w, router_b, moe_w_gate, moe_w_up, moe_w_down, ln2_g, ln2_b):
    v_first = None
    for l in range(DEPTH):
        w_in = w_in_first if l == 0 else w_in_rest[l - 1]
        proj = x @ w_in
        pa = token_shift_mix(proj[..., :RWKV_COLS], rwkv_mu[l])
        r = pa[..., OFF_R:OFF_K]
        k = pa[..., OFF_K:OFF_V]
        v = pa[..., OFF_V:OFF_WL]
        wl = pa[..., OFF_WL:OFF_AL]
        al = pa[..., OFF_AL:OFF_GL]
        gl = pa[..., OFF_GL:RWKV_COLS]
        if l == 0:
            v_first = v
        else:
            vl = token_shift_mix(proj[..., OFF_VRES:], rwkv_mu_vres[l - 1])
            v = v + (v_first - v) * jax.nn.sigmoid(rwkv_v0[l - 1] + vl @ rwkv_v_up[l - 1])
        o_a = rwkv7_branch(r, k, v, wl, al, gl, rwkv_w0[l], rwkv_w_up[l], rwkv_a0[l], rwkv_a_up[l],
                           rwkv_g_up[l], rwkv_k_k[l], rwkv_k_a[l], rwkv_r_k[l], rwkv_gn_g[l], rwkv_gn_b[l],
                           rwkv_w_o[l])
        o_b = sgu_branch(proj[..., OFF_SGU:OFF_CONV], sgu_ln_g[l], sgu_ln_b[l], sgu_w[l], sgu_b[l], sgu_w_o[l])
        o_c = conv_branch(proj[..., OFF_CONV:OFF_GATE], conv_dw[l], conv_db[l], conv_ln_g[l], conv_ln_b[l],
                          conv_w_o[l])
        gates = jax.nn.sigmoid(proj[..., OFF_GATE:IN_COLS])
        merged = (gates[..., :D_MODEL] * o_a + gates[..., D_MODEL:2 * D_MODEL] * o_b
                  + gates[..., 2 * D_MODEL:] * o_c)
        x = layer_norm(ALPHA * x + merged @ w_out[l], ln1_g[l], ln1_b[l])
        moe_out = grouped_moe(x, router_w, router_b, moe_w_gate[l], moe_w_up[l], moe_w_down[l])
        x = layer_norm(ALPHA * x + moe_out, ln2_g[l], ln2_b[l])
    return x
```

```cpp
#include <hip/hip_runtime.h>
#include <stdint.h>
#include <stdio.h>

#ifndef DEBUG_MODE
#define DEBUG_MODE 0
#endif
#ifndef REPEAT_K
#define REPEAT_K -1
#endif
#ifndef ONE_LAUNCH
#define ONE_LAUNCH 1
#endif

#define LAS __attribute__((address_space(3)))
typedef unsigned short bf16_t;
typedef short bf16x8 __attribute__((ext_vector_type(8)));
typedef float f32x4 __attribute__((ext_vector_type(4)));
typedef float f32x2 __attribute__((ext_vector_type(2)));
typedef unsigned u32x4 __attribute__((ext_vector_type(4)));
typedef unsigned u32x2 __attribute__((ext_vector_type(2)));

constexpr int T = 32768, SEQ = 2048, D = 1024, NL = 4;
constexpr int NIN = 5888;
constexpr int RKVW = 1792;
constexpr int NE = 32;
constexpr float ALPHA = 1.681792830507429f;
constexpr float LN_EPS = 1e-5f, GN_EPS = 64e-5f;

constexpr size_t MiB = 1u << 20;
constexpr size_t WS_CTL = 0;
constexpr size_t WS_WIN = 1 * MiB;
constexpr size_t WS_WBR = WS_WIN + 46 * MiB;
constexpr size_t WS_WOUT = WS_WBR + 8 * MiB;
constexpr size_t WS_WRT = WS_WOUT + 8 * MiB;
constexpr size_t WS_WMOE = WS_WRT + 1 * MiB;
constexpr size_t WS_X = WS_WMOE + 96 * MiB;
constexpr size_t WS_X1 = WS_X + 64 * MiB;
constexpr size_t WS_VFIRST = WS_X1 + 64 * MiB;
constexpr size_t WS_RKV = WS_VFIRST + 32 * MiB;
constexpr size_t WS_SGUZ = WS_RKV + 112 * MiB;
constexpr size_t WS_CONVH = WS_SGUZ + 32 * MiB;
constexpr size_t WS_GATES = WS_CONVH + 16 * MiB;
constexpr size_t WS_PHI = WS_GATES + 192 * MiB;
constexpr size_t WS_PSI = WS_PHI + 32 * MiB;
constexpr size_t WS_GT = WS_PSI + 32 * MiB;
constexpr size_t WS_Y0T = WS_GT + 32 * MiB;
constexpr size_t WS_VT = WS_Y0T + 32 * MiB;
constexpr size_t WS_MT = WS_VT + 32 * MiB;
constexpr size_t WS_RK = WS_MT + 32 * MiB;
constexpr size_t WS_LORA = WS_RK + 1 * MiB;
constexpr size_t WS_SGUW = WS_LORA + 1 * MiB;
constexpr size_t WS_OUTA = WS_SGUW + 1 * MiB;
constexpr size_t WS_HB = WS_OUTA + 32 * MiB;
constexpr size_t WS_HC = WS_HB + 16 * MiB;
constexpr size_t WS_XQ = WS_HC + 16 * MiB;
constexpr size_t WS_END = WS_XQ + 32 * MiB;
constexpr size_t WS_X1Q = WS_WMOE + 64 * MiB;
constexpr size_t WS_STATS = WS_Y0T;
constexpr size_t WS_WRG = WS_WBR + 4 * MiB;
constexpr size_t WS_RC = WS_SGUW + 512 * 1024;
constexpr size_t WS_MERGEDQ = WS_GT;
constexpr size_t WS_MERGED = WS_RKV;
constexpr size_t WS_PRE = WS_PHI;
constexpr size_t WS_H = WS_RKV;
constexpr size_t WS_Y = WS_GATES;
constexpr size_t WS_LIST = WS_SGUZ;
constexpr size_t WS_GATEV = WS_SGUZ + 16 * MiB;
static_assert(WS_END <= 1024 * MiB, "workspace map");
#if DEBUG_MODE
constexpr size_t WS_SV = WS_GATES, WS_SA = WS_SV + 32 * MiB, WS_SB = WS_SA + 32 * MiB, WS_SR = WS_SB + 32 * MiB, WS_SK = WS_SR + 32 * MiB, WS_SG = WS_SK + 32 * MiB;
constexpr size_t WS_SW = WS_X1;
constexpr size_t DBG_OUTAREF = WS_WMOE, DBG_MREF = WS_WMOE + 32 * MiB, DBG_YREF = WS_SGUZ, DBG_RKREF = WS_HB, DBG_YDBG = WS_HC;
#endif
constexpr int CW_BAR = 4096;
constexpr int CW_CNT = 16384;
constexpr size_t CTL_BYTES = 1 * MiB;

constexpr int LDS_STAGE = 131072;
constexpr int LDS_MISC = LDS_STAGE;
constexpr int LDS_BYTES = LDS_STAGE + 4096;

typedef __bf16 bf16x2_t __attribute__((ext_vector_type(2)));
__device__ __forceinline__ unsigned cvt_pk_bf16(float lo, float hi) { const f32x2 v = {lo, hi}; const bf16x2_t b = __builtin_convertvector(v, bf16x2_t); return __builtin_bit_cast(unsigned, b); }
__device__ __forceinline__ unsigned pack_fp8x4(float a, float b, float c, float d) { int w = 0; w = __builtin_amdgcn_cvt_pk_fp8_f32(a, b, w, false); w = __builtin_amdgcn_cvt_pk_fp8_f32(c, d, w, true); return (unsigned)w; }
__device__ __forceinline__ bf16_t f2bf(float f) { return (bf16_t)(cvt_pk_bf16(f, 0.f) & 0xffffu); }
__device__ __forceinline__ float bf2f(unsigned short b) { return __uint_as_float(((unsigned)b) << 16); }
__device__ __forceinline__ float bflo(unsigned w) { return __uint_as_float(w << 16); }
__device__ __forceinline__ float bfhi(unsigned w) { return __uint_as_float(w & 0xffff0000u); }
__device__ __forceinline__ float sigmoidf_(float x) { return __builtin_amdgcn_rcpf(1.0f + __expf(-x)); }
template <int CTRL> __device__ __forceinline__ float dpp_mov(float x) { return __builtin_bit_cast(float, __builtin_amdgcn_mov_dpp(__builtin_bit_cast(int, x), CTRL, 0xF, 0xF, true)); }
__device__ __forceinline__ float row16_sum(float v) { v += dpp_mov<0xB1>(v); v += dpp_mov<0x4E>(v); v += dpp_mov<0x141>(v); v += dpp_mov<0x140>(v); return v; }
__device__ __forceinline__ float wave_sum(float v) {
    v = row16_sum(v); const int vi = __builtin_bit_cast(int, v);
    return (__builtin_bit_cast(float, __builtin_amdgcn_readlane(vi, 0)) + __builtin_bit_cast(float, __builtin_amdgcn_readlane(vi, 16))) + (__builtin_bit_cast(float, __builtin_amdgcn_readlane(vi, 32)) + __builtin_bit_cast(float, __builtin_amdgcn_readlane(vi, 48)));
}
__device__ __forceinline__ float dpp_f(float x, const int ctrl_sel) {
    int xi = __builtin_bit_cast(int, x), r;
    if (ctrl_sel == 0) r = __builtin_amdgcn_update_dpp(0, xi, 0xB1, 0xF, 0xF, true);
    else if (ctrl_sel == 1) r = __builtin_amdgcn_update_dpp(0, xi, 0x4E, 0xF, 0xF, true);
    else r = __builtin_amdgcn_update_dpp(0, xi, 0x141, 0xF, 0xF, true);
    return __builtin_bit_cast(float, r);
}
__device__ __forceinline__ float reduce8(float x) { x += dpp_f(x, 0); x += dpp_f(x, 1); x += dpp_f(x, 2); return x; }
__device__ __forceinline__ float gelu_f(float v) {
    const float av = fabsf(v), t = __builtin_amdgcn_rcpf(av * 0.2316418882f + 1.0f);
    float q = t * 0.5307027145f + (-0.7265760135f); q = q * t + 0.7107068705f; q = q * t + (-0.142248368f); q = q * t + 0.127414796f; q = q * t;
    const float e = __builtin_amdgcn_exp2f((v * v) * (-0.72134752044f));
    const float m = v * (q * e);
    return v < 0.f ? m : v - m;
}

#define XB_TMO      128
#define XB_XCNT(j)  (256  + 64 * (j))
#define XB_XSUB(j)  (1280 + 64 * (j))
#define XB_XGEN(j)  (2304 + 64 * (j))
#define XB_TOP      3328
#define XB_TOPGEN   3392
#define XCD_BAR_WORDS 3456
#define XB_SPIN_CAP (1u << 22)
__device__ __forceinline__ unsigned xb_ld(unsigned* p)              { return __hip_atomic_load(p, __ATOMIC_RELAXED, __HIP_MEMORY_SCOPE_AGENT); }
__device__ __forceinline__ unsigned xb_add(unsigned* p, unsigned v) { return __hip_atomic_fetch_add(p, v, __ATOMIC_RELAXED, __HIP_MEMORY_SCOPE_AGENT); }
__device__ __forceinline__ unsigned xb_xcc_id() { return (unsigned)__builtin_amdgcn_s_getreg((3 << 11) | 20) & 0xFu; }
#define XB_SPIN(cond, bar) do { unsigned _sp = 0; while (cond) { __builtin_amdgcn_s_sleep(1); \
    if ((++_sp & 255u) == 0u) { if (xb_ld(&(bar)[XB_TMO])) break; if (_sp > XB_SPIN_CAP) { atomicAdd(&(bar)[XB_TMO], 1u); break; } } } } while (0)
struct XcdBarrier { unsigned* bar; unsigned x; volatile LAS unsigned* st; };
__device__ __forceinline__ XcdBarrier xcd_barrier_post(unsigned* bar, volatile LAS unsigned* st) {
    XcdBarrier b; b.bar = bar; b.x = xb_xcc_id(); b.st = st;
    if (threadIdx.x == 0) (void)xb_add(&bar[XB_XCNT(b.x)], 1u);
    return b;
}
__device__ __forceinline__ void xcd_barrier_complete(unsigned* bar, unsigned x, unsigned& nloc, unsigned& nx) {
    const unsigned G = gridDim.x * gridDim.y * gridDim.z;
    unsigned sum, cnt, mine, sp = 0u;
    for (;;) {
        sum = 0u; cnt = 0u; mine = 0u;
#pragma unroll
        for (unsigned j = 0; j < 16; ++j) { const unsigned c = xb_ld(&bar[XB_XCNT(j)]); sum += c; cnt += (c > 0u) ? 1u : 0u; mine = (j == x) ? c : mine; }
        if (sum == G) break;
        __builtin_amdgcn_s_sleep(1);
        if ((++sp & 255u) == 0u) { if (xb_ld(&bar[XB_TMO])) break; if (sp > XB_SPIN_CAP) { atomicAdd(&bar[XB_TMO], 1u); break; } }
    }
    nloc = mine > 0u ? mine : 1u; nx = cnt > 0u ? cnt : 1u;
}
__device__ __forceinline__ void xcd_barrier(const XcdBarrier& b) {
    asm volatile("s_waitcnt vmcnt(0)" ::: "memory");
    __syncthreads();
    if (threadIdx.x == 0) {
        unsigned* bar = b.bar;
        __builtin_amdgcn_s_waitcnt(0);
        unsigned nloc = b.st[0], nx = b.st[1];
        if (nloc == 0u) { xcd_barrier_complete(bar, b.x, nloc, nx); b.st[0] = nloc; b.st[1] = nx; }
        const unsigned old = xb_add(&bar[XB_XSUB(b.x)], 1u);
        const unsigned gen = old / nloc;
        if (old + 1u == (gen + 1u) * nloc) {
            __builtin_amdgcn_fence(__ATOMIC_RELEASE, "agent");
            asm volatile("s_waitcnt vmcnt(0)" ::: "memory");
            const unsigned og = xb_add(&bar[XB_TOP], 1u);
            const unsigned tg = og / nx;
            if (og + 1u == (tg + 1u) * nx) xb_add(&bar[XB_TOPGEN], 1u);
            else XB_SPIN(xb_ld(&bar[XB_TOPGEN]) == tg, bar);
            __builtin_amdgcn_fence(__ATOMIC_ACQUIRE, "agent");
            xb_add(&bar[XB_XGEN(b.x)], 1u);
            asm volatile("s_waitcnt vmcnt(0)" ::: "memory");
        } else {
            XB_SPIN(xb_ld(&bar[XB_XGEN(b.x)]) == gen, bar);
            __builtin_amdgcn_fence(__ATOMIC_ACQUIRE, "agent");
            asm volatile("s_waitcnt vmcnt(0)" ::: "memory");
        }
    }
    __syncthreads();
}

struct Params {
    const float* in[38];
    float* out;
    unsigned char* ws;
    int phase_lo, phase_hi;
    int layer_lo, layer_hi;
};

namespace ge {
constexpr int BM = 256, BK = 64, HALF = 128, HTB = HALF * BK * 2;
__device__ __forceinline__ int lds_byte(int r, int c) { const int st = (r >> 4) * 2 + (c >> 5), rr = r & 15, cc = c & 31, ob = rr * 64 + cc * 2; return st * 1024 + (ob ^ (((ob >> 9) & 1) << 5)); }
__device__ __forceinline__ void stage_rc(int b, int& R, int& C) { const int st = b / 1024, sb = b % 1024, swz = sb ^ (((sb >> 9) & 1) << 5); R = (st >> 1) * 16 + swz / 64; C = (st & 1) * 32 + (swz % 64) / 2; }
__device__ __forceinline__ int perm32(int rho) { const int n = rho >> 4, i = rho & 15; return 8 * (i >> 2) + 4 * n + (i & 3); }

struct NoPre { };
struct Unit {
    const char* A; const char* B;
    const int* gat;
    unsigned lda, ldb;
    int nt;
    int gshift, nvalid;
    int pm, pn, aux;
};
typedef f32x4 Acc[2][2][4][2];

typedef int i32x8 __attribute__((ext_vector_type(8)));
template <class Sched, class Epi, bool FP8 = false, int SCALE_W = 0x7A7A7A7A, int SCALE_A = 0x7F7F7F7F>
__device__ __forceinline__ void gemm_phase(LAS unsigned char* lds, const Sched& S, const Epi& E) {
    int tid = threadIdx.x; asm volatile("" : "+v"(tid));
    const int wid = __builtin_amdgcn_readfirstlane(tid >> 6), lane = tid & 63, wr = wid >> 2, wc = wid & 3, fr = lane & 15, fq = lane >> 4;
    const unsigned ldsw = (unsigned)wid * 1024u;
    const int aoff = FP8 ? lds_byte(wr * 64 + fr, fq * 16) : lds_byte(wr * 64 + fr, fq * 8), boff = FP8 ? lds_byte(wc * 32 + fr, fq * 16) : lds_byte(wc * 32 + fr, fq * 8);
    const int aoff1 = FP8 ? lds_byte(wr * 64 + fr, fq * 16 + 8) : aoff + 1024, boff1 = FP8 ? lds_byte(wc * 32 + fr, fq * 16 + 8) : boff + 1024;
#define GE_SA(b, h) (((b) * 2 + (h)) * HTB)
#define GE_SB(b, h) ((4 + (b) * 2 + (h)) * HTB)
#define GE_STAGE(bufoff, gbase, o0, o1) do { \
        __builtin_amdgcn_global_load_lds((const unsigned*)((gbase) + (o0)), (LAS unsigned*)(lds + (bufoff) + ldsw), 16, 0, 0); \
        __builtin_amdgcn_global_load_lds((const unsigned*)((gbase) + (o1)), (LAS unsigned*)(lds + (bufoff) + ldsw + 8192), 16, 0, 0); } while (0)
#define GE_LDA(dst, b, h) do { _Pragma("unroll") for (int m = 0; m < 4; ++m) { dst[m][0] = *(const LAS bf16x8*)(lds + GE_SA(b, h) + aoff + m * 2048); dst[m][1] = *(const LAS bf16x8*)(lds + GE_SA(b, h) + aoff1 + m * 2048); } } while (0)
#define GE_LDB(dst, b, h) do { _Pragma("unroll") for (int n = 0; n < 2; ++n) { dst[n][0] = *(const LAS bf16x8*)(lds + GE_SB(b, h) + boff + n * 2048); dst[n][1] = *(const LAS bf16x8*)(lds + GE_SB(b, h) + boff1 + n * 2048); } } while (0)
#define GE_CAT(x0, x1) __builtin_shufflevector(__builtin_bit_cast(u32x4, x0), __builtin_bit_cast(u32x4, x1), 0, 1, 2, 3, 4, 5, 6, 7)
#define GE_MMA(ai, bj, At, Bt) do { __builtin_amdgcn_s_setprio(1); _Pragma("unroll") for (int m = 0; m < 4; ++m) _Pragma("unroll") for (int n = 0; n < 2; ++n) { \
        if constexpr (FP8) acc[ai][bj][m][n] = __builtin_amdgcn_mfma_scale_f32_16x16x128_f8f6f4(__builtin_bit_cast(i32x8, GE_CAT(Bt[n][0], Bt[n][1])), __builtin_bit_cast(i32x8, GE_CAT(At[m][0], At[m][1])), acc[ai][bj][m][n], 0, 0, 0, SCALE_W, 0, SCALE_A); \
        else { _Pragma("unroll") for (int k = 0; k < 2; ++k) acc[ai][bj][m][n] = __builtin_amdgcn_mfma_f32_16x16x32_bf16(Bt[n][k], At[m][k], acc[ai][bj][m][n], 0, 0, 0); } } __builtin_amdgcn_s_setprio(0); } while (0)
#define GE_WAIT_V(n) asm volatile("s_waitcnt vmcnt(" #n ")" ::: "memory")
#define GE_WAIT_L(n) asm volatile("s_waitcnt lgkmcnt(" #n ")" ::: "memory")
#define GE_BAR __builtin_amdgcn_s_barrier()
#define GE_SCHED __builtin_amdgcn_sched_barrier(0)
#define GE_OFFS(u, oA00, oA01, oA10, oA11, oB0, oB1) do { \
        int tq_ = tid; asm volatile("" : "+v"(tq_)); int R0, C0, R1, C1; stage_rc(tq_ * 16, R0, C0); stage_rc(tq_ * 16 + 8192, R1, C1); \
        const int Rb0 = (R0 & ~31) + perm32(R0 & 31), Rb1 = (R1 & ~31) + perm32(R1 & 31); \
        int r00 = R0, r01 = R1, r10 = 128 + R0, r11 = 128 + R1; \
        if ((u).gat) { const int* g_ = (u).gat; const int nv_ = (u).nvalid, sh_ = (u).gshift; \
            r00 = (r00 < nv_) ? (g_[2 * r00] >> sh_) : 0; r01 = (r01 < nv_) ? (g_[2 * r01] >> sh_) : 0; r10 = (r10 < nv_) ? (g_[2 * r10] >> sh_) : 0; r11 = (r11 < nv_) ? (g_[2 * r11] >> sh_) : 0; } \
        oA00 = (unsigned)r00 * (u).lda + (unsigned)C0 * 2u; oA01 = (unsigned)r01 * (u).lda + (unsigned)C1 * 2u; \
        oA10 = (unsigned)r10 * (u).lda + (unsigned)C0 * 2u; oA11 = (unsigned)r11 * (u).lda + (unsigned)C1 * 2u; \
        oB0 = (unsigned)Rb0 * (u).ldb + (unsigned)C0 * 2u; oB1 = (unsigned)Rb1 * (u).ldb + (unsigned)C1 * 2u; } while (0)
    Unit cur, nxt; int ui = 0;
    if (!S.next(0, cur)) return;
    Acc acc;
#pragma unroll
    for (int a = 0; a < 2; ++a)
#pragma unroll
        for (int b = 0; b < 2; ++b)
#pragma unroll
            for (int m = 0; m < 4; ++m)
#pragma unroll
                for (int n = 0; n < 2; ++n) acc[a][b][m][n] = (f32x4){0.f, 0.f, 0.f, 0.f};
    bf16x8 At[4][2], B0[2][2], B1[2][2];
    unsigned oA00, oA01, oA10, oA11, oB0, oB1;
    GE_OFFS(cur, oA00, oA01, oA10, oA11, oB0, oB1);
    typename Epi::Pre pre = E.prefetch(cur, wr, wc, fr, fq);
    const char* cA = cur.A; const char* cB = cur.B; size_t chB = (size_t)128 * cur.ldb;
    const size_t kstep = 128;
    GE_STAGE(GE_SB(0, 0), cB, oB0, oB1); GE_STAGE(GE_SA(0, 0), cA, oA00, oA01); GE_STAGE(GE_SB(0, 1), cB + chB, oB0, oB1); GE_STAGE(GE_SA(0, 1), cA, oA10, oA11);
    if (wr == 1) GE_BAR;
    GE_WAIT_V(4); GE_BAR;
    GE_STAGE(GE_SB(1, 0), cB + kstep, oB0, oB1); GE_STAGE(GE_SA(1, 0), cA + kstep, oA00, oA01); GE_STAGE(GE_SB(1, 1), cB + chB + kstep, oB0, oB1);
    GE_WAIT_V(6); GE_BAR;
    for (;;) {
        const bool has_next = S.next(ui + 1, nxt);
        const char* nA = has_next ? nxt.A : cA; const char* nB = has_next ? nxt.B : cB; const size_t nhB = has_next ? (size_t)128 * nxt.ldb : chB;
        const int nt = cur.nt;
        for (int t = 0; t < nt; t += 2) {
            const bool last = (t == nt - 2);
            const char* a1 = cA + (size_t)(t + 1) * kstep;
            const char* a2 = last ? nA : cA + (size_t)(t + 2) * kstep; const char* b2 = last ? nB : cB + (size_t)(t + 2) * kstep;
            const size_t hB2 = last ? nhB : chB;
            const char* a3 = a2 + kstep; const char* b3 = b2 + kstep;
            GE_LDB(B0, 0, 0); GE_SCHED; GE_LDA(At, 0, 0); GE_STAGE(GE_SA(1, 1), a1, oA10, oA11);
            if (last && has_next) { GE_OFFS(nxt, oA00, oA01, oA10, oA11, oB0, oB1); }
            GE_WAIT_L(8); GE_BAR; GE_WAIT_L(0); GE_MMA(0, 0, At, B0); GE_BAR; GE_SCHED;
            GE_LDB(B1, 0, 1); GE_STAGE(GE_SB(0, 0), b2, oB0, oB1);
            GE_BAR; GE_WAIT_L(0); GE_MMA(0, 1, At, B1); GE_BAR;
            GE_LDA(At, 0, 1); GE_STAGE(GE_SA(0, 0), a2, oA00, oA01);
            GE_BAR; GE_WAIT_L(0); GE_MMA(1, 0, At, B0); GE_BAR; GE_SCHED;
            GE_STAGE(GE_SB(0, 1), b2 + hB2, oB0, oB1);
            GE_WAIT_V(6); GE_BAR; GE_MMA(1, 1, At, B1); GE_BAR;
            GE_LDB(B0, 1, 0); GE_SCHED; GE_LDA(At, 1, 0); GE_STAGE(GE_SA(0, 1), a2, oA10, oA11);
            GE_WAIT_L(8); GE_BAR; GE_WAIT_L(0); GE_MMA(0, 0, At, B0); GE_BAR; GE_SCHED;
            GE_LDB(B1, 1, 1); GE_STAGE(GE_SB(1, 0), b3, oB0, oB1);
            GE_BAR; GE_WAIT_L(0); GE_MMA(0, 1, At, B1); GE_BAR;
            GE_LDA(At, 1, 1); GE_STAGE(GE_SA(1, 0), a3, oA00, oA01);
            GE_BAR; GE_WAIT_L(0); GE_MMA(1, 0, At, B0); GE_BAR; GE_SCHED;
            GE_STAGE(GE_SB(1, 1), b3 + hB2, oB0, oB1);
            GE_WAIT_V(6); GE_BAR; GE_MMA(1, 1, At, B1); GE_BAR;
        }
        if constexpr (!Epi::AFTER_DRAIN) E(acc, cur, wr, wc, fr, fq, pre);
        if (!has_next) break;
#pragma unroll
        for (int a = 0; a < 2; ++a)
#pragma unroll
            for (int b = 0; b < 2; ++b)
#pragma unroll
                for (int m = 0; m < 4; ++m)
#pragma unroll
                    for (int n = 0; n < 2; ++n) acc[a][b][m][n] = (f32x4){0.f, 0.f, 0.f, 0.f};
        cur = nxt; cA = nA; cB = nB; chB = nhB; ++ui; pre = E.prefetch(cur, wr, wc, fr, fq);
    }
    GE_WAIT_V(0);
    if (wr == 0) GE_BAR;
    GE_BAR;
    if constexpr (Epi::AFTER_DRAIN) E.drained(acc, cur, wr, wc, fr, fq, lds);
#undef GE_SA
#undef GE_SB
#undef GE_STAGE
#undef GE_LDA
#undef GE_LDB
#undef GE_MMA
#undef GE_WAIT_V
#undef GE_WAIT_L
#undef GE_BAR
#undef GE_SCHED
#undef GE_OFFS
#undef GE_CAT
}
__device__ __forceinline__ bool static_tile(long L, int nM, int nN, int& pm, int& pn) {
    const int nwg = nM * nN; if (L >= nwg) return false;
    int wgid = (int)L; { const int q = nwg / 8, r = nwg % 8, xcd = wgid % 8, off = wgid / 8; wgid = (xcd < r ? xcd * (q + 1) : r * (q + 1) + (xcd - r) * q) + off; }
    const int nig = 8 * nN, gid = wgid / nig, fm = gid * 8, gsz = (nM - fm) < 8 ? (nM - fm) : 8;
    pm = fm + ((wgid % nig) % gsz); pn = (wgid % nig) / gsz; return true;
}
}

struct Frame {
    LAS unsigned char* lds;
    int tid, lane, wave, G, vcu;
    unsigned char* ws;
    float* out;
};
#define WSP(T_, off) ((T_*)(F.ws + (off)))

extern __shared__ __attribute__((aligned(16))) unsigned char lds_raw[];
__device__ __forceinline__ Params load_params() {
    typedef const __attribute__((address_space(4))) unsigned long long cu64;
    cu64* k = (cu64*)__builtin_amdgcn_kernarg_segment_ptr();
    asm volatile("" : "+s"(k));
    Params P;
#pragma unroll
    for (int i = 0; i < 38; ++i) P.in[i] = (const float*)(const __attribute__((address_space(1))) float*)k[i];
    P.out = (float*)(__attribute__((address_space(1))) float*)k[38]; P.ws = (unsigned char*)(__attribute__((address_space(1))) unsigned char*)k[39];
    P.phase_lo = 0; P.phase_hi = 0; P.layer_lo = 0; P.layer_hi = 0;
    return P;
}
#define KPARAMS() load_params()
__device__ __forceinline__ Frame make_frame(unsigned char* ws, float* out) {
    Frame F;
    F.lds = (LAS unsigned char*)lds_raw;
    int tz = threadIdx.x; asm volatile("" : "+v"(tz));
    F.tid = tz; F.lane = F.tid & 63; F.wave = __builtin_amdgcn_readfirstlane(F.tid >> 6);
    F.G = gridDim.x; { const int bx = blockIdx.x; F.vcu = (F.G % 8 == 0) ? (bx % 8) * (F.G / 8) + bx / 8 : bx; }
    F.ws = ws; F.out = out;
    return F;
}
template <bool FP8OUT, class ColMap>
__device__ __forceinline__ void transpose_item(const float* W, int ldw, int K, void* WTv, int nblk, LAS float* scr, int item, int lane, const ColMap& cm) {
    const int kb = item / nblk, nb = item % nblk, k0 = 64 * kb, n0 = 32 * nb;
    const int sc = cm(n0 + (lane & 31));
#pragma unroll 8
    for (int i = 0; i < 32; ++i) { const int kk = 2 * i + (lane >> 5); scr[kk * 33 + (lane & 31)] = (sc >= 0) ? W[(size_t)(k0 + kk) * ldw + sc] : 0.f; }
    asm volatile("s_waitcnt lgkmcnt(0)" ::: "memory");
    const int c = lane & 7;
#pragma unroll
    for (int j = 0; j < 4; ++j) { const int n = (lane >> 3) + 8 * j; const LAS float* s = scr + (8 * c) * 33 + n;
        if (FP8OUT) { u32x2 o; o.x = pack_fp8x4(32.f * s[0 * 33], 32.f * s[1 * 33], 32.f * s[2 * 33], 32.f * s[3 * 33]); o.y = pack_fp8x4(32.f * s[4 * 33], 32.f * s[5 * 33], 32.f * s[6 * 33], 32.f * s[7 * 33]);
            *(u32x2*)((unsigned char*)WTv + (size_t)(n0 + n) * K + k0 + 8 * c) = o; }
        else { u32x4 o; o.x = cvt_pk_bf16(s[0 * 33], s[1 * 33]); o.y = cvt_pk_bf16(s[2 * 33], s[3 * 33]); o.z = cvt_pk_bf16(s[4 * 33], s[5 * 33]); o.w = cvt_pk_bf16(s[6 * 33], s[7 * 33]);
            *(u32x4*)((bf16_t*)WTv + (size_t)(n0 + n) * K + k0 + 8 * c) = o; } }
    asm volatile("s_waitcnt lgkmcnt(0)" ::: "memory");
}
struct CmIdent { __device__ __forceinline__ int operator()(int n) const { return n; } };
struct CmInproj { int layer; __device__ __forceinline__ int operator()(int j) const {
    if (j < 1536) return j;
    if (j < 1792) { const int q = j - 1536; if (q < 160) return 1536 + q; if (q < 192) return layer > 0 ? 5792 + (q - 160) : -1; return -1; }
    if (j < 2304) return 1696 + (j - 1792);
    if (j < 2816) { const int jj = j - 2304, c = jj >> 1; return (jj & 1) ? 2208 + 256 + c : 2208 + c; }
    return 2720 + (j - 2816); } };
struct CmRouter { __device__ __forceinline__ int operator()(int n) const { return n < 32 ? n : -1; } };
struct CmGU { __device__ __forceinline__ int operator()(int n) const { return n; } };

__device__ __forceinline__ void phase_convert_static(Frame& F, const Params& P) {
    LAS float* scr = (LAS float*)(F.lds + F.wave * 8448);
    const int gw = F.vcu * 8 + F.wave, NGW = F.G * 8;
    constexpr int I_IN = 16 * (NIN / 32);
    for (int it = gw; it < NL * I_IN; it += NGW) { const int l = it / I_IN, r = it % I_IN;
        const float* W = (l == 0) ? P.in[1] : P.in[2] + (size_t)(l - 1) * 1024 * 5824; const int ldw = (l == 0) ? 5792 : 5824;
        transpose_item<true>(W, ldw, 1024, WSP(unsigned char, WS_WIN) + (size_t)l * NIN * 1024, NIN / 32, scr, r, F.lane, CmInproj{l}); }
    constexpr int I_A = 8 * 32, I_B = 4 * 32;
    for (int it = gw; it < NL * (I_A + 2 * I_B); it += NGW) { const int l = it / (I_A + 2 * I_B); int r = it % (I_A + 2 * I_B);
        unsigned char* base = WSP(unsigned char, WS_WBR) + (size_t)l * (1024 * 1024);
        if (r < I_A) { transpose_item<true>(P.in[17] + (size_t)l * 512 * 1024, 1024, 512, base, 32, scr, r, F.lane, CmIdent{}); continue; } r -= I_A;
        if (r < I_B) { transpose_item<true>(P.in[22] + (size_t)l * 256 * 1024, 1024, 256, base + 1024 * 512, 32, scr, r, F.lane, CmIdent{}); continue; } r -= I_B;
        transpose_item<true>(P.in[27] + (size_t)l * 256 * 1024, 1024, 256, base + 1024 * 512 + 1024 * 256, 32, scr, r, F.lane, CmIdent{}); }
    constexpr int I_O = 16 * 32;
    for (int it = gw; it < NL * I_O; it += NGW) { const int l = it / I_O, r = it % I_O;
        transpose_item<true>(P.in[28] + (size_t)l * 1024 * 1024, 1024, 1024, WSP(unsigned char, WS_WOUT) + (size_t)l * 1024 * 1024, 32, scr, r, F.lane, CmIdent{}); }
    for (int it = gw; it < 16 * 8; it += NGW) transpose_item<false>(P.in[31], 32, 1024, WSP(bf16_t, WS_WRT), 8, scr, it, F.lane, CmRouter{});
}
template <bool FP8OUT> __device__ __forceinline__ void moe_item_store(void* WTv, int K, int k0, int n0, LAS float* scr, int lane) {
    asm volatile("s_waitcnt lgkmcnt(0)" ::: "memory");
    const int c = lane & 7;
#pragma unroll
    for (int j = 0; j < 4; ++j) { const int nn = (lane >> 3) + 8 * j; const LAS float* s = scr + (8 * c) * 33 + nn;
        if (FP8OUT) { u32x2 o; o.x = pack_fp8x4(32.f * s[0 * 33], 32.f * s[1 * 33], 32.f * s[2 * 33], 32.f * s[3 * 33]); o.y = pack_fp8x4(32.f * s[4 * 33], 32.f * s[5 * 33], 32.f * s[6 * 33], 32.f * s[7 * 33]);
            *(u32x2*)((unsigned char*)WTv + (size_t)(n0 + nn) * K + k0 + 8 * c) = o; }
        else { u32x4 o; o.x = cvt_pk_bf16(s[0 * 33], s[1 * 33]); o.y = cvt_pk_bf16(s[2 * 33], s[3 * 33]); o.z = cvt_pk_bf16(s[4 * 33], s[5 * 33]); o.w = cvt_pk_bf16(s[6 * 33], s[7 * 33]);
            *(u32x4*)((bf16_t*)WTv + (size_t)(n0 + nn) * K + k0 + 8 * c) = o; } }
    asm volatile("s_waitcnt lgkmcnt(0)" ::: "memory");
}
__device__ __forceinline__ unsigned char* moe_wbuf(Frame& F, int l) { return (l & 1) ? (unsigned char*)F.out : F.ws + WS_WMOE; }
__device__ __forceinline__ void phase_convert_moe(Frame& F, const Params& P, int l) {
    LAS float* scr = (LAS float*)(F.lds + F.wave * 8448);
    const int gw = F.vcu * 8 + F.wave, NGW = F.G * 8; const int lane = F.lane;
    constexpr int I_GU = 16 * 32;
    constexpr int I_DN = 8 * 32;
    for (int it = gw; it < NE * I_GU; it += NGW) { const int e = it / I_GU, item = it % I_GU;
        const int kb = item / 32, nb = item % 32, k0 = 64 * kb, n0 = 32 * nb;
        const int m = (lane >> 2) & 1, c4 = (lane & 3) * 4;
        const float* Ws = ((m ? P.in[34] : P.in[33]) + ((size_t)l * NE + e) * 1024 * 512) + (n0 >> 1) + c4;
        f32x4 v[8];
#pragma unroll
        for (int i = 0; i < 8; ++i) v[i] = *(const f32x4*)(Ws + (size_t)(k0 + 8 * i + (lane >> 3)) * 512);
#pragma unroll
        for (int i = 0; i < 8; ++i) { LAS float* d = scr + (8 * i + (lane >> 3)) * 33 + 2 * c4 + m; d[0] = v[i][0]; d[2] = v[i][1]; d[4] = v[i][2]; d[6] = v[i][3]; }
        moe_item_store<true>(moe_wbuf(F, l) + (size_t)e * 1024 * 1024, 1024, k0, n0, scr, lane); }
    for (int it = gw; it < NE * I_DN; it += NGW) { const int e = it / I_DN, item = it % I_DN;
        const int kb = item / 32, nb = item % 32, k0 = 64 * kb, n0 = 32 * nb; const int c4 = (lane & 7) * 4;
        const float* Ws = P.in[35] + ((size_t)l * NE + e) * 512 * 1024 + n0 + c4;
        f32x4 v[8];
#pragma unroll
        for (int i = 0; i < 8; ++i) v[i] = *(const f32x4*)(Ws + (size_t)(k0 + 8 * i + (lane >> 3)) * 1024);
#pragma unroll
        for (int i = 0; i < 8; ++i) { LAS float* d = scr + (8 * i + (lane >> 3)) * 33 + c4; d[0] = v[i][0]; d[1] = v[i][1]; d[2] = v[i][2]; d[3] = v[i][3]; }
        moe_item_store<true>(moe_wbuf(F, l) + (size_t)NE * 1024 * 1024 + (size_t)e * 1024 * 512, 512, k0, n0, scr, lane); }
}
__device__ __forceinline__ void phase_convert_lora(Frame& F, const Params& P) {
    bf16_t* dst = WSP(bf16_t, WS_LORA);
    for (int idx = (int)blockIdx.x * 512 + F.tid; idx < 11 * 512 * 32 + 4 * 512 * 96; idx += F.G * 512) {
        float val;
        if (idx < 11 * 512 * 32) { const int m = idx / (512 * 32), rem = idx % (512 * 32), ch = rem / 32, i = rem % 32;
            if (m < 4) val = P.in[6][((size_t)m * 32 + i) * 512 + ch]; else if (m < 8) val = P.in[8][((size_t)(m - 4) * 32 + i) * 512 + ch]; else val = P.in[11][((size_t)(m - 8) * 32 + i) * 512 + ch]; }
        else { const int r2 = idx - 11 * 512 * 32, m = r2 / (512 * 96), rem = r2 % (512 * 96), ch = rem / 96, i = rem % 96; val = P.in[9][((size_t)m * 96 + i) * 512 + ch]; }
        dst[idx] = f2bf(val); }
}
__device__ __forceinline__ void phase_convert_sgu(Frame& F, const Params& P) {
    bf16_t* dst = WSP(bf16_t, WS_SGUW);
    for (int idx = (int)blockIdx.x * 512 + F.tid; idx < NL * 4 * 128 * 128; idx += F.G * 512) { const int p = (idx >> 7) & 127, qq = idx & 127; dst[idx] = f2bf(qq <= p ? P.in[20][idx] : 0.f); }
}
__device__ __forceinline__ void phase_convert_router(Frame& F, const Params& P) {
    bf16_t* dst = WSP(bf16_t, WS_WRG); float* rc = WSP(float, WS_RC);
    for (int idx = (int)blockIdx.x * 512 + F.tid; idx < NL * 256 * 1024; idx += F.G * 512) { const int l = idx >> 18, n = (idx >> 10) & 255, k = idx & 1023;
        dst[idx] = f2bf(n < 32 ? P.in[29][(size_t)l * 1024 + k] * P.in[31][(size_t)k * 32 + n] : 0.f); }
    const int gt = (int)blockIdx.x * 512 + F.tid;
    if (gt < NL * 32) { const int l = gt >> 5, e = gt & 31; float c1 = 0.f, c0 = 0.f;
        for (int k = 0; k < 1024; ++k) { const float w = P.in[31][(size_t)k * 32 + e]; c1 += P.in[29][(size_t)l * 1024 + k] * w; c0 += P.in[30][(size_t)l * 1024 + k] * w; }
        rc[l * 64 + e] = c1; rc[l * 64 + 32 + e] = c0; }
}
__device__ __forceinline__ void phase_x_to_bf16(Frame& F, const Params& P) {
    const size_t n8 = (size_t)T * D / 8; const float* x = P.in[0]; bf16_t* xb = WSP(bf16_t, WS_X); unsigned char* xq = WSP(unsigned char, WS_XQ);
    for (size_t i = (size_t)blockIdx.x * 512 + F.tid; i < n8; i += (size_t)F.G * 512) {
        const f32x4 a = *(const f32x4*)(x + i * 8), b = *(const f32x4*)(x + i * 8 + 4);
        u32x4 o; o.x = cvt_pk_bf16(a[0], a[1]); o.y = cvt_pk_bf16(a[2], a[3]); o.z = cvt_pk_bf16(b[0], b[1]); o.w = cvt_pk_bf16(b[2], b[3]);
        *(u32x4*)(xb + i * 8) = o;
        u32x2 qv; qv.x = pack_fp8x4(a[0], a[1], a[2], a[3]); qv.y = pack_fp8x4(b[0], b[1], b[2], b[3]); *(u32x2*)(xq + i * 8) = qv; }
}

struct SchedInproj { const char* X; const char* W; int G, c;
    __device__ __forceinline__ bool next(int i, ge::Unit& u) const { int pm, pn; if (!ge::static_tile((long)i * G + c, T / 256, NIN / 256, pm, pn)) return false;
        u.A = X + (size_t)pm * 256 * 1024; u.B = W + (size_t)pn * 256 * 1024; u.gat = nullptr; u.lda = 1024; u.ldb = 1024; u.nt = 8; u.gshift = 0; u.nvalid = 256; u.pm = pm; u.pn = pn; u.aux = 0; return true; } };
struct EpiInproj { static constexpr bool AFTER_DRAIN = false; bf16_t* rkv; bf16_t* sguz; bf16_t* convh; unsigned char* gates;
    typedef ge::NoPre Pre; __device__ __forceinline__ Pre prefetch(const ge::Unit&, int, int, int, int) const { return Pre{}; }
    __device__ __forceinline__ void operator()(const ge::Acc& acc, const ge::Unit& u, int wr, int wc, int fr, int fq, const Pre&) const {
        const int pn = u.pn; const int row0 = u.pm * 256 + wr * 64 + fr;
        int kind, ld, colt; bf16_t* base;
        if (pn < 7) { kind = 0; base = rkv; ld = RKVW; colt = pn * 256; }
        else if (pn < 9) { kind = 1; base = sguz; ld = 512; colt = (pn - 7) * 256; }
        else if (pn < 11) { kind = 2; base = convh; ld = 256; colt = (pn - 9) * 128; }
        else { kind = 3; base = rkv; ld = 3072; colt = (pn - 11) * 256; }
#pragma unroll
        for (int ai = 0; ai < 2; ++ai)
#pragma unroll
            for (int m = 0; m < 4; ++m) { const size_t r = (size_t)(row0 + ai * 128 + m * 16);
#pragma unroll
                for (int bj = 0; bj < 2; ++bj) { const int c = 128 * bj + 32 * wc + 8 * fq; f32x4 v0 = acc[ai][bj][m][0], v1 = acc[ai][bj][m][1];
                    if (kind == 2) {
                        const float h0 = v0[0] * sigmoidf_(v0[1]), h1 = v0[2] * sigmoidf_(v0[3]), h2 = v1[0] * sigmoidf_(v1[1]), h3 = v1[2] * sigmoidf_(v1[3]);
                        u32x2 w; w.x = cvt_pk_bf16(h0, h1); w.y = cvt_pk_bf16(h2, h3);
                        *(u32x2*)(base + r * ld + colt + (c >> 1)) = w;
                    } else if (kind == 3) {
                        u32x2 w; unsigned w0 = 0, w1 = 0;
                        w0 = __builtin_amdgcn_cvt_pk_u8_f32(255.f * sigmoidf_(v0[0]) + 0.5f, 0, w0); w0 = __builtin_amdgcn_cvt_pk_u8_f32(255.f * sigmoidf_(v0[1]) + 0.5f, 1, w0);
                        w0 = __builtin_amdgcn_cvt_pk_u8_f32(255.f * sigmoidf_(v0[2]) + 0.5f, 2, w0); w0 = __builtin_amdgcn_cvt_pk_u8_f32(255.f * sigmoidf_(v0[3]) + 0.5f, 3, w0);
                        w1 = __builtin_amdgcn_cvt_pk_u8_f32(255.f * sigmoidf_(v1[0]) + 0.5f, 0, w1); w1 = __builtin_amdgcn_cvt_pk_u8_f32(255.f * sigmoidf_(v1[1]) + 0.5f, 1, w1);
                        w1 = __builtin_amdgcn_cvt_pk_u8_f32(255.f * sigmoidf_(v1[2]) + 0.5f, 2, w1); w1 = __builtin_amdgcn_cvt_pk_u8_f32(255.f * sigmoidf_(v1[3]) + 0.5f, 3, w1);
                        w.x = w0; w.y = w1; *(u32x2*)(gates + r * 3072 + colt + c) = w;
                    } else {
                        if (kind == 1) {
#pragma unroll
                            for (int j = 0; j < 4; ++j) { v0[j] = gelu_f(v0[j]); v1[j] = gelu_f(v1[j]); } }
                        u32x4 w; w.x = cvt_pk_bf16(v0[0], v0[1]); w.y = cvt_pk_bf16(v0[2], v0[3]); w.z = cvt_pk_bf16(v1[0], v1[1]); w.w = cvt_pk_bf16(v1[2], v1[3]);
                        *(u32x4*)(base + r * ld + colt + c) = w; } } }
    } };
struct EpiNull { static constexpr bool AFTER_DRAIN = false; bf16_t* sink;
    typedef ge::NoPre Pre; __device__ __forceinline__ Pre prefetch(const ge::Unit&, int, int, int, int) const { return Pre{}; }
    __device__ __forceinline__ void operator()(const ge::Acc& acc, const ge::Unit& u, int wr, int wc, int fr, int fq, const Pre&) const {
        float t = 0.f;
#pragma unroll
        for (int ai = 0; ai < 2; ++ai)
#pragma unroll
            for (int bj = 0; bj < 2; ++bj)
#pragma unroll
                for (int m = 0; m < 4; ++m)
#pragma unroll
                    for (int n = 0; n < 2; ++n) t += acc[ai][bj][m][n][0];
        if (t == 123456.789f) sink[0] = f2bf(t); } };
struct SchedBranch { const char* ws; size_t woff; int G, v;
    __device__ __forceinline__ bool next(int i, ge::Unit& u) const { const int tile = (i / 3) * G + v, br = i % 3, pm = tile >> 2, pn = tile & 3; if (tile >= 512) return false;
        const unsigned kb = (br == 0) ? 512u : 256u;
        size_t ao = WS_OUTA, wo = woff; if (br == 1) { ao = WS_HB; wo += (size_t)1024 * 512; } if (br == 2) { ao = WS_HC; wo += (size_t)1024 * 512 + (size_t)1024 * 256; }
        u.A = ws + ao + (size_t)pm * 256 * kb; u.lda = kb; u.nt = (int)(kb >> 7); u.B = ws + wo + (size_t)pn * 256 * kb; u.ldb = kb;
        u.gat = nullptr; u.gshift = 0; u.nvalid = 256; u.pm = pm; u.pn = pn; u.aux = br; return true; } };
struct EpiBranch { static constexpr bool AFTER_DRAIN = false; const unsigned char* gates; bf16_t* merged; unsigned char* mq;
    typedef ge::NoPre Pre; __device__ __forceinline__ Pre prefetch(const ge::Unit&, int, int, int, int) const { return Pre{}; }
    __device__ __forceinline__ void operator()(const ge::Acc& acc, const ge::Unit& u, int wr, int wc, int fr, int fq, const Pre&) const {
        const int br = u.aux; const int row0 = u.pm * 256 + wr * 64 + fr;
#pragma unroll
        for (int ai = 0; ai < 2; ++ai) {
            u32x2 g[8]; u32x4 p[8];
#pragma unroll
            for (int m = 0; m < 4; ++m)
#pragma unroll
                for (int bj = 0; bj < 2; ++bj) { const size_t r = (size_t)(row0 + ai * 128 + m * 16); const int c = u.pn * 256 + 128 * bj + 32 * wc + 8 * fq;
                    g[m * 2 + bj] = *(const u32x2*)(gates + r * 3072 + br * 1024 + c);
                    p[m * 2 + bj] = (br > 0) ? *(const u32x4*)(merged + r * 1024 + c) : (u32x4){0u, 0u, 0u, 0u}; }
#pragma unroll
            for (int m = 0; m < 4; ++m)
#pragma unroll
                for (int bj = 0; bj < 2; ++bj) { const size_t r = (size_t)(row0 + ai * 128 + m * 16); const int c = u.pn * 256 + 128 * bj + 32 * wc + 8 * fq;
                    const f32x4 v0 = acc[ai][bj][m][0], v1 = acc[ai][bj][m][1]; const u32x2 gg = g[m * 2 + bj]; const u32x4 pp = p[m * 2 + bj];
                    const float k = 1.f / 255.f;
                    const float g0 = k * (float)(gg.x & 0xffu), g1 = k * (float)((gg.x >> 8) & 0xffu), g2 = k * (float)((gg.x >> 16) & 0xffu), g3 = k * (float)(gg.x >> 24);
                    const float g4 = k * (float)(gg.y & 0xffu), g5 = k * (float)((gg.y >> 8) & 0xffu), g6 = k * (float)((gg.y >> 16) & 0xffu), g7 = k * (float)(gg.y >> 24);
                    u32x4 w; w.x = cvt_pk_bf16(v0[0] * g0 + bflo(pp.x), v0[1] * g1 + bfhi(pp.x)); w.y = cvt_pk_bf16(v0[2] * g2 + bflo(pp.y), v0[3] * g3 + bfhi(pp.y));
                    w.z = cvt_pk_bf16(v1[0] * g4 + bflo(pp.z), v1[1] * g5 + bfhi(pp.z)); w.w = cvt_pk_bf16(v1[2] * g6 + bflo(pp.w), v1[3] * g7 + bfhi(pp.w));
                    if (br == 2) { u32x2 wq; wq.x = pack_fp8x4(4.f * (v0[0] * g0 + bflo(pp.x)), 4.f * (v0[1] * g1 + bfhi(pp.x)), 4.f * (v0[2] * g2 + bflo(pp.y)), 4.f * (v0[3] * g3 + bfhi(pp.y)));
                        wq.y = pack_fp8x4(4.f * (v1[0] * g4 + bflo(pp.z)), 4.f * (v1[1] * g5 + bfhi(pp.z)), 4.f * (v1[2] * g6 + bflo(pp.w)), 4.f * (v1[3] * g7 + bfhi(pp.w))); *(u32x2*)(mq + r * 1024 + c) = wq; }
                    else *(u32x4*)(merged + r * 1024 + c) = w; }
            asm volatile("" ::: "memory"); }
    } };
struct SchedWout { const char* A; const char* W; int G, v;
    __device__ __forceinline__ bool next(int i, ge::Unit& u) const { const int tile = i * G + v, pm = tile >> 2, pn = tile & 3; if (tile >= 512) return false;
        u.A = A + (size_t)pm * 256 * 1024; u.B = W + (size_t)pn * 256 * 1024; u.gat = nullptr; u.lda = 1024; u.ldb = 1024; u.nt = 8; u.gshift = 0; u.nvalid = 256; u.pm = pm; u.pn = pn; u.aux = 0; return true; } };
struct EpiWout { static constexpr bool AFTER_DRAIN = false; const bf16_t* x; bf16_t* pre; float* stats;
    typedef ge::NoPre Pre; __device__ __forceinline__ Pre prefetch(const ge::Unit&, int, int, int, int) const { return Pre{}; }
    __device__ __forceinline__ void operator()(const ge::Acc& acc, const ge::Unit& u, int wr, int wc, int fr, int fq, const Pre&) const {
        const int row0 = u.pm * 256 + wr * 64 + fr;
#pragma unroll
        for (int ai = 0; ai < 2; ++ai)
#pragma unroll
            for (int m = 0; m < 4; ++m) { const size_t r = (size_t)(row0 + ai * 128 + m * 16); float s1 = 0.f, s2 = 0.f;
#pragma unroll
                for (int bj = 0; bj < 2; ++bj) { const int c = u.pn * 256 + 128 * bj + 32 * wc + 8 * fq; const f32x4 v0 = acc[ai][bj][m][0], v1 = acc[ai][bj][m][1];
                    const u32x4 p = *(const u32x4*)(x + r * 1024 + c);
                    u32x4 w; w.x = cvt_pk_bf16(v0[0] + ALPHA * bflo(p.x), v0[1] + ALPHA * bfhi(p.x)); w.y = cvt_pk_bf16(v0[2] + ALPHA * bflo(p.y), v0[3] + ALPHA * bfhi(p.y));
                    w.z = cvt_pk_bf16(v1[0] + ALPHA * bflo(p.z), v1[1] + ALPHA * bfhi(p.z)); w.w = cvt_pk_bf16(v1[2] + ALPHA * bflo(p.w), v1[3] + ALPHA * bfhi(p.w));
                    *(u32x4*)(pre + r * 1024 + c) = w;
                    const float q0 = bflo(w.x), q1 = bfhi(w.x), q2 = bflo(w.y), q3 = bfhi(w.y), q4 = bflo(w.z), q5 = bfhi(w.z), q6 = bflo(w.w), q7 = bfhi(w.w);
                    s1 += ((q0 + q1) + (q2 + q3)) + ((q4 + q5) + (q6 + q7)); s2 += ((q0 * q0 + q1 * q1) + (q2 * q2 + q3 * q3)) + ((q4 * q4 + q5 * q5) + (q6 * q6 + q7 * q7)); }
                s1 += __shfl_xor(s1, 16); s2 += __shfl_xor(s2, 16); s1 += __shfl_xor(s1, 32); s2 += __shfl_xor(s2, 32);
                if (fq == 0) *(f32x2*)(stats + (r * 16 + u.pn * 4 + wc) * 2) = (f32x2){s1, s2};
                asm volatile("" ::: "memory"); }
    } };
struct SchedRouter { const char* A; const char* W; int G, v;
    __device__ __forceinline__ bool next(int i, ge::Unit& u) const { const int pm = i * G + v; if (pm >= 128) return false;
        u.A = A + (size_t)pm * 256 * 2048; u.B = W; u.gat = nullptr; u.lda = 2048; u.ldb = 2048; u.nt = 16; u.gshift = 0; u.nvalid = 256; u.pm = pm; u.pn = 0; u.aux = 0; return true; } };
struct EpiRouter { static constexpr bool AFTER_DRAIN = true; const float* rbias; unsigned* cnt; int* list; const float* stats; const float* rc;
    typedef ge::NoPre Pre; __device__ __forceinline__ Pre prefetch(const ge::Unit&, int, int, int, int) const { return Pre{}; }
    __device__ __forceinline__ void drained(const ge::Acc& acc, const ge::Unit& u, int wr, int wc, int fr, int fq, LAS unsigned char* lds) const {
        LAS int* lcnt = (LAS int*)lds; LAS int* lbase = lcnt + 32;
        const bool t32 = (wr == 0 && wc == 0 && fq < 2); const int t = fq * 16 + fr;
        if (t32) lcnt[t] = 0;
        __syncthreads();
        int e1[8], e2[8], r1[8], r2[8]; float g1[8], g2[8];
        const int row0 = u.pm * 256 + wr * 64 + fr;
        if (wc == 0) {
            float bias[8], c1v[8], c0v[8];
#pragma unroll
            for (int j = 0; j < 8; ++j) { bias[j] = rbias[8 * fq + j]; c1v[j] = rc[8 * fq + j]; c0v[j] = rc[32 + 8 * fq + j]; }
#pragma unroll
            for (int ai = 0; ai < 2; ++ai)
#pragma unroll
                for (int m = 0; m < 4; ++m) { const int i8 = ai * 4 + m;
                    const f32x4 v0 = acc[ai][0][m][0], v1 = acc[ai][0][m][1];
                    float mean, rstd;
                    {   const size_t r = (size_t)(row0 + ai * 128 + m * 16); const f32x4 a0 = *(const f32x4*)(stats + (r * 16 + 4 * fq) * 2), a1 = *(const f32x4*)(stats + (r * 16 + 4 * fq + 2) * 2);
                        float s1 = (a0[0] + a0[2]) + (a1[0] + a1[2]), s2 = (a0[1] + a0[3]) + (a1[1] + a1[3]);
                        s1 += __shfl_xor(s1, 16); s2 += __shfl_xor(s2, 16); s1 += __shfl_xor(s1, 32); s2 += __shfl_xor(s2, 32);
                        mean = s1 * (1.f / 1024.f); rstd = rsqrtf(fmaxf(s2 * (1.f / 1024.f) - mean * mean, 0.f) + LN_EPS); }
                    float s[8], sel[8];
#pragma unroll
                    for (int j = 0; j < 4; ++j) { s[j] = sigmoidf_(rstd * (v0[j] - mean * c1v[j]) + c0v[j]); s[4 + j] = sigmoidf_(rstd * (v1[j] - mean * c1v[4 + j]) + c0v[4 + j]); }
#pragma unroll
                    for (int j = 0; j < 8; ++j) sel[j] = s[j] + bias[j];
                    int i1 = 0; float m1 = sel[0];
#pragma unroll
                    for (int j = 1; j < 8; ++j) if (sel[j] > m1) { m1 = sel[j]; i1 = j; }
                    int i2 = (i1 == 0) ? 1 : 0; float m2 = (i1 == 0) ? sel[1] : sel[0];
#pragma unroll
                    for (int j = 0; j < 8; ++j) if (j != i1 && j != ((i1 == 0) ? 1 : 0) && sel[j] > m2) { m2 = sel[j]; i2 = j; }
                    float gs = m1 + m2; int gi = fq;
                    { const float os = __shfl_xor(gs, 16); const int oi = __shfl_xor(gi, 16); if (os > gs || (os == gs && oi < gi)) { gs = os; gi = oi; } }
                    { const float os = __shfl_xor(gs, 32); const int oi = __shfl_xor(gi, 32); if (os > gs || (os == gs && oi < gi)) { gs = os; gi = oi; } }
                    e1[i8] = -1; e2[i8] = -1; r1[i8] = 0; r2[i8] = 0; g1[i8] = 0.f; g2[i8] = 0.f;
                    if (gi == fq) {
                        float s1 = s[0], s2 = s[0];
#pragma unroll
                        for (int j = 0; j < 8; ++j) { s1 = (j == i1) ? s[j] : s1; s2 = (j == i2) ? s[j] : s2; }
                        const float inv = 1.0f / (s1 + s2);
                        e1[i8] = 8 * fq + i1; e2[i8] = 8 * fq + i2; g1[i8] = s1 * inv; g2[i8] = s2 * inv;
                        r1[i8] = __hip_atomic_fetch_add(lcnt + e1[i8], 1, __ATOMIC_RELAXED, __HIP_MEMORY_SCOPE_WORKGROUP);
                        r2[i8] = __hip_atomic_fetch_add(lcnt + e2[i8], 1, __ATOMIC_RELAXED, __HIP_MEMORY_SCOPE_WORKGROUP); } }
        }
        __syncthreads();
        if (t32) { const int c = lcnt[t]; lbase[t] = (c > 0) ? (int)atomicAdd(cnt + t, (unsigned)c) : 0; }
        __syncthreads();
        if (wc == 0) {
#pragma unroll
            for (int i8 = 0; i8 < 8; ++i8) if (e1[i8] >= 0) { const int r = row0 + (i8 >> 2) * 128 + (i8 & 3) * 16;
                u32x2 p1, p2; p1.x = (unsigned)(2 * r); p1.y = __float_as_uint(g1[i8]); p2.x = (unsigned)(2 * r + 1); p2.y = __float_as_uint(g2[i8]);
                *(u32x2*)(list + ((size_t)e1[i8] * T + lbase[e1[i8]] + r1[i8]) * 2) = p1; *(u32x2*)(list + ((size_t)e2[i8] * T + lbase[e2[i8]] + r2[i8]) * 2) = p2; } }
        __syncthreads();
    } };
__device__ __forceinline__ int build_tile_table(Frame& F, const unsigned* cnt) {
    volatile LAS int* tab = (volatile LAS int*)(F.lds + LDS_MISC + 64);
    __syncthreads();
    if (F.tid == 0) { int n = 0; for (int e = 0; e < NE; ++e) { const int c = (int)__hip_atomic_load(cnt + e, __ATOMIC_RELAXED, __HIP_MEMORY_SCOPE_AGENT); const int nt = (c + 255) >> 8; for (int j = 0; j < nt; ++j) tab[1 + n++] = (e << 16) | j; } tab[0] = n; }
    __syncthreads();
    return tab[0];
}
struct SchedMoe1 { const char* X1; const char* W; const int* list; const unsigned* cnt; LAS int* tab; int ntiles, G, v;
    __device__ __forceinline__ bool next(int i, ge::Unit& u) const { const int L = i * G + v, rt = L >> 2, pn = L & 3; if (rt >= ntiles) return false;
        const int ej = tab[1 + rt], e = ej >> 16, j = ej & 0xffff; const int c = (int)cnt[e];
        u.A = X1; u.gat = list + ((size_t)e * T + j * 256) * 2; u.gshift = 1; u.nvalid = (c - j * 256) < 256 ? (c - j * 256) : 256; u.lda = 1024; u.nt = 8;
        u.B = W + ((size_t)e * 1024 + (size_t)pn * 256) * 1024; u.ldb = 1024; u.pm = rt; u.pn = pn; u.aux = e; return true; } };
struct EpiMoe1 { static constexpr bool AFTER_DRAIN = false; unsigned char* H;
    typedef ge::NoPre Pre; __device__ __forceinline__ Pre prefetch(const ge::Unit&, int, int, int, int) const { return Pre{}; }
    __device__ __forceinline__ void operator()(const ge::Acc& acc, const ge::Unit& u, int wr, int wc, int fr, int fq, const Pre&) const {
        const int row0 = u.pm * 256 + wr * 64 + fr;
#pragma unroll
        for (int ai = 0; ai < 2; ++ai)
#pragma unroll
            for (int m = 0; m < 4; ++m) { const size_t r = (size_t)(row0 + ai * 128 + m * 16);
#pragma unroll
                for (int bj = 0; bj < 2; ++bj) { const int c = 128 * bj + 32 * wc + 8 * fq; const f32x4 v0 = acc[ai][bj][m][0], v1 = acc[ai][bj][m][1];
                    const float h0 = v0[0] * sigmoidf_(v0[0]) * v0[1], h1 = v0[2] * sigmoidf_(v0[2]) * v0[3], h2 = v1[0] * sigmoidf_(v1[0]) * v1[1], h3 = v1[2] * sigmoidf_(v1[2]) * v1[3];
                    *(unsigned*)(H + r * 512 + u.pn * 128 + (c >> 1)) = pack_fp8x4(h0, h1, h2, h3); }
                asm volatile("" ::: "memory"); }
    } };
struct SchedMoe2 { const char* H; const char* W; const int* list; const unsigned* cnt; LAS int* tab; int ntiles, G, v, ntk;
    __device__ __forceinline__ bool next(int i, ge::Unit& u) const { const int L = i * G + v, rt = L >> 2, pn = L & 3; if (rt >= ntiles) return false;
        const int ej = tab[1 + rt], e = ej >> 16, j = ej & 0xffff; const int c = (int)cnt[e];
        u.A = H + (size_t)rt * 256 * 512; u.gat = nullptr; u.gshift = 0; u.nvalid = (c - j * 256) < 256 ? (c - j * 256) : 256; u.lda = 512; u.nt = ntk;
        u.B = W + ((size_t)e * 1024 + (size_t)pn * 256) * 512; u.ldb = 512; u.pm = rt; u.pn = pn; u.aux = (e << 16) | j; return true; } };
template <int MODE> struct EpiMoe2T { static constexpr bool AFTER_DRAIN = false; const int* list; unsigned char* Y; int* inv;
    typedef ge::NoPre Pre; __device__ __forceinline__ Pre prefetch(const ge::Unit&, int, int, int, int) const { return Pre{}; }
    __device__ __forceinline__ void operator()(const ge::Acc& acc, const ge::Unit& u, int wr, int wc, int fr, int fq, const Pre&) const {
        const int e = u.aux >> 16, j = u.aux & 0xffff; const int* lst = list + ((size_t)e * T + j * 256) * 2;
        const unsigned row0 = (unsigned)u.pm * 256u + (unsigned)(wr * 64 + fr); const unsigned col0 = (unsigned)(u.pn * 256 + 32 * wc + 8 * fq);
        const bool invw = (u.pn == 0 && wc == 0 && fq == 0);
#pragma unroll
        for (int ai = 0; ai < 2; ++ai) {
            u32x2 sg[4];
#pragma unroll
            for (int m = 0; m < 4; ++m) { const int rr = ai * 128 + wr * 64 + m * 16 + fr; const u32x2 v = *(const u32x2*)(lst + 2 * (rr < u.nvalid ? rr : 0)); sg[m].x = (rr < u.nvalid) ? v.x : 0xffffffffu; sg[m].y = v.y; }
#pragma unroll
            for (int m = 0; m < 4; ++m) { const int sl = (int)sg[m].x; const float gg = __uint_as_float(sg[m].y);
                const unsigned yrow = row0 + (unsigned)(ai * 128 + m * 16);
                if (MODE == 1) { if (sl == 0x7ffffff0) Y[0] = (unsigned char)pack_fp8x4(acc[ai][0][m][0][0] * gg, 0.f, 0.f, 0.f); }
                else if (sl >= 0) {
                    if (invw) inv[sl] = (int)yrow;
#pragma unroll
                    for (int bj = 0; bj < 2; ++bj) { const f32x4 v0 = acc[ai][bj][m][0], v1 = acc[ai][bj][m][1];
                        const float g8 = 8.f * gg; u32x2 w; w.x = pack_fp8x4(g8 * v0[0], g8 * v0[1], g8 * v0[2], g8 * v0[3]); w.y = pack_fp8x4(g8 * v1[0], g8 * v1[1], g8 * v1[2], g8 * v1[3]);
                        *(u32x2*)(Y + (yrow * 1024u + col0 + 128u * bj)) = w; } } }
            asm volatile("" ::: "memory"); }
    } };
typedef EpiMoe2T<0> EpiMoe2;
typedef short bf16x4 __attribute__((ext_vector_type(4)));
#if DEBUG_MODE
#define DBGF(stage, val) do { const float v_ = (val); if (!(fabsf(v_) < 1e30f)) atomicOr((unsigned*)(F.ws + WS_CTL) + 12, 1u << (stage)); } while (0)
#else
#define DBGF(stage, val) do { } while (0)
#endif
#define MFMA16(a, b, c) __builtin_amdgcn_mfma_f32_16x16x16bf16_1k(a, b, c, 0, 0, 0)
#define MFMA32(a, b, c) __builtin_amdgcn_mfma_f32_16x16x32_bf16(a, b, c, 0, 0, 0)
__device__ __forceinline__ bf16x4 pack4(const f32x4 v) { u32x2 w; w.x = cvt_pk_bf16(v[0], v[1]); w.y = cvt_pk_bf16(v[2], v[3]); return __builtin_bit_cast(bf16x4, w); }
__device__ __forceinline__ f32x4 unpack4(const u32x2 w) { return (f32x4){bflo(w.x), bfhi(w.x), bflo(w.y), bfhi(w.y)}; }
constexpr int TP = 72;
constexpr int TILE_B = 64 * TP * 2;
constexpr int LA_ACT = 0;
constexpr int LA_AT = 13312, LA_RT = LA_AT + TILE_B, LA_BT = LA_RT + TILE_B, LA_KT = LA_BT + TILE_B;
constexpr int LA_BTT = LA_KT + TILE_B, LA_KTT = LA_BTT + TILE_B, LA_VT = LA_KTT + TILE_B;
constexpr int LA_AAB = LA_VT + TILE_B, LA_AAK = LA_AAB + TILE_B, LA_ARB = LA_AAK + TILE_B, LA_ARK = LA_ARB + TILE_B;
constexpr int LA_DIAG = LA_ARK + TILE_B;
constexpr int LA_TII = LA_DIAG + 4096;
constexpr int LA_SEG = LA_TII + 3072;
constexpr int LA_KSQ = LA_SEG + 4096;
constexpr int LA_RKP = LA_KSQ + 1024;
constexpr int LA_PC = LA_RKP + 1024;
static_assert(LA_PC + 256 <= LDS_STAGE, "pass A LDS map");

template <bool EONLY> __device__ __forceinline__ void phase_wkv_a(Frame& F, const Params& P, int l) {
    LAS unsigned char* lds = F.lds;
    const bf16_t* rkv = WSP(bf16_t, WS_RKV);
    const bf16_t* wupT = WSP(bf16_t, WS_LORA) + (size_t)l * 512 * 32;
    const bf16_t* aupT = WSP(bf16_t, WS_LORA) + (size_t)(4 + l) * 512 * 32;
    const bf16_t* vupT = WSP(bf16_t, WS_LORA) + (size_t)(8 + (l > 0 ? l - 1 : 0)) * 512 * 32;
    const float* mu = P.in[3] + (size_t)l * 1696; const float* muv = (l > 0) ? P.in[4] + (size_t)(l - 1) * 32 : nullptr;
    bf16_t* PHI = WSP(bf16_t, WS_PHI); bf16_t* PSI = WSP(bf16_t, WS_PSI); bf16_t* GT = WSP(bf16_t, WS_GT); bf16_t* Y0T = WSP(bf16_t, WS_Y0T); bf16_t* VT = WSP(bf16_t, WS_VT); bf16_t* VF = WSP(bf16_t, WS_VFIRST);
    float* RK = WSP(float, WS_RK);
    const int lane = F.lane, w = F.wave, cb = w & 3, th = w >> 2;
    for (int unit = blockIdx.x; unit < T / 64; unit += F.G) {
        const int t0 = unit * 64; const bool firstchunk = (t0 & (SEQ - 1)) == 0;
        __syncthreads();
        for (int idx = F.tid; idx < 64 * 96; idx += 512) { const int tok = idx / 96, qq = idx % 96; const int col = (qq < 64) ? 1536 + qq : 1536 + 96 + qq;
            const int t = t0 + tok;
            const bool hp = (tok > 0 || !firstchunk); const float p = bf2f(rkv[(size_t)t * RKVW + col]); const float ppl = bf2f(rkv[(size_t)(hp ? t - 1 : t) * RKVW + col]); const float pp = hp ? ppl : 0.f;
            const float m_ = (qq < 64) ? mu[1536 + qq] : ((l > 0) ? P.in[4][(size_t)(l > 0 ? l - 1 : 0) * 32 + qq - 64] : 0.f);
            float val = p + (pp - p) * m_; if (qq < 32) val = tanhf(val);
            *(LAS bf16_t*)(lds + LA_ACT + (tok * 104 + qq) * 2) = f2bf(val); }
        __syncthreads();
        for (int h = 0; h < 8; ++h) {
            int lz = lane; asm volatile("" : "+v"(lz)); const int c = lz & 15, q = lz >> 4;
            const int chid = unit * 8 + h; const int ch = 16 * cb + c, chg = h * 64 + ch;
            f32x4 zw[2], za[2], zv[2];
            {   const bf16x8 bw = *(const bf16x8*)(wupT + (size_t)chg * 32 + 8 * q), ba = *(const bf16x8*)(aupT + (size_t)chg * 32 + 8 * q), bv = *(const bf16x8*)(vupT + (size_t)chg * 32 + 8 * q);
#pragma unroll
                for (int ii = 0; ii < 2; ++ii) { const int i = 2 * th + ii; const LAS unsigned char* ar = lds + LA_ACT + ((16 * i + c) * 104 + 8 * q) * 2;
                    const bf16x8 a0 = *(const LAS bf16x8*)(ar), a1 = *(const LAS bf16x8*)(ar + 64), a2 = *(const LAS bf16x8*)(ar + 128);
                    const f32x4 z = {0.f, 0.f, 0.f, 0.f};
                    zw[ii] = MFMA32(a0, bw, z); za[ii] = MFMA32(a1, ba, z); zv[ii] = MFMA32(a2, bv, z); } }
            const float mu_r = mu[chg], mu_k = mu[512 + chg], mu_v = mu[1024 + chg];
            const float w0 = P.in[5][(size_t)l * 512 + chg], a0_ = P.in[7][(size_t)l * 512 + chg], v0_ = (l > 0) ? P.in[10][(size_t)(l - 1) * 512 + chg] : 0.f;
            const float k_k = P.in[12][(size_t)l * 512 + chg], k_a = P.in[13][(size_t)l * 512 + chg], r_k = P.in[14][(size_t)l * 512 + chg];
            float rr[2][4], kh[2][4], vv[2][4], lw[2][4], ic[2][4], kkr[2][4];
#pragma unroll
            for (int ii = 0; ii < 2; ++ii) { const int i = 2 * th + ii; const int tl0 = 16 * i + 4 * q;
                const bool hasprev = (tl0 > 0) || !firstchunk;
                const bf16_t* base = rkv + (size_t)(t0 + tl0) * RKVW + chg;
                const bf16_t* pbase = hasprev ? base - RKVW : base;
                const float lpr = bf2f(pbase[0]), lpk = bf2f(pbase[512]), lpv = bf2f(pbase[1024]);
                float pr = hasprev ? lpr : 0.f, pk = hasprev ? lpk : 0.f, pv = hasprev ? lpv : 0.f;
                f32x4 vf = {0.f, 0.f, 0.f, 0.f};
                if (l > 0) vf = unpack4(*(const u32x2*)(VF + ((size_t)chid * 64 + ch) * 64 + tl0));
                float lsum = 0.f;
#pragma unroll
                for (int r = 0; r < 4; ++r) { const float cr = bf2f(base[(size_t)r * RKVW]), ck = bf2f(base[(size_t)r * RKVW + 512]), cv = bf2f(base[(size_t)r * RKVW + 1024]);
                    const float r_ = cr + (pr - cr) * mu_r, k_ = ck + (pk - ck) * mu_k; float v_ = cv + (pv - cv) * mu_v; pr = cr; pk = ck; pv = cv;
                    const float lw_ = -0.6065306597126334f * sigmoidf_(w0 + zw[ii][r]); const float icl = sigmoidf_(a0_ + za[ii][r]);
                    if (l > 0) v_ = v_ + (vf[r] - v_) * sigmoidf_(v0_ + zv[ii][r]);
                    const float kk_ = k_ * k_k, kh_ = k_ * (1.0f + (icl - 1.0f) * k_a);
                    rr[ii][r] = r_; kh[ii][r] = kh_; vv[ii][r] = v_; lw[ii][r] = lw_; ic[ii][r] = icl; kkr[ii][r] = kk_; lsum += lw_;
                    const float s1 = row16_sum(kk_ * kk_), s2 = row16_sum(r_ * kh_ * r_k);
                    *(LAS float*)(lds + LA_KSQ + (cb * 64 + tl0 + r) * 4) = s1; *(LAS float*)(lds + LA_RKP + (cb * 64 + tl0 + r) * 4) = s2; }
                *(LAS float*)(lds + LA_SEG + (ch * 16 + i * 4 + q) * 4) = lsum; }
            __syncthreads();
            {   float seg[16];
#pragma unroll
                for (int j4 = 0; j4 < 4; ++j4) { const f32x4 s4 = *(const LAS f32x4*)(lds + LA_SEG + (ch * 16 + 4 * j4) * 4); seg[4 * j4] = s4[0]; seg[4 * j4 + 1] = s4[1]; seg[4 * j4 + 2] = s4[2]; seg[4 * j4 + 3] = s4[3]; }
                float tot = 0.f;
#pragma unroll
                for (int j = 0; j < 16; ++j) tot += seg[j];
                if (th == 0) *(LAS float*)(lds + LA_PC + ch * 4) = __expf(tot);
                float mine[8];
#pragma unroll
                for (int j = 0; j < 8; ++j) mine[j] = th ? seg[8 + j] : seg[j];
                const float firsthalf = th ? (((seg[0] + seg[1]) + (seg[2] + seg[3])) + ((seg[4] + seg[5]) + (seg[6] + seg[7]))) : 0.f;
#pragma unroll
                for (int ii = 0; ii < 2; ++ii) { const int i = 2 * th + ii; const int tl0 = 16 * i + 4 * q; const int sidx = i * 4 + q;
                    float cum = firsthalf + (ii ? ((mine[0] + mine[1]) + (mine[2] + mine[3])) : 0.f);
                    { const float s0 = mine[4 * ii], s1 = mine[4 * ii + 1], s2 = mine[4 * ii + 2]; cum += (q > 0 ? s0 : 0.f) + (q > 1 ? s1 : 0.f) + (q > 2 ? s2 : 0.f); }
                    f32x4 at, rt, bt, kt;
#pragma unroll
                    for (int r = 0; r < 4; ++r) { const int tl = tl0 + r;
                        const float ks = (*(const LAS float*)(lds + LA_KSQ + tl * 4) + *(const LAS float*)(lds + LA_KSQ + (64 + tl) * 4)) + (*(const LAS float*)(lds + LA_KSQ + (128 + tl) * 4) + *(const LAS float*)(lds + LA_KSQ + (192 + tl) * 4));
                        const float kk_ = kkr[ii][r] * __builtin_amdgcn_rsqf(fmaxf(ks, 1e-24f));
                        const float cumx = cum; cum += lw[ii][r];
                        const float ex = __expf(cumx), ei = __expf(cum), en = __expf(-cum);
                        at[r] = -kk_ * ex; rt[r] = rr[ii][r] * ei; bt[r] = kk_ * ic[ii][r] * en; kt[r] = kh[ii][r] * en;
#if DEBUG_MODE
                        { bf16_t* dd = (bf16_t*)F.out; const size_t oo = (size_t)(t0 + tl) * 512 + chg; dd[oo] = f2bf(__expf(lw[ii][r])); dd[(size_t)T * 512 + oo] = f2bf(kk_ * ic[ii][r]); dd[(size_t)2 * T * 512 + oo] = f2bf(-kk_); }
#endif
                        DBGF(1, lw[ii][r]); DBGF(1, cum); DBGF(2, at[r]); DBGF(2, rt[r]); DBGF(2, bt[r]); DBGF(2, kt[r]);
                        *(LAS bf16_t*)(lds + LA_AT + (tl * TP + ch) * 2) = f2bf(at[r]); *(LAS bf16_t*)(lds + LA_RT + (tl * TP + ch) * 2) = f2bf(rt[r]);
                        *(LAS bf16_t*)(lds + LA_BT + (tl * TP + ch) * 2) = f2bf(bt[r]); *(LAS bf16_t*)(lds + LA_KT + (tl * TP + ch) * 2) = f2bf(kt[r]);
                        if (cb == 0) { const float rk = (*(const LAS float*)(lds + LA_RKP + tl * 4) + *(const LAS float*)(lds + LA_RKP + (64 + tl) * 4)) + (*(const LAS float*)(lds + LA_RKP + (128 + tl) * 4) + *(const LAS float*)(lds + LA_RKP + (192 + tl) * 4));
                            if (c == 0) RK[(size_t)(t0 + tl) * 8 + h] = rk; } }
                    const f32x4 v4 = {vv[ii][0], vv[ii][1], vv[ii][2], vv[ii][3]};
                    *(LAS bf16x4*)(lds + LA_BTT + (ch * TP + tl0) * 2) = pack4(bt); *(LAS bf16x4*)(lds + LA_KTT + (ch * TP + tl0) * 2) = pack4(kt); *(LAS bf16x4*)(lds + LA_VT + (ch * TP + tl0) * 2) = pack4(v4);
                    *(bf16x4*)(VT + ((size_t)chid * 64 + ch) * 64 + tl0) = pack4(v4);
                    if (l == 0) *(bf16x4*)(VF + ((size_t)chid * 64 + ch) * 64 + tl0) = pack4(v4); } }
            __syncthreads();
            if (EONLY) continue;
            {   const bool isR = w >= 4; const int i = w & 3;
                const LAS unsigned char* brow = lds + (isR ? LA_RT : LA_AT) + ((16 * i + c) * TP + 8 * q) * 2;
                const bf16x8 bf0 = *(const LAS bf16x8*)(brow), bf1 = *(const LAS bf16x8*)(brow + 64);
                LAS unsigned char* ob = lds + (isR ? LA_ARB : LA_AAB); LAS unsigned char* ok = lds + (isR ? LA_ARK : LA_AAK);
                const int tloc = 16 * i + c;
#pragma unroll
                for (int j = 0; j < 4; ++j) { f32x4 db = {0.f, 0.f, 0.f, 0.f}, dk = {0.f, 0.f, 0.f, 0.f};
                    if (j <= i) { const LAS unsigned char* arb = lds + LA_BT + ((16 * j + c) * TP + 8 * q) * 2; const LAS unsigned char* ark = lds + LA_KT + ((16 * j + c) * TP + 8 * q) * 2;
                        db = MFMA32(*(const LAS bf16x8*)(arb), bf0, db); db = MFMA32(*(const LAS bf16x8*)(arb + 64), bf1, db);
                        dk = MFMA32(*(const LAS bf16x8*)(ark), bf0, dk); dk = MFMA32(*(const LAS bf16x8*)(ark + 64), bf1, dk);
                        if (j == i) {
#pragma unroll
                            for (int r = 0; r < 4; ++r) { const int s = 16 * j + 4 * q + r; const bool keep = isR ? (s <= tloc) : (s < tloc); db[r] = keep ? db[r] : 0.f; dk[r] = keep ? dk[r] : 0.f; }
                            if (!isR) *(LAS f32x4*)(lds + LA_DIAG + ((i * 16 + c) * 16 + 4 * q) * 4) = db; } }
                    DBGF(3, db[0] + db[1] + db[2] + db[3]); DBGF(3, dk[0] + dk[1] + dk[2] + dk[3]);
                    *(LAS bf16x4*)(ob + (tloc * TP + 16 * j + 4 * q) * 2) = pack4(db); *(LAS bf16x4*)(ok + (tloc * TP + 16 * j + 4 * q) * 2) = pack4(dk); } }
            __syncthreads();
            f32x4 X[4];
            if (w == 0) { const int blk = q, jc = c; float tc[16];
                f32x4 Lr[15][4];
#pragma unroll
                for (int t = 1; t < 16; ++t)
#pragma unroll
                    for (int s4 = 0; s4 < 4; ++s4) if (4 * s4 < t) Lr[t - 1][s4] = *(const LAS f32x4*)(lds + LA_DIAG + ((blk * 16 + t) * 16 + 4 * s4) * 4);
                __builtin_amdgcn_sched_barrier(0);
#pragma unroll
                for (int s = 0; s < 16; ++s) tc[s] = (s == jc) ? 1.f : 0.f;
#pragma unroll
                for (int t = 1; t < 16; ++t) { float val = 0.f;
#pragma unroll
                    for (int s4 = 0; s4 < 4; ++s4) if (4 * s4 < t) { const f32x4 L = Lr[t - 1][s4];
#pragma unroll
                        for (int e = 0; e < 4; ++e) if (4 * s4 + e < t) val += L[e] * tc[4 * s4 + e]; }
                    tc[t] += val; }
#pragma unroll
                for (int t = 0; t < 16; ++t) { DBGF(4, tc[t]); *(LAS bf16_t*)(lds + LA_TII + ((blk * 16 + t) * 24 + jc) * 2) = f2bf(tc[t]); } }
            if (w < 4) {
#pragma unroll
                for (int i = 0; i < 4; ++i)
#pragma unroll
                    for (int r = 0; r < 4; ++r) X[i][r] = bf2f(*(const LAS bf16_t*)(lds + LA_AT + ((16 * i + 4 * q + r) * TP + 16 * w + c) * 2));
            } else { const int vb = w - 4; const LAS unsigned char* vrow = lds + LA_VT + ((16 * vb + c) * TP + 8 * q) * 2;
                const bf16x8 v0 = *(const LAS bf16x8*)(vrow), v1 = *(const LAS bf16x8*)(vrow + 64);
#pragma unroll
                for (int i = 0; i < 4; ++i) { const LAS unsigned char* arow = lds + LA_AAK + ((16 * i + c) * TP + 8 * q) * 2; f32x4 d = {0.f, 0.f, 0.f, 0.f};
                    d = MFMA32(*(const LAS bf16x8*)(arow), v0, d); d = MFMA32(*(const LAS bf16x8*)(arow + 64), v1, d); X[i] = d; } }
            DBGF(5, (X[0][0] + X[1][1]) + (X[2][2] + X[3][3]));
            __syncthreads();
            bf16x4 Xb[4];
            {   bf16x4 Af[6], Tf[4];
#pragma unroll
                for (int i = 1; i < 4; ++i)
#pragma unroll
                    for (int j = 0; j < 3; ++j) if (j < i) Af[(i * (i - 1)) / 2 + j] = *(const LAS bf16x4*)(lds + LA_AAB + ((16 * i + c) * TP + 16 * j + 4 * q) * 2);
#pragma unroll
                for (int i = 0; i < 4; ++i) Tf[i] = *(const LAS bf16x4*)(lds + LA_TII + ((i * 16 + c) * 24 + 4 * q) * 2);
                __builtin_amdgcn_sched_barrier(0);
#pragma unroll
                for (int i = 0; i < 4; ++i) { f32x4 y = X[i];
#pragma unroll
                    for (int j = 0; j < 3; ++j) if (j < i) y = MFMA16(Af[(i * (i - 1)) / 2 + j], Xb[j], y);
                    const f32x4 z = {0.f, 0.f, 0.f, 0.f};
                    X[i] = MFMA16(Tf[i], pack4(y), z); Xb[i] = pack4(X[i]); } }
            DBGF(6, (X[0][0] + X[1][1]) + (X[2][2] + X[3][3]));
            if (w < 4) {
                {   bf16x4 Bf[16]; float pcv[4];
#pragma unroll
                    for (int kb = 0; kb < 4; ++kb) { pcv[kb] = *(const LAS float*)(lds + LA_PC + (16 * kb + c) * 4);
#pragma unroll
                        for (int j = 0; j < 4; ++j) Bf[kb * 4 + j] = *(const LAS bf16x4*)(lds + LA_BTT + ((16 * kb + c) * TP + 16 * j + 4 * q) * 2); }
                    __builtin_amdgcn_sched_barrier(0);
#pragma unroll
                    for (int kb = 0; kb < 4; ++kb) { f32x4 d = {0.f, 0.f, 0.f, 0.f};
#pragma unroll
                        for (int j = 0; j < 4; ++j) d = MFMA16(Xb[j], Bf[kb * 4 + j], d);
                        const int ko = 16 * kb + c; const float pc = pcv[kb];
#pragma unroll
                        for (int r = 0; r < 4; ++r) d[r] = pc * (d[r] + ((16 * w + 4 * q + r) == ko ? 1.f : 0.f));
                        DBGF(7, d[0] + d[1] + d[2] + d[3]);
                        *(bf16x4*)(PHI + ((size_t)chid * 64 + ko) * 64 + 16 * w + 4 * q) = pack4(d); } }
                {   bf16x4 Rf[16]; u32x2 Rt[4];
#pragma unroll
                    for (int tb = 0; tb < 4; ++tb) { Rt[tb] = *(const LAS u32x2*)(lds + LA_RT + ((16 * tb + c) * TP + 16 * w + 4 * q) * 2);
#pragma unroll
                        for (int j = 0; j < 4; ++j) Rf[tb * 4 + j] = *(const LAS bf16x4*)(lds + LA_ARB + ((16 * tb + c) * TP + 16 * j + 4 * q) * 2); }
                    __builtin_amdgcn_sched_barrier(0);
#pragma unroll
                    for (int tb = 0; tb < 4; ++tb) { f32x4 d = unpack4(Rt[tb]);
#pragma unroll
                        for (int j = 0; j < 4; ++j) d = MFMA16(Xb[j], Rf[tb * 4 + j], d);
                        *(bf16x4*)(PSI + ((size_t)chid * 64 + 16 * tb + c) * 64 + 16 * w + 4 * q) = pack4(d); } }
            } else { const int vb = w - 4;
                bf16x4 Vb[4];
#pragma unroll
                for (int j = 0; j < 4; ++j) Vb[j] = *(const LAS bf16x4*)(lds + LA_VT + ((16 * vb + c) * TP + 16 * j + 4 * q) * 2);
                {   bf16x4 Bf[16], Kf[16]; f32x4 pcv[4];
#pragma unroll
                    for (int kb = 0; kb < 4; ++kb) { pcv[kb] = *(const LAS f32x4*)(lds + LA_PC + (16 * kb + 4 * q) * 4);
#pragma unroll
                        for (int j = 0; j < 4; ++j) { Bf[kb * 4 + j] = *(const LAS bf16x4*)(lds + LA_BTT + ((16 * kb + c) * TP + 16 * j + 4 * q) * 2); Kf[kb * 4 + j] = *(const LAS bf16x4*)(lds + LA_KTT + ((16 * kb + c) * TP + 16 * j + 4 * q) * 2); } }
                    __builtin_amdgcn_sched_barrier(0);
#pragma unroll
                    for (int kb = 0; kb < 4; ++kb) { f32x4 d = {0.f, 0.f, 0.f, 0.f};
#pragma unroll
                        for (int j = 0; j < 4; ++j) { d = MFMA16(Bf[kb * 4 + j], Xb[j], d); d = MFMA16(Kf[kb * 4 + j], Vb[j], d); }
                        *(bf16x4*)(GT + ((size_t)chid * 64 + 16 * vb + c) * 64 + 16 * kb + 4 * q) = pack4(d * pcv[kb]); } }
                {   bf16x4 Rf[16], Kf[16];
#pragma unroll
                    for (int tb = 0; tb < 4; ++tb)
#pragma unroll
                        for (int j = 0; j < 4; ++j) { Rf[tb * 4 + j] = *(const LAS bf16x4*)(lds + LA_ARB + ((16 * tb + c) * TP + 16 * j + 4 * q) * 2); Kf[tb * 4 + j] = *(const LAS bf16x4*)(lds + LA_ARK + ((16 * tb + c) * TP + 16 * j + 4 * q) * 2); }
                    __builtin_amdgcn_sched_barrier(0);
#pragma unroll
                    for (int tb = 0; tb < 4; ++tb) { f32x4 d = {0.f, 0.f, 0.f, 0.f};
#pragma unroll
                        for (int j = 0; j < 4; ++j) { d = MFMA16(Rf[tb * 4 + j], Xb[j], d); d = MFMA16(Kf[tb * 4 + j], Vb[j], d); }
                        *(bf16x4*)(Y0T + ((size_t)chid * 64 + 16 * vb + c) * 64 + 16 * tb + 4 * q) = pack4(d); } } }
            __syncthreads();
        }
    }
}
__device__ __forceinline__ void phase_wkv_b(Frame& F, const Params& P) {
    const bf16_t* PHI = WSP(bf16_t, WS_PHI); const bf16_t* GT = WSP(bf16_t, WS_GT); bf16_t* MT = WSP(bf16_t, WS_MT);
    LAS unsigned char* lds = F.lds;
    const int lane = F.lane, c = lane & 15, q = lane >> 4, w = F.wave, tid = F.tid;
    const int pair = w >> 2, vb = w & 3; const int bh = (int)blockIdx.x * 2 + pair, b = bh >> 3, h = bh & 7;
    const int lrow = tid >> 3, lcol = (tid & 7) * 16;
    f32x4 M[4];
#pragma unroll
    for (int i = 0; i < 4; ++i) M[i] = (f32x4){0.f, 0.f, 0.f, 0.f};
    u32x4 rA[4], rB[4];
#define WKVB_LD(r_, ckk) do { const int ck_ = (ckk) < 32 ? (ckk) : 31; _Pragma("unroll") for (int ti = 0; ti < 4; ++ti) { const int bh_ = (int)blockIdx.x * 2 + (ti >> 1); \
        const size_t chl_ = (size_t)((bh_ >> 3) * 32 + ck_) * 8 + (bh_ & 7); r_[ti] = *(const u32x4*)(((ti & 1) ? GT : PHI) + chl_ * 4096 + (size_t)tid * 8); } } while (0)
#define WKVB_ST(r_, buf) do { _Pragma("unroll") for (int ti = 0; ti < 4; ++ti) *(LAS u32x4*)(lds + ((buf) * 4 + ti) * TILE_B + lrow * (TP * 2) + lcol) = r_[ti]; } while (0)
#define WKVB_STEP(buf, ckk) do { const size_t chs_ = (size_t)(b * 32 + (ckk)) * 8 + h; bf16x4 Mb[4]; \
        const LAS unsigned char* tp_ = lds + ((buf) * 4 + pair * 2) * TILE_B; const LAS unsigned char* tg_ = tp_ + TILE_B; \
        _Pragma("unroll") for (int i = 0; i < 4; ++i) { Mb[i] = pack4(M[i]); *(bf16x4*)(MT + (chs_ * 64 + 16 * vb + c) * 64 + 16 * i + 4 * q) = Mb[i]; } \
        _Pragma("unroll") for (int i = 0; i < 4; ++i) { f32x4 d = unpack4(*(const LAS u32x2*)(tg_ + (16 * vb + c) * (TP * 2) + (16 * i + 4 * q) * 2)); \
            _Pragma("unroll") for (int j = 0; j < 4; ++j) d = MFMA16(*(const LAS bf16x4*)(tp_ + (16 * i + c) * (TP * 2) + (16 * j + 4 * q) * 2), Mb[j], d); M[i] = d; } } while (0)
    WKVB_LD(rA, 0); WKVB_LD(rB, 1);
    __syncthreads();
    for (int ck = 0; ck < 32; ck += 2) {
        WKVB_ST(rA, 0); __syncthreads(); WKVB_LD(rA, ck + 2); WKVB_STEP(0, ck);
        WKVB_ST(rB, 1); __syncthreads(); WKVB_LD(rB, ck + 3); WKVB_STEP(1, ck + 1);
    }
    __syncthreads();
#undef WKVB_LD
#undef WKVB_ST
#undef WKVB_STEP
}
constexpr int LC_SGL = 0;
constexpr int LC_OT = 13312;
__device__ __forceinline__ void phase_wkv_c(Frame& F, const Params& P, int l) {
    LAS unsigned char* lds = F.lds;
    const bf16_t* rkv = WSP(bf16_t, WS_RKV);
    const bf16_t* gupT = WSP(bf16_t, WS_LORA) + (size_t)11 * 512 * 32 + (size_t)l * 512 * 96;
    const bf16_t* PSI = WSP(bf16_t, WS_PSI); const bf16_t* Y0T = WSP(bf16_t, WS_Y0T); const bf16_t* VT = WSP(bf16_t, WS_VT); const bf16_t* MT = WSP(bf16_t, WS_MT);
    const float* RK = WSP(float, WS_RK); unsigned char* outa = WSP(unsigned char, WS_OUTA);
    const float* mu = P.in[3] + (size_t)l * 1696;
    const int lane = F.lane, h = F.wave;
    LAS unsigned char* ot = lds + LC_OT + h * TILE_B;
    for (int unit = blockIdx.x; unit < T / 64; unit += F.G) {
        int lz = lane; asm volatile("" : "+v"(lz)); const int c = lz & 15, q = lz >> 4;
        float gng[4], gnb[4];
#pragma unroll
        for (int vb = 0; vb < 4; ++vb) { gng[vb] = P.in[15][(size_t)l * 512 + h * 64 + 16 * vb + c]; gnb[vb] = P.in[16][(size_t)l * 512 + h * 64 + 16 * vb + c]; }
        const int t0 = unit * 64; const bool firstchunk = (t0 & (SEQ - 1)) == 0; const size_t chid = (size_t)unit * 8 + h;
        __syncthreads();
        for (int idx = F.tid; idx < 64 * 96; idx += 512) { const int tok = idx / 96, qq = idx % 96; const int col = 1536 + 64 + qq; const int t = t0 + tok;
            const bool hp = (tok > 0 || !firstchunk); const float p = bf2f(rkv[(size_t)t * RKVW + col]); const float ppl = bf2f(rkv[(size_t)(hp ? t - 1 : t) * RKVW + col]); const float pp = hp ? ppl : 0.f;
            *(LAS bf16_t*)(lds + LC_SGL + (tok * 104 + qq) * 2) = f2bf(sigmoidf_(p + (pp - p) * mu[1536 + 64 + qq])); }
        __syncthreads();
        float rkv_[16];
#pragma unroll
        for (int i = 0; i < 16; ++i) rkv_[i] = RK[(size_t)(t0 + 16 * (i >> 2) + 4 * q + (i & 3)) * 8 + h];
        bf16x4 Mf[16];
#pragma unroll
        for (int j = 0; j < 4; ++j)
#pragma unroll
            for (int vb = 0; vb < 4; ++vb) Mf[j * 4 + vb] = *(const bf16x4*)(MT + (chid * 64 + 16 * vb + c) * 64 + 16 * j + 4 * q);
        bf16x8 Gf[12];
#pragma unroll
        for (int vb = 0; vb < 4; ++vb)
#pragma unroll
            for (int ks = 0; ks < 3; ++ks) Gf[vb * 3 + ks] = *(const bf16x8*)(gupT + (size_t)(h * 64 + 16 * vb + c) * 96 + 32 * ks + 8 * q);
#pragma unroll
        for (int tb = 0; tb < 4; ++tb) {
            bf16x4 Pf[4];
#pragma unroll
            for (int j = 0; j < 4; ++j) Pf[j] = *(const bf16x4*)(PSI + (chid * 64 + 16 * tb + c) * 64 + 16 * j + 4 * q);
            f32x4 y[4], gt[4], vv[4];
#pragma unroll
            for (int vb = 0; vb < 4; ++vb) { y[vb] = unpack4(*(const u32x2*)(Y0T + (chid * 64 + 16 * vb + c) * 64 + 16 * tb + 4 * q)); vv[vb] = unpack4(*(const u32x2*)(VT + (chid * 64 + 16 * vb + c) * 64 + 16 * tb + 4 * q));
#pragma unroll
                for (int j = 0; j < 4; ++j) y[vb] = MFMA16(Pf[j], Mf[j * 4 + vb], y[vb]); }
            {   const LAS unsigned char* ar = lds + LC_SGL + ((16 * tb + c) * 104 + 8 * q) * 2;
                const bf16x8 a0 = *(const LAS bf16x8*)(ar), a1 = *(const LAS bf16x8*)(ar + 64), a2 = *(const LAS bf16x8*)(ar + 128);
#pragma unroll
                for (int vb = 0; vb < 4; ++vb) { f32x4 d = {0.f, 0.f, 0.f, 0.f}; d = MFMA32(a0, Gf[vb * 3], d); d = MFMA32(a1, Gf[vb * 3 + 1], d); d = MFMA32(a2, Gf[vb * 3 + 2], d); gt[vb] = d; } }
#pragma unroll
            for (int r = 0; r < 4; ++r) { const int tl = 16 * tb + 4 * q + r;
#if DEBUG_MODE
                { bf16_t* yd = WSP(bf16_t, DBG_YDBG) + (size_t)(t0 + tl) * 512 + h * 64; yd[c] = f2bf(y[0][r]); yd[16 + c] = f2bf(y[1][r]); yd[32 + c] = f2bf(y[2][r]); yd[48 + c] = f2bf(y[3][r]); }
#endif
                const float s = row16_sum((y[0][r] + y[1][r]) + (y[2][r] + y[3][r])); const float mean = s * (1.f / 64.f);
                const float d0 = y[0][r] - mean, d1 = y[1][r] - mean, d2 = y[2][r] - mean, d3 = y[3][r] - mean;
                const float var = row16_sum((d0 * d0 + d1 * d1) + (d2 * d2 + d3 * d3)) * (1.f / 64.f); const float rstd = rsqrtf(var + GN_EPS);
                const float rk = rkv_[tb * 4 + r];
                const float o0 = (d0 * rstd * gng[0] + gnb[0] + rk * vv[0][r]) * gt[0][r], o1 = (d1 * rstd * gng[1] + gnb[1] + rk * vv[1][r]) * gt[1][r];
                const float o2 = (d2 * rstd * gng[2] + gnb[2] + rk * vv[2][r]) * gt[2][r], o3 = (d3 * rstd * gng[3] + gnb[3] + rk * vv[3][r]) * gt[3][r];
                const unsigned pq = pack_fp8x4(4.f * o0, 4.f * o1, 4.f * o2, 4.f * o3);
                *(LAS unsigned char*)(ot + tl * 80 + c) = (unsigned char)pq; *(LAS unsigned char*)(ot + tl * 80 + 16 + c) = (unsigned char)(pq >> 8);
                *(LAS unsigned char*)(ot + tl * 80 + 32 + c) = (unsigned char)(pq >> 16); *(LAS unsigned char*)(ot + tl * 80 + 48 + c) = (unsigned char)(pq >> 24); }
        }
        asm volatile("s_waitcnt lgkmcnt(0)" ::: "memory");
        {   const LAS unsigned char* rowp = ot + lane * 80; unsigned char* dst = outa + (size_t)(t0 + lane) * 512 + h * 64;
#pragma unroll
            for (int m4 = 0; m4 < 4; ++m4) *(u32x4*)(dst + 16 * m4) = *(const LAS u32x4*)(rowp + 16 * m4); }
    }
    __syncthreads();
}
#if DEBUG_MODE
__device__ __forceinline__ void dbg_prep(Frame& F, const Params& P, int l) {
    LAS float* lora = (LAS float*)F.lds;
    const bf16_t* rkv = WSP(bf16_t, WS_RKV);
    const int c = F.tid;
    const float* mu = P.in[3] + (size_t)l * 1696; const float* muv = (l > 0) ? P.in[4] + (size_t)(l - 1) * 32 : nullptr;
    bf16_t* sv = WSP(bf16_t, WS_SV); bf16_t* sa = WSP(bf16_t, WS_SA); bf16_t* sb = WSP(bf16_t, WS_SB); bf16_t* sr = WSP(bf16_t, WS_SR); bf16_t* sk = WSP(bf16_t, WS_SK); bf16_t* sg = WSP(bf16_t, WS_SG);
    float* sw = WSP(float, WS_SW); float* rkb = WSP(float, DBG_RKREF); bf16_t* vfirst = WSP(bf16_t, WS_VFIRST);
    for (int grp = blockIdx.x; grp < T / 64; grp += F.G) {
        const int t0 = grp * 64;
        __syncthreads();
        for (int idx = F.tid; idx < 64 * 192; idx += 512) { const int tok = idx / 192, q = idx % 192; const int t = t0 + tok;
            const float p = bf2f(rkv[(size_t)t * RKVW + 1536 + q]); const float pp = ((t & (SEQ - 1)) != 0) ? bf2f(rkv[(size_t)(t - 1) * RKVW + 1536 + q]) : 0.f;
            const float m_ = (q < 160) ? mu[1536 + q] : (muv ? muv[q - 160] : 0.f);
            float val = p + (pp - p) * m_;
            if (q < 32) val = tanhf(val); else if (q >= 64 && q < 160) val = sigmoidf_(val);
            lora[tok * 192 + q] = val; }
        __syncthreads();
        {
            unsigned cc = c; asm volatile("" : "+v"(cc));
            float col[32]; const float w0 = P.in[5][(size_t)l * 512 + c];
#pragma unroll
            for (int i = 0; i < 32; ++i) col[i] = (P.in[6] + (size_t)l * 32 * 512)[(unsigned)(i * 512) + cc];
            for (int tok = 0; tok < 64; ++tok) { const LAS float* lr = lora + tok * 192; float z = w0;
#pragma unroll
                for (int i = 0; i < 32; ++i) z += lr[i] * col[i];
                sw[(size_t)(t0 + tok) * 512 + c] = __expf(-0.6065306597126334f * sigmoidf_(z)); }
            asm volatile("" ::: "memory"); }
        {
            unsigned cc = c; asm volatile("" : "+v"(cc));
            float col[32]; const float a0 = P.in[7][(size_t)l * 512 + c];
            const float mu_r = mu[c], mu_k = mu[512 + c];
            const float k_k = P.in[12][(size_t)l * 512 + c], k_a = P.in[13][(size_t)l * 512 + c], r_k = P.in[14][(size_t)l * 512 + c];
#pragma unroll
            for (int i = 0; i < 32; ++i) col[i] = (P.in[8] + (size_t)l * 32 * 512)[(unsigned)(i * 512) + cc];
            for (int tok = 0; tok < 64; ++tok) { const int t = t0 + tok; const bool first = (t & (SEQ - 1)) == 0;
                const size_t ro = (size_t)t * RKVW, rp = (size_t)(t - 1) * RKVW;
                const float pr = bf2f(rkv[ro + c]), pk = bf2f(rkv[ro + 512 + c]);
                const float qr = first ? 0.f : bf2f(rkv[rp + c]), qk = first ? 0.f : bf2f(rkv[rp + 512 + c]);
                const float r = pr + (qr - pr) * mu_r, k = pk + (qk - pk) * mu_k;
                const LAS float* lr = lora + tok * 192 + 32; float z = a0;
#pragma unroll
                for (int i = 0; i < 32; ++i) z += lr[i] * col[i];
                const float iclr = sigmoidf_(z);
                float kk = k * k_k; const float ss = wave_sum(kk * kk); kk = kk / fmaxf(sqrtf(ss), 1e-12f);
                const float kh = k * (1.0f + (iclr - 1.0f) * k_a);
                const float rks = wave_sum(r * kh * r_k);
                const size_t o = (size_t)t * 512 + c;
                sr[o] = f2bf(r); sk[o] = f2bf(kh); sa[o] = f2bf(-kk); sb[o] = f2bf(kk * iclr);
                if (F.lane == 0) rkb[(size_t)t * 8 + F.wave] = rks; }
            asm volatile("" ::: "memory"); }
        {
            unsigned cc = c; asm volatile("" : "+v"(cc));
            float col[32]; const float v0 = (l > 0) ? P.in[10][(size_t)(l - 1) * 512 + c] : 0.f; const float mu_v = mu[1024 + c];
#pragma unroll
            for (int i = 0; i < 32; ++i) col[i] = (l > 0) ? (P.in[11] + (size_t)(l - 1) * 32 * 512)[(unsigned)(i * 512) + cc] : 0.f;
            for (int tok = 0; tok < 64; ++tok) { const int t = t0 + tok; const bool first = (t & (SEQ - 1)) == 0;
                const float pv = bf2f(rkv[(size_t)t * RKVW + 1024 + c]); const float qv = first ? 0.f : bf2f(rkv[(size_t)(t - 1) * RKVW + 1024 + c]);
                float v = pv + (qv - pv) * mu_v;
                const size_t o = (size_t)t * 512 + c;
                if (l == 0) vfirst[o] = f2bf(v);
                else { const LAS float* lr = lora + tok * 192 + 160; float z = v0;
#pragma unroll
                    for (int i = 0; i < 32; ++i) z += lr[i] * col[i];
                    v = v + (bf2f(vfirst[o]) - v) * sigmoidf_(z); }
                sv[o] = f2bf(v); }
            asm volatile("" ::: "memory"); }
        {
            unsigned cc = c; asm volatile("" : "+v"(cc));
            float col[96];
#pragma unroll
            for (int i = 0; i < 96; ++i) col[i] = (P.in[9] + (size_t)l * 96 * 512)[(unsigned)(i * 512) + cc];
            for (int tok = 0; tok < 64; ++tok) { const LAS float* lr = lora + tok * 192 + 64; float g = 0.f;
#pragma unroll
                for (int i = 0; i < 96; ++i) g += lr[i] * col[i];
                sg[(size_t)(t0 + tok) * 512 + c] = f2bf(g); }
            asm volatile("" ::: "memory"); }
    }
    __syncthreads();
}
__device__ __forceinline__ void dbg_scan(Frame& F, const Params& P, int l, int wg0, int nwg) {
    constexpr int CH = 32;
    LAS float* buf = (LAS float*)F.lds;
    LAS float* ybuf = (LAS float*)(F.lds + 2 * 6 * CH * 64 * 4);
    const bf16_t* sv = WSP(bf16_t, WS_SV); const bf16_t* sa = WSP(bf16_t, WS_SA); const bf16_t* sb = WSP(bf16_t, WS_SB); const bf16_t* sr = WSP(bf16_t, WS_SR); const bf16_t* sk = WSP(bf16_t, WS_SK); const bf16_t* sg = WSP(bf16_t, WS_SG);
    const float* sw = WSP(float, WS_SW); const float* rkb = WSP(float, DBG_RKREF); bf16_t* outa = WSP(bf16_t, DBG_OUTAREF);
    const float* gn_g = P.in[15] + (size_t)l * 512; const float* gn_b = P.in[16] + (size_t)l * 512;
    int bh0 = __builtin_amdgcn_readfirstlane((int)blockIdx.x - wg0);
    for (int bh = bh0; bh < 128; bh += nwg) {
        const int b = bh >> 3, h = bh & 7; const size_t tb = (size_t)b * SEQ;
        const int ltok = F.tid >> 4, lch = (F.tid & 15) * 4;
        float S[8];
#pragma unroll
        for (int j = 0; j < 8; ++j) S[j] = 0.f;
        const int i8 = F.lane >> 3, seg = F.lane & 7, vrow = 8 * F.wave + i8;
        u32x2 pre_b[5]; f32x4 pre_w;
        __syncthreads();
        {   const size_t o = (tb + ltok) * 512 + h * 64 + lch;
            pre_b[0] = *(const u32x2*)(sr + o); pre_b[1] = *(const u32x2*)(sk + o); pre_b[2] = *(const u32x2*)(sv + o); pre_b[3] = *(const u32x2*)(sa + o); pre_b[4] = *(const u32x2*)(sb + o); pre_w = *(const f32x4*)(sw + o);
            LAS float* d = buf + ltok * 64 + lch;
#pragma unroll
            for (int a = 0; a < 5; ++a) { *(LAS f32x4*)(d + a * CH * 64) = (f32x4){bflo(pre_b[a].x), bfhi(pre_b[a].x), bflo(pre_b[a].y), bfhi(pre_b[a].y)}; }
            *(LAS f32x4*)(d + 5 * CH * 64) = pre_w; }
        __syncthreads();
        for (int ck = 0; ck < SEQ / CH; ++ck) {
            const int cur = ck & 1; const LAS float* cb = buf + cur * 6 * CH * 64;
            if (ck + 1 < SEQ / CH) { const size_t o = (tb + (ck + 1) * CH + ltok) * 512 + h * 64 + lch;
                pre_b[0] = *(const u32x2*)(sr + o); pre_b[1] = *(const u32x2*)(sk + o); pre_b[2] = *(const u32x2*)(sv + o); pre_b[3] = *(const u32x2*)(sa + o); pre_b[4] = *(const u32x2*)(sb + o); pre_w = *(const f32x4*)(sw + o); }
            if ((ck & 1) == 0) { float* mr = WSP(float, DBG_MREF) + ((size_t)((b * 32 + (ck >> 1)) * 8 + h)) * 4096;
#pragma unroll
                for (int j = 0; j < 8; ++j) mr[(size_t)(8 * seg + j) * 64 + vrow] = S[j]; }
            for (int tok = 0; tok < CH; ++tok) {
                const LAS float* p = cb + tok * 64 + seg * 8;
                const f32x4 r0 = *(const LAS f32x4*)(p), r1 = *(const LAS f32x4*)(p + 4);
                const f32x4 k0 = *(const LAS f32x4*)(p + CH * 64), k1 = *(const LAS f32x4*)(p + CH * 64 + 4);
                const float vv = cb[2 * CH * 64 + tok * 64 + vrow];
                const f32x4 a0 = *(const LAS f32x4*)(p + 3 * CH * 64), a1 = *(const LAS f32x4*)(p + 3 * CH * 64 + 4);
                const f32x4 b0 = *(const LAS f32x4*)(p + 4 * CH * 64), b1 = *(const LAS f32x4*)(p + 4 * CH * 64 + 4);
                const f32x4 w0 = *(const LAS f32x4*)(p + 5 * CH * 64), w1 = *(const LAS f32x4*)(p + 5 * CH * 64 + 4);
                float sa_ = 0.f;
#pragma unroll
                for (int j = 0; j < 4; ++j) { sa_ += S[j] * a0[j]; sa_ += S[4 + j] * a1[j]; }
                sa_ = reduce8(sa_);
                float y = 0.f;
#pragma unroll
                for (int j = 0; j < 4; ++j) { S[j] = S[j] * w0[j] + (sa_ * b0[j] + vv * k0[j]); S[4 + j] = S[4 + j] * w1[j] + (sa_ * b1[j] + vv * k1[j]); y += S[j] * r0[j]; y += S[4 + j] * r1[j]; }
                y = reduce8(y);
                if (seg == 0) ybuf[tok * 64 + vrow] = y;
            }
            __syncthreads();
            {
                const int tok = F.tid >> 4, vq = (F.tid & 15) * 4; const size_t t = tb + (size_t)ck * CH + tok;
                const f32x4 yv = *(const LAS f32x4*)(ybuf + tok * 64 + vq);
                { u32x2 wy; wy.x = cvt_pk_bf16(yv[0], yv[1]); wy.y = cvt_pk_bf16(yv[2], yv[3]); *(u32x2*)(WSP(bf16_t, DBG_YREF) + t * 512 + h * 64 + vq) = wy; }
                float s = (yv[0] + yv[1]) + (yv[2] + yv[3]);
                s += __shfl_xor(s, 1); s += __shfl_xor(s, 2); s += __shfl_xor(s, 4); s += __shfl_xor(s, 8);
                const float mean = s * (1.f / 64.f);
                const f32x4 dv = yv - mean; float q = (dv[0] * dv[0] + dv[1] * dv[1]) + (dv[2] * dv[2] + dv[3] * dv[3]);
                q += __shfl_xor(q, 1); q += __shfl_xor(q, 2); q += __shfl_xor(q, 4); q += __shfl_xor(q, 8);
                const float rstd = rsqrtf(q * (1.f / 64.f) + GN_EPS);
                const float rk = rkb[t * 8 + h];
                const f32x4 vv = *(const LAS f32x4*)(cb + 2 * CH * 64 + tok * 64 + vq);
                const f32x4 gg = *(const f32x4*)(gn_g + h * 64 + vq), gb = *(const f32x4*)(gn_b + h * 64 + vq);
                const u32x2 gt = *(const u32x2*)(sg + t * 512 + h * 64 + vq);
                float o[4]; const float gtf[4] = {bflo(gt.x), bfhi(gt.x), bflo(gt.y), bfhi(gt.y)};
#pragma unroll
                for (int j = 0; j < 4; ++j) o[j] = (dv[j] * rstd * gg[j] + gb[j] + rk * vv[j]) * gtf[j];
                u32x2 w; w.x = cvt_pk_bf16(o[0], o[1]); w.y = cvt_pk_bf16(o[2], o[3]);
                *(u32x2*)(outa + t * 512 + h * 64 + vq) = w; }
            if (ck + 1 < SEQ / CH) { LAS float* d = buf + (cur ^ 1) * 6 * CH * 64 + ltok * 64 + lch;
#pragma unroll
                for (int a = 0; a < 5; ++a) { *(LAS f32x4*)(d + a * CH * 64) = (f32x4){bflo(pre_b[a].x), bfhi(pre_b[a].x), bflo(pre_b[a].y), bfhi(pre_b[a].y)}; }
                *(LAS f32x4*)(d + 5 * CH * 64) = pre_w; }
            __syncthreads();
        }
    }
}

template <class TA, class TB> __device__ __forceinline__ void dbg_compare(Frame& F, const TA* a, const TB* b, size_t n, unsigned* ctl, int mode_transpose64) {
    float num = 0.f, den = 0.f;
    for (size_t i = (size_t)blockIdx.x * 512 + F.tid; i < n; i += (size_t)F.G * 512) {
        size_t ia = i;
        if (mode_transpose64) { const size_t tile = i >> 12, rem = i & 4095, r = rem >> 6, c2 = rem & 63; ia = (tile << 12) + c2 * 64 + r; }
        float x, y;
        if (sizeof(TA) == 2) x = bf2f(((const bf16_t*)a)[ia]); else x = ((const float*)a)[ia];
        if (sizeof(TB) == 2) y = bf2f(((const bf16_t*)b)[i]); else y = ((const float*)b)[i];
        const float d = x - y; num += d * d; den += y * y; }
    num = wave_sum(num); den = wave_sum(den);
    LAS float* red = (LAS float*)F.lds;
    __syncthreads();
    if (F.lane == 0) { red[F.wave * 2] = num; red[F.wave * 2 + 1] = den; }
    __syncthreads();
    if (F.tid == 0) { float n2 = 0.f, d2 = 0.f; for (int w8 = 0; w8 < 8; ++w8) { n2 += red[w8 * 2]; d2 += red[w8 * 2 + 1]; }
        ((float*)ctl)[1024 + 2 * blockIdx.x] = n2; ((float*)ctl)[1025 + 2 * blockIdx.x] = d2; }
}

constexpr size_t DBG_BF = WS_CONVH;
__device__ __forceinline__ void dbg_bruteforce(Frame& F) {
    LAS float* Ph = (LAS float*)F.lds; LAS float* Gm = Ph + 64 * 65; LAS float* vec = Gm + 64 * 65; LAS float* s1 = vec + 6 * 64; LAS float* s2 = s1 + 64;
    const bf16_t* sv = WSP(bf16_t, WS_SV); const bf16_t* sa = WSP(bf16_t, WS_SA); const bf16_t* sb = WSP(bf16_t, WS_SB); const bf16_t* sr = WSP(bf16_t, WS_SR); const bf16_t* sk = WSP(bf16_t, WS_SK); const float* sw = WSP(float, WS_SW);
    float* out = WSP(float, DBG_BF);
    const int chid = blockIdx.x, unit = chid >> 3, h = chid & 7, t0 = unit * 64;
    const int k = F.tid >> 3, j0 = (F.tid & 7) * 8;
    for (int e = 0; e < 8; ++e) { Ph[k * 65 + j0 + e] = (k == j0 + e) ? 1.f : 0.f; Gm[k * 65 + j0 + e] = 0.f; }
    __syncthreads();
    for (int t = 0; t < 64; ++t) {
        if (F.tid < 384) { const int a = F.tid >> 6, ch = F.tid & 63; const size_t o = (size_t)(t0 + t) * 512 + h * 64 + ch;
            float x; if (a == 0) x = sw[o]; else if (a == 1) x = bf2f(sa[o]); else if (a == 2) x = bf2f(sb[o]); else if (a == 3) x = bf2f(sk[o]); else if (a == 4) x = bf2f(sv[o]); else x = bf2f(sr[o]);
            vec[a * 64 + ch] = x; }
        __syncthreads();
        if (F.tid < 64) { float s = 0.f; for (int kk = 0; kk < 64; ++kk) s += vec[64 + kk] * Ph[kk * 65 + F.tid]; s1[F.tid] = s; }
        else if (F.tid < 128) { const int j = F.tid - 64; float s = 0.f; for (int kk = 0; kk < 64; ++kk) s += vec[64 + kk] * Gm[kk * 65 + j]; s2[j] = s; }
        __syncthreads();
        for (int e = 0; e < 8; ++e) { const int j = j0 + e; Ph[k * 65 + j] = vec[k] * Ph[k * 65 + j] + vec[128 + k] * s1[j]; Gm[k * 65 + j] = vec[k] * Gm[k * 65 + j] + vec[128 + k] * s2[j] + vec[192 + k] * vec[256 + j]; }
        __syncthreads();
        if (F.tid < 64) { float s = 0.f; for (int kk = 0; kk < 64; ++kk) s += vec[320 + kk] * Ph[kk * 65 + F.tid]; out[((size_t)(2 * 256 + chid) * 64 + t) * 64 + F.tid] = s; }
        else if (F.tid < 128) { const int j = F.tid - 64; float s = 0.f; for (int kk = 0; kk < 64; ++kk) s += vec[320 + kk] * Gm[kk * 65 + j]; out[((size_t)(3 * 256 + chid) * 64 + t) * 64 + j] = s; }
    }
    __syncthreads();
    for (int e = 0; e < 8; ++e) { out[((size_t)(0 * 256 + chid) * 64 + k) * 64 + j0 + e] = Ph[k * 65 + j0 + e]; out[((size_t)(1 * 256 + chid) * 64 + k) * 64 + j0 + e] = Gm[k * 65 + j0 + e]; }
}
__device__ __forceinline__ void dbg_compare_vt(Frame& F, unsigned* ctl) {
    const bf16_t* VT = WSP(bf16_t, WS_VT); const bf16_t* sv = WSP(bf16_t, WS_SV); float num = 0.f, den = 0.f;
    for (size_t i = (size_t)blockIdx.x * 512 + F.tid; i < (size_t)T * 512; i += (size_t)F.G * 512) { const size_t t = i >> 9, cg = i & 511, hh = cg >> 6, ch = cg & 63; const size_t chid = (t >> 6) * 8 + hh;
        const float x = bf2f(VT[(chid * 64 + ch) * 64 + (t & 63)]), y = bf2f(sv[i]); const float d = x - y; num += d * d; den += y * y; }
    num = wave_sum(num); den = wave_sum(den);
    LAS float* red = (LAS float*)F.lds; __syncthreads(); if (F.lane == 0) { red[F.wave * 2] = num; red[F.wave * 2 + 1] = den; } __syncthreads();
    if (F.tid == 0) { float n2 = 0.f, d2 = 0.f; for (int w8 = 0; w8 < 8; ++w8) { n2 += red[w8 * 2]; d2 += red[w8 * 2 + 1]; } ((float*)ctl)[1024 + 2 * blockIdx.x] = n2; ((float*)ctl)[1025 + 2 * blockIdx.x] = d2; }
}
#endif
__device__ __forceinline__ void phase_sgu(Frame& F, const Params& P, int l, int wg0, int nwg) {
    LAS unsigned char* vt = F.lds;
    const bf16_t* z = WSP(bf16_t, WS_SGUZ); unsigned char* hb = WSP(unsigned char, WS_HB);
    const bf16_t* Wm = WSP(bf16_t, WS_SGUW) + (size_t)l * 4 * 128 * 128;
    const float* bs = P.in[21] + (size_t)l * 4 * 128;
    int u0 = __builtin_amdgcn_readfirstlane((int)blockIdx.x - wg0);
    for (int u = u0; u < T / 128; u += nwg) {
        int uu = u; asm volatile("" : "+v"(uu)); uu = __builtin_amdgcn_readfirstlane(uu);
        int lz = F.lane; asm volatile("" : "+v"(lz));
        const size_t t0 = (size_t)uu * 128;
        __syncthreads();
        {
            float lg[4], lb[4];
#pragma unroll
            for (int e = 0; e < 4; ++e) { lg[e] = P.in[18][(size_t)l * 256 + lz + 64 * e]; lb[e] = P.in[19][(size_t)l * 256 + lz + 64 * e]; }
            float vall[16][4];
#pragma unroll
            for (int i = 0; i < 16; ++i) { const bf16_t* zr = z + (t0 + F.wave * 16 + i) * 512 + 256 + lz;
#pragma unroll
                for (int e = 0; e < 4; ++e) vall[i][e] = bf2f(zr[64 * e]); }
#pragma unroll
            for (int i = 0; i < 16; ++i) { const int tok = F.wave * 16 + i;
                float v[4];
#pragma unroll
                for (int e = 0; e < 4; ++e) v[e] = vall[i][e];
                const float mean = wave_sum((v[0] + v[1]) + (v[2] + v[3])) * (1.f / 256.f);
#pragma unroll
                for (int e = 0; e < 4; ++e) v[e] -= mean;
                const float rstd = rsqrtf(wave_sum((v[0] * v[0] + v[1] * v[1]) + (v[2] * v[2] + v[3] * v[3])) * (1.f / 256.f) + LN_EPS);
#pragma unroll
                for (int e = 0; e < 4; ++e) { const int ch = lz + 64 * e; *(LAS bf16_t*)(vt + ch * 256 + ((((tok >> 3) ^ (ch & 15)) << 4) | ((tok & 7) << 1))) = f2bf(v[e] * rstd * lg[e] + lb[e]); } } }
        __syncthreads();
        {   const int c = lz & 15, qd = lz >> 4, g = F.wave >> 1, sel = F.wave & 1;
            const bf16_t* Wg = Wm + (size_t)g * 128 * 128;
            f32x4 acc[4][4];
#pragma unroll
            for (int pi = 0; pi < 4; ++pi)
#pragma unroll
                for (int db = 0; db < 4; ++db) acc[pi][db] = (f32x4){0.f, 0.f, 0.f, 0.f};
#pragma unroll
            for (int ks = 0; ks < 4; ++ks) {
                bf16x8 af[4];
#pragma unroll
                for (int db = 0; db < 4; ++db) { const int ch = 64 * g + 16 * db + c; af[db] = *(const LAS bf16x8*)(vt + ch * 256 + (((4 * ks + qd) ^ (ch & 15)) << 4)); }
#pragma unroll
                for (int pi = 0; pi < 4; ++pi) { const int pb = sel ? ((pi == 0) ? 1 : (pi == 1) ? 2 : (pi == 2) ? 5 : 6) : ((pi == 0) ? 0 : (pi == 1) ? 3 : (pi == 2) ? 4 : 7);
                    if (32 * ks <= 16 * pb + 15) { const bf16x8 bfr = *(const bf16x8*)(Wg + (size_t)(16 * pb + c) * 128 + 32 * ks + 8 * qd);
#pragma unroll
                        for (int db = 0; db < 4; ++db) acc[pi][db] = MFMA32(af[db], bfr, acc[pi][db]); } } }
            u32x2 uraw[4][4]; float biasv[4];
#pragma unroll
            for (int pi = 0; pi < 4; ++pi) { const int pb = sel ? ((pi == 0) ? 1 : (pi == 1) ? 2 : (pi == 2) ? 5 : 6) : ((pi == 0) ? 0 : (pi == 1) ? 3 : (pi == 2) ? 4 : 7);
                const int p = 16 * pb + c; biasv[pi] = bs[g * 128 + p];
#pragma unroll
                for (int db = 0; db < 4; ++db) uraw[pi][db] = *(const u32x2*)(z + (t0 + p) * 512 + 64 * g + 16 * db + 4 * qd); }
#pragma unroll
            for (int pi = 0; pi < 4; ++pi) { const int pb = sel ? ((pi == 0) ? 1 : (pi == 1) ? 2 : (pi == 2) ? 5 : 6) : ((pi == 0) ? 0 : (pi == 1) ? 3 : (pi == 2) ? 4 : 7);
                const size_t t = t0 + 16 * pb + c;
#pragma unroll
                for (int db = 0; db < 4; ++db) { const int ch = 64 * g + 16 * db + 4 * qd;
                    const f32x4 o = unpack4(uraw[pi][db]) * (acc[pi][db] + biasv[pi]) * 4.f; *(unsigned*)(hb + t * 256 + ch) = pack_fp8x4(o[0], o[1], o[2], o[3]); } } }
    }
    __syncthreads();
}
__device__ __forceinline__ void phase_conv(Frame& F, const Params& P, int l, int wg0, int nwg) {
    LAS float* cv = (LAS float*)F.lds;
    const bf16_t* hin = WSP(bf16_t, WS_CONVH); unsigned char* hc = WSP(unsigned char, WS_HC);
    const float* dw = P.in[23] + (size_t)l * 31 * 256; const float* db = P.in[24] + (size_t)l * 256;
    const float* lg = P.in[25] + (size_t)l * 256; const float* lb = P.in[26] + (size_t)l * 256;
    int u0 = __builtin_amdgcn_readfirstlane((int)blockIdx.x - wg0);
    for (int u = u0; u < T / 64; u += nwg) {
        int tz = F.tid; asm volatile("" : "+v"(tz)); const int ch = tz & 255, hf = tz >> 8, lz = tz & 63;
        float kw[31];
#pragma unroll
        for (int j = 0; j < 31; ++j) kw[j] = dw[j * 256 + ch];
        const float bias = db[ch];
        const int t0 = u * 64 + hf * 32; const int s0 = t0 & (SEQ - 1);
        __syncthreads();
        float x[38];
#pragma unroll
        for (int m = 0; m < 30; ++m) { const int s = s0 - 30 + m; const float ld = bf2f(hin[(size_t)(t0 - 30 + m + (s >= 0 ? 0 : 30)) * 256 + ch]); x[m] = (s >= 0) ? ld : 0.f; }
#pragma unroll
        for (int g8 = 0; g8 < 4; ++g8) {
#pragma unroll
            for (int m = 0; m < 8; ++m) x[30 + m] = bf2f(hin[(size_t)(t0 + 8 * g8 + m) * 256 + ch]);
#pragma unroll
            for (int i = 0; i < 8; ++i) { float a = bias;
#pragma unroll
                for (int j = 0; j < 31; ++j) a += kw[j] * x[i + j];
                cv[(hf * 32 + 8 * g8 + i) * 256 + ch] = a; }
#pragma unroll
            for (int m = 0; m < 30; ++m) x[m] = x[m + 8]; }
        __syncthreads();
        {   const f32x4 g = *(const f32x4*)(lg + lz * 4), bb = *(const f32x4*)(lb + lz * 4);
            for (int i = 0; i < 8; ++i) { const int tok = F.wave * 8 + i; f32x4 v = *(const LAS f32x4*)(cv + tok * 256 + lz * 4);
                const float mean = wave_sum((v[0] + v[1]) + (v[2] + v[3])) * (1.f / 256.f);
                v = v - mean; const float var = wave_sum((v[0] * v[0] + v[1] * v[1]) + (v[2] * v[2] + v[3] * v[3])) * (1.f / 256.f);
                const float rstd = rsqrtf(var + LN_EPS);
                v = v * rstd * g + bb;
                float o[4];
#pragma unroll
                for (int j = 0; j < 4; ++j) o[j] = v[j] * sigmoidf_(v[j]);
                *(unsigned*)(hc + (size_t)(u * 64 + tok) * 256 + lz * 4) = pack_fp8x4(4.f * o[0], 4.f * o[1], 4.f * o[2], 4.f * o[3]); } }
    }
    __syncthreads();
}
__device__ __forceinline__ void ln_load16(const bf16_t* p, float (&v)[16]) {
    const u32x4 a = *(const u32x4*)p, b = *(const u32x4*)(p + 8);
    v[0] = bflo(a.x); v[1] = bfhi(a.x); v[2] = bflo(a.y); v[3] = bfhi(a.y); v[4] = bflo(a.z); v[5] = bfhi(a.z); v[6] = bflo(a.w); v[7] = bfhi(a.w);
    v[8] = bflo(b.x); v[9] = bfhi(b.x); v[10] = bflo(b.y); v[11] = bfhi(b.y); v[12] = bflo(b.z); v[13] = bfhi(b.z); v[14] = bflo(b.w); v[15] = bfhi(b.w);
}
__device__ __forceinline__ void ln_norm16(float (&v)[16], const float* g, const float* b, int lane) {
    float s = 0.f;
#pragma unroll
    for (int j = 0; j < 16; ++j) s += v[j];
    const float mean = wave_sum(s) * (1.f / 1024.f); float q = 0.f;
#pragma unroll
    for (int j = 0; j < 16; ++j) { v[j] -= mean; q += v[j] * v[j]; }
    const float rstd = rsqrtf(wave_sum(q) * (1.f / 1024.f) + LN_EPS);
#pragma unroll
    for (int j4 = 0; j4 < 4; ++j4) { const f32x4 gg = *(const f32x4*)(g + lane * 16 + j4 * 4), bb = *(const f32x4*)(b + lane * 16 + j4 * 4);
#pragma unroll
        for (int j = 0; j < 4; ++j) v[j4 * 4 + j] = v[j4 * 4 + j] * rstd * gg[j] + bb[j]; }
}
__device__ __forceinline__ void ln_store16(bf16_t* p, const float (&v)[16]) {
    u32x4 a, b; a.x = cvt_pk_bf16(v[0], v[1]); a.y = cvt_pk_bf16(v[2], v[3]); a.z = cvt_pk_bf16(v[4], v[5]); a.w = cvt_pk_bf16(v[6], v[7]);
    b.x = cvt_pk_bf16(v[8], v[9]); b.y = cvt_pk_bf16(v[10], v[11]); b.z = cvt_pk_bf16(v[12], v[13]); b.w = cvt_pk_bf16(v[14], v[15]);
    *(u32x4*)p = a; *(u32x4*)(p + 8) = b;
}
__device__ __forceinline__ void ln_load16q(const unsigned char* p, float (&v)[16]) {
    const u32x4 a = *(const u32x4*)p; const unsigned w[4] = {a.x, a.y, a.z, a.w};
#pragma unroll
    for (int i = 0; i < 4; ++i) { const f32x2 lo = __builtin_amdgcn_cvt_pk_f32_fp8((int)w[i], false), hi = __builtin_amdgcn_cvt_pk_f32_fp8((int)w[i], true); v[4 * i] = lo[0]; v[4 * i + 1] = lo[1]; v[4 * i + 2] = hi[0]; v[4 * i + 3] = hi[1]; }
}
__device__ __forceinline__ void ln_store16q(unsigned char* p, const float (&v)[16]) {
    u32x4 a; a.x = pack_fp8x4(v[0], v[1], v[2], v[3]); a.y = pack_fp8x4(v[4], v[5], v[6], v[7]); a.z = pack_fp8x4(v[8], v[9], v[10], v[11]); a.w = pack_fp8x4(v[12], v[13], v[14], v[15]);
    *(u32x4*)p = a;
}
__device__ __forceinline__ void phase_ln1(Frame& F, const Params& P, int l, int wg0, int nwg) {
    const bf16_t* pre = WSP(bf16_t, WS_PRE); const float* stats = WSP(float, WS_STATS);
    const float* g = P.in[29] + (size_t)l * 1024; const float* b = P.in[30] + (size_t)l * 1024;
    const int gw = ((int)blockIdx.x - wg0) * 8 + F.wave, NGW = nwg * 8;
    float gg[16], bb[16];
#pragma unroll
    for (int j4 = 0; j4 < 4; ++j4) { const f32x4 g4 = *(const f32x4*)(g + F.lane * 16 + j4 * 4), b4 = *(const f32x4*)(b + F.lane * 16 + j4 * 4);
#pragma unroll
        for (int j = 0; j < 4; ++j) { gg[j4 * 4 + j] = g4[j]; bb[j4 * 4 + j] = b4[j]; } }
    for (int row = gw; row < T; row += NGW) { float v[16]; ln_load16(pre + (size_t)row * 1024 + F.lane * 16, v);
        const f32x2 sl = *(const f32x2*)(stats + ((size_t)row * 16 + (F.lane & 15)) * 2);
        const float mean = row16_sum(sl[0]) * (1.f / 1024.f), ex2 = row16_sum(sl[1]) * (1.f / 1024.f);
        const float rstd = rsqrtf(fmaxf(ex2 - mean * mean, 0.f) + LN_EPS);
#pragma unroll
        for (int j = 0; j < 16; ++j) v[j] = (v[j] - mean) * rstd * gg[j] + bb[j];
        ln_store16q(WSP(unsigned char, WS_X1Q) + (size_t)row * 1024 + F.lane * 16, v); }
}
__device__ __forceinline__ void phase_ln2(Frame& F, const Params& P, int l) {
    const bf16_t* pre = WSP(bf16_t, WS_PRE); const float* stats = WSP(float, WS_STATS); const unsigned char* Y = WSP(unsigned char, WS_Y); bf16_t* x = WSP(bf16_t, WS_X); const int* inv = WSP(int, WS_GATEV);
    const float* g = P.in[36] + (size_t)l * 1024; const float* b = P.in[37] + (size_t)l * 1024; const float* g1 = P.in[29] + (size_t)l * 1024; const float* b1 = P.in[30] + (size_t)l * 1024;
    const int gw = blockIdx.x * 8 + F.wave, NGW = F.G * 8;
    int n0 = inv[2 * gw], n1 = inv[2 * gw + 1];
#pragma unroll 1
    for (int row = gw; row < T; row += NGW) { float v[16], y0[16], y1[16];
        const int c0 = __builtin_amdgcn_readfirstlane(n0), c1 = __builtin_amdgcn_readfirstlane(n1);
        { const int rn = (row + NGW < T) ? row + NGW : row; n0 = inv[2 * rn]; n1 = inv[2 * rn + 1]; }
        ln_load16(pre + (size_t)row * 1024 + F.lane * 16, v); ln_load16q(Y + (size_t)c0 * 1024 + F.lane * 16, y0); ln_load16q(Y + (size_t)c1 * 1024 + F.lane * 16, y1);
        {   const f32x2 sl = *(const f32x2*)(stats + ((size_t)row * 16 + (F.lane & 15)) * 2);
            const float mean = row16_sum(sl[0]) * (1.f / 1024.f), ex2 = row16_sum(sl[1]) * (1.f / 1024.f); const float rstd = rsqrtf(fmaxf(ex2 - mean * mean, 0.f) + LN_EPS);
#pragma unroll
            for (int j4 = 0; j4 < 4; ++j4) { const f32x4 g4 = *(const f32x4*)(g1 + F.lane * 16 + j4 * 4), b4 = *(const f32x4*)(b1 + F.lane * 16 + j4 * 4);
#pragma unroll
                for (int j = 0; j < 4; ++j) v[j4 * 4 + j] = (v[j4 * 4 + j] - mean) * rstd * g4[j] + b4[j]; } }
#pragma unroll
        for (int j = 0; j < 16; ++j) v[j] = ALPHA * v[j] + 0.125f * (y0[j] + y1[j]);
        ln_norm16(v, g, b, F.lane);
        if (l == NL - 1) { float* o = F.out + (size_t)row * 1024 + F.lane * 16;
#pragma unroll
            for (int j4 = 0; j4 < 4; ++j4) *(f32x4*)(o + j4 * 4) = (f32x4){v[j4 * 4], v[j4 * 4 + 1], v[j4 * 4 + 2], v[j4 * 4 + 3]}; }
        else { ln_store16(x + (size_t)row * 1024 + F.lane * 16, v); ln_store16q(WSP(unsigned char, WS_XQ) + (size_t)row * 1024 + F.lane * 16, v); } }
}

#define PHASE_PROLOGUE() const Params P = KPARAMS(); Frame F = make_frame(P.ws, P.out); unsigned* ctl = (unsigned*)(F.ws + WS_CTL); (void)ctl
__device__ __forceinline__ void ph_prologue() { PHASE_PROLOGUE(); phase_convert_static(F, P); phase_convert_lora(F, P); phase_convert_sgu(F, P); phase_convert_router(F, P); phase_x_to_bf16(F, P); phase_convert_moe(F, P, 0); __syncthreads(); }
__device__ __forceinline__ void ph_inproj(int l) { PHASE_PROLOGUE();
    SchedInproj S{(const char*)WSP(unsigned char, WS_XQ), (const char*)(WSP(unsigned char, WS_WIN) + (size_t)l * NIN * 1024), F.G, (int)blockIdx.x};
    EpiInproj E{WSP(bf16_t, WS_RKV), WSP(bf16_t, WS_SGUZ), WSP(bf16_t, WS_CONVH), WSP(unsigned char, WS_GATES)};
    ge::gemm_phase<SchedInproj, EpiInproj, true>(F.lds, S, E); }
__device__ __forceinline__ void ph_inproj_null(int l) { PHASE_PROLOGUE();
    SchedInproj S{(const char*)WSP(unsigned char, WS_XQ), (const char*)(WSP(unsigned char, WS_WIN) + (size_t)l * NIN * 1024), F.G, (int)blockIdx.x};
    EpiNull E{WSP(bf16_t, WS_HB)};
    ge::gemm_phase<SchedInproj, EpiNull, true>(F.lds, S, E); }
__device__ __forceinline__ void ph_wkva(int l) { PHASE_PROLOGUE(); phase_wkv_a<false>(F, P, l); }
__device__ __forceinline__ void ph_wkva_e(int l) { PHASE_PROLOGUE(); phase_wkv_a<true>(F, P, l); }
__device__ __forceinline__ void ph_cvtmoe(int l) { PHASE_PROLOGUE(); phase_convert_moe(F, P, l); __syncthreads(); }
__device__ __forceinline__ void ph_wkvb() { PHASE_PROLOGUE(); phase_wkv_b(F, P); }
__device__ __forceinline__ void ph_wkvc(int l) { PHASE_PROLOGUE(); phase_wkv_c(F, P, l); }
__device__ __forceinline__ void ph_sguconv(int l) { PHASE_PROLOGUE();
    phase_sgu(F, P, l, 64, 192); phase_conv(F, P, l, 64, 192); }
__device__ __forceinline__ void ph_branch(int l) { PHASE_PROLOGUE();
    SchedBranch S{(const char*)F.ws, WS_WBR + (size_t)l * 1024 * 1024, F.G, F.vcu};
    EpiBranch E{WSP(unsigned char, WS_GATES), WSP(bf16_t, WS_MERGED), WSP(unsigned char, WS_MERGEDQ)};
    ge::gemm_phase<SchedBranch, EpiBranch, true, 0x7A7A7A7A, 0x7D7D7D7D>(F.lds, S, E); }
__device__ __forceinline__ void ph_wout(int l) { PHASE_PROLOGUE();
    SchedWout S{(const char*)WSP(unsigned char, WS_MERGEDQ), (const char*)(WSP(unsigned char, WS_WOUT) + (size_t)l * 1024 * 1024), F.G, F.vcu};
    EpiWout E{WSP(bf16_t, WS_X), WSP(bf16_t, WS_PRE), WSP(float, WS_STATS)};
    ge::gemm_phase<SchedWout, EpiWout, true, 0x7A7A7A7A, 0x7D7D7D7D>(F.lds, S, E); }
__device__ __forceinline__ void ph_ln1(int l) { PHASE_PROLOGUE(); phase_ln1(F, P, l, 128, 128); }
__device__ __forceinline__ void ph_router(int l) { PHASE_PROLOGUE();
    SchedRouter S{(const char*)WSP(bf16_t, WS_PRE), (const char*)(WSP(bf16_t, WS_WRG) + (size_t)l * 256 * 1024), 128, (int)blockIdx.x};
    EpiRouter E{P.in[32], ctl + CW_CNT + 64 * l, WSP(int, WS_LIST), WSP(float, WS_STATS), WSP(float, WS_RC) + l * 64};
    ge::gemm_phase(F.lds, S, E); }
__device__ __forceinline__ void ph_router_probe(int l) { PHASE_PROLOGUE();
    SchedRouter S{(const char*)WSP(bf16_t, WS_PRE), (const char*)(WSP(bf16_t, WS_WRG) + (size_t)l * 256 * 1024), 128, (int)blockIdx.x};
    EpiRouter E{P.in[32], ctl + CW_CNT + 64 * l + 32, WSP(int, WS_Y), WSP(float, WS_STATS), WSP(float, WS_RC) + l * 64};
    ge::gemm_phase(F.lds, S, E); }
__device__ __forceinline__ void ph_moe1(int l) { PHASE_PROLOGUE();
    const int ntiles = build_tile_table(F, ctl + CW_CNT + 64 * l);
    SchedMoe1 S{(const char*)WSP(unsigned char, WS_X1Q), (const char*)moe_wbuf(F, l), WSP(int, WS_LIST), ctl + CW_CNT + 64 * l, (LAS int*)(F.lds + LDS_MISC + 64), ntiles, F.G, F.vcu};
    EpiMoe1 E{WSP(unsigned char, WS_H)};
    ge::gemm_phase<SchedMoe1, EpiMoe1, true>(F.lds, S, E); }
__device__ __forceinline__ void ph_moe2(int l) { PHASE_PROLOGUE(); int ntk4 = 4; asm volatile("" : "+s"(ntk4));
    const int ntiles = build_tile_table(F, ctl + CW_CNT + 64 * l);
    SchedMoe2 S{(const char*)WSP(unsigned char, WS_H), (const char*)(moe_wbuf(F, l) + (size_t)NE * 1024 * 1024), WSP(int, WS_LIST), ctl + CW_CNT + 64 * l, (LAS int*)(F.lds + LDS_MISC + 64), ntiles, F.G, F.vcu, ntk4};
    EpiMoe2 E{WSP(int, WS_LIST), WSP(unsigned char, WS_Y), WSP(int, WS_GATEV)};
    ge::gemm_phase<SchedMoe2, EpiMoe2, true>(F.lds, S, E); }
__device__ __forceinline__ void ph_moe2_nostore(int l) { PHASE_PROLOGUE(); int ntk4 = 4; asm volatile("" : "+s"(ntk4));
    const int ntiles = build_tile_table(F, ctl + CW_CNT + 64 * l);
    SchedMoe2 S{(const char*)WSP(unsigned char, WS_H), (const char*)(moe_wbuf(F, l) + (size_t)NE * 1024 * 1024), WSP(int, WS_LIST), ctl + CW_CNT + 64 * l, (LAS int*)(F.lds + LDS_MISC + 64), ntiles, F.G, F.vcu, ntk4};
    EpiMoe2T<1> E{WSP(int, WS_LIST), WSP(unsigned char, WS_Y), WSP(int, WS_GATEV)};
    ge::gemm_phase<SchedMoe2, EpiMoe2T<1>, true>(F.lds, S, E); }
__device__ __forceinline__ void ph_ln2(int l) { PHASE_PROLOGUE(); phase_ln2(F, P, l); }

constexpr int PH_PER_LAYER = 11, N_PHASES = 1 + NL * PH_PER_LAYER;
__global__ void __launch_bounds__(512, 2) fwd_kernel(Params p) {
    for (int u = threadIdx.x; u < (LDS_BYTES - LDS_MISC) / 4; u += 512) ((LAS unsigned*)((LAS unsigned char*)lds_raw + LDS_MISC))[u] = 0u;
    __syncthreads();
#if ONE_LAUNCH
    XcdBarrier bar = xcd_barrier_post((unsigned*)(p.ws + WS_CTL) + CW_BAR, (volatile LAS unsigned*)((LAS unsigned char*)lds_raw + LDS_MISC));
#define SEAM() xcd_barrier(bar)
#else
#define SEAM() do { } while (0)
#endif
    const int lo = p.phase_lo, hi = p.phase_hi;
#ifdef ONLY_K
#define IN(k) ((k) == ONLY_K && lo <= pb + (k) && pb + (k) < hi)
#else
#define IN(k) (lo <= pb + (k) && pb + (k) < hi)
#endif
#ifndef ONLY_K
    { const int pb = 0; if (IN(0)) { ph_prologue(); SEAM(); if (REPEAT_K == 20) { ph_prologue(); SEAM(); } } }
#endif
#if DEBUG_MODE
    {
        { ph_inproj(0); SEAM(); }
        { PHASE_PROLOGUE(); dbg_prep(F, P, 0); } SEAM();
        { PHASE_PROLOGUE(); if (blockIdx.x < 128) dbg_scan(F, P, 0, 0, 128); } SEAM();
        if (DEBUG_MODE >= 6) { PHASE_PROLOGUE(); dbg_bruteforce(F); SEAM(); }
        ph_wkva(0); SEAM();
        if (blockIdx.x < 64) ph_wkvb(); SEAM();
        ph_wkvc(0); SEAM();
        { PHASE_PROLOGUE();
          if (DEBUG_MODE == 1) dbg_compare(F, WSP(bf16_t, WS_OUTA), WSP(bf16_t, DBG_OUTAREF), (size_t)T * 512, ctl, 0);
          if (DEBUG_MODE == 2) dbg_compare(F, WSP(bf16_t, WS_MT), WSP(float, DBG_MREF), (size_t)4096 * 4096, ctl, 1);
          if (DEBUG_MODE == 3) dbg_compare(F, WSP(bf16_t, DBG_YDBG), WSP(bf16_t, DBG_YREF), (size_t)T * 512, ctl, 0);
          if (DEBUG_MODE == 4) dbg_compare(F, WSP(float, WS_RK), WSP(float, DBG_RKREF), (size_t)T * 8, ctl, 0);
          if (DEBUG_MODE == 5) dbg_compare_vt(F, ctl);
          if (DEBUG_MODE == 20 && blockIdx.x == 0 && F.tid == 0) { const unsigned bits = __hip_atomic_load(ctl + 12, __ATOMIC_RELAXED, __HIP_MEMORY_SCOPE_AGENT); float st = 0.f; for (int bb = 15; bb >= 1; --bb) if (bits & (1u << bb)) st = (float)bb; ((float*)ctl)[1024] = st * st * 1e-4f; ((float*)ctl)[1025] = 1.f; }
          if (DEBUG_MODE == 10) dbg_compare(F, (const bf16_t*)F.out, WSP(float, WS_SW), (size_t)T * 512, ctl, 0);
          if (DEBUG_MODE == 11) dbg_compare(F, (const bf16_t*)F.out + (size_t)T * 512, WSP(bf16_t, WS_SB), (size_t)T * 512, ctl, 0);
          if (DEBUG_MODE == 12) dbg_compare(F, (const bf16_t*)F.out + (size_t)2 * T * 512, WSP(bf16_t, WS_SA), (size_t)T * 512, ctl, 0);
          if (DEBUG_MODE == 6) dbg_compare(F, WSP(bf16_t, WS_PHI), WSP(float, DBG_BF), (size_t)256 * 4096, ctl, 0);
          if (DEBUG_MODE == 7) dbg_compare(F, WSP(bf16_t, WS_GT), WSP(float, DBG_BF) + (size_t)1 * 256 * 4096, (size_t)256 * 4096, ctl, 1);
          if (DEBUG_MODE == 8) dbg_compare(F, WSP(bf16_t, WS_PSI), WSP(float, DBG_BF) + (size_t)2 * 256 * 4096, (size_t)256 * 4096, ctl, 0);
          if (DEBUG_MODE == 9) dbg_compare(F, WSP(bf16_t, WS_Y0T), WSP(float, DBG_BF) + (size_t)3 * 256 * 4096, (size_t)256 * 4096, ctl, 1);
        } SEAM();
        { PHASE_PROLOGUE(); float num = 0.f, den = 0.f; for (int g2 = 0; g2 < 256; ++g2) { num += ((const float*)ctl)[1024 + 2 * g2]; den += ((const float*)ctl)[1025 + 2 * g2]; }
          float e = 1000.f * sqrtf(num / fmaxf(den, 1e-30f)); if (!(e == e)) e = 7.0e6f; else if (e > 5e6f) e = 5.0e6f; if (!(den == den)) e = 9.0e6f;
          for (size_t i = (size_t)blockIdx.x * 512 + F.tid; i < (size_t)T * D; i += (size_t)F.G * 512) F.out[i] = e; }
        return;
    }
#endif
#define RUN_LAYER(l) do { const int pb = 1 + (l) * PH_PER_LAYER;\
        if (IN(0)) { ph_inproj(l); SEAM(); if (REPEAT_K == 0) { ph_inproj(l); SEAM(); } if (REPEAT_K == 30) { ph_inproj_null(l); SEAM(); } }\
        if (IN(1)) { ph_wkva(l); SEAM(); if (REPEAT_K == 1) { ph_wkva(l); SEAM(); } if (REPEAT_K == 15) { ph_wkva_e(l); SEAM(); } if (REPEAT_K == 11) { ph_cvtmoe(l); SEAM(); } }\
        if (IN(2)) { if (blockIdx.x < 64) ph_wkvb(); else ph_sguconv(l); if ((l) + 1 < NL) ph_cvtmoe((l) + 1); SEAM(); if (REPEAT_K == 2) { if (blockIdx.x < 64) ph_wkvb(); else ph_sguconv(l); SEAM(); } if (REPEAT_K == 13) { if (blockIdx.x < 64) ph_wkvb(); SEAM(); } if (REPEAT_K == 14) { if (blockIdx.x >= 64) ph_sguconv(l); SEAM(); } }\
        if (IN(3)) { ph_wkvc(l); SEAM(); if (REPEAT_K == 3) { ph_wkvc(l); SEAM(); } }\
        if (IN(4)) { ph_branch(l); SEAM(); if (REPEAT_K == 4) { ph_branch(l); SEAM(); } }\
        if (IN(5)) { ph_wout(l); SEAM(); if (REPEAT_K == 5) { ph_wout(l); SEAM(); } }\
        if (IN(6)) { if (blockIdx.x < 128) ph_router(l); else ph_ln1(l); SEAM(); if (REPEAT_K == 6) { if (blockIdx.x >= 128) ph_ln1(l); SEAM(); } if (REPEAT_K == 7) { if (blockIdx.x < 128) ph_router_probe(l); SEAM(); } }\
        if (IN(8)) { ph_moe1(l); SEAM(); if (REPEAT_K == 8) { ph_moe1(l); SEAM(); } }\
        if (IN(9)) { ph_moe2(l); SEAM(); if (REPEAT_K == 9) { ph_moe2(l); SEAM(); } if (REPEAT_K == 19) { ph_moe2_nostore(l); SEAM(); } }\
        if (IN(10)) { if (REPEAT_K == 10) { ph_ln2(l); SEAM(); } if (REPEAT_K == 12) { SEAM(); SEAM(); SEAM(); SEAM(); SEAM(); SEAM(); SEAM(); SEAM(); SEAM(); SEAM(); } ph_ln2(l); if (l + 1 < NL) SEAM(); } } while (0)
    RUN_LAYER(0); RUN_LAYER(1); RUN_LAYER(2); RUN_LAYER(3);
#undef RUN_LAYER
#undef IN
#undef SEAM
}

extern "C" void kernel_launch(void* const* d_in, const int* in_sizes, int n_in, void* d_out, int out_size, void* d_ws, size_t ws_size, hipStream_t stream) {
    static int grid = 0;
    if (grid == 0) {
        if (n_in != 38 || in_sizes[0] != T * D || out_size != T * D || ws_size < WS_END) { fprintf(stderr, "kernel_launch: unexpected shapes (n_in %d, in0 %d, out %d, ws %zu, need %zu); nothing launched\n", n_in, n_in > 0 ? in_sizes[0] : -1, out_size, ws_size, (size_t)WS_END); grid = -1; return; }
        int dev = 0, cus = 0, per_cu = 0;
        if (hipGetDevice(&dev) != hipSuccess || hipDeviceGetAttribute(&cus, hipDeviceAttributeMultiprocessorCount, dev) != hipSuccess) { grid = -1; return; }
        if (hipFuncSetAttribute((const void*)fwd_kernel, hipFuncAttributeMaxDynamicSharedMemorySize, LDS_BYTES) != hipSuccess) { fprintf(stderr, "kernel_launch: hipFuncSetAttribute failed\n"); grid = -1; return; }
        if (hipOccupancyMaxActiveBlocksPerMultiprocessor(&per_cu, (const void*)fwd_kernel, 512, LDS_BYTES) != hipSuccess || per_cu < 1) fprintf(stderr, "kernel_launch: occupancy query reports %d blocks per CU\n", per_cu);
        (void)hipGetLastError();
        grid = cus;
        if (grid != 256) { fprintf(stderr, "kernel_launch: built for a 256-CU device, found %d CUs; nothing launched\n", cus); grid = -1; return; }
    }
    if (grid < 0) return;
    (void)hipMemsetAsync((char*)d_ws + WS_CTL, 0, CTL_BYTES, stream);
    Params p{};
    for (int i = 0; i < 38; ++i) p.in[i] = (const float*)d_in[i];
    p.out = (float*)d_out; p.ws = (unsigned char*)d_ws; p.layer_lo = 0; p.layer_hi = NL;
#if ONE_LAUNCH
    p.phase_lo = 0; p.phase_hi = N_PHASES;
    hipLaunchKernelGGL(fwd_kernel, dim3(grid), dim3(512), LDS_BYTES, stream, p);
#else
    for (int ph = 0; ph < N_PHASES; ++ph) { p.phase_lo = ph; p.phase_hi = ph + 1; hipLaunchKernelGGL(fwd_kernel, dim3(grid), dim3(512), LDS_BYTES, stream, p); }
#endif
}
```

```cpp
#include <hip/hip_runtime.h>
#include <stdint.h>
#include <stdio.h>

#ifndef DEBUG_MODE
#define DEBUG_MODE 0
#endif
#ifndef REPEAT_K
#define REPEAT_K -1
#endif
#ifndef ONE_LAUNCH
#define ONE_LAUNCH 1
#endif

#define LAS __attribute__((address_space(3)))
typedef unsigned short bf16_t;
typedef short bf16x8 __attribute__((ext_vector_type(8)));
typedef float f32x4 __attribute__((ext_vector_type(4)));
typedef float f32x2 __attribute__((ext_vector_type(2)));
typedef unsigned u32x4 __attribute__((ext_vector_type(4)));
typedef unsigned u32x2 __attribute__((ext_vector_type(2)));

constexpr int T = 32768, SEQ = 2048, D = 1024, NL = 4;
constexpr int NIN = 5888;
constexpr int RKVW = 1792;
constexpr int NE = 32;
constexpr float ALPHA = 1.681792830507429f;
constexpr float LN_EPS = 1e-5f, GN_EPS = 64e-5f;

constexpr size_t MiB = 1u << 20;
constexpr size_t WS_CTL = 0;
constexpr size_t WS_WIN = 1 * MiB;
constexpr size_t WS_WBR = WS_WIN + 46 * MiB;
constexpr size_t WS_WOUT = WS_WBR + 8 * MiB;
constexpr size_t WS_WRT = WS_WOUT + 8 * MiB;
constexpr size_t WS_WMOE = WS_WRT + 1 * MiB;
constexpr size_t WS_X = WS_WMOE + 96 * MiB;
constexpr size_t WS_X1 = WS_X + 64 * MiB;
constexpr size_t WS_VFIRST = WS_X1 + 64 * MiB;
constexpr size_t WS_RKV = WS_VFIRST + 32 * MiB;
constexpr size_t WS_SGUZ = WS_RKV + 112 * MiB;
constexpr size_t WS_CONVH = WS_SGUZ + 32 * MiB;
constexpr size_t WS_GATES = WS_CONVH + 16 * MiB;
constexpr size_t WS_PHI = WS_GATES + 192 * MiB;
constexpr size_t WS_PSI = WS_PHI + 32 * MiB;
constexpr size_t WS_GT = WS_PSI + 32 * MiB;
constexpr size_t WS_Y0T = WS_GT + 32 * MiB;
constexpr size_t WS_VT = WS_Y0T + 32 * MiB;
constexpr size_t WS_MT = WS_VT + 32 * MiB;
constexpr size_t WS_RK = WS_MT + 32 * MiB;
constexpr size_t WS_LORA = WS_RK + 1 * MiB;
constexpr size_t WS_SGUW = WS_LORA + 1 * MiB;
constexpr size_t WS_OUTA = WS_SGUW + 1 * MiB;
constexpr size_t WS_HB = WS_OUTA + 32 * MiB;
constexpr size_t WS_HC = WS_HB + 16 * MiB;
constexpr size_t WS_XQ = WS_HC + 16 * MiB;
constexpr size_t WS_END = WS_XQ + 32 * MiB;
constexpr size_t WS_X1Q = WS_WMOE + 64 * MiB;
constexpr size_t WS_STATS = WS_Y0T;
constexpr size_t WS_WRG = WS_WBR + 4 * MiB;
constexpr size_t WS_RC = WS_SGUW + 512 * 1024;
constexpr size_t WS_MERGEDQ = WS_GT;
constexpr size_t WS_MERGED = WS_RKV;
constexpr size_t WS_PRE = WS_PHI;
constexpr size_t WS_H = WS_RKV;
constexpr size_t WS_Y = WS_GATES;
constexpr size_t WS_LIST = WS_SGUZ;
constexpr size_t WS_GATEV = WS_SGUZ + 16 * MiB;
static_assert(WS_END <= 1024 * MiB, "workspace map");
#if DEBUG_MODE
constexpr size_t WS_SV = WS_GATES, WS_SA = WS_SV + 32 * MiB, WS_SB = WS_SA + 32 * MiB, WS_SR = WS_SB + 32 * MiB, WS_SK = WS_SR + 32 * MiB, WS_SG = WS_SK + 32 * MiB;
constexpr size_t WS_SW = WS_X1;
constexpr size_t DBG_OUTAREF = WS_WMOE, DBG_MREF = WS_WMOE + 32 * MiB, DBG_YREF = WS_SGUZ, DBG_RKREF = WS_HB, DBG_YDBG = WS_HC;
#endif
constexpr int CW_BAR = 4096;
constexpr int CW_CNT = 16384;
constexpr size_t CTL_BYTES = 1 * MiB;

constexpr int LDS_STAGE = 131072;
constexpr int LDS_MISC = LDS_STAGE;
constexpr int LDS_BYTES = LDS_STAGE + 4096;

typedef __bf16 bf16x2_t __attribute__((ext_vector_type(2)));
__device__ __forceinline__ unsigned cvt_pk_bf16(float lo, float hi) { const f32x2 v = {lo, hi}; const bf16x2_t b = __builtin_convertvector(v, bf16x2_t); return __builtin_bit_cast(unsigned, b); }
__device__ __forceinline__ unsigned pack_fp8x4(float a, float b, float c, float d) { int w = 0; w = __builtin_amdgcn_cvt_pk_fp8_f32(a, b, w, false); w = __builtin_amdgcn_cvt_pk_fp8_f32(c, d, w, true); return (unsigned)w; }
__device__ __forceinline__ bf16_t f2bf(float f) { return (bf16_t)(cvt_pk_bf16(f, 0.f) & 0xffffu); }
__device__ __forceinline__ float bf2f(unsigned short b) { return __uint_as_float(((unsigned)b) << 16); }
__device__ __forceinline__ float bflo(unsigned w) { return __uint_as_float(w << 16); }
__device__ __forceinline__ float bfhi(unsigned w) { return __uint_as_float(w & 0xffff0000u); }
__device__ __forceinline__ float sigmoidf_(float x) { return __builtin_amdgcn_rcpf(1.0f + __expf(-x)); }
template <int CTRL> __device__ __forceinline__ float dpp_mov(float x) { return __builtin_bit_cast(float, __builtin_amdgcn_mov_dpp(__builtin_bit_cast(int, x), CTRL, 0xF, 0xF, true)); }
__device__ __forceinline__ float row16_sum(float v) { v += dpp_mov<0xB1>(v); v += dpp_mov<0x4E>(v); v += dpp_mov<0x141>(v); v += dpp_mov<0x140>(v); return v; }
__device__ __forceinline__ float wave_sum(float v) {
    v = row16_sum(v); const int vi = __builtin_bit_cast(int, v);
    return (__builtin_bit_cast(float, __builtin_amdgcn_readlane(vi, 0)) + __builtin_bit_cast(float, __builtin_amdgcn_readlane(vi, 16))) + (__builtin_bit_cast(float, __builtin_amdgcn_readlane(vi, 32)) + __builtin_bit_cast(float, __builtin_amdgcn_readlane(vi, 48)));
}
__device__ __forceinline__ float dpp_f(float x, const int ctrl_sel) {
    int xi = __builtin_bit_cast(int, x), r;
    if (ctrl_sel == 0) r = __builtin_amdgcn_update_dpp(0, xi, 0xB1, 0xF, 0xF, true);
    else if (ctrl_sel == 1) r = __builtin_amdgcn_update_dpp(0, xi, 0x4E, 0xF, 0xF, true);
    else r = __builtin_amdgcn_update_dpp(0, xi, 0x141, 0xF, 0xF, true);
    return __builtin_bit_cast(float, r);
}
__device__ __forceinline__ float reduce8(float x) { x += dpp_f(x, 0); x += dpp_f(x, 1); x += dpp_f(x, 2); return x; }
__device__ __forceinline__ float gelu_f(float v) {
    const float av = fabsf(v), t = __builtin_amdgcn_rcpf(av * 0.2316418882f + 1.0f);
    float q = t * 0.5307027145f + (-0.7265760135f); q = q * t + 0.7107068705f; q = q * t + (-0.142248368f); q = q * t + 0.127414796f; q = q * t;
    const float e = __builtin_amdgcn_exp2f((v * v) * (-0.72134752044f));
    const float m = v * (q * e);
    return v < 0.f ? m : v - m;
}

#define XB_TMO      128
#define XB_XCNT(j)  (256  + 64 * (j))
#define XB_XSUB(j)  (1280 + 64 * (j))
#define XB_XGEN(j)  (2304 + 64 * (j))
#define XB_TOP      3328
#define XB_TOPGEN   3392
#define XCD_BAR_WORDS 3456
#define XB_SPIN_CAP (1u << 22)
__device__ __forceinline__ unsigned xb_ld(unsigned* p)              { return __hip_atomic_load(p, __ATOMIC_RELAXED, __HIP_MEMORY_SCOPE_AGENT); }
__device__ __forceinline__ unsigned xb_add(unsigned* p, unsigned v) { return __hip_atomic_fetch_add(p, v, __ATOMIC_RELAXED, __HIP_MEMORY_SCOPE_AGENT); }
__device__ __forceinline__ unsigned xb_xcc_id() { return (unsigned)__builtin_amdgcn_s_getreg((3 << 11) | 20) & 0xFu; }
#define XB_SPIN(cond, bar) do { unsigned _sp = 0; while (cond) { __builtin_amdgcn_s_sleep(1); \
    if ((++_sp & 255u) == 0u) { if (xb_ld(&(bar)[XB_TMO])) break; if (_sp > XB_SPIN_CAP) { atomicAdd(&(bar)[XB_TMO], 1u); break; } } } } while (0)
struct XcdBarrier { unsigned* bar; unsigned x; volatile LAS unsigned* st; };
__device__ __forceinline__ XcdBarrier xcd_barrier_post(unsigned* bar, volatile LAS unsigned* st) {
    XcdBarrier b; b.bar = bar; b.x = xb_xcc_id(); b.st = st;
    if (threadIdx.x == 0) (void)xb_add(&bar[XB_XCNT(b.x)], 1u);
    return b;
}
__device__ __forceinline__ void xcd_barrier_complete(unsigned* bar, unsigned x, unsigned& nloc, unsigned& nx) {
    const unsigned G = gridDim.x * gridDim.y * gridDim.z;
    unsigned sum, cnt, mine, sp = 0u;
    for (;;) {
        sum = 0u; cnt = 0u; mine = 0u;
#pragma unroll
        for (unsigned j = 0; j < 16; ++j) { const unsigned c = xb_ld(&bar[XB_XCNT(j)]); sum += c; cnt += (c > 0u) ? 1u : 0u; mine = (j == x) ? c : mine; }
        if (sum == G) break;
        __builtin_amdgcn_s_sleep(1);
        if ((++sp & 255u) == 0u) { if (xb_ld(&bar[XB_TMO])) break; if (sp > XB_SPIN_CAP) { atomicAdd(&bar[XB_TMO], 1u); break; } }
    }
    nloc = mine > 0u ? mine : 1u; nx = cnt > 0u ? cnt : 1u;
}
__device__ __forceinline__ void xcd_barrier(const XcdBarrier& b) {
    asm volatile("s_waitcnt vmcnt(0)" ::: "memory");
    __syncthreads();
    if (threadIdx.x == 0) {
        unsigned* bar = b.bar;
        __builtin_amdgcn_s_waitcnt(0);
        unsigned nloc = b.st[0], nx = b.st[1];
        if (nloc == 0u) { xcd_barrier_complete(bar, b.x, nloc, nx); b.st[0] = nloc; b.st[1] = nx; }
        const unsigned old = xb_add(&bar[XB_XSUB(b.x)], 1u);
        const unsigned gen = old / nloc;
        if (old + 1u == (gen + 1u) * nloc) {
            __builtin_amdgcn_fence(__ATOMIC_RELEASE, "agent");
            asm volatile("s_waitcnt vmcnt(0)" ::: "memory");
            const unsigned og = xb_add(&bar[XB_TOP], 1u);
            const unsigned tg = og / nx;
            if (og + 1u == (tg + 1u) * nx) xb_add(&bar[XB_TOPGEN], 1u);
            else XB_SPIN(xb_ld(&bar[XB_TOPGEN]) == tg, bar);
            __builtin_amdgcn_fence(__ATOMIC_ACQUIRE, "agent");
            xb_add(&bar[XB_XGEN(b.x)], 1u);
            asm volatile("s_waitcnt vmcnt(0)" ::: "memory");
        } else {
            XB_SPIN(xb_ld(&bar[XB_XGEN(b.x)]) == gen, bar);
            __builtin_amdgcn_fence(__ATOMIC_ACQUIRE, "agent");
            asm volatile("s_waitcnt vmcnt(0)" ::: "memory");
        }
    }
    __syncthreads();
}

struct Params {
    const float* in[38];
    float* out;
    unsigned char* ws;
    int phase_lo, phase_hi;
    int layer_lo, layer_hi;
};

namespace ge {
constexpr int BM = 256, BK = 64, HALF = 128, HTB = HALF * BK * 2;
__device__ __forceinline__ int lds_byte(int r, int c) { const int st = (r >> 4) * 2 + (c >> 5), rr = r & 15, cc = c & 31, ob = rr * 64 + cc * 2; return st * 1024 + (ob ^ (((ob >> 9) & 1) << 5)); }
__device__ __forceinline__ void stage_rc(int b, int& R, int& C) { const int st = b / 1024, sb = b % 1024, swz = sb ^ (((sb >> 9) & 1) << 5); R = (st >> 1) * 16 + swz / 64; C = (st & 1) * 32 + (swz % 64) / 2; }
__device__ __forceinline__ int perm32(int rho) { const int n = rho >> 4, i = rho & 15; return 8 * (i >> 2) + 4 * n + (i & 3); }

struct NoPre { };
struct Unit {
    const char* A; const char* B;
    const int* gat;
    unsigned lda, ldb;
    int nt;
    int gshift, nvalid;
    int pm, pn, aux;
};
typedef f32x4 Acc[2][2][4][2];

typedef int i32x8 __attribute__((ext_vector_type(8)));
template <class Sched, class Epi, bool FP8 = false, int SCALE_W = 0x7A7A7A7A, int SCALE_A = 0x7F7F7F7F>
__device__ __forceinline__ void gemm_phase(LAS unsigned char* lds, const Sched& S, const Epi& E) {
    int tid = threadIdx.x; asm volatile("" : "+v"(tid));
    const int wid = __builtin_amdgcn_readfirstlane(tid >> 6), lane = tid & 63, wr = wid >> 2, wc = wid & 3, fr = lane & 15, fq = lane >> 4;
    const unsigned ldsw = (unsigned)wid * 1024u;
    const int aoff = FP8 ? lds_byte(wr * 64 + fr, fq * 16) : lds_byte(wr * 64 + fr, fq * 8), boff = FP8 ? lds_byte(wc * 32 + fr, fq * 16) : lds_byte(wc * 32 + fr, fq * 8);
    const int aoff1 = FP8 ? lds_byte(wr * 64 + fr, fq * 16 + 8) : aoff + 1024, boff1 = FP8 ? lds_byte(wc * 32 + fr, fq * 16 + 8) : boff + 1024;
#define GE_SA(b, h) (((b) * 2 + (h)) * HTB)
#define GE_SB(b, h) ((4 + (b) * 2 + (h)) * HTB)
#define GE_STAGE(bufoff, gbase, o0, o1) do { \
        __builtin_amdgcn_global_load_lds((const unsigned*)((gbase) + (o0)), (LAS unsigned*)(lds + (bufoff) + ldsw), 16, 0, 0); \
        __builtin_amdgcn_global_load_lds((const unsigned*)((gbase) + (o1)), (LAS unsigned*)(lds + (bufoff) + ldsw + 8192), 16, 0, 0); } while (0)
#define GE_LDA(dst, b, h) do { _Pragma("unroll") for (int m = 0; m < 4; ++m) { dst[m][0] = *(const LAS bf16x8*)(lds + GE_SA(b, h) + aoff + m * 2048); dst[m][1] = *(const LAS bf16x8*)(lds + GE_SA(b, h) + aoff1 + m * 2048); } } while (0)
#define GE_LDB(dst, b, h) do { _Pragma("unroll") for (int n = 0; n < 2; ++n) { dst[n][0] = *(const LAS bf16x8*)(lds + GE_SB(b, h) + boff + n * 2048); dst[n][1] = *(const LAS bf16x8*)(lds + GE_SB(b, h) + boff1 + n * 2048); } } while (0)
#define GE_CAT(x0, x1) __builtin_shufflevector(__builtin_bit_cast(u32x4, x0), __builtin_bit_cast(u32x4, x1), 0, 1, 2, 3, 4, 5, 6, 7)
#define GE_MMA(ai, bj, At, Bt) do { __builtin_amdgcn_s_setprio(1); _Pragma("unroll") for (int m = 0; m < 4; ++m) _Pragma("unroll") for (int n = 0; n < 2; ++n) { \
        if constexpr (FP8) acc[ai][bj][m][n] = __builtin_amdgcn_mfma_scale_f32_16x16x128_f8f6f4(__builtin_bit_cast(i32x8, GE_CAT(Bt[n][0], Bt[n][1])), __builtin_bit_cast(i32x8, GE_CAT(At[m][0], At[m][1])), acc[ai][bj][m][n], 0, 0, 0, SCALE_W, 0, SCALE_A); \
        else { _Pragma("unroll") for (int k = 0; k < 2; ++k) acc[ai][bj][m][n] = __builtin_amdgcn_mfma_f32_16x16x32_bf16(Bt[n][k], At[m][k], acc[ai][bj][m][n], 0, 0, 0); } } __builtin_amdgcn_s_setprio(0); } while (0)
#define GE_WAIT_V(n) asm volatile("s_waitcnt vmcnt(" #n ")" ::: "memory")
#define GE_WAIT_L(n) asm volatile("s_waitcnt lgkmcnt(" #n ")" ::: "memory")
#define GE_BAR __builtin_amdgcn_s_barrier()
#define GE_SCHED __builtin_amdgcn_sched_barrier(0)
#define GE_OFFS(u, oA00, oA01, oA10, oA11, oB0, oB1) do { \
        int tq_ = tid; asm volatile("" : "+v"(tq_)); int R0, C0, R1, C1; stage_rc(tq_ * 16, R0, C0); stage_rc(tq_ * 16 + 8192, R1, C1); \
        const int Rb0 = (R0 & ~31) + perm32(R0 & 31), Rb1 = (R1 & ~31) + perm32(R1 & 31); \
        int r00 = R0, r01 = R1, r10 = 128 + R0, r11 = 128 + R1; \
        if ((u).gat) { const int* g_ = (u).gat; const int nv_ = (u).nvalid, sh_ = (u).gshift; \
            r00 = (r00 < nv_) ? (g_[2 * r00] >> sh_) : 0; r01 = (r01 < nv_) ? (g_[2 * r01] >> sh_) : 0; r10 = (r10 < nv_) ? (g_[2 * r10] >> sh_) : 0; r11 = (r11 < nv_) ? (g_[2 * r11] >> sh_) : 0; } \
        oA00 = (unsigned)r00 * (u).lda + (unsigned)C0 * 2u; oA01 = (unsigned)r01 * (u).lda + (unsigned)C1 * 2u; \
        oA10 = (unsigned)r10 * (u).lda + (unsigned)C0 * 2u; oA11 = (unsigned)r11 * (u).lda + (unsigned)C1 * 2u; \
        oB0 = (unsigned)Rb0 * (u).ldb + (unsigned)C0 * 2u; oB1 = (unsigned)Rb1 * (u).ldb + (unsigned)C1 * 2u; } while (0)
    Unit cur, nxt; int ui = 0;
    if (!S.next(0, cur)) return;
    Acc acc;
#pragma unroll
    for (int a = 0; a < 2; ++a)
#pragma unroll
        for (int b = 0; b < 2; ++b)
#pragma unroll
            for (int m = 0; m < 4; ++m)
#pragma unroll
                for (int n = 0; n < 2; ++n) acc[a][b][m][n] = (f32x4){0.f, 0.f, 0.f, 0.f};
    bf16x8 At[4][2], B0[2][2], B1[2][2];
    unsigned oA00, oA01, oA10, oA11, oB0, oB1;
    GE_OFFS(cur, oA00, oA01, oA10, oA11, oB0, oB1);
    typename Epi::Pre pre = E.prefetch(cur, wr, wc, fr, fq);
    const char* cA = cur.A; const char* cB = cur.B; size_t chB = (size_t)128 * cur.ldb;
    const size_t kstep = 128;
    GE_STAGE(GE_SB(0, 0), cB, oB0, oB1); GE_STAGE(GE_SA(0, 0), cA, oA00, oA01); GE_STAGE(GE_SB(0, 1), cB + chB, oB0, oB1); GE_STAGE(GE_SA(0, 1), cA, oA10, oA11);
    if (wr == 1) GE_BAR;
    GE_WAIT_V(4); GE_BAR;
    GE_STAGE(GE_SB(1, 0), cB + kstep, oB0, oB1); GE_STAGE(GE_SA(1, 0), cA + kstep, oA00, oA01); GE_STAGE(GE_SB(1, 1), cB + chB + kstep, oB0, oB1);
    GE_WAIT_V(6); GE_BAR;
    for (;;) {
        const bool has_next = S.next(ui + 1, nxt);
        const char* nA = has_next ? nxt.A : cA; const char* nB = has_next ? nxt.B : cB; const size_t nhB = has_next ? (size_t)128 * nxt.ldb : chB;
        const int nt = cur.nt;
        for (int t = 0; t < nt; t += 2) {
            const bool last = (t == nt - 2);
            const char* a1 = cA + (size_t)(t + 1) * kstep;
            const char* a2 = last ? nA : cA + (size_t)(t + 2) * kstep; const char* b2 = last ? nB : cB + (size_t)(t + 2) * kstep;
            const size_t hB2 = last ? nhB : chB;
            const char* a3 = a2 + kstep; const char* b3 = b2 + kstep;
            GE_LDB(B0, 0, 0); GE_SCHED; GE_LDA(At, 0, 0); GE_STAGE(GE_SA(1, 1), a1, oA10, oA11);
            if (last && has_next) { GE_OFFS(nxt, oA00, oA01, oA10, oA11, oB0, oB1); }
            GE_WAIT_L(8); GE_BAR; GE_WAIT_L(0); GE_MMA(0, 0, At, B0); GE_BAR; GE_SCHED;
            GE_LDB(B1, 0, 1); GE_STAGE(GE_SB(0, 0), b2, oB0, oB1);
            GE_BAR; GE_WAIT_L(0); GE_MMA(0, 1, At, B1); GE_BAR;
            GE_LDA(At, 0, 1); GE_STAGE(GE_SA(0, 0), a2, oA00, oA01);
            GE_BAR; GE_WAIT_L(0); GE_MMA(1, 0, At, B0); GE_BAR; GE_SCHED;
            GE_STAGE(GE_SB(0, 1), b2 + hB2, oB0, oB1);
            GE_WAIT_V(6); GE_BAR; GE_MMA(1, 1, At, B1); GE_BAR;
            GE_LDB(B0, 1, 0); GE_SCHED; GE_LDA(At, 1, 0); GE_STAGE(GE_SA(0, 1), a2, oA10, oA11);
            GE_WAIT_L(8); GE_BAR; GE_WAIT_L(0); GE_MMA(0, 0, At, B0); GE_BAR; GE_SCHED;
            GE_LDB(B1, 1, 1); GE_STAGE(GE_SB(1, 0), b3, oB0, oB1);
            GE_BAR; GE_WAIT_L(0); GE_MMA(0, 1, At, B1); GE_BAR;
            GE_LDA(At, 1, 1); GE_STAGE(GE_SA(1, 0), a3, oA00, oA01);
            GE_BAR; GE_WAIT_L(0); GE_MMA(1, 0, At, B0); GE_BAR; GE_SCHED;
            GE_STAGE(GE_SB(1, 1), b3 + hB2, oB0, oB1);
            GE_WAIT_V(6); GE_BAR; GE_MMA(1, 1, At, B1); GE_BAR;
        }
        if constexpr (!Epi::AFTER_DRAIN) E(acc, cur, wr, wc, fr, fq, pre);
        if (!has_next) break;
#pragma unroll
        for (int a = 0; a < 2; ++a)
#pragma unroll
            for (int b = 0; b < 2; ++b)
#pragma unroll
                for (int m = 0; m < 4; ++m)
#pragma unroll
                    for (int n = 0; n < 2; ++n) acc[a][b][m][n] = (f32x4){0.f, 0.f, 0.f, 0.f};
        cur = nxt; cA = nA; cB = nB; chB = nhB; ++ui; pre = E.prefetch(cur, wr, wc, fr, fq);
    }
    GE_WAIT_V(0);
    if (wr == 0) GE_BAR;
    GE_BAR;
    if constexpr (Epi::AFTER_DRAIN) E.drained(acc, cur, wr, wc, fr, fq, lds);
#undef GE_SA
#undef GE_SB
#undef GE_STAGE
#undef GE_LDA
#undef GE_LDB
#undef GE_MMA
#undef GE_WAIT_V
#undef GE_WAIT_L
#undef GE_BAR
#undef GE_SCHED
#undef GE_OFFS
#undef GE_CAT
}
__device__ __forceinline__ bool static_tile(long L, int nM, int nN, int& pm, int& pn) {
    const int nwg = nM * nN; if (L >= nwg) return false;
    int wgid = (int)L; { const int q = nwg / 8, r = nwg % 8, xcd = wgid % 8, off = wgid / 8; wgid = (xcd < r ? xcd * (q + 1) : r * (q + 1) + (xcd - r) * q) + off; }
    const int nig = 8 * nN, gid = wgid / nig, fm = gid * 8, gsz = (nM - fm) < 8 ? (nM - fm) : 8;
    pm = fm + ((wgid % nig) % gsz); pn = (wgid % nig) / gsz; return true;
}
}

struct Frame {
    LAS unsigned char* lds;
    int tid, lane, wave, G, vcu;
    unsigned char* ws;
    float* out;
};
#define WSP(T_, off) ((T_*)(F.ws + (off)))

extern __shared__ __attribute__((aligned(16))) unsigned char lds_raw[];
__device__ __forceinline__ Params load_params() {
    typedef const __attribute__((address_space(4))) unsigned long long cu64;
    cu64* k = (cu64*)__builtin_amdgcn_kernarg_segment_ptr();
    asm volatile("" : "+s"(k));
    Params P;
#pragma unroll
    for (int i = 0; i < 38; ++i) P.in[i] = (const float*)(const __attribute__((address_space(1))) float*)k[i];
    P.out = (float*)(__attribute__((address_space(1))) float*)k[38]; P.ws = (unsigned char*)(__attribute__((address_space(1))) unsigned char*)k[39];
    P.phase_lo = 0; P.phase_hi = 0; P.layer_lo = 0; P.layer_hi = 0;
    return P;
}
#define KPARAMS() load_params()
__device__ __forceinline__ Frame make_frame(unsigned char* ws, float* out) {
    Frame F;
    F.lds = (LAS unsigned char*)lds_raw;
    int tz = threadIdx.x; asm volatile("" : "+v"(tz));
    F.tid = tz; F.lane = F.tid & 63; F.wave = __builtin_amdgcn_readfirstlane(F.tid >> 6);
    F.G = gridDim.x; { const int bx = blockIdx.x; F.vcu = (F.G % 8 == 0) ? (bx % 8) * (F.G / 8) + bx / 8 : bx; }
    F.ws = ws; F.out = out;
    return F;
}
template <bool FP8OUT, class ColMap>
__device__ __forceinline__ void transpose_item(const float* W, int ldw, int K, void* WTv, int nblk, LAS float* scr, int item, int lane, const ColMap& cm) {
    const int kb = item / nblk, nb = item % nblk, k0 = 64 * kb, n0 = 32 * nb;
    const int sc = cm(n0 + (lane & 31));
#pragma unroll 8
    for (int i = 0; i < 32; ++i) { const int kk = 2 * i + (lane >> 5); scr[kk * 33 + (lane & 31)] = (sc >= 0) ? W[(size_t)(k0 + kk) * ldw + sc] : 0.f; }
    asm volatile("s_waitcnt lgkmcnt(0)" ::: "memory");
    const int c = lane & 7;
#pragma unroll
    for (int j = 0; j < 4; ++j) { const int n = (lane >> 3) + 8 * j; const LAS float* s = scr + (8 * c) * 33 + n;
        if (FP8OUT) { u32x2 o; o.x = pack_fp8x4(32.f * s[0 * 33], 32.f * s[1 * 33], 32.f * s[2 * 33], 32.f * s[3 * 33]); o.y = pack_fp8x4(32.f * s[4 * 33], 32.f * s[5 * 33], 32.f * s[6 * 33], 32.f * s[7 * 33]);
            *(u32x2*)((unsigned char*)WTv + (size_t)(n0 + n) * K + k0 + 8 * c) = o; }
        else { u32x4 o; o.x = cvt_pk_bf16(s[0 * 33], s[1 * 33]); o.y = cvt_pk_bf16(s[2 * 33], s[3 * 33]); o.z = cvt_pk_bf16(s[4 * 33], s[5 * 33]); o.w = cvt_pk_bf16(s[6 * 33], s[7 * 33]);
            *(u32x4*)((bf16_t*)WTv + (size_t)(n0 + n) * K + k0 + 8 * c) = o; } }
    asm volatile("s_waitcnt lgkmcnt(0)" ::: "memory");
}
struct CmIdent { __device__ __forceinline__ int operator()(int n) const { return n; } };
struct CmInproj { int layer; __device__ __forceinline__ int operator()(int j) const {
    if (j < 1536) return j;
    if (j < 1792) { const int q = j - 1536; if (q < 160) return 1536 + q; if (q < 192) return layer > 0 ? 5792 + (q - 160) : -1; return -1; }
    if (j < 2304) return 1696 + (j - 1792);
    if (j < 2816) { const int jj = j - 2304, c = jj >> 1; return (jj & 1) ? 2208 + 256 + c : 2208 + c; }
    return 2720 + (j - 2816); } };
struct CmRouter { __device__ __forceinline__ int operator()(int n) const { return n < 32 ? n : -1; } };
struct CmGU { __device__ __forceinline__ int operator()(int n) const { return n; } };

template <bool FP8OUT> __device__ __forceinline__ void moe_item_store(void* WTv, int K, int k0, int n0, LAS float* scr, int lane) {
    asm volatile("s_waitcnt lgkmcnt(0)" ::: "memory");
    const int c = lane & 7;
#pragma unroll
    for (int j = 0; j < 4; ++j) { const int nn = (lane >> 3) + 8 * j; const LAS float* s = scr + (8 * c) * 33 + nn;
        if (FP8OUT) { u32x2 o; o.x = pack_fp8x4(32.f * s[0 * 33], 32.f * s[1 * 33], 32.f * s[2 * 33], 32.f * s[3 * 33]); o.y = pack_fp8x4(32.f * s[4 * 33], 32.f * s[5 * 33], 32.f * s[6 * 33], 32.f * s[7 * 33]);
            *(u32x2*)((unsigned char*)WTv + (size_t)(n0 + nn) * K + k0 + 8 * c) = o; }
        else { u32x4 o; o.x = cvt_pk_bf16(s[0 * 33], s[1 * 33]); o.y = cvt_pk_bf16(s[2 * 33], s[3 * 33]); o.z = cvt_pk_bf16(s[4 * 33], s[5 * 33]); o.w = cvt_pk_bf16(s[6 * 33], s[7 * 33]);
            *(u32x4*)((bf16_t*)WTv + (size_t)(n0 + nn) * K + k0 + 8 * c) = o; } }
    asm volatile("s_waitcnt lgkmcnt(0)" ::: "memory");
}
__device__ __forceinline__ void fast_item_plain(const float* W, int ldw, int K, unsigned char* WT, int nblk, LAS float* scr, int item, int lane) {
    const int kb = item / nblk, nb = item % nblk, k0 = 64 * kb, n0 = 32 * nb; const int c4 = (lane & 7) * 4; const float* Ws = W + n0 + c4;
    f32x4 v[8];
#pragma unroll
    for (int i = 0; i < 8; ++i) v[i] = *(const f32x4*)(Ws + (size_t)(k0 + 8 * i + (lane >> 3)) * ldw);
#pragma unroll
    for (int i = 0; i < 8; ++i) { LAS float* d = scr + (8 * i + (lane >> 3)) * 33 + c4; d[0] = v[i][0]; d[1] = v[i][1]; d[2] = v[i][2]; d[3] = v[i][3]; }
    moe_item_store<true>(WT, K, k0, n0, scr, lane);
}
__device__ __forceinline__ void phase_convert_static(Frame& F, const Params& P) {
    LAS float* scr = (LAS float*)(F.lds + F.wave * 8448);
    const int gw = F.vcu * 8 + F.wave, NGW = F.G * 8;
    constexpr int I_IN = 16 * (NIN / 32);
    for (int it = gw; it < NL * I_IN; it += NGW) { const int l = it / I_IN, r = it % I_IN; const int lane = F.lane;
        const float* W = (l == 0) ? P.in[1] : P.in[2] + (size_t)(l - 1) * 1024 * 5824; const int ldw = (l == 0) ? 5792 : 5824;
        const int kb = r / (NIN / 32), nb = r % (NIN / 32), k0 = 64 * kb, n0 = 32 * nb;
        f32x4 v[8];
        if (n0 >= 2304 && n0 < 2816) {
            const int m = (lane >> 2) & 1, c4 = (lane & 3) * 4; const float* Ws = W + 2208 + 256 * m + ((n0 - 2304) >> 1) + c4;
#pragma unroll
            for (int i = 0; i < 8; ++i) v[i] = *(const f32x4*)(Ws + (size_t)(k0 + 8 * i + (lane >> 3)) * ldw);
#pragma unroll
            for (int i = 0; i < 8; ++i) { LAS float* d = scr + (8 * i + (lane >> 3)) * 33 + 2 * c4 + m; d[0] = v[i][0]; d[2] = v[i][1]; d[4] = v[i][2]; d[6] = v[i][3]; }
        } else {
            int src = n0; bool zero = false;
            if (n0 >= 1696 && n0 < 1728) { src = 5792 + (n0 - 1696); zero = (l == 0); } else if (n0 >= 1728 && n0 < 1792) zero = true; else if (n0 >= 1792) src = n0 - 96;
            const int c4 = (lane & 7) * 4; const float* Ws = W + (zero ? 0 : src) + c4;
#pragma unroll
            for (int i = 0; i < 8; ++i) { v[i] = *(const f32x4*)(Ws + (size_t)(k0 + 8 * i + (lane >> 3)) * ldw); if (zero) v[i] = (f32x4){0.f, 0.f, 0.f, 0.f}; }
#pragma unroll
            for (int i = 0; i < 8; ++i) { LAS float* d = scr + (8 * i + (lane >> 3)) * 33 + c4; d[0] = v[i][0]; d[1] = v[i][1]; d[2] = v[i][2]; d[3] = v[i][3]; }
        }
        moe_item_store<true>(WSP(unsigned char, WS_WIN) + (size_t)l * NIN * 1024, 1024, k0, n0, scr, lane); }
    constexpr int I_A = 8 * 32, I_B = 4 * 32;
    for (int it = gw; it < NL * (I_A + 2 * I_B); it += NGW) { const int l = it / (I_A + 2 * I_B); int r = it % (I_A + 2 * I_B);
        unsigned char* base = WSP(unsigned char, WS_WBR) + (size_t)l * (1024 * 1024);
        if (r < I_A) { fast_item_plain(P.in[17] + (size_t)l * 512 * 1024, 1024, 512, base, 32, scr, r, F.lane); continue; } r -= I_A;
        if (r < I_B) { fast_item_plain(P.in[22] + (size_t)l * 256 * 1024, 1024, 256, base + 1024 * 512, 32, scr, r, F.lane); continue; } r -= I_B;
        fast_item_plain(P.in[27] + (size_t)l * 256 * 1024, 1024, 256, base + 1024 * 512 + 1024 * 256, 32, scr, r, F.lane); }
    constexpr int I_O = 16 * 32;
    for (int it = gw; it < NL * I_O; it += NGW) { const int l = it / I_O, r = it % I_O;
        fast_item_plain(P.in[28] + (size_t)l * 1024 * 1024, 1024, 1024, WSP(unsigned char, WS_WOUT) + (size_t)l * 1024 * 1024, 32, scr, r, F.lane); }
    for (int it = gw; it < 16 * 8; it += NGW) transpose_item<false>(P.in[31], 32, 1024, WSP(bf16_t, WS_WRT), 8, scr, it, F.lane, CmRouter{});
}
__device__ __forceinline__ unsigned char* moe_wbuf(Frame& F, int l) { return (l & 1) ? (unsigned char*)F.out : F.ws + WS_WMOE; }
__device__ __forceinline__ void phase_convert_moe(Frame& F, const Params& P, int l) {
    LAS float* scr = (LAS float*)(F.lds + F.wave * 8448);
    const int gw = F.vcu * 8 + F.wave, NGW = F.G * 8; const int lane = F.lane;
    constexpr int I_GU = 16 * 32;
    constexpr int I_DN = 8 * 32;
    for (int it = gw; it < NE * I_GU; it += NGW) { const int e = it / I_GU, item = it % I_GU;
        const int kb = item / 32, nb = item % 32, k0 = 64 * kb, n0 = 32 * nb;
        const int m = (lane >> 2) & 1, c4 = (lane & 3) * 4;
        const float* Ws = ((m ? P.in[34] : P.in[33]) + ((size_t)l * NE + e) * 1024 * 512) + (n0 >> 1) + c4;
        f32x4 v[8];
#pragma unroll
        for (int i = 0; i < 8; ++i) v[i] = *(const f32x4*)(Ws + (size_t)(k0 + 8 * i + (lane >> 3)) * 512);
#pragma unroll
        for (int i = 0; i < 8; ++i) { LAS float* d = scr + (8 * i + (lane >> 3)) * 33 + 2 * c4 + m; d[0] = v[i][0]; d[2] = v[i][1]; d[4] = v[i][2]; d[6] = v[i][3]; }
        moe_item_store<true>(moe_wbuf(F, l) + (size_t)e * 1024 * 1024, 1024, k0, n0, scr, lane); }
    for (int it = gw; it < NE * I_DN; it += NGW) { const int e = it / I_DN, item = it % I_DN;
        const int kb = item / 32, nb = item % 32, k0 = 64 * kb, n0 = 32 * nb; const int c4 = (lane & 7) * 4;
        const float* Ws = P.in[35] + ((size_t)l * NE + e) * 512 * 1024 + n0 + c4;
        f32x4 v[8];
#pragma unroll
        for (int i = 0; i < 8; ++i) v[i] = *(const f32x4*)(Ws + (size_t)(k0 + 8 * i + (lane >> 3)) * 1024);
#pragma unroll
        for (int i = 0; i < 8; ++i) { LAS float* d = scr + (8 * i + (lane >> 3)) * 33 + c4; d[0] = v[i][0]; d[1] = v[i][1]; d[2] = v[i][2]; d[3] = v[i][3]; }
        moe_item_store<true>(moe_wbuf(F, l) + (size_t)NE * 1024 * 1024 + (size_t)e * 1024 * 512, 512, k0, n0, scr, lane); }
}
__device__ __forceinline__ void phase_convert_lora(Frame& F, const Params& P) {
    bf16_t* dst = WSP(bf16_t, WS_LORA);
    for (int idx = (int)blockIdx.x * 512 + F.tid; idx < 11 * 512 * 32 + 4 * 512 * 96; idx += F.G * 512) {
        float val;
        if (idx < 11 * 512 * 32) { const int m = idx / (512 * 32), rem = idx % (512 * 32), ch = rem / 32, i = rem % 32;
            if (m < 4) val = P.in[6][((size_t)m * 32 + i) * 512 + ch]; else if (m < 8) val = P.in[8][((size_t)(m - 4) * 32 + i) * 512 + ch]; else val = P.in[11][((size_t)(m - 8) * 32 + i) * 512 + ch]; }
        else { const int r2 = idx - 11 * 512 * 32, m = r2 / (512 * 96), rem = r2 % (512 * 96), ch = rem / 96, i = rem % 96; val = P.in[9][((size_t)m * 96 + i) * 512 + ch]; }
        dst[idx] = f2bf(val); }
}
__device__ __forceinline__ void phase_convert_sgu(Frame& F, const Params& P) {
    bf16_t* dst = WSP(bf16_t, WS_SGUW);
    for (int idx = (int)blockIdx.x * 512 + F.tid; idx < NL * 4 * 128 * 128; idx += F.G * 512) { const int p = (idx >> 7) & 127, qq = idx & 127; dst[idx] = f2bf(qq <= p ? P.in[20][idx] : 0.f); }
}
__device__ __forceinline__ void phase_convert_router(Frame& F, const Params& P) {
    bf16_t* dst = WSP(bf16_t, WS_WRG); float* rc = WSP(float, WS_RC);
    for (int idx = (int)blockIdx.x * 512 + F.tid; idx < NL * 256 * 1024; idx += F.G * 512) { const int l = idx >> 18, n = (idx >> 10) & 255, k = idx & 1023;
        dst[idx] = f2bf(n < 32 ? P.in[29][(size_t)l * 1024 + k] * P.in[31][(size_t)k * 32 + n] : 0.f); }
    const int gwv = (int)blockIdx.x * 8 + F.wave;
    if (gwv < NL * 32) { const int l = gwv >> 5, e = gwv & 31; float c1 = 0.f, c0 = 0.f;
#pragma unroll
        for (int j = 0; j < 16; ++j) { const int k = F.lane + 64 * j; const float w = P.in[31][(size_t)k * 32 + e]; c1 += P.in[29][(size_t)l * 1024 + k] * w; c0 += P.in[30][(size_t)l * 1024 + k] * w; }
        c1 = wave_sum(c1); c0 = wave_sum(c0);
        if (F.lane == 0) { rc[l * 64 + e] = c1; rc[l * 64 + 32 + e] = c0; } }
}
__device__ __forceinline__ void phase_x_to_bf16(Frame& F, const Params& P) {
    const size_t n8 = (size_t)T * D / 8; const float* x = P.in[0]; bf16_t* xb = WSP(bf16_t, WS_X); unsigned char* xq = WSP(unsigned char, WS_XQ);
    for (size_t i = (size_t)blockIdx.x * 512 + F.tid; i < n8; i += (size_t)F.G * 512) {
        const f32x4 a = *(const f32x4*)(x + i * 8), b = *(const f32x4*)(x + i * 8 + 4);
        u32x4 o; o.x = cvt_pk_bf16(a[0], a[1]); o.y = cvt_pk_bf16(a[2], a[3]); o.z = cvt_pk_bf16(b[0], b[1]); o.w = cvt_pk_bf16(b[2], b[3]);
        *(u32x4*)(xb + i * 8) = o;
        u32x2 qv; qv.x = pack_fp8x4(a[0], a[1], a[2], a[3]); qv.y = pack_fp8x4(b[0], b[1], b[2], b[3]); *(u32x2*)(xq + i * 8) = qv; }
}

struct SchedInproj { const char* X; const char* W; int G, c;
    __device__ __forceinline__ bool next(int i, ge::Unit& u) const { int pm, pn; if (!ge::static_tile((long)i * G + c, T / 256, NIN / 256, pm, pn)) return false;
        u.A = X + (size_t)pm * 256 * 1024; u.B = W + (size_t)pn * 256 * 1024; u.gat = nullptr; u.lda = 1024; u.ldb = 1024; u.nt = 8; u.gshift = 0; u.nvalid = 256; u.pm = pm; u.pn = pn; u.aux = 0; return true; } };
struct EpiInproj { static constexpr bool AFTER_DRAIN = false; bf16_t* rkv; bf16_t* sguz; bf16_t* convh; unsigned char* gates;
    typedef ge::NoPre Pre; __device__ __forceinline__ Pre prefetch(const ge::Unit&, int, int, int, int) const { return Pre{}; }
    __device__ __forceinline__ void operator()(const ge::Acc& acc, const ge::Unit& u, int wr, int wc, int fr, int fq, const Pre&) const {
        const int pn = u.pn; const int row0 = u.pm * 256 + wr * 64 + fr;
        int kind, ld, colt; bf16_t* base;
        if (pn < 7) { kind = 0; base = rkv; ld = RKVW; colt = pn * 256; }
        else if (pn < 9) { kind = 1; base = sguz; ld = 512; colt = (pn - 7) * 256; }
        else if (pn < 11) { kind = 2; base = convh; ld = 256; colt = (pn - 9) * 128; }
        else { kind = 3; base = rkv; ld = 3072; colt = (pn - 11) * 256; }
#pragma unroll
        for (int ai = 0; ai < 2; ++ai)
#pragma unroll
            for (int m = 0; m < 4; ++m) { const size_t r = (size_t)(row0 + ai * 128 + m * 16);
#pragma unroll
                for (int bj = 0; bj < 2; ++bj) { const int c = 128 * bj + 32 * wc + 8 * fq; f32x4 v0 = acc[ai][bj][m][0], v1 = acc[ai][bj][m][1];
                    if (kind == 2) {
                        const float h0 = v0[0] * sigmoidf_(v0[1]), h1 = v0[2] * sigmoidf_(v0[3]), h2 = v1[0] * sigmoidf_(v1[1]), h3 = v1[2] * sigmoidf_(v1[3]);
                        u32x2 w; w.x = cvt_pk_bf16(h0, h1); w.y = cvt_pk_bf16(h2, h3);
                        *(u32x2*)(base + r * ld + colt + (c >> 1)) = w;
                    } else if (kind == 3) {
                        u32x2 w; unsigned w0 = 0, w1 = 0;
                        w0 = __builtin_amdgcn_cvt_pk_u8_f32(255.f * sigmoidf_(v0[0]) + 0.5f, 0, w0); w0 = __builtin_amdgcn_cvt_pk_u8_f32(255.f * sigmoidf_(v0[1]) + 0.5f, 1, w0);
                        w0 = __builtin_amdgcn_cvt_pk_u8_f32(255.f * sigmoidf_(v0[2]) + 0.5f, 2, w0); w0 = __builtin_amdgcn_cvt_pk_u8_f32(255.f * sigmoidf_(v0[3]) + 0.5f, 3, w0);
                        w1 = __builtin_amdgcn_cvt_pk_u8_f32(255.f * sigmoidf_(v1[0]) + 0.5f, 0, w1); w1 = __builtin_amdgcn_cvt_pk_u8_f32(255.f * sigmoidf_(v1[1]) + 0.5f, 1, w1);
                        w1 = __builtin_amdgcn_cvt_pk_u8_f32(255.f * sigmoidf_(v1[2]) + 0.5f, 2, w1); w1 = __builtin_amdgcn_cvt_pk_u8_f32(255.f * sigmoidf_(v1[3]) + 0.5f, 3, w1);
                        w.x = w0; w.y = w1; *(u32x2*)(gates + r * 3072 + colt + c) = w;
                    } else {
                        if (kind == 1) {
#pragma unroll
                            for (int j = 0; j < 4; ++j) { v0[j] = gelu_f(v0[j]); v1[j] = gelu_f(v1[j]); } }
                        u32x4 w; w.x = cvt_pk_bf16(v0[0], v0[1]); w.y = cvt_pk_bf16(v0[2], v0[3]); w.z = cvt_pk_bf16(v1[0], v1[1]); w.w = cvt_pk_bf16(v1[2], v1[3]);
                        *(u32x4*)(base + r * ld + colt + c) = w; } } }
    } };
struct EpiNull { static constexpr bool AFTER_DRAIN = false; bf16_t* sink;
    typedef ge::NoPre Pre; __device__ __forceinline__ Pre prefetch(const ge::Unit&, int, int, int, int) const { return Pre{}; }
    __device__ __forceinline__ void operator()(const ge::Acc& acc, const ge::Unit& u, int wr, int wc, int fr, int fq, const Pre&) const {
        float t = 0.f;
#pragma unroll
        for (int ai = 0; ai < 2; ++ai)
#pragma unroll
            for (int bj = 0; bj < 2; ++bj)
#pragma unroll
                for (int m = 0; m < 4; ++m)
#pragma unroll
                    for (int n = 0; n < 2; ++n) t += acc[ai][bj][m][n][0];
        if (t == 123456.789f) sink[0] = f2bf(t); } };
struct SchedBranch { const char* ws; size_t woff; int G, v;
    __device__ __forceinline__ bool next(int i, ge::Unit& u) const { const int tile = (i / 3) * G + v, br = i % 3, pm = tile >> 2, pn = tile & 3; if (tile >= 512) return false;
        const unsigned kb = (br == 0) ? 512u : 256u;
        size_t ao = WS_OUTA, wo = woff; if (br == 1) { ao = WS_HB; wo += (size_t)1024 * 512; } if (br == 2) { ao = WS_HC; wo += (size_t)1024 * 512 + (size_t)1024 * 256; }
        u.A = ws + ao + (size_t)pm * 256 * kb; u.lda = kb; u.nt = (int)(kb >> 7); u.B = ws + wo + (size_t)pn * 256 * kb; u.ldb = kb;
        u.gat = nullptr; u.gshift = 0; u.nvalid = 256; u.pm = pm; u.pn = pn; u.aux = br; return true; } };
struct EpiBranch { static constexpr bool AFTER_DRAIN = false; const unsigned char* gates; bf16_t* merged; unsigned char* mq;
    typedef ge::NoPre Pre; __device__ __forceinline__ Pre prefetch(const ge::Unit&, int, int, int, int) const { return Pre{}; }
    __device__ __forceinline__ void operator()(const ge::Acc& acc, const ge::Unit& u, int wr, int wc, int fr, int fq, const Pre&) const {
        const int br = u.aux; const int row0 = u.pm * 256 + wr * 64 + fr;
#pragma unroll
        for (int ai = 0; ai < 2; ++ai) {
            u32x2 g[8]; u32x4 p[8];
#pragma unroll
            for (int m = 0; m < 4; ++m)
#pragma unroll
                for (int bj = 0; bj < 2; ++bj) { const size_t r = (size_t)(row0 + ai * 128 + m * 16); const int c = u.pn * 256 + 128 * bj + 32 * wc + 8 * fq;
                    g[m * 2 + bj] = *(const u32x2*)(gates + r * 3072 + br * 1024 + c);
                    p[m * 2 + bj] = (br > 0) ? *(const u32x4*)(merged + r * 1024 + c) : (u32x4){0u, 0u, 0u, 0u}; }
#pragma unroll
            for (int m = 0; m < 4; ++m)
#pragma unroll
                for (int bj = 0; bj < 2; ++bj) { const size_t r = (size_t)(row0 + ai * 128 + m * 16); const int c = u.pn * 256 + 128 * bj + 32 * wc + 8 * fq;
                    const f32x4 v0 = acc[ai][bj][m][0], v1 = acc[ai][bj][m][1]; const u32x2 gg = g[m * 2 + bj]; const u32x4 pp = p[m * 2 + bj];
                    const float k = 1.f / 255.f;
                    const float g0 = k * (float)(gg.x & 0xffu), g1 = k * (float)((gg.x >> 8) & 0xffu), g2 = k * (float)((gg.x >> 16) & 0xffu), g3 = k * (float)(gg.x >> 24);
                    const float g4 = k * (float)(gg.y & 0xffu), g5 = k * (float)((gg.y >> 8) & 0xffu), g6 = k * (float)((gg.y >> 16) & 0xffu), g7 = k * (float)(gg.y >> 24);
                    u32x4 w; w.x = cvt_pk_bf16(v0[0] * g0 + bflo(pp.x), v0[1] * g1 + bfhi(pp.x)); w.y = cvt_pk_bf16(v0[2] * g2 + bflo(pp.y), v0[3] * g3 + bfhi(pp.y));
                    w.z = cvt_pk_bf16(v1[0] * g4 + bflo(pp.z), v1[1] * g5 + bfhi(pp.z)); w.w = cvt_pk_bf16(v1[2] * g6 + bflo(pp.w), v1[3] * g7 + bfhi(pp.w));
                    if (br == 2) { u32x2 wq; wq.x = pack_fp8x4(4.f * (v0[0] * g0 + bflo(pp.x)), 4.f * (v0[1] * g1 + bfhi(pp.x)), 4.f * (v0[2] * g2 + bflo(pp.y)), 4.f * (v0[3] * g3 + bfhi(pp.y)));
                        wq.y = pack_fp8x4(4.f * (v1[0] * g4 + bflo(pp.z)), 4.f * (v1[1] * g5 + bfhi(pp.z)), 4.f * (v1[2] * g6 + bflo(pp.w)), 4.f * (v1[3] * g7 + bfhi(pp.w))); *(u32x2*)(mq + r * 1024 + c) = wq; }
                    else *(u32x4*)(merged + r * 1024 + c) = w; }
            asm volatile("" ::: "memory"); }
    } };
struct SchedWout { const char* A; const char* W; int G, v;
    __device__ __forceinline__ bool next(int i, ge::Unit& u) const { const int tile = i * G + v, pm = tile >> 2, pn = tile & 3; if (tile >= 512) return false;
        u.A = A + (size_t)pm * 256 * 1024; u.B = W + (size_t)pn * 256 * 1024; u.gat = nullptr; u.lda = 1024; u.ldb = 1024; u.nt = 8; u.gshift = 0; u.nvalid = 256; u.pm = pm; u.pn = pn; u.aux = 0; return true; } };
struct EpiWout { static constexpr bool AFTER_DRAIN = false; const bf16_t* x; bf16_t* pre; float* stats;
    typedef ge::NoPre Pre; __device__ __forceinline__ Pre prefetch(const ge::Unit&, int, int, int, int) const { return Pre{}; }
    __device__ __forceinline__ void operator()(const ge::Acc& acc, const ge::Unit& u, int wr, int wc, int fr, int fq, const Pre&) const {
        const int row0 = u.pm * 256 + wr * 64 + fr;
#pragma unroll
        for (int ai = 0; ai < 2; ++ai)
#pragma unroll
            for (int m = 0; m < 4; ++m) { const size_t r = (size_t)(row0 + ai * 128 + m * 16); float s1 = 0.f, s2 = 0.f;
#pragma unroll
                for (int bj = 0; bj < 2; ++bj) { const int c = u.pn * 256 + 128 * bj + 32 * wc + 8 * fq; const f32x4 v0 = acc[ai][bj][m][0], v1 = acc[ai][bj][m][1];
                    const u32x4 p = *(const u32x4*)(x + r * 1024 + c);
                    u32x4 w; w.x = cvt_pk_bf16(v0[0] + ALPHA * bflo(p.x), v0[1] + ALPHA * bfhi(p.x)); w.y = cvt_pk_bf16(v0[2] + ALPHA * bflo(p.y), v0[3] + ALPHA * bfhi(p.y));
                    w.z = cvt_pk_bf16(v1[0] + ALPHA * bflo(p.z), v1[1] + ALPHA * bfhi(p.z)); w.w = cvt_pk_bf16(v1[2] + ALPHA * bflo(p.w), v1[3] + ALPHA * bfhi(p.w));
                    *(u32x4*)(pre + r * 1024 + c) = w;
                    const float q0 = bflo(w.x), q1 = bfhi(w.x), q2 = bflo(w.y), q3 = bfhi(w.y), q4 = bflo(w.z), q5 = bfhi(w.z), q6 = bflo(w.w), q7 = bfhi(w.w);
                    s1 += ((q0 + q1) + (q2 + q3)) + ((q4 + q5) + (q6 + q7)); s2 += ((q0 * q0 + q1 * q1) + (q2 * q2 + q3 * q3)) + ((q4 * q4 + q5 * q5) + (q6 * q6 + q7 * q7)); }
                s1 += __shfl_xor(s1, 16); s2 += __shfl_xor(s2, 16); s1 += __shfl_xor(s1, 32); s2 += __shfl_xor(s2, 32);
                if (fq == 0) *(f32x2*)(stats + (r * 16 + u.pn * 4 + wc) * 2) = (f32x2){s1, s2};
                asm volatile("" ::: "memory"); }
    } };
struct SchedRouter { const char* A; const char* W; int G, v;
    __device__ __forceinline__ bool next(int i, ge::Unit& u) const { const int pm = i * G + v; if (pm >= 128) return false;
        u.A = A + (size_t)pm * 256 * 2048; u.B = W; u.gat = nullptr; u.lda = 2048; u.ldb = 2048; u.nt = 16; u.gshift = 0; u.nvalid = 256; u.pm = pm; u.pn = 0; u.aux = 0; return true; } };
struct EpiRouter { static constexpr bool AFTER_DRAIN = true; const float* rbias; unsigned* cnt; int* list; const float* stats; const float* rc;
    typedef ge::NoPre Pre; __device__ __forceinline__ Pre prefetch(const ge::Unit&, int, int, int, int) const { return Pre{}; }
    __device__ __forceinline__ void drained(const ge::Acc& acc, const ge::Unit& u, int wr, int wc, int fr, int fq, LAS unsigned char* lds) const {
        LAS int* lcnt = (LAS int*)lds; LAS int* lbase = lcnt + 32;
        const bool t32 = (wr == 0 && wc == 0 && fq < 2); const int t = fq * 16 + fr;
        if (t32) lcnt[t] = 0;
        __syncthreads();
        int e1[8], e2[8], r1[8], r2[8]; float g1[8], g2[8];
        const int row0 = u.pm * 256 + wr * 64 + fr;
        if (wc == 0) {
            float bias[8], c1v[8], c0v[8];
#pragma unroll
            for (int j = 0; j < 8; ++j) { bias[j] = rbias[8 * fq + j]; c1v[j] = rc[8 * fq + j]; c0v[j] = rc[32 + 8 * fq + j]; }
#pragma unroll
            for (int ai = 0; ai < 2; ++ai)
#pragma unroll
                for (int m = 0; m < 4; ++m) { const int i8 = ai * 4 + m;
                    const f32x4 v0 = acc[ai][0][m][0], v1 = acc[ai][0][m][1];
                    float mean, rstd;
                    {   const size_t r = (size_t)(row0 + ai * 128 + m * 16); const f32x4 a0 = *(const f32x4*)(stats + (r * 16 + 4 * fq) * 2), a1 = *(const f32x4*)(stats + (r * 16 + 4 * fq + 2) * 2);
                        float s1 = (a0[0] + a0[2]) + (a1[0] + a1[2]), s2 = (a0[1] + a0[3]) + (a1[1] + a1[3]);
                        s1 += __shfl_xor(s1, 16); s2 += __shfl_xor(s2, 16); s1 += __shfl_xor(s1, 32); s2 += __shfl_xor(s2, 32);
                        mean = s1 * (1.f / 1024.f); rstd = rsqrtf(fmaxf(s2 * (1.f / 1024.f) - mean * mean, 0.f) + LN_EPS); }
                    float s[8], sel[8];
#pragma unroll
                    for (int j = 0; j < 4; ++j) { s[j] = sigmoidf_(rstd * (v0[j] - mean * c1v[j]) + c0v[j]); s[4 + j] = sigmoidf_(rstd * (v1[j] - mean * c1v[4 + j]) + c0v[4 + j]); }
#pragma unroll
                    for (int j = 0; j < 8; ++j) sel[j] = s[j] + bias[j];
                    int i1 = 0; float m1 = sel[0];
#pragma unroll
                    for (int j = 1; j < 8; ++j) if (sel[j] > m1) { m1 = sel[j]; i1 = j; }
                    int i2 = (i1 == 0) ? 1 : 0; float m2 = (i1 == 0) ? sel[1] : sel[0];
#pragma unroll
                    for (int j = 0; j < 8; ++j) if (j != i1 && j != ((i1 == 0) ? 1 : 0) && sel[j] > m2) { m2 = sel[j]; i2 = j; }
                    float gs = m1 + m2; int gi = fq;
                    { const float os = __shfl_xor(gs, 16); const int oi = __shfl_xor(gi, 16); if (os > gs || (os == gs && oi < gi)) { gs = os; gi = oi; } }
                    { const float os = __shfl_xor(gs, 32); const int oi = __shfl_xor(gi, 32); if (os > gs || (os == gs && oi < gi)) { gs = os; gi = oi; } }
                    e1[i8] = -1; e2[i8] = -1; r1[i8] = 0; r2[i8] = 0; g1[i8] = 0.f; g2[i8] = 0.f;
                    if (gi == fq) {
                        float s1 = s[0], s2 = s[0];
#pragma unroll
                        for (int j = 0; j < 8; ++j) { s1 = (j == i1) ? s[j] : s1; s2 = (j == i2) ? s[j] : s2; }
                        const float inv = 1.0f / (s1 + s2);
                        e1[i8] = 8 * fq + i1; e2[i8] = 8 * fq + i2; g1[i8] = s1 * inv; g2[i8] = s2 * inv;
                        r1[i8] = __hip_atomic_fetch_add(lcnt + e1[i8], 1, __ATOMIC_RELAXED, __HIP_MEMORY_SCOPE_WORKGROUP);
                        r2[i8] = __hip_atomic_fetch_add(lcnt + e2[i8], 1, __ATOMIC_RELAXED, __HIP_MEMORY_SCOPE_WORKGROUP); } }
        }
        __syncthreads();
        if (t32) { const int c = lcnt[t]; lbase[t] = (c > 0) ? (int)atomicAdd(cnt + t, (unsigned)c) : 0; }
        __syncthreads();
        if (wc == 0) {
#pragma unroll
            for (int i8 = 0; i8 < 8; ++i8) if (e1[i8] >= 0) { const int r = row0 + (i8 >> 2) * 128 + (i8 & 3) * 16;
                u32x2 p1, p2; p1.x = (unsigned)(2 * r); p1.y = __float_as_uint(g1[i8]); p2.x = (unsigned)(2 * r + 1); p2.y = __float_as_uint(g2[i8]);
                *(u32x2*)(list + ((size_t)e1[i8] * T + lbase[e1[i8]] + r1[i8]) * 2) = p1; *(u32x2*)(list + ((size_t)e2[i8] * T + lbase[e2[i8]] + r2[i8]) * 2) = p2; } }
        __syncthreads();
    } };
__device__ __forceinline__ int build_tile_table(Frame& F, const unsigned* cnt) {
    volatile LAS int* tab = (volatile LAS int*)(F.lds + LDS_MISC + 64);
    __syncthreads();
    if (F.tid == 0) { int n = 0; for (int e = 0; e < NE; ++e) { const int c = (int)__hip_atomic_load(cnt + e, __ATOMIC_RELAXED, __HIP_MEMORY_SCOPE_AGENT); const int nt = (c + 255) >> 8; for (int j = 0; j < nt; ++j) tab[1 + n++] = (e << 16) | j; } tab[0] = n; }
    __syncthreads();
    return tab[0];
}
struct SchedMoe1 { const char* X1; const char* W; const int* list; const unsigned* cnt; LAS int* tab; int ntiles, G, v;
    __device__ __forceinline__ bool next(int i, ge::Unit& u) const { const int L = i * G + v, rt = L >> 2, pn = L & 3; if (rt >= ntiles) return false;
        const int ej = tab[1 + rt], e = ej >> 16, j = ej & 0xffff; const int c = (int)cnt[e];
        u.A = X1; u.gat = list + ((size_t)e * T + j * 256) * 2; u.gshift = 1; u.nvalid = (c - j * 256) < 256 ? (c - j * 256) : 256; u.lda = 1024; u.nt = 8;
        u.B = W + ((size_t)e * 1024 + (size_t)pn * 256) * 1024; u.ldb = 1024; u.pm = rt; u.pn = pn; u.aux = e; return true; } };
struct EpiMoe1 { static constexpr bool AFTER_DRAIN = false; unsigned char* H;
    typedef ge::NoPre Pre; __device__ __forceinline__ Pre prefetch(const ge::Unit&, int, int, int, int) const { return Pre{}; }
    __device__ __forceinline__ void operator()(const ge::Acc& acc, const ge::Unit& u, int wr, int wc, int fr, int fq, const Pre&) const {
        const int row0 = u.pm * 256 + wr * 64 + fr;
#pragma unroll
        for (int ai = 0; ai < 2; ++ai)
#pragma unroll
            for (int m = 0; m < 4; ++m) { const size_t r = (size_t)(row0 + ai * 128 + m * 16);
#pragma unroll
                for (int bj = 0; bj < 2; ++bj) { const int c = 128 * bj + 32 * wc + 8 * fq; const f32x4 v0 = acc[ai][bj][m][0], v1 = acc[ai][bj][m][1];
                    const float h0 = v0[0] * sigmoidf_(v0[0]) * v0[1], h1 = v0[2] * sigmoidf_(v0[2]) * v0[3], h2 = v1[0] * sigmoidf_(v1[0]) * v1[1], h3 = v1[2] * sigmoidf_(v1[2]) * v1[3];
                    *(unsigned*)(H + r * 512 + u.pn * 128 + (c >> 1)) = pack_fp8x4(h0, h1, h2, h3); }
                asm volatile("" ::: "memory"); }
    } };
struct SchedMoe2 { const char* H; const char* W; const int* list; const unsigned* cnt; LAS int* tab; int ntiles, G, v, ntk;
    __device__ __forceinline__ bool next(int i, ge::Unit& u) const { const int L = i * G + v, rt = L >> 2, pn = L & 3; if (rt >= ntiles) return false;
        const int ej = tab[1 + rt], e = ej >> 16, j = ej & 0xffff; const int c = (int)cnt[e];
        u.A = H + (size_t)rt * 256 * 512; u.gat = nullptr; u.gshift = 0; u.nvalid = (c - j * 256) < 256 ? (c - j * 256) : 256; u.lda = 512; u.nt = ntk;
        u.B = W + ((size_t)e * 1024 + (size_t)pn * 256) * 512; u.ldb = 512; u.pm = rt; u.pn = pn; u.aux = (e << 16) | j; return true; } };
template <int MODE> struct EpiMoe2T { static constexpr bool AFTER_DRAIN = false; const int* list; unsigned char* Y; int* inv;
    typedef ge::NoPre Pre; __device__ __forceinline__ Pre prefetch(const ge::Unit&, int, int, int, int) const { return Pre{}; }
    __device__ __forceinline__ void operator()(const ge::Acc& acc, const ge::Unit& u, int wr, int wc, int fr, int fq, const Pre&) const {
        const int e = u.aux >> 16, j = u.aux & 0xffff; const int* lst = list + ((size_t)e * T + j * 256) * 2;
        const unsigned row0 = (unsigned)u.pm * 256u + (unsigned)(wr * 64 + fr); const unsigned col0 = (unsigned)(u.pn * 256 + 32 * wc + 8 * fq);
        const bool invw = (u.pn == 0 && wc == 0 && fq == 0);
#pragma unroll
        for (int ai = 0; ai < 2; ++ai) {
            u32x2 sg[4];
#pragma unroll
            for (int m = 0; m < 4; ++m) { const int rr = ai * 128 + wr * 64 + m * 16 + fr; const u32x2 v = *(const u32x2*)(lst + 2 * (rr < u.nvalid ? rr : 0)); sg[m].x = (rr < u.nvalid) ? v.x : 0xffffffffu; sg[m].y = v.y; }
#pragma unroll
            for (int m = 0; m < 4; ++m) { const int sl = (int)sg[m].x; const float gg = __uint_as_float(sg[m].y);
                const unsigned yrow = row0 + (unsigned)(ai * 128 + m * 16);
                if (MODE == 1) { if (sl == 0x7ffffff0) Y[0] = (unsigned char)pack_fp8x4(acc[ai][0][m][0][0] * gg, 0.f, 0.f, 0.f); }
                else if (sl >= 0) {
                    if (invw) inv[sl] = (int)yrow;
#pragma unroll
                    for (int bj = 0; bj < 2; ++bj) { const f32x4 v0 = acc[ai][bj][m][0], v1 = acc[ai][bj][m][1];
                        const float g8 = 8.f * gg; u32x2 w; w.x = pack_fp8x4(g8 * v0[0], g8 * v0[1], g8 * v0[2], g8 * v0[3]); w.y = pack_fp8x4(g8 * v1[0], g8 * v1[1], g8 * v1[2], g8 * v1[3]);
                        *(u32x2*)(Y + (yrow * 1024u + col0 + 128u * bj)) = w; } } }
            asm volatile("" ::: "memory"); }
    } };
typedef EpiMoe2T<0> EpiMoe2;
typedef short bf16x4 __attribute__((ext_vector_type(4)));
#if DEBUG_MODE
#define DBGF(stage, val) do { const float v_ = (val); if (!(fabsf(v_) < 1e30f)) atomicOr((unsigned*)(F.ws + WS_CTL) + 12, 1u << (stage)); } while (0)
#else
#define DBGF(stage, val) do { } while (0)
#endif
#define MFMA16(a, b, c) __builtin_amdgcn_mfma_f32_16x16x16bf16_1k(a, b, c, 0, 0, 0)
#define MFMA32(a, b, c) __builtin_amdgcn_mfma_f32_16x16x32_bf16(a, b, c, 0, 0, 0)
__device__ __forceinline__ bf16x4 pack4(const f32x4 v) { u32x2 w; w.x = cvt_pk_bf16(v[0], v[1]); w.y = cvt_pk_bf16(v[2], v[3]); return __builtin_bit_cast(bf16x4, w); }
__device__ __forceinline__ f32x4 unpack4(const u32x2 w) { return (f32x4){bflo(w.x), bfhi(w.x), bflo(w.y), bfhi(w.y)}; }
constexpr int TP = 72;
constexpr int TILE_B = 64 * TP * 2;
constexpr int LA_ACT = 0;
constexpr int LA_AT = 13312, LA_RT = LA_AT + TILE_B, LA_BT = LA_RT + TILE_B, LA_KT = LA_BT + TILE_B;
constexpr int LA_BTT = LA_KT + TILE_B, LA_KTT = LA_BTT + TILE_B, LA_VT = LA_KTT + TILE_B;
constexpr int LA_AAB = LA_VT + TILE_B, LA_AAK = LA_AAB + TILE_B, LA_ARB = LA_AAK + TILE_B, LA_ARK = LA_ARB + TILE_B;
constexpr int LA_DIAG = LA_ARK + TILE_B;
constexpr int LA_TII = LA_DIAG + 4096;
constexpr int LA_SEG = LA_TII + 3072;
constexpr int LA_KSQ = LA_SEG + 4096;
constexpr int LA_RKP = LA_KSQ + 1024;
constexpr int LA_PC = LA_RKP + 1024;
static_assert(LA_PC + 256 <= LDS_STAGE, "pass A LDS map");

template <bool EONLY> __device__ __forceinline__ void phase_wkv_a(Frame& F, const Params& P, int l) {
    LAS unsigned char* lds = F.lds;
    const bf16_t* rkv = WSP(bf16_t, WS_RKV);
    const bf16_t* wupT = WSP(bf16_t, WS_LORA) + (size_t)l * 512 * 32;
    const bf16_t* aupT = WSP(bf16_t, WS_LORA) + (size_t)(4 + l) * 512 * 32;
    const bf16_t* vupT = WSP(bf16_t, WS_LORA) + (size_t)(8 + (l > 0 ? l - 1 : 0)) * 512 * 32;
    const float* mu = P.in[3] + (size_t)l * 1696; const float* muv = (l > 0) ? P.in[4] + (size_t)(l - 1) * 32 : nullptr;
    bf16_t* PHI = WSP(bf16_t, WS_PHI); bf16_t* PSI = WSP(bf16_t, WS_PSI); bf16_t* GT = WSP(bf16_t, WS_GT); bf16_t* Y0T = WSP(bf16_t, WS_Y0T); bf16_t* VT = WSP(bf16_t, WS_VT); bf16_t* VF = WSP(bf16_t, WS_VFIRST);
    float* RK = WSP(float, WS_RK);
    const int lane = F.lane, w = F.wave, cb = w & 3, th = w >> 2;
    for (int unit = blockIdx.x; unit < T / 64; unit += F.G) {
        const int t0 = unit * 64; const bool firstchunk = (t0 & (SEQ - 1)) == 0;
        __syncthreads();
        for (int idx = F.tid; idx < 64 * 96; idx += 512) { const int tok = idx / 96, qq = idx % 96; const int col = (qq < 64) ? 1536 + qq : 1536 + 96 + qq;
            const int t = t0 + tok;
            const bool hp = (tok > 0 || !firstchunk); const float p = bf2f(rkv[(size_t)t * RKVW + col]); const float ppl = bf2f(rkv[(size_t)(hp ? t - 1 : t) * RKVW + col]); const float pp = hp ? ppl : 0.f;
            const float m_ = (qq < 64) ? mu[1536 + qq] : ((l > 0) ? P.in[4][(size_t)(l > 0 ? l - 1 : 0) * 32 + qq - 64] : 0.f);
            float val = p + (pp - p) * m_; if (qq < 32) val = tanhf(val);
            *(LAS bf16_t*)(lds + LA_ACT + (tok * 104 + qq) * 2) = f2bf(val); }
        __syncthreads();
        for (int h = 0; h < 8; ++h) {
            int lz = lane; asm volatile("" : "+v"(lz)); const int c = lz & 15, q = lz >> 4;
            const int chid = unit * 8 + h; const int ch = 16 * cb + c, chg = h * 64 + ch;
            f32x4 zw[2], za[2], zv[2];
            {   const bf16x8 bw = *(const bf16x8*)(wupT + (size_t)chg * 32 + 8 * q), ba = *(const bf16x8*)(aupT + (size_t)chg * 32 + 8 * q), bv = *(const bf16x8*)(vupT + (size_t)chg * 32 + 8 * q);
#pragma unroll
                for (int ii = 0; ii < 2; ++ii) { const int i = 2 * th + ii; const LAS unsigned char* ar = lds + LA_ACT + ((16 * i + c) * 104 + 8 * q) * 2;
                    const bf16x8 a0 = *(const LAS bf16x8*)(ar), a1 = *(const LAS bf16x8*)(ar + 64), a2 = *(const LAS bf16x8*)(ar + 128);
                    const f32x4 z = {0.f, 0.f, 0.f, 0.f};
                    zw[ii] = MFMA32(a0, bw, z); za[ii] = MFMA32(a1, ba, z); zv[ii] = MFMA32(a2, bv, z); } }
            const float mu_r = mu[chg], mu_k = mu[512 + chg], mu_v = mu[1024 + chg];
            const float w0 = P.in[5][(size_t)l * 512 + chg], a0_ = P.in[7][(size_t)l * 512 + chg], v0_ = (l > 0) ? P.in[10][(size_t)(l - 1) * 512 + chg] : 0.f;
            const float k_k = P.in[12][(size_t)l * 512 + chg], k_a = P.in[13][(size_t)l * 512 + chg], r_k = P.in[14][(size_t)l * 512 + chg];
            float rr[2][4], kh[2][4], vv[2][4], lw[2][4], ic[2][4], kkr[2][4];
#pragma unroll
            for (int ii = 0; ii < 2; ++ii) { const int i = 2 * th + ii; const int tl0 = 16 * i + 4 * q;
                const bool hasprev = (tl0 > 0) || !firstchunk;
                const bf16_t* base = rkv + (size_t)(t0 + tl0) * RKVW + chg;
                const bf16_t* pbase = hasprev ? base - RKVW : base;
                const float lpr = bf2f(pbase[0]), lpk = bf2f(pbase[512]), lpv = bf2f(pbase[1024]);
                float pr = hasprev ? lpr : 0.f, pk = hasprev ? lpk : 0.f, pv = hasprev ? lpv : 0.f;
                f32x4 vf = {0.f, 0.f, 0.f, 0.f};
                if (l > 0) vf = unpack4(*(const u32x2*)(VF + ((size_t)chid * 64 + ch) * 64 + tl0));
                float lsum = 0.f;
#pragma unroll
                for (int r = 0; r < 4; ++r) { const float cr = bf2f(base[(size_t)r * RKVW]), ck = bf2f(base[(size_t)r * RKVW + 512]), cv = bf2f(base[(size_t)r * RKVW + 1024]);
                    const float r_ = cr + (pr - cr) * mu_r, k_ = ck + (pk - ck) * mu_k; float v_ = cv + (pv - cv) * mu_v; pr = cr; pk = ck; pv = cv;
                    const float lw_ = -0.6065306597126334f * sigmoidf_(w0 + zw[ii][r]); const float icl = sigmoidf_(a0_ + za[ii][r]);
                    if (l > 0) v_ = v_ + (vf[r] - v_) * sigmoidf_(v0_ + zv[ii][r]);
                    const float kk_ = k_ * k_k, kh_ = k_ * (1.0f + (icl - 1.0f) * k_a);
                    rr[ii][r] = r_; kh[ii][r] = kh_; vv[ii][r] = v_; lw[ii][r] = lw_; ic[ii][r] = icl; kkr[ii][r] = kk_; lsum += lw_;
                    const float s1 = row16_sum(kk_ * kk_), s2 = row16_sum(r_ * kh_ * r_k);
                    *(LAS float*)(lds + LA_KSQ + (cb * 64 + tl0 + r) * 4) = s1; *(LAS float*)(lds + LA_RKP + (cb * 64 + tl0 + r) * 4) = s2; }
                *(LAS float*)(lds + LA_SEG + (ch * 16 + i * 4 + q) * 4) = lsum; }
            __syncthreads();
            {   float seg[16];
#pragma unroll
                for (int j4 = 0; j4 < 4; ++j4) { const f32x4 s4 = *(const LAS f32x4*)(lds + LA_SEG + (ch * 16 + 4 * j4) * 4); seg[4 * j4] = s4[0]; seg[4 * j4 + 1] = s4[1]; seg[4 * j4 + 2] = s4[2]; seg[4 * j4 + 3] = s4[3]; }
                float tot = 0.f;
#pragma unroll
                for (int j = 0; j < 16; ++j) tot += seg[j];
                if (th == 0) *(LAS float*)(lds + LA_PC + ch * 4) = __expf(tot);
                float mine[8];
#pragma unroll
                for (int j = 0; j < 8; ++j) mine[j] = th ? seg[8 + j] : seg[j];
                const float firsthalf = th ? (((seg[0] + seg[1]) + (seg[2] + seg[3])) + ((seg[4] + seg[5]) + (seg[6] + seg[7]))) : 0.f;
#pragma unroll
                for (int ii = 0; ii < 2; ++ii) { const int i = 2 * th + ii; const int tl0 = 16 * i + 4 * q; const int sidx = i * 4 + q;
                    float cum = firsthalf + (ii ? ((mine[0] + mine[1]) + (mine[2] + mine[3])) : 0.f);
                    { const float s0 = mine[4 * ii], s1 = mine[4 * ii + 1], s2 = mine[4 * ii + 2]; cum += (q > 0 ? s0 : 0.f) + (q > 1 ? s1 : 0.f) + (q > 2 ? s2 : 0.f); }
                    f32x4 at, rt, bt, kt;
#pragma unroll
                    for (int r = 0; r < 4; ++r) { const int tl = tl0 + r;
                        const float ks = (*(const LAS float*)(lds + LA_KSQ + tl * 4) + *(const LAS float*)(lds + LA_KSQ + (64 + tl) * 4)) + (*(const LAS float*)(lds + LA_KSQ + (128 + tl) * 4) + *(const LAS float*)(lds + LA_KSQ + (192 + tl) * 4));
                        const float kk_ = kkr[ii][r] * __builtin_amdgcn_rsqf(fmaxf(ks, 1e-24f));
                        const float cumx = cum; cum += lw[ii][r];
                        const float ex = __expf(cumx), ei = __expf(cum), en = __expf(-cum);
                        at[r] = -kk_ * ex; rt[r] = rr[ii][r] * ei; bt[r] = kk_ * ic[ii][r] * en; kt[r] = kh[ii][r] * en;
#if DEBUG_MODE
                        { bf16_t* dd = (bf16_t*)F.out; const size_t oo = (size_t)(t0 + tl) * 512 + chg; dd[oo] = f2bf(__expf(lw[ii][r])); dd[(size_t)T * 512 + oo] = f2bf(kk_ * ic[ii][r]); dd[(size_t)2 * T * 512 + oo] = f2bf(-kk_); }
#endif
                        DBGF(1, lw[ii][r]); DBGF(1, cum); DBGF(2, at[r]); DBGF(2, rt[r]); DBGF(2, bt[r]); DBGF(2, kt[r]);
                        *(LAS bf16_t*)(lds + LA_AT + (tl * TP + ch) * 2) = f2bf(at[r]); *(LAS bf16_t*)(lds + LA_RT + (tl * TP + ch) * 2) = f2bf(rt[r]);
                        *(LAS bf16_t*)(lds + LA_BT + (tl * TP + ch) * 2) = f2bf(bt[r]); *(LAS bf16_t*)(lds + LA_KT + (tl * TP + ch) * 2) = f2bf(kt[r]);
                        if (cb == 0) { const float rk = (*(const LAS float*)(lds + LA_RKP + tl * 4) + *(const LAS float*)(lds + LA_RKP + (64 + tl) * 4)) + (*(const LAS float*)(lds + LA_RKP + (128 + tl) * 4) + *(const LAS float*)(lds + LA_RKP + (192 + tl) * 4));
                            if (c == 0) RK[(size_t)(t0 + tl) * 8 + h] = rk; } }
                    const f32x4 v4 = {vv[ii][0], vv[ii][1], vv[ii][2], vv[ii][3]};
                    *(LAS bf16x4*)(lds + LA_BTT + (ch * TP + tl0) * 2) = pack4(bt); *(LAS bf16x4*)(lds + LA_KTT + (ch * TP + tl0) * 2) = pack4(kt); *(LAS bf16x4*)(lds + LA_VT + (ch * TP + tl0) * 2) = pack4(v4);
                    *(bf16x4*)(VT + ((size_t)chid * 64 + ch) * 64 + tl0) = pack4(v4);
                    if (l == 0) *(bf16x4*)(VF + ((size_t)chid * 64 + ch) * 64 + tl0) = pack4(v4); } }
            __syncthreads();
            if (EONLY) continue;
            {   const bool isR = w >= 4; const int i = w & 3;
                const LAS unsigned char* brow = lds + (isR ? LA_RT : LA_AT) + ((16 * i + c) * TP + 8 * q) * 2;
                const bf16x8 bf0 = *(const LAS bf16x8*)(brow), bf1 = *(const LAS bf16x8*)(brow + 64);
                LAS unsigned char* ob = lds + (isR ? LA_ARB : LA_AAB); LAS unsigned char* ok = lds + (isR ? LA_ARK : LA_AAK);
                const int tloc = 16 * i + c;
#pragma unroll
                for (int j = 0; j < 4; ++j) { f32x4 db = {0.f, 0.f, 0.f, 0.f}, dk = {0.f, 0.f, 0.f, 0.f};
                    if (j <= i) { const LAS unsigned char* arb = lds + LA_BT + ((16 * j + c) * TP + 8 * q) * 2; const LAS unsigned char* ark = lds + LA_KT + ((16 * j + c) * TP + 8 * q) * 2;
                        db = MFMA32(*(const LAS bf16x8*)(arb), bf0, db); db = MFMA32(*(const LAS bf16x8*)(arb + 64), bf1, db);
                        dk = MFMA32(*(const LAS bf16x8*)(ark), bf0, dk); dk = MFMA32(*(const LAS bf16x8*)(ark + 64), bf1, dk);
                        if (j == i) {
#pragma unroll
                            for (int r = 0; r < 4; ++r) { const int s = 16 * j + 4 * q + r; const bool keep = isR ? (s <= tloc) : (s < tloc); db[r] = keep ? db[r] : 0.f; dk[r] = keep ? dk[r] : 0.f; }
                            if (!isR) *(LAS f32x4*)(lds + LA_DIAG + ((i * 16 + c) * 16 + 4 * q) * 4) = db; } }
                    DBGF(3, db[0] + db[1] + db[2] + db[3]); DBGF(3, dk[0] + dk[1] + dk[2] + dk[3]);
                    *(LAS bf16x4*)(ob + (tloc * TP + 16 * j + 4 * q) * 2) = pack4(db); *(LAS bf16x4*)(ok + (tloc * TP + 16 * j + 4 * q) * 2) = pack4(dk); } }
            __syncthreads();
            f32x4 X[4];
            if (w == 0) { const int blk = q, jc = c; float tc[16];
                f32x4 Lr[15][4];
#pragma unroll
                for (int t = 1; t < 16; ++t)
#pragma unroll
                    for (int s4 = 0; s4 < 4; ++s4) if (4 * s4 < t) Lr[t - 1][s4] = *(const LAS f32x4*)(lds + LA_DIAG + ((blk * 16 + t) * 16 + 4 * s4) * 4);
                __builtin_amdgcn_sched_barrier(0);
#pragma unroll
                for (int s = 0; s < 16; ++s) tc[s] = (s == jc) ? 1.f : 0.f;
#pragma unroll
                for (int t = 1; t < 16; ++t) { float val = 0.f;
#pragma unroll
                    for (int s4 = 0; s4 < 4; ++s4) if (4 * s4 < t) { const f32x4 L = Lr[t - 1][s4];
#pragma unroll
                        for (int e = 0; e < 4; ++e) if (4 * s4 + e < t) val += L[e] * tc[4 * s4 + e]; }
                    tc[t] += val; }
#pragma unroll
                for (int t = 0; t < 16; ++t) { DBGF(4, tc[t]); *(LAS bf16_t*)(lds + LA_TII + ((blk * 16 + t) * 24 + jc) * 2) = f2bf(tc[t]); } }
            if (w < 4) {
#pragma unroll
                for (int i = 0; i < 4; ++i)
#pragma unroll
                    for (int r = 0; r < 4; ++r) X[i][r] = bf2f(*(const LAS bf16_t*)(lds + LA_AT + ((16 * i + 4 * q + r) * TP + 16 * w + c) * 2));
            } else { const int vb = w - 4; const LAS unsigned char* vrow = lds + LA_VT + ((16 * vb + c) * TP + 8 * q) * 2;
                const bf16x8 v0 = *(const LAS bf16x8*)(vrow), v1 = *(const LAS bf16x8*)(vrow + 64);
#pragma unroll
                for (int i = 0; i < 4; ++i) { const LAS unsigned char* arow = lds + LA_AAK + ((16 * i + c) * TP + 8 * q) * 2; f32x4 d = {0.f, 0.f, 0.f, 0.f};
                    d = MFMA32(*(const LAS bf16x8*)(arow), v0, d); d = MFMA32(*(const LAS bf16x8*)(arow + 64), v1, d); X[i] = d; } }
            DBGF(5, (X[0][0] + X[1][1]) + (X[2][2] + X[3][3]));
            __syncthreads();
            bf16x4 Xb[4];
            {   bf16x4 Af[6], Tf[4];
#pragma unroll
                for (int i = 1; i < 4; ++i)
#pragma unroll
                    for (int j = 0; j < 3; ++j) if (j < i) Af[(i * (i - 1)) / 2 + j] = *(const LAS bf16x4*)(lds + LA_AAB + ((16 * i + c) * TP + 16 * j + 4 * q) * 2);
#pragma unroll
                for (int i = 0; i < 4; ++i) Tf[i] = *(const LAS bf16x4*)(lds + LA_TII + ((i * 16 + c) * 24 + 4 * q) * 2);
                __builtin_amdgcn_sched_barrier(0);
#pragma unroll
                for (int i = 0; i < 4; ++i) { f32x4 y = X[i];
#pragma unroll
                    for (int j = 0; j < 3; ++j) if (j < i) y = MFMA16(Af[(i * (i - 1)) / 2 + j], Xb[j], y);
                    const f32x4 z = {0.f, 0.f, 0.f, 0.f};
                    X[i] = MFMA16(Tf[i], pack4(y), z); Xb[i] = pack4(X[i]); } }
            DBGF(6, (X[0][0] + X[1][1]) + (X[2][2] + X[3][3]));
            if (w < 4) {
                {   bf16x4 Bf[16]; float pcv[4];
#pragma unroll
                    for (int kb = 0; kb < 4; ++kb) { pcv[kb] = *(const LAS float*)(lds + LA_PC + (16 * kb + c) * 4);
#pragma unroll
                        for (int j = 0; j < 4; ++j) Bf[kb * 4 + j] = *(const LAS bf16x4*)(lds + LA_BTT + ((16 * kb + c) * TP + 16 * j + 4 * q) * 2); }
                    __builtin_amdgcn_sched_barrier(0);
#pragma unroll
                    for (int kb = 0; kb < 4; ++kb) { f32x4 d = {0.f, 0.f, 0.f, 0.f};
#pragma unroll
                        for (int j = 0; j < 4; ++j) d = MFMA16(Xb[j], Bf[kb * 4 + j], d);
                        const int ko = 16 * kb + c; const float pc = pcv[kb];
#pragma unroll
                        for (int r = 0; r < 4; ++r) d[r] = pc * (d[r] + ((16 * w + 4 * q + r) == ko ? 1.f : 0.f));
                        DBGF(7, d[0] + d[1] + d[2] + d[3]);
                        *(bf16x4*)(PHI + ((size_t)chid * 64 + ko) * 64 + 16 * w + 4 * q) = pack4(d); } }
                {   bf16x4 Rf[16]; u32x2 Rt[4];
#pragma unroll
                    for (int tb = 0; tb < 4; ++tb) { Rt[tb] = *(const LAS u32x2*)(lds + LA_RT + ((16 * tb + c) * TP + 16 * w + 4 * q) * 2);
#pragma unroll
                        for (int j = 0; j < 4; ++j) Rf[tb * 4 + j] = *(const LAS bf16x4*)(lds + LA_ARB + ((16 * tb + c) * TP + 16 * j + 4 * q) * 2); }
                    __builtin_amdgcn_sched_barrier(0);
#pragma unroll
                    for (int tb = 0; tb < 4; ++tb) { f32x4 d = unpack4(Rt[tb]);
#pragma unroll
                        for (int j = 0; j < 4; ++j) d = MFMA16(Xb[j], Rf[tb * 4 + j], d);
                        *(bf16x4*)(PSI + ((size_t)chid * 64 + 16 * tb + c) * 64 + 16 * w + 4 * q) = pack4(d); } }
            } else { const int vb = w - 4;
                bf16x4 Vb[4];
#pragma unroll
                for (int j = 0; j < 4; ++j) Vb[j] = *(const LAS bf16x4*)(lds + LA_VT + ((16 * vb + c) * TP + 16 * j + 4 * q) * 2);
                {   bf16x4 Bf[16], Kf[16]; f32x4 pcv[4];
#pragma unroll
                    for (int kb = 0; kb < 4; ++kb) { pcv[kb] = *(const LAS f32x4*)(lds + LA_PC + (16 * kb + 4 * q) * 4);
#pragma unroll
                        for (int j = 0; j < 4; ++j) { Bf[kb * 4 + j] = *(const LAS bf16x4*)(lds + LA_BTT + ((16 * kb + c) * TP + 16 * j + 4 * q) * 2); Kf[kb * 4 + j] = *(const LAS bf16x4*)(lds + LA_KTT + ((16 * kb + c) * TP + 16 * j + 4 * q) * 2); } }
                    __builtin_amdgcn_sched_barrier(0);
#pragma unroll
                    for (int kb = 0; kb < 4; ++kb) { f32x4 d = {0.f, 0.f, 0.f, 0.f};
#pragma unroll
                        for (int j = 0; j < 4; ++j) { d = MFMA16(Bf[kb * 4 + j], Xb[j], d); d = MFMA16(Kf[kb * 4 + j], Vb[j], d); }
                        *(bf16x4*)(GT + ((size_t)chid * 64 + 16 * vb + c) * 64 + 16 * kb + 4 * q) = pack4(d * pcv[kb]); } }
                {   bf16x4 Rf[16], Kf[16];
#pragma unroll
                    for (int tb = 0; tb < 4; ++tb)
#pragma unroll
                        for (int j = 0; j < 4; ++j) { Rf[tb * 4 + j] = *(const LAS bf16x4*)(lds + LA_ARB + ((16 * tb + c) * TP + 16 * j + 4 * q) * 2); Kf[tb * 4 + j] = *(const LAS bf16x4*)(lds + LA_ARK + ((16 * tb + c) * TP + 16 * j + 4 * q) * 2); }
                    __builtin_amdgcn_sched_barrier(0);
#pragma unroll
                    for (int tb = 0; tb < 4; ++tb) { f32x4 d = {0.f, 0.f, 0.f, 0.f};
#pragma unroll
                        for (int j = 0; j < 4; ++j) { d = MFMA16(Rf[tb * 4 + j], Xb[j], d); d = MFMA16(Kf[tb * 4 + j], Vb[j], d); }
                        *(bf16x4*)(Y0T + ((size_t)chid * 64 + 16 * vb + c) * 64 + 16 * tb + 4 * q) = pack4(d); } } }
            __syncthreads();
        }
    }
}
__device__ __forceinline__ void phase_wkv_b(Frame& F, const Params& P) {
    const bf16_t* PHI = WSP(bf16_t, WS_PHI); const bf16_t* GT = WSP(bf16_t, WS_GT); bf16_t* MT = WSP(bf16_t, WS_MT);
    LAS unsigned char* lds = F.lds;
    const int lane = F.lane, c = lane & 15, q = lane >> 4, w = F.wave, tid = F.tid;
    const int pair = w >> 2, vb = w & 3; const int bh = (int)blockIdx.x * 2 + pair, b = bh >> 3, h = bh & 7;
    const int lrow = tid >> 3, lcol = (tid & 7) * 16;
    f32x4 M[4];
#pragma unroll
    for (int i = 0; i < 4; ++i) M[i] = (f32x4){0.f, 0.f, 0.f, 0.f};
    u32x4 rA[4], rB[4];
#define WKVB_LD(r_, ckk) do { const int ck_ = (ckk) < 32 ? (ckk) : 31; _Pragma("unroll") for (int ti = 0; ti < 4; ++ti) { const int bh_ = (int)blockIdx.x * 2 + (ti >> 1); \
        const size_t chl_ = (size_t)((bh_ >> 3) * 32 + ck_) * 8 + (bh_ & 7); r_[ti] = *(const u32x4*)(((ti & 1) ? GT : PHI) + chl_ * 4096 + (size_t)tid * 8); } } while (0)
#define WKVB_ST(r_, buf) do { _Pragma("unroll") for (int ti = 0; ti < 4; ++ti) *(LAS u32x4*)(lds + ((buf) * 4 + ti) * TILE_B + lrow * (TP * 2) + lcol) = r_[ti]; } while (0)
#define WKVB_STEP(buf, ckk) do { const size_t chs_ = (size_t)(b * 32 + (ckk)) * 8 + h; bf16x4 Mb[4]; \
        const LAS unsigned char* tp_ = lds + ((buf) * 4 + pair * 2) * TILE_B; const LAS unsigned char* tg_ = tp_ + TILE_B; \
        _Pragma("unroll") for (int i = 0; i < 4; ++i) { Mb[i] = pack4(M[i]); *(bf16x4*)(MT + (chs_ * 64 + 16 * vb + c) * 64 + 16 * i + 4 * q) = Mb[i]; } \
        _Pragma("unroll") for (int i = 0; i < 4; ++i) { f32x4 d = unpack4(*(const LAS u32x2*)(tg_ + (16 * vb + c) * (TP * 2) + (16 * i + 4 * q) * 2)); \
            _Pragma("unroll") for (int j = 0; j < 4; ++j) d = MFMA16(*(const LAS bf16x4*)(tp_ + (16 * i + c) * (TP * 2) + (16 * j + 4 * q) * 2), Mb[j], d); M[i] = d; } } while (0)
    WKVB_LD(rA, 0); WKVB_LD(rB, 1);
    __syncthreads();
    for (int ck = 0; ck < 32; ck += 2) {
        WKVB_ST(rA, 0); __syncthreads(); WKVB_LD(rA, ck + 2); WKVB_STEP(0, ck);
        WKVB_ST(rB, 1); __syncthreads(); WKVB_LD(rB, ck + 3); WKVB_STEP(1, ck + 1);
    }
    __syncthreads();
#undef WKVB_LD
#undef WKVB_ST
#undef WKVB_STEP
}
constexpr int LC_SGL = 0;
constexpr int LC_OT = 13312;
__device__ __forceinline__ void phase_wkv_c(Frame& F, const Params& P, int l) {
    LAS unsigned char* lds = F.lds;
    const bf16_t* rkv = WSP(bf16_t, WS_RKV);
    const bf16_t* gupT = WSP(bf16_t, WS_LORA) + (size_t)11 * 512 * 32 + (size_t)l * 512 * 96;
    const bf16_t* PSI = WSP(bf16_t, WS_PSI); const bf16_t* Y0T = WSP(bf16_t, WS_Y0T); const bf16_t* VT = WSP(bf16_t, WS_VT); const bf16_t* MT = WSP(bf16_t, WS_MT);
    const float* RK = WSP(float, WS_RK); unsigned char* outa = WSP(unsigned char, WS_OUTA);
    const float* mu = P.in[3] + (size_t)l * 1696;
    const int lane = F.lane, h = F.wave;
    LAS unsigned char* ot = lds + LC_OT + h * TILE_B;
    for (int unit = blockIdx.x; unit < T / 64; unit += F.G) {
        int lz = lane; asm volatile("" : "+v"(lz)); const int c = lz & 15, q = lz >> 4;
        float gng[4], gnb[4];
#pragma unroll
        for (int vb = 0; vb < 4; ++vb) { gng[vb] = P.in[15][(size_t)l * 512 + h * 64 + 16 * vb + c]; gnb[vb] = P.in[16][(size_t)l * 512 + h * 64 + 16 * vb + c]; }
        const int t0 = unit * 64; const bool firstchunk = (t0 & (SEQ - 1)) == 0; const size_t chid = (size_t)unit * 8 + h;
        __syncthreads();
        for (int idx = F.tid; idx < 64 * 96; idx += 512) { const int tok = idx / 96, qq = idx % 96; const int col = 1536 + 64 + qq; const int t = t0 + tok;
            const bool hp = (tok > 0 || !firstchunk); const float p = bf2f(rkv[(size_t)t * RKVW + col]); const float ppl = bf2f(rkv[(size_t)(hp ? t - 1 : t) * RKVW + col]); const float pp = hp ? ppl : 0.f;
            *(LAS bf16_t*)(lds + LC_SGL + (tok * 104 + qq) * 2) = f2bf(sigmoidf_(p + (pp - p) * mu[1536 + 64 + qq])); }
        __syncthreads();
        float rkv_[16];
#pragma unroll
        for (int i = 0; i < 16; ++i) rkv_[i] = RK[(size_t)(t0 + 16 * (i >> 2) + 4 * q + (i & 3)) * 8 + h];
        bf16x4 Mf[16];
#pragma unroll
        for (int j = 0; j < 4; ++j)
#pragma unroll
            for (int vb = 0; vb < 4; ++vb) Mf[j * 4 + vb] = *(const bf16x4*)(MT + (chid * 64 + 16 * vb + c) * 64 + 16 * j + 4 * q);
        bf16x8 Gf[12];
#pragma unroll
        for (int vb = 0; vb < 4; ++vb)
#pragma unroll
            for (int ks = 0; ks < 3; ++ks) Gf[vb * 3 + ks] = *(const bf16x8*)(gupT + (size_t)(h * 64 + 16 * vb + c) * 96 + 32 * ks + 8 * q);
#pragma unroll
        for (int tb = 0; tb < 4; ++tb) {
            bf16x4 Pf[4];
#pragma unroll
            for (int j = 0; j < 4; ++j) Pf[j] = *(const bf16x4*)(PSI + (chid * 64 + 16 * tb + c) * 64 + 16 * j + 4 * q);
            f32x4 y[4], gt[4], vv[4];
#pragma unroll
            for (int vb = 0; vb < 4; ++vb) { y[vb] = unpack4(*(const u32x2*)(Y0T + (chid * 64 + 16 * vb + c) * 64 + 16 * tb + 4 * q)); vv[vb] = unpack4(*(const u32x2*)(VT + (chid * 64 + 16 * vb + c) * 64 + 16 * tb + 4 * q));
#pragma unroll
                for (int j = 0; j < 4; ++j) y[vb] = MFMA16(Pf[j], Mf[j * 4 + vb], y[vb]); }
            {   const LAS unsigned char* ar = lds + LC_SGL + ((16 * tb + c) * 104 + 8 * q) * 2;
                const bf16x8 a0 = *(const LAS bf16x8*)(ar), a1 = *(const LAS bf16x8*)(ar + 64), a2 = *(const LAS bf16x8*)(ar + 128);
#pragma unroll
                for (int vb = 0; vb < 4; ++vb) { f32x4 d = {0.f, 0.f, 0.f, 0.f}; d = MFMA32(a0, Gf[vb * 3], d); d = MFMA32(a1, Gf[vb * 3 + 1], d); d = MFMA32(a2, Gf[vb * 3 + 2], d); gt[vb] = d; } }
#pragma unroll
            for (int r = 0; r < 4; ++r) { const int tl = 16 * tb + 4 * q + r;
#if DEBUG_MODE
                { bf16_t* yd = WSP(bf16_t, DBG_YDBG) + (size_t)(t0 + tl) * 512 + h * 64; yd[c] = f2bf(y[0][r]); yd[16 + c] = f2bf(y[1][r]); yd[32 + c] = f2bf(y[2][r]); yd[48 + c] = f2bf(y[3][r]); }
#endif
                const float s = row16_sum((y[0][r] + y[1][r]) + (y[2][r] + y[3][r])); const float mean = s * (1.f / 64.f);
                const float d0 = y[0][r] - mean, d1 = y[1][r] - mean, d2 = y[2][r] - mean, d3 = y[3][r] - mean;
                const float var = row16_sum((d0 * d0 + d1 * d1) + (d2 * d2 + d3 * d3)) * (1.f / 64.f); const float rstd = rsqrtf(var + GN_EPS);
                const float rk = rkv_[tb * 4 + r];
                const float o0 = (d0 * rstd * gng[0] + gnb[0] + rk * vv[0][r]) * gt[0][r], o1 = (d1 * rstd * gng[1] + gnb[1] + rk * vv[1][r]) * gt[1][r];
                const float o2 = (d2 * rstd * gng[2] + gnb[2] + rk * vv[2][r]) * gt[2][r], o3 = (d3 * rstd * gng[3] + gnb[3] + rk * vv[3][r]) * gt[3][r];
                const unsigned pq = pack_fp8x4(4.f * o0, 4.f * o1, 4.f * o2, 4.f * o3);
                *(LAS unsigned char*)(ot + tl * 80 + c) = (unsigned char)pq; *(LAS unsigned char*)(ot + tl * 80 + 16 + c) = (unsigned char)(pq >> 8);
                *(LAS unsigned char*)(ot + tl * 80 + 32 + c) = (unsigned char)(pq >> 16); *(LAS unsigned char*)(ot + tl * 80 + 48 + c) = (unsigned char)(pq >> 24); }
        }
        asm volatile("s_waitcnt lgkmcnt(0)" ::: "memory");
        {   const LAS unsigned char* rowp = ot + lane * 80; unsigned char* dst = outa + (size_t)(t0 + lane) * 512 + h * 64;
#pragma unroll
            for (int m4 = 0; m4 < 4; ++m4) *(u32x4*)(dst + 16 * m4) = *(const LAS u32x4*)(rowp + 16 * m4); }
    }
    __syncthreads();
}
#if DEBUG_MODE
__device__ __forceinline__ void dbg_prep(Frame& F, const Params& P, int l) {
    LAS float* lora = (LAS float*)F.lds;
    const bf16_t* rkv = WSP(bf16_t, WS_RKV);
    const int c = F.tid;
    const float* mu = P.in[3] + (size_t)l * 1696; const float* muv = (l > 0) ? P.in[4] + (size_t)(l - 1) * 32 : nullptr;
    bf16_t* sv = WSP(bf16_t, WS_SV); bf16_t* sa = WSP(bf16_t, WS_SA); bf16_t* sb = WSP(bf16_t, WS_SB); bf16_t* sr = WSP(bf16_t, WS_SR); bf16_t* sk = WSP(bf16_t, WS_SK); bf16_t* sg = WSP(bf16_t, WS_SG);
    float* sw = WSP(float, WS_SW); float* rkb = WSP(float, DBG_RKREF); bf16_t* vfirst = WSP(bf16_t, WS_VFIRST);
    for (int grp = blockIdx.x; grp < T / 64; grp += F.G) {
        const int t0 = grp * 64;
        __syncthreads();
        for (int idx = F.tid; idx < 64 * 192; idx += 512) { const int tok = idx / 192, q = idx % 192; const int t = t0 + tok;
            const float p = bf2f(rkv[(size_t)t * RKVW + 1536 + q]); const float pp = ((t & (SEQ - 1)) != 0) ? bf2f(rkv[(size_t)(t - 1) * RKVW + 1536 + q]) : 0.f;
            const float m_ = (q < 160) ? mu[1536 + q] : (muv ? muv[q - 160] : 0.f);
            float val = p + (pp - p) * m_;
            if (q < 32) val = tanhf(val); else if (q >= 64 && q < 160) val = sigmoidf_(val);
            lora[tok * 192 + q] = val; }
        __syncthreads();
        {
            unsigned cc = c; asm volatile("" : "+v"(cc));
            float col[32]; const float w0 = P.in[5][(size_t)l * 512 + c];
#pragma unroll
            for (int i = 0; i < 32; ++i) col[i] = (P.in[6] + (size_t)l * 32 * 512)[(unsigned)(i * 512) + cc];
            for (int tok = 0; tok < 64; ++tok) { const LAS float* lr = lora + tok * 192; float z = w0;
#pragma unroll
                for (int i = 0; i < 32; ++i) z += lr[i] * col[i];
                sw[(size_t)(t0 + tok) * 512 + c] = __expf(-0.6065306597126334f * sigmoidf_(z)); }
            asm volatile("" ::: "memory"); }
        {
            unsigned cc = c; asm volatile("" : "+v"(cc));
            float col[32]; const float a0 = P.in[7][(size_t)l * 512 + c];
            const float mu_r = mu[c], mu_k = mu[512 + c];
            const float k_k = P.in[12][(size_t)l * 512 + c], k_a = P.in[13][(size_t)l * 512 + c], r_k = P.in[14][(size_t)l * 512 + c];
#pragma unroll
            for (int i = 0; i < 32; ++i) col[i] = (P.in[8] + (size_t)l * 32 * 512)[(unsigned)(i * 512) + cc];
            for (int tok = 0; tok < 64; ++tok) { const int t = t0 + tok; const bool first = (t & (SEQ - 1)) == 0;
                const size_t ro = (size_t)t * RKVW, rp = (size_t)(t - 1) * RKVW;
                const float pr = bf2f(rkv[ro + c]), pk = bf2f(rkv[ro + 512 + c]);
                const float qr = first ? 0.f : bf2f(rkv[rp + c]), qk = first ? 0.f : bf2f(rkv[rp + 512 + c]);
                const float r = pr + (qr - pr) * mu_r, k = pk + (qk - pk) * mu_k;
                const LAS float* lr = lora + tok * 192 + 32; float z = a0;
#pragma unroll
                for (int i = 0; i < 32; ++i) z += lr[i] * col[i];
                const float iclr = sigmoidf_(z);
                float kk = k * k_k; const float ss = wave_sum(kk * kk); kk = kk / fmaxf(sqrtf(ss), 1e-12f);
                const float kh = k * (1.0f + (iclr - 1.0f) * k_a);
                const float rks = wave_sum(r * kh * r_k);
                const size_t o = (size_t)t * 512 + c;
                sr[o] = f2bf(r); sk[o] = f2bf(kh); sa[o] = f2bf(-kk); sb[o] = f2bf(kk * iclr);
                if (F.lane == 0) rkb[(size_t)t * 8 + F.wave] = rks; }
            asm volatile("" ::: "memory"); }
        {
            unsigned cc = c; asm volatile("" : "+v"(cc));
            float col[32]; const float v0 = (l > 0) ? P.in[10][(size_t)(l - 1) * 512 + c] : 0.f; const float mu_v = mu[1024 + c];
#pragma unroll
            for (int i = 0; i < 32; ++i) col[i] = (l > 0) ? (P.in[11] + (size_t)(l - 1) * 32 * 512)[(unsigned)(i * 512) + cc] : 0.f;
            for (int tok = 0; tok < 64; ++tok) { const int t = t0 + tok; const bool first = (t & (SEQ - 1)) == 0;
                const float pv = bf2f(rkv[(size_t)t * RKVW + 1024 + c]); const float qv = first ? 0.f : bf2f(rkv[(size_t)(t - 1) * RKVW + 1024 + c]);
                float v = pv + (qv - pv) * mu_v;
                const size_t o = (size_t)t * 512 + c;
                if (l == 0) vfirst[o] = f2bf(v);
                else { const LAS float* lr = lora + tok * 192 + 160; float z = v0;
#pragma unroll
                    for (int i = 0; i < 32; ++i) z += lr[i] * col[i];
                    v = v + (bf2f(vfirst[o]) - v) * sigmoidf_(z); }
                sv[o] = f2bf(v); }
            asm volatile("" ::: "memory"); }
        {
            unsigned cc = c; asm volatile("" : "+v"(cc));
            float col[96];
#pragma unroll
            for (int i = 0; i < 96; ++i) col[i] = (P.in[9] + (size_t)l * 96 * 512)[(unsigned)(i * 512) + cc];
            for (int tok = 0; tok < 64; ++tok) { const LAS float* lr = lora + tok * 192 + 64; float g = 0.f;
#pragma unroll
                for (int i = 0; i < 96; ++i) g += lr[i] * col[i];
                sg[(size_t)(t0 + tok) * 512 + c] = f2bf(g); }
            asm volatile("" ::: "memory"); }
    }
    __syncthreads();
}
__device__ __forceinline__ void dbg_scan(Frame& F, const Params& P, int l, int wg0, int nwg) {
    constexpr int CH = 32;
    LAS float* buf = (LAS float*)F.lds;
    LAS float* ybuf = (LAS float*)(F.lds + 2 * 6 * CH * 64 * 4);
    const bf16_t* sv = WSP(bf16_t, WS_SV); const bf16_t* sa = WSP(bf16_t, WS_SA); const bf16_t* sb = WSP(bf16_t, WS_SB); const bf16_t* sr = WSP(bf16_t, WS_SR); const bf16_t* sk = WSP(bf16_t, WS_SK); const bf16_t* sg = WSP(bf16_t, WS_SG);
    const float* sw = WSP(float, WS_SW); const float* rkb = WSP(float, DBG_RKREF); bf16_t* outa = WSP(bf16_t, DBG_OUTAREF);
    const float* gn_g = P.in[15] + (size_t)l * 512; const float* gn_b = P.in[16] + (size_t)l * 512;
    int bh0 = __builtin_amdgcn_readfirstlane((int)blockIdx.x - wg0);
    for (int bh = bh0; bh < 128; bh += nwg) {
        const int b = bh >> 3, h = bh & 7; const size_t tb = (size_t)b * SEQ;
        const int ltok = F.tid >> 4, lch = (F.tid & 15) * 4;
        float S[8];
#pragma unroll
        for (int j = 0; j < 8; ++j) S[j] = 0.f;
        const int i8 = F.lane >> 3, seg = F.lane & 7, vrow = 8 * F.wave + i8;
        u32x2 pre_b[5]; f32x4 pre_w;
        __syncthreads();
        {   const size_t o = (tb + ltok) * 512 + h * 64 + lch;
            pre_b[0] = *(const u32x2*)(sr + o); pre_b[1] = *(const u32x2*)(sk + o); pre_b[2] = *(const u32x2*)(sv + o); pre_b[3] = *(const u32x2*)(sa + o); pre_b[4] = *(const u32x2*)(sb + o); pre_w = *(const f32x4*)(sw + o);
            LAS float* d = buf + ltok * 64 + lch;
#pragma unroll
            for (int a = 0; a < 5; ++a) { *(LAS f32x4*)(d + a * CH * 64) = (f32x4){bflo(pre_b[a].x), bfhi(pre_b[a].x), bflo(pre_b[a].y), bfhi(pre_b[a].y)}; }
            *(LAS f32x4*)(d + 5 * CH * 64) = pre_w; }
        __syncthreads();
        for (int ck = 0; ck < SEQ / CH; ++ck) {
            const int cur = ck & 1; const LAS float* cb = buf + cur * 6 * CH * 64;
            if (ck + 1 < SEQ / CH) { const size_t o = (tb + (ck + 1) * CH + ltok) * 512 + h * 64 + lch;
                pre_b[0] = *(const u32x2*)(sr + o); pre_b[1] = *(const u32x2*)(sk + o); pre_b[2] = *(const u32x2*)(sv + o); pre_b[3] = *(const u32x2*)(sa + o); pre_b[4] = *(const u32x2*)(sb + o); pre_w = *(const f32x4*)(sw + o); }
            if ((ck & 1) == 0) { float* mr = WSP(float, DBG_MREF) + ((size_t)((b * 32 + (ck >> 1)) * 8 + h)) * 4096;
#pragma unroll
                for (int j = 0; j < 8; ++j) mr[(size_t)(8 * seg + j) * 64 + vrow] = S[j]; }
            for (int tok = 0; tok < CH; ++tok) {
                const LAS float* p = cb + tok * 64 + seg * 8;
                const f32x4 r0 = *(const LAS f32x4*)(p), r1 = *(const LAS f32x4*)(p + 4);
                const f32x4 k0 = *(const LAS f32x4*)(p + CH * 64), k1 = *(const LAS f32x4*)(p + CH * 64 + 4);
                const float vv = cb[2 * CH * 64 + tok * 64 + vrow];
                const f32x4 a0 = *(const LAS f32x4*)(p + 3 * CH * 64), a1 = *(const LAS f32x4*)(p + 3 * CH * 64 + 4);
                const f32x4 b0 = *(const LAS f32x4*)(p + 4 * CH * 64), b1 = *(const LAS f32x4*)(p + 4 * CH * 64 + 4);
                const f32x4 w0 = *(const LAS f32x4*)(p + 5 * CH * 64), w1 = *(const LAS f32x4*)(p + 5 * CH * 64 + 4);
                float sa_ = 0.f;
#pragma unroll
                for (int j = 0; j < 4; ++j) { sa_ += S[j] * a0[j]; sa_ += S[4 + j] * a1[j]; }
                sa_ = reduce8(sa_);
                float y = 0.f;
#pragma unroll
                for (int j = 0; j < 4; ++j) { S[j] = S[j] * w0[j] + (sa_ * b0[j] + vv * k0[j]); S[4 + j] = S[4 + j] * w1[j] + (sa_ * b1[j] + vv * k1[j]); y += S[j] * r0[j]; y += S[4 + j] * r1[j]; }
                y = reduce8(y);
                if (seg == 0) ybuf[tok * 64 + vrow] = y;
            }
            __syncthreads();
            {
                const int tok = F.tid >> 4, vq = (F.tid & 15) * 4; const size_t t = tb + (size_t)ck * CH + tok;
                const f32x4 yv = *(const LAS f32x4*)(ybuf + tok * 64 + vq);
                { u32x2 wy; wy.x = cvt_pk_bf16(yv[0], yv[1]); wy.y = cvt_pk_bf16(yv[2], yv[3]); *(u32x2*)(WSP(bf16_t, DBG_YREF) + t * 512 + h * 64 + vq) = wy; }
                float s = (yv[0] + yv[1]) + (yv[2] + yv[3]);
                s += __shfl_xor(s, 1); s += __shfl_xor(s, 2); s += __shfl_xor(s, 4); s += __shfl_xor(s, 8);
                const float mean = s * (1.f / 64.f);
                const f32x4 dv = yv - mean; float q = (dv[0] * dv[0] + dv[1] * dv[1]) + (dv[2] * dv[2] + dv[3] * dv[3]);
                q += __shfl_xor(q, 1); q += __shfl_xor(q, 2); q += __shfl_xor(q, 4); q += __shfl_xor(q, 8);
                const float rstd = rsqrtf(q * (1.f / 64.f) + GN_EPS);
                const float rk = rkb[t * 8 + h];
                const f32x4 vv = *(const LAS f32x4*)(cb + 2 * CH * 64 + tok * 64 + vq);
                const f32x4 gg = *(const f32x4*)(gn_g + h * 64 + vq), gb = *(const f32x4*)(gn_b + h * 64 + vq);
                const u32x2 gt = *(const u32x2*)(sg + t * 512 + h * 64 + vq);
                float o[4]; const float gtf[4] = {bflo(gt.x), bfhi(gt.x), bflo(gt.y), bfhi(gt.y)};
#pragma unroll
                for (int j = 0; j < 4; ++j) o[j] = (dv[j] * rstd * gg[j] + gb[j] + rk * vv[j]) * gtf[j];
                u32x2 w; w.x = cvt_pk_bf16(o[0], o[1]); w.y = cvt_pk_bf16(o[2], o[3]);
                *(u32x2*)(outa + t * 512 + h * 64 + vq) = w; }
            if (ck + 1 < SEQ / CH) { LAS float* d = buf + (cur ^ 1) * 6 * CH * 64 + ltok * 64 + lch;
#pragma unroll
                for (int a = 0; a < 5; ++a) { *(LAS f32x4*)(d + a * CH * 64) = (f32x4){bflo(pre_b[a].x), bfhi(pre_b[a].x), bflo(pre_b[a].y), bfhi(pre_b[a].y)}; }
                *(LAS f32x4*)(d + 5 * CH * 64) = pre_w; }
            __syncthreads();
        }
    }
}

template <class TA, class TB> __device__ __forceinline__ void dbg_compare(Frame& F, const TA* a, const TB* b, size_t n, unsigned* ctl, int mode_transpose64) {
    float num = 0.f, den = 0.f;
    for (size_t i = (size_t)blockIdx.x * 512 + F.tid; i < n; i += (size_t)F.G * 512) {
        size_t ia = i;
        if (mode_transpose64) { const size_t tile = i >> 12, rem = i & 4095, r = rem >> 6, c2 = rem & 63; ia = (tile << 12) + c2 * 64 + r; }
        float x, y;
        if (sizeof(TA) == 2) x = bf2f(((const bf16_t*)a)[ia]); else x = ((const float*)a)[ia];
        if (sizeof(TB) == 2) y = bf2f(((const bf16_t*)b)[i]); else y = ((const float*)b)[i];
        const float d = x - y; num += d * d; den += y * y; }
    num = wave_sum(num); den = wave_sum(den);
    LAS float* red = (LAS float*)F.lds;
    __syncthreads();
    if (F.lane == 0) { red[F.wave * 2] = num; red[F.wave * 2 + 1] = den; }
    __syncthreads();
    if (F.tid == 0) { float n2 = 0.f, d2 = 0.f; for (int w8 = 0; w8 < 8; ++w8) { n2 += red[w8 * 2]; d2 += red[w8 * 2 + 1]; }
        ((float*)ctl)[1024 + 2 * blockIdx.x] = n2; ((float*)ctl)[1025 + 2 * blockIdx.x] = d2; }
}

constexpr size_t DBG_BF = WS_CONVH;
__device__ __forceinline__ void dbg_bruteforce(Frame& F) {
    LAS float* Ph = (LAS float*)F.lds; LAS float* Gm = Ph + 64 * 65; LAS float* vec = Gm + 64 * 65; LAS float* s1 = vec + 6 * 64; LAS float* s2 = s1 + 64;
    const bf16_t* sv = WSP(bf16_t, WS_SV); const bf16_t* sa = WSP(bf16_t, WS_SA); const bf16_t* sb = WSP(bf16_t, WS_SB); const bf16_t* sr = WSP(bf16_t, WS_SR); const bf16_t* sk = WSP(bf16_t, WS_SK); const float* sw = WSP(float, WS_SW);
    float* out = WSP(float, DBG_BF);
    const int chid = blockIdx.x, unit = chid >> 3, h = chid & 7, t0 = unit * 64;
    const int k = F.tid >> 3, j0 = (F.tid & 7) * 8;
    for (int e = 0; e < 8; ++e) { Ph[k * 65 + j0 + e] = (k == j0 + e) ? 1.f : 0.f; Gm[k * 65 + j0 + e] = 0.f; }
    __syncthreads();
    for (int t = 0; t < 64; ++t) {
        if (F.tid < 384) { const int a = F.tid >> 6, ch = F.tid & 63; const size_t o = (size_t)(t0 + t) * 512 + h * 64 + ch;
            float x; if (a == 0) x = sw[o]; else if (a == 1) x = bf2f(sa[o]); else if (a == 2) x = bf2f(sb[o]); else if (a == 3) x = bf2f(sk[o]); else if (a == 4) x = bf2f(sv[o]); else x = bf2f(sr[o]);
            vec[a * 64 + ch] = x; }
        __syncthreads();
        if (F.tid < 64) { float s = 0.f; for (int kk = 0; kk < 64; ++kk) s += vec[64 + kk] * Ph[kk * 65 + F.tid]; s1[F.tid] = s; }
        else if (F.tid < 128) { const int j = F.tid - 64; float s = 0.f; for (int kk = 0; kk < 64; ++kk) s += vec[64 + kk] * Gm[kk * 65 + j]; s2[j] = s; }
        __syncthreads();
        for (int e = 0; e < 8; ++e) { const int j = j0 + e; Ph[k * 65 + j] = vec[k] * Ph[k * 65 + j] + vec[128 + k] * s1[j]; Gm[k * 65 + j] = vec[k] * Gm[k * 65 + j] + vec[128 + k] * s2[j] + vec[192 + k] * vec[256 + j]; }
        __syncthreads();
        if (F.tid < 64) { float s = 0.f; for (int kk = 0; kk < 64; ++kk) s += vec[320 + kk] * Ph[kk * 65 + F.tid]; out[((size_t)(2 * 256 + chid) * 64 + t) * 64 + F.tid] = s; }
        else if (F.tid < 128) { const int j = F.tid - 64; float s = 0.f; for (int kk = 0; kk < 64; ++kk) s += vec[320 + kk] * Gm[kk * 65 + j]; out[((size_t)(3 * 256 + chid) * 64 + t) * 64 + j] = s; }
    }
    __syncthreads();
    for (int e = 0; e < 8; ++e) { out[((size_t)(0 * 256 + chid) * 64 + k) * 64 + j0 + e] = Ph[k * 65 + j0 + e]; out[((size_t)(1 * 256 + chid) * 64 + k) * 64 + j0 + e] = Gm[k * 65 + j0 + e]; }
}
__device__ __forceinline__ void dbg_compare_vt(Frame& F, unsigned* ctl) {
    const bf16_t* VT = WSP(bf16_t, WS_VT); const bf16_t* sv = WSP(bf16_t, WS_SV); float num = 0.f, den = 0.f;
    for (size_t i = (size_t)blockIdx.x * 512 + F.tid; i < (size_t)T * 512; i += (size_t)F.G * 512) { const size_t t = i >> 9, cg = i & 511, hh = cg >> 6, ch = cg & 63; const size_t chid = (t >> 6) * 8 + hh;
        const float x = bf2f(VT[(chid * 64 + ch) * 64 + (t & 63)]), y = bf2f(sv[i]); const float d = x - y; num += d * d; den += y * y; }
    num = wave_sum(num); den = wave_sum(den);
    LAS float* red = (LAS float*)F.lds; __syncthreads(); if (F.lane == 0) { red[F.wave * 2] = num; red[F.wave * 2 + 1] = den; } __syncthreads();
    if (F.tid == 0) { float n2 = 0.f, d2 = 0.f; for (int w8 = 0; w8 < 8; ++w8) { n2 += red[w8 * 2]; d2 += red[w8 * 2 + 1]; } ((float*)ctl)[1024 + 2 * blockIdx.x] = n2; ((float*)ctl)[1025 + 2 * blockIdx.x] = d2; }
}
#endif
__device__ __forceinline__ void phase_sgu(Frame& F, const Params& P, int l, int wg0, int nwg) {
    LAS unsigned char* vt = F.lds;
    const bf16_t* z = WSP(bf16_t, WS_SGUZ); unsigned char* hb = WSP(unsigned char, WS_HB);
    const bf16_t* Wm = WSP(bf16_t, WS_SGUW) + (size_t)l * 4 * 128 * 128;
    const float* bs = P.in[21] + (size_t)l * 4 * 128;
    int u0 = __builtin_amdgcn_readfirstlane((int)blockIdx.x - wg0);
    for (int u = u0; u < T / 128; u += nwg) {
        int uu = u; asm volatile("" : "+v"(uu)); uu = __builtin_amdgcn_readfirstlane(uu);
        int lz = F.lane; asm volatile("" : "+v"(lz));
        const size_t t0 = (size_t)uu * 128;
        __syncthreads();
        {
            float lg[4], lb[4];
#pragma unroll
            for (int e = 0; e < 4; ++e) { lg[e] = P.in[18][(size_t)l * 256 + lz + 64 * e]; lb[e] = P.in[19][(size_t)l * 256 + lz + 64 * e]; }
            float vall[16][4];
#pragma unroll
            for (int i = 0; i < 16; ++i) { const bf16_t* zr = z + (t0 + F.wave * 16 + i) * 512 + 256 + lz;
#pragma unroll
                for (int e = 0; e < 4; ++e) vall[i][e] = bf2f(zr[64 * e]); }
#pragma unroll
            for (int i = 0; i < 16; ++i) { const int tok = F.wave * 16 + i;
                float v[4];
#pragma unroll
                for (int e = 0; e < 4; ++e) v[e] = vall[i][e];
                const float mean = wave_sum((v[0] + v[1]) + (v[2] + v[3])) * (1.f / 256.f);
#pragma unroll
                for (int e = 0; e < 4; ++e) v[e] -= mean;
                const float rstd = rsqrtf(wave_sum((v[0] * v[0] + v[1] * v[1]) + (v[2] * v[2] + v[3] * v[3])) * (1.f / 256.f) + LN_EPS);
#pragma unroll
                for (int e = 0; e < 4; ++e) { const int ch = lz + 64 * e; *(LAS bf16_t*)(vt + ch * 256 + ((((tok >> 3) ^ (ch & 15)) << 4) | ((tok & 7) << 1))) = f2bf(v[e] * rstd * lg[e] + lb[e]); } } }
        __syncthreads();
        {   const int c = lz & 15, qd = lz >> 4, g = F.wave >> 1, sel = F.wave & 1;
            const bf16_t* Wg = Wm + (size_t)g * 128 * 128;
            f32x4 acc[4][4];
#pragma unroll
            for (int pi = 0; pi < 4; ++pi)
#pragma unroll
                for (int db = 0; db < 4; ++db) acc[pi][db] = (f32x4){0.f, 0.f, 0.f, 0.f};
#pragma unroll
            for (int ks = 0; ks < 4; ++ks) {
                bf16x8 af[4];
#pragma unroll
                for (int db = 0; db < 4; ++db) { const int ch = 64 * g + 16 * db + c; af[db] = *(const LAS bf16x8*)(vt + ch * 256 + (((4 * ks + qd) ^ (ch & 15)) << 4)); }
#pragma unroll
                for (int pi = 0; pi < 4; ++pi) { const int pb = sel ? ((pi == 0) ? 1 : (pi == 1) ? 2 : (pi == 2) ? 5 : 6) : ((pi == 0) ? 0 : (pi == 1) ? 3 : (pi == 2) ? 4 : 7);
                    if (32 * ks <= 16 * pb + 15) { const bf16x8 bfr = *(const bf16x8*)(Wg + (size_t)(16 * pb + c) * 128 + 32 * ks + 8 * qd);
#pragma unroll
                        for (int db = 0; db < 4; ++db) acc[pi][db] = MFMA32(af[db], bfr, acc[pi][db]); } } }
            u32x2 uraw[4][4]; float biasv[4];
#pragma unroll
            for (int pi = 0; pi < 4; ++pi) { const int pb = sel ? ((pi == 0) ? 1 : (pi == 1) ? 2 : (pi == 2) ? 5 : 6) : ((pi == 0) ? 0 : (pi == 1) ? 3 : (pi == 2) ? 4 : 7);
                const int p = 16 * pb + c; biasv[pi] = bs[g * 128 + p];
#pragma unroll
                for (int db = 0; db < 4; ++db) uraw[pi][db] = *(const u32x2*)(z + (t0 + p) * 512 + 64 * g + 16 * db + 4 * qd); }
#pragma unroll
            for (int pi = 0; pi < 4; ++pi) { const int pb = sel ? ((pi == 0) ? 1 : (pi == 1) ? 2 : (pi == 2) ? 5 : 6) : ((pi == 0) ? 0 : (pi == 1) ? 3 : (pi == 2) ? 4 : 7);
                const size_t t = t0 + 16 * pb + c;
#pragma unroll
                for (int db = 0; db < 4; ++db) { const int ch = 64 * g + 16 * db + 4 * qd;
                    const f32x4 o = unpack4(uraw[pi][db]) * (acc[pi][db] + biasv[pi]) * 4.f; *(unsigned*)(hb + t * 256 + ch) = pack_fp8x4(o[0], o[1], o[2], o[3]); } } }
    }
    __syncthreads();
}
__device__ __forceinline__ void phase_conv(Frame& F, const Params& P, int l, int wg0, int nwg) {
    LAS float* cv = (LAS float*)F.lds;
    const bf16_t* hin = WSP(bf16_t, WS_CONVH); unsigned char* hc = WSP(unsigned char, WS_HC);
    const float* dw = P.in[23] + (size_t)l * 31 * 256; const float* db = P.in[24] + (size_t)l * 256;
    const float* lg = P.in[25] + (size_t)l * 256; const float* lb = P.in[26] + (size_t)l * 256;
    int u0 = __builtin_amdgcn_readfirstlane((int)blockIdx.x - wg0);
    for (int u = u0; u < T / 64; u += nwg) {
        int tz = F.tid; asm volatile("" : "+v"(tz)); const int ch = tz & 255, hf = tz >> 8, lz = tz & 63;
        float kw[31];
#pragma unroll
        for (int j = 0; j < 31; ++j) kw[j] = dw[j * 256 + ch];
        const float bias = db[ch];
        const int t0 = u * 64 + hf * 32; const int s0 = t0 & (SEQ - 1);
        __syncthreads();
        float x[38];
#pragma unroll
        for (int m = 0; m < 30; ++m) { const int s = s0 - 30 + m; const float ld = bf2f(hin[(size_t)(t0 - 30 + m + (s >= 0 ? 0 : 30)) * 256 + ch]); x[m] = (s >= 0) ? ld : 0.f; }
#pragma unroll
        for (int g8 = 0; g8 < 4; ++g8) {
#pragma unroll
            for (int m = 0; m < 8; ++m) x[30 + m] = bf2f(hin[(size_t)(t0 + 8 * g8 + m) * 256 + ch]);
#pragma unroll
            for (int i = 0; i < 8; ++i) { float a = bias;
#pragma unroll
                for (int j = 0; j < 31; ++j) a += kw[j] * x[i + j];
                cv[(hf * 32 + 8 * g8 + i) * 256 + ch] = a; }
#pragma unroll
            for (int m = 0; m < 30; ++m) x[m] = x[m + 8]; }
        __syncthreads();
        {   const f32x4 g = *(const f32x4*)(lg + lz * 4), bb = *(const f32x4*)(lb + lz * 4);
            for (int i = 0; i < 8; ++i) { const int tok = F.wave * 8 + i; f32x4 v = *(const LAS f32x4*)(cv + tok * 256 + lz * 4);
                const float mean = wave_sum((v[0] + v[1]) + (v[2] + v[3])) * (1.f / 256.f);
                v = v - mean; const float var = wave_sum((v[0] * v[0] + v[1] * v[1]) + (v[2] * v[2] + v[3] * v[3])) * (1.f / 256.f);
                const float rstd = rsqrtf(var + LN_EPS);
                v = v * rstd * g + bb;
                float o[4];
#pragma unroll
                for (int j = 0; j < 4; ++j) o[j] = v[j] * sigmoidf_(v[j]);
                *(unsigned*)(hc + (size_t)(u * 64 + tok) * 256 + lz * 4) = pack_fp8x4(4.f * o[0], 4.f * o[1], 4.f * o[2], 4.f * o[3]); } }
    }
    __syncthreads();
}
__device__ __forceinline__ void ln_load16(const bf16_t* p, float (&v)[16]) {
    const u32x4 a = *(const u32x4*)p, b = *(const u32x4*)(p + 8);
    v[0] = bflo(a.x); v[1] = bfhi(a.x); v[2] = bflo(a.y); v[3] = bfhi(a.y); v[4] = bflo(a.z); v[5] = bfhi(a.z); v[6] = bflo(a.w); v[7] = bfhi(a.w);
    v[8] = bflo(b.x); v[9] = bfhi(b.x); v[10] = bflo(b.y); v[11] = bfhi(b.y); v[12] = bflo(b.z); v[13] = bfhi(b.z); v[14] = bflo(b.w); v[15] = bfhi(b.w);
}
__device__ __forceinline__ void ln_norm16(float (&v)[16], const float* g, const float* b, int lane) {
    float s = 0.f;
#pragma unroll
    for (int j = 0; j < 16; ++j) s += v[j];
    const float mean = wave_sum(s) * (1.f / 1024.f); float q = 0.f;
#pragma unroll
    for (int j = 0; j < 16; ++j) { v[j] -= mean; q += v[j] * v[j]; }
    const float rstd = rsqrtf(wave_sum(q) * (1.f / 1024.f) + LN_EPS);
#pragma unroll
    for (int j4 = 0; j4 < 4; ++j4) { const f32x4 gg = *(const f32x4*)(g + lane * 16 + j4 * 4), bb = *(const f32x4*)(b + lane * 16 + j4 * 4);
#pragma unroll
        for (int j = 0; j < 4; ++j) v[j4 * 4 + j] = v[j4 * 4 + j] * rstd * gg[j] + bb[j]; }
}
__device__ __forceinline__ void ln_store16(bf16_t* p, const float (&v)[16]) {
    u32x4 a, b; a.x = cvt_pk_bf16(v[0], v[1]); a.y = cvt_pk_bf16(v[2], v[3]); a.z = cvt_pk_bf16(v[4], v[5]); a.w = cvt_pk_bf16(v[6], v[7]);
    b.x = cvt_pk_bf16(v[8], v[9]); b.y = cvt_pk_bf16(v[10], v[11]); b.z = cvt_pk_bf16(v[12], v[13]); b.w = cvt_pk_bf16(v[14], v[15]);
    *(u32x4*)p = a; *(u32x4*)(p + 8) = b;
}
__device__ __forceinline__ void ln_load16q(const unsigned char* p, float (&v)[16]) {
    const u32x4 a = *(const u32x4*)p; const unsigned w[4] = {a.x, a.y, a.z, a.w};
#pragma unroll
    for (int i = 0; i < 4; ++i) { const f32x2 lo = __builtin_amdgcn_cvt_pk_f32_fp8((int)w[i], false), hi = __builtin_amdgcn_cvt_pk_f32_fp8((int)w[i], true); v[4 * i] = lo[0]; v[4 * i + 1] = lo[1]; v[4 * i + 2] = hi[0]; v[4 * i + 3] = hi[1]; }
}
__device__ __forceinline__ void ln_store16q(unsigned char* p, const float (&v)[16]) {
    u32x4 a; a.x = pack_fp8x4(v[0], v[1], v[2], v[3]); a.y = pack_fp8x4(v[4], v[5], v[6], v[7]); a.z = pack_fp8x4(v[8], v[9], v[10], v[11]); a.w = pack_fp8x4(v[12], v[13], v[14], v[15]);
    *(u32x4*)p = a;
}
__device__ __forceinline__ void phase_ln1(Frame& F, const Params& P, int l, int wg0, int nwg) {
    const bf16_t* pre = WSP(bf16_t, WS_PRE); const float* stats = WSP(float, WS_STATS);
    const float* g = P.in[29] + (size_t)l * 1024; const float* b = P.in[30] + (size_t)l * 1024;
    const int gw = ((int)blockIdx.x - wg0) * 8 + F.wave, NGW = nwg * 8;
    float gg[16], bb[16];
#pragma unroll
    for (int j4 = 0; j4 < 4; ++j4) { const f32x4 g4 = *(const f32x4*)(g + F.lane * 16 + j4 * 4), b4 = *(const f32x4*)(b + F.lane * 16 + j4 * 4);
#pragma unroll
        for (int j = 0; j < 4; ++j) { gg[j4 * 4 + j] = g4[j]; bb[j4 * 4 + j] = b4[j]; } }
    for (int row = gw; row < T; row += NGW) { float v[16]; ln_load16(pre + (size_t)row * 1024 + F.lane * 16, v);
        const f32x2 sl = *(const f32x2*)(stats + ((size_t)row * 16 + (F.lane & 15)) * 2);
        const float mean = row16_sum(sl[0]) * (1.f / 1024.f), ex2 = row16_sum(sl[1]) * (1.f / 1024.f);
        const float rstd = rsqrtf(fmaxf(ex2 - mean * mean, 0.f) + LN_EPS);
#pragma unroll
        for (int j = 0; j < 16; ++j) v[j] = (v[j] - mean) * rstd * gg[j] + bb[j];
        ln_store16q(WSP(unsigned char, WS_X1Q) + (size_t)row * 1024 + F.lane * 16, v); }
}
__device__ __forceinline__ void phase_ln2(Frame& F, const Params& P, int l) {
    const bf16_t* pre = WSP(bf16_t, WS_PRE); const float* stats = WSP(float, WS_STATS); const unsigned char* Y = WSP(unsigned char, WS_Y); bf16_t* x = WSP(bf16_t, WS_X); const int* inv = WSP(int, WS_GATEV);
    const float* g = P.in[36] + (size_t)l * 1024; const float* b = P.in[37] + (size_t)l * 1024; const float* g1 = P.in[29] + (size_t)l * 1024; const float* b1 = P.in[30] + (size_t)l * 1024;
    const int gw = blockIdx.x * 8 + F.wave, NGW = F.G * 8;
    int n0 = inv[2 * gw], n1 = inv[2 * gw + 1];
#pragma unroll 1
    for (int row = gw; row < T; row += NGW) { float v[16], y0[16], y1[16];
        const int c0 = __builtin_amdgcn_readfirstlane(n0), c1 = __builtin_amdgcn_readfirstlane(n1);
        { const int rn = (row + NGW < T) ? row + NGW : row; n0 = inv[2 * rn]; n1 = inv[2 * rn + 1]; }
        ln_load16(pre + (size_t)row * 1024 + F.lane * 16, v); ln_load16q(Y + (size_t)c0 * 1024 + F.lane * 16, y0); ln_load16q(Y + (size_t)c1 * 1024 + F.lane * 16, y1);
        {   const f32x2 sl = *(const f32x2*)(stats + ((size_t)row * 16 + (F.lane & 15)) * 2);
            const float mean = row16_sum(sl[0]) * (1.f / 1024.f), ex2 = row16_sum(sl[1]) * (1.f / 1024.f); const float rstd = rsqrtf(fmaxf(ex2 - mean * mean, 0.f) + LN_EPS);
#pragma unroll
            for (int j4 = 0; j4 < 4; ++j4) { const f32x4 g4 = *(const f32x4*)(g1 + F.lane * 16 + j4 * 4), b4 = *(const f32x4*)(b1 + F.lane * 16 + j4 * 4);
#pragma unroll
                for (int j = 0; j < 4; ++j) v[j4 * 4 + j] = (v[j4 * 4 + j] - mean) * rstd * g4[j] + b4[j]; } }
#pragma unroll
        for (int j = 0; j < 16; ++j) v[j] = ALPHA * v[j] + 0.125f * (y0[j] + y1[j]);
        ln_norm16(v, g, b, F.lane);
        if (l == NL - 1) { float* o = F.out + (size_t)row * 1024 + F.lane * 16;
#pragma unroll
            for (int j4 = 0; j4 < 4; ++j4) *(f32x4*)(o + j4 * 4) = (f32x4){v[j4 * 4], v[j4 * 4 + 1], v[j4 * 4 + 2], v[j4 * 4 + 3]}; }
        else { ln_store16(x + (size_t)row * 1024 + F.lane * 16, v); ln_store16q(WSP(unsigned char, WS_XQ) + (size_t)row * 1024 + F.lane * 16, v); } }
}

#define PHASE_PROLOGUE() const Params P = KPARAMS(); Frame F = make_frame(P.ws, P.out); unsigned* ctl = (unsigned*)(F.ws + WS_CTL); (void)ctl
__device__ __forceinline__ void ph_prologue_a() { PHASE_PROLOGUE(); phase_convert_static(F, P); __syncthreads(); }
__device__ __forceinline__ void ph_prologue_b() { PHASE_PROLOGUE(); phase_convert_lora(F, P); phase_convert_sgu(F, P); phase_convert_router(F, P); __syncthreads(); }
__device__ __forceinline__ void ph_prologue_c() { PHASE_PROLOGUE(); phase_x_to_bf16(F, P); __syncthreads(); }
__device__ __forceinline__ void ph_prologue() { PHASE_PROLOGUE(); phase_convert_static(F, P); phase_convert_lora(F, P); phase_convert_sgu(F, P); phase_convert_router(F, P); phase_x_to_bf16(F, P); phase_convert_moe(F, P, 0); __syncthreads(); }
__device__ __forceinline__ void ph_inproj(int l) { PHASE_PROLOGUE();
    SchedInproj S{(const char*)WSP(unsigned char, WS_XQ), (const char*)(WSP(unsigned char, WS_WIN) + (size_t)l * NIN * 1024), F.G, (int)blockIdx.x};
    EpiInproj E{WSP(bf16_t, WS_RKV), WSP(bf16_t, WS_SGUZ), WSP(bf16_t, WS_CONVH), WSP(unsigned char, WS_GATES)};
    ge::gemm_phase<SchedInproj, EpiInproj, true>(F.lds, S, E); }
__device__ __forceinline__ void ph_inproj_null(int l) { PHASE_PROLOGUE();
    SchedInproj S{(const char*)WSP(unsigned char, WS_XQ), (const char*)(WSP(unsigned char, WS_WIN) + (size_t)l * NIN * 1024), F.G, (int)blockIdx.x};
    EpiNull E{WSP(bf16_t, WS_HB)};
    ge::gemm_phase<SchedInproj, EpiNull, true>(F.lds, S, E); }
__device__ __forceinline__ void ph_wkva(int l) { PHASE_PROLOGUE(); phase_wkv_a<false>(F, P, l); }
__device__ __forceinline__ void ph_wkva_e(int l) { PHASE_PROLOGUE(); phase_wkv_a<true>(F, P, l); }
__device__ __forceinline__ void ph_cvtmoe(int l) { PHASE_PROLOGUE(); phase_convert_moe(F, P, l); __syncthreads(); }
__device__ __forceinline__ void ph_wkvb() { PHASE_PROLOGUE(); phase_wkv_b(F, P); }
__device__ __forceinline__ void ph_wkvc(int l) { PHASE_PROLOGUE(); phase_wkv_c(F, P, l); }
__device__ __forceinline__ void ph_sguconv(int l) { PHASE_PROLOGUE();
    phase_sgu(F, P, l, 64, 192); phase_conv(F, P, l, 64, 192); }
__device__ __forceinline__ void ph_branch(int l) { PHASE_PROLOGUE();
    SchedBranch S{(const char*)F.ws, WS_WBR + (size_t)l * 1024 * 1024, F.G, F.vcu};
    EpiBranch E{WSP(unsigned char, WS_GATES), WSP(bf16_t, WS_MERGED), WSP(unsigned char, WS_MERGEDQ)};
    ge::gemm_phase<SchedBranch, EpiBranch, true, 0x7A7A7A7A, 0x7D7D7D7D>(F.lds, S, E); }
__device__ __forceinline__ void ph_wout(int l) { PHASE_PROLOGUE();
    SchedWout S{(const char*)WSP(unsigned char, WS_MERGEDQ), (const char*)(WSP(unsigned char, WS_WOUT) + (size_t)l * 1024 * 1024), F.G, F.vcu};
    EpiWout E{WSP(bf16_t, WS_X), WSP(bf16_t, WS_PRE), WSP(float, WS_STATS)};
    ge::gemm_phase<SchedWout, EpiWout, true, 0x7A7A7A7A, 0x7D7D7D7D>(F.lds, S, E); }
__device__ __forceinline__ void ph_ln1(int l) { PHASE_PROLOGUE(); phase_ln1(F, P, l, 128, 128); }
__device__ __forceinline__ void ph_router(int l) { PHASE_PROLOGUE();
    SchedRouter S{(const char*)WSP(bf16_t, WS_PRE), (const char*)(WSP(bf16_t, WS_WRG) + (size_t)l * 256 * 1024), 128, (int)blockIdx.x};
    EpiRouter E{P.in[32], ctl + CW_CNT + 64 * l, WSP(int, WS_LIST), WSP(float, WS_STATS), WSP(float, WS_RC) + l * 64};
    ge::gemm_phase(F.lds, S, E); }
__device__ __forceinline__ void ph_router_probe(int l) { PHASE_PROLOGUE();
    SchedRouter S{(const char*)WSP(bf16_t, WS_PRE), (const char*)(WSP(bf16_t, WS_WRG) + (size_t)l * 256 * 1024), 128, (int)blockIdx.x};
    EpiRouter E{P.in[32], ctl + CW_CNT + 64 * l + 32, WSP(int, WS_Y), WSP(float, WS_STATS), WSP(float, WS_RC) + l * 64};
    ge::gemm_phase(F.lds, S, E); }
__device__ __forceinline__ void ph_moe1(int l) { PHASE_PROLOGUE();
    const int ntiles = build_tile_table(F, ctl + CW_CNT + 64 * l);
    SchedMoe1 S{(const char*)WSP(unsigned char, WS_X1Q), (const char*)moe_wbuf(F, l), WSP(int, WS_LIST), ctl + CW_CNT + 64 * l, (LAS int*)(F.lds + LDS_MISC + 64), ntiles, F.G, F.vcu};
    EpiMoe1 E{WSP(unsigned char, WS_H)};
    ge::gemm_phase<SchedMoe1, EpiMoe1, true>(F.lds, S, E); }
__device__ __forceinline__ void ph_moe2(int l) { PHASE_PROLOGUE(); int ntk4 = 4; asm volatile("" : "+s"(ntk4));
    const int ntiles = build_tile_table(F, ctl + CW_CNT + 64 * l);
    SchedMoe2 S{(const char*)WSP(unsigned char, WS_H), (const char*)(moe_wbuf(F, l) + (size_t)NE * 1024 * 1024), WSP(int, WS_LIST), ctl + CW_CNT + 64 * l, (LAS int*)(F.lds + LDS_MISC + 64), ntiles, F.G, F.vcu, ntk4};
    EpiMoe2 E{WSP(int, WS_LIST), WSP(unsigned char, WS_Y), WSP(int, WS_GATEV)};
    ge::gemm_phase<SchedMoe2, EpiMoe2, true>(F.lds, S, E); }
__device__ __forceinline__ void ph_moe2_nostore(int l) { PHASE_PROLOGUE(); int ntk4 = 4; asm volatile("" : "+s"(ntk4));
    const int ntiles = build_tile_table(F, ctl + CW_CNT + 64 * l);
    SchedMoe2 S{(const char*)WSP(unsigned char, WS_H), (const char*)(moe_wbuf(F, l) + (size_t)NE * 1024 * 1024), WSP(int, WS_LIST), ctl + CW_CNT + 64 * l, (LAS int*)(F.lds + LDS_MISC + 64), ntiles, F.G, F.vcu, ntk4};
    EpiMoe2T<1> E{WSP(int, WS_LIST), WSP(unsigned char, WS_Y), WSP(int, WS_GATEV)};
    ge::gemm_phase<SchedMoe2, EpiMoe2T<1>, true>(F.lds, S, E); }
__device__ __forceinline__ void ph_ln2(int l) { PHASE_PROLOGUE(); phase_ln2(F, P, l); }

constexpr int PH_PER_LAYER = 11, N_PHASES = 1 + NL * PH_PER_LAYER;
__global__ void __launch_bounds__(512, 2) fwd_kernel(Params p) {
    for (int u = threadIdx.x; u < (LDS_BYTES - LDS_MISC) / 4; u += 512) ((LAS unsigned*)((LAS unsigned char*)lds_raw + LDS_MISC))[u] = 0u;
    __syncthreads();
#if ONE_LAUNCH
    XcdBarrier bar = xcd_barrier_post((unsigned*)(p.ws + WS_CTL) + CW_BAR, (volatile LAS unsigned*)((LAS unsigned char*)lds_raw + LDS_MISC));
#define SEAM() xcd_barrier(bar)
#else
#define SEAM() do { } while (0)
#endif
    const int lo = p.phase_lo, hi = p.phase_hi;
#ifdef ONLY_K
#define IN(k) ((k) == ONLY_K && lo <= pb + (k) && pb + (k) < hi)
#else
#define IN(k) (lo <= pb + (k) && pb + (k) < hi)
#endif
#ifndef ONLY_K
    { const int pb = 0; if (IN(0)) { ph_prologue(); SEAM(); if (REPEAT_K == 20) { ph_prologue(); SEAM(); } if (REPEAT_K == 21) { ph_prologue_a(); SEAM(); } if (REPEAT_K == 22) { ph_prologue_b(); SEAM(); } if (REPEAT_K == 23) { ph_prologue_c(); SEAM(); } } }
#endif
#if DEBUG_MODE
    {
        { ph_inproj(0); SEAM(); }
        { PHASE_PROLOGUE(); dbg_prep(F, P, 0); } SEAM();
        { PHASE_PROLOGUE(); if (blockIdx.x < 128) dbg_scan(F, P, 0, 0, 128); } SEAM();
        if (DEBUG_MODE >= 6) { PHASE_PROLOGUE(); dbg_bruteforce(F); SEAM(); }
        ph_wkva(0); SEAM();
        if (blockIdx.x < 64) ph_wkvb(); SEAM();
        ph_wkvc(0); SEAM();
        { PHASE_PROLOGUE();
          if (DEBUG_MODE == 1) dbg_compare(F, WSP(bf16_t, WS_OUTA), WSP(bf16_t, DBG_OUTAREF), (size_t)T * 512, ctl, 0);
          if (DEBUG_MODE == 2) dbg_compare(F, WSP(bf16_t, WS_MT), WSP(float, DBG_MREF), (size_t)4096 * 4096, ctl, 1);
          if (DEBUG_MODE == 3) dbg_compare(F, WSP(bf16_t, DBG_YDBG), WSP(bf16_t, DBG_YREF), (size_t)T * 512, ctl, 0);
          if (DEBUG_MODE == 4) dbg_compare(F, WSP(float, WS_RK), WSP(float, DBG_RKREF), (size_t)T * 8, ctl, 0);
          if (DEBUG_MODE == 5) dbg_compare_vt(F, ctl);
          if (DEBUG_MODE == 20 && blockIdx.x == 0 && F.tid == 0) { const unsigned bits = __hip_atomic_load(ctl + 12, __ATOMIC_RELAXED, __HIP_MEMORY_SCOPE_AGENT); float st = 0.f; for (int bb = 15; bb >= 1; --bb) if (bits & (1u << bb)) st = (float)bb; ((float*)ctl)[1024] = st * st * 1e-4f; ((float*)ctl)[1025] = 1.f; }
          if (DEBUG_MODE == 10) dbg_compare(F, (const bf16_t*)F.out, WSP(float, WS_SW), (size_t)T * 512, ctl, 0);
          if (DEBUG_MODE == 11) dbg_compare(F, (const bf16_t*)F.out + (size_t)T * 512, WSP(bf16_t, WS_SB), (size_t)T * 512, ctl, 0);
          if (DEBUG_MODE == 12) dbg_compare(F, (const bf16_t*)F.out + (size_t)2 * T * 512, WSP(bf16_t, WS_SA), (size_t)T * 512, ctl, 0);
          if (DEBUG_MODE == 6) dbg_compare(F, WSP(bf16_t, WS_PHI), WSP(float, DBG_BF), (size_t)256 * 4096, ctl, 0);
          if (DEBUG_MODE == 7) dbg_compare(F, WSP(bf16_t, WS_GT), WSP(float, DBG_BF) + (size_t)1 * 256 * 4096, (size_t)256 * 4096, ctl, 1);
          if (DEBUG_MODE == 8) dbg_compare(F, WSP(bf16_t, WS_PSI), WSP(float, DBG_BF) + (size_t)2 * 256 * 4096, (size_t)256 * 4096, ctl, 0);
          if (DEBUG_MODE == 9) dbg_compare(F, WSP(bf16_t, WS_Y0T), WSP(float, DBG_BF) + (size_t)3 * 256 * 4096, (size_t)256 * 4096, ctl, 1);
        } SEAM();
        { PHASE_PROLOGUE(); float num = 0.f, den = 0.f; for (int g2 = 0; g2 < 256; ++g2) { num += ((const float*)ctl)[1024 + 2 * g2]; den += ((const float*)ctl)[1025 + 2 * g2]; }
          float e = 1000.f * sqrtf(num / fmaxf(den, 1e-30f)); if (!(e == e)) e = 7.0e6f; else if (e > 5e6f) e = 5.0e6f; if (!(den == den)) e = 9.0e6f;
          for (size_t i = (size_t)blockIdx.x * 512 + F.tid; i < (size_t)T * D; i += (size_t)F.G * 512) F.out[i] = e; }
        return;
    }
#endif
#define RUN_LAYER(l) do { const int pb = 1 + (l) * PH_PER_LAYER;\
        if (IN(0)) { ph_inproj(l); SEAM(); if (REPEAT_K == 0) { ph_inproj(l); SEAM(); } if (REPEAT_K == 30) { ph_inproj_null(l); SEAM(); } }\
        if (IN(1)) { ph_wkva(l); SEAM(); if (REPEAT_K == 1) { ph_wkva(l); SEAM(); } if (REPEAT_K == 15) { ph_wkva_e(l); SEAM(); } if (REPEAT_K == 11) { ph_cvtmoe(l); SEAM(); } }\
        if (IN(2)) { if (blockIdx.x < 64) ph_wkvb(); else ph_sguconv(l); if ((l) + 1 < NL) ph_cvtmoe((l) + 1); SEAM(); if (REPEAT_K == 2) { if (blockIdx.x < 64) ph_wkvb(); else ph_sguconv(l); SEAM(); } if (REPEAT_K == 13) { if (blockIdx.x < 64) ph_wkvb(); SEAM(); } if (REPEAT_K == 14) { if (blockIdx.x >= 64) ph_sguconv(l); SEAM(); } }\
        if (IN(3)) { ph_wkvc(l); SEAM(); if (REPEAT_K == 3) { ph_wkvc(l); SEAM(); } }\
        if (IN(4)) { ph_branch(l); SEAM(); if (REPEAT_K == 4) { ph_branch(l); SEAM(); } }\
        if (IN(5)) { ph_wout(l); SEAM(); if (REPEAT_K == 5) { ph_wout(l); SEAM(); } }\
        if (IN(6)) { if (blockIdx.x < 128) ph_router(l); else ph_ln1(l); SEAM(); if (REPEAT_K == 6) { if (blockIdx.x >= 128) ph_ln1(l); SEAM(); } if (REPEAT_K == 7) { if (blockIdx.x < 128) ph_router_probe(l); SEAM(); } }\
        if (IN(8)) { ph_moe1(l); SEAM(); if (REPEAT_K == 8) { ph_moe1(l); SEAM(); } }\
        if (IN(9)) { ph_moe2(l); SEAM(); if (REPEAT_K == 9) { ph_moe2(l); SEAM(); } if (REPEAT_K == 19) { ph_moe2_nostore(l); SEAM(); } }\
        if (IN(10)) { if (REPEAT_K == 10) { ph_ln2(l); SEAM(); } if (REPEAT_K == 12) { SEAM(); SEAM(); SEAM(); SEAM(); SEAM(); SEAM(); SEAM(); SEAM(); SEAM(); SEAM(); } ph_ln2(l); if (l + 1 < NL) SEAM(); } } while (0)
    RUN_LAYER(0); RUN_LAYER(1); RUN_LAYER(2); RUN_LAYER(3);
#undef RUN_LAYER
#undef IN
#undef SEAM
}

extern "C" void kernel_launch(void* const* d_in, const int* in_sizes, int n_in, void* d_out, int out_size, void* d_ws, size_t ws_size, hipStream_t stream) {
    static int grid = 0;
    if (grid == 0) {
        if (n_in != 38 || in_sizes[0] != T * D || out_size != T * D || ws_size < WS_END) { fprintf(stderr, "kernel_launch: unexpected shapes (n_in %d, in0 %d, out %d, ws %zu, need %zu); nothing launched\n", n_in, n_in > 0 ? in_sizes[0] : -1, out_size, ws_size, (size_t)WS_END); grid = -1; return; }
        int dev = 0, cus = 0, per_cu = 0;
        if (hipGetDevice(&dev) != hipSuccess || hipDeviceGetAttribute(&cus, hipDeviceAttributeMultiprocessorCount, dev) != hipSuccess) { grid = -1; return; }
        if (hipFuncSetAttribute((const void*)fwd_kernel, hipFuncAttributeMaxDynamicSharedMemorySize, LDS_BYTES) != hipSuccess) { fprintf(stderr, "kernel_launch: hipFuncSetAttribute failed\n"); grid = -1; return; }
        if (hipOccupancyMaxActiveBlocksPerMultiprocessor(&per_cu, (const void*)fwd_kernel, 512, LDS_BYTES) != hipSuccess || per_cu < 1) fprintf(stderr, "kernel_launch: occupancy query reports %d blocks per CU\n", per_cu);
        (void)hipGetLastError();
        grid = cus;
        if (grid != 256) { fprintf(stderr, "kernel_launch: built for a 256-CU device, found %d CUs; nothing launched\n", cus); grid = -1; return; }
    }
    if (grid < 0) return;
    (void)hipMemsetAsync((char*)d_ws + WS_CTL, 0, CTL_BYTES, stream);
    Params p{};
    for (int i = 0; i < 38; ++i) p.in[i] = (const float*)d_in[i];
    p.out = (float*)d_out; p.ws = (unsigned char*)d_ws; p.layer_lo = 0; p.layer_hi = NL;
#if ONE_LAUNCH
    p.phase_lo = 0; p.phase_hi = N_PHASES;
    hipLaunchKernelGGL(fwd_kernel, dim3(grid), dim3(512), LDS_BYTES, stream, p);
#else
    for (int ph = 0; ph < N_PHASES; ++ph) { p.phase_lo = ph; p.phase_hi = ph + 1; hipLaunchKernelGGL(fwd_kernel, dim3(grid), dim3(512), LDS_BYTES, stream, p); }
#endif
}
```

```cpp
#include <hip/hip_runtime.h>
#include <stdint.h>
#include <stdio.h>

#ifndef DEBUG_MODE
#define DEBUG_MODE 0
#endif
#ifndef REPEAT_K
#define REPEAT_K -1
#endif
#ifndef ONE_LAUNCH
#define ONE_LAUNCH 1
#endif

#define LAS __attribute__((address_space(3)))
typedef unsigned short bf16_t;
typedef short bf16x8 __attribute__((ext_vector_type(8)));
typedef float f32x4 __attribute__((ext_vector_type(4)));
typedef float f32x2 __attribute__((ext_vector_type(2)));
typedef unsigned u32x4 __attribute__((ext_vector_type(4)));
typedef unsigned u32x2 __attribute__((ext_vector_type(2)));

constexpr int T = 32768, SEQ = 2048, D = 1024, NL = 4;
constexpr int NIN = 5888;
constexpr int RKVW = 1792;
constexpr int NE = 32;
constexpr float ALPHA = 1.681792830507429f;
constexpr float LN_EPS = 1e-5f, GN_EPS = 64e-5f;

constexpr size_t MiB = 1u << 20;
constexpr size_t WS_CTL = 0;
constexpr size_t WS_WIN = 1 * MiB;
constexpr size_t WS_WBR = WS_WIN + 46 * MiB;
constexpr size_t WS_WOUT = WS_WBR + 8 * MiB;
constexpr size_t WS_WRT = WS_WOUT + 8 * MiB;
constexpr size_t WS_WMOE = WS_WRT + 1 * MiB;
constexpr size_t WS_X = WS_WMOE + 96 * MiB;
constexpr size_t WS_X1 = WS_X + 64 * MiB;
constexpr size_t WS_VFIRST = WS_X1 + 64 * MiB;
constexpr size_t WS_RKV = WS_VFIRST + 32 * MiB;
constexpr size_t WS_SGUZ = WS_RKV + 112 * MiB;
constexpr size_t WS_CONVH = WS_SGUZ + 32 * MiB;
constexpr size_t WS_GATES = WS_CONVH + 16 * MiB;
constexpr size_t WS_PHI = WS_GATES + 192 * MiB;
constexpr size_t WS_PSI = WS_PHI + 32 * MiB;
constexpr size_t WS_GT = WS_PSI + 32 * MiB;
constexpr size_t WS_Y0T = WS_GT + 32 * MiB;
constexpr size_t WS_VT = WS_Y0T + 32 * MiB;
constexpr size_t WS_MT = WS_VT + 32 * MiB;
constexpr size_t WS_RK = WS_MT + 32 * MiB;
constexpr size_t WS_LORA = WS_RK + 1 * MiB;
constexpr size_t WS_SGUW = WS_LORA + 1 * MiB;
constexpr size_t WS_OUTA = WS_SGUW + 1 * MiB;
constexpr size_t WS_HB = WS_OUTA + 32 * MiB;
constexpr size_t WS_HC = WS_HB + 16 * MiB;
constexpr size_t WS_XQ = WS_HC + 16 * MiB;
constexpr size_t WS_END = WS_XQ + 32 * MiB;
constexpr size_t WS_X1Q = WS_WMOE + 64 * MiB;
constexpr size_t WS_STATS = WS_Y0T;
constexpr size_t WS_WRG = WS_WBR + 4 * MiB;
constexpr size_t WS_RC = WS_SGUW + 512 * 1024;
constexpr size_t WS_MERGEDQ = WS_GT;
constexpr size_t WS_MERGED = WS_RKV;
constexpr size_t WS_PRE = WS_PHI;
constexpr size_t WS_H = WS_RKV;
constexpr size_t WS_Y = WS_GATES;
constexpr size_t WS_LIST = WS_SGUZ;
constexpr size_t WS_GATEV = WS_SGUZ + 16 * MiB;
static_assert(WS_END <= 1024 * MiB, "workspace map");
#if DEBUG_MODE
constexpr size_t WS_SV = WS_GATES, WS_SA = WS_SV + 32 * MiB, WS_SB = WS_SA + 32 * MiB, WS_SR = WS_SB + 32 * MiB, WS_SK = WS_SR + 32 * MiB, WS_SG = WS_SK + 32 * MiB;
constexpr size_t WS_SW = WS_X1;
constexpr size_t DBG_OUTAREF = WS_WMOE, DBG_MREF = WS_WMOE + 32 * MiB, DBG_YREF = WS_SGUZ, DBG_RKREF = WS_HB, DBG_YDBG = WS_HC;
#endif
constexpr int CW_BAR = 4096;
constexpr int CW_CNT = 16384;
constexpr size_t CTL_BYTES = 1 * MiB;

constexpr int LDS_STAGE = 131072;
constexpr int LDS_MISC = LDS_STAGE;
constexpr int LDS_RAW = LDS_STAGE + 4096;
constexpr int LDS_BYTES = 163840;

typedef __bf16 bf16x2_t __attribute__((ext_vector_type(2)));
__device__ __forceinline__ unsigned cvt_pk_bf16(float lo, float hi) { const f32x2 v = {lo, hi}; const bf16x2_t b = __builtin_convertvector(v, bf16x2_t); return __builtin_bit_cast(unsigned, b); }
__device__ __forceinline__ unsigned pack_fp8x4(float a, float b, float c, float d) { int w = 0; w = __builtin_amdgcn_cvt_pk_fp8_f32(a, b, w, false); w = __builtin_amdgcn_cvt_pk_fp8_f32(c, d, w, true); return (unsigned)w; }
__device__ __forceinline__ bf16_t f2bf(float f) { return (bf16_t)(cvt_pk_bf16(f, 0.f) & 0xffffu); }
__device__ __forceinline__ float bf2f(unsigned short b) { return __uint_as_float(((unsigned)b) << 16); }
__device__ __forceinline__ float bflo(unsigned w) { return __uint_as_float(w << 16); }
__device__ __forceinline__ float bfhi(unsigned w) { return __uint_as_float(w & 0xffff0000u); }
__device__ __forceinline__ float sigmoidf_(float x) { return __builtin_amdgcn_rcpf(1.0f + __expf(-x)); }
template <int CTRL> __device__ __forceinline__ float dpp_mov(float x) { return __builtin_bit_cast(float, __builtin_amdgcn_mov_dpp(__builtin_bit_cast(int, x), CTRL, 0xF, 0xF, true)); }
__device__ __forceinline__ float row16_sum(float v) { v += dpp_mov<0xB1>(v); v += dpp_mov<0x4E>(v); v += dpp_mov<0x141>(v); v += dpp_mov<0x140>(v); return v; }
__device__ __forceinline__ float wave_sum(float v) {
    v = row16_sum(v); const int vi = __builtin_bit_cast(int, v);
    return (__builtin_bit_cast(float, __builtin_amdgcn_readlane(vi, 0)) + __builtin_bit_cast(float, __builtin_amdgcn_readlane(vi, 16))) + (__builtin_bit_cast(float, __builtin_amdgcn_readlane(vi, 32)) + __builtin_bit_cast(float, __builtin_amdgcn_readlane(vi, 48)));
}
__device__ __forceinline__ float dpp_f(float x, const int ctrl_sel) {
    int xi = __builtin_bit_cast(int, x), r;
    if (ctrl_sel == 0) r = __builtin_amdgcn_update_dpp(0, xi, 0xB1, 0xF, 0xF, true);
    else if (ctrl_sel == 1) r = __builtin_amdgcn_update_dpp(0, xi, 0x4E, 0xF, 0xF, true);
    else r = __builtin_amdgcn_update_dpp(0, xi, 0x141, 0xF, 0xF, true);
    return __builtin_bit_cast(float, r);
}
__device__ __forceinline__ float reduce8(float x) { x += dpp_f(x, 0); x += dpp_f(x, 1); x += dpp_f(x, 2); return x; }
__device__ __forceinline__ float gelu_f(float v) {
    const float av = fabsf(v), t = __builtin_amdgcn_rcpf(av * 0.2316418882f + 1.0f);
    float q = t * 0.5307027145f + (-0.7265760135f); q = q * t + 0.7107068705f; q = q * t + (-0.142248368f); q = q * t + 0.127414796f; q = q * t;
    const float e = __builtin_amdgcn_exp2f((v * v) * (-0.72134752044f));
    const float m = v * (q * e);
    return v < 0.f ? m : v - m;
}

#define XB_TMO      128
#define XB_XCNT(j)  (256  + 64 * (j))
#define XB_XSUB(j)  (1280 + 64 * (j))
#define XB_XGEN(j)  (2304 + 64 * (j))
#define XB_TOP      3328
#define XB_TOPGEN   3392
#define XCD_BAR_WORDS 3456
#define XB_SPIN_CAP (1u << 22)
__device__ __forceinline__ unsigned xb_ld(unsigned* p)              { return __hip_atomic_load(p, __ATOMIC_RELAXED, __HIP_MEMORY_SCOPE_AGENT); }
__device__ __forceinline__ unsigned xb_add(unsigned* p, unsigned v) { return __hip_atomic_fetch_add(p, v, __ATOMIC_RELAXED, __HIP_MEMORY_SCOPE_AGENT); }
__device__ __forceinline__ unsigned xb_xcc_id() { return (unsigned)__builtin_amdgcn_s_getreg((3 << 11) | 20) & 0xFu; }
#define XB_SPIN(cond, bar) do { unsigned _sp = 0; while (cond) { __builtin_amdgcn_s_sleep(1); \
    if ((++_sp & 255u) == 0u) { if (xb_ld(&(bar)[XB_TMO])) break; if (_sp > XB_SPIN_CAP) { atomicAdd(&(bar)[XB_TMO], 1u); break; } } } } while (0)
struct XcdBarrier { unsigned* bar; unsigned x; volatile LAS unsigned* st; };
__device__ __forceinline__ XcdBarrier xcd_barrier_post(unsigned* bar, volatile LAS unsigned* st) {
    XcdBarrier b; b.bar = bar; b.x = xb_xcc_id(); b.st = st;
    if (threadIdx.x == 0) (void)xb_add(&bar[XB_XCNT(b.x)], 1u);
    return b;
}
__device__ __forceinline__ void xcd_barrier_complete(unsigned* bar, unsigned x, unsigned& nloc, unsigned& nx) {
    const unsigned G = gridDim.x * gridDim.y * gridDim.z;
    unsigned sum, cnt, mine, sp = 0u;
    for (;;) {
        sum = 0u; cnt = 0u; mine = 0u;
#pragma unroll
        for (unsigned j = 0; j < 16; ++j) { const unsigned c = xb_ld(&bar[XB_XCNT(j)]); sum += c; cnt += (c > 0u) ? 1u : 0u; mine = (j == x) ? c : mine; }
        if (sum == G) break;
        __builtin_amdgcn_s_sleep(1);
        if ((++sp & 255u) == 0u) { if (xb_ld(&bar[XB_TMO])) break; if (sp > XB_SPIN_CAP) { atomicAdd(&bar[XB_TMO], 1u); break; } }
    }
    nloc = mine > 0u ? mine : 1u; nx = cnt > 0u ? cnt : 1u;
}
__device__ __forceinline__ void xcd_barrier(const XcdBarrier& b) {
    asm volatile("s_waitcnt vmcnt(0)" ::: "memory");
    __syncthreads();
    if (threadIdx.x == 0) {
        unsigned* bar = b.bar;
        __builtin_amdgcn_s_waitcnt(0);
        unsigned nloc = b.st[0], nx = b.st[1];
        if (nloc == 0u) { xcd_barrier_complete(bar, b.x, nloc, nx); b.st[0] = nloc; b.st[1] = nx; }
        const unsigned old = xb_add(&bar[XB_XSUB(b.x)], 1u);
        const unsigned gen = old / nloc;
        if (old + 1u == (gen + 1u) * nloc) {
            __builtin_amdgcn_fence(__ATOMIC_RELEASE, "agent");
            asm volatile("s_waitcnt vmcnt(0)" ::: "memory");
            const unsigned og = xb_add(&bar[XB_TOP], 1u);
            const unsigned tg = og / nx;
            if (og + 1u == (tg + 1u) * nx) xb_add(&bar[XB_TOPGEN], 1u);
            else XB_SPIN(xb_ld(&bar[XB_TOPGEN]) == tg, bar);
            __builtin_amdgcn_fence(__ATOMIC_ACQUIRE, "agent");
            xb_add(&bar[XB_XGEN(b.x)], 1u);
            asm volatile("s_waitcnt vmcnt(0)" ::: "memory");
        } else {
            XB_SPIN(xb_ld(&bar[XB_XGEN(b.x)]) == gen, bar);
            __builtin_amdgcn_fence(__ATOMIC_ACQUIRE, "agent");
            asm volatile("s_waitcnt vmcnt(0)" ::: "memory");
        }
    }
    __syncthreads();
}

struct Params {
    const float* in[38];
    float* out;
    unsigned char* ws;
    int phase_lo, phase_hi;
    int layer_lo, layer_hi;
};

namespace ge {
constexpr int BM = 256, BK = 64, HALF = 128, HTB = HALF * BK * 2;
__device__ __forceinline__ int lds_byte(int r, int c) { const int st = (r >> 4) * 2 + (c >> 5), rr = r & 15, cc = c & 31, ob = rr * 64 + cc * 2; return st * 1024 + (ob ^ (((ob >> 9) & 1) << 5)); }
__device__ __forceinline__ void stage_rc(int b, int& R, int& C) { const int st = b / 1024, sb = b % 1024, swz = sb ^ (((sb >> 9) & 1) << 5); R = (st >> 1) * 16 + swz / 64; C = (st & 1) * 32 + (swz % 64) / 2; }
__device__ __forceinline__ int perm32(int rho) { const int n = rho >> 4, i = rho & 15; return 8 * (i >> 2) + 4 * n + (i & 3); }

struct NoPre { };
struct Unit {
    const char* A; const char* B;
    const int* gat;
    unsigned lda, ldb;
    int nt;
    int gshift, nvalid;
    int pm, pn, aux;
};
typedef f32x4 Acc[2][2][4][2];

typedef int i32x8 __attribute__((ext_vector_type(8)));
template <class Sched, class Epi, bool FP8 = false, int SCALE_W = 0x7A7A7A7A, int SCALE_A = 0x7F7F7F7F>
__device__ __forceinline__ void gemm_phase(LAS unsigned char* lds, const Sched& S, const Epi& E) {
    int tid = threadIdx.x; asm volatile("" : "+v"(tid));
    const int wid = __builtin_amdgcn_readfirstlane(tid >> 6), lane = tid & 63, wr = wid >> 2, wc = wid & 3, fr = lane & 15, fq = lane >> 4;
    const unsigned ldsw = (unsigned)wid * 1024u;
    const int aoff = FP8 ? lds_byte(wr * 64 + fr, fq * 16) : lds_byte(wr * 64 + fr, fq * 8), boff = FP8 ? lds_byte(wc * 32 + fr, fq * 16) : lds_byte(wc * 32 + fr, fq * 8);
    const int aoff1 = FP8 ? lds_byte(wr * 64 + fr, fq * 16 + 8) : aoff + 1024, boff1 = FP8 ? lds_byte(wc * 32 + fr, fq * 16 + 8) : boff + 1024;
#define GE_SA(b, h) (((b) * 2 + (h)) * HTB)
#define GE_SB(b, h) ((4 + (b) * 2 + (h)) * HTB)
#define GE_STAGE(bufoff, gbase, o0, o1) do { \
        __builtin_amdgcn_global_load_lds((const unsigned*)((gbase) + (o0)), (LAS unsigned*)(lds + (bufoff) + ldsw), 16, 0, 0); \
        __builtin_amdgcn_global_load_lds((const unsigned*)((gbase) + (o1)), (LAS unsigned*)(lds + (bufoff) + ldsw + 8192), 16, 0, 0); } while (0)
#define GE_LDA(dst, b, h) do { _Pragma("unroll") for (int m = 0; m < 4; ++m) { dst[m][0] = *(const LAS bf16x8*)(lds + GE_SA(b, h) + aoff + m * 2048); dst[m][1] = *(const LAS bf16x8*)(lds + GE_SA(b, h) + aoff1 + m * 2048); } } while (0)
#define GE_LDB(dst, b, h) do { _Pragma("unroll") for (int n = 0; n < 2; ++n) { dst[n][0] = *(const LAS bf16x8*)(lds + GE_SB(b, h) + boff + n * 2048); dst[n][1] = *(const LAS bf16x8*)(lds + GE_SB(b, h) + boff1 + n * 2048); } } while (0)
#define GE_CAT(x0, x1) __builtin_shufflevector(__builtin_bit_cast(u32x4, x0), __builtin_bit_cast(u32x4, x1), 0, 1, 2, 3, 4, 5, 6, 7)
#define GE_MMA(ai, bj, At, Bt) do { __builtin_amdgcn_s_setprio(1); _Pragma("unroll") for (int m = 0; m < 4; ++m) _Pragma("unroll") for (int n = 0; n < 2; ++n) { \
        if constexpr (FP8) acc[ai][bj][m][n] = __builtin_amdgcn_mfma_scale_f32_16x16x128_f8f6f4(__builtin_bit_cast(i32x8, GE_CAT(Bt[n][0], Bt[n][1])), __builtin_bit_cast(i32x8, GE_CAT(At[m][0], At[m][1])), acc[ai][bj][m][n], 0, 0, 0, SCALE_W, 0, SCALE_A); \
        else { _Pragma("unroll") for (int k = 0; k < 2; ++k) acc[ai][bj][m][n] = __builtin_amdgcn_mfma_f32_16x16x32_bf16(Bt[n][k], At[m][k], acc[ai][bj][m][n], 0, 0, 0); } } __builtin_amdgcn_s_setprio(0); } while (0)
#define GE_WAIT_V(n) asm volatile("s_waitcnt vmcnt(" #n ")" ::: "memory")
#define GE_WAIT_L(n) asm volatile("s_waitcnt lgkmcnt(" #n ")" ::: "memory")
#define GE_BAR __builtin_amdgcn_s_barrier()
#define GE_SCHED __builtin_amdgcn_sched_barrier(0)
#define GE_OFFS(u, oA00, oA01, oA10, oA11, oB0, oB1) do { \
        int tq_ = tid; asm volatile("" : "+v"(tq_)); int R0, C0, R1, C1; stage_rc(tq_ * 16, R0, C0); stage_rc(tq_ * 16 + 8192, R1, C1); \
        const int Rb0 = (R0 & ~31) + perm32(R0 & 31), Rb1 = (R1 & ~31) + perm32(R1 & 31); \
        int r00 = R0, r01 = R1, r10 = 128 + R0, r11 = 128 + R1; \
        if ((u).gat) { const int* g_ = (u).gat; const int nv_ = (u).nvalid, sh_ = (u).gshift; \
            r00 = (r00 < nv_) ? (g_[2 * r00] >> sh_) : 0; r01 = (r01 < nv_) ? (g_[2 * r01] >> sh_) : 0; r10 = (r10 < nv_) ? (g_[2 * r10] >> sh_) : 0; r11 = (r11 < nv_) ? (g_[2 * r11] >> sh_) : 0; } \
        oA00 = (unsigned)r00 * (u).lda + (unsigned)C0 * 2u; oA01 = (unsigned)r01 * (u).lda + (unsigned)C1 * 2u; \
        oA10 = (unsigned)r10 * (u).lda + (unsigned)C0 * 2u; oA11 = (unsigned)r11 * (u).lda + (unsigned)C1 * 2u; \
        oB0 = (unsigned)Rb0 * (u).ldb + (unsigned)C0 * 2u; oB1 = (unsigned)Rb1 * (u).ldb + (unsigned)C1 * 2u; } while (0)
    Unit cur, nxt; int ui = 0;
    if (!S.next(0, cur)) return;
    Acc acc;
#pragma unroll
    for (int a = 0; a < 2; ++a)
#pragma unroll
        for (int b = 0; b < 2; ++b)
#pragma unroll
            for (int m = 0; m < 4; ++m)
#pragma unroll
                for (int n = 0; n < 2; ++n) acc[a][b][m][n] = (f32x4){0.f, 0.f, 0.f, 0.f};
    bf16x8 At[4][2], B0[2][2], B1[2][2];
    unsigned oA00, oA01, oA10, oA11, oB0, oB1;
    GE_OFFS(cur, oA00, oA01, oA10, oA11, oB0, oB1);
    typename Epi::Pre pre = E.prefetch(cur, wr, wc, fr, fq);
    const char* cA = cur.A; const char* cB = cur.B; size_t chB = (size_t)128 * cur.ldb;
    const size_t kstep = 128;
    GE_STAGE(GE_SB(0, 0), cB, oB0, oB1); GE_STAGE(GE_SA(0, 0), cA, oA00, oA01); GE_STAGE(GE_SB(0, 1), cB + chB, oB0, oB1); GE_STAGE(GE_SA(0, 1), cA, oA10, oA11);
    if (wr == 1) GE_BAR;
    GE_WAIT_V(4); GE_BAR;
    GE_STAGE(GE_SB(1, 0), cB + kstep, oB0, oB1); GE_STAGE(GE_SA(1, 0), cA + kstep, oA00, oA01); GE_STAGE(GE_SB(1, 1), cB + chB + kstep, oB0, oB1);
    GE_WAIT_V(6); GE_BAR;
    for (;;) {
        const bool has_next = S.next(ui + 1, nxt);
        const char* nA = has_next ? nxt.A : cA; const char* nB = has_next ? nxt.B : cB; const size_t nhB = has_next ? (size_t)128 * nxt.ldb : chB;
        const int nt = cur.nt;
        for (int t = 0; t < nt; t += 2) {
            const bool last = (t == nt - 2);
            const char* a1 = cA + (size_t)(t + 1) * kstep;
            const char* a2 = last ? nA : cA + (size_t)(t + 2) * kstep; const char* b2 = last ? nB : cB + (size_t)(t + 2) * kstep;
            const size_t hB2 = last ? nhB : chB;
            const char* a3 = a2 + kstep; const char* b3 = b2 + kstep;
            GE_LDB(B0, 0, 0); GE_SCHED; GE_LDA(At, 0, 0); GE_STAGE(GE_SA(1, 1), a1, oA10, oA11);
            if (last && has_next) { GE_OFFS(nxt, oA00, oA01, oA10, oA11, oB0, oB1); }
            GE_WAIT_L(8); GE_BAR; GE_WAIT_L(0); GE_MMA(0, 0, At, B0); GE_BAR; GE_SCHED;
            GE_LDB(B1, 0, 1); GE_STAGE(GE_SB(0, 0), b2, oB0, oB1);
            GE_BAR; GE_WAIT_L(0); GE_MMA(0, 1, At, B1); GE_BAR;
            GE_LDA(At, 0, 1); GE_STAGE(GE_SA(0, 0), a2, oA00, oA01);
            GE_BAR; GE_WAIT_L(0); GE_MMA(1, 0, At, B0); GE_BAR; GE_SCHED;
            GE_STAGE(GE_SB(0, 1), b2 + hB2, oB0, oB1);
            GE_WAIT_V(6); GE_BAR; GE_MMA(1, 1, At, B1); GE_BAR;
            GE_LDB(B0, 1, 0); GE_SCHED; GE_LDA(At, 1, 0); GE_STAGE(GE_SA(0, 1), a2, oA10, oA11);
            GE_WAIT_L(8); GE_BAR; GE_WAIT_L(0); GE_MMA(0, 0, At, B0); GE_BAR; GE_SCHED;
            GE_LDB(B1, 1, 1); GE_STAGE(GE_SB(1, 0), b3, oB0, oB1);
            GE_BAR; GE_WAIT_L(0); GE_MMA(0, 1, At, B1); GE_BAR;
            GE_LDA(At, 1, 1); GE_STAGE(GE_SA(1, 0), a3, oA00, oA01);
            GE_BAR; GE_WAIT_L(0); GE_MMA(1, 0, At, B0); GE_BAR; GE_SCHED;
            GE_STAGE(GE_SB(1, 1), b3 + hB2, oB0, oB1);
            GE_WAIT_V(6); GE_BAR; GE_MMA(1, 1, At, B1); GE_BAR;
        }
        if constexpr (!Epi::AFTER_DRAIN) E(acc, cur, wr, wc, fr, fq, pre);
        if (!has_next) break;
#pragma unroll
        for (int a = 0; a < 2; ++a)
#pragma unroll
            for (int b = 0; b < 2; ++b)
#pragma unroll
                for (int m = 0; m < 4; ++m)
#pragma unroll
                    for (int n = 0; n < 2; ++n) acc[a][b][m][n] = (f32x4){0.f, 0.f, 0.f, 0.f};
        cur = nxt; cA = nA; cB = nB; chB = nhB; ++ui; pre = E.prefetch(cur, wr, wc, fr, fq);
    }
    GE_WAIT_V(0);
    if (wr == 0) GE_BAR;
    GE_BAR;
    if constexpr (Epi::AFTER_DRAIN) E.drained(acc, cur, wr, wc, fr, fq, lds);
#undef GE_SA
#undef GE_SB
#undef GE_STAGE
#undef GE_LDA
#undef GE_LDB
#undef GE_MMA
#undef GE_WAIT_V
#undef GE_WAIT_L
#undef GE_BAR
#undef GE_SCHED
#undef GE_OFFS
#undef GE_CAT
}
__device__ __forceinline__ bool static_tile(long L, int nM, int nN, int& pm, int& pn) {
    const int nwg = nM * nN; if (L >= nwg) return false;
    int wgid = (int)L; { const int q = nwg / 8, r = nwg % 8, xcd = wgid % 8, off = wgid / 8; wgid = (xcd < r ? xcd * (q + 1) : r * (q + 1) + (xcd - r) * q) + off; }
    const int nig = 8 * nN, gid = wgid / nig, fm = gid * 8, gsz = (nM - fm) < 8 ? (nM - fm) : 8;
    pm = fm + ((wgid % nig) % gsz); pn = (wgid % nig) / gsz; return true;
}
}

struct Frame {
    LAS unsigned char* lds;
    int tid, lane, wave, G, vcu;
    unsigned char* ws;
    float* out;
};
#define WSP(T_, off) ((T_*)(F.ws + (off)))

extern __shared__ __attribute__((aligned(16))) unsigned char lds_raw[];
__device__ __forceinline__ Params load_params() {
    typedef const __attribute__((address_space(4))) unsigned long long cu64;
    cu64* k = (cu64*)__builtin_amdgcn_kernarg_segment_ptr();
    asm volatile("" : "+s"(k));
    Params P;
#pragma unroll
    for (int i = 0; i < 38; ++i) P.in[i] = (const float*)(const __attribute__((address_space(1))) float*)k[i];
    P.out = (float*)(__attribute__((address_space(1))) float*)k[38]; P.ws = (unsigned char*)(__attribute__((address_space(1))) unsigned char*)k[39];
    P.phase_lo = 0; P.phase_hi = 0; P.layer_lo = 0; P.layer_hi = 0;
    return P;
}
#define KPARAMS() load_params()
__device__ __forceinline__ Frame make_frame(unsigned char* ws, float* out) {
    Frame F;
    F.lds = (LAS unsigned char*)lds_raw;
    int tz = threadIdx.x; asm volatile("" : "+v"(tz));
    F.tid = tz; F.lane = F.tid & 63; F.wave = __builtin_amdgcn_readfirstlane(F.tid >> 6);
    F.G = gridDim.x; { const int bx = blockIdx.x; F.vcu = (F.G % 8 == 0) ? (bx % 8) * (F.G / 8) + bx / 8 : bx; }
    F.ws = ws; F.out = out;
    return F;
}
template <bool FP8OUT, class ColMap>
__device__ __forceinline__ void transpose_item(const float* W, int ldw, int K, void* WTv, int nblk, LAS float* scr, int item, int lane, const ColMap& cm) {
    const int kb = item / nblk, nb = item % nblk, k0 = 64 * kb, n0 = 32 * nb;
    const int sc = cm(n0 + (lane & 31));
#pragma unroll 8
    for (int i = 0; i < 32; ++i) { const int kk = 2 * i + (lane >> 5); scr[kk * 33 + (lane & 31)] = (sc >= 0) ? W[(size_t)(k0 + kk) * ldw + sc] : 0.f; }
    asm volatile("s_waitcnt lgkmcnt(0)" ::: "memory");
    const int c = lane & 7;
#pragma unroll
    for (int j = 0; j < 4; ++j) { const int n = (lane >> 3) + 8 * j; const LAS float* s = scr + (8 * c) * 33 + n;
        if (FP8OUT) { u32x2 o; o.x = pack_fp8x4(32.f * s[0 * 33], 32.f * s[1 * 33], 32.f * s[2 * 33], 32.f * s[3 * 33]); o.y = pack_fp8x4(32.f * s[4 * 33], 32.f * s[5 * 33], 32.f * s[6 * 33], 32.f * s[7 * 33]);
            *(u32x2*)((unsigned char*)WTv + (size_t)(n0 + n) * K + k0 + 8 * c) = o; }
        else { u32x4 o; o.x = cvt_pk_bf16(s[0 * 33], s[1 * 33]); o.y = cvt_pk_bf16(s[2 * 33], s[3 * 33]); o.z = cvt_pk_bf16(s[4 * 33], s[5 * 33]); o.w = cvt_pk_bf16(s[6 * 33], s[7 * 33]);
            *(u32x4*)((bf16_t*)WTv + (size_t)(n0 + n) * K + k0 + 8 * c) = o; } }
    asm volatile("s_waitcnt lgkmcnt(0)" ::: "memory");
}
struct CmIdent { __device__ __forceinline__ int operator()(int n) const { return n; } };
struct CmInproj { int layer; __device__ __forceinline__ int operator()(int j) const {
    if (j < 1536) return j;
    if (j < 1792) { const int q = j - 1536; if (q < 160) return 1536 + q; if (q < 192) return layer > 0 ? 5792 + (q - 160) : -1; return -1; }
    if (j < 2304) return 1696 + (j - 1792);
    if (j < 2816) { const int jj = j - 2304, c = jj >> 1; return (jj & 1) ? 2208 + 256 + c : 2208 + c; }
    return 2720 + (j - 2816); } };
struct CmRouter { __device__ __forceinline__ int operator()(int n) const { return n < 32 ? n : -1; } };
struct CmGU { __device__ __forceinline__ int operator()(int n) const { return n; } };

template <bool FP8OUT> __device__ __forceinline__ void moe_item_store(void* WTv, int K, int k0, int n0, LAS float* scr, int lane) {
    asm volatile("s_waitcnt lgkmcnt(0)" ::: "memory");
    const int c = lane & 7;
#pragma unroll
    for (int j = 0; j < 4; ++j) { const int nn = (lane >> 3) + 8 * j; const LAS float* s = scr + (8 * c) * 33 + nn;
        if (FP8OUT) { u32x2 o; o.x = pack_fp8x4(32.f * s[0 * 33], 32.f * s[1 * 33], 32.f * s[2 * 33], 32.f * s[3 * 33]); o.y = pack_fp8x4(32.f * s[4 * 33], 32.f * s[5 * 33], 32.f * s[6 * 33], 32.f * s[7 * 33]);
            *(u32x2*)((unsigned char*)WTv + (size_t)(n0 + nn) * K + k0 + 8 * c) = o; }
        else { u32x4 o; o.x = cvt_pk_bf16(s[0 * 33], s[1 * 33]); o.y = cvt_pk_bf16(s[2 * 33], s[3 * 33]); o.z = cvt_pk_bf16(s[4 * 33], s[5 * 33]); o.w = cvt_pk_bf16(s[6 * 33], s[7 * 33]);
            *(u32x4*)((bf16_t*)WTv + (size_t)(n0 + nn) * K + k0 + 8 * c) = o; } }
    asm volatile("s_waitcnt lgkmcnt(0)" ::: "memory");
}
__device__ __forceinline__ void fast_item_plain(const float* W, int ldw, int K, unsigned char* WT, int nblk, LAS float* scr, int item, int lane) {
    const int kb = item / nblk, nb = item % nblk, k0 = 64 * kb, n0 = 32 * nb; const int c4 = (lane & 7) * 4; const float* Ws = W + n0 + c4;
    f32x4 v[8];
#pragma unroll
    for (int i = 0; i < 8; ++i) v[i] = *(const f32x4*)(Ws + (size_t)(k0 + 8 * i + (lane >> 3)) * ldw);
#pragma unroll
    for (int i = 0; i < 8; ++i) { LAS float* d = scr + (8 * i + (lane >> 3)) * 33 + c4; d[0] = v[i][0]; d[1] = v[i][1]; d[2] = v[i][2]; d[3] = v[i][3]; }
    moe_item_store<true>(WT, K, k0, n0, scr, lane);
}
__device__ __forceinline__ void phase_convert_static(Frame& F, const Params& P) {
    LAS float* scr = (LAS float*)(F.lds + F.wave * 8448);
    const int gw = F.vcu * 8 + F.wave, NGW = F.G * 8;
    constexpr int I_IN = 16 * (NIN / 32);
    for (int it = gw; it < NL * I_IN; it += NGW) { const int l = it / I_IN, r = it % I_IN; const int lane = F.lane;
        const float* W = (l == 0) ? P.in[1] : P.in[2] + (size_t)(l - 1) * 1024 * 5824; const int ldw = (l == 0) ? 5792 : 5824;
        const int kb = r / (NIN / 32), nb = r % (NIN / 32), k0 = 64 * kb, n0 = 32 * nb;
        f32x4 v[8];
        if (n0 >= 2304 && n0 < 2816) {
            const int m = (lane >> 2) & 1, c4 = (lane & 3) * 4; const float* Ws = W + 2208 + 256 * m + ((n0 - 2304) >> 1) + c4;
#pragma unroll
            for (int i = 0; i < 8; ++i) v[i] = *(const f32x4*)(Ws + (size_t)(k0 + 8 * i + (lane >> 3)) * ldw);
#pragma unroll
            for (int i = 0; i < 8; ++i) { LAS float* d = scr + (8 * i + (lane >> 3)) * 33 + 2 * c4 + m; d[0] = v[i][0]; d[2] = v[i][1]; d[4] = v[i][2]; d[6] = v[i][3]; }
        } else {
            int src = n0; bool zero = false;
            if (n0 >= 1696 && n0 < 1728) { src = 5792 + (n0 - 1696); zero = (l == 0); } else if (n0 >= 1728 && n0 < 1792) zero = true; else if (n0 >= 1792) src = n0 - 96;
            const int c4 = (lane & 7) * 4; const float* Ws = W + (zero ? 0 : src) + c4;
#pragma unroll
            for (int i = 0; i < 8; ++i) { v[i] = *(const f32x4*)(Ws + (size_t)(k0 + 8 * i + (lane >> 3)) * ldw); if (zero) v[i] = (f32x4){0.f, 0.f, 0.f, 0.f}; }
#pragma unroll
            for (int i = 0; i < 8; ++i) { LAS float* d = scr + (8 * i + (lane >> 3)) * 33 + c4; d[0] = v[i][0]; d[1] = v[i][1]; d[2] = v[i][2]; d[3] = v[i][3]; }
        }
        moe_item_store<true>(WSP(unsigned char, WS_WIN) + (size_t)l * NIN * 1024, 1024, k0, n0, scr, lane); }
    constexpr int I_A = 8 * 32, I_B = 4 * 32;
    for (int it = gw; it < NL * (I_A + 2 * I_B); it += NGW) { const int l = it / (I_A + 2 * I_B); int r = it % (I_A + 2 * I_B);
        unsigned char* base = WSP(unsigned char, WS_WBR) + (size_t)l * (1024 * 1024);
        if (r < I_A) { fast_item_plain(P.in[17] + (size_t)l * 512 * 1024, 1024, 512, base, 32, scr, r, F.lane); continue; } r -= I_A;
        if (r < I_B) { fast_item_plain(P.in[22] + (size_t)l * 256 * 1024, 1024, 256, base + 1024 * 512, 32, scr, r, F.lane); continue; } r -= I_B;
        fast_item_plain(P.in[27] + (size_t)l * 256 * 1024, 1024, 256, base + 1024 * 512 + 1024 * 256, 32, scr, r, F.lane); }
    constexpr int I_O = 16 * 32;
    for (int it = gw; it < NL * I_O; it += NGW) { const int l = it / I_O, r = it % I_O;
        fast_item_plain(P.in[28] + (size_t)l * 1024 * 1024, 1024, 1024, WSP(unsigned char, WS_WOUT) + (size_t)l * 1024 * 1024, 32, scr, r, F.lane); }
    for (int it = gw; it < 16 * 8; it += NGW) transpose_item<false>(P.in[31], 32, 1024, WSP(bf16_t, WS_WRT), 8, scr, it, F.lane, CmRouter{});
}
__device__ __forceinline__ unsigned char* moe_wbuf(Frame& F, int l) { return (l & 1) ? (unsigned char*)F.out : F.ws + WS_WMOE; }
__device__ __forceinline__ void phase_convert_moe(Frame& F, const Params& P, int l) {
    LAS float* scr = (LAS float*)(F.lds + F.wave * 8448);
    const int gw = F.vcu * 8 + F.wave, NGW = F.G * 8; const int lane = F.lane;
    constexpr int I_GU = 16 * 32;
    constexpr int I_DN = 8 * 32;
    for (int it = gw; it < NE * I_GU; it += NGW) { const int e = it / I_GU, item = it % I_GU;
        const int kb = item / 32, nb = item % 32, k0 = 64 * kb, n0 = 32 * nb;
        const int m = (lane >> 2) & 1, c4 = (lane & 3) * 4;
        const float* Ws = ((m ? P.in[34] : P.in[33]) + ((size_t)l * NE + e) * 1024 * 512) + (n0 >> 1) + c4;
        f32x4 v[8];
#pragma unroll
        for (int i = 0; i < 8; ++i) v[i] = *(const f32x4*)(Ws + (size_t)(k0 + 8 * i + (lane >> 3)) * 512);
#pragma unroll
        for (int i = 0; i < 8; ++i) { LAS float* d = scr + (8 * i + (lane >> 3)) * 33 + 2 * c4 + m; d[0] = v[i][0]; d[2] = v[i][1]; d[4] = v[i][2]; d[6] = v[i][3]; }
        moe_item_store<true>(moe_wbuf(F, l) + (size_t)e * 1024 * 1024, 1024, k0, n0, scr, lane); }
    for (int it = gw; it < NE * I_DN; it += NGW) { const int e = it / I_DN, item = it % I_DN;
        const int kb = item / 32, nb = item % 32, k0 = 64 * kb, n0 = 32 * nb; const int c4 = (lane & 7) * 4;
        const float* Ws = P.in[35] + ((size_t)l * NE + e) * 512 * 1024 + n0 + c4;
        f32x4 v[8];
#pragma unroll
        for (int i = 0; i < 8; ++i) v[i] = *(const f32x4*)(Ws + (size_t)(k0 + 8 * i + (lane >> 3)) * 1024);
#pragma unroll
        for (int i = 0; i < 8; ++i) { LAS float* d = scr + (8 * i + (lane >> 3)) * 33 + c4; d[0] = v[i][0]; d[1] = v[i][1]; d[2] = v[i][2]; d[3] = v[i][3]; }
        moe_item_store<true>(moe_wbuf(F, l) + (size_t)NE * 1024 * 1024 + (size_t)e * 1024 * 512, 512, k0, n0, scr, lane); }
}
__device__ __forceinline__ void phase_convert_lora(Frame& F, const Params& P) {
    bf16_t* dst = WSP(bf16_t, WS_LORA);
    for (int idx = (int)blockIdx.x * 512 + F.tid; idx < 11 * 512 * 32 + 4 * 512 * 96; idx += F.G * 512) {
        float val;
        if (idx < 11 * 512 * 32) { const int m = idx / (512 * 32), rem = idx % (512 * 32), ch = rem / 32, i = rem % 32;
            if (m < 4) val = P.in[6][((size_t)m * 32 + i) * 512 + ch]; else if (m < 8) val = P.in[8][((size_t)(m - 4) * 32 + i) * 512 + ch]; else val = P.in[11][((size_t)(m - 8) * 32 + i) * 512 + ch]; }
        else { const int r2 = idx - 11 * 512 * 32, m = r2 / (512 * 96), rem = r2 % (512 * 96), ch = rem / 96, i = rem % 96; val = P.in[9][((size_t)m * 96 + i) * 512 + ch]; }
        dst[idx] = f2bf(val); }
}
__device__ __forceinline__ void phase_convert_sgu(Frame& F, const Params& P) {
    bf16_t* dst = WSP(bf16_t, WS_SGUW);
    for (int idx = (int)blockIdx.x * 512 + F.tid; idx < NL * 4 * 128 * 128; idx += F.G * 512) { const int p = (idx >> 7) & 127, qq = idx & 127; dst[idx] = f2bf(qq <= p ? P.in[20][idx] : 0.f); }
}
__device__ __forceinline__ void phase_convert_router(Frame& F, const Params& P) {
    bf16_t* dst = WSP(bf16_t, WS_WRG); float* rc = WSP(float, WS_RC);
    for (int idx = (int)blockIdx.x * 512 + F.tid; idx < NL * 256 * 1024; idx += F.G * 512) { const int l = idx >> 18, n = (idx >> 10) & 255, k = idx & 1023;
        dst[idx] = f2bf(n < 32 ? P.in[29][(size_t)l * 1024 + k] * P.in[31][(size_t)k * 32 + n] : 0.f); }
    const int gwv = (int)blockIdx.x * 8 + F.wave;
    if (gwv < NL * 32) { const int l = gwv >> 5, e = gwv & 31; float c1 = 0.f, c0 = 0.f;
#pragma unroll
        for (int j = 0; j < 16; ++j) { const int k = F.lane + 64 * j; const float w = P.in[31][(size_t)k * 32 + e]; c1 += P.in[29][(size_t)l * 1024 + k] * w; c0 += P.in[30][(size_t)l * 1024 + k] * w; }
        c1 = wave_sum(c1); c0 = wave_sum(c0);
        if (F.lane == 0) { rc[l * 64 + e] = c1; rc[l * 64 + 32 + e] = c0; } }
}
__device__ __forceinline__ void phase_x_to_bf16(Frame& F, const Params& P) {
    const size_t n8 = (size_t)T * D / 8; const float* x = P.in[0]; bf16_t* xb = WSP(bf16_t, WS_X); unsigned char* xq = WSP(unsigned char, WS_XQ);
    for (size_t i = (size_t)blockIdx.x * 512 + F.tid; i < n8; i += (size_t)F.G * 512) {
        const f32x4 a = *(const f32x4*)(x + i * 8), b = *(const f32x4*)(x + i * 8 + 4);
        u32x4 o; o.x = cvt_pk_bf16(a[0], a[1]); o.y = cvt_pk_bf16(a[2], a[3]); o.z = cvt_pk_bf16(b[0], b[1]); o.w = cvt_pk_bf16(b[2], b[3]);
        *(u32x4*)(xb + i * 8) = o;
        u32x2 qv; qv.x = pack_fp8x4(a[0], a[1], a[2], a[3]); qv.y = pack_fp8x4(b[0], b[1], b[2], b[3]); *(u32x2*)(xq + i * 8) = qv; }
}

struct SchedInproj { const char* X; const char* W; int G, c;
    __device__ __forceinline__ bool next(int i, ge::Unit& u) const { int pm, pn; if (!ge::static_tile((long)i * G + c, T / 256, NIN / 256, pm, pn)) return false;
        u.A = X + (size_t)pm * 256 * 1024; u.B = W + (size_t)pn * 256 * 1024; u.gat = nullptr; u.lda = 1024; u.ldb = 1024; u.nt = 8; u.gshift = 0; u.nvalid = 256; u.pm = pm; u.pn = pn; u.aux = 0; return true; } };
struct EpiInproj { static constexpr bool AFTER_DRAIN = false; bf16_t* rkv; bf16_t* sguz; bf16_t* convh; unsigned char* gates;
    typedef ge::NoPre Pre; __device__ __forceinline__ Pre prefetch(const ge::Unit&, int, int, int, int) const { return Pre{}; }
    __device__ __forceinline__ void operator()(const ge::Acc& acc, const ge::Unit& u, int wr, int wc, int fr, int fq, const Pre&) const {
        const int pn = u.pn; const int row0 = u.pm * 256 + wr * 64 + fr;
        int kind, ld, colt; bf16_t* base;
        if (pn < 7) { kind = 0; base = rkv; ld = RKVW; colt = pn * 256; }
        else if (pn < 9) { kind = 1; base = sguz; ld = 512; colt = (pn - 7) * 256; }
        else if (pn < 11) { kind = 2; base = convh; ld = 256; colt = (pn - 9) * 128; }
        else { kind = 3; base = rkv; ld = 3072; colt = (pn - 11) * 256; }
#pragma unroll
        for (int ai = 0; ai < 2; ++ai)
#pragma unroll
            for (int m = 0; m < 4; ++m) { const size_t r = (size_t)(row0 + ai * 128 + m * 16);
#pragma unroll
                for (int bj = 0; bj < 2; ++bj) { const int c = 128 * bj + 32 * wc + 8 * fq; f32x4 v0 = acc[ai][bj][m][0], v1 = acc[ai][bj][m][1];
                    if (kind == 2) {
                        const float h0 = v0[0] * sigmoidf_(v0[1]), h1 = v0[2] * sigmoidf_(v0[3]), h2 = v1[0] * sigmoidf_(v1[1]), h3 = v1[2] * sigmoidf_(v1[3]);
                        u32x2 w; w.x = cvt_pk_bf16(h0, h1); w.y = cvt_pk_bf16(h2, h3);
                        *(u32x2*)(base + r * ld + colt + (c >> 1)) = w;
                    } else if (kind == 3) {
                        u32x2 w; unsigned w0 = 0, w1 = 0;
                        w0 = __builtin_amdgcn_cvt_pk_u8_f32(255.f * sigmoidf_(v0[0]) + 0.5f, 0, w0); w0 = __builtin_amdgcn_cvt_pk_u8_f32(255.f * sigmoidf_(v0[1]) + 0.5f, 1, w0);
                        w0 = __builtin_amdgcn_cvt_pk_u8_f32(255.f * sigmoidf_(v0[2]) + 0.5f, 2, w0); w0 = __builtin_amdgcn_cvt_pk_u8_f32(255.f * sigmoidf_(v0[3]) + 0.5f, 3, w0);
                        w1 = __builtin_amdgcn_cvt_pk_u8_f32(255.f * sigmoidf_(v1[0]) + 0.5f, 0, w1); w1 = __builtin_amdgcn_cvt_pk_u8_f32(255.f * sigmoidf_(v1[1]) + 0.5f, 1, w1);
                        w1 = __builtin_amdgcn_cvt_pk_u8_f32(255.f * sigmoidf_(v1[2]) + 0.5f, 2, w1); w1 = __builtin_amdgcn_cvt_pk_u8_f32(255.f * sigmoidf_(v1[3]) + 0.5f, 3, w1);
                        w.x = w0; w.y = w1; *(u32x2*)(gates + r * 3072 + colt + c) = w;
                    } else {
                        if (kind == 1) {
#pragma unroll
                            for (int j = 0; j < 4; ++j) { v0[j] = gelu_f(v0[j]); v1[j] = gelu_f(v1[j]); } }
                        u32x4 w; w.x = cvt_pk_bf16(v0[0], v0[1]); w.y = cvt_pk_bf16(v0[2], v0[3]); w.z = cvt_pk_bf16(v1[0], v1[1]); w.w = cvt_pk_bf16(v1[2], v1[3]);
                        *(u32x4*)(base + r * ld + colt + c) = w; } } }
    } };
struct EpiNull { static constexpr bool AFTER_DRAIN = false; bf16_t* sink;
    typedef ge::NoPre Pre; __device__ __forceinline__ Pre prefetch(const ge::Unit&, int, int, int, int) const { return Pre{}; }
    __device__ __forceinline__ void operator()(const ge::Acc& acc, const ge::Unit& u, int wr, int wc, int fr, int fq, const Pre&) const {
        float t = 0.f;
#pragma unroll
        for (int ai = 0; ai < 2; ++ai)
#pragma unroll
            for (int bj = 0; bj < 2; ++bj)
#pragma unroll
                for (int m = 0; m < 4; ++m)
#pragma unroll
                    for (int n = 0; n < 2; ++n) t += acc[ai][bj][m][n][0];
        if (t == 123456.789f) sink[0] = f2bf(t); } };
struct SchedBranch { const char* ws; size_t woff; int G, v;
    __device__ __forceinline__ bool next(int i, ge::Unit& u) const { const int tile = (i / 3) * G + v, br = i % 3, pm = tile >> 2, pn = tile & 3; if (tile >= 512) return false;
        const unsigned kb = (br == 0) ? 512u : 256u;
        size_t ao = WS_OUTA, wo = woff; if (br == 1) { ao = WS_HB; wo += (size_t)1024 * 512; } if (br == 2) { ao = WS_HC; wo += (size_t)1024 * 512 + (size_t)1024 * 256; }
        u.A = ws + ao + (size_t)pm * 256 * kb; u.lda = kb; u.nt = (int)(kb >> 7); u.B = ws + wo + (size_t)pn * 256 * kb; u.ldb = kb;
        u.gat = nullptr; u.gshift = 0; u.nvalid = 256; u.pm = pm; u.pn = pn; u.aux = br; return true; } };
struct EpiBranch { static constexpr bool AFTER_DRAIN = false; const unsigned char* gates; bf16_t* merged; unsigned char* mq;
    typedef ge::NoPre Pre; __device__ __forceinline__ Pre prefetch(const ge::Unit&, int, int, int, int) const { return Pre{}; }
    __device__ __forceinline__ void operator()(const ge::Acc& acc, const ge::Unit& u, int wr, int wc, int fr, int fq, const Pre&) const {
        const int br = u.aux; const int row0 = u.pm * 256 + wr * 64 + fr;
#pragma unroll
        for (int ai = 0; ai < 2; ++ai) {
            u32x2 g[8]; u32x4 p[8];
#pragma unroll
            for (int m = 0; m < 4; ++m)
#pragma unroll
                for (int bj = 0; bj < 2; ++bj) { const size_t r = (size_t)(row0 + ai * 128 + m * 16); const int c = u.pn * 256 + 128 * bj + 32 * wc + 8 * fq;
                    g[m * 2 + bj] = *(const u32x2*)(gates + r * 3072 + br * 1024 + c);
                    p[m * 2 + bj] = (br > 0) ? *(const u32x4*)(merged + r * 1024 + c) : (u32x4){0u, 0u, 0u, 0u}; }
#pragma unroll
            for (int m = 0; m < 4; ++m)
#pragma unroll
                for (int bj = 0; bj < 2; ++bj) { const size_t r = (size_t)(row0 + ai * 128 + m * 16); const int c = u.pn * 256 + 128 * bj + 32 * wc + 8 * fq;
                    const f32x4 v0 = acc[ai][bj][m][0], v1 = acc[ai][bj][m][1]; const u32x2 gg = g[m * 2 + bj]; const u32x4 pp = p[m * 2 + bj];
                    const float k = 1.f / 255.f;
                    const float g0 = k * (float)(gg.x & 0xffu), g1 = k * (float)((gg.x >> 8) & 0xffu), g2 = k * (float)((gg.x >> 16) & 0xffu), g3 = k * (float)(gg.x >> 24);
                    const float g4 = k * (float)(gg.y & 0xffu), g5 = k * (float)((gg.y >> 8) & 0xffu), g6 = k * (float)((gg.y >> 16) & 0xffu), g7 = k * (float)(gg.y >> 24);
                    u32x4 w; w.x = cvt_pk_bf16(v0[0] * g0 + bflo(pp.x), v0[1] * g1 + bfhi(pp.x)); w.y = cvt_pk_bf16(v0[2] * g2 + bflo(pp.y), v0[3] * g3 + bfhi(pp.y));
                    w.z = cvt_pk_bf16(v1[0] * g4 + bflo(pp.z), v1[1] * g5 + bfhi(pp.z)); w.w = cvt_pk_bf16(v1[2] * g6 + bflo(pp.w), v1[3] * g7 + bfhi(pp.w));
                    if (br == 2) { u32x2 wq; wq.x = pack_fp8x4(4.f * (v0[0] * g0 + bflo(pp.x)), 4.f * (v0[1] * g1 + bfhi(pp.x)), 4.f * (v0[2] * g2 + bflo(pp.y)), 4.f * (v0[3] * g3 + bfhi(pp.y)));
                        wq.y = pack_fp8x4(4.f * (v1[0] * g4 + bflo(pp.z)), 4.f * (v1[1] * g5 + bfhi(pp.z)), 4.f * (v1[2] * g6 + bflo(pp.w)), 4.f * (v1[3] * g7 + bfhi(pp.w))); *(u32x2*)(mq + r * 1024 + c) = wq; }
                    else *(u32x4*)(merged + r * 1024 + c) = w; }
            asm volatile("" ::: "memory"); }
    } };
struct SchedWout { const char* A; const char* W; int G, v;
    __device__ __forceinline__ bool next(int i, ge::Unit& u) const { const int tile = i * G + v, pm = tile >> 2, pn = tile & 3; if (tile >= 512) return false;
        u.A = A + (size_t)pm * 256 * 1024; u.B = W + (size_t)pn * 256 * 1024; u.gat = nullptr; u.lda = 1024; u.ldb = 1024; u.nt = 8; u.gshift = 0; u.nvalid = 256; u.pm = pm; u.pn = pn; u.aux = 0; return true; } };
struct EpiWout { static constexpr bool AFTER_DRAIN = false; const bf16_t* x; bf16_t* pre; float* stats;
    typedef ge::NoPre Pre; __device__ __forceinline__ Pre prefetch(const ge::Unit&, int, int, int, int) const { return Pre{}; }
    __device__ __forceinline__ void operator()(const ge::Acc& acc, const ge::Unit& u, int wr, int wc, int fr, int fq, const Pre&) const {
        const int row0 = u.pm * 256 + wr * 64 + fr;
#pragma unroll
        for (int ai = 0; ai < 2; ++ai)
#pragma unroll
            for (int m = 0; m < 4; ++m) { const size_t r = (size_t)(row0 + ai * 128 + m * 16); float s1 = 0.f, s2 = 0.f;
#pragma unroll
                for (int bj = 0; bj < 2; ++bj) { const int c = u.pn * 256 + 128 * bj + 32 * wc + 8 * fq; const f32x4 v0 = acc[ai][bj][m][0], v1 = acc[ai][bj][m][1];
                    const u32x4 p = *(const u32x4*)(x + r * 1024 + c);
                    u32x4 w; w.x = cvt_pk_bf16(v0[0] + ALPHA * bflo(p.x), v0[1] + ALPHA * bfhi(p.x)); w.y = cvt_pk_bf16(v0[2] + ALPHA * bflo(p.y), v0[3] + ALPHA * bfhi(p.y));
                    w.z = cvt_pk_bf16(v1[0] + ALPHA * bflo(p.z), v1[1] + ALPHA * bfhi(p.z)); w.w = cvt_pk_bf16(v1[2] + ALPHA * bflo(p.w), v1[3] + ALPHA * bfhi(p.w));
                    *(u32x4*)(pre + r * 1024 + c) = w;
                    const float q0 = bflo(w.x), q1 = bfhi(w.x), q2 = bflo(w.y), q3 = bfhi(w.y), q4 = bflo(w.z), q5 = bfhi(w.z), q6 = bflo(w.w), q7 = bfhi(w.w);
                    s1 += ((q0 + q1) + (q2 + q3)) + ((q4 + q5) + (q6 + q7)); s2 += ((q0 * q0 + q1 * q1) + (q2 * q2 + q3 * q3)) + ((q4 * q4 + q5 * q5) + (q6 * q6 + q7 * q7)); }
                s1 += __shfl_xor(s1, 16); s2 += __shfl_xor(s2, 16); s1 += __shfl_xor(s1, 32); s2 += __shfl_xor(s2, 32);
                if (fq == 0) *(f32x2*)(stats + (r * 16 + u.pn * 4 + wc) * 2) = (f32x2){s1, s2};
                asm volatile("" ::: "memory"); }
    } };
struct SchedRouter { const char* A; const char* W; int G, v;
    __device__ __forceinline__ bool next(int i, ge::Unit& u) const { const int pm = i * G + v; if (pm >= 128) return false;
        u.A = A + (size_t)pm * 256 * 2048; u.B = W; u.gat = nullptr; u.lda = 2048; u.ldb = 2048; u.nt = 16; u.gshift = 0; u.nvalid = 256; u.pm = pm; u.pn = 0; u.aux = 0; return true; } };
struct EpiRouter { static constexpr bool AFTER_DRAIN = true; const float* rbias; unsigned* cnt; int* list; const float* stats; const float* rc;
    typedef ge::NoPre Pre; __device__ __forceinline__ Pre prefetch(const ge::Unit&, int, int, int, int) const { return Pre{}; }
    __device__ __forceinline__ void drained(const ge::Acc& acc, const ge::Unit& u, int wr, int wc, int fr, int fq, LAS unsigned char* lds) const {
        LAS int* lcnt = (LAS int*)lds; LAS int* lbase = lcnt + 32;
        const bool t32 = (wr == 0 && wc == 0 && fq < 2); const int t = fq * 16 + fr;
        if (t32) lcnt[t] = 0;
        __syncthreads();
        int e1[8], e2[8], r1[8], r2[8]; float g1[8], g2[8];
        const int row0 = u.pm * 256 + wr * 64 + fr;
        if (wc == 0) {
            float bias[8], c1v[8], c0v[8];
#pragma unroll
            for (int j = 0; j < 8; ++j) { bias[j] = rbias[8 * fq + j]; c1v[j] = rc[8 * fq + j]; c0v[j] = rc[32 + 8 * fq + j]; }
#pragma unroll
            for (int ai = 0; ai < 2; ++ai)
#pragma unroll
                for (int m = 0; m < 4; ++m) { const int i8 = ai * 4 + m;
                    const f32x4 v0 = acc[ai][0][m][0], v1 = acc[ai][0][m][1];
                    float mean, rstd;
                    {   const size_t r = (size_t)(row0 + ai * 128 + m * 16); const f32x4 a0 = *(const f32x4*)(stats + (r * 16 + 4 * fq) * 2), a1 = *(const f32x4*)(stats + (r * 16 + 4 * fq + 2) * 2);
                        float s1 = (a0[0] + a0[2]) + (a1[0] + a1[2]), s2 = (a0[1] + a0[3]) + (a1[1] + a1[3]);
                        s1 += __shfl_xor(s1, 16); s2 += __shfl_xor(s2, 16); s1 += __shfl_xor(s1, 32); s2 += __shfl_xor(s2, 32);
                        mean = s1 * (1.f / 1024.f); rstd = rsqrtf(fmaxf(s2 * (1.f / 1024.f) - mean * mean, 0.f) + LN_EPS); }
                    float s[8], sel[8];
#pragma unroll
                    for (int j = 0; j < 4; ++j) { s[j] = sigmoidf_(rstd * (v0[j] - mean * c1v[j]) + c0v[j]); s[4 + j] = sigmoidf_(rstd * (v1[j] - mean * c1v[4 + j]) + c0v[4 + j]); }
#pragma unroll
                    for (int j = 0; j < 8; ++j) sel[j] = s[j] + bias[j];
                    int i1 = 0; float m1 = sel[0];
#pragma unroll
                    for (int j = 1; j < 8; ++j) if (sel[j] > m1) { m1 = sel[j]; i1 = j; }
                    int i2 = (i1 == 0) ? 1 : 0; float m2 = (i1 == 0) ? sel[1] : sel[0];
#pragma unroll
                    for (int j = 0; j < 8; ++j) if (j != i1 && j != ((i1 == 0) ? 1 : 0) && sel[j] > m2) { m2 = sel[j]; i2 = j; }
                    float gs = m1 + m2; int gi = fq;
                    { const float os = __shfl_xor(gs, 16); const int oi = __shfl_xor(gi, 16); if (os > gs || (os == gs && oi < gi)) { gs = os; gi = oi; } }
                    { const float os = __shfl_xor(gs, 32); const int oi = __shfl_xor(gi, 32); if (os > gs || (os == gs && oi < gi)) { gs = os; gi = oi; } }
                    e1[i8] = -1; e2[i8] = -1; r1[i8] = 0; r2[i8] = 0; g1[i8] = 0.f; g2[i8] = 0.f;
                    if (gi == fq) {
                        float s1 = s[0], s2 = s[0];
#pragma unroll
                        for (int j = 0; j < 8; ++j) { s1 = (j == i1) ? s[j] : s1; s2 = (j == i2) ? s[j] : s2; }
                        const float inv = 1.0f / (s1 + s2);
                        e1[i8] = 8 * fq + i1; e2[i8] = 8 * fq + i2; g1[i8] = s1 * inv; g2[i8] = s2 * inv;
                        r1[i8] = __hip_atomic_fetch_add(lcnt + e1[i8], 1, __ATOMIC_RELAXED, __HIP_MEMORY_SCOPE_WORKGROUP);
                        r2[i8] = __hip_atomic_fetch_add(lcnt + e2[i8], 1, __ATOMIC_RELAXED, __HIP_MEMORY_SCOPE_WORKGROUP); } }
        }
        __syncthreads();
        if (t32) { const int c = lcnt[t]; lbase[t] = (c > 0) ? (int)atomicAdd(cnt + t, (unsigned)c) : 0; }
        __syncthreads();
        if (wc == 0) {
#pragma unroll
            for (int i8 = 0; i8 < 8; ++i8) if (e1[i8] >= 0) { const int r = row0 + (i8 >> 2) * 128 + (i8 & 3) * 16;
                u32x2 p1, p2; p1.x = (unsigned)(2 * r); p1.y = __float_as_uint(g1[i8]); p2.x = (unsigned)(2 * r + 1); p2.y = __float_as_uint(g2[i8]);
                *(u32x2*)(list + ((size_t)e1[i8] * T + lbase[e1[i8]] + r1[i8]) * 2) = p1; *(u32x2*)(list + ((size_t)e2[i8] * T + lbase[e2[i8]] + r2[i8]) * 2) = p2; } }
        __syncthreads();
    } };
__device__ __forceinline__ int build_tile_table(Frame& F, const unsigned* cnt) {
    volatile LAS int* tab = (volatile LAS int*)(F.lds + LDS_MISC + 64);
    __syncthreads();
    if (F.tid == 0) { int n = 0; for (int e = 0; e < NE; ++e) { const int c = (int)__hip_atomic_load(cnt + e, __ATOMIC_RELAXED, __HIP_MEMORY_SCOPE_AGENT); const int nt = (c + 255) >> 8; for (int j = 0; j < nt; ++j) tab[1 + n++] = (e << 16) | j; } tab[0] = n; }
    __syncthreads();
    return tab[0];
}
struct SchedMoe1 { const char* X1; const char* W; const int* list; const unsigned* cnt; LAS int* tab; int ntiles, G, v;
    __device__ __forceinline__ bool next(int i, ge::Unit& u) const { const int L = i * G + v, rt = L >> 2, pn = L & 3; if (rt >= ntiles) return false;
        const int ej = tab[1 + rt], e = ej >> 16, j = ej & 0xffff; const int c = (int)cnt[e];
        u.A = X1; u.gat = list + ((size_t)e * T + j * 256) * 2; u.gshift = 1; u.nvalid = (c - j * 256) < 256 ? (c - j * 256) : 256; u.lda = 1024; u.nt = 8;
        u.B = W + ((size_t)e * 1024 + (size_t)pn * 256) * 1024; u.ldb = 1024; u.pm = rt; u.pn = pn; u.aux = e; return true; } };
struct EpiMoe1 { static constexpr bool AFTER_DRAIN = false; unsigned char* H;
    typedef ge::NoPre Pre; __device__ __forceinline__ Pre prefetch(const ge::Unit&, int, int, int, int) const { return Pre{}; }
    __device__ __forceinline__ void operator()(const ge::Acc& acc, const ge::Unit& u, int wr, int wc, int fr, int fq, const Pre&) const {
        const int row0 = u.pm * 256 + wr * 64 + fr;
#pragma unroll
        for (int ai = 0; ai < 2; ++ai)
#pragma unroll
            for (int m = 0; m < 4; ++m) { const size_t r = (size_t)(row0 + ai * 128 + m * 16);
#pragma unroll
                for (int bj = 0; bj < 2; ++bj) { const int c = 128 * bj + 32 * wc + 8 * fq; const f32x4 v0 = acc[ai][bj][m][0], v1 = acc[ai][bj][m][1];
                    const float h0 = v0[0] * sigmoidf_(v0[0]) * v0[1], h1 = v0[2] * sigmoidf_(v0[2]) * v0[3], h2 = v1[0] * sigmoidf_(v1[0]) * v1[1], h3 = v1[2] * sigmoidf_(v1[2]) * v1[3];
                    *(unsigned*)(H + r * 512 + u.pn * 128 + (c >> 1)) = pack_fp8x4(h0, h1, h2, h3); }
                asm volatile("" ::: "memory"); }
    } };
struct SchedMoe2 { const char* H; const char* W; const int* list; const unsigned* cnt; LAS int* tab; int ntiles, G, v, ntk;
    __device__ __forceinline__ bool next(int i, ge::Unit& u) const { const int L = i * G + v, rt = L >> 2, pn = L & 3; if (rt >= ntiles) return false;
        const int ej = tab[1 + rt], e = ej >> 16, j = ej & 0xffff; const int c = (int)cnt[e];
        u.A = H + (size_t)rt * 256 * 512; u.gat = nullptr; u.gshift = 0; u.nvalid = (c - j * 256) < 256 ? (c - j * 256) : 256; u.lda = 512; u.nt = ntk;
        u.B = W + ((size_t)e * 1024 + (size_t)pn * 256) * 512; u.ldb = 512; u.pm = rt; u.pn = pn; u.aux = (e << 16) | j; return true; } };
template <int MODE> struct EpiMoe2T { static constexpr bool AFTER_DRAIN = false; const int* list; unsigned char* Y; int* inv;
    typedef ge::NoPre Pre; __device__ __forceinline__ Pre prefetch(const ge::Unit&, int, int, int, int) const { return Pre{}; }
    __device__ __forceinline__ void operator()(const ge::Acc& acc, const ge::Unit& u, int wr, int wc, int fr, int fq, const Pre&) const {
        const int e = u.aux >> 16, j = u.aux & 0xffff; const int* lst = list + ((size_t)e * T + j * 256) * 2;
        const unsigned row0 = (unsigned)u.pm * 256u + (unsigned)(wr * 64 + fr); const unsigned col0 = (unsigned)(u.pn * 256 + 32 * wc + 8 * fq);
        const bool invw = (u.pn == 0 && wc == 0 && fq == 0);
#pragma unroll
        for (int ai = 0; ai < 2; ++ai) {
            u32x2 sg[4];
#pragma unroll
            for (int m = 0; m < 4; ++m) { const int rr = ai * 128 + wr * 64 + m * 16 + fr; const u32x2 v = *(const u32x2*)(lst + 2 * (rr < u.nvalid ? rr : 0)); sg[m].x = (rr < u.nvalid) ? v.x : 0xffffffffu; sg[m].y = v.y; }
#pragma unroll
            for (int m = 0; m < 4; ++m) { const int sl = (int)sg[m].x; const float gg = __uint_as_float(sg[m].y);
                const unsigned yrow = row0 + (unsigned)(ai * 128 + m * 16);
                if (MODE == 1) { if (sl == 0x7ffffff0) Y[0] = (unsigned char)pack_fp8x4(acc[ai][0][m][0][0] * gg, 0.f, 0.f, 0.f); }
                else if (sl >= 0) {
                    if (invw) inv[sl] = (int)yrow;
#pragma unroll
                    for (int bj = 0; bj < 2; ++bj) { const f32x4 v0 = acc[ai][bj][m][0], v1 = acc[ai][bj][m][1];
                        const float g8 = 8.f * gg; u32x2 w; w.x = pack_fp8x4(g8 * v0[0], g8 * v0[1], g8 * v0[2], g8 * v0[3]); w.y = pack_fp8x4(g8 * v1[0], g8 * v1[1], g8 * v1[2], g8 * v1[3]);
                        *(u32x2*)(Y + (yrow * 1024u + col0 + 128u * bj)) = w; } } }
            asm volatile("" ::: "memory"); }
    } };
typedef EpiMoe2T<0> EpiMoe2;
typedef short bf16x4 __attribute__((ext_vector_type(4)));
#if DEBUG_MODE
#define DBGF(stage, val) do { const float v_ = (val); if (!(fabsf(v_) < 1e30f)) atomicOr((unsigned*)(F.ws + WS_CTL) + 12, 1u << (stage)); } while (0)
#else
#define DBGF(stage, val) do { } while (0)
#endif
#define MFMA16(a, b, c) __builtin_amdgcn_mfma_f32_16x16x16bf16_1k(a, b, c, 0, 0, 0)
#define MFMA32(a, b, c) __builtin_amdgcn_mfma_f32_16x16x32_bf16(a, b, c, 0, 0, 0)
__device__ __forceinline__ bf16x4 pack4(const f32x4 v) { u32x2 w; w.x = cvt_pk_bf16(v[0], v[1]); w.y = cvt_pk_bf16(v[2], v[3]); return __builtin_bit_cast(bf16x4, w); }
__device__ __forceinline__ f32x4 unpack4(const u32x2 w) { return (f32x4){bflo(w.x), bfhi(w.x), bflo(w.y), bfhi(w.y)}; }
constexpr int TP = 72;
constexpr int TILE_B = 64 * TP * 2;
constexpr int LA_ACT = 0;
constexpr int LA_AT = 13312, LA_RT = LA_AT + TILE_B, LA_BT = LA_RT + TILE_B, LA_KT = LA_BT + TILE_B;
constexpr int LA_BTT = LA_KT + TILE_B, LA_KTT = LA_BTT + TILE_B, LA_VT = LA_KTT + TILE_B;
constexpr int LA_AAB = LA_VT + TILE_B, LA_AAK = LA_AAB + TILE_B, LA_ARB = LA_AAK + TILE_B, LA_ARK = LA_ARB + TILE_B;
constexpr int LA_DIAG = LA_ARK + TILE_B;
constexpr int LA_TII = LA_DIAG + 4096;
constexpr int LA_SEG = LA_TII + 3072;
constexpr int LA_KSQ = LA_SEG + 4096;
constexpr int LA_RKP = LA_KSQ + 1024;
constexpr int LA_PC = LA_RKP + 1024;
static_assert(LA_PC + 256 <= LDS_STAGE, "pass A LDS map");

template <bool EONLY> __device__ __forceinline__ void phase_wkv_a(Frame& F, const Params& P, int l) {
    LAS unsigned char* lds = F.lds;
    const bf16_t* rkv = WSP(bf16_t, WS_RKV);
    const bf16_t* wupT = WSP(bf16_t, WS_LORA) + (size_t)l * 512 * 32;
    const bf16_t* aupT = WSP(bf16_t, WS_LORA) + (size_t)(4 + l) * 512 * 32;
    const bf16_t* vupT = WSP(bf16_t, WS_LORA) + (size_t)(8 + (l > 0 ? l - 1 : 0)) * 512 * 32;
    const float* mu = P.in[3] + (size_t)l * 1696; const float* muv = (l > 0) ? P.in[4] + (size_t)(l - 1) * 32 : nullptr;
    bf16_t* PHI = WSP(bf16_t, WS_PHI); bf16_t* PSI = WSP(bf16_t, WS_PSI); bf16_t* GT = WSP(bf16_t, WS_GT); bf16_t* Y0T = WSP(bf16_t, WS_Y0T); bf16_t* VT = WSP(bf16_t, WS_VT); bf16_t* VF = WSP(bf16_t, WS_VFIRST);
    float* RK = WSP(float, WS_RK);
    const int lane = F.lane, w = F.wave, cb = w & 3, th = w >> 2;
#define WKVA_RAW_LOAD(dst, hn) do { _Pragma("unroll") for (int i_ = 0; i_ < 4; ++i_) { const int p_ = F.tid + 512 * i_; const int pc_ = p_ < 1560 ? p_ : 1559; const int row_ = pc_ / 24, rem_ = pc_ % 24; \
        const int tok_ = (row_ == 0 && firstchunk) ? t0 : t0 - 1 + row_; dst[i_] = *(const u32x4*)(rkv + (size_t)tok_ * RKVW + (rem_ >> 3) * 512 + (hn) * 64 + (rem_ & 7) * 8); } } while (0)
#define WKVA_RAW_STORE(src) do { _Pragma("unroll") for (int i_ = 0; i_ < 4; ++i_) { const int p_ = F.tid + 512 * i_; if (p_ < 1560) { const int row_ = p_ / 24, rem_ = p_ % 24; \
        *(LAS u32x4*)(lds + LDS_RAW + (row_ * 192 + (rem_ >> 3) * 64 + (rem_ & 7) * 8) * 2) = src[i_]; } } } while (0)
    for (int unit = blockIdx.x; unit < T / 64; unit += F.G) {
        const int t0 = unit * 64; const bool firstchunk = (t0 & (SEQ - 1)) == 0;
        __syncthreads();
        { u32x4 r0_[4]; WKVA_RAW_LOAD(r0_, 0); WKVA_RAW_STORE(r0_); }
        for (int idx = F.tid; idx < 64 * 96; idx += 512) { const int tok = idx / 96, qq = idx % 96; const int col = (qq < 64) ? 1536 + qq : 1536 + 96 + qq;
            const int t = t0 + tok;
            const bool hp = (tok > 0 || !firstchunk); const float p = bf2f(rkv[(size_t)t * RKVW + col]); const float ppl = bf2f(rkv[(size_t)(hp ? t - 1 : t) * RKVW + col]); const float pp = hp ? ppl : 0.f;
            const float m_ = (qq < 64) ? mu[1536 + qq] : ((l > 0) ? P.in[4][(size_t)(l > 0 ? l - 1 : 0) * 32 + qq - 64] : 0.f);
            float val = p + (pp - p) * m_; if (qq < 32) val = tanhf(val);
            *(LAS bf16_t*)(lds + LA_ACT + (tok * 104 + qq) * 2) = f2bf(val); }
        __syncthreads();
        for (int h = 0; h < 8; ++h) {
            int lz = lane; asm volatile("" : "+v"(lz)); const int c = lz & 15, q = lz >> 4;
            const int chid = unit * 8 + h; const int ch = 16 * cb + c, chg = h * 64 + ch;
            f32x4 zw[2], za[2], zv[2];
            {   const bf16x8 bw = *(const bf16x8*)(wupT + (size_t)chg * 32 + 8 * q), ba = *(const bf16x8*)(aupT + (size_t)chg * 32 + 8 * q), bv = *(const bf16x8*)(vupT + (size_t)chg * 32 + 8 * q);
#pragma unroll
                for (int ii = 0; ii < 2; ++ii) { const int i = 2 * th + ii; const LAS unsigned char* ar = lds + LA_ACT + ((16 * i + c) * 104 + 8 * q) * 2;
                    const bf16x8 a0 = *(const LAS bf16x8*)(ar), a1 = *(const LAS bf16x8*)(ar + 64), a2 = *(const LAS bf16x8*)(ar + 128);
                    const f32x4 z = {0.f, 0.f, 0.f, 0.f};
                    zw[ii] = MFMA32(a0, bw, z); za[ii] = MFMA32(a1, ba, z); zv[ii] = MFMA32(a2, bv, z); } }
            const float mu_r = mu[chg], mu_k = mu[512 + chg], mu_v = mu[1024 + chg];
            const float w0 = P.in[5][(size_t)l * 512 + chg], a0_ = P.in[7][(size_t)l * 512 + chg], v0_ = (l > 0) ? P.in[10][(size_t)(l - 1) * 512 + chg] : 0.f;
            const float k_k = P.in[12][(size_t)l * 512 + chg], k_a = P.in[13][(size_t)l * 512 + chg], r_k = P.in[14][(size_t)l * 512 + chg];
            float rr[2][4], kh[2][4], vv[2][4], lw[2][4], ic[2][4], kkr[2][4];
#pragma unroll
            for (int ii = 0; ii < 2; ++ii) { const int i = 2 * th + ii; const int tl0 = 16 * i + 4 * q;
                const bool hasprev = (tl0 > 0) || !firstchunk;
                const LAS unsigned char* rb = lds + LDS_RAW + (tl0 * 192 + ch) * 2;
                const float lpr = bf2f(*(const LAS bf16_t*)(rb)), lpk = bf2f(*(const LAS bf16_t*)(rb + 128)), lpv = bf2f(*(const LAS bf16_t*)(rb + 256));
                float pr = hasprev ? lpr : 0.f, pk = hasprev ? lpk : 0.f, pv = hasprev ? lpv : 0.f;
                f32x4 vf = {0.f, 0.f, 0.f, 0.f};
                if (l > 0) vf = unpack4(*(const u32x2*)(VF + ((size_t)chid * 64 + ch) * 64 + tl0));
                float lsum = 0.f;
#pragma unroll
                for (int r = 0; r < 4; ++r) { const LAS unsigned char* rc_ = rb + (r + 1) * 384; const float cr = bf2f(*(const LAS bf16_t*)(rc_)), ck = bf2f(*(const LAS bf16_t*)(rc_ + 128)), cv = bf2f(*(const LAS bf16_t*)(rc_ + 256));
                    const float r_ = cr + (pr - cr) * mu_r, k_ = ck + (pk - ck) * mu_k; float v_ = cv + (pv - cv) * mu_v; pr = cr; pk = ck; pv = cv;
                    const float lw_ = -0.6065306597126334f * sigmoidf_(w0 + zw[ii][r]); const float icl = sigmoidf_(a0_ + za[ii][r]);
                    if (l > 0) v_ = v_ + (vf[r] - v_) * sigmoidf_(v0_ + zv[ii][r]);
                    const float kk_ = k_ * k_k, kh_ = k_ * (1.0f + (icl - 1.0f) * k_a);
                    rr[ii][r] = r_; kh[ii][r] = kh_; vv[ii][r] = v_; lw[ii][r] = lw_; ic[ii][r] = icl; kkr[ii][r] = kk_; lsum += lw_;
                    const float s1 = row16_sum(kk_ * kk_), s2 = row16_sum(r_ * kh_ * r_k);
                    *(LAS float*)(lds + LA_KSQ + (cb * 64 + tl0 + r) * 4) = s1; *(LAS float*)(lds + LA_RKP + (cb * 64 + tl0 + r) * 4) = s2; }
                *(LAS float*)(lds + LA_SEG + (ch * 16 + i * 4 + q) * 4) = lsum; }
            __syncthreads();
            u32x4 nraw[4]; if (h < 7) WKVA_RAW_LOAD(nraw, h + 1);
            {   float seg[16];
#pragma unroll
                for (int j4 = 0; j4 < 4; ++j4) { const f32x4 s4 = *(const LAS f32x4*)(lds + LA_SEG + (ch * 16 + 4 * j4) * 4); seg[4 * j4] = s4[0]; seg[4 * j4 + 1] = s4[1]; seg[4 * j4 + 2] = s4[2]; seg[4 * j4 + 3] = s4[3]; }
                float tot = 0.f;
#pragma unroll
                for (int j = 0; j < 16; ++j) tot += seg[j];
                if (th == 0) *(LAS float*)(lds + LA_PC + ch * 4) = __expf(tot);
                float mine[8];
#pragma unroll
                for (int j = 0; j < 8; ++j) mine[j] = th ? seg[8 + j] : seg[j];
                const float firsthalf = th ? (((seg[0] + seg[1]) + (seg[2] + seg[3])) + ((seg[4] + seg[5]) + (seg[6] + seg[7]))) : 0.f;
#pragma unroll
                for (int ii = 0; ii < 2; ++ii) { const int i = 2 * th + ii; const int tl0 = 16 * i + 4 * q; const int sidx = i * 4 + q;
                    float cum = firsthalf + (ii ? ((mine[0] + mine[1]) + (mine[2] + mine[3])) : 0.f);
                    { const float s0 = mine[4 * ii], s1 = mine[4 * ii + 1], s2 = mine[4 * ii + 2]; cum += (q > 0 ? s0 : 0.f) + (q > 1 ? s1 : 0.f) + (q > 2 ? s2 : 0.f); }
                    f32x4 at, rt, bt, kt;
#pragma unroll
                    for (int r = 0; r < 4; ++r) { const int tl = tl0 + r;
                        const float ks = (*(const LAS float*)(lds + LA_KSQ + tl * 4) + *(const LAS float*)(lds + LA_KSQ + (64 + tl) * 4)) + (*(const LAS float*)(lds + LA_KSQ + (128 + tl) * 4) + *(const LAS float*)(lds + LA_KSQ + (192 + tl) * 4));
                        const float kk_ = kkr[ii][r] * __builtin_amdgcn_rsqf(fmaxf(ks, 1e-24f));
                        const float cumx = cum; cum += lw[ii][r];
                        const float ex = __expf(cumx), ei = __expf(cum), en = __expf(-cum);
                        at[r] = -kk_ * ex; rt[r] = rr[ii][r] * ei; bt[r] = kk_ * ic[ii][r] * en; kt[r] = kh[ii][r] * en;
#if DEBUG_MODE
                        { bf16_t* dd = (bf16_t*)F.out; const size_t oo = (size_t)(t0 + tl) * 512 + chg; dd[oo] = f2bf(__expf(lw[ii][r])); dd[(size_t)T * 512 + oo] = f2bf(kk_ * ic[ii][r]); dd[(size_t)2 * T * 512 + oo] = f2bf(-kk_); }
#endif
                        DBGF(1, lw[ii][r]); DBGF(1, cum); DBGF(2, at[r]); DBGF(2, rt[r]); DBGF(2, bt[r]); DBGF(2, kt[r]);
                        *(LAS bf16_t*)(lds + LA_AT + (tl * TP + ch) * 2) = f2bf(at[r]); *(LAS bf16_t*)(lds + LA_RT + (tl * TP + ch) * 2) = f2bf(rt[r]);
                        *(LAS bf16_t*)(lds + LA_BT + (tl * TP + ch) * 2) = f2bf(bt[r]); *(LAS bf16_t*)(lds + LA_KT + (tl * TP + ch) * 2) = f2bf(kt[r]);
                        if (cb == 0) { const float rk = (*(const LAS float*)(lds + LA_RKP + tl * 4) + *(const LAS float*)(lds + LA_RKP + (64 + tl) * 4)) + (*(const LAS float*)(lds + LA_RKP + (128 + tl) * 4) + *(const LAS float*)(lds + LA_RKP + (192 + tl) * 4));
                            if (c == 0) RK[(size_t)(t0 + tl) * 8 + h] = rk; } }
                    const f32x4 v4 = {vv[ii][0], vv[ii][1], vv[ii][2], vv[ii][3]};
                    *(LAS bf16x4*)(lds + LA_BTT + (ch * TP + tl0) * 2) = pack4(bt); *(LAS bf16x4*)(lds + LA_KTT + (ch * TP + tl0) * 2) = pack4(kt); *(LAS bf16x4*)(lds + LA_VT + (ch * TP + tl0) * 2) = pack4(v4);
                    *(bf16x4*)(VT + ((size_t)chid * 64 + ch) * 64 + tl0) = pack4(v4);
                    if (l == 0) *(bf16x4*)(VF + ((size_t)chid * 64 + ch) * 64 + tl0) = pack4(v4); } }
            __syncthreads();
            if (EONLY) { if (h < 7) WKVA_RAW_STORE(nraw); __syncthreads(); continue; }
            {   const bool isR = w >= 4; const int i = w & 3;
                const LAS unsigned char* brow = lds + (isR ? LA_RT : LA_AT) + ((16 * i + c) * TP + 8 * q) * 2;
                const bf16x8 bf0 = *(const LAS bf16x8*)(brow), bf1 = *(const LAS bf16x8*)(brow + 64);
                LAS unsigned char* ob = lds + (isR ? LA_ARB : LA_AAB); LAS unsigned char* ok = lds + (isR ? LA_ARK : LA_AAK);
                const int tloc = 16 * i + c;
#pragma unroll
                for (int j = 0; j < 4; ++j) { f32x4 db = {0.f, 0.f, 0.f, 0.f}, dk = {0.f, 0.f, 0.f, 0.f};
                    if (j <= i) { const LAS unsigned char* arb = lds + LA_BT + ((16 * j + c) * TP + 8 * q) * 2; const LAS unsigned char* ark = lds + LA_KT + ((16 * j + c) * TP + 8 * q) * 2;
                        db = MFMA32(*(const LAS bf16x8*)(arb), bf0, db); db = MFMA32(*(const LAS bf16x8*)(arb + 64), bf1, db);
                        dk = MFMA32(*(const LAS bf16x8*)(ark), bf0, dk); dk = MFMA32(*(const LAS bf16x8*)(ark + 64), bf1, dk);
                        if (j == i) {
#pragma unroll
                            for (int r = 0; r < 4; ++r) { const int s = 16 * j + 4 * q + r; const bool keep = isR ? (s <= tloc) : (s < tloc); db[r] = keep ? db[r] : 0.f; dk[r] = keep ? dk[r] : 0.f; }
                            if (!isR) *(LAS f32x4*)(lds + LA_DIAG + ((i * 16 + c) * 16 + 4 * q) * 4) = db; } }
                    DBGF(3, db[0] + db[1] + db[2] + db[3]); DBGF(3, dk[0] + dk[1] + dk[2] + dk[3]);
                    *(LAS bf16x4*)(ob + (tloc * TP + 16 * j + 4 * q) * 2) = pack4(db); *(LAS bf16x4*)(ok + (tloc * TP + 16 * j + 4 * q) * 2) = pack4(dk); } }
            __syncthreads();
            f32x4 X[4];
            if (w == 0) { const int blk = q, jc = c; float tc[16];
                f32x4 Lr[15][4];
#pragma unroll
                for (int t = 1; t < 16; ++t)
#pragma unroll
                    for (int s4 = 0; s4 < 4; ++s4) if (4 * s4 < t) Lr[t - 1][s4] = *(const LAS f32x4*)(lds + LA_DIAG + ((blk * 16 + t) * 16 + 4 * s4) * 4);
                __builtin_amdgcn_sched_barrier(0);
#pragma unroll
                for (int s = 0; s < 16; ++s) tc[s] = (s == jc) ? 1.f : 0.f;
#pragma unroll
                for (int t = 1; t < 16; ++t) { float val = 0.f;
#pragma unroll
                    for (int s4 = 0; s4 < 4; ++s4) if (4 * s4 < t) { const f32x4 L = Lr[t - 1][s4];
#pragma unroll
                        for (int e = 0; e < 4; ++e) if (4 * s4 + e < t) val += L[e] * tc[4 * s4 + e]; }
                    tc[t] += val; }
#pragma unroll
                for (int t = 0; t < 16; ++t) { DBGF(4, tc[t]); *(LAS bf16_t*)(lds + LA_TII + ((blk * 16 + t) * 24 + jc) * 2) = f2bf(tc[t]); } }
            if (w < 4) {
#pragma unroll
                for (int i = 0; i < 4; ++i)
#pragma unroll
                    for (int r = 0; r < 4; ++r) X[i][r] = bf2f(*(const LAS bf16_t*)(lds + LA_AT + ((16 * i + 4 * q + r) * TP + 16 * w + c) * 2));
            } else { const int vb = w - 4; const LAS unsigned char* vrow = lds + LA_VT + ((16 * vb + c) * TP + 8 * q) * 2;
                const bf16x8 v0 = *(const LAS bf16x8*)(vrow), v1 = *(const LAS bf16x8*)(vrow + 64);
#pragma unroll
                for (int i = 0; i < 4; ++i) { const LAS unsigned char* arow = lds + LA_AAK + ((16 * i + c) * TP + 8 * q) * 2; f32x4 d = {0.f, 0.f, 0.f, 0.f};
                    d = MFMA32(*(const LAS bf16x8*)(arow), v0, d); d = MFMA32(*(const LAS bf16x8*)(arow + 64), v1, d); X[i] = d; } }
            DBGF(5, (X[0][0] + X[1][1]) + (X[2][2] + X[3][3]));
            __syncthreads();
            bf16x4 Xb[4];
            {   bf16x4 Af[6], Tf[4];
#pragma unroll
                for (int i = 1; i < 4; ++i)
#pragma unroll
                    for (int j = 0; j < 3; ++j) if (j < i) Af[(i * (i - 1)) / 2 + j] = *(const LAS bf16x4*)(lds + LA_AAB + ((16 * i + c) * TP + 16 * j + 4 * q) * 2);
#pragma unroll
                for (int i = 0; i < 4; ++i) Tf[i] = *(const LAS bf16x4*)(lds + LA_TII + ((i * 16 + c) * 24 + 4 * q) * 2);
                __builtin_amdgcn_sched_barrier(0);
#pragma unroll
                for (int i = 0; i < 4; ++i) { f32x4 y = X[i];
#pragma unroll
                    for (int j = 0; j < 3; ++j) if (j < i) y = MFMA16(Af[(i * (i - 1)) / 2 + j], Xb[j], y);
                    const f32x4 z = {0.f, 0.f, 0.f, 0.f};
                    X[i] = MFMA16(Tf[i], pack4(y), z); Xb[i] = pack4(X[i]); } }
            DBGF(6, (X[0][0] + X[1][1]) + (X[2][2] + X[3][3]));
            if (w < 4) {
                {   bf16x4 Bf[16]; float pcv[4];
#pragma unroll
                    for (int kb = 0; kb < 4; ++kb) { pcv[kb] = *(const LAS float*)(lds + LA_PC + (16 * kb + c) * 4);
#pragma unroll
                        for (int j = 0; j < 4; ++j) Bf[kb * 4 + j] = *(const LAS bf16x4*)(lds + LA_BTT + ((16 * kb + c) * TP + 16 * j + 4 * q) * 2); }
                    __builtin_amdgcn_sched_barrier(0);
#pragma unroll
                    for (int kb = 0; kb < 4; ++kb) { f32x4 d = {0.f, 0.f, 0.f, 0.f};
#pragma unroll
                        for (int j = 0; j < 4; ++j) d = MFMA16(Xb[j], Bf[kb * 4 + j], d);
                        const int ko = 16 * kb + c; const float pc = pcv[kb];
#pragma unroll
                        for (int r = 0; r < 4; ++r) d[r] = pc * (d[r] + ((16 * w + 4 * q + r) == ko ? 1.f : 0.f));
                        DBGF(7, d[0] + d[1] + d[2] + d[3]);
                        *(bf16x4*)(PHI + ((size_t)chid * 64 + ko) * 64 + 16 * w + 4 * q) = pack4(d); } }
                {   bf16x4 Rf[16]; u32x2 Rt[4];
#pragma unroll
                    for (int tb = 0; tb < 4; ++tb) { Rt[tb] = *(const LAS u32x2*)(lds + LA_RT + ((16 * tb + c) * TP + 16 * w + 4 * q) * 2);
#pragma unroll
                        for (int j = 0; j < 4; ++j) Rf[tb * 4 + j] = *(const LAS bf16x4*)(lds + LA_ARB + ((16 * tb + c) * TP + 16 * j + 4 * q) * 2); }
                    __builtin_amdgcn_sched_barrier(0);
#pragma unroll
                    for (int tb = 0; tb < 4; ++tb) { f32x4 d = unpack4(Rt[tb]);
#pragma unroll
                        for (int j = 0; j < 4; ++j) d = MFMA16(Xb[j], Rf[tb * 4 + j], d);
                        *(bf16x4*)(PSI + ((size_t)chid * 64 + 16 * tb + c) * 64 + 16 * w + 4 * q) = pack4(d); } }
            } else { const int vb = w - 4;
                bf16x4 Vb[4];
#pragma unroll
                for (int j = 0; j < 4; ++j) Vb[j] = *(const LAS bf16x4*)(lds + LA_VT + ((16 * vb + c) * TP + 16 * j + 4 * q) * 2);
                {   bf16x4 Bf[16], Kf[16]; f32x4 pcv[4];
#pragma unroll
                    for (int kb = 0; kb < 4; ++kb) { pcv[kb] = *(const LAS f32x4*)(lds + LA_PC + (16 * kb + 4 * q) * 4);
#pragma unroll
                        for (int j = 0; j < 4; ++j) { Bf[kb * 4 + j] = *(const LAS bf16x4*)(lds + LA_BTT + ((16 * kb + c) * TP + 16 * j + 4 * q) * 2); Kf[kb * 4 + j] = *(const LAS bf16x4*)(lds + LA_KTT + ((16 * kb + c) * TP + 16 * j + 4 * q) * 2); } }
                    __builtin_amdgcn_sched_barrier(0);
#pragma unroll
                    for (int kb = 0; kb < 4; ++kb) { f32x4 d = {0.f, 0.f, 0.f, 0.f};
#pragma unroll
                        for (int j = 0; j < 4; ++j) { d = MFMA16(Bf[kb * 4 + j], Xb[j], d); d = MFMA16(Kf[kb * 4 + j], Vb[j], d); }
                        *(bf16x4*)(GT + ((size_t)chid * 64 + 16 * vb + c) * 64 + 16 * kb + 4 * q) = pack4(d * pcv[kb]); } }
                {   bf16x4 Rf[16], Kf[16];
#pragma unroll
                    for (int tb = 0; tb < 4; ++tb)
#pragma unroll
                        for (int j = 0; j < 4; ++j) { Rf[tb * 4 + j] = *(const LAS bf16x4*)(lds + LA_ARB + ((16 * tb + c) * TP + 16 * j + 4 * q) * 2); Kf[tb * 4 + j] = *(const LAS bf16x4*)(lds + LA_ARK + ((16 * tb + c) * TP + 16 * j + 4 * q) * 2); }
                    __builtin_amdgcn_sched_barrier(0);
#pragma unroll
                    for (int tb = 0; tb < 4; ++tb) { f32x4 d = {0.f, 0.f, 0.f, 0.f};
#pragma unroll
                        for (int j = 0; j < 4; ++j) { d = MFMA16(Rf[tb * 4 + j], Xb[j], d); d = MFMA16(Kf[tb * 4 + j], Vb[j], d); }
                        *(bf16x4*)(Y0T + ((size_t)chid * 64 + 16 * vb + c) * 64 + 16 * tb + 4 * q) = pack4(d); } } }
            if (h < 7) WKVA_RAW_STORE(nraw);
            __syncthreads();
        }
    }
#undef WKVA_RAW_LOAD
#undef WKVA_RAW_STORE
}
__device__ __forceinline__ void phase_wkv_b(Frame& F, const Params& P) {
    const bf16_t* PHI = WSP(bf16_t, WS_PHI); const bf16_t* GT = WSP(bf16_t, WS_GT); bf16_t* MT = WSP(bf16_t, WS_MT);
    LAS unsigned char* lds = F.lds;
    const int lane = F.lane, c = lane & 15, q = lane >> 4, w = F.wave, tid = F.tid;
    const int pair = w >> 2, vb = w & 3; const int bh = (int)blockIdx.x * 2 + pair, b = bh >> 3, h = bh & 7;
    const int lrow = tid >> 3, lcol = (tid & 7) * 16;
    f32x4 M[4];
#pragma unroll
    for (int i = 0; i < 4; ++i) M[i] = (f32x4){0.f, 0.f, 0.f, 0.f};
    u32x4 rA[4], rB[4];
#define WKVB_LD(r_, ckk) do { const int ck_ = (ckk) < 32 ? (ckk) : 31; _Pragma("unroll") for (int ti = 0; ti < 4; ++ti) { const int bh_ = (int)blockIdx.x * 2 + (ti >> 1); \
        const size_t chl_ = (size_t)((bh_ >> 3) * 32 + ck_) * 8 + (bh_ & 7); r_[ti] = *(const u32x4*)(((ti & 1) ? GT : PHI) + chl_ * 4096 + (size_t)tid * 8); } } while (0)
#define WKVB_ST(r_, buf) do { _Pragma("unroll") for (int ti = 0; ti < 4; ++ti) *(LAS u32x4*)(lds + ((buf) * 4 + ti) * TILE_B + lrow * (TP * 2) + lcol) = r_[ti]; } while (0)
#define WKVB_STEP(buf, ckk) do { const size_t chs_ = (size_t)(b * 32 + (ckk)) * 8 + h; bf16x4 Mb[4]; \
        const LAS unsigned char* tp_ = lds + ((buf) * 4 + pair * 2) * TILE_B; const LAS unsigned char* tg_ = tp_ + TILE_B; \
        _Pragma("unroll") for (int i = 0; i < 4; ++i) { Mb[i] = pack4(M[i]); *(bf16x4*)(MT + (chs_ * 64 + 16 * vb + c) * 64 + 16 * i + 4 * q) = Mb[i]; } \
        _Pragma("unroll") for (int i = 0; i < 4; ++i) { f32x4 d = unpack4(*(const LAS u32x2*)(tg_ + (16 * vb + c) * (TP * 2) + (16 * i + 4 * q) * 2)); \
            _Pragma("unroll") for (int j = 0; j < 4; ++j) d = MFMA16(*(const LAS bf16x4*)(tp_ + (16 * i + c) * (TP * 2) + (16 * j + 4 * q) * 2), Mb[j], d); M[i] = d; } } while (0)
    WKVB_LD(rA, 0); WKVB_LD(rB, 1);
    __syncthreads();
    for (int ck = 0; ck < 32; ck += 2) {
        WKVB_ST(rA, 0); __syncthreads(); WKVB_LD(rA, ck + 2); WKVB_STEP(0, ck);
        WKVB_ST(rB, 1); __syncthreads(); WKVB_LD(rB, ck + 3); WKVB_STEP(1, ck + 1);
    }
    __syncthreads();
#undef WKVB_LD
#undef WKVB_ST
#undef WKVB_STEP
}
constexpr int LC_SGL = 0;
constexpr int LC_OT = 13312;
__device__ __forceinline__ void phase_wkv_c(Frame& F, const Params& P, int l) {
    LAS unsigned char* lds = F.lds;
    const bf16_t* rkv = WSP(bf16_t, WS_RKV);
    const bf16_t* gupT = WSP(bf16_t, WS_LORA) + (size_t)11 * 512 * 32 + (size_t)l * 512 * 96;
    const bf16_t* PSI = WSP(bf16_t, WS_PSI); const bf16_t* Y0T = WSP(bf16_t, WS_Y0T); const bf16_t* VT = WSP(bf16_t, WS_VT); const bf16_t* MT = WSP(bf16_t, WS_MT);
    const float* RK = WSP(float, WS_RK); unsigned char* outa = WSP(unsigned char, WS_OUTA);
    const float* mu = P.in[3] + (size_t)l * 1696;
    const int lane = F.lane, h = F.wave;
    LAS unsigned char* ot = lds + LC_OT + h * TILE_B;
    for (int unit = blockIdx.x; unit < T / 64; unit += F.G) {
        int lz = lane; asm volatile("" : "+v"(lz)); const int c = lz & 15, q = lz >> 4;
        float gng[4], gnb[4];
#pragma unroll
        for (int vb = 0; vb < 4; ++vb) { gng[vb] = P.in[15][(size_t)l * 512 + h * 64 + 16 * vb + c]; gnb[vb] = P.in[16][(size_t)l * 512 + h * 64 + 16 * vb + c]; }
        const int t0 = unit * 64; const bool firstchunk = (t0 & (SEQ - 1)) == 0; const size_t chid = (size_t)unit * 8 + h;
        __syncthreads();
        for (int idx = F.tid; idx < 64 * 96; idx += 512) { const int tok = idx / 96, qq = idx % 96; const int col = 1536 + 64 + qq; const int t = t0 + tok;
            const bool hp = (tok > 0 || !firstchunk); const float p = bf2f(rkv[(size_t)t * RKVW + col]); const float ppl = bf2f(rkv[(size_t)(hp ? t - 1 : t) * RKVW + col]); const float pp = hp ? ppl : 0.f;
            *(LAS bf16_t*)(lds + LC_SGL + (tok * 104 + qq) * 2) = f2bf(sigmoidf_(p + (pp - p) * mu[1536 + 64 + qq])); }
        __syncthreads();
        float rkv_[16];
#pragma unroll
        for (int i = 0; i < 16; ++i) rkv_[i] = RK[(size_t)(t0 + 16 * (i >> 2) + 4 * q + (i & 3)) * 8 + h];
        bf16x4 Mf[16];
#pragma unroll
        for (int j = 0; j < 4; ++j)
#pragma unroll
            for (int vb = 0; vb < 4; ++vb) Mf[j * 4 + vb] = *(const bf16x4*)(MT + (chid * 64 + 16 * vb + c) * 64 + 16 * j + 4 * q);
        bf16x8 Gf[12];
#pragma unroll
        for (int vb = 0; vb < 4; ++vb)
#pragma unroll
            for (int ks = 0; ks < 3; ++ks) Gf[vb * 3 + ks] = *(const bf16x8*)(gupT + (size_t)(h * 64 + 16 * vb + c) * 96 + 32 * ks + 8 * q);
#pragma unroll
        for (int tb = 0; tb < 4; ++tb) {
            bf16x4 Pf[4];
#pragma unroll
            for (int j = 0; j < 4; ++j) Pf[j] = *(const bf16x4*)(PSI + (chid * 64 + 16 * tb + c) * 64 + 16 * j + 4 * q);
            f32x4 y[4], gt[4], vv[4];
#pragma unroll
            for (int vb = 0; vb < 4; ++vb) { y[vb] = unpack4(*(const u32x2*)(Y0T + (chid * 64 + 16 * vb + c) * 64 + 16 * tb + 4 * q)); vv[vb] = unpack4(*(const u32x2*)(VT + (chid * 64 + 16 * vb + c) * 64 + 16 * tb + 4 * q));
#pragma unroll
                for (int j = 0; j < 4; ++j) y[vb] = MFMA16(Pf[j], Mf[j * 4 + vb], y[vb]); }
            {   const LAS unsigned char* ar = lds + LC_SGL + ((16 * tb + c) * 104 + 8 * q) * 2;
                const bf16x8 a0 = *(const LAS bf16x8*)(ar), a1 = *(const LAS bf16x8*)(ar + 64), a2 = *(const LAS bf16x8*)(ar + 128);
#pragma unroll
                for (int vb = 0; vb < 4; ++vb) { f32x4 d = {0.f, 0.f, 0.f, 0.f}; d = MFMA32(a0, Gf[vb * 3], d); d = MFMA32(a1, Gf[vb * 3 + 1], d); d = MFMA32(a2, Gf[vb * 3 + 2], d); gt[vb] = d; } }
#pragma unroll
            for (int r = 0; r < 4; ++r) { const int tl = 16 * tb + 4 * q + r;
#if DEBUG_MODE
                { bf16_t* yd = WSP(bf16_t, DBG_YDBG) + (size_t)(t0 + tl) * 512 + h * 64; yd[c] = f2bf(y[0][r]); yd[16 + c] = f2bf(y[1][r]); yd[32 + c] = f2bf(y[2][r]); yd[48 + c] = f2bf(y[3][r]); }
#endif
                const float s = row16_sum((y[0][r] + y[1][r]) + (y[2][r] + y[3][r])); const float mean = s * (1.f / 64.f);
                const float d0 = y[0][r] - mean, d1 = y[1][r] - mean, d2 = y[2][r] - mean, d3 = y[3][r] - mean;
                const float var = row16_sum((d0 * d0 + d1 * d1) + (d2 * d2 + d3 * d3)) * (1.f / 64.f); const float rstd = rsqrtf(var + GN_EPS);
                const float rk = rkv_[tb * 4 + r];
                const float o0 = (d0 * rstd * gng[0] + gnb[0] + rk * vv[0][r]) * gt[0][r], o1 = (d1 * rstd * gng[1] + gnb[1] + rk * vv[1][r]) * gt[1][r];
                const float o2 = (d2 * rstd * gng[2] + gnb[2] + rk * vv[2][r]) * gt[2][r], o3 = (d3 * rstd * gng[3] + gnb[3] + rk * vv[3][r]) * gt[3][r];
                const unsigned pq = pack_fp8x4(4.f * o0, 4.f * o1, 4.f * o2, 4.f * o3);
                *(LAS unsigned char*)(ot + tl * 80 + c) = (unsigned char)pq; *(LAS unsigned char*)(ot + tl * 80 + 16 + c) = (unsigned char)(pq >> 8);
                *(LAS unsigned char*)(ot + tl * 80 + 32 + c) = (unsigned char)(pq >> 16); *(LAS unsigned char*)(ot + tl * 80 + 48 + c) = (unsigned char)(pq >> 24); }
        }
        asm volatile("s_waitcnt lgkmcnt(0)" ::: "memory");
        {   const LAS unsigned char* rowp = ot + lane * 80; unsigned char* dst = outa + (size_t)(t0 + lane) * 512 + h * 64;
#pragma unroll
            for (int m4 = 0; m4 < 4; ++m4) *(u32x4*)(dst + 16 * m4) = *(const LAS u32x4*)(rowp + 16 * m4); }
    }
    __syncthreads();
}
#if DEBUG_MODE
__device__ __forceinline__ void dbg_prep(Frame& F, const Params& P, int l) {
    LAS float* lora = (LAS float*)F.lds;
    const bf16_t* rkv = WSP(bf16_t, WS_RKV);
    const int c = F.tid;
    const float* mu = P.in[3] + (size_t)l * 1696; const float* muv = (l > 0) ? P.in[4] + (size_t)(l - 1) * 32 : nullptr;
    bf16_t* sv = WSP(bf16_t, WS_SV); bf16_t* sa = WSP(bf16_t, WS_SA); bf16_t* sb = WSP(bf16_t, WS_SB); bf16_t* sr = WSP(bf16_t, WS_SR); bf16_t* sk = WSP(bf16_t, WS_SK); bf16_t* sg = WSP(bf16_t, WS_SG);
    float* sw = WSP(float, WS_SW); float* rkb = WSP(float, DBG_RKREF); bf16_t* vfirst = WSP(bf16_t, WS_VFIRST);
    for (int grp = blockIdx.x; grp < T / 64; grp += F.G) {
        const int t0 = grp * 64;
        __syncthreads();
        for (int idx = F.tid; idx < 64 * 192; idx += 512) { const int tok = idx / 192, q = idx % 192; const int t = t0 + tok;
            const float p = bf2f(rkv[(size_t)t * RKVW + 1536 + q]); const float pp = ((t & (SEQ - 1)) != 0) ? bf2f(rkv[(size_t)(t - 1) * RKVW + 1536 + q]) : 0.f;
            const float m_ = (q < 160) ? mu[1536 + q] : (muv ? muv[q - 160] : 0.f);
            float val = p + (pp - p) * m_;
            if (q < 32) val = tanhf(val); else if (q >= 64 && q < 160) val = sigmoidf_(val);
            lora[tok * 192 + q] = val; }
        __syncthreads();
        {
            unsigned cc = c; asm volatile("" : "+v"(cc));
            float col[32]; const float w0 = P.in[5][(size_t)l * 512 + c];
#pragma unroll
            for (int i = 0; i < 32; ++i) col[i] = (P.in[6] + (size_t)l * 32 * 512)[(unsigned)(i * 512) + cc];
            for (int tok = 0; tok < 64; ++tok) { const LAS float* lr = lora + tok * 192; float z = w0;
#pragma unroll
                for (int i = 0; i < 32; ++i) z += lr[i] * col[i];
                sw[(size_t)(t0 + tok) * 512 + c] = __expf(-0.6065306597126334f * sigmoidf_(z)); }
            asm volatile("" ::: "memory"); }
        {
            unsigned cc = c; asm volatile("" : "+v"(cc));
            float col[32]; const float a0 = P.in[7][(size_t)l * 512 + c];
            const float mu_r = mu[c], mu_k = mu[512 + c];
            const float k_k = P.in[12][(size_t)l * 512 + c], k_a = P.in[13][(size_t)l * 512 + c], r_k = P.in[14][(size_t)l * 512 + c];
#pragma unroll
            for (int i = 0; i < 32; ++i) col[i] = (P.in[8] + (size_t)l * 32 * 512)[(unsigned)(i * 512) + cc];
            for (int tok = 0; tok < 64; ++tok) { const int t = t0 + tok; const bool first = (t & (SEQ - 1)) == 0;
                const size_t ro = (size_t)t * RKVW, rp = (size_t)(t - 1) * RKVW;
                const float pr = bf2f(rkv[ro + c]), pk = bf2f(rkv[ro + 512 + c]);
                const float qr = first ? 0.f : bf2f(rkv[rp + c]), qk = first ? 0.f : bf2f(rkv[rp + 512 + c]);
                const float r = pr + (qr - pr) * mu_r, k = pk + (qk - pk) * mu_k;
                const LAS float* lr = lora + tok * 192 + 32; float z = a0;
#pragma unroll
                for (int i = 0; i < 32; ++i) z += lr[i] * col[i];
                const float iclr = sigmoidf_(z);
                float kk = k * k_k; const float ss = wave_sum(kk * kk); kk = kk / fmaxf(sqrtf(ss), 1e-12f);
                const float kh = k * (1.0f + (iclr - 1.0f) * k_a);
                const float rks = wave_sum(r * kh * r_k);
                const size_t o = (size_t)t * 512 + c;
                sr[o] = f2bf(r); sk[o] = f2bf(kh); sa[o] = f2bf(-kk); sb[o] = f2bf(kk * iclr);
                if (F.lane == 0) rkb[(size_t)t * 8 + F.wave] = rks; }
            asm volatile("" ::: "memory"); }
        {
            unsigned cc = c; asm volatile("" : "+v"(cc));
            float col[32]; const float v0 = (l > 0) ? P.in[10][(size_t)(l - 1) * 512 + c] : 0.f; const float mu_v = mu[1024 + c];
#pragma unroll
            for (int i = 0; i < 32; ++i) col[i] = (l > 0) ? (P.in[11] + (size_t)(l - 1) * 32 * 512)[(unsigned)(i * 512) + cc] : 0.f;
            for (int tok = 0; tok < 64; ++tok) { const int t = t0 + tok; const bool first = (t & (SEQ - 1)) == 0;
                const float pv = bf2f(rkv[(size_t)t * RKVW + 1024 + c]); const float qv = first ? 0.f : bf2f(rkv[(size_t)(t - 1) * RKVW + 1024 + c]);
                float v = pv + (qv - pv) * mu_v;
                const size_t o = (size_t)t * 512 + c;
                if (l == 0) vfirst[o] = f2bf(v);
                else { const LAS float* lr = lora + tok * 192 + 160; float z = v0;
#pragma unroll
                    for (int i = 0; i < 32; ++i) z += lr[i] * col[i];
                    v = v + (bf2f(vfirst[o]) - v) * sigmoidf_(z); }
                sv[o] = f2bf(v); }
            asm volatile("" ::: "memory"); }
        {
            unsigned cc = c; asm volatile("" : "+v"(cc));
            float col[96];
#pragma unroll
            for (int i = 0; i < 96; ++i) col[i] = (P.in[9] + (size_t)l * 96 * 512)[(unsigned)(i * 512) + cc];
            for (int tok = 0; tok < 64; ++tok) { const LAS float* lr = lora + tok * 192 + 64; float g = 0.f;
#pragma unroll
                for (int i = 0; i < 96; ++i) g += lr[i] * col[i];
                sg[(size_t)(t0 + tok) * 512 + c] = f2bf(g); }
            asm volatile("" ::: "memory"); }
    }
    __syncthreads();
}
__device__ __forceinline__ void dbg_scan(Frame& F, const Params& P, int l, int wg0, int nwg) {
    constexpr int CH = 32;
    LAS float* buf = (LAS float*)F.lds;
    LAS float* ybuf = (LAS float*)(F.lds + 2 * 6 * CH * 64 * 4);
    const bf16_t* sv = WSP(bf16_t, WS_SV); const bf16_t* sa = WSP(bf16_t, WS_SA); const bf16_t* sb = WSP(bf16_t, WS_SB); const bf16_t* sr = WSP(bf16_t, WS_SR); const bf16_t* sk = WSP(bf16_t, WS_SK); const bf16_t* sg = WSP(bf16_t, WS_SG);
    const float* sw = WSP(float, WS_SW); const float* rkb = WSP(float, DBG_RKREF); bf16_t* outa = WSP(bf16_t, DBG_OUTAREF);
    const float* gn_g = P.in[15] + (size_t)l * 512; const float* gn_b = P.in[16] + (size_t)l * 512;
    int bh0 = __builtin_amdgcn_readfirstlane((int)blockIdx.x - wg0);
    for (int bh = bh0; bh < 128; bh += nwg) {
        const int b = bh >> 3, h = bh & 7; const size_t tb = (size_t)b * SEQ;
        const int ltok = F.tid >> 4, lch = (F.tid & 15) * 4;
        float S[8];
#pragma unroll
        for (int j = 0; j < 8; ++j) S[j] = 0.f;
        const int i8 = F.lane >> 3, seg = F.lane & 7, vrow = 8 * F.wave + i8;
        u32x2 pre_b[5]; f32x4 pre_w;
        __syncthreads();
        {   const size_t o = (tb + ltok) * 512 + h * 64 + lch;
            pre_b[0] = *(const u32x2*)(sr + o); pre_b[1] = *(const u32x2*)(sk + o); pre_b[2] = *(const u32x2*)(sv + o); pre_b[3] = *(const u32x2*)(sa + o); pre_b[4] = *(const u32x2*)(sb + o); pre_w = *(const f32x4*)(sw + o);
            LAS float* d = buf + ltok * 64 + lch;
#pragma unroll
            for (int a = 0; a < 5; ++a) { *(LAS f32x4*)(d + a * CH * 64) = (f32x4){bflo(pre_b[a].x), bfhi(pre_b[a].x), bflo(pre_b[a].y), bfhi(pre_b[a].y)}; }
            *(LAS f32x4*)(d + 5 * CH * 64) = pre_w; }
        __syncthreads();
        for (int ck = 0; ck < SEQ / CH; ++ck) {
            const int cur = ck & 1; const LAS float* cb = buf + cur * 6 * CH * 64;
            if (ck + 1 < SEQ / CH) { const size_t o = (tb + (ck + 1) * CH + ltok) * 512 + h * 64 + lch;
                pre_b[0] = *(const u32x2*)(sr + o); pre_b[1] = *(const u32x2*)(sk + o); pre_b[2] = *(const u32x2*)(sv + o); pre_b[3] = *(const u32x2*)(sa + o); pre_b[4] = *(const u32x2*)(sb + o); pre_w = *(const f32x4*)(sw + o); }
            if ((ck & 1) == 0) { float* mr = WSP(float, DBG_MREF) + ((size_t)((b * 32 + (ck >> 1)) * 8 + h)) * 4096;
#pragma unroll
                for (int j = 0; j < 8; ++j) mr[(size_t)(8 * seg + j) * 64 + vrow] = S[j]; }
            for (int tok = 0; tok < CH; ++tok) {
                const LAS float* p = cb + tok * 64 + seg * 8;
                const f32x4 r0 = *(const LAS f32x4*)(p), r1 = *(const LAS f32x4*)(p + 4);
                const f32x4 k0 = *(const LAS f32x4*)(p + CH * 64), k1 = *(const LAS f32x4*)(p + CH * 64 + 4);
                const float vv = cb[2 * CH * 64 + tok * 64 + vrow];
                const f32x4 a0 = *(const LAS f32x4*)(p + 3 * CH * 64), a1 = *(const LAS f32x4*)(p + 3 * CH * 64 + 4);
                const f32x4 b0 = *(const LAS f32x4*)(p + 4 * CH * 64), b1 = *(const LAS f32x4*)(p + 4 * CH * 64 + 4);
                const f32x4 w0 = *(const LAS f32x4*)(p + 5 * CH * 64), w1 = *(const LAS f32x4*)(p + 5 * CH * 64 + 4);
                float sa_ = 0.f;
#pragma unroll
                for (int j = 0; j < 4; ++j) { sa_ += S[j] * a0[j]; sa_ += S[4 + j] * a1[j]; }
                sa_ = reduce8(sa_);
                float y = 0.f;
#pragma unroll
                for (int j = 0; j < 4; ++j) { S[j] = S[j] * w0[j] + (sa_ * b0[j] + vv * k0[j]); S[4 + j] = S[4 + j] * w1[j] + (sa_ * b1[j] + vv * k1[j]); y += S[j] * r0[j]; y += S[4 + j] * r1[j]; }
                y = reduce8(y);
                if (seg == 0) ybuf[tok * 64 + vrow] = y;
            }
            __syncthreads();
            {
                const int tok = F.tid >> 4, vq = (F.tid & 15) * 4; const size_t t = tb + (size_t)ck * CH + tok;
                const f32x4 yv = *(const LAS f32x4*)(ybuf + tok * 64 + vq);
                { u32x2 wy; wy.x = cvt_pk_bf16(yv[0], yv[1]); wy.y = cvt_pk_bf16(yv[2], yv[3]); *(u32x2*)(WSP(bf16_t, DBG_YREF) + t * 512 + h * 64 + vq) = wy; }
                float s = (yv[0] + yv[1]) + (yv[2] + yv[3]);
                s += __shfl_xor(s, 1); s += __shfl_xor(s, 2); s += __shfl_xor(s, 4); s += __shfl_xor(s, 8);
                const float mean = s * (1.f / 64.f);
                const f32x4 dv = yv - mean; float q = (dv[0] * dv[0] + dv[1] * dv[1]) + (dv[2] * dv[2] + dv[3] * dv[3]);
                q += __shfl_xor(q, 1); q += __shfl_xor(q, 2); q += __shfl_xor(q, 4); q += __shfl_xor(q, 8);
                const float rstd = rsqrtf(q * (1.f / 64.f) + GN_EPS);
                const float rk = rkb[t * 8 + h];
                const f32x4 vv = *(const LAS f32x4*)(cb + 2 * CH * 64 + tok * 64 + vq);
                const f32x4 gg = *(const f32x4*)(gn_g + h * 64 + vq), gb = *(const f32x4*)(gn_b + h * 64 + vq);
                const u32x2 gt = *(const u32x2*)(sg + t * 512 + h * 64 + vq);
                float o[4]; const float gtf[4] = {bflo(gt.x), bfhi(gt.x), bflo(gt.y), bfhi(gt.y)};
#pragma unroll
                for (int j = 0; j < 4; ++j) o[j] = (dv[j] * rstd * gg[j] + gb[j] + rk * vv[j]) * gtf[j];
                u32x2 w; w.x = cvt_pk_bf16(o[0], o[1]); w.y = cvt_pk_bf16(o[2], o[3]);
                *(u32x2*)(outa + t * 512 + h * 64 + vq) = w; }
            if (ck + 1 < SEQ / CH) { LAS float* d = buf + (cur ^ 1) * 6 * CH * 64 + ltok * 64 + lch;
#pragma unroll
                for (int a = 0; a < 5; ++a) { *(LAS f32x4*)(d + a * CH * 64) = (f32x4){bflo(pre_b[a].x), bfhi(pre_b[a].x), bflo(pre_b[a].y), bfhi(pre_b[a].y)}; }
                *(LAS f32x4*)(d + 5 * CH * 64) = pre_w; }
            __syncthreads();
        }
    }
}

template <class TA, class TB> __device__ __forceinline__ void dbg_compare(Frame& F, const TA* a, const TB* b, size_t n, unsigned* ctl, int mode_transpose64) {
    float num = 0.f, den = 0.f;
    for (size_t i = (size_t)blockIdx.x * 512 + F.tid; i < n; i += (size_t)F.G * 512) {
        size_t ia = i;
        if (mode_transpose64) { const size_t tile = i >> 12, rem = i & 4095, r = rem >> 6, c2 = rem & 63; ia = (tile << 12) + c2 * 64 + r; }
        float x, y;
        if (sizeof(TA) == 2) x = bf2f(((const bf16_t*)a)[ia]); else x = ((const float*)a)[ia];
        if (sizeof(TB) == 2) y = bf2f(((const bf16_t*)b)[i]); else y = ((const float*)b)[i];
        const float d = x - y; num += d * d; den += y * y; }
    num = wave_sum(num); den = wave_sum(den);
    LAS float* red = (LAS float*)F.lds;
    __syncthreads();
    if (F.lane == 0) { red[F.wave * 2] = num; red[F.wave * 2 + 1] = den; }
    __syncthreads();
    if (F.tid == 0) { float n2 = 0.f, d2 = 0.f; for (int w8 = 0; w8 < 8; ++w8) { n2 += red[w8 * 2]; d2 += red[w8 * 2 + 1]; }
        ((float*)ctl)[1024 + 2 * blockIdx.x] = n2; ((float*)ctl)[1025 + 2 * blockIdx.x] = d2; }
}

constexpr size_t DBG_BF = WS_CONVH;
__device__ __forceinline__ void dbg_bruteforce(Frame& F) {
    LAS float* Ph = (LAS float*)F.lds; LAS float* Gm = Ph + 64 * 65; LAS float* vec = Gm + 64 * 65; LAS float* s1 = vec + 6 * 64; LAS float* s2 = s1 + 64;
    const bf16_t* sv = WSP(bf16_t, WS_SV); const bf16_t* sa = WSP(bf16_t, WS_SA); const bf16_t* sb = WSP(bf16_t, WS_SB); const bf16_t* sr = WSP(bf16_t, WS_SR); const bf16_t* sk = WSP(bf16_t, WS_SK); const float* sw = WSP(float, WS_SW);
    float* out = WSP(float, DBG_BF);
    const int chid = blockIdx.x, unit = chid >> 3, h = chid & 7, t0 = unit * 64;
    const int k = F.tid >> 3, j0 = (F.tid & 7) * 8;
    for (int e = 0; e < 8; ++e) { Ph[k * 65 + j0 + e] = (k == j0 + e) ? 1.f : 0.f; Gm[k * 65 + j0 + e] = 0.f; }
    __syncthreads();
    for (int t = 0; t < 64; ++t) {
        if (F.tid < 384) { const int a = F.tid >> 6, ch = F.tid & 63; const size_t o = (size_t)(t0 + t) * 512 + h * 64 + ch;
            float x; if (a == 0) x = sw[o]; else if (a == 1) x = bf2f(sa[o]); else if (a == 2) x = bf2f(sb[o]); else if (a == 3) x = bf2f(sk[o]); else if (a == 4) x = bf2f(sv[o]); else x = bf2f(sr[o]);
            vec[a * 64 + ch] = x; }
        __syncthreads();
        if (F.tid < 64) { float s = 0.f; for (int kk = 0; kk < 64; ++kk) s += vec[64 + kk] * Ph[kk * 65 + F.tid]; s1[F.tid] = s; }
        else if (F.tid < 128) { const int j = F.tid - 64; float s = 0.f; for (int kk = 0; kk < 64; ++kk) s += vec[64 + kk] * Gm[kk * 65 + j]; s2[j] = s; }
        __syncthreads();
        for (int e = 0; e < 8; ++e) { const int j = j0 + e; Ph[k * 65 + j] = vec[k] * Ph[k * 65 + j] + vec[128 + k] * s1[j]; Gm[k * 65 + j] = vec[k] * Gm[k * 65 + j] + vec[128 + k] * s2[j] + vec[192 + k] * vec[256 + j]; }
        __syncthreads();
        if (F.tid < 64) { float s = 0.f; for (int kk = 0; kk < 64; ++kk) s += vec[320 + kk] * Ph[kk * 65 + F.tid]; out[((size_t)(2 * 256 + chid) * 64 + t) * 64 + F.tid] = s; }
        else if (F.tid < 128) { const int j = F.tid - 64; float s = 0.f; for (int kk = 0; kk < 64; ++kk) s += vec[320 + kk] * Gm[kk * 65 + j]; out[((size_t)(3 * 256 + chid) * 64 + t) * 64 + j] = s; }
    }
    __syncthreads();
    for (int e = 0; e < 8; ++e) { out[((size_t)(0 * 256 + chid) * 64 + k) * 64 + j0 + e] = Ph[k * 65 + j0 + e]; out[((size_t)(1 * 256 + chid) * 64 + k) * 64 + j0 + e] = Gm[k * 65 + j0 + e]; }
}
__device__ __forceinline__ void dbg_compare_vt(Frame& F, unsigned* ctl) {
    const bf16_t* VT = WSP(bf16_t, WS_VT); const bf16_t* sv = WSP(bf16_t, WS_SV); float num = 0.f, den = 0.f;
    for (size_t i = (size_t)blockIdx.x * 512 + F.tid; i < (size_t)T * 512; i += (size_t)F.G * 512) { const size_t t = i >> 9, cg = i & 511, hh = cg >> 6, ch = cg & 63; const size_t chid = (t >> 6) * 8 + hh;
        const float x = bf2f(VT[(chid * 64 + ch) * 64 + (t & 63)]), y = bf2f(sv[i]); const float d = x - y; num += d * d; den += y * y; }
    num = wave_sum(num); den = wave_sum(den);
    LAS float* red = (LAS float*)F.lds; __syncthreads(); if (F.lane == 0) { red[F.wave * 2] = num; red[F.wave * 2 + 1] = den; } __syncthreads();
    if (F.tid == 0) { float n2 = 0.f, d2 = 0.f; for (int w8 = 0; w8 < 8; ++w8) { n2 += red[w8 * 2]; d2 += red[w8 * 2 + 1]; } ((float*)ctl)[1024 + 2 * blockIdx.x] = n2; ((float*)ctl)[1025 + 2 * blockIdx.x] = d2; }
}
#endif
__device__ __forceinline__ void phase_sgu(Frame& F, const Params& P, int l, int wg0, int nwg) {
    LAS unsigned char* vt = F.lds;
    const bf16_t* z = WSP(bf16_t, WS_SGUZ); unsigned char* hb = WSP(unsigned char, WS_HB);
    const bf16_t* Wm = WSP(bf16_t, WS_SGUW) + (size_t)l * 4 * 128 * 128;
    const float* bs = P.in[21] + (size_t)l * 4 * 128;
    int u0 = __builtin_amdgcn_readfirstlane((int)blockIdx.x - wg0);
    for (int u = u0; u < T / 128; u += nwg) {
        int uu = u; asm volatile("" : "+v"(uu)); uu = __builtin_amdgcn_readfirstlane(uu);
        int lz = F.lane; asm volatile("" : "+v"(lz));
        const size_t t0 = (size_t)uu * 128;
        __syncthreads();
        {
            float lg[4], lb[4];
#pragma unroll
            for (int e = 0; e < 4; ++e) { lg[e] = P.in[18][(size_t)l * 256 + lz + 64 * e]; lb[e] = P.in[19][(size_t)l * 256 + lz + 64 * e]; }
            float vall[16][4];
#pragma unroll
            for (int i = 0; i < 16; ++i) { const bf16_t* zr = z + (t0 + F.wave * 16 + i) * 512 + 256 + lz;
#pragma unroll
                for (int e = 0; e < 4; ++e) vall[i][e] = bf2f(zr[64 * e]); }
#pragma unroll
            for (int i = 0; i < 16; ++i) { const int tok = F.wave * 16 + i;
                float v[4];
#pragma unroll
                for (int e = 0; e < 4; ++e) v[e] = vall[i][e];
                const float mean = wave_sum((v[0] + v[1]) + (v[2] + v[3])) * (1.f / 256.f);
#pragma unroll
                for (int e = 0; e < 4; ++e) v[e] -= mean;
                const float rstd = rsqrtf(wave_sum((v[0] * v[0] + v[1] * v[1]) + (v[2] * v[2] + v[3] * v[3])) * (1.f / 256.f) + LN_EPS);
#pragma unroll
                for (int e = 0; e < 4; ++e) { const int ch = lz + 64 * e; *(LAS bf16_t*)(vt + ch * 256 + ((((tok >> 3) ^ (ch & 15)) << 4) | ((tok & 7) << 1))) = f2bf(v[e] * rstd * lg[e] + lb[e]); } } }
        __syncthreads();
        {   const int c = lz & 15, qd = lz >> 4, g = F.wave >> 1, sel = F.wave & 1;
            const bf16_t* Wg = Wm + (size_t)g * 128 * 128;
            f32x4 acc[4][4];
#pragma unroll
            for (int pi = 0; pi < 4; ++pi)
#pragma unroll
                for (int db = 0; db < 4; ++db) acc[pi][db] = (f32x4){0.f, 0.f, 0.f, 0.f};
#pragma unroll
            for (int ks = 0; ks < 4; ++ks) {
                bf16x8 af[4];
#pragma unroll
                for (int db = 0; db < 4; ++db) { const int ch = 64 * g + 16 * db + c; af[db] = *(const LAS bf16x8*)(vt + ch * 256 + (((4 * ks + qd) ^ (ch & 15)) << 4)); }
#pragma unroll
                for (int pi = 0; pi < 4; ++pi) { const int pb = sel ? ((pi == 0) ? 1 : (pi == 1) ? 2 : (pi == 2) ? 5 : 6) : ((pi == 0) ? 0 : (pi == 1) ? 3 : (pi == 2) ? 4 : 7);
                    if (32 * ks <= 16 * pb + 15) { const bf16x8 bfr = *(const bf16x8*)(Wg + (size_t)(16 * pb + c) * 128 + 32 * ks + 8 * qd);
#pragma unroll
                        for (int db = 0; db < 4; ++db) acc[pi][db] = MFMA32(af[db], bfr, acc[pi][db]); } } }
            u32x2 uraw[4][4]; float biasv[4];
#pragma unroll
            for (int pi = 0; pi < 4; ++pi) { const int pb = sel ? ((pi == 0) ? 1 : (pi == 1) ? 2 : (pi == 2) ? 5 : 6) : ((pi == 0) ? 0 : (pi == 1) ? 3 : (pi == 2) ? 4 : 7);
                const int p = 16 * pb + c; biasv[pi] = bs[g * 128 + p];
#pragma unroll
                for (int db = 0; db < 4; ++db) uraw[pi][db] = *(const u32x2*)(z + (t0 + p) * 512 + 64 * g + 16 * db + 4 * qd); }
#pragma unroll
            for (int pi = 0; pi < 4; ++pi) { const int pb = sel ? ((pi == 0) ? 1 : (pi == 1) ? 2 : (pi == 2) ? 5 : 6) : ((pi == 0) ? 0 : (pi == 1) ? 3 : (pi == 2) ? 4 : 7);
                const size_t t = t0 + 16 * pb + c;
#pragma unroll
                for (int db = 0; db < 4; ++db) { const int ch = 64 * g + 16 * db + 4 * qd;
                    const f32x4 o = unpack4(uraw[pi][db]) * (acc[pi][db] + biasv[pi]) * 4.f; *(unsigned*)(hb + t * 256 + ch) = pack_fp8x4(o[0], o[1], o[2], o[3]); } } }
    }
    __syncthreads();
}
__device__ __forceinline__ void phase_conv(Frame& F, const Params& P, int l, int wg0, int nwg) {
    LAS float* cv = (LAS float*)F.lds;
    const bf16_t* hin = WSP(bf16_t, WS_CONVH); unsigned char* hc = WSP(unsigned char, WS_HC);
    const float* dw = P.in[23] + (size_t)l * 31 * 256; const float* db = P.in[24] + (size_t)l * 256;
    const float* lg = P.in[25] + (size_t)l * 256; const float* lb = P.in[26] + (size_t)l * 256;
    int u0 = __builtin_amdgcn_readfirstlane((int)blockIdx.x - wg0);
    for (int u = u0; u < T / 64; u += nwg) {
        int tz = F.tid; asm volatile("" : "+v"(tz)); const int ch = tz & 255, hf = tz >> 8, lz = tz & 63;
        float kw[31];
#pragma unroll
        for (int j = 0; j < 31; ++j) kw[j] = dw[j * 256 + ch];
        const float bias = db[ch];
        const int t0 = u * 64 + hf * 32; const int s0 = t0 & (SEQ - 1);
        __syncthreads();
        float x[38];
#pragma unroll
        for (int m = 0; m < 30; ++m) { const int s = s0 - 30 + m; const float ld = bf2f(hin[(size_t)(t0 - 30 + m + (s >= 0 ? 0 : 30)) * 256 + ch]); x[m] = (s >= 0) ? ld : 0.f; }
#pragma unroll
        for (int g8 = 0; g8 < 4; ++g8) {
#pragma unroll
            for (int m = 0; m < 8; ++m) x[30 + m] = bf2f(hin[(size_t)(t0 + 8 * g8 + m) * 256 + ch]);
#pragma unroll
            for (int i = 0; i < 8; ++i) { float a = bias;
#pragma unroll
                for (int j = 0; j < 31; ++j) a += kw[j] * x[i + j];
                cv[(hf * 32 + 8 * g8 + i) * 256 + ch] = a; }
#pragma unroll
            for (int m = 0; m < 30; ++m) x[m] = x[m + 8]; }
        __syncthreads();
        {   const f32x4 g = *(const f32x4*)(lg + lz * 4), bb = *(const f32x4*)(lb + lz * 4);
            for (int i = 0; i < 8; ++i) { const int tok = F.wave * 8 + i; f32x4 v = *(const LAS f32x4*)(cv + tok * 256 + lz * 4);
                const float mean = wave_sum((v[0] + v[1]) + (v[2] + v[3])) * (1.f / 256.f);
                v = v - mean; const float var = wave_sum((v[0] * v[0] + v[1] * v[1]) + (v[2] * v[2] + v[3] * v[3])) * (1.f / 256.f);
                const float rstd = rsqrtf(var + LN_EPS);
                v = v * rstd * g + bb;
                float o[4];
#pragma unroll
                for (int j = 0; j < 4; ++j) o[j] = v[j] * sigmoidf_(v[j]);
                *(unsigned*)(hc + (size_t)(u * 64 + tok) * 256 + lz * 4) = pack_fp8x4(4.f * o[0], 4.f * o[1], 4.f * o[2], 4.f * o[3]); } }
    }
    __syncthreads();
}
__device__ __forceinline__ void ln_load16(const bf16_t* p, float (&v)[16]) {
    const u32x4 a = *(const u32x4*)p, b = *(const u32x4*)(p + 8);
    v[0] = bflo(a.x); v[1] = bfhi(a.x); v[2] = bflo(a.y); v[3] = bfhi(a.y); v[4] = bflo(a.z); v[5] = bfhi(a.z); v[6] = bflo(a.w); v[7] = bfhi(a.w);
    v[8] = bflo(b.x); v[9] = bfhi(b.x); v[10] = bflo(b.y); v[11] = bfhi(b.y); v[12] = bflo(b.z); v[13] = bfhi(b.z); v[14] = bflo(b.w); v[15] = bfhi(b.w);
}
__device__ __forceinline__ void ln_norm16(float (&v)[16], const float* g, const float* b, int lane) {
    float s = 0.f;
#pragma unroll
    for (int j = 0; j < 16; ++j) s += v[j];
    const float mean = wave_sum(s) * (1.f / 1024.f); float q = 0.f;
#pragma unroll
    for (int j = 0; j < 16; ++j) { v[j] -= mean; q += v[j] * v[j]; }
    const float rstd = rsqrtf(wave_sum(q) * (1.f / 1024.f) + LN_EPS);
#pragma unroll
    for (int j4 = 0; j4 < 4; ++j4) { const f32x4 gg = *(const f32x4*)(g + lane * 16 + j4 * 4), bb = *(const f32x4*)(b + lane * 16 + j4 * 4);
#pragma unroll
        for (int j = 0; j < 4; ++j) v[j4 * 4 + j] = v[j4 * 4 + j] * rstd * gg[j] + bb[j]; }
}
__device__ __forceinline__ void ln_store16(bf16_t* p, const float (&v)[16]) {
    u32x4 a, b; a.x = cvt_pk_bf16(v[0], v[1]); a.y = cvt_pk_bf16(v[2], v[3]); a.z = cvt_pk_bf16(v[4], v[5]); a.w = cvt_pk_bf16(v[6], v[7]);
    b.x = cvt_pk_bf16(v[8], v[9]); b.y = cvt_pk_bf16(v[10], v[11]); b.z = cvt_pk_bf16(v[12], v[13]); b.w = cvt_pk_bf16(v[14], v[15]);
    *(u32x4*)p = a; *(u32x4*)(p + 8) = b;
}
__device__ __forceinline__ void ln_load16q(const unsigned char* p, float (&v)[16]) {
    const u32x4 a = *(const u32x4*)p; const unsigned w[4] = {a.x, a.y, a.z, a.w};
#pragma unroll
    for (int i = 0; i < 4; ++i) { const f32x2 lo = __builtin_amdgcn_cvt_pk_f32_fp8((int)w[i], false), hi = __builtin_amdgcn_cvt_pk_f32_fp8((int)w[i], true); v[4 * i] = lo[0]; v[4 * i + 1] = lo[1]; v[4 * i + 2] = hi[0]; v[4 * i + 3] = hi[1]; }
}
__device__ __forceinline__ void ln_store16q(unsigned char* p, const float (&v)[16]) {
    u32x4 a; a.x = pack_fp8x4(v[0], v[1], v[2], v[3]); a.y = pack_fp8x4(v[4], v[5], v[6], v[7]); a.z = pack_fp8x4(v[8], v[9], v[10], v[11]); a.w = pack_fp8x4(v[12], v[13], v[14], v[15]);
    *(u32x4*)p = a;
}
__device__ __forceinline__ void phase_ln1(Frame& F, const Params& P, int l, int wg0, int nwg) {
    const bf16_t* pre = WSP(bf16_t, WS_PRE); const float* stats = WSP(float, WS_STATS);
    const float* g = P.in[29] + (size_t)l * 1024; const float* b = P.in[30] + (size_t)l * 1024;
    const int gw = ((int)blockIdx.x - wg0) * 8 + F.wave, NGW = nwg * 8;
    float gg[16], bb[16];
#pragma unroll
    for (int j4 = 0; j4 < 4; ++j4) { const f32x4 g4 = *(const f32x4*)(g + F.lane * 16 + j4 * 4), b4 = *(const f32x4*)(b + F.lane * 16 + j4 * 4);
#pragma unroll
        for (int j = 0; j < 4; ++j) { gg[j4 * 4 + j] = g4[j]; bb[j4 * 4 + j] = b4[j]; } }
    for (int row = gw; row < T; row += NGW) { float v[16]; ln_load16(pre + (size_t)row * 1024 + F.lane * 16, v);
        const f32x2 sl = *(const f32x2*)(stats + ((size_t)row * 16 + (F.lane & 15)) * 2);
        const float mean = row16_sum(sl[0]) * (1.f / 1024.f), ex2 = row16_sum(sl[1]) * (1.f / 1024.f);
        const float rstd = rsqrtf(fmaxf(ex2 - mean * mean, 0.f) + LN_EPS);
#pragma unroll
        for (int j = 0; j < 16; ++j) v[j] = (v[j] - mean) * rstd * gg[j] + bb[j];
        ln_store16q(WSP(unsigned char, WS_X1Q) + (size_t)row * 1024 + F.lane * 16, v); }
}
__device__ __forceinline__ void phase_ln2(Frame& F, const Params& P, int l) {
    const bf16_t* pre = WSP(bf16_t, WS_PRE); const float* stats = WSP(float, WS_STATS); const unsigned char* Y = WSP(unsigned char, WS_Y); bf16_t* x = WSP(bf16_t, WS_X); const int* inv = WSP(int, WS_GATEV);
    const float* g = P.in[36] + (size_t)l * 1024; const float* b = P.in[37] + (size_t)l * 1024; const float* g1 = P.in[29] + (size_t)l * 1024; const float* b1 = P.in[30] + (size_t)l * 1024;
    const int gw = blockIdx.x * 8 + F.wave, NGW = F.G * 8;
    int n0 = inv[2 * gw], n1 = inv[2 * gw + 1];
#pragma unroll 1
    for (int row = gw; row < T; row += NGW) { float v[16], y0[16], y1[16];
        const int c0 = __builtin_amdgcn_readfirstlane(n0), c1 = __builtin_amdgcn_readfirstlane(n1);
        { const int rn = (row + NGW < T) ? row + NGW : row; n0 = inv[2 * rn]; n1 = inv[2 * rn + 1]; }
        ln_load16(pre + (size_t)row * 1024 + F.lane * 16, v); ln_load16q(Y + (size_t)c0 * 1024 + F.lane * 16, y0); ln_load16q(Y + (size_t)c1 * 1024 + F.lane * 16, y1);
        {   const f32x2 sl = *(const f32x2*)(stats + ((size_t)row * 16 + (F.lane & 15)) * 2);
            const float mean = row16_sum(sl[0]) * (1.f / 1024.f), ex2 = row16_sum(sl[1]) * (1.f / 1024.f); const float rstd = rsqrtf(fmaxf(ex2 - mean * mean, 0.f) + LN_EPS);
#pragma unroll
            for (int j4 = 0; j4 < 4; ++j4) { const f32x4 g4 = *(const f32x4*)(g1 + F.lane * 16 + j4 * 4), b4 = *(const f32x4*)(b1 + F.lane * 16 + j4 * 4);
#pragma unroll
                for (int j = 0; j < 4; ++j) v[j4 * 4 + j] = (v[j4 * 4 + j] - mean) * rstd * g4[j] + b4[j]; } }
#pragma unroll
        for (int j = 0; j < 16; ++j) v[j] = ALPHA * v[j] + 0.125f * (y0[j] + y1[j]);
        ln_norm16(v, g, b, F.lane);
        if (l == NL - 1) { float* o = F.out + (size_t)row * 1024 + F.lane * 16;
#pragma unroll
            for (int j4 = 0; j4 < 4; ++j4) *(f32x4*)(o + j4 * 4) = (f32x4){v[j4 * 4], v[j4 * 4 + 1], v[j4 * 4 + 2], v[j4 * 4 + 3]}; }
        else { ln_store16(x + (size_t)row * 1024 + F.lane * 16, v); ln_store16q(WSP(unsigned char, WS_XQ) + (size_t)row * 1024 + F.lane * 16, v); } }
}

#define PHASE_PROLOGUE() const Params P = KPARAMS(); Frame F = make_frame(P.ws, P.out); unsigned* ctl = (unsigned*)(F.ws + WS_CTL); (void)ctl
__device__ __forceinline__ void ph_prologue_a() { PHASE_PROLOGUE(); phase_convert_static(F, P); __syncthreads(); }
__device__ __forceinline__ void ph_prologue_b() { PHASE_PROLOGUE(); phase_convert_lora(F, P); phase_convert_sgu(F, P); phase_convert_router(F, P); __syncthreads(); }
__device__ __forceinline__ void ph_prologue_c() { PHASE_PROLOGUE(); phase_x_to_bf16(F, P); __syncthreads(); }
__device__ __forceinline__ void ph_prologue() { PHASE_PROLOGUE(); phase_convert_static(F, P); phase_convert_lora(F, P); phase_convert_sgu(F, P); phase_convert_router(F, P); phase_x_to_bf16(F, P); phase_convert_moe(F, P, 0); __syncthreads(); }
__device__ __forceinline__ void ph_inproj(int l) { PHASE_PROLOGUE();
    SchedInproj S{(const char*)WSP(unsigned char, WS_XQ), (const char*)(WSP(unsigned char, WS_WIN) + (size_t)l * NIN * 1024), F.G, (int)blockIdx.x};
    EpiInproj E{WSP(bf16_t, WS_RKV), WSP(bf16_t, WS_SGUZ), WSP(bf16_t, WS_CONVH), WSP(unsigned char, WS_GATES)};
    ge::gemm_phase<SchedInproj, EpiInproj, true>(F.lds, S, E); }
__device__ __forceinline__ void ph_inproj_null(int l) { PHASE_PROLOGUE();
    SchedInproj S{(const char*)WSP(unsigned char, WS_XQ), (const char*)(WSP(unsigned char, WS_WIN) + (size_t)l * NIN * 1024), F.G, (int)blockIdx.x};
    EpiNull E{WSP(bf16_t, WS_HB)};
    ge::gemm_phase<SchedInproj, EpiNull, true>(F.lds, S, E); }
__device__ __forceinline__ void ph_wkva(int l) { PHASE_PROLOGUE(); phase_wkv_a<false>(F, P, l); }
__device__ __forceinline__ void ph_wkva_e(int l) { PHASE_PROLOGUE(); phase_wkv_a<true>(F, P, l); }
__device__ __forceinline__ void ph_cvtmoe(int l) { PHASE_PROLOGUE(); phase_convert_moe(F, P, l); __syncthreads(); }
__device__ __forceinline__ void ph_wkvb() { PHASE_PROLOGUE(); phase_wkv_b(F, P); }
__device__ __forceinline__ void ph_wkvc(int l) { PHASE_PROLOGUE(); phase_wkv_c(F, P, l); }
__device__ __forceinline__ void ph_sguconv(int l) { PHASE_PROLOGUE();
    phase_sgu(F, P, l, 64, 192); phase_conv(F, P, l, 64, 192); }
__device__ __forceinline__ void ph_branch(int l) { PHASE_PROLOGUE();
    SchedBranch S{(const char*)F.ws, WS_WBR + (size_t)l * 1024 * 1024, F.G, F.vcu};
    EpiBranch E{WSP(unsigned char, WS_GATES), WSP(bf16_t, WS_MERGED), WSP(unsigned char, WS_MERGEDQ)};
    ge::gemm_phase<SchedBranch, EpiBranch, true, 0x7A7A7A7A, 0x7D7D7D7D>(F.lds, S, E); }
__device__ __forceinline__ void ph_wout(int l) { PHASE_PROLOGUE();
    SchedWout S{(const char*)WSP(unsigned char, WS_MERGEDQ), (const char*)(WSP(unsigned char, WS_WOUT) + (size_t)l * 1024 * 1024), F.G, F.vcu};
    EpiWout E{WSP(bf16_t, WS_X), WSP(bf16_t, WS_PRE), WSP(float, WS_STATS)};
    ge::gemm_phase<SchedWout, EpiWout, true, 0x7A7A7A7A, 0x7D7D7D7D>(F.lds, S, E); }
__device__ __forceinline__ void ph_ln1(int l) { PHASE_PROLOGUE(); phase_ln1(F, P, l, 128, 128); }
__device__ __forceinline__ void ph_router(int l) { PHASE_PROLOGUE();
    SchedRouter S{(const char*)WSP(bf16_t, WS_PRE), (const char*)(WSP(bf16_t, WS_WRG) + (size_t)l * 256 * 1024), 128, (int)blockIdx.x};
    EpiRouter E{P.in[32], ctl + CW_CNT + 64 * l, WSP(int, WS_LIST), WSP(float, WS_STATS), WSP(float, WS_RC) + l * 64};
    ge::gemm_phase(F.lds, S, E); }
__device__ __forceinline__ void ph_router_probe(int l) { PHASE_PROLOGUE();
    SchedRouter S{(const char*)WSP(bf16_t, WS_PRE), (const char*)(WSP(bf16_t, WS_WRG) + (size_t)l * 256 * 1024), 128, (int)blockIdx.x};
    EpiRouter E{P.in[32], ctl + CW_CNT + 64 * l + 32, WSP(int, WS_Y), WSP(float, WS_STATS), WSP(float, WS_RC) + l * 64};
    ge::gemm_phase(F.lds, S, E); }
__device__ __forceinline__ void ph_moe1(int l) { PHASE_PROLOGUE();
    const int ntiles = build_tile_table(F, ctl + CW_CNT + 64 * l);
    SchedMoe1 S{(const char*)WSP(unsigned char, WS_X1Q), (const char*)moe_wbuf(F, l), WSP(int, WS_LIST), ctl + CW_CNT + 64 * l, (LAS int*)(F.lds + LDS_MISC + 64), ntiles, F.G, F.vcu};
    EpiMoe1 E{WSP(unsigned char, WS_H)};
    ge::gemm_phase<SchedMoe1, EpiMoe1, true>(F.lds, S, E); }
__device__ __forceinline__ void ph_moe2(int l) { PHASE_PROLOGUE(); int ntk4 = 4; asm volatile("" : "+s"(ntk4));
    const int ntiles = build_tile_table(F, ctl + CW_CNT + 64 * l);
    SchedMoe2 S{(const char*)WSP(unsigned char, WS_H), (const char*)(moe_wbuf(F, l) + (size_t)NE * 1024 * 1024), WSP(int, WS_LIST), ctl + CW_CNT + 64 * l, (LAS int*)(F.lds + LDS_MISC + 64), ntiles, F.G, F.vcu, ntk4};
    EpiMoe2 E{WSP(int, WS_LIST), WSP(unsigned char, WS_Y), WSP(int, WS_GATEV)};
    ge::gemm_phase<SchedMoe2, EpiMoe2, true>(F.lds, S, E); }
__device__ __forceinline__ void ph_moe2_nostore(int l) { PHASE_PROLOGUE(); int ntk4 = 4; asm volatile("" : "+s"(ntk4));
    const int ntiles = build_tile_table(F, ctl + CW_CNT + 64 * l);
    SchedMoe2 S{(const char*)WSP(unsigned char, WS_H), (const char*)(moe_wbuf(F, l) + (size_t)NE * 1024 * 1024), WSP(int, WS_LIST), ctl + CW_CNT + 64 * l, (LAS int*)(F.lds + LDS_MISC + 64), ntiles, F.G, F.vcu, ntk4};
    EpiMoe2T<1> E{WSP(int, WS_LIST), WSP(unsigned char, WS_Y), WSP(int, WS_GATEV)};
    ge::gemm_phase<SchedMoe2, EpiMoe2T<1>, true>(F.lds, S, E); }
__device__ __forceinline__ void ph_ln2(int l) { PHASE_PROLOGUE(); phase_ln2(F, P, l); }

constexpr int PH_PER_LAYER = 11, N_PHASES = 1 + NL * PH_PER_LAYER;
__global__ void __launch_bounds__(512, 2) fwd_kernel(Params p) {
    for (int u = threadIdx.x; u < (LDS_BYTES - LDS_MISC) / 4; u += 512) ((LAS unsigned*)((LAS unsigned char*)lds_raw + LDS_MISC))[u] = 0u;
    __syncthreads();
#if ONE_LAUNCH
    XcdBarrier bar = xcd_barrier_post((unsigned*)(p.ws + WS_CTL) + CW_BAR, (volatile LAS unsigned*)((LAS unsigned char*)lds_raw + LDS_MISC));
#define SEAM() xcd_barrier(bar)
#else
#define SEAM() do { } while (0)
#endif
    const int lo = p.phase_lo, hi = p.phase_hi;
#ifdef ONLY_K
#define IN(k) ((k) == ONLY_K && lo <= pb + (k) && pb + (k) < hi)
#else
#define IN(k) (lo <= pb + (k) && pb + (k) < hi)
#endif
#ifndef ONLY_K
    { const int pb = 0; if (IN(0)) { ph_prologue(); SEAM(); if (REPEAT_K == 20) { ph_prologue(); SEAM(); } if (REPEAT_K == 21) { ph_prologue_a(); SEAM(); } if (REPEAT_K == 22) { ph_prologue_b(); SEAM(); } if (REPEAT_K == 23) { ph_prologue_c(); SEAM(); } } }
#endif
#if DEBUG_MODE
    {
        { ph_inproj(0); SEAM(); }
        { PHASE_PROLOGUE(); dbg_prep(F, P, 0); } SEAM();
        { PHASE_PROLOGUE(); if (blockIdx.x < 128) dbg_scan(F, P, 0, 0, 128); } SEAM();
        if (DEBUG_MODE >= 6) { PHASE_PROLOGUE(); dbg_bruteforce(F); SEAM(); }
        ph_wkva(0); SEAM();
        if (blockIdx.x < 64) ph_wkvb(); SEAM();
        ph_wkvc(0); SEAM();
        { PHASE_PROLOGUE();
          if (DEBUG_MODE == 1) dbg_compare(F, WSP(bf16_t, WS_OUTA), WSP(bf16_t, DBG_OUTAREF), (size_t)T * 512, ctl, 0);
          if (DEBUG_MODE == 2) dbg_compare(F, WSP(bf16_t, WS_MT), WSP(float, DBG_MREF), (size_t)4096 * 4096, ctl, 1);
          if (DEBUG_MODE == 3) dbg_compare(F, WSP(bf16_t, DBG_YDBG), WSP(bf16_t, DBG_YREF), (size_t)T * 512, ctl, 0);
          if (DEBUG_MODE == 4) dbg_compare(F, WSP(float, WS_RK), WSP(float, DBG_RKREF), (size_t)T * 8, ctl, 0);
          if (DEBUG_MODE == 5) dbg_compare_vt(F, ctl);
          if (DEBUG_MODE == 20 && blockIdx.x == 0 && F.tid == 0) { const unsigned bits = __hip_atomic_load(ctl + 12, __ATOMIC_RELAXED, __HIP_MEMORY_SCOPE_AGENT); float st = 0.f; for (int bb = 15; bb >= 1; --bb) if (bits & (1u << bb)) st = (float)bb; ((float*)ctl)[1024] = st * st * 1e-4f; ((float*)ctl)[1025] = 1.f; }
          if (DEBUG_MODE == 10) dbg_compare(F, (const bf16_t*)F.out, WSP(float, WS_SW), (size_t)T * 512, ctl, 0);
          if (DEBUG_MODE == 11) dbg_compare(F, (const bf16_t*)F.out + (size_t)T * 512, WSP(bf16_t, WS_SB), (size_t)T * 512, ctl, 0);
          if (DEBUG_MODE == 12) dbg_compare(F, (const bf16_t*)F.out + (size_t)2 * T * 512, WSP(bf16_t, WS_SA), (size_t)T * 512, ctl, 0);
          if (DEBUG_MODE == 6) dbg_compare(F, WSP(bf16_t, WS_PHI), WSP(float, DBG_BF), (size_t)256 * 4096, ctl, 0);
          if (DEBUG_MODE == 7) dbg_compare(F, WSP(bf16_t, WS_GT), WSP(float, DBG_BF) + (size_t)1 * 256 * 4096, (size_t)256 * 4096, ctl, 1);
          if (DEBUG_MODE == 8) dbg_compare(F, WSP(bf16_t, WS_PSI), WSP(float, DBG_BF) + (size_t)2 * 256 * 4096, (size_t)256 * 4096, ctl, 0);
          if (DEBUG_MODE == 9) dbg_compare(F, WSP(bf16_t, WS_Y0T), WSP(float, DBG_BF) + (size_t)3 * 256 * 4096, (size_t)256 * 4096, ctl, 1);
        } SEAM();
        { PHASE_PROLOGUE(); float num = 0.f, den = 0.f; for (int g2 = 0; g2 < 256; ++g2) { num += ((const float*)ctl)[1024 + 2 * g2]; den += ((const float*)ctl)[1025 + 2 * g2]; }
          float e = 1000.f * sqrtf(num / fmaxf(den, 1e-30f)); if (!(e == e)) e = 7.0e6f; else if (e > 5e6f) e = 5.0e6f; if (!(den == den)) e = 9.0e6f;
          for (size_t i = (size_t)blockIdx.x * 512 + F.tid; i < (size_t)T * D; i += (size_t)F.G * 512) F.out[i] = e; }
        return;
    }
#endif
#define RUN_LAYER(l) do { const int pb = 1 + (l) * PH_PER_LAYER;\
        if (IN(0)) { ph_inproj(l); SEAM(); if (REPEAT_K == 0) { ph_inproj(l); SEAM(); } if (REPEAT_K == 30) { ph_inproj_null(l); SEAM(); } }\
        if (IN(1)) { ph_wkva(l); SEAM(); if (REPEAT_K == 1) { ph_wkva(l); SEAM(); } if (REPEAT_K == 15) { ph_wkva_e(l); SEAM(); } if (REPEAT_K == 11) { ph_cvtmoe(l); SEAM(); } }\
        if (IN(2)) { if (blockIdx.x < 64) ph_wkvb(); else ph_sguconv(l); if ((l) + 1 < NL) ph_cvtmoe((l) + 1); SEAM(); if (REPEAT_K == 2) { if (blockIdx.x < 64) ph_wkvb(); else ph_sguconv(l); SEAM(); } if (REPEAT_K == 13) { if (blockIdx.x < 64) ph_wkvb(); SEAM(); } if (REPEAT_K == 14) { if (blockIdx.x >= 64) ph_sguconv(l); SEAM(); } }\
        if (IN(3)) { ph_wkvc(l); SEAM(); if (REPEAT_K == 3) { ph_wkvc(l); SEAM(); } }\
        if (IN(4)) { ph_branch(l); SEAM(); if (REPEAT_K == 4) { ph_branch(l); SEAM(); } }\
        if (IN(5)) { ph_wout(l); SEAM(); if (REPEAT_K == 5) { ph_wout(l); SEAM(); } }\
        if (IN(6)) { if (blockIdx.x < 128) ph_router(l); else ph_ln1(l); SEAM(); if (REPEAT_K == 6) { if (blockIdx.x >= 128) ph_ln1(l); SEAM(); } if (REPEAT_K == 7) { if (blockIdx.x < 128) ph_router_probe(l); SEAM(); } }\
        if (IN(8)) { ph_moe1(l); SEAM(); if (REPEAT_K == 8) { ph_moe1(l); SEAM(); } }\
        if (IN(9)) { ph_moe2(l); SEAM(); if (REPEAT_K == 9) { ph_moe2(l); SEAM(); } if (REPEAT_K == 19) { ph_moe2_nostore(l); SEAM(); } }\
        if (IN(10)) { if (REPEAT_K == 10) { ph_ln2(l); SEAM(); } if (REPEAT_K == 12) { SEAM(); SEAM(); SEAM(); SEAM(); SEAM(); SEAM(); SEAM(); SEAM(); SEAM(); SEAM(); } ph_ln2(l); if (l + 1 < NL) SEAM(); } } while (0)
    RUN_LAYER(0); RUN_LAYER(1); RUN_LAYER(2); RUN_LAYER(3);
#undef RUN_LAYER
#undef IN
#undef SEAM
}

extern "C" void kernel_launch(void* const* d_in, const int* in_sizes, int n_in, void* d_out, int out_size, void* d_ws, size_t ws_size, hipStream_t stream) {
    static int grid = 0;
    if (grid == 0) {
        if (n_in != 38 || in_sizes[0] != T * D || out_size != T * D || ws_size < WS_END) { fprintf(stderr, "kernel_launch: unexpected shapes (n_in %d, in0 %d, out %d, ws %zu, need %zu); nothing launched\n", n_in, n_in > 0 ? in_sizes[0] : -1, out_size, ws_size, (size_t)WS_END); grid = -1; return; }
        int dev = 0, cus = 0, per_cu = 0;
        if (hipGetDevice(&dev) != hipSuccess || hipDeviceGetAttribute(&cus, hipDeviceAttributeMultiprocessorCount, dev) != hipSuccess) { grid = -1; return; }
        if (hipFuncSetAttribute((const void*)fwd_kernel, hipFuncAttributeMaxDynamicSharedMemorySize, LDS_BYTES) != hipSuccess) { fprintf(stderr, "kernel_launch: hipFuncSetAttribute failed\n"); grid = -1; return; }
        if (hipOccupancyMaxActiveBlocksPerMultiprocessor(&per_cu, (const void*)fwd_kernel, 512, LDS_BYTES) != hipSuccess || per_cu < 1) fprintf(stderr, "kernel_launch: occupancy query reports %d blocks per CU\n", per_cu);
        (void)hipGetLastError();
        grid = cus;
        if (grid != 256) { fprintf(stderr, "kernel_launch: built for a 256-CU device, found %d CUs; nothing launched\n", cus); grid = -1; return; }
    }
    if (grid < 0) return;
    (void)hipMemsetAsync((char*)d_ws + WS_CTL, 0, CTL_BYTES, stream);
    Params p{};
    for (int i = 0; i < 38; ++i) p.in[i] = (const float*)d_in[i];
    p.out = (float*)d_out; p.ws = (unsigned char*)d_ws; p.layer_lo = 0; p.layer_hi = NL;
#if ONE_LAUNCH
    p.phase_lo = 0; p.phase_hi = N_PHASES;
    hipLaunchKernelGGL(fwd_kernel, dim3(grid), dim3(512), LDS_BYTES, stream, p);
#else
    for (int ph = 0; ph < N_PHASES; ++ph) { p.phase_lo = ph; p.phase_hi = ph + 1; hipLaunchKernelGGL(fwd_kernel, dim3(grid), dim3(512), LDS_BYTES, stream, p); }
#endif
}
```

```cpp
#include <hip/hip_runtime.h>
#include <stdint.h>
#include <stdio.h>

#ifndef DEBUG_MODE
#define DEBUG_MODE 0
#endif
#ifndef REPEAT_K
#define REPEAT_K -1
#endif
#ifndef ONE_LAUNCH
#define ONE_LAUNCH 1
#endif

#define LAS __attribute__((address_space(3)))
typedef unsigned short bf16_t;
typedef short bf16x8 __attribute__((ext_vector_type(8)));
typedef float f32x4 __attribute__((ext_vector_type(4)));
typedef float f32x2 __attribute__((ext_vector_type(2)));
typedef unsigned u32x4 __attribute__((ext_vector_type(4)));
typedef unsigned u32x2 __attribute__((ext_vector_type(2)));

constexpr int T = 32768, SEQ = 2048, D = 1024, NL = 4;
constexpr int NIN = 5888;
constexpr int RKVW = 1792;
constexpr int NE = 32;
constexpr float ALPHA = 1.681792830507429f;
constexpr float LN_EPS = 1e-5f, GN_EPS = 64e-5f;

constexpr size_t MiB = 1u << 20;
constexpr size_t WS_CTL = 0;
constexpr size_t WS_WIN = 1 * MiB;
constexpr size_t WS_WBR = WS_WIN + 46 * MiB;
constexpr size_t WS_WOUT = WS_WBR + 8 * MiB;
constexpr size_t WS_WRT = WS_WOUT + 8 * MiB;
constexpr size_t WS_WMOE = WS_WRT + 1 * MiB;
constexpr size_t WS_X = WS_WMOE + 96 * MiB;
constexpr size_t WS_X1 = WS_X + 64 * MiB;
constexpr size_t WS_VFIRST = WS_X1 + 64 * MiB;
constexpr size_t WS_RKV = WS_VFIRST + 32 * MiB;
constexpr size_t WS_SGUZ = WS_RKV + 112 * MiB;
constexpr size_t WS_CONVH = WS_SGUZ + 32 * MiB;
constexpr size_t WS_GATES = WS_CONVH + 16 * MiB;
constexpr size_t WS_PHI = WS_GATES + 192 * MiB;
constexpr size_t WS_PSI = WS_PHI + 32 * MiB;
constexpr size_t WS_GT = WS_PSI + 32 * MiB;
constexpr size_t WS_Y0T = WS_GT + 32 * MiB;
constexpr size_t WS_VT = WS_Y0T + 32 * MiB;
constexpr size_t WS_MT = WS_VT + 32 * MiB;
constexpr size_t WS_RK = WS_MT + 32 * MiB;
constexpr size_t WS_LORA = WS_RK + 1 * MiB;
constexpr size_t WS_SGUW = WS_LORA + 1 * MiB;
constexpr size_t WS_OUTA = WS_SGUW + 1 * MiB;
constexpr size_t WS_HB = WS_OUTA + 32 * MiB;
constexpr size_t WS_HC = WS_HB + 16 * MiB;
constexpr size_t WS_XQ = WS_HC + 16 * MiB;
constexpr size_t WS_END = WS_XQ + 32 * MiB;
constexpr size_t WS_X1Q = WS_WMOE + 64 * MiB;
constexpr size_t WS_STATS = WS_Y0T;
constexpr size_t WS_WRG = WS_WBR + 4 * MiB;
constexpr size_t WS_RC = WS_SGUW + 512 * 1024;
constexpr size_t WS_MERGEDQ = WS_GT;
constexpr size_t WS_MERGED = WS_RKV;
constexpr size_t WS_PRE = WS_PHI;
constexpr size_t WS_H = WS_RKV;
constexpr size_t WS_Y = WS_GATES;
constexpr size_t WS_LIST = WS_SGUZ;
constexpr size_t WS_GATEV = WS_SGUZ + 16 * MiB;
static_assert(WS_END <= 1024 * MiB, "workspace map");
#if DEBUG_MODE
constexpr size_t WS_SV = WS_GATES, WS_SA = WS_SV + 32 * MiB, WS_SB = WS_SA + 32 * MiB, WS_SR = WS_SB + 32 * MiB, WS_SK = WS_SR + 32 * MiB, WS_SG = WS_SK + 32 * MiB;
constexpr size_t WS_SW = WS_X1;
constexpr size_t DBG_OUTAREF = WS_WMOE, DBG_MREF = WS_WMOE + 32 * MiB, DBG_YREF = WS_SGUZ, DBG_RKREF = WS_HB, DBG_YDBG = WS_HC;
#endif
constexpr int CW_BAR = 4096;
constexpr int CW_CNT = 16384;
constexpr size_t CTL_BYTES = 1 * MiB;

constexpr int LDS_STAGE = 131072;
constexpr int LDS_MISC = LDS_STAGE;
constexpr int LDS_RAW = LDS_STAGE + 4096;
constexpr int LDS_BYTES = 163840;

typedef __bf16 bf16x2_t __attribute__((ext_vector_type(2)));
__device__ __forceinline__ unsigned cvt_pk_bf16(float lo, float hi) { const f32x2 v = {lo, hi}; const bf16x2_t b = __builtin_convertvector(v, bf16x2_t); return __builtin_bit_cast(unsigned, b); }
__device__ __forceinline__ unsigned pack_fp8x4(float a, float b, float c, float d) { int w = 0; w = __builtin_amdgcn_cvt_pk_fp8_f32(a, b, w, false); w = __builtin_amdgcn_cvt_pk_fp8_f32(c, d, w, true); return (unsigned)w; }
__device__ __forceinline__ bf16_t f2bf(float f) { return (bf16_t)(cvt_pk_bf16(f, 0.f) & 0xffffu); }
__device__ __forceinline__ float bf2f(unsigned short b) { return __uint_as_float(((unsigned)b) << 16); }
__device__ __forceinline__ float bflo(unsigned w) { return __uint_as_float(w << 16); }
__device__ __forceinline__ float bfhi(unsigned w) { return __uint_as_float(w & 0xffff0000u); }
__device__ __forceinline__ float sigmoidf_(float x) { return __builtin_amdgcn_rcpf(1.0f + __expf(-x)); }
template <int CTRL> __device__ __forceinline__ float dpp_mov(float x) { return __builtin_bit_cast(float, __builtin_amdgcn_mov_dpp(__builtin_bit_cast(int, x), CTRL, 0xF, 0xF, true)); }
__device__ __forceinline__ float row16_sum(float v) { v += dpp_mov<0xB1>(v); v += dpp_mov<0x4E>(v); v += dpp_mov<0x141>(v); v += dpp_mov<0x140>(v); return v; }
__device__ __forceinline__ float wave_sum(float v) {
    v = row16_sum(v); const int vi = __builtin_bit_cast(int, v);
    return (__builtin_bit_cast(float, __builtin_amdgcn_readlane(vi, 0)) + __builtin_bit_cast(float, __builtin_amdgcn_readlane(vi, 16))) + (__builtin_bit_cast(float, __builtin_amdgcn_readlane(vi, 32)) + __builtin_bit_cast(float, __builtin_amdgcn_readlane(vi, 48)));
}
__device__ __forceinline__ float dpp_f(float x, const int ctrl_sel) {
    int xi = __builtin_bit_cast(int, x), r;
    if (ctrl_sel == 0) r = __builtin_amdgcn_update_dpp(0, xi, 0xB1, 0xF, 0xF, true);
    else if (ctrl_sel == 1) r = __builtin_amdgcn_update_dpp(0, xi, 0x4E, 0xF, 0xF, true);
    else r = __builtin_amdgcn_update_dpp(0, xi, 0x141, 0xF, 0xF, true);
    return __builtin_bit_cast(float, r);
}
__device__ __forceinline__ float reduce8(float x) { x += dpp_f(x, 0); x += dpp_f(x, 1); x += dpp_f(x, 2); return x; }
__device__ __forceinline__ float gelu_f(float v) {
    const float av = fabsf(v), t = __builtin_amdgcn_rcpf(av * 0.2316418882f + 1.0f);
    float q = t * 0.5307027145f + (-0.7265760135f); q = q * t + 0.7107068705f; q = q * t + (-0.142248368f); q = q * t + 0.127414796f; q = q * t;
    const float e = __builtin_amdgcn_exp2f((v * v) * (-0.72134752044f));
    const float m = v * (q * e);
    return v < 0.f ? m : v - m;
}

#define XB_TMO      128
#define XB_XCNT(j)  (256  + 64 * (j))
#define XB_XSUB(j)  (1280 + 64 * (j))
#define XB_XGEN(j)  (2304 + 64 * (j))
#define XB_TOP      3328
#define XB_TOPGEN   3392
#define XCD_BAR_WORDS 3456
#define XB_SPIN_CAP (1u << 22)
__device__ __forceinline__ unsigned xb_ld(unsigned* p)              { return __hip_atomic_load(p, __ATOMIC_RELAXED, __HIP_MEMORY_SCOPE_AGENT); }
__device__ __forceinline__ unsigned xb_add(unsigned* p, unsigned v) { return __hip_atomic_fetch_add(p, v, __ATOMIC_RELAXED, __HIP_MEMORY_SCOPE_AGENT); }
__device__ __forceinline__ unsigned xb_xcc_id() { return (unsigned)__builtin_amdgcn_s_getreg((3 << 11) | 20) & 0xFu; }
#define XB_SPIN(cond, bar) do { unsigned _sp = 0; while (cond) { __builtin_amdgcn_s_sleep(1); \
    if ((++_sp & 255u) == 0u) { if (xb_ld(&(bar)[XB_TMO])) break; if (_sp > XB_SPIN_CAP) { atomicAdd(&(bar)[XB_TMO], 1u); break; } } } } while (0)
struct XcdBarrier { unsigned* bar; unsigned x; volatile LAS unsigned* st; };
__device__ __forceinline__ XcdBarrier xcd_barrier_post(unsigned* bar, volatile LAS unsigned* st) {
    XcdBarrier b; b.bar = bar; b.x = xb_xcc_id(); b.st = st;
    if (threadIdx.x == 0) (void)xb_add(&bar[XB_XCNT(b.x)], 1u);
    return b;
}
__device__ __forceinline__ void xcd_barrier_complete(unsigned* bar, unsigned x, unsigned& nloc, unsigned& nx) {
    const unsigned G = gridDim.x * gridDim.y * gridDim.z;
    unsigned sum, cnt, mine, sp = 0u;
    for (;;) {
        sum = 0u; cnt = 0u; mine = 0u;
#pragma unroll
        for (unsigned j = 0; j < 16; ++j) { const unsigned c = xb_ld(&bar[XB_XCNT(j)]); sum += c; cnt += (c > 0u) ? 1u : 0u; mine = (j == x) ? c : mine; }
        if (sum == G) break;
        __builtin_amdgcn_s_sleep(1);
        if ((++sp & 255u) == 0u) { if (xb_ld(&bar[XB_TMO])) break; if (sp > XB_SPIN_CAP) { atomicAdd(&bar[XB_TMO], 1u); break; } }
    }
    nloc = mine > 0u ? mine : 1u; nx = cnt > 0u ? cnt : 1u;
}
__device__ __forceinline__ void xcd_barrier(const XcdBarrier& b) {
    asm volatile("s_waitcnt vmcnt(0)" ::: "memory");
    __syncthreads();
    if (threadIdx.x == 0) {
        unsigned* bar = b.bar;
        __builtin_amdgcn_s_waitcnt(0);
        unsigned nloc = b.st[0], nx = b.st[1];
        if (nloc == 0u) { xcd_barrier_complete(bar, b.x, nloc, nx); b.st[0] = nloc; b.st[1] = nx; }
        const unsigned old = xb_add(&bar[XB_XSUB(b.x)], 1u);
        const unsigned gen = old / nloc;
        if (old + 1u == (gen + 1u) * nloc) {
            __builtin_amdgcn_fence(__ATOMIC_RELEASE, "agent");
            asm volatile("s_waitcnt vmcnt(0)" ::: "memory");
            const unsigned og = xb_add(&bar[XB_TOP], 1u);
            const unsigned tg = og / nx;
            if (og + 1u == (tg + 1u) * nx) xb_add(&bar[XB_TOPGEN], 1u);
            else XB_SPIN(xb_ld(&bar[XB_TOPGEN]) == tg, bar);
            __builtin_amdgcn_fence(__ATOMIC_ACQUIRE, "agent");
            xb_add(&bar[XB_XGEN(b.x)], 1u);
            asm volatile("s_waitcnt vmcnt(0)" ::: "memory");
        } else {
            XB_SPIN(xb_ld(&bar[XB_XGEN(b.x)]) == gen, bar);
            __builtin_amdgcn_fence(__ATOMIC_ACQUIRE, "agent");
            asm volatile("s_waitcnt vmcnt(0)" ::: "memory");
        }
    }
    __syncthreads();
}

struct Params {
    const float* in[38];
    float* out;
    unsigned char* ws;
    int phase_lo, phase_hi;
    int layer_lo, layer_hi;
};

namespace ge {
constexpr int BM = 256, BK = 64, HALF = 128, HTB = HALF * BK * 2;
__device__ __forceinline__ int lds_byte(int r, int c) { const int st = (r >> 4) * 2 + (c >> 5), rr = r & 15, cc = c & 31, ob = rr * 64 + cc * 2; return st * 1024 + (ob ^ (((ob >> 9) & 1) << 5)); }
__device__ __forceinline__ void stage_rc(int b, int& R, int& C) { const int st = b / 1024, sb = b % 1024, swz = sb ^ (((sb >> 9) & 1) << 5); R = (st >> 1) * 16 + swz / 64; C = (st & 1) * 32 + (swz % 64) / 2; }
__device__ __forceinline__ int perm32(int rho) { const int n = rho >> 4, i = rho & 15; return 8 * (i >> 2) + 4 * n + (i & 3); }

struct NoPre { };
struct Unit {
    const char* A; const char* B;
    const int* gat;
    unsigned lda, ldb;
    int nt;
    int gshift, nvalid;
    int pm, pn, aux;
};
typedef f32x4 Acc[2][2][4][2];

typedef int i32x8 __attribute__((ext_vector_type(8)));
template <class Sched, class Epi, bool FP8 = false, int SCALE_W = 0x7A7A7A7A, int SCALE_A = 0x7F7F7F7F>
__device__ __forceinline__ void gemm_phase(LAS unsigned char* lds, const Sched& S, const Epi& E) {
    int tid = threadIdx.x; asm volatile("" : "+v"(tid));
    const int wid = __builtin_amdgcn_readfirstlane(tid >> 6), lane = tid & 63, wr = wid >> 2, wc = wid & 3, fr = lane & 15, fq = lane >> 4;
    const unsigned ldsw = (unsigned)wid * 1024u;
    const int aoff = FP8 ? lds_byte(wr * 64 + fr, fq * 16) : lds_byte(wr * 64 + fr, fq * 8), boff = FP8 ? lds_byte(wc * 32 + fr, fq * 16) : lds_byte(wc * 32 + fr, fq * 8);
    const int aoff1 = FP8 ? lds_byte(wr * 64 + fr, fq * 16 + 8) : aoff + 1024, boff1 = FP8 ? lds_byte(wc * 32 + fr, fq * 16 + 8) : boff + 1024;
#define GE_SA(b, h) (((b) * 2 + (h)) * HTB)
#define GE_SB(b, h) ((4 + (b) * 2 + (h)) * HTB)
#define GE_STAGE(bufoff, gbase, o0, o1) do { \
        __builtin_amdgcn_global_load_lds((const unsigned*)((gbase) + (o0)), (LAS unsigned*)(lds + (bufoff) + ldsw), 16, 0, 0); \
        __builtin_amdgcn_global_load_lds((const unsigned*)((gbase) + (o1)), (LAS unsigned*)(lds + (bufoff) + ldsw + 8192), 16, 0, 0); } while (0)
#define GE_LDA(dst, b, h) do { _Pragma("unroll") for (int m = 0; m < 4; ++m) { dst[m][0] = *(const LAS bf16x8*)(lds + GE_SA(b, h) + aoff + m * 2048); dst[m][1] = *(const LAS bf16x8*)(lds + GE_SA(b, h) + aoff1 + m * 2048); } } while (0)
#define GE_LDB(dst, b, h) do { _Pragma("unroll") for (int n = 0; n < 2; ++n) { dst[n][0] = *(const LAS bf16x8*)(lds + GE_SB(b, h) + boff + n * 2048); dst[n][1] = *(const LAS bf16x8*)(lds + GE_SB(b, h) + boff1 + n * 2048); } } while (0)
#define GE_CAT(x0, x1) __builtin_shufflevector(__builtin_bit_cast(u32x4, x0), __builtin_bit_cast(u32x4, x1), 0, 1, 2, 3, 4, 5, 6, 7)
#define GE_MMA(ai, bj, At, Bt) do { __builtin_amdgcn_s_setprio(1); _Pragma("unroll") for (int m = 0; m < 4; ++m) _Pragma("unroll") for (int n = 0; n < 2; ++n) { \
        if constexpr (FP8) acc[ai][bj][m][n] = __builtin_amdgcn_mfma_scale_f32_16x16x128_f8f6f4(__builtin_bit_cast(i32x8, GE_CAT(Bt[n][0], Bt[n][1])), __builtin_bit_cast(i32x8, GE_CAT(At[m][0], At[m][1])), acc[ai][bj][m][n], 0, 0, 0, SCALE_W, 0, SCALE_A); \
        else { _Pragma("unroll") for (int k = 0; k < 2; ++k) acc[ai][bj][m][n] = __builtin_amdgcn_mfma_f32_16x16x32_bf16(Bt[n][k], At[m][k], acc[ai][bj][m][n], 0, 0, 0); } } __builtin_amdgcn_s_setprio(0); } while (0)
#define GE_WAIT_V(n) asm volatile("s_waitcnt vmcnt(" #n ")" ::: "memory")
#define GE_WAIT_L(n) asm volatile("s_waitcnt lgkmcnt(" #n ")" ::: "memory")
#define GE_BAR __builtin_amdgcn_s_barrier()
#define GE_SCHED __builtin_amdgcn_sched_barrier(0)
#define GE_OFFS(u, oA00, oA01, oA10, oA11, oB0, oB1) do { \
        int tq_ = tid; asm volatile("" : "+v"(tq_)); int R0, C0, R1, C1; stage_rc(tq_ * 16, R0, C0); stage_rc(tq_ * 16 + 8192, R1, C1); \
        const int Rb0 = (R0 & ~31) + perm32(R0 & 31), Rb1 = (R1 & ~31) + perm32(R1 & 31); \
        int r00 = R0, r01 = R1, r10 = 128 + R0, r11 = 128 + R1; \
        if ((u).gat) { const int* g_ = (u).gat; const int nv_ = (u).nvalid, sh_ = (u).gshift; \
            r00 = (r00 < nv_) ? (g_[2 * r00] >> sh_) : 0; r01 = (r01 < nv_) ? (g_[2 * r01] >> sh_) : 0; r10 = (r10 < nv_) ? (g_[2 * r10] >> sh_) : 0; r11 = (r11 < nv_) ? (g_[2 * r11] >> sh_) : 0; } \
        oA00 = (unsigned)r00 * (u).lda + (unsigned)C0 * 2u; oA01 = (unsigned)r01 * (u).lda + (unsigned)C1 * 2u; \
        oA10 = (unsigned)r10 * (u).lda + (unsigned)C0 * 2u; oA11 = (unsigned)r11 * (u).lda + (unsigned)C1 * 2u; \
        oB0 = (unsigned)Rb0 * (u).ldb + (unsigned)C0 * 2u; oB1 = (unsigned)Rb1 * (u).ldb + (unsigned)C1 * 2u; } while (0)
    Unit cur, nxt; int ui = 0;
    if (!S.next(0, cur)) return;
    Acc acc;
#pragma unroll
    for (int a = 0; a < 2; ++a)
#pragma unroll
        for (int b = 0; b < 2; ++b)
#pragma unroll
            for (int m = 0; m < 4; ++m)
#pragma unroll
                for (int n = 0; n < 2; ++n) acc[a][b][m][n] = (f32x4){0.f, 0.f, 0.f, 0.f};
    bf16x8 At[4][2], B0[2][2], B1[2][2];
    unsigned oA00, oA01, oA10, oA11, oB0, oB1;
    GE_OFFS(cur, oA00, oA01, oA10, oA11, oB0, oB1);
    typename Epi::Pre pre = E.prefetch(cur, wr, wc, fr, fq);
    const char* cA = cur.A; const char* cB = cur.B; size_t chB = (size_t)128 * cur.ldb;
    const size_t kstep = 128;
    GE_STAGE(GE_SB(0, 0), cB, oB0, oB1); GE_STAGE(GE_SA(0, 0), cA, oA00, oA01); GE_STAGE(GE_SB(0, 1), cB + chB, oB0, oB1); GE_STAGE(GE_SA(0, 1), cA, oA10, oA11);
    if (wr == 1) GE_BAR;
    GE_WAIT_V(4); GE_BAR;
    GE_STAGE(GE_SB(1, 0), cB + kstep, oB0, oB1); GE_STAGE(GE_SA(1, 0), cA + kstep, oA00, oA01); GE_STAGE(GE_SB(1, 1), cB + chB + kstep, oB0, oB1);
    GE_WAIT_V(6); GE_BAR;
    for (;;) {
        const bool has_next = S.next(ui + 1, nxt);
        const char* nA = has_next ? nxt.A : cA; const char* nB = has_next ? nxt.B : cB; const size_t nhB = has_next ? (size_t)128 * nxt.ldb : chB;
        const int nt = cur.nt;
        for (int t = 0; t < nt; t += 2) {
            const bool last = (t == nt - 2);
            const char* a1 = cA + (size_t)(t + 1) * kstep;
            const char* a2 = last ? nA : cA + (size_t)(t + 2) * kstep; const char* b2 = last ? nB : cB + (size_t)(t + 2) * kstep;
            const size_t hB2 = last ? nhB : chB;
            const char* a3 = a2 + kstep; const char* b3 = b2 + kstep;
            GE_LDB(B0, 0, 0); GE_SCHED; GE_LDA(At, 0, 0); GE_STAGE(GE_SA(1, 1), a1, oA10, oA11);
            if (last && has_next) { GE_OFFS(nxt, oA00, oA01, oA10, oA11, oB0, oB1); }
            GE_WAIT_L(8); GE_BAR; GE_WAIT_L(0); GE_MMA(0, 0, At, B0); GE_BAR; GE_SCHED;
            GE_LDB(B1, 0, 1); GE_STAGE(GE_SB(0, 0), b2, oB0, oB1);
            GE_BAR; GE_WAIT_L(0); GE_MMA(0, 1, At, B1); GE_BAR;
            GE_LDA(At, 0, 1); GE_STAGE(GE_SA(0, 0), a2, oA00, oA01);
            GE_BAR; GE_WAIT_L(0); GE_MMA(1, 0, At, B0); GE_BAR; GE_SCHED;
            GE_STAGE(GE_SB(0, 1), b2 + hB2, oB0, oB1);
            GE_WAIT_V(6); GE_BAR; GE_MMA(1, 1, At, B1); GE_BAR;
            GE_LDB(B0, 1, 0); GE_SCHED; GE_LDA(At, 1, 0); GE_STAGE(GE_SA(0, 1), a2, oA10, oA11);
            GE_WAIT_L(8); GE_BAR; GE_WAIT_L(0); GE_MMA(0, 0, At, B0); GE_BAR; GE_SCHED;
            GE_LDB(B1, 1, 1); GE_STAGE(GE_SB(1, 0), b3, oB0, oB1);
            GE_BAR; GE_WAIT_L(0); GE_MMA(0, 1, At, B1); GE_BAR;
            GE_LDA(At, 1, 1); GE_STAGE(GE_SA(1, 0), a3, oA00, oA01);
            GE_BAR; GE_WAIT_L(0); GE_MMA(1, 0, At, B0); GE_BAR; GE_SCHED;
            GE_STAGE(GE_SB(1, 1), b3 + hB2, oB0, oB1);
            GE_WAIT_V(6); GE_BAR; GE_MMA(1, 1, At, B1); GE_BAR;
        }
        if constexpr (!Epi::AFTER_DRAIN) E(acc, cur, wr, wc, fr, fq, pre);
        if (!has_next) break;
#pragma unroll
        for (int a = 0; a < 2; ++a)
#pragma unroll
            for (int b = 0; b < 2; ++b)
#pragma unroll
                for (int m = 0; m < 4; ++m)
#pragma unroll
                    for (int n = 0; n < 2; ++n) acc[a][b][m][n] = (f32x4){0.f, 0.f, 0.f, 0.f};
        cur = nxt; cA = nA; cB = nB; chB = nhB; ++ui; pre = E.prefetch(cur, wr, wc, fr, fq);
    }
    GE_WAIT_V(0);
    if (wr == 0) GE_BAR;
    GE_BAR;
    if constexpr (Epi::AFTER_DRAIN) E.drained(acc, cur, wr, wc, fr, fq, lds);
#undef GE_SA
#undef GE_SB
#undef GE_STAGE
#undef GE_LDA
#undef GE_LDB
#undef GE_MMA
#undef GE_WAIT_V
#undef GE_WAIT_L
#undef GE_BAR
#undef GE_SCHED
#undef GE_OFFS
#undef GE_CAT
}
__device__ __forceinline__ bool static_tile(long L, int nM, int nN, int& pm, int& pn) {
    const int nwg = nM * nN; if (L >= nwg) return false;
    int wgid = (int)L; { const int q = nwg / 8, r = nwg % 8, xcd = wgid % 8, off = wgid / 8; wgid = (xcd < r ? xcd * (q + 1) : r * (q + 1) + (xcd - r) * q) + off; }
    const int nig = 8 * nN, gid = wgid / nig, fm = gid * 8, gsz = (nM - fm) < 8 ? (nM - fm) : 8;
    pm = fm + ((wgid % nig) % gsz); pn = (wgid % nig) / gsz; return true;
}
}

struct Frame {
    LAS unsigned char* lds;
    int tid, lane, wave, G, vcu;
    unsigned char* ws;
    float* out;
};
#define WSP(T_, off) ((T_*)(F.ws + (off)))

extern __shared__ __attribute__((aligned(16))) unsigned char lds_raw[];
__device__ __forceinline__ Params load_params() {
    typedef const __attribute__((address_space(4))) unsigned long long cu64;
    cu64* k = (cu64*)__builtin_amdgcn_kernarg_segment_ptr();
    asm volatile("" : "+s"(k));
    Params P;
#pragma unroll
    for (int i = 0; i < 38; ++i) P.in[i] = (const float*)(const __attribute__((address_space(1))) float*)k[i];
    P.out = (float*)(__attribute__((address_space(1))) float*)k[38]; P.ws = (unsigned char*)(__attribute__((address_space(1))) unsigned char*)k[39];
    P.phase_lo = 0; P.phase_hi = 0; P.layer_lo = 0; P.layer_hi = 0;
    return P;
}
#define KPARAMS() load_params()
__device__ __forceinline__ Frame make_frame(unsigned char* ws, float* out) {
    Frame F;
    F.lds = (LAS unsigned char*)lds_raw;
    int tz = threadIdx.x; asm volatile("" : "+v"(tz));
    F.tid = tz; F.lane = F.tid & 63; F.wave = __builtin_amdgcn_readfirstlane(F.tid >> 6);
    F.G = gridDim.x; { const int bx = blockIdx.x; F.vcu = (F.G % 8 == 0) ? (bx % 8) * (F.G / 8) + bx / 8 : bx; }
    F.ws = ws; F.out = out;
    return F;
}
template <bool FP8OUT, class ColMap>
__device__ __forceinline__ void transpose_item(const float* W, int ldw, int K, void* WTv, int nblk, LAS float* scr, int item, int lane, const ColMap& cm) {
    const int kb = item / nblk, nb = item % nblk, k0 = 64 * kb, n0 = 32 * nb;
    const int sc = cm(n0 + (lane & 31));
#pragma unroll 8
    for (int i = 0; i < 32; ++i) { const int kk = 2 * i + (lane >> 5); scr[kk * 33 + (lane & 31)] = (sc >= 0) ? W[(size_t)(k0 + kk) * ldw + sc] : 0.f; }
    asm volatile("s_waitcnt lgkmcnt(0)" ::: "memory");
    const int c = lane & 7;
#pragma unroll
    for (int j = 0; j < 4; ++j) { const int n = (lane >> 3) + 8 * j; const LAS float* s = scr + (8 * c) * 33 + n;
        if (FP8OUT) { u32x2 o; o.x = pack_fp8x4(32.f * s[0 * 33], 32.f * s[1 * 33], 32.f * s[2 * 33], 32.f * s[3 * 33]); o.y = pack_fp8x4(32.f * s[4 * 33], 32.f * s[5 * 33], 32.f * s[6 * 33], 32.f * s[7 * 33]);
            *(u32x2*)((unsigned char*)WTv + (size_t)(n0 + n) * K + k0 + 8 * c) = o; }
        else { u32x4 o; o.x = cvt_pk_bf16(s[0 * 33], s[1 * 33]); o.y = cvt_pk_bf16(s[2 * 33], s[3 * 33]); o.z = cvt_pk_bf16(s[4 * 33], s[5 * 33]); o.w = cvt_pk_bf16(s[6 * 33], s[7 * 33]);
            *(u32x4*)((bf16_t*)WTv + (size_t)(n0 + n) * K + k0 + 8 * c) = o; } }
    asm volatile("s_waitcnt lgkmcnt(0)" ::: "memory");
}
struct CmIdent { __device__ __forceinline__ int operator()(int n) const { return n; } };
struct CmInproj { int layer; __device__ __forceinline__ int operator()(int j) const {
    if (j < 1536) return j;
    if (j < 1792) { const int q = j - 1536; if (q < 160) return 1536 + q; if (q < 192) return layer > 0 ? 5792 + (q - 160) : -1; return -1; }
    if (j < 2304) return 1696 + (j - 1792);
    if (j < 2816) { const int jj = j - 2304, c = jj >> 1; return (jj & 1) ? 2208 + 256 + c : 2208 + c; }
    return 2720 + (j - 2816); } };
struct CmRouter { __device__ __forceinline__ int operator()(int n) const { return n < 32 ? n : -1; } };
struct CmGU { __device__ __forceinline__ int operator()(int n) const { return n; } };

template <bool FP8OUT> __device__ __forceinline__ void moe_item_store(void* WTv, int K, int k0, int n0, LAS float* scr, int lane) {
    asm volatile("s_waitcnt lgkmcnt(0)" ::: "memory");
    const int c = lane & 7;
#pragma unroll
    for (int j = 0; j < 4; ++j) { const int nn = (lane >> 3) + 8 * j; const LAS float* s = scr + (8 * c) * 33 + nn;
        if (FP8OUT) { u32x2 o; o.x = pack_fp8x4(32.f * s[0 * 33], 32.f * s[1 * 33], 32.f * s[2 * 33], 32.f * s[3 * 33]); o.y = pack_fp8x4(32.f * s[4 * 33], 32.f * s[5 * 33], 32.f * s[6 * 33], 32.f * s[7 * 33]);
            *(u32x2*)((unsigned char*)WTv + (size_t)(n0 + nn) * K + k0 + 8 * c) = o; }
        else { u32x4 o; o.x = cvt_pk_bf16(s[0 * 33], s[1 * 33]); o.y = cvt_pk_bf16(s[2 * 33], s[3 * 33]); o.z = cvt_pk_bf16(s[4 * 33], s[5 * 33]); o.w = cvt_pk_bf16(s[6 * 33], s[7 * 33]);
            *(u32x4*)((bf16_t*)WTv + (size_t)(n0 + nn) * K + k0 + 8 * c) = o; } }
    asm volatile("s_waitcnt lgkmcnt(0)" ::: "memory");
}
__device__ __forceinline__ void fast_item_plain(const float* W, int ldw, int K, unsigned char* WT, int nblk, LAS float* scr, int item, int lane) {
    const int kb = item / nblk, nb = item % nblk, k0 = 64 * kb, n0 = 32 * nb; const int c4 = (lane & 7) * 4; const float* Ws = W + n0 + c4;
    f32x4 v[8];
#pragma unroll
    for (int i = 0; i < 8; ++i) v[i] = *(const f32x4*)(Ws + (size_t)(k0 + 8 * i + (lane >> 3)) * ldw);
#pragma unroll
    for (int i = 0; i < 8; ++i) { LAS float* d = scr + (8 * i + (lane >> 3)) * 33 + c4; d[0] = v[i][0]; d[1] = v[i][1]; d[2] = v[i][2]; d[3] = v[i][3]; }
    moe_item_store<true>(WT, K, k0, n0, scr, lane);
}
__device__ __forceinline__ void phase_convert_static(Frame& F, const Params& P) {
    LAS float* scr = (LAS float*)(F.lds + F.wave * 8448);
    const int gw = F.vcu * 8 + F.wave, NGW = F.G * 8;
    constexpr int I_IN = 16 * (NIN / 32);
    for (int it = gw; it < NL * I_IN; it += NGW) { const int l = it / I_IN, r = it % I_IN; const int lane = F.lane;
        const float* W = (l == 0) ? P.in[1] : P.in[2] + (size_t)(l - 1) * 1024 * 5824; const int ldw = (l == 0) ? 5792 : 5824;
        const int kb = r / (NIN / 32), nb = r % (NIN / 32), k0 = 64 * kb, n0 = 32 * nb;
        f32x4 v[8];
        if (n0 >= 2304 && n0 < 2816) {
            const int m = (lane >> 2) & 1, c4 = (lane & 3) * 4; const float* Ws = W + 2208 + 256 * m + ((n0 - 2304) >> 1) + c4;
#pragma unroll
            for (int i = 0; i < 8; ++i) v[i] = *(const f32x4*)(Ws + (size_t)(k0 + 8 * i + (lane >> 3)) * ldw);
#pragma unroll
            for (int i = 0; i < 8; ++i) { LAS float* d = scr + (8 * i + (lane >> 3)) * 33 + 2 * c4 + m; d[0] = v[i][0]; d[2] = v[i][1]; d[4] = v[i][2]; d[6] = v[i][3]; }
        } else {
            int src = n0; bool zero = false;
            if (n0 >= 1696 && n0 < 1728) { src = 5792 + (n0 - 1696); zero = (l == 0); } else if (n0 >= 1728 && n0 < 1792) zero = true; else if (n0 >= 1792) src = n0 - 96;
            const int c4 = (lane & 7) * 4; const float* Ws = W + (zero ? 0 : src) + c4;
#pragma unroll
            for (int i = 0; i < 8; ++i) { v[i] = *(const f32x4*)(Ws + (size_t)(k0 + 8 * i + (lane >> 3)) * ldw); if (zero) v[i] = (f32x4){0.f, 0.f, 0.f, 0.f}; }
#pragma unroll
            for (int i = 0; i < 8; ++i) { LAS float* d = scr + (8 * i + (lane >> 3)) * 33 + c4; d[0] = v[i][0]; d[1] = v[i][1]; d[2] = v[i][2]; d[3] = v[i][3]; }
        }
        moe_item_store<true>(WSP(unsigned char, WS_WIN) + (size_t)l * NIN * 1024, 1024, k0, n0, scr, lane); }
    constexpr int I_A = 8 * 32, I_B = 4 * 32;
    for (int it = gw; it < NL * (I_A + 2 * I_B); it += NGW) { const int l = it / (I_A + 2 * I_B); int r = it % (I_A + 2 * I_B);
        unsigned char* base = WSP(unsigned char, WS_WBR) + (size_t)l * (1024 * 1024);
        if (r < I_A) { fast_item_plain(P.in[17] + (size_t)l * 512 * 1024, 1024, 512, base, 32, scr, r, F.lane); continue; } r -= I_A;
        if (r < I_B) { fast_item_plain(P.in[22] + (size_t)l * 256 * 1024, 1024, 256, base + 1024 * 512, 32, scr, r, F.lane); continue; } r -= I_B;
        fast_item_plain(P.in[27] + (size_t)l * 256 * 1024, 1024, 256, base + 1024 * 512 + 1024 * 256, 32, scr, r, F.lane); }
    constexpr int I_O = 16 * 32;
    for (int it = gw; it < NL * I_O; it += NGW) { const int l = it / I_O, r = it % I_O;
        fast_item_plain(P.in[28] + (size_t)l * 1024 * 1024, 1024, 1024, WSP(unsigned char, WS_WOUT) + (size_t)l * 1024 * 1024, 32, scr, r, F.lane); }
    for (int it = gw; it < 16 * 8; it += NGW) transpose_item<false>(P.in[31], 32, 1024, WSP(bf16_t, WS_WRT), 8, scr, it, F.lane, CmRouter{});
}
__device__ __forceinline__ unsigned char* moe_wbuf(Frame& F, int l) { return (l & 1) ? (unsigned char*)F.out : F.ws + WS_WMOE; }
__device__ __forceinline__ void phase_convert_moe(Frame& F, const Params& P, int l) {
    LAS float* scr = (LAS float*)(F.lds + F.wave * 8448);
    const int gw = F.vcu * 8 + F.wave, NGW = F.G * 8; const int lane = F.lane;
    constexpr int I_GU = 16 * 32;
    constexpr int I_DN = 8 * 32;
    for (int it = gw; it < NE * I_GU; it += NGW) { const int e = it / I_GU, item = it % I_GU;
        const int kb = item / 32, nb = item % 32, k0 = 64 * kb, n0 = 32 * nb;
        const int m = (lane >> 2) & 1, c4 = (lane & 3) * 4;
        const float* Ws = ((m ? P.in[34] : P.in[33]) + ((size_t)l * NE + e) * 1024 * 512) + (n0 >> 1) + c4;
        f32x4 v[8];
#pragma unroll
        for (int i = 0; i < 8; ++i) v[i] = *(const f32x4*)(Ws + (size_t)(k0 + 8 * i + (lane >> 3)) * 512);
#pragma unroll
        for (int i = 0; i < 8; ++i) { LAS float* d = scr + (8 * i + (lane >> 3)) * 33 + 2 * c4 + m; d[0] = v[i][0]; d[2] = v[i][1]; d[4] = v[i][2]; d[6] = v[i][3]; }
        moe_item_store<true>(moe_wbuf(F, l) + (size_t)e * 1024 * 1024, 1024, k0, n0, scr, lane); }
    for (int it = gw; it < NE * I_DN; it += NGW) { const int e = it / I_DN, item = it % I_DN;
        const int kb = item / 32, nb = item % 32, k0 = 64 * kb, n0 = 32 * nb; const int c4 = (lane & 7) * 4;
        const float* Ws = P.in[35] + ((size_t)l * NE + e) * 512 * 1024 + n0 + c4;
        f32x4 v[8];
#pragma unroll
        for (int i = 0; i < 8; ++i) v[i] = *(const f32x4*)(Ws + (size_t)(k0 + 8 * i + (lane >> 3)) * 1024);
#pragma unroll
        for (int i = 0; i < 8; ++i) { LAS float* d = scr + (8 * i + (lane >> 3)) * 33 + c4; d[0] = v[i][0]; d[1] = v[i][1]; d[2] = v[i][2]; d[3] = v[i][3]; }
        moe_item_store<true>(moe_wbuf(F, l) + (size_t)NE * 1024 * 1024 + (size_t)e * 1024 * 512, 512, k0, n0, scr, lane); }
}
__device__ __forceinline__ void phase_convert_lora(Frame& F, const Params& P) {
    bf16_t* dst = WSP(bf16_t, WS_LORA);
    for (int idx = (int)blockIdx.x * 512 + F.tid; idx < 11 * 512 * 32 + 4 * 512 * 96; idx += F.G * 512) {
        float val;
        if (idx < 11 * 512 * 32) { const int m = idx / (512 * 32), rem = idx % (512 * 32), ch = rem / 32, i = rem % 32;
            if (m < 4) val = P.in[6][((size_t)m * 32 + i) * 512 + ch]; else if (m < 8) val = P.in[8][((size_t)(m - 4) * 32 + i) * 512 + ch]; else val = P.in[11][((size_t)(m - 8) * 32 + i) * 512 + ch]; }
        else { const int r2 = idx - 11 * 512 * 32, m = r2 / (512 * 96), rem = r2 % (512 * 96), ch = rem / 96, i = rem % 96; val = P.in[9][((size_t)m * 96 + i) * 512 + ch]; }
        dst[idx] = f2bf(val); }
}
__device__ __forceinline__ void phase_convert_sgu(Frame& F, const Params& P) {
    bf16_t* dst = WSP(bf16_t, WS_SGUW);
    for (int idx = (int)blockIdx.x * 512 + F.tid; idx < NL * 4 * 128 * 128; idx += F.G * 512) { const int p = (idx >> 7) & 127, qq = idx & 127; dst[idx] = f2bf(qq <= p ? P.in[20][idx] : 0.f); }
}
__device__ __forceinline__ void phase_convert_router(Frame& F, const Params& P) {
    bf16_t* dst = WSP(bf16_t, WS_WRG); float* rc = WSP(float, WS_RC);
    for (int idx = (int)blockIdx.x * 512 + F.tid; idx < NL * 256 * 1024; idx += F.G * 512) { const int l = idx >> 18, n = (idx >> 10) & 255, k = idx & 1023;
        dst[idx] = f2bf(n < 32 ? P.in[29][(size_t)l * 1024 + k] * P.in[31][(size_t)k * 32 + n] : 0.f); }
    const int gwv = (int)blockIdx.x * 8 + F.wave;
    if (gwv < NL * 32) { const int l = gwv >> 5, e = gwv & 31; float c1 = 0.f, c0 = 0.f;
#pragma unroll
        for (int j = 0; j < 16; ++j) { const int k = F.lane + 64 * j; const float w = P.in[31][(size_t)k * 32 + e]; c1 += P.in[29][(size_t)l * 1024 + k] * w; c0 += P.in[30][(size_t)l * 1024 + k] * w; }
        c1 = wave_sum(c1); c0 = wave_sum(c0);
        if (F.lane == 0) { rc[l * 64 + e] = c1; rc[l * 64 + 32 + e] = c0; } }
}
__device__ __forceinline__ void phase_x_to_bf16(Frame& F, const Params& P) {
    const size_t n8 = (size_t)T * D / 8; const float* x = P.in[0]; bf16_t* xb = WSP(bf16_t, WS_X); unsigned char* xq = WSP(unsigned char, WS_XQ);
    for (size_t i = (size_t)blockIdx.x * 512 + F.tid; i < n8; i += (size_t)F.G * 512) {
        const f32x4 a = *(const f32x4*)(x + i * 8), b = *(const f32x4*)(x + i * 8 + 4);
        u32x4 o; o.x = cvt_pk_bf16(a[0], a[1]); o.y = cvt_pk_bf16(a[2], a[3]); o.z = cvt_pk_bf16(b[0], b[1]); o.w = cvt_pk_bf16(b[2], b[3]);
        *(u32x4*)(xb + i * 8) = o;
        u32x2 qv; qv.x = pack_fp8x4(a[0], a[1], a[2], a[3]); qv.y = pack_fp8x4(b[0], b[1], b[2], b[3]); *(u32x2*)(xq + i * 8) = qv; }
}

struct SchedInproj { const char* X; const char* W; int G, c;
    __device__ __forceinline__ bool next(int i, ge::Unit& u) const { int pm, pn; if (!ge::static_tile((long)i * G + c, T / 256, NIN / 256, pm, pn)) return false;
        u.A = X + (size_t)pm * 256 * 1024; u.B = W + (size_t)pn * 256 * 1024; u.gat = nullptr; u.lda = 1024; u.ldb = 1024; u.nt = 8; u.gshift = 0; u.nvalid = 256; u.pm = pm; u.pn = pn; u.aux = 0; return true; } };
struct EpiInproj { static constexpr bool AFTER_DRAIN = false; bf16_t* rkv; bf16_t* sguz; bf16_t* convh; unsigned char* gates;
    typedef ge::NoPre Pre; __device__ __forceinline__ Pre prefetch(const ge::Unit&, int, int, int, int) const { return Pre{}; }
    __device__ __forceinline__ void operator()(const ge::Acc& acc, const ge::Unit& u, int wr, int wc, int fr, int fq, const Pre&) const {
        const int pn = u.pn; const int row0 = u.pm * 256 + wr * 64 + fr;
        int kind, ld, colt; bf16_t* base;
        if (pn < 7) { kind = 0; base = rkv; ld = RKVW; colt = pn * 256; }
        else if (pn < 9) { kind = 1; base = sguz; ld = 512; colt = (pn - 7) * 256; }
        else if (pn < 11) { kind = 2; base = convh; ld = 256; colt = (pn - 9) * 128; }
        else { kind = 3; base = rkv; ld = 3072; colt = (pn - 11) * 256; }
#pragma unroll
        for (int ai = 0; ai < 2; ++ai)
#pragma unroll
            for (int m = 0; m < 4; ++m) { const size_t r = (size_t)(row0 + ai * 128 + m * 16);
#pragma unroll
                for (int bj = 0; bj < 2; ++bj) { const int c = 128 * bj + 32 * wc + 8 * fq; f32x4 v0 = acc[ai][bj][m][0], v1 = acc[ai][bj][m][1];
                    if (kind == 2) {
                        const float h0 = v0[0] * sigmoidf_(v0[1]), h1 = v0[2] * sigmoidf_(v0[3]), h2 = v1[0] * sigmoidf_(v1[1]), h3 = v1[2] * sigmoidf_(v1[3]);
                        u32x2 w; w.x = cvt_pk_bf16(h0, h1); w.y = cvt_pk_bf16(h2, h3);
                        *(u32x2*)(base + r * ld + colt + (c >> 1)) = w;
                    } else if (kind == 3) {
                        u32x2 w; unsigned w0 = 0, w1 = 0;
                        w0 = __builtin_amdgcn_cvt_pk_u8_f32(255.f * sigmoidf_(v0[0]) + 0.5f, 0, w0); w0 = __builtin_amdgcn_cvt_pk_u8_f32(255.f * sigmoidf_(v0[1]) + 0.5f, 1, w0);
                        w0 = __builtin_amdgcn_cvt_pk_u8_f32(255.f * sigmoidf_(v0[2]) + 0.5f, 2, w0); w0 = __builtin_amdgcn_cvt_pk_u8_f32(255.f * sigmoidf_(v0[3]) + 0.5f, 3, w0);
                        w1 = __builtin_amdgcn_cvt_pk_u8_f32(255.f * sigmoidf_(v1[0]) + 0.5f, 0, w1); w1 = __builtin_amdgcn_cvt_pk_u8_f32(255.f * sigmoidf_(v1[1]) + 0.5f, 1, w1);
                        w1 = __builtin_amdgcn_cvt_pk_u8_f32(255.f * sigmoidf_(v1[2]) + 0.5f, 2, w1); w1 = __builtin_amdgcn_cvt_pk_u8_f32(255.f * sigmoidf_(v1[3]) + 0.5f, 3, w1);
                        w.x = w0; w.y = w1; *(u32x2*)(gates + r * 3072 + colt + c) = w;
                    } else {
                        if (kind == 1) {
#pragma unroll
                            for (int j = 0; j < 4; ++j) { v0[j] = gelu_f(v0[j]); v1[j] = gelu_f(v1[j]); } }
                        u32x4 w; w.x = cvt_pk_bf16(v0[0], v0[1]); w.y = cvt_pk_bf16(v0[2], v0[3]); w.z = cvt_pk_bf16(v1[0], v1[1]); w.w = cvt_pk_bf16(v1[2], v1[3]);
                        *(u32x4*)(base + r * ld + colt + c) = w; } } }
    } };
struct EpiNull { static constexpr bool AFTER_DRAIN = false; bf16_t* sink;
    typedef ge::NoPre Pre; __device__ __forceinline__ Pre prefetch(const ge::Unit&, int, int, int, int) const { return Pre{}; }
    __device__ __forceinline__ void operator()(const ge::Acc& acc, const ge::Unit& u, int wr, int wc, int fr, int fq, const Pre&) const {
        float t = 0.f;
#pragma unroll
        for (int ai = 0; ai < 2; ++ai)
#pragma unroll
            for (int bj = 0; bj < 2; ++bj)
#pragma unroll
                for (int m = 0; m < 4; ++m)
#pragma unroll
                    for (int n = 0; n < 2; ++n) t += acc[ai][bj][m][n][0];
        if (t == 123456.789f) sink[0] = f2bf(t); } };
struct SchedBranch { const char* ws; size_t woff; int G, v;
    __device__ __forceinline__ bool next(int i, ge::Unit& u) const { const int tile = (i / 3) * G + v, br = i % 3, pm = tile >> 2, pn = tile & 3; if (tile >= 512) return false;
        const unsigned kb = (br == 0) ? 512u : 256u;
        size_t ao = WS_OUTA, wo = woff; if (br == 1) { ao = WS_HB; wo += (size_t)1024 * 512; } if (br == 2) { ao = WS_HC; wo += (size_t)1024 * 512 + (size_t)1024 * 256; }
        u.A = ws + ao + (size_t)pm * 256 * kb; u.lda = kb; u.nt = (int)(kb >> 7); u.B = ws + wo + (size_t)pn * 256 * kb; u.ldb = kb;
        u.gat = nullptr; u.gshift = 0; u.nvalid = 256; u.pm = pm; u.pn = pn; u.aux = br; return true; } };
struct EpiBranch { static constexpr bool AFTER_DRAIN = false; const unsigned char* gates; bf16_t* merged; unsigned char* mq;
    typedef ge::NoPre Pre; __device__ __forceinline__ Pre prefetch(const ge::Unit&, int, int, int, int) const { return Pre{}; }
    __device__ __forceinline__ void operator()(const ge::Acc& acc, const ge::Unit& u, int wr, int wc, int fr, int fq, const Pre&) const {
        const int br = u.aux; const int row0 = u.pm * 256 + wr * 64 + fr;
#pragma unroll
        for (int ai = 0; ai < 2; ++ai) {
            u32x2 g[8]; u32x4 p[8];
#pragma unroll
            for (int m = 0; m < 4; ++m)
#pragma unroll
                for (int bj = 0; bj < 2; ++bj) { const size_t r = (size_t)(row0 + ai * 128 + m * 16); const int c = u.pn * 256 + 128 * bj + 32 * wc + 8 * fq;
                    g[m * 2 + bj] = *(const u32x2*)(gates + r * 3072 + br * 1024 + c);
                    p[m * 2 + bj] = (br > 0) ? *(const u32x4*)(merged + r * 1024 + c) : (u32x4){0u, 0u, 0u, 0u}; }
#pragma unroll
            for (int m = 0; m < 4; ++m)
#pragma unroll
                for (int bj = 0; bj < 2; ++bj) { const size_t r = (size_t)(row0 + ai * 128 + m * 16); const int c = u.pn * 256 + 128 * bj + 32 * wc + 8 * fq;
                    const f32x4 v0 = acc[ai][bj][m][0], v1 = acc[ai][bj][m][1]; const u32x2 gg = g[m * 2 + bj]; const u32x4 pp = p[m * 2 + bj];
                    const float k = 1.f / 255.f;
                    const float g0 = k * (float)(gg.x & 0xffu), g1 = k * (float)((gg.x >> 8) & 0xffu), g2 = k * (float)((gg.x >> 16) & 0xffu), g3 = k * (float)(gg.x >> 24);
                    const float g4 = k * (float)(gg.y & 0xffu), g5 = k * (float)((gg.y >> 8) & 0xffu), g6 = k * (float)((gg.y >> 16) & 0xffu), g7 = k * (float)(gg.y >> 24);
                    u32x4 w; w.x = cvt_pk_bf16(v0[0] * g0 + bflo(pp.x), v0[1] * g1 + bfhi(pp.x)); w.y = cvt_pk_bf16(v0[2] * g2 + bflo(pp.y), v0[3] * g3 + bfhi(pp.y));
                    w.z = cvt_pk_bf16(v1[0] * g4 + bflo(pp.z), v1[1] * g5 + bfhi(pp.z)); w.w = cvt_pk_bf16(v1[2] * g6 + bflo(pp.w), v1[3] * g7 + bfhi(pp.w));
                    if (br == 2) { u32x2 wq; wq.x = pack_fp8x4(4.f * (v0[0] * g0 + bflo(pp.x)), 4.f * (v0[1] * g1 + bfhi(pp.x)), 4.f * (v0[2] * g2 + bflo(pp.y)), 4.f * (v0[3] * g3 + bfhi(pp.y)));
                        wq.y = pack_fp8x4(4.f * (v1[0] * g4 + bflo(pp.z)), 4.f * (v1[1] * g5 + bfhi(pp.z)), 4.f * (v1[2] * g6 + bflo(pp.w)), 4.f * (v1[3] * g7 + bfhi(pp.w))); *(u32x2*)(mq + r * 1024 + c) = wq; }
                    else *(u32x4*)(merged + r * 1024 + c) = w; }
            asm volatile("" ::: "memory"); }
    } };
struct SchedWout { const char* A; const char* W; int G, v;
    __device__ __forceinline__ bool next(int i, ge::Unit& u) const { const int tile = i * G + v, pm = tile >> 2, pn = tile & 3; if (tile >= 512) return false;
        u.A = A + (size_t)pm * 256 * 1024; u.B = W + (size_t)pn * 256 * 1024; u.gat = nullptr; u.lda = 1024; u.ldb = 1024; u.nt = 8; u.gshift = 0; u.nvalid = 256; u.pm = pm; u.pn = pn; u.aux = 0; return true; } };
struct EpiWout { static constexpr bool AFTER_DRAIN = false; const bf16_t* x; bf16_t* pre; float* stats;
    typedef ge::NoPre Pre; __device__ __forceinline__ Pre prefetch(const ge::Unit&, int, int, int, int) const { return Pre{}; }
    __device__ __forceinline__ void operator()(const ge::Acc& acc, const ge::Unit& u, int wr, int wc, int fr, int fq, const Pre&) const {
        const int row0 = u.pm * 256 + wr * 64 + fr;
#pragma unroll
        for (int ai = 0; ai < 2; ++ai)
#pragma unroll
            for (int m = 0; m < 4; ++m) { const size_t r = (size_t)(row0 + ai * 128 + m * 16); float s1 = 0.f, s2 = 0.f;
#pragma unroll
                for (int bj = 0; bj < 2; ++bj) { const int c = u.pn * 256 + 128 * bj + 32 * wc + 8 * fq; const f32x4 v0 = acc[ai][bj][m][0], v1 = acc[ai][bj][m][1];
                    const u32x4 p = *(const u32x4*)(x + r * 1024 + c);
                    u32x4 w; w.x = cvt_pk_bf16(v0[0] + ALPHA * bflo(p.x), v0[1] + ALPHA * bfhi(p.x)); w.y = cvt_pk_bf16(v0[2] + ALPHA * bflo(p.y), v0[3] + ALPHA * bfhi(p.y));
                    w.z = cvt_pk_bf16(v1[0] + ALPHA * bflo(p.z), v1[1] + ALPHA * bfhi(p.z)); w.w = cvt_pk_bf16(v1[2] + ALPHA * bflo(p.w), v1[3] + ALPHA * bfhi(p.w));
                    *(u32x4*)(pre + r * 1024 + c) = w;
                    const float q0 = bflo(w.x), q1 = bfhi(w.x), q2 = bflo(w.y), q3 = bfhi(w.y), q4 = bflo(w.z), q5 = bfhi(w.z), q6 = bflo(w.w), q7 = bfhi(w.w);
                    s1 += ((q0 + q1) + (q2 + q3)) + ((q4 + q5) + (q6 + q7)); s2 += ((q0 * q0 + q1 * q1) + (q2 * q2 + q3 * q3)) + ((q4 * q4 + q5 * q5) + (q6 * q6 + q7 * q7)); }
                s1 += __shfl_xor(s1, 16); s2 += __shfl_xor(s2, 16); s1 += __shfl_xor(s1, 32); s2 += __shfl_xor(s2, 32);
                if (fq == 0) *(f32x2*)(stats + (r * 16 + u.pn * 4 + wc) * 2) = (f32x2){s1, s2};
                asm volatile("" ::: "memory"); }
    } };
struct SchedRouter { const char* A; const char* W; int G, v;
    __device__ __forceinline__ bool next(int i, ge::Unit& u) const { const int pm = i * G + v; if (pm >= 128) return false;
        u.A = A + (size_t)pm * 256 * 2048; u.B = W; u.gat = nullptr; u.lda = 2048; u.ldb = 2048; u.nt = 16; u.gshift = 0; u.nvalid = 256; u.pm = pm; u.pn = 0; u.aux = 0; return true; } };
struct EpiRouter { static constexpr bool AFTER_DRAIN = true; const float* rbias; unsigned* cnt; int* list; const float* stats; const float* rc;
    typedef ge::NoPre Pre; __device__ __forceinline__ Pre prefetch(const ge::Unit&, int, int, int, int) const { return Pre{}; }
    __device__ __forceinline__ void drained(const ge::Acc& acc, const ge::Unit& u, int wr, int wc, int fr, int fq, LAS unsigned char* lds) const {
        LAS int* lcnt = (LAS int*)lds; LAS int* lbase = lcnt + 32;
        const bool t32 = (wr == 0 && wc == 0 && fq < 2); const int t = fq * 16 + fr;
        if (t32) lcnt[t] = 0;
        __syncthreads();
        int e1[8], e2[8], r1[8], r2[8]; float g1[8], g2[8];
        const int row0 = u.pm * 256 + wr * 64 + fr;
        if (wc == 0) {
            float bias[8], c1v[8], c0v[8];
#pragma unroll
            for (int j = 0; j < 8; ++j) { bias[j] = rbias[8 * fq + j]; c1v[j] = rc[8 * fq + j]; c0v[j] = rc[32 + 8 * fq + j]; }
#pragma unroll
            for (int ai = 0; ai < 2; ++ai)
#pragma unroll
                for (int m = 0; m < 4; ++m) { const int i8 = ai * 4 + m;
                    const f32x4 v0 = acc[ai][0][m][0], v1 = acc[ai][0][m][1];
                    float mean, rstd;
                    {   const size_t r = (size_t)(row0 + ai * 128 + m * 16); const f32x4 a0 = *(const f32x4*)(stats + (r * 16 + 4 * fq) * 2), a1 = *(const f32x4*)(stats + (r * 16 + 4 * fq + 2) * 2);
                        float s1 = (a0[0] + a0[2]) + (a1[0] + a1[2]), s2 = (a0[1] + a0[3]) + (a1[1] + a1[3]);
                        s1 += __shfl_xor(s1, 16); s2 += __shfl_xor(s2, 16); s1 += __shfl_xor(s1, 32); s2 += __shfl_xor(s2, 32);
                        mean = s1 * (1.f / 1024.f); rstd = rsqrtf(fmaxf(s2 * (1.f / 1024.f) - mean * mean, 0.f) + LN_EPS); }
                    float s[8], sel[8];
#pragma unroll
                    for (int j = 0; j < 4; ++j) { s[j] = sigmoidf_(rstd * (v0[j] - mean * c1v[j]) + c0v[j]); s[4 + j] = sigmoidf_(rstd * (v1[j] - mean * c1v[4 + j]) + c0v[4 + j]); }
#pragma unroll
                    for (int j = 0; j < 8; ++j) sel[j] = s[j] + bias[j];
                    int i1 = 0; float m1 = sel[0];
#pragma unroll
                    for (int j = 1; j < 8; ++j) if (sel[j] > m1) { m1 = sel[j]; i1 = j; }
                    int i2 = (i1 == 0) ? 1 : 0; float m2 = (i1 == 0) ? sel[1] : sel[0];
#pragma unroll
                    for (int j = 0; j < 8; ++j) if (j != i1 && j != ((i1 == 0) ? 1 : 0) && sel[j] > m2) { m2 = sel[j]; i2 = j; }
                    float gs = m1 + m2; int gi = fq;
                    { const float os = __shfl_xor(gs, 16); const int oi = __shfl_xor(gi, 16); if (os > gs || (os == gs && oi < gi)) { gs = os; gi = oi; } }
                    { const float os = __shfl_xor(gs, 32); const int oi = __shfl_xor(gi, 32); if (os > gs || (os == gs && oi < gi)) { gs = os; gi = oi; } }
                    e1[i8] = -1; e2[i8] = -1; r1[i8] = 0; r2[i8] = 0; g1[i8] = 0.f; g2[i8] = 0.f;
                    if (gi == fq) {
                        float s1 = s[0], s2 = s[0];
#pragma unroll
                        for (int j = 0; j < 8; ++j) { s1 = (j == i1) ? s[j] : s1; s2 = (j == i2) ? s[j] : s2; }
                        const float inv = 1.0f / (s1 + s2);
                        e1[i8] = 8 * fq + i1; e2[i8] = 8 * fq + i2; g1[i8] = s1 * inv; g2[i8] = s2 * inv;
                        r1[i8] = __hip_atomic_fetch_add(lcnt + e1[i8], 1, __ATOMIC_RELAXED, __HIP_MEMORY_SCOPE_WORKGROUP);
                        r2[i8] = __hip_atomic_fetch_add(lcnt + e2[i8], 1, __ATOMIC_RELAXED, __HIP_MEMORY_SCOPE_WORKGROUP); } }
        }
        __syncthreads();
        if (t32) { const int c = lcnt[t]; lbase[t] = (c > 0) ? (int)atomicAdd(cnt + t, (unsigned)c) : 0; }
        __syncthreads();
        if (wc == 0) {
#pragma unroll
            for (int i8 = 0; i8 < 8; ++i8) if (e1[i8] >= 0) { const int r = row0 + (i8 >> 2) * 128 + (i8 & 3) * 16;
                u32x2 p1, p2; p1.x = (unsigned)(2 * r); p1.y = __float_as_uint(g1[i8]); p2.x = (unsigned)(2 * r + 1); p2.y = __float_as_uint(g2[i8]);
                *(u32x2*)(list + ((size_t)e1[i8] * T + lbase[e1[i8]] + r1[i8]) * 2) = p1; *(u32x2*)(list + ((size_t)e2[i8] * T + lbase[e2[i8]] + r2[i8]) * 2) = p2; } }
        __syncthreads();
    } };
__device__ __forceinline__ int build_tile_table(Frame& F, const unsigned* cnt) {
    volatile LAS int* tab = (volatile LAS int*)(F.lds + LDS_MISC + 64);
    __syncthreads();
    if (F.wave == 0) {
        const int e = F.lane & 31; const int c = (int)__hip_atomic_load(cnt + e, __ATOMIC_RELAXED, __HIP_MEMORY_SCOPE_AGENT); const int nt = (F.lane < 32) ? ((c + 255) >> 8) : 0;
        int incl = nt;
#pragma unroll
        for (int o = 1; o < 32; o <<= 1) { const int up = __shfl_up(incl, o); if ((F.lane & 31) >= o) incl += up; }
        const int base = incl - nt;
        if (F.lane < 32) for (int j = 0; j < nt; ++j) tab[1 + base + j] = (e << 16) | j;
        if (F.lane == 31) tab[0] = incl; }
    __syncthreads();
    return tab[0];
}
struct SchedMoe1 { const char* X1; const char* W; const int* list; const unsigned* cnt; LAS int* tab; int ntiles, G, v;
    __device__ __forceinline__ bool next(int i, ge::Unit& u) const { const int L = i * G + v, rt = L >> 2, pn = L & 3; if (rt >= ntiles) return false;
        const int ej = tab[1 + rt], e = ej >> 16, j = ej & 0xffff; const int c = (int)cnt[e];
        u.A = X1; u.gat = list + ((size_t)e * T + j * 256) * 2; u.gshift = 1; u.nvalid = (c - j * 256) < 256 ? (c - j * 256) : 256; u.lda = 1024; u.nt = 8;
        u.B = W + ((size_t)e * 1024 + (size_t)pn * 256) * 1024; u.ldb = 1024; u.pm = rt; u.pn = pn; u.aux = e; return true; } };
struct EpiMoe1 { static constexpr bool AFTER_DRAIN = false; unsigned char* H;
    typedef ge::NoPre Pre; __device__ __forceinline__ Pre prefetch(const ge::Unit&, int, int, int, int) const { return Pre{}; }
    __device__ __forceinline__ void operator()(const ge::Acc& acc, const ge::Unit& u, int wr, int wc, int fr, int fq, const Pre&) const {
        const int row0 = u.pm * 256 + wr * 64 + fr;
#pragma unroll
        for (int ai = 0; ai < 2; ++ai)
#pragma unroll
            for (int m = 0; m < 4; ++m) { const size_t r = (size_t)(row0 + ai * 128 + m * 16);
#pragma unroll
                for (int bj = 0; bj < 2; ++bj) { const int c = 128 * bj + 32 * wc + 8 * fq; const f32x4 v0 = acc[ai][bj][m][0], v1 = acc[ai][bj][m][1];
                    const float h0 = v0[0] * sigmoidf_(v0[0]) * v0[1], h1 = v0[2] * sigmoidf_(v0[2]) * v0[3], h2 = v1[0] * sigmoidf_(v1[0]) * v1[1], h3 = v1[2] * sigmoidf_(v1[2]) * v1[3];
                    *(unsigned*)(H + r * 512 + u.pn * 128 + (c >> 1)) = pack_fp8x4(h0, h1, h2, h3); }
                asm volatile("" ::: "memory"); }
    } };
struct SchedMoe2 { const char* H; const char* W; const int* list; const unsigned* cnt; LAS int* tab; int ntiles, G, v, ntk;
    __device__ __forceinline__ bool next(int i, ge::Unit& u) const { const int L = i * G + v, rt = L >> 2, pn = L & 3; if (rt >= ntiles) return false;
        const int ej = tab[1 + rt], e = ej >> 16, j = ej & 0xffff; const int c = (int)cnt[e];
        u.A = H + (size_t)rt * 256 * 512; u.gat = nullptr; u.gshift = 0; u.nvalid = (c - j * 256) < 256 ? (c - j * 256) : 256; u.lda = 512; u.nt = ntk;
        u.B = W + ((size_t)e * 1024 + (size_t)pn * 256) * 512; u.ldb = 512; u.pm = rt; u.pn = pn; u.aux = (e << 16) | j; return true; } };
template <int MODE> struct EpiMoe2T { static constexpr bool AFTER_DRAIN = false; const int* list; unsigned char* Y; int* inv;
    typedef ge::NoPre Pre; __device__ __forceinline__ Pre prefetch(const ge::Unit&, int, int, int, int) const { return Pre{}; }
    __device__ __forceinline__ void operator()(const ge::Acc& acc, const ge::Unit& u, int wr, int wc, int fr, int fq, const Pre&) const {
        const int e = u.aux >> 16, j = u.aux & 0xffff; const int* lst = list + ((size_t)e * T + j * 256) * 2;
        const unsigned row0 = (unsigned)u.pm * 256u + (unsigned)(wr * 64 + fr); const unsigned col0 = (unsigned)(u.pn * 256 + 32 * wc + 8 * fq);
        const bool invw = (u.pn == 0 && wc == 0 && fq == 0);
#pragma unroll
        for (int ai = 0; ai < 2; ++ai) {
            u32x2 sg[4];
#pragma unroll
            for (int m = 0; m < 4; ++m) { const int rr = ai * 128 + wr * 64 + m * 16 + fr; const u32x2 v = *(const u32x2*)(lst + 2 * (rr < u.nvalid ? rr : 0)); sg[m].x = (rr < u.nvalid) ? v.x : 0xffffffffu; sg[m].y = v.y; }
#pragma unroll
            for (int m = 0; m < 4; ++m) { const int sl = (int)sg[m].x; const float gg = __uint_as_float(sg[m].y);
                const unsigned yrow = row0 + (unsigned)(ai * 128 + m * 16);
                if (MODE == 1) { if (sl == 0x7ffffff0) Y[0] = (unsigned char)pack_fp8x4(acc[ai][0][m][0][0] * gg, 0.f, 0.f, 0.f); }
                else if (sl >= 0) {
                    if (invw) inv[sl] = (int)yrow;
#pragma unroll
                    for (int bj = 0; bj < 2; ++bj) { const f32x4 v0 = acc[ai][bj][m][0], v1 = acc[ai][bj][m][1];
                        const float g8 = 8.f * gg; u32x2 w; w.x = pack_fp8x4(g8 * v0[0], g8 * v0[1], g8 * v0[2], g8 * v0[3]); w.y = pack_fp8x4(g8 * v1[0], g8 * v1[1], g8 * v1[2], g8 * v1[3]);
                        *(u32x2*)(Y + (yrow * 1024u + col0 + 128u * bj)) = w; } } }
            asm volatile("" ::: "memory"); }
    } };
typedef EpiMoe2T<0> EpiMoe2;
typedef short bf16x4 __attribute__((ext_vector_type(4)));
#if DEBUG_MODE
#define DBGF(stage, val) do { const float v_ = (val); if (!(fabsf(v_) < 1e30f)) atomicOr((unsigned*)(F.ws + WS_CTL) + 12, 1u << (stage)); } while (0)
#else
#define DBGF(stage, val) do { } while (0)
#endif
#define MFMA16(a, b, c) __builtin_amdgcn_mfma_f32_16x16x16bf16_1k(a, b, c, 0, 0, 0)
#define MFMA32(a, b, c) __builtin_amdgcn_mfma_f32_16x16x32_bf16(a, b, c, 0, 0, 0)
__device__ __forceinline__ bf16x4 pack4(const f32x4 v) { u32x2 w; w.x = cvt_pk_bf16(v[0], v[1]); w.y = cvt_pk_bf16(v[2], v[3]); return __builtin_bit_cast(bf16x4, w); }
__device__ __forceinline__ f32x4 unpack4(const u32x2 w) { return (f32x4){bflo(w.x), bfhi(w.x), bflo(w.y), bfhi(w.y)}; }
constexpr int TP = 72;
constexpr int TILE_B = 64 * TP * 2;
constexpr int LA_ACT = 0;
constexpr int LA_AT = 13312, LA_RT = LA_AT + TILE_B, LA_BT = LA_RT + TILE_B, LA_KT = LA_BT + TILE_B;
constexpr int LA_BTT = LA_KT + TILE_B, LA_KTT = LA_BTT + TILE_B, LA_VT = LA_KTT + TILE_B;
constexpr int LA_AAB = LA_VT + TILE_B, LA_AAK = LA_AAB + TILE_B, LA_ARB = LA_AAK + TILE_B, LA_ARK = LA_ARB + TILE_B;
constexpr int LA_DIAG = LA_ARK + TILE_B;
constexpr int LA_TII = LA_DIAG + 4096;
constexpr int LA_SEG = LA_TII + 3072;
constexpr int LA_KSQ = LA_SEG + 4096;
constexpr int LA_RKP = LA_KSQ + 1024;
constexpr int LA_PC = LA_RKP + 1024;
static_assert(LA_PC + 256 <= LDS_STAGE, "pass A LDS map");

template <bool EONLY> __device__ __forceinline__ void phase_wkv_a(Frame& F, const Params& P, int l) {
    LAS unsigned char* lds = F.lds;
    const bf16_t* rkv = WSP(bf16_t, WS_RKV);
    const bf16_t* wupT = WSP(bf16_t, WS_LORA) + (size_t)l * 512 * 32;
    const bf16_t* aupT = WSP(bf16_t, WS_LORA) + (size_t)(4 + l) * 512 * 32;
    const bf16_t* vupT = WSP(bf16_t, WS_LORA) + (size_t)(8 + (l > 0 ? l - 1 : 0)) * 512 * 32;
    const float* mu = P.in[3] + (size_t)l * 1696; const float* muv = (l > 0) ? P.in[4] + (size_t)(l - 1) * 32 : nullptr;
    bf16_t* PHI = WSP(bf16_t, WS_PHI); bf16_t* PSI = WSP(bf16_t, WS_PSI); bf16_t* GT = WSP(bf16_t, WS_GT); bf16_t* Y0T = WSP(bf16_t, WS_Y0T); bf16_t* VT = WSP(bf16_t, WS_VT); bf16_t* VF = WSP(bf16_t, WS_VFIRST);
    float* RK = WSP(float, WS_RK);
    const int lane = F.lane, w = F.wave, cb = w & 3, th = w >> 2;
#define WKVA_RAW_LOAD(dst, hn) do { _Pragma("unroll") for (int i_ = 0; i_ < 4; ++i_) { const int p_ = F.tid + 512 * i_; const int pc_ = p_ < 1560 ? p_ : 1559; const int row_ = pc_ / 24, rem_ = pc_ % 24; \
        const int tok_ = (row_ == 0 && firstchunk) ? t0 : t0 - 1 + row_; dst[i_] = *(const u32x4*)(rkv + (size_t)tok_ * RKVW + (rem_ >> 3) * 512 + (hn) * 64 + (rem_ & 7) * 8); } } while (0)
#define WKVA_RAW_STORE(src) do { _Pragma("unroll") for (int i_ = 0; i_ < 4; ++i_) { const int p_ = F.tid + 512 * i_; if (p_ < 1560) { const int row_ = p_ / 24, rem_ = p_ % 24; \
        *(LAS u32x4*)(lds + LDS_RAW + (row_ * 192 + (rem_ >> 3) * 64 + (rem_ & 7) * 8) * 2) = src[i_]; } } } while (0)
    for (int unit = blockIdx.x; unit < T / 64; unit += F.G) {
        const int t0 = unit * 64; const bool firstchunk = (t0 & (SEQ - 1)) == 0;
        __syncthreads();
        { u32x4 r0_[4]; WKVA_RAW_LOAD(r0_, 0); WKVA_RAW_STORE(r0_); }
        for (int idx = F.tid; idx < 64 * 96; idx += 512) { const int tok = idx / 96, qq = idx % 96; const int col = (qq < 64) ? 1536 + qq : 1536 + 96 + qq;
            const int t = t0 + tok;
            const bool hp = (tok > 0 || !firstchunk); const float p = bf2f(rkv[(size_t)t * RKVW + col]); const float ppl = bf2f(rkv[(size_t)(hp ? t - 1 : t) * RKVW + col]); const float pp = hp ? ppl : 0.f;
            const float m_ = (qq < 64) ? mu[1536 + qq] : ((l > 0) ? P.in[4][(size_t)(l > 0 ? l - 1 : 0) * 32 + qq - 64] : 0.f);
            float val = p + (pp - p) * m_; if (qq < 32) val = tanhf(val);
            *(LAS bf16_t*)(lds + LA_ACT + (tok * 104 + qq) * 2) = f2bf(val); }
        __syncthreads();
        for (int h = 0; h < 8; ++h) {
            int lz = lane; asm volatile("" : "+v"(lz)); const int c = lz & 15, q = lz >> 4;
            const int chid = unit * 8 + h; const int ch = 16 * cb + c, chg = h * 64 + ch;
            f32x4 zw[2], za[2], zv[2];
            {   const bf16x8 bw = *(const bf16x8*)(wupT + (size_t)chg * 32 + 8 * q), ba = *(const bf16x8*)(aupT + (size_t)chg * 32 + 8 * q), bv = *(const bf16x8*)(vupT + (size_t)chg * 32 + 8 * q);
#pragma unroll
                for (int ii = 0; ii < 2; ++ii) { const int i = 2 * th + ii; const LAS unsigned char* ar = lds + LA_ACT + ((16 * i + c) * 104 + 8 * q) * 2;
                    const bf16x8 a0 = *(const LAS bf16x8*)(ar), a1 = *(const LAS bf16x8*)(ar + 64), a2 = *(const LAS bf16x8*)(ar + 128);
                    const f32x4 z = {0.f, 0.f, 0.f, 0.f};
                    zw[ii] = MFMA32(a0, bw, z); za[ii] = MFMA32(a1, ba, z); zv[ii] = MFMA32(a2, bv, z); } }
            const float mu_r = mu[chg], mu_k = mu[512 + chg], mu_v = mu[1024 + chg];
            const float w0 = P.in[5][(size_t)l * 512 + chg], a0_ = P.in[7][(size_t)l * 512 + chg], v0_ = (l > 0) ? P.in[10][(size_t)(l - 1) * 512 + chg] : 0.f;
            const float k_k = P.in[12][(size_t)l * 512 + chg], k_a = P.in[13][(size_t)l * 512 + chg], r_k = P.in[14][(size_t)l * 512 + chg];
            float rr[2][4], kh[2][4], vv[2][4], lw[2][4], ic[2][4], kkr[2][4];
#pragma unroll
            for (int ii = 0; ii < 2; ++ii) { const int i = 2 * th + ii; const int tl0 = 16 * i + 4 * q;
                const bool hasprev = (tl0 > 0) || !firstchunk;
                const LAS unsigned char* rb = lds + LDS_RAW + (tl0 * 192 + ch) * 2;
                const float lpr = bf2f(*(const LAS bf16_t*)(rb)), lpk = bf2f(*(const LAS bf16_t*)(rb + 128)), lpv = bf2f(*(const LAS bf16_t*)(rb + 256));
                float pr = hasprev ? lpr : 0.f, pk = hasprev ? lpk : 0.f, pv = hasprev ? lpv : 0.f;
                f32x4 vf = {0.f, 0.f, 0.f, 0.f};
                if (l > 0) vf = unpack4(*(const u32x2*)(VF + ((size_t)chid * 64 + ch) * 64 + tl0));
                float lsum = 0.f;
#pragma unroll
                for (int r = 0; r < 4; ++r) { const LAS unsigned char* rc_ = rb + (r + 1) * 384; const float cr = bf2f(*(const LAS bf16_t*)(rc_)), ck = bf2f(*(const LAS bf16_t*)(rc_ + 128)), cv = bf2f(*(const LAS bf16_t*)(rc_ + 256));
                    const float r_ = cr + (pr - cr) * mu_r, k_ = ck + (pk - ck) * mu_k; float v_ = cv + (pv - cv) * mu_v; pr = cr; pk = ck; pv = cv;
                    const float lw_ = -0.6065306597126334f * sigmoidf_(w0 + zw[ii][r]); const float icl = sigmoidf_(a0_ + za[ii][r]);
                    if (l > 0) v_ = v_ + (vf[r] - v_) * sigmoidf_(v0_ + zv[ii][r]);
                    const float kk_ = k_ * k_k, kh_ = k_ * (1.0f + (icl - 1.0f) * k_a);
                    rr[ii][r] = r_; kh[ii][r] = kh_; vv[ii][r] = v_; lw[ii][r] = lw_; ic[ii][r] = icl; kkr[ii][r] = kk_; lsum += lw_;
                    const float s1 = row16_sum(kk_ * kk_), s2 = row16_sum(r_ * kh_ * r_k);
                    *(LAS float*)(lds + LA_KSQ + (cb * 64 + tl0 + r) * 4) = s1; *(LAS float*)(lds + LA_RKP + (cb * 64 + tl0 + r) * 4) = s2; }
                *(LAS float*)(lds + LA_SEG + (ch * 16 + i * 4 + q) * 4) = lsum; }
            __syncthreads();
            u32x4 nraw[4]; if (h < 7) WKVA_RAW_LOAD(nraw, h + 1);
            {   float seg[16];
#pragma unroll
                for (int j4 = 0; j4 < 4; ++j4) { const f32x4 s4 = *(const LAS f32x4*)(lds + LA_SEG + (ch * 16 + 4 * j4) * 4); seg[4 * j4] = s4[0]; seg[4 * j4 + 1] = s4[1]; seg[4 * j4 + 2] = s4[2]; seg[4 * j4 + 3] = s4[3]; }
                float tot = 0.f;
#pragma unroll
                for (int j = 0; j < 16; ++j) tot += seg[j];
                if (th == 0) *(LAS float*)(lds + LA_PC + ch * 4) = __expf(tot);
                float mine[8];
#pragma unroll
                for (int j = 0; j < 8; ++j) mine[j] = th ? seg[8 + j] : seg[j];
                const float firsthalf = th ? (((seg[0] + seg[1]) + (seg[2] + seg[3])) + ((seg[4] + seg[5]) + (seg[6] + seg[7]))) : 0.f;
#pragma unroll
                for (int ii = 0; ii < 2; ++ii) { const int i = 2 * th + ii; const int tl0 = 16 * i + 4 * q; const int sidx = i * 4 + q;
                    float cum = firsthalf + (ii ? ((mine[0] + mine[1]) + (mine[2] + mine[3])) : 0.f);
                    { const float s0 = mine[4 * ii], s1 = mine[4 * ii + 1], s2 = mine[4 * ii + 2]; cum += (q > 0 ? s0 : 0.f) + (q > 1 ? s1 : 0.f) + (q > 2 ? s2 : 0.f); }
                    f32x4 at, rt, bt, kt;
#pragma unroll
                    for (int r = 0; r < 4; ++r) { const int tl = tl0 + r;
                        const float ks = (*(const LAS float*)(lds + LA_KSQ + tl * 4) + *(const LAS float*)(lds + LA_KSQ + (64 + tl) * 4)) + (*(const LAS float*)(lds + LA_KSQ + (128 + tl) * 4) + *(const LAS float*)(lds + LA_KSQ + (192 + tl) * 4));
                        const float kk_ = kkr[ii][r] * __builtin_amdgcn_rsqf(fmaxf(ks, 1e-24f));
                        const float cumx = cum; cum += lw[ii][r];
                        const float ex = __expf(cumx), ei = __expf(cum), en = __expf(-cum);
                        at[r] = -kk_ * ex; rt[r] = rr[ii][r] * ei; bt[r] = kk_ * ic[ii][r] * en; kt[r] = kh[ii][r] * en;
#if DEBUG_MODE
                        { bf16_t* dd = (bf16_t*)F.out; const size_t oo = (size_t)(t0 + tl) * 512 + chg; dd[oo] = f2bf(__expf(lw[ii][r])); dd[(size_t)T * 512 + oo] = f2bf(kk_ * ic[ii][r]); dd[(size_t)2 * T * 512 + oo] = f2bf(-kk_); }
#endif
                        DBGF(1, lw[ii][r]); DBGF(1, cum); DBGF(2, at[r]); DBGF(2, rt[r]); DBGF(2, bt[r]); DBGF(2, kt[r]);
                        *(LAS bf16_t*)(lds + LA_AT + (tl * TP + ch) * 2) = f2bf(at[r]); *(LAS bf16_t*)(lds + LA_RT + (tl * TP + ch) * 2) = f2bf(rt[r]);
                        *(LAS bf16_t*)(lds + LA_BT + (tl * TP + ch) * 2) = f2bf(bt[r]); *(LAS bf16_t*)(lds + LA_KT + (tl * TP + ch) * 2) = f2bf(kt[r]);
                        if (cb == 0) { const float rk = (*(const LAS float*)(lds + LA_RKP + tl * 4) + *(const LAS float*)(lds + LA_RKP + (64 + tl) * 4)) + (*(const LAS float*)(lds + LA_RKP + (128 + tl) * 4) + *(const LAS float*)(lds + LA_RKP + (192 + tl) * 4));
                            if (c == 0) RK[(size_t)(t0 + tl) * 8 + h] = rk; } }
                    const f32x4 v4 = {vv[ii][0], vv[ii][1], vv[ii][2], vv[ii][3]};
                    *(LAS bf16x4*)(lds + LA_BTT + (ch * TP + tl0) * 2) = pack4(bt); *(LAS bf16x4*)(lds + LA_KTT + (ch * TP + tl0) * 2) = pack4(kt); *(LAS bf16x4*)(lds + LA_VT + (ch * TP + tl0) * 2) = pack4(v4);
                    *(bf16x4*)(VT + ((size_t)chid * 64 + ch) * 64 + tl0) = pack4(v4);
                    if (l == 0) *(bf16x4*)(VF + ((size_t)chid * 64 + ch) * 64 + tl0) = pack4(v4); } }
            __syncthreads();
            if (EONLY) { if (h < 7) WKVA_RAW_STORE(nraw); __syncthreads(); continue; }
            {   const bool isR = w >= 4; const int i = w & 3;
                const LAS unsigned char* brow = lds + (isR ? LA_RT : LA_AT) + ((16 * i + c) * TP + 8 * q) * 2;
                const bf16x8 bf0 = *(const LAS bf16x8*)(brow), bf1 = *(const LAS bf16x8*)(brow + 64);
                LAS unsigned char* ob = lds + (isR ? LA_ARB : LA_AAB); LAS unsigned char* ok = lds + (isR ? LA_ARK : LA_AAK);
                const int tloc = 16 * i + c;
#pragma unroll
                for (int j = 0; j < 4; ++j) { f32x4 db = {0.f, 0.f, 0.f, 0.f}, dk = {0.f, 0.f, 0.f, 0.f};
                    if (j <= i) { const LAS unsigned char* arb = lds + LA_BT + ((16 * j + c) * TP + 8 * q) * 2; const LAS unsigned char* ark = lds + LA_KT + ((16 * j + c) * TP + 8 * q) * 2;
                        db = MFMA32(*(const LAS bf16x8*)(arb), bf0, db); db = MFMA32(*(const LAS bf16x8*)(arb + 64), bf1, db);
                        dk = MFMA32(*(const LAS bf16x8*)(ark), bf0, dk); dk = MFMA32(*(const LAS bf16x8*)(ark + 64), bf1, dk);
                        if (j == i) {
#pragma unroll
                            for (int r = 0; r < 4; ++r) { const int s = 16 * j + 4 * q + r; const bool keep = isR ? (s <= tloc) : (s < tloc); db[r] = keep ? db[r] : 0.f; dk[r] = keep ? dk[r] : 0.f; }
                            if (!isR) *(LAS f32x4*)(lds + LA_DIAG + ((i * 16 + c) * 16 + 4 * q) * 4) = db; } }
                    DBGF(3, db[0] + db[1] + db[2] + db[3]); DBGF(3, dk[0] + dk[1] + dk[2] + dk[3]);
                    *(LAS bf16x4*)(ob + (tloc * TP + 16 * j + 4 * q) * 2) = pack4(db); *(LAS bf16x4*)(ok + (tloc * TP + 16 * j + 4 * q) * 2) = pack4(dk); } }
            __syncthreads();
            f32x4 X[4];
            if (w == 0) { const int blk = q, jc = c; float tc[16];
                f32x4 Lr[15][4];
#pragma unroll
                for (int t = 1; t < 16; ++t)
#pragma unroll
                    for (int s4 = 0; s4 < 4; ++s4) if (4 * s4 < t) Lr[t - 1][s4] = *(const LAS f32x4*)(lds + LA_DIAG + ((blk * 16 + t) * 16 + 4 * s4) * 4);
                __builtin_amdgcn_sched_barrier(0);
#pragma unroll
                for (int s = 0; s < 16; ++s) tc[s] = (s == jc) ? 1.f : 0.f;
#pragma unroll
                for (int t = 1; t < 16; ++t) { float val = 0.f;
#pragma unroll
                    for (int s4 = 0; s4 < 4; ++s4) if (4 * s4 < t) { const f32x4 L = Lr[t - 1][s4];
#pragma unroll
                        for (int e = 0; e < 4; ++e) if (4 * s4 + e < t) val += L[e] * tc[4 * s4 + e]; }
                    tc[t] += val; }
#pragma unroll
                for (int t = 0; t < 16; ++t) { DBGF(4, tc[t]); *(LAS bf16_t*)(lds + LA_TII + ((blk * 16 + t) * 24 + jc) * 2) = f2bf(tc[t]); } }
            if (w < 4) {
#pragma unroll
                for (int i = 0; i < 4; ++i)
#pragma unroll
                    for (int r = 0; r < 4; ++r) X[i][r] = bf2f(*(const LAS bf16_t*)(lds + LA_AT + ((16 * i + 4 * q + r) * TP + 16 * w + c) * 2));
            } else { const int vb = w - 4; const LAS unsigned char* vrow = lds + LA_VT + ((16 * vb + c) * TP + 8 * q) * 2;
                const bf16x8 v0 = *(const LAS bf16x8*)(vrow), v1 = *(const LAS bf16x8*)(vrow + 64);
#pragma unroll
                for (int i = 0; i < 4; ++i) { const LAS unsigned char* arow = lds + LA_AAK + ((16 * i + c) * TP + 8 * q) * 2; f32x4 d = {0.f, 0.f, 0.f, 0.f};
                    d = MFMA32(*(const LAS bf16x8*)(arow), v0, d); d = MFMA32(*(const LAS bf16x8*)(arow + 64), v1, d); X[i] = d; } }
            DBGF(5, (X[0][0] + X[1][1]) + (X[2][2] + X[3][3]));
            __syncthreads();
            bf16x4 Xb[4];
            {   bf16x4 Af[6], Tf[4];
#pragma unroll
                for (int i = 1; i < 4; ++i)
#pragma unroll
                    for (int j = 0; j < 3; ++j) if (j < i) Af[(i * (i - 1)) / 2 + j] = *(const LAS bf16x4*)(lds + LA_AAB + ((16 * i + c) * TP + 16 * j + 4 * q) * 2);
#pragma unroll
                for (int i = 0; i < 4; ++i) Tf[i] = *(const LAS bf16x4*)(lds + LA_TII + ((i * 16 + c) * 24 + 4 * q) * 2);
                __builtin_amdgcn_sched_barrier(0);
#pragma unroll
                for (int i = 0; i < 4; ++i) { f32x4 y = X[i];
#pragma unroll
                    for (int j = 0; j < 3; ++j) if (j < i) y = MFMA16(Af[(i * (i - 1)) / 2 + j], Xb[j], y);
                    const f32x4 z = {0.f, 0.f, 0.f, 0.f};
                    X[i] = MFMA16(Tf[i], pack4(y), z); Xb[i] = pack4(X[i]); } }
            DBGF(6, (X[0][0] + X[1][1]) + (X[2][2] + X[3][3]));
            if (w < 4) {
                {   bf16x4 Bf[16]; float pcv[4];
#pragma unroll
                    for (int kb = 0; kb < 4; ++kb) { pcv[kb] = *(const LAS float*)(lds + LA_PC + (16 * kb + c) * 4);
#pragma unroll
                        for (int j = 0; j < 4; ++j) Bf[kb * 4 + j] = *(const LAS bf16x4*)(lds + LA_BTT + ((16 * kb + c) * TP + 16 * j + 4 * q) * 2); }
                    __builtin_amdgcn_sched_barrier(0);
#pragma unroll
                    for (int kb = 0; kb < 4; ++kb) { f32x4 d = {0.f, 0.f, 0.f, 0.f};
#pragma unroll
                        for (int j = 0; j < 4; ++j) d = MFMA16(Xb[j], Bf[kb * 4 + j], d);
                        const int ko = 16 * kb + c; const float pc = pcv[kb];
#pragma unroll
                        for (int r = 0; r < 4; ++r) d[r] = pc * (d[r] + ((16 * w + 4 * q + r) == ko ? 1.f : 0.f));
                        DBGF(7, d[0] + d[1] + d[2] + d[3]);
                        *(bf16x4*)(PHI + ((size_t)chid * 64 + ko) * 64 + 16 * w + 4 * q) = pack4(d); } }
                {   bf16x4 Rf[16]; u32x2 Rt[4];
#pragma unroll
                    for (int tb = 0; tb < 4; ++tb) { Rt[tb] = *(const LAS u32x2*)(lds + LA_RT + ((16 * tb + c) * TP + 16 * w + 4 * q) * 2);
#pragma unroll
                        for (int j = 0; j < 4; ++j) Rf[tb * 4 + j] = *(const LAS bf16x4*)(lds + LA_ARB + ((16 * tb + c) * TP + 16 * j + 4 * q) * 2); }
                    __builtin_amdgcn_sched_barrier(0);
#pragma unroll
                    for (int tb = 0; tb < 4; ++tb) { f32x4 d = unpack4(Rt[tb]);
#pragma unroll
                        for (int j = 0; j < 4; ++j) d = MFMA16(Xb[j], Rf[tb * 4 + j], d);
                        *(bf16x4*)(PSI + ((size_t)chid * 64 + 16 * tb + c) * 64 + 16 * w + 4 * q) = pack4(d); } }
            } else { const int vb = w - 4;
                bf16x4 Vb[4];
#pragma unroll
                for (int j = 0; j < 4; ++j) Vb[j] = *(const LAS bf16x4*)(lds + LA_VT + ((16 * vb + c) * TP + 16 * j + 4 * q) * 2);
                {   bf16x4 Bf[16], Kf[16]; f32x4 pcv[4];
#pragma unroll
                    for (int kb = 0; kb < 4; ++kb) { pcv[kb] = *(const LAS f32x4*)(lds + LA_PC + (16 * kb + 4 * q) * 4);
#pragma unroll
                        for (int j = 0; j < 4; ++j) { Bf[kb * 4 + j] = *(const LAS bf16x4*)(lds + LA_BTT + ((16 * kb + c) * TP + 16 * j + 4 * q) * 2); Kf[kb * 4 + j] = *(const LAS bf16x4*)(lds + LA_KTT + ((16 * kb + c) * TP + 16 * j + 4 * q) * 2); } }
                    __builtin_amdgcn_sched_barrier(0);
#pragma unroll
                    for (int kb = 0; kb < 4; ++kb) { f32x4 d = {0.f, 0.f, 0.f, 0.f};
#pragma unroll
                        for (int j = 0; j < 4; ++j) { d = MFMA16(Bf[kb * 4 + j], Xb[j], d); d = MFMA16(Kf[kb * 4 + j], Vb[j], d); }
                        *(bf16x4*)(GT + ((size_t)chid * 64 + 16 * vb + c) * 64 + 16 * kb + 4 * q) = pack4(d * pcv[kb]); } }
                {   bf16x4 Rf[16], Kf[16];
#pragma unroll
                    for (int tb = 0; tb < 4; ++tb)
#pragma unroll
                        for (int j = 0; j < 4; ++j) { Rf[tb * 4 + j] = *(const LAS bf16x4*)(lds + LA_ARB + ((16 * tb + c) * TP + 16 * j + 4 * q) * 2); Kf[tb * 4 + j] = *(const LAS bf16x4*)(lds + LA_ARK + ((16 * tb + c) * TP + 16 * j + 4 * q) * 2); }
                    __builtin_amdgcn_sched_barrier(0);
#pragma unroll
                    for (int tb = 0; tb < 4; ++tb) { f32x4 d = {0.f, 0.f, 0.f, 0.f};
#pragma unroll
                        for (int j = 0; j < 4; ++j) { d = MFMA16(Rf[tb * 4 + j], Xb[j], d); d = MFMA16(Kf[tb * 4 + j], Vb[j], d); }
                        *(bf16x4*)(Y0T + ((size_t)chid * 64 + 16 * vb + c) * 64 + 16 * tb + 4 * q) = pack4(d); } } }
            if (h < 7) WKVA_RAW_STORE(nraw);
            __syncthreads();
        }
    }
#undef WKVA_RAW_LOAD
#undef WKVA_RAW_STORE
}
__device__ __forceinline__ void phase_wkv_b(Frame& F, const Params& P) {
    const bf16_t* PHI = WSP(bf16_t, WS_PHI); const bf16_t* GT = WSP(bf16_t, WS_GT); bf16_t* MT = WSP(bf16_t, WS_MT);
    LAS unsigned char* lds = F.lds;
    const int lane = F.lane, c = lane & 15, q = lane >> 4, w = F.wave, tid = F.tid;
    const int pair = w >> 2, vb = w & 3; const int bh = (int)blockIdx.x * 2 + pair, b = bh >> 3, h = bh & 7;
    const int lrow = tid >> 3, lcol = (tid & 7) * 16;
    f32x4 M[4];
#pragma unroll
    for (int i = 0; i < 4; ++i) M[i] = (f32x4){0.f, 0.f, 0.f, 0.f};
    u32x4 rA[4], rB[4];
#define WKVB_LD(r_, ckk) do { const int ck_ = (ckk) < 32 ? (ckk) : 31; _Pragma("unroll") for (int ti = 0; ti < 4; ++ti) { const int bh_ = (int)blockIdx.x * 2 + (ti >> 1); \
        const size_t chl_ = (size_t)((bh_ >> 3) * 32 + ck_) * 8 + (bh_ & 7); r_[ti] = *(const u32x4*)(((ti & 1) ? GT : PHI) + chl_ * 4096 + (size_t)tid * 8); } } while (0)
#define WKVB_ST(r_, buf) do { _Pragma("unroll") for (int ti = 0; ti < 4; ++ti) *(LAS u32x4*)(lds + ((buf) * 4 + ti) * TILE_B + lrow * (TP * 2) + lcol) = r_[ti]; } while (0)
#define WKVB_STEP(buf, ckk) do { const size_t chs_ = (size_t)(b * 32 + (ckk)) * 8 + h; bf16x4 Mb[4]; \
        const LAS unsigned char* tp_ = lds + ((buf) * 4 + pair * 2) * TILE_B; const LAS unsigned char* tg_ = tp_ + TILE_B; \
        _Pragma("unroll") for (int i = 0; i < 4; ++i) { Mb[i] = pack4(M[i]); *(bf16x4*)(MT + (chs_ * 64 + 16 * vb + c) * 64 + 16 * i + 4 * q) = Mb[i]; } \
        _Pragma("unroll") for (int i = 0; i < 4; ++i) { f32x4 d = unpack4(*(const LAS u32x2*)(tg_ + (16 * vb + c) * (TP * 2) + (16 * i + 4 * q) * 2)); \
            _Pragma("unroll") for (int j = 0; j < 4; ++j) d = MFMA16(*(const LAS bf16x4*)(tp_ + (16 * i + c) * (TP * 2) + (16 * j + 4 * q) * 2), Mb[j], d); M[i] = d; } } while (0)
    WKVB_LD(rA, 0); WKVB_LD(rB, 1);
    __syncthreads();
    for (int ck = 0; ck < 32; ck += 2) {
        WKVB_ST(rA, 0); __syncthreads(); WKVB_LD(rA, ck + 2); WKVB_STEP(0, ck);
        WKVB_ST(rB, 1); __syncthreads(); WKVB_LD(rB, ck + 3); WKVB_STEP(1, ck + 1);
    }
    __syncthreads();
#undef WKVB_LD
#undef WKVB_ST
#undef WKVB_STEP
}
constexpr int LC_SGL = 0;
constexpr int LC_OT = 13312;
__device__ __forceinline__ void phase_wkv_c(Frame& F, const Params& P, int l) {
    LAS unsigned char* lds = F.lds;
    const bf16_t* rkv = WSP(bf16_t, WS_RKV);
    const bf16_t* gupT = WSP(bf16_t, WS_LORA) + (size_t)11 * 512 * 32 + (size_t)l * 512 * 96;
    const bf16_t* PSI = WSP(bf16_t, WS_PSI); const bf16_t* Y0T = WSP(bf16_t, WS_Y0T); const bf16_t* VT = WSP(bf16_t, WS_VT); const bf16_t* MT = WSP(bf16_t, WS_MT);
    const float* RK = WSP(float, WS_RK); unsigned char* outa = WSP(unsigned char, WS_OUTA);
    const float* mu = P.in[3] + (size_t)l * 1696;
    const int lane = F.lane, h = F.wave;
    LAS unsigned char* ot = lds + LC_OT + h * TILE_B;
    for (int unit = blockIdx.x; unit < T / 64; unit += F.G) {
        int lz = lane; asm volatile("" : "+v"(lz)); const int c = lz & 15, q = lz >> 4;
        float gng[4], gnb[4];
#pragma unroll
        for (int vb = 0; vb < 4; ++vb) { gng[vb] = P.in[15][(size_t)l * 512 + h * 64 + 16 * vb + c]; gnb[vb] = P.in[16][(size_t)l * 512 + h * 64 + 16 * vb + c]; }
        const int t0 = unit * 64; const bool firstchunk = (t0 & (SEQ - 1)) == 0; const size_t chid = (size_t)unit * 8 + h;
        __syncthreads();
        for (int idx = F.tid; idx < 64 * 96; idx += 512) { const int tok = idx / 96, qq = idx % 96; const int col = 1536 + 64 + qq; const int t = t0 + tok;
            const bool hp = (tok > 0 || !firstchunk); const float p = bf2f(rkv[(size_t)t * RKVW + col]); const float ppl = bf2f(rkv[(size_t)(hp ? t - 1 : t) * RKVW + col]); const float pp = hp ? ppl : 0.f;
            *(LAS bf16_t*)(lds + LC_SGL + (tok * 104 + qq) * 2) = f2bf(sigmoidf_(p + (pp - p) * mu[1536 + 64 + qq])); }
        __syncthreads();
        float rkv_[16];
#pragma unroll
        for (int i = 0; i < 16; ++i) rkv_[i] = RK[(size_t)(t0 + 16 * (i >> 2) + 4 * q + (i & 3)) * 8 + h];
        bf16x4 Mf[16];
#pragma unroll
        for (int j = 0; j < 4; ++j)
#pragma unroll
            for (int vb = 0; vb < 4; ++vb) Mf[j * 4 + vb] = *(const bf16x4*)(MT + (chid * 64 + 16 * vb + c) * 64 + 16 * j + 4 * q);
        bf16x8 Gf[12];
#pragma unroll
        for (int vb = 0; vb < 4; ++vb)
#pragma unroll
            for (int ks = 0; ks < 3; ++ks) Gf[vb * 3 + ks] = *(const bf16x8*)(gupT + (size_t)(h * 64 + 16 * vb + c) * 96 + 32 * ks + 8 * q);
#pragma unroll
        for (int tb = 0; tb < 4; ++tb) {
            bf16x4 Pf[4];
#pragma unroll
            for (int j = 0; j < 4; ++j) Pf[j] = *(const bf16x4*)(PSI + (chid * 64 + 16 * tb + c) * 64 + 16 * j + 4 * q);
            f32x4 y[4], gt[4], vv[4];
#pragma unroll
            for (int vb = 0; vb < 4; ++vb) { y[vb] = unpack4(*(const u32x2*)(Y0T + (chid * 64 + 16 * vb + c) * 64 + 16 * tb + 4 * q)); vv[vb] = unpack4(*(const u32x2*)(VT + (chid * 64 + 16 * vb + c) * 64 + 16 * tb + 4 * q));
#pragma unroll
                for (int j = 0; j < 4; ++j) y[vb] = MFMA16(Pf[j], Mf[j * 4 + vb], y[vb]); }
            {   const LAS unsigned char* ar = lds + LC_SGL + ((16 * tb + c) * 104 + 8 * q) * 2;
                const bf16x8 a0 = *(const LAS bf16x8*)(ar), a1 = *(const LAS bf16x8*)(ar + 64), a2 = *(const LAS bf16x8*)(ar + 128);
#pragma unroll
                for (int vb = 0; vb < 4; ++vb) { f32x4 d = {0.f, 0.f, 0.f, 0.f}; d = MFMA32(a0, Gf[vb * 3], d); d = MFMA32(a1, Gf[vb * 3 + 1], d); d = MFMA32(a2, Gf[vb * 3 + 2], d); gt[vb] = d; } }
#pragma unroll
            for (int r = 0; r < 4; ++r) { const int tl = 16 * tb + 4 * q + r;
#if DEBUG_MODE
                { bf16_t* yd = WSP(bf16_t, DBG_YDBG) + (size_t)(t0 + tl) * 512 + h * 64; yd[c] = f2bf(y[0][r]); yd[16 + c] = f2bf(y[1][r]); yd[32 + c] = f2bf(y[2][r]); yd[48 + c] = f2bf(y[3][r]); }
#endif
                const float s = row16_sum((y[0][r] + y[1][r]) + (y[2][r] + y[3][r])); const float mean = s * (1.f / 64.f);
                const float d0 = y[0][r] - mean, d1 = y[1][r] - mean, d2 = y[2][r] - mean, d3 = y[3][r] - mean;
                const float var = row16_sum((d0 * d0 + d1 * d1) + (d2 * d2 + d3 * d3)) * (1.f / 64.f); const float rstd = rsqrtf(var + GN_EPS);
                const float rk = rkv_[tb * 4 + r];
                const float o0 = (d0 * rstd * gng[0] + gnb[0] + rk * vv[0][r]) * gt[0][r], o1 = (d1 * rstd * gng[1] + gnb[1] + rk * vv[1][r]) * gt[1][r];
                const float o2 = (d2 * rstd * gng[2] + gnb[2] + rk * vv[2][r]) * gt[2][r], o3 = (d3 * rstd * gng[3] + gnb[3] + rk * vv[3][r]) * gt[3][r];
                const unsigned pq = pack_fp8x4(4.f * o0, 4.f * o1, 4.f * o2, 4.f * o3);
                *(LAS unsigned char*)(ot + tl * 80 + c) = (unsigned char)pq; *(LAS unsigned char*)(ot + tl * 80 + 16 + c) = (unsigned char)(pq >> 8);
                *(LAS unsigned char*)(ot + tl * 80 + 32 + c) = (unsigned char)(pq >> 16); *(LAS unsigned char*)(ot + tl * 80 + 48 + c) = (unsigned char)(pq >> 24); }
        }
        asm volatile("s_waitcnt lgkmcnt(0)" ::: "memory");
        {   const LAS unsigned char* rowp = ot + lane * 80; unsigned char* dst = outa + (size_t)(t0 + lane) * 512 + h * 64;
#pragma unroll
            for (int m4 = 0; m4 < 4; ++m4) *(u32x4*)(dst + 16 * m4) = *(const LAS u32x4*)(rowp + 16 * m4); }
    }
    __syncthreads();
}
#if DEBUG_MODE
__device__ __forceinline__ void dbg_prep(Frame& F, const Params& P, int l) {
    LAS float* lora = (LAS float*)F.lds;
    const bf16_t* rkv = WSP(bf16_t, WS_RKV);
    const int c = F.tid;
    const float* mu = P.in[3] + (size_t)l * 1696; const float* muv = (l > 0) ? P.in[4] + (size_t)(l - 1) * 32 : nullptr;
    bf16_t* sv = WSP(bf16_t, WS_SV); bf16_t* sa = WSP(bf16_t, WS_SA); bf16_t* sb = WSP(bf16_t, WS_SB); bf16_t* sr = WSP(bf16_t, WS_SR); bf16_t* sk = WSP(bf16_t, WS_SK); bf16_t* sg = WSP(bf16_t, WS_SG);
    float* sw = WSP(float, WS_SW); float* rkb = WSP(float, DBG_RKREF); bf16_t* vfirst = WSP(bf16_t, WS_VFIRST);
    for (int grp = blockIdx.x; grp < T / 64; grp += F.G) {
        const int t0 = grp * 64;
        __syncthreads();
        for (int idx = F.tid; idx < 64 * 192; idx += 512) { const int tok = idx / 192, q = idx % 192; const int t = t0 + tok;
            const float p = bf2f(rkv[(size_t)t * RKVW + 1536 + q]); const float pp = ((t & (SEQ - 1)) != 0) ? bf2f(rkv[(size_t)(t - 1) * RKVW + 1536 + q]) : 0.f;
            const float m_ = (q < 160) ? mu[1536 + q] : (muv ? muv[q - 160] : 0.f);
            float val = p + (pp - p) * m_;
            if (q < 32) val = tanhf(val); else if (q >= 64 && q < 160) val = sigmoidf_(val);
            lora[tok * 192 + q] = val; }
        __syncthreads();
        {
            unsigned cc = c; asm volatile("" : "+v"(cc));
            float col[32]; const float w0 = P.in[5][(size_t)l * 512 + c];
#pragma unroll
            for (int i = 0; i < 32; ++i) col[i] = (P.in[6] + (size_t)l * 32 * 512)[(unsigned)(i * 512) + cc];
            for (int tok = 0; tok < 64; ++tok) { const LAS float* lr = lora + tok * 192; float z = w0;
#pragma unroll
                for (int i = 0; i < 32; ++i) z += lr[i] * col[i];
                sw[(size_t)(t0 + tok) * 512 + c] = __expf(-0.6065306597126334f * sigmoidf_(z)); }
            asm volatile("" ::: "memory"); }
        {
            unsigned cc = c; asm volatile("" : "+v"(cc));
            float col[32]; const float a0 = P.in[7][(size_t)l * 512 + c];
            const float mu_r = mu[c], mu_k = mu[512 + c];
            const float k_k = P.in[12][(size_t)l * 512 + c], k_a = P.in[13][(size_t)l * 512 + c], r_k = P.in[14][(size_t)l * 512 + c];
#pragma unroll
            for (int i = 0; i < 32; ++i) col[i] = (P.in[8] + (size_t)l * 32 * 512)[(unsigned)(i * 512) + cc];
            for (int tok = 0; tok < 64; ++tok) { const int t = t0 + tok; const bool first = (t & (SEQ - 1)) == 0;
                const size_t ro = (size_t)t * RKVW, rp = (size_t)(t - 1) * RKVW;
                const float pr = bf2f(rkv[ro + c]), pk = bf2f(rkv[ro + 512 + c]);
                const float qr = first ? 0.f : bf2f(rkv[rp + c]), qk = first ? 0.f : bf2f(rkv[rp + 512 + c]);
                const float r = pr + (qr - pr) * mu_r, k = pk + (qk - pk) * mu_k;
                const LAS float* lr = lora + tok * 192 + 32; float z = a0;
#pragma unroll
                for (int i = 0; i < 32; ++i) z += lr[i] * col[i];
                const float iclr = sigmoidf_(z);
                float kk = k * k_k; const float ss = wave_sum(kk * kk); kk = kk / fmaxf(sqrtf(ss), 1e-12f);
                const float kh = k * (1.0f + (iclr - 1.0f) * k_a);
                const float rks = wave_sum(r * kh * r_k);
                const size_t o = (size_t)t * 512 + c;
                sr[o] = f2bf(r); sk[o] = f2bf(kh); sa[o] = f2bf(-kk); sb[o] = f2bf(kk * iclr);
                if (F.lane == 0) rkb[(size_t)t * 8 + F.wave] = rks; }
            asm volatile("" ::: "memory"); }
        {
            unsigned cc = c; asm volatile("" : "+v"(cc));
            float col[32]; const float v0 = (l > 0) ? P.in[10][(size_t)(l - 1) * 512 + c] : 0.f; const float mu_v = mu[1024 + c];
#pragma unroll
            for (int i = 0; i < 32; ++i) col[i] = (l > 0) ? (P.in[11] + (size_t)(l - 1) * 32 * 512)[(unsigned)(i * 512) + cc] : 0.f;
            for (int tok = 0; tok < 64; ++tok) { const int t = t0 + tok; const bool first = (t & (SEQ - 1)) == 0;
                const float pv = bf2f(rkv[(size_t)t * RKVW + 1024 + c]); const float qv = first ? 0.f : bf2f(rkv[(size_t)(t - 1) * RKVW + 1024 + c]);
                float v = pv + (qv - pv) * mu_v;
                const size_t o = (size_t)t * 512 + c;
                if (l == 0) vfirst[o] = f2bf(v);
                else { const LAS float* lr = lora + tok * 192 + 160; float z = v0;
#pragma unroll
                    for (int i = 0; i < 32; ++i) z += lr[i] * col[i];
                    v = v + (bf2f(vfirst[o]) - v) * sigmoidf_(z); }
                sv[o] = f2bf(v); }
            asm volatile("" ::: "memory"); }
        {
            unsigned cc = c; asm volatile("" : "+v"(cc));
            float col[96];
#pragma unroll
            for (int i = 0; i < 96; ++i) col[i] = (P.in[9] + (size_t)l * 96 * 512)[(unsigned)(i * 512) + cc];
            for (int tok = 0; tok < 64; ++tok) { const LAS float* lr = lora + tok * 192 + 64; float g = 0.f;
#pragma unroll
                for (int i = 0; i < 96; ++i) g += lr[i] * col[i];
                sg[(size_t)(t0 + tok) * 512 + c] = f2bf(g); }
            asm volatile("" ::: "memory"); }
    }
    __syncthreads();
}
__device__ __forceinline__ void dbg_scan(Frame& F, const Params& P, int l, int wg0, int nwg) {
    constexpr int CH = 32;
    LAS float* buf = (LAS float*)F.lds;
    LAS float* ybuf = (LAS float*)(F.lds + 2 * 6 * CH * 64 * 4);
    const bf16_t* sv = WSP(bf16_t, WS_SV); const bf16_t* sa = WSP(bf16_t, WS_SA); const bf16_t* sb = WSP(bf16_t, WS_SB); const bf16_t* sr = WSP(bf16_t, WS_SR); const bf16_t* sk = WSP(bf16_t, WS_SK); const bf16_t* sg = WSP(bf16_t, WS_SG);
    const float* sw = WSP(float, WS_SW); const float* rkb = WSP(float, DBG_RKREF); bf16_t* outa = WSP(bf16_t, DBG_OUTAREF);
    const float* gn_g = P.in[15] + (size_t)l * 512; const float* gn_b = P.in[16] + (size_t)l * 512;
    int bh0 = __builtin_amdgcn_readfirstlane((int)blockIdx.x - wg0);
    for (int bh = bh0; bh < 128; bh += nwg) {
        const int b = bh >> 3, h = bh & 7; const size_t tb = (size_t)b * SEQ;
        const int ltok = F.tid >> 4, lch = (F.tid & 15) * 4;
        float S[8];
#pragma unroll
        for (int j = 0; j < 8; ++j) S[j] = 0.f;
        const int i8 = F.lane >> 3, seg = F.lane & 7, vrow = 8 * F.wave + i8;
        u32x2 pre_b[5]; f32x4 pre_w;
        __syncthreads();
        {   const size_t o = (tb + ltok) * 512 + h * 64 + lch;
            pre_b[0] = *(const u32x2*)(sr + o); pre_b[1] = *(const u32x2*)(sk + o); pre_b[2] = *(const u32x2*)(sv + o); pre_b[3] = *(const u32x2*)(sa + o); pre_b[4] = *(const u32x2*)(sb + o); pre_w = *(const f32x4*)(sw + o);
            LAS float* d = buf + ltok * 64 + lch;
#pragma unroll
            for (int a = 0; a < 5; ++a) { *(LAS f32x4*)(d + a * CH * 64) = (f32x4){bflo(pre_b[a].x), bfhi(pre_b[a].x), bflo(pre_b[a].y), bfhi(pre_b[a].y)}; }
            *(LAS f32x4*)(d + 5 * CH * 64) = pre_w; }
        __syncthreads();
        for (int ck = 0; ck < SEQ / CH; ++ck) {
            const int cur = ck & 1; const LAS float* cb = buf + cur * 6 * CH * 64;
            if (ck + 1 < SEQ / CH) { const size_t o = (tb + (ck + 1) * CH + ltok) * 512 + h * 64 + lch;
                pre_b[0] = *(const u32x2*)(sr + o); pre_b[1] = *(const u32x2*)(sk + o); pre_b[2] = *(const u32x2*)(sv + o); pre_b[3] = *(const u32x2*)(sa + o); pre_b[4] = *(const u32x2*)(sb + o); pre_w = *(const f32x4*)(sw + o); }
            if ((ck & 1) == 0) { float* mr = WSP(float, DBG_MREF) + ((size_t)((b * 32 + (ck >> 1)) * 8 + h)) * 4096;
#pragma unroll
                for (int j = 0; j < 8; ++j) mr[(size_t)(8 * seg + j) * 64 + vrow] = S[j]; }
            for (int tok = 0; tok < CH; ++tok) {
                const LAS float* p = cb + tok * 64 + seg * 8;
                const f32x4 r0 = *(const LAS f32x4*)(p), r1 = *(const LAS f32x4*)(p + 4);
                const f32x4 k0 = *(const LAS f32x4*)(p + CH * 64), k1 = *(const LAS f32x4*)(p + CH * 64 + 4);
                const float vv = cb[2 * CH * 64 + tok * 64 + vrow];
                const f32x4 a0 = *(const LAS f32x4*)(p + 3 * CH * 64), a1 = *(const LAS f32x4*)(p + 3 * CH * 64 + 4);
                const f32x4 b0 = *(const LAS f32x4*)(p + 4 * CH * 64), b1 = *(const LAS f32x4*)(p + 4 * CH * 64 + 4);
                const f32x4 w0 = *(const LAS f32x4*)(p + 5 * CH * 64), w1 = *(const LAS f32x4*)(p + 5 * CH * 64 + 4);
                float sa_ = 0.f;
#pragma unroll
                for (int j = 0; j < 4; ++j) { sa_ += S[j] * a0[j]; sa_ += S[4 + j] * a1[j]; }
                sa_ = reduce8(sa_);
                float y = 0.f;
#pragma unroll
                for (int j = 0; j < 4; ++j) { S[j] = S[j] * w0[j] + (sa_ * b0[j] + vv * k0[j]); S[4 + j] = S[4 + j] * w1[j] + (sa_ * b1[j] + vv * k1[j]); y += S[j] * r0[j]; y += S[4 + j] * r1[j]; }
                y = reduce8(y);
                if (seg == 0) ybuf[tok * 64 + vrow] = y;
            }
            __syncthreads();
            {
                const int tok = F.tid >> 4, vq = (F.tid & 15) * 4; const size_t t = tb + (size_t)ck * CH + tok;
                const f32x4 yv = *(const LAS f32x4*)(ybuf + tok * 64 + vq);
                { u32x2 wy; wy.x = cvt_pk_bf16(yv[0], yv[1]); wy.y = cvt_pk_bf16(yv[2], yv[3]); *(u32x2*)(WSP(bf16_t, DBG_YREF) + t * 512 + h * 64 + vq) = wy; }
                float s = (yv[0] + yv[1]) + (yv[2] + yv[3]);
                s += __shfl_xor(s, 1); s += __shfl_xor(s, 2); s += __shfl_xor(s, 4); s += __shfl_xor(s, 8);
                const float mean = s * (1.f / 64.f);
                const f32x4 dv = yv - mean; float q = (dv[0] * dv[0] + dv[1] * dv[1]) + (dv[2] * dv[2] + dv[3] * dv[3]);
                q += __shfl_xor(q, 1); q += __shfl_xor(q, 2); q += __shfl_xor(q, 4); q += __shfl_xor(q, 8);
                const float rstd = rsqrtf(q * (1.f / 64.f) + GN_EPS);
                const float rk = rkb[t * 8 + h];
                const f32x4 vv = *(const LAS f32x4*)(cb + 2 * CH * 64 + tok * 64 + vq);
                const f32x4 gg = *(const f32x4*)(gn_g + h * 64 + vq), gb = *(const f32x4*)(gn_b + h * 64 + vq);
                const u32x2 gt = *(const u32x2*)(sg + t * 512 + h * 64 + vq);
                float o[4]; const float gtf[4] = {bflo(gt.x), bfhi(gt.x), bflo(gt.y), bfhi(gt.y)};
#pragma unroll
                for (int j = 0; j < 4; ++j) o[j] = (dv[j] * rstd * gg[j] + gb[j] + rk * vv[j]) * gtf[j];
                u32x2 w; w.x = cvt_pk_bf16(o[0], o[1]); w.y = cvt_pk_bf16(o[2], o[3]);
                *(u32x2*)(outa + t * 512 + h * 64 + vq) = w; }
            if (ck + 1 < SEQ / CH) { LAS float* d = buf + (cur ^ 1) * 6 * CH * 64 + ltok * 64 + lch;
#pragma unroll
                for (int a = 0; a < 5; ++a) { *(LAS f32x4*)(d + a * CH * 64) = (f32x4){bflo(pre_b[a].x), bfhi(pre_b[a].x), bflo(pre_b[a].y), bfhi(pre_b[a].y)}; }
                *(LAS f32x4*)(d + 5 * CH * 64) = pre_w; }
            __syncthreads();
        }
    }
}

template <class TA, class TB> __device__ __forceinline__ void dbg_compare(Frame& F, const TA* a, const TB* b, size_t n, unsigned* ctl, int mode_transpose64) {
    float num = 0.f, den = 0.f;
    for (size_t i = (size_t)blockIdx.x * 512 + F.tid; i < n; i += (size_t)F.G * 512) {
        size_t ia = i;
        if (mode_transpose64) { const size_t tile = i >> 12, rem = i & 4095, r = rem >> 6, c2 = rem & 63; ia = (tile << 12) + c2 * 64 + r; }
        float x, y;
        if (sizeof(TA) == 2) x = bf2f(((const bf16_t*)a)[ia]); else x = ((const float*)a)[ia];
        if (sizeof(TB) == 2) y = bf2f(((const bf16_t*)b)[i]); else y = ((const float*)b)[i];
        const float d = x - y; num += d * d; den += y * y; }
    num = wave_sum(num); den = wave_sum(den);
    LAS float* red = (LAS float*)F.lds;
    __syncthreads();
    if (F.lane == 0) { red[F.wave * 2] = num; red[F.wave * 2 + 1] = den; }
    __syncthreads();
    if (F.tid == 0) { float n2 = 0.f, d2 = 0.f; for (int w8 = 0; w8 < 8; ++w8) { n2 += red[w8 * 2]; d2 += red[w8 * 2 + 1]; }
        ((float*)ctl)[1024 + 2 * blockIdx.x] = n2; ((float*)ctl)[1025 + 2 * blockIdx.x] = d2; }
}

constexpr size_t DBG_BF = WS_CONVH;
__device__ __forceinline__ void dbg_bruteforce(Frame& F) {
    LAS float* Ph = (LAS float*)F.lds; LAS float* Gm = Ph + 64 * 65; LAS float* vec = Gm + 64 * 65; LAS float* s1 = vec + 6 * 64; LAS float* s2 = s1 + 64;
    const bf16_t* sv = WSP(bf16_t, WS_SV); const bf16_t* sa = WSP(bf16_t, WS_SA); const bf16_t* sb = WSP(bf16_t, WS_SB); const bf16_t* sr = WSP(bf16_t, WS_SR); const bf16_t* sk = WSP(bf16_t, WS_SK); const float* sw = WSP(float, WS_SW);
    float* out = WSP(float, DBG_BF);
    const int chid = blockIdx.x, unit = chid >> 3, h = chid & 7, t0 = unit * 64;
    const int k = F.tid >> 3, j0 = (F.tid & 7) * 8;
    for (int e = 0; e < 8; ++e) { Ph[k * 65 + j0 + e] = (k == j0 + e) ? 1.f : 0.f; Gm[k * 65 + j0 + e] = 0.f; }
    __syncthreads();
    for (int t = 0; t < 64; ++t) {
        if (F.tid < 384) { const int a = F.tid >> 6, ch = F.tid & 63; const size_t o = (size_t)(t0 + t) * 512 + h * 64 + ch;
            float x; if (a == 0) x = sw[o]; else if (a == 1) x = bf2f(sa[o]); else if (a == 2) x = bf2f(sb[o]); else if (a == 3) x = bf2f(sk[o]); else if (a == 4) x = bf2f(sv[o]); else x = bf2f(sr[o]);
            vec[a * 64 + ch] = x; }
        __syncthreads();
        if (F.tid < 64) { float s = 0.f; for (int kk = 0; kk < 64; ++kk) s += vec[64 + kk] * Ph[kk * 65 + F.tid]; s1[F.tid] = s; }
        else if (F.tid < 128) { const int j = F.tid - 64; float s = 0.f; for (int kk = 0; kk < 64; ++kk) s += vec[64 + kk] * Gm[kk * 65 + j]; s2[j] = s; }
        __syncthreads();
        for (int e = 0; e < 8; ++e) { const int j = j0 + e; Ph[k * 65 + j] = vec[k] * Ph[k * 65 + j] + vec[128 + k] * s1[j]; Gm[k * 65 + j] = vec[k] * Gm[k * 65 + j] + vec[128 + k] * s2[j] + vec[192 + k] * vec[256 + j]; }
        __syncthreads();
        if (F.tid < 64) { float s = 0.f; for (int kk = 0; kk < 64; ++kk) s += vec[320 + kk] * Ph[kk * 65 + F.tid]; out[((size_t)(2 * 256 + chid) * 64 + t) * 64 + F.tid] = s; }
        else if (F.tid < 128) { const int j = F.tid - 64; float s = 0.f; for (int kk = 0; kk < 64; ++kk) s += vec[320 + kk] * Gm[kk * 65 + j]; out[((size_t)(3 * 256 + chid) * 64 + t) * 64 + j] = s; }
    }
    __syncthreads();
    for (int e = 0; e < 8; ++e) { out[((size_t)(0 * 256 + chid) * 64 + k) * 64 + j0 + e] = Ph[k * 65 + j0 + e]; out[((size_t)(1 * 256 + chid) * 64 + k) * 64 + j0 + e] = Gm[k * 65 + j0 + e]; }
}
__device__ __forceinline__ void dbg_compare_vt(Frame& F, unsigned* ctl) {
    const bf16_t* VT = WSP(bf16_t, WS_VT); const bf16_t* sv = WSP(bf16_t, WS_SV); float num = 0.f, den = 0.f;
    for (size_t i = (size_t)blockIdx.x * 512 + F.tid; i < (size_t)T * 512; i += (size_t)F.G * 512) { const size_t t = i >> 9, cg = i & 511, hh = cg >> 6, ch = cg & 63; const size_t chid = (t >> 6) * 8 + hh;
        const float x = bf2f(VT[(chid * 64 + ch) * 64 + (t & 63)]), y = bf2f(sv[i]); const float d = x - y; num += d * d; den += y * y; }
    num = wave_sum(num); den = wave_sum(den);
    LAS float* red = (LAS float*)F.lds; __syncthreads(); if (F.lane == 0) { red[F.wave * 2] = num; red[F.wave * 2 + 1] = den; } __syncthreads();
    if (F.tid == 0) { float n2 = 0.f, d2 = 0.f; for (int w8 = 0; w8 < 8; ++w8) { n2 += red[w8 * 2]; d2 += red[w8 * 2 + 1]; } ((float*)ctl)[1024 + 2 * blockIdx.x] = n2; ((float*)ctl)[1025 + 2 * blockIdx.x] = d2; }
}
#endif
__device__ __forceinline__ void phase_sgu(Frame& F, const Params& P, int l, int wg0, int nwg) {
    LAS unsigned char* vt = F.lds;
    const bf16_t* z = WSP(bf16_t, WS_SGUZ); unsigned char* hb = WSP(unsigned char, WS_HB);
    const bf16_t* Wm = WSP(bf16_t, WS_SGUW) + (size_t)l * 4 * 128 * 128;
    const float* bs = P.in[21] + (size_t)l * 4 * 128;
    int u0 = __builtin_amdgcn_readfirstlane((int)blockIdx.x - wg0);
    for (int u = u0; u < T / 128; u += nwg) {
        int uu = u; asm volatile("" : "+v"(uu)); uu = __builtin_amdgcn_readfirstlane(uu);
        int lz = F.lane; asm volatile("" : "+v"(lz));
        const size_t t0 = (size_t)uu * 128;
        __syncthreads();
        {
            float lg[4], lb[4];
#pragma unroll
            for (int e = 0; e < 4; ++e) { lg[e] = P.in[18][(size_t)l * 256 + lz + 64 * e]; lb[e] = P.in[19][(size_t)l * 256 + lz + 64 * e]; }
            float vall[16][4];
#pragma unroll
            for (int i = 0; i < 16; ++i) { const bf16_t* zr = z + (t0 + F.wave * 16 + i) * 512 + 256 + lz;
#pragma unroll
                for (int e = 0; e < 4; ++e) vall[i][e] = bf2f(zr[64 * e]); }
#pragma unroll
            for (int i = 0; i < 16; ++i) { const int tok = F.wave * 16 + i;
                float v[4];
#pragma unroll
                for (int e = 0; e < 4; ++e) v[e] = vall[i][e];
                const float mean = wave_sum((v[0] + v[1]) + (v[2] + v[3])) * (1.f / 256.f);
#pragma unroll
                for (int e = 0; e < 4; ++e) v[e] -= mean;
                const float rstd = rsqrtf(wave_sum((v[0] * v[0] + v[1] * v[1]) + (v[2] * v[2] + v[3] * v[3])) * (1.f / 256.f) + LN_EPS);
#pragma unroll
                for (int e = 0; e < 4; ++e) { const int ch = lz + 64 * e; *(LAS bf16_t*)(vt + ch * 256 + ((((tok >> 3) ^ (ch & 15)) << 4) | ((tok & 7) << 1))) = f2bf(v[e] * rstd * lg[e] + lb[e]); } } }
        __syncthreads();
        {   const int c = lz & 15, qd = lz >> 4, g = F.wave >> 1, sel = F.wave & 1;
            const bf16_t* Wg = Wm + (size_t)g * 128 * 128;
            f32x4 acc[4][4];
#pragma unroll
            for (int pi = 0; pi < 4; ++pi)
#pragma unroll
                for (int db = 0; db < 4; ++db) acc[pi][db] = (f32x4){0.f, 0.f, 0.f, 0.f};
#pragma unroll
            for (int ks = 0; ks < 4; ++ks) {
                bf16x8 af[4];
#pragma unroll
                for (int db = 0; db < 4; ++db) { const int ch = 64 * g + 16 * db + c; af[db] = *(const LAS bf16x8*)(vt + ch * 256 + (((4 * ks + qd) ^ (ch & 15)) << 4)); }
#pragma unroll
                for (int pi = 0; pi < 4; ++pi) { const int pb = sel ? ((pi == 0) ? 1 : (pi == 1) ? 2 : (pi == 2) ? 5 : 6) : ((pi == 0) ? 0 : (pi == 1) ? 3 : (pi == 2) ? 4 : 7);
                    if (32 * ks <= 16 * pb + 15) { const bf16x8 bfr = *(const bf16x8*)(Wg + (size_t)(16 * pb + c) * 128 + 32 * ks + 8 * qd);
#pragma unroll
                        for (int db = 0; db < 4; ++db) acc[pi][db] = MFMA32(af[db], bfr, acc[pi][db]); } } }
            u32x2 uraw[4][4]; float biasv[4];
#pragma unroll
            for (int pi = 0; pi < 4; ++pi) { const int pb = sel ? ((pi == 0) ? 1 : (pi == 1) ? 2 : (pi == 2) ? 5 : 6) : ((pi == 0) ? 0 : (pi == 1) ? 3 : (pi == 2) ? 4 : 7);
                const int p = 16 * pb + c; biasv[pi] = bs[g * 128 + p];
#pragma unroll
                for (int db = 0; db < 4; ++db) uraw[pi][db] = *(const u32x2*)(z + (t0 + p) * 512 + 64 * g + 16 * db + 4 * qd); }
#pragma unroll
            for (int pi = 0; pi < 4; ++pi) { const int pb = sel ? ((pi == 0) ? 1 : (pi == 1) ? 2 : (pi == 2) ? 5 : 6) : ((pi == 0) ? 0 : (pi == 1) ? 3 : (pi == 2) ? 4 : 7);
                const size_t t = t0 + 16 * pb + c;
#pragma unroll
                for (int db = 0; db < 4; ++db) { const int ch = 64 * g + 16 * db + 4 * qd;
                    const f32x4 o = unpack4(uraw[pi][db]) * (acc[pi][db] + biasv[pi]) * 4.f; *(unsigned*)(hb + t * 256 + ch) = pack_fp8x4(o[0], o[1], o[2], o[3]); } } }
    }
    __syncthreads();
}
__device__ __forceinline__ void phase_conv(Frame& F, const Params& P, int l, int wg0, int nwg) {
    LAS float* cv = (LAS float*)F.lds;
    const bf16_t* hin = WSP(bf16_t, WS_CONVH); unsigned char* hc = WSP(unsigned char, WS_HC);
    const float* dw = P.in[23] + (size_t)l * 31 * 256; const float* db = P.in[24] + (size_t)l * 256;
    const float* lg = P.in[25] + (size_t)l * 256; const float* lb = P.in[26] + (size_t)l * 256;
    int u0 = __builtin_amdgcn_readfirstlane((int)blockIdx.x - wg0);
    for (int u = u0; u < T / 64; u += nwg) {
        int tz = F.tid; asm volatile("" : "+v"(tz)); const int ch = tz & 255, hf = tz >> 8, lz = tz & 63;
        float kw[31];
#pragma unroll
        for (int j = 0; j < 31; ++j) kw[j] = dw[j * 256 + ch];
        const float bias = db[ch];
        const int t0 = u * 64 + hf * 32; const int s0 = t0 & (SEQ - 1);
        __syncthreads();
        float x[38];
#pragma unroll
        for (int m = 0; m < 30; ++m) { const int s = s0 - 30 + m; const float ld = bf2f(hin[(size_t)(t0 - 30 + m + (s >= 0 ? 0 : 30)) * 256 + ch]); x[m] = (s >= 0) ? ld : 0.f; }
#pragma unroll
        for (int g8 = 0; g8 < 4; ++g8) {
#pragma unroll
            for (int m = 0; m < 8; ++m) x[30 + m] = bf2f(hin[(size_t)(t0 + 8 * g8 + m) * 256 + ch]);
#pragma unroll
            for (int i = 0; i < 8; ++i) { float a = bias;
#pragma unroll
                for (int j = 0; j < 31; ++j) a += kw[j] * x[i + j];
                cv[(hf * 32 + 8 * g8 + i) * 256 + ch] = a; }
#pragma unroll
            for (int m = 0; m < 30; ++m) x[m] = x[m + 8]; }
        __syncthreads();
        {   const f32x4 g = *(const f32x4*)(lg + lz * 4), bb = *(const f32x4*)(lb + lz * 4);
            for (int i = 0; i < 8; ++i) { const int tok = F.wave * 8 + i; f32x4 v = *(const LAS f32x4*)(cv + tok * 256 + lz * 4);
                const float mean = wave_sum((v[0] + v[1]) + (v[2] + v[3])) * (1.f / 256.f);
                v = v - mean; const float var = wave_sum((v[0] * v[0] + v[1] * v[1]) + (v[2] * v[2] + v[3] * v[3])) * (1.f / 256.f);
                const float rstd = rsqrtf(var + LN_EPS);
                v = v * rstd * g + bb;
                float o[4];
#pragma unroll
                for (int j = 0; j < 4; ++j) o[j] = v[j] * sigmoidf_(v[j]);
                *(unsigned*)(hc + (size_t)(u * 64 + tok) * 256 + lz * 4) = pack_fp8x4(4.f * o[0], 4.f * o[1], 4.f * o[2], 4.f * o[3]); } }
    }
    __syncthreads();
}
__device__ __forceinline__ void ln_load16(const bf16_t* p, float (&v)[16]) {
    const u32x4 a = *(const u32x4*)p, b = *(const u32x4*)(p + 8);
    v[0] = bflo(a.x); v[1] = bfhi(a.x); v[2] = bflo(a.y); v[3] = bfhi(a.y); v[4] = bflo(a.z); v[5] = bfhi(a.z); v[6] = bflo(a.w); v[7] = bfhi(a.w);
    v[8] = bflo(b.x); v[9] = bfhi(b.x); v[10] = bflo(b.y); v[11] = bfhi(b.y); v[12] = bflo(b.z); v[13] = bfhi(b.z); v[14] = bflo(b.w); v[15] = bfhi(b.w);
}
__device__ __forceinline__ void ln_norm16(float (&v)[16], const float* g, const float* b, int lane) {
    float s = 0.f;
#pragma unroll
    for (int j = 0; j < 16; ++j) s += v[j];
    const float mean = wave_sum(s) * (1.f / 1024.f); float q = 0.f;
#pragma unroll
    for (int j = 0; j < 16; ++j) { v[j] -= mean; q += v[j] * v[j]; }
    const float rstd = rsqrtf(wave_sum(q) * (1.f / 1024.f) + LN_EPS);
#pragma unroll
    for (int j4 = 0; j4 < 4; ++j4) { const f32x4 gg = *(const f32x4*)(g + lane * 16 + j4 * 4), bb = *(const f32x4*)(b + lane * 16 + j4 * 4);
#pragma unroll
        for (int j = 0; j < 4; ++j) v[j4 * 4 + j] = v[j4 * 4 + j] * rstd * gg[j] + bb[j]; }
}
__device__ __forceinline__ void ln_store16(bf16_t* p, const float (&v)[16]) {
    u32x4 a, b; a.x = cvt_pk_bf16(v[0], v[1]); a.y = cvt_pk_bf16(v[2], v[3]); a.z = cvt_pk_bf16(v[4], v[5]); a.w = cvt_pk_bf16(v[6], v[7]);
    b.x = cvt_pk_bf16(v[8], v[9]); b.y = cvt_pk_bf16(v[10], v[11]); b.z = cvt_pk_bf16(v[12], v[13]); b.w = cvt_pk_bf16(v[14], v[15]);
    *(u32x4*)p = a; *(u32x4*)(p + 8) = b;
}
__device__ __forceinline__ void ln_load16q(const unsigned char* p, float (&v)[16]) {
    const u32x4 a = *(const u32x4*)p; const unsigned w[4] = {a.x, a.y, a.z, a.w};
#pragma unroll
    for (int i = 0; i < 4; ++i) { const f32x2 lo = __builtin_amdgcn_cvt_pk_f32_fp8((int)w[i], false), hi = __builtin_amdgcn_cvt_pk_f32_fp8((int)w[i], true); v[4 * i] = lo[0]; v[4 * i + 1] = lo[1]; v[4 * i + 2] = hi[0]; v[4 * i + 3] = hi[1]; }
}
__device__ __forceinline__ void ln_store16q(unsigned char* p, const float (&v)[16]) {
    u32x4 a; a.x = pack_fp8x4(v[0], v[1], v[2], v[3]); a.y = pack_fp8x4(v[4], v[5], v[6], v[7]); a.z = pack_fp8x4(v[8], v[9], v[10], v[11]); a.w = pack_fp8x4(v[12], v[13], v[14], v[15]);
    *(u32x4*)p = a;
}
__device__ __forceinline__ void phase_ln1(Frame& F, const Params& P, int l, int wg0, int nwg) {
    const bf16_t* pre = WSP(bf16_t, WS_PRE); const float* stats = WSP(float, WS_STATS);
    const float* g = P.in[29] + (size_t)l * 1024; const float* b = P.in[30] + (size_t)l * 1024;
    const int gw = ((int)blockIdx.x - wg0) * 8 + F.wave, NGW = nwg * 8;
    float gg[16], bb[16];
#pragma unroll
    for (int j4 = 0; j4 < 4; ++j4) { const f32x4 g4 = *(const f32x4*)(g + F.lane * 16 + j4 * 4), b4 = *(const f32x4*)(b + F.lane * 16 + j4 * 4);
#pragma unroll
        for (int j = 0; j < 4; ++j) { gg[j4 * 4 + j] = g4[j]; bb[j4 * 4 + j] = b4[j]; } }
    for (int row = gw; row < T; row += NGW) { float v[16]; ln_load16(pre + (size_t)row * 1024 + F.lane * 16, v);
        const f32x2 sl = *(const f32x2*)(stats + ((size_t)row * 16 + (F.lane & 15)) * 2);
        const float mean = row16_sum(sl[0]) * (1.f / 1024.f), ex2 = row16_sum(sl[1]) * (1.f / 1024.f);
        const float rstd = rsqrtf(fmaxf(ex2 - mean * mean, 0.f) + LN_EPS);
#pragma unroll
        for (int j = 0; j < 16; ++j) v[j] = (v[j] - mean) * rstd * gg[j] + bb[j];
        ln_store16q(WSP(unsigned char, WS_X1Q) + (size_t)row * 1024 + F.lane * 16, v); }
}
__device__ __forceinline__ void phase_ln2(Frame& F, const Params& P, int l) {
    const bf16_t* pre = WSP(bf16_t, WS_PRE); const float* stats = WSP(float, WS_STATS); const unsigned char* Y = WSP(unsigned char, WS_Y); bf16_t* x = WSP(bf16_t, WS_X); const int* inv = WSP(int, WS_GATEV);
    const float* g = P.in[36] + (size_t)l * 1024; const float* b = P.in[37] + (size_t)l * 1024; const float* g1 = P.in[29] + (size_t)l * 1024; const float* b1 = P.in[30] + (size_t)l * 1024;
    const int gw = blockIdx.x * 8 + F.wave, NGW = F.G * 8;
    int n0 = inv[2 * gw], n1 = inv[2 * gw + 1];
#pragma unroll 1
    for (int row = gw; row < T; row += NGW) { float v[16], y0[16], y1[16];
        const int c0 = __builtin_amdgcn_readfirstlane(n0), c1 = __builtin_amdgcn_readfirstlane(n1);
        { const int rn = (row + NGW < T) ? row + NGW : row; n0 = inv[2 * rn]; n1 = inv[2 * rn + 1]; }
        ln_load16(pre + (size_t)row * 1024 + F.lane * 16, v); ln_load16q(Y + (size_t)c0 * 1024 + F.lane * 16, y0); ln_load16q(Y + (size_t)c1 * 1024 + F.lane * 16, y1);
        {   const f32x2 sl = *(const f32x2*)(stats + ((size_t)row * 16 + (F.lane & 15)) * 2);
            const float mean = row16_sum(sl[0]) * (1.f / 1024.f), ex2 = row16_sum(sl[1]) * (1.f / 1024.f); const float rstd = rsqrtf(fmaxf(ex2 - mean * mean, 0.f) + LN_EPS);
#pragma unroll
            for (int j4 = 0; j4 < 4; ++j4) { const f32x4 g4 = *(const f32x4*)(g1 + F.lane * 16 + j4 * 4), b4 = *(const f32x4*)(b1 + F.lane * 16 + j4 * 4);
#pragma unroll
                for (int j = 0; j < 4; ++j) v[j4 * 4 + j] = (v[j4 * 4 + j] - mean) * rstd * g4[j] + b4[j]; } }
#pragma unroll
        for (int j = 0; j < 16; ++j) v[j] = ALPHA * v[j] + 0.125f * (y0[j] + y1[j]);
        ln_norm16(v, g, b, F.lane);
        if (l == NL - 1) { float* o = F.out + (size_t)row * 1024 + F.lane * 16;
#pragma unroll
            for (int j4 = 0; j4 < 4; ++j4) *(f32x4*)(o + j4 * 4) = (f32x4){v[j4 * 4], v[j4 * 4 + 1], v[j4 * 4 + 2], v[j4 * 4 + 3]}; }
        else { ln_store16(x + (size_t)row * 1024 + F.lane * 16, v); ln_store16q(WSP(unsigned char, WS_XQ) + (size_t)row * 1024 + F.lane * 16, v); } }
}

#define PHASE_PROLOGUE() const Params P = KPARAMS(); Frame F = make_frame(P.ws, P.out); unsigned* ctl = (unsigned*)(F.ws + WS_CTL); (void)ctl
__device__ __forceinline__ void ph_prologue_a() { PHASE_PROLOGUE(); phase_convert_static(F, P); __syncthreads(); }
__device__ __forceinline__ void ph_prologue_b() { PHASE_PROLOGUE(); phase_convert_lora(F, P); phase_convert_sgu(F, P); phase_convert_router(F, P); __syncthreads(); }
__device__ __forceinline__ void ph_prologue_c() { PHASE_PROLOGUE(); phase_x_to_bf16(F, P); __syncthreads(); }
__device__ __forceinline__ void ph_prologue() { PHASE_PROLOGUE(); phase_convert_static(F, P); phase_convert_lora(F, P); phase_convert_sgu(F, P); phase_convert_router(F, P); phase_x_to_bf16(F, P); phase_convert_moe(F, P, 0); __syncthreads(); }
__device__ __forceinline__ void ph_inproj(int l) { PHASE_PROLOGUE();
    SchedInproj S{(const char*)WSP(unsigned char, WS_XQ), (const char*)(WSP(unsigned char, WS_WIN) + (size_t)l * NIN * 1024), F.G, (int)blockIdx.x};
    EpiInproj E{WSP(bf16_t, WS_RKV), WSP(bf16_t, WS_SGUZ), WSP(bf16_t, WS_CONVH), WSP(unsigned char, WS_GATES)};
    ge::gemm_phase<SchedInproj, EpiInproj, true>(F.lds, S, E); }
__device__ __forceinline__ void ph_inproj_null(int l) { PHASE_PROLOGUE();
    SchedInproj S{(const char*)WSP(unsigned char, WS_XQ), (const char*)(WSP(unsigned char, WS_WIN) + (size_t)l * NIN * 1024), F.G, (int)blockIdx.x};
    EpiNull E{WSP(bf16_t, WS_HB)};
    ge::gemm_phase<SchedInproj, EpiNull, true>(F.lds, S, E); }
__device__ __forceinline__ void ph_wkva(int l) { PHASE_PROLOGUE(); phase_wkv_a<false>(F, P, l); }
__device__ __forceinline__ void ph_wkva_e(int l) { PHASE_PROLOGUE(); phase_wkv_a<true>(F, P, l); }
__device__ __forceinline__ void ph_cvtmoe(int l) { PHASE_PROLOGUE(); phase_convert_moe(F, P, l); __syncthreads(); }
__device__ __forceinline__ void ph_wkvb() { PHASE_PROLOGUE(); phase_wkv_b(F, P); }
__device__ __forceinline__ void ph_wkvc(int l) { PHASE_PROLOGUE(); phase_wkv_c(F, P, l); }
__device__ __forceinline__ void ph_sguconv(int l) { PHASE_PROLOGUE();
    phase_sgu(F, P, l, 64, 192); phase_conv(F, P, l, 64, 192); }
__device__ __forceinline__ void ph_branch(int l) { PHASE_PROLOGUE();
    SchedBranch S{(const char*)F.ws, WS_WBR + (size_t)l * 1024 * 1024, F.G, F.vcu};
    EpiBranch E{WSP(unsigned char, WS_GATES), WSP(bf16_t, WS_MERGED), WSP(unsigned char, WS_MERGEDQ)};
    ge::gemm_phase<SchedBranch, EpiBranch, true, 0x7A7A7A7A, 0x7D7D7D7D>(F.lds, S, E); }
__device__ __forceinline__ void ph_wout(int l) { PHASE_PROLOGUE();
    SchedWout S{(const char*)WSP(unsigned char, WS_MERGEDQ), (const char*)(WSP(unsigned char, WS_WOUT) + (size_t)l * 1024 * 1024), F.G, F.vcu};
    EpiWout E{WSP(bf16_t, WS_X), WSP(bf16_t, WS_PRE), WSP(float, WS_STATS)};
    ge::gemm_phase<SchedWout, EpiWout, true, 0x7A7A7A7A, 0x7D7D7D7D>(F.lds, S, E); }
__device__ __forceinline__ void ph_ln1(int l) { PHASE_PROLOGUE(); phase_ln1(F, P, l, 128, 128); }
__device__ __forceinline__ void ph_router(int l) { PHASE_PROLOGUE();
    SchedRouter S{(const char*)WSP(bf16_t, WS_PRE), (const char*)(WSP(bf16_t, WS_WRG) + (size_t)l * 256 * 1024), 128, (int)blockIdx.x};
    EpiRouter E{P.in[32], ctl + CW_CNT + 64 * l, WSP(int, WS_LIST), WSP(float, WS_STATS), WSP(float, WS_RC) + l * 64};
    ge::gemm_phase(F.lds, S, E); }
__device__ __forceinline__ void ph_router_probe(int l) { PHASE_PROLOGUE();
    SchedRouter S{(const char*)WSP(bf16_t, WS_PRE), (const char*)(WSP(bf16_t, WS_WRG) + (size_t)l * 256 * 1024), 128, (int)blockIdx.x};
    EpiRouter E{P.in[32], ctl + CW_CNT + 64 * l + 32, WSP(int, WS_Y), WSP(float, WS_STATS), WSP(float, WS_RC) + l * 64};
    ge::gemm_phase(F.lds, S, E); }
__device__ __forceinline__ void ph_moe1(int l) { PHASE_PROLOGUE();
    const int ntiles = build_tile_table(F, ctl + CW_CNT + 64 * l);
    SchedMoe1 S{(const char*)WSP(unsigned char, WS_X1Q), (const char*)moe_wbuf(F, l), WSP(int, WS_LIST), ctl + CW_CNT + 64 * l, (LAS int*)(F.lds + LDS_MISC + 64), ntiles, F.G, F.vcu};
    EpiMoe1 E{WSP(unsigned char, WS_H)};
    ge::gemm_phase<SchedMoe1, EpiMoe1, true>(F.lds, S, E); }
__device__ __forceinline__ void ph_moe2(int l) { PHASE_PROLOGUE(); int ntk4 = 4; asm volatile("" : "+s"(ntk4));
    const int ntiles = build_tile_table(F, ctl + CW_CNT + 64 * l);
    SchedMoe2 S{(const char*)WSP(unsigned char, WS_H), (const char*)(moe_wbuf(F, l) + (size_t)NE * 1024 * 1024), WSP(int, WS_LIST), ctl + CW_CNT + 64 * l, (LAS int*)(F.lds + LDS_MISC + 64), ntiles, F.G, F.vcu, ntk4};
    EpiMoe2 E{WSP(int, WS_LIST), WSP(unsigned char, WS_Y), WSP(int, WS_GATEV)};
    ge::gemm_phase<SchedMoe2, EpiMoe2, true>(F.lds, S, E); }
__device__ __forceinline__ void ph_moe2_nostore(int l) { PHASE_PROLOGUE(); int ntk4 = 4; asm volatile("" : "+s"(ntk4));
    const int ntiles = build_tile_table(F, ctl + CW_CNT + 64 * l);
    SchedMoe2 S{(const char*)WSP(unsigned char, WS_H), (const char*)(moe_wbuf(F, l) + (size_t)NE * 1024 * 1024), WSP(int, WS_LIST), ctl + CW_CNT + 64 * l, (LAS int*)(F.lds + LDS_MISC + 64), ntiles, F.G, F.vcu, ntk4};
    EpiMoe2T<1> E{WSP(int, WS_LIST), WSP(unsigned char, WS_Y), WSP(int, WS_GATEV)};
    ge::gemm_phase<SchedMoe2, EpiMoe2T<1>, true>(F.lds, S, E); }
__device__ __forceinline__ void ph_ln2(int l) { PHASE_PROLOGUE(); phase_ln2(F, P, l); }

constexpr int PH_PER_LAYER = 11, N_PHASES = 1 + NL * PH_PER_LAYER;
__global__ void __launch_bounds__(512, 2) fwd_kernel(Params p) {
    for (int u = threadIdx.x; u < (LDS_BYTES - LDS_MISC) / 4; u += 512) ((LAS unsigned*)((LAS unsigned char*)lds_raw + LDS_MISC))[u] = 0u;
    __syncthreads();
#if ONE_LAUNCH
    XcdBarrier bar = xcd_barrier_post((unsigned*)(p.ws + WS_CTL) + CW_BAR, (volatile LAS unsigned*)((LAS unsigned char*)lds_raw + LDS_MISC));
#define SEAM() xcd_barrier(bar)
#else
#define SEAM() do { } while (0)
#endif
    const int lo = p.phase_lo, hi = p.phase_hi;
#ifdef ONLY_K
#define IN(k) ((k) == ONLY_K && lo <= pb + (k) && pb + (k) < hi)
#else
#define IN(k) (lo <= pb + (k) && pb + (k) < hi)
#endif
#ifndef ONLY_K
    { const int pb = 0; if (IN(0)) { ph_prologue(); SEAM(); if (REPEAT_K == 20) { ph_prologue(); SEAM(); } if (REPEAT_K == 21) { ph_prologue_a(); SEAM(); } if (REPEAT_K == 22) { ph_prologue_b(); SEAM(); } if (REPEAT_K == 23) { ph_prologue_c(); SEAM(); } } }
#endif
#if DEBUG_MODE
    {
        { ph_inproj(0); SEAM(); }
        { PHASE_PROLOGUE(); dbg_prep(F, P, 0); } SEAM();
        { PHASE_PROLOGUE(); if (blockIdx.x < 128) dbg_scan(F, P, 0, 0, 128); } SEAM();
        if (DEBUG_MODE >= 6) { PHASE_PROLOGUE(); dbg_bruteforce(F); SEAM(); }
        ph_wkva(0); SEAM();
        if (blockIdx.x < 64) ph_wkvb(); SEAM();
        ph_wkvc(0); SEAM();
        { PHASE_PROLOGUE();
          if (DEBUG_MODE == 1) dbg_compare(F, WSP(bf16_t, WS_OUTA), WSP(bf16_t, DBG_OUTAREF), (size_t)T * 512, ctl, 0);
          if (DEBUG_MODE == 2) dbg_compare(F, WSP(bf16_t, WS_MT), WSP(float, DBG_MREF), (size_t)4096 * 4096, ctl, 1);
          if (DEBUG_MODE == 3) dbg_compare(F, WSP(bf16_t, DBG_YDBG), WSP(bf16_t, DBG_YREF), (size_t)T * 512, ctl, 0);
          if (DEBUG_MODE == 4) dbg_compare(F, WSP(float, WS_RK), WSP(float, DBG_RKREF), (size_t)T * 8, ctl, 0);
          if (DEBUG_MODE == 5) dbg_compare_vt(F, ctl);
          if (DEBUG_MODE == 20 && blockIdx.x == 0 && F.tid == 0) { const unsigned bits = __hip_atomic_load(ctl + 12, __ATOMIC_RELAXED, __HIP_MEMORY_SCOPE_AGENT); float st = 0.f; for (int bb = 15; bb >= 1; --bb) if (bits & (1u << bb)) st = (float)bb; ((float*)ctl)[1024] = st * st * 1e-4f; ((float*)ctl)[1025] = 1.f; }
          if (DEBUG_MODE == 10) dbg_compare(F, (const bf16_t*)F.out, WSP(float, WS_SW), (size_t)T * 512, ctl, 0);
          if (DEBUG_MODE == 11) dbg_compare(F, (const bf16_t*)F.out + (size_t)T * 512, WSP(bf16_t, WS_SB), (size_t)T * 512, ctl, 0);
          if (DEBUG_MODE == 12) dbg_compare(F, (const bf16_t*)F.out + (size_t)2 * T * 512, WSP(bf16_t, WS_SA), (size_t)T * 512, ctl, 0);
          if (DEBUG_MODE == 6) dbg_compare(F, WSP(bf16_t, WS_PHI), WSP(float, DBG_BF), (size_t)256 * 4096, ctl, 0);
          if (DEBUG_MODE == 7) dbg_compare(F, WSP(bf16_t, WS_GT), WSP(float, DBG_BF) + (size_t)1 * 256 * 4096, (size_t)256 * 4096, ctl, 1);
          if (DEBUG_MODE == 8) dbg_compare(F, WSP(bf16_t, WS_PSI), WSP(float, DBG_BF) + (size_t)2 * 256 * 4096, (size_t)256 * 4096, ctl, 0);
          if (DEBUG_MODE == 9) dbg_compare(F, WSP(bf16_t, WS_Y0T), WSP(float, DBG_BF) + (size_t)3 * 256 * 4096, (size_t)256 * 4096, ctl, 1);
        } SEAM();
        { PHASE_PROLOGUE(); float num = 0.f, den = 0.f; for (int g2 = 0; g2 < 256; ++g2) { num += ((const float*)ctl)[1024 + 2 * g2]; den += ((const float*)ctl)[1025 + 2 * g2]; }
          float e = 1000.f * sqrtf(num / fmaxf(den, 1e-30f)); if (!(e == e)) e = 7.0e6f; else if (e > 5e6f) e = 5.0e6f; if (!(den == den)) e = 9.0e6f;
          for (size_t i = (size_t)blockIdx.x * 512 + F.tid; i < (size_t)T * D; i += (size_t)F.G * 512) F.out[i] = e; }
        return;
    }
#endif
#define RUN_LAYER(l) do { const int pb = 1 + (l) * PH_PER_LAYER;\
        if (IN(0)) { ph_inproj(l); SEAM(); if (REPEAT_K == 0) { ph_inproj(l); SEAM(); } if (REPEAT_K == 30) { ph_inproj_null(l); SEAM(); } }\
        if (IN(1)) { ph_wkva(l); SEAM(); if (REPEAT_K == 1) { ph_wkva(l); SEAM(); } if (REPEAT_K == 15) { ph_wkva_e(l); SEAM(); } if (REPEAT_K == 11) { ph_cvtmoe(l); SEAM(); } }\
        if (IN(2)) { if (blockIdx.x < 64) ph_wkvb(); else ph_sguconv(l); if ((l) + 1 < NL) ph_cvtmoe((l) + 1); SEAM(); if (REPEAT_K == 2) { if (blockIdx.x < 64) ph_wkvb(); else ph_sguconv(l); SEAM(); } if (REPEAT_K == 13) { if (blockIdx.x < 64) ph_wkvb(); SEAM(); } if (REPEAT_K == 14) { if (blockIdx.x >= 64) ph_sguconv(l); SEAM(); } }\
        if (IN(3)) { ph_wkvc(l); SEAM(); if (REPEAT_K == 3) { ph_wkvc(l); SEAM(); } }\
        if (IN(4)) { ph_branch(l); SEAM(); if (REPEAT_K == 4) { ph_branch(l); SEAM(); } }\
        if (IN(5)) { ph_wout(l); SEAM(); if (REPEAT_K == 5) { ph_wout(l); SEAM(); } }\
        if (IN(6)) { if (blockIdx.x < 128) ph_router(l); else ph_ln1(l); SEAM(); if (REPEAT_K == 6) { if (blockIdx.x >= 128) ph_ln1(l); SEAM(); } if (REPEAT_K == 7) { if (blockIdx.x < 128) ph_router_probe(l); SEAM(); } }\
        if (IN(8)) { ph_moe1(l); SEAM(); if (REPEAT_K == 8) { ph_moe1(l); SEAM(); } }\
        if (IN(9)) { ph_moe2(l); SEAM(); if (REPEAT_K == 9) { ph_moe2(l); SEAM(); } if (REPEAT_K == 19) { ph_moe2_nostore(l); SEAM(); } }\
        if (IN(10)) { if (REPEAT_K == 10) { ph_ln2(l); SEAM(); } if (REPEAT_K == 12) { SEAM(); SEAM(); SEAM(); SEAM(); SEAM(); SEAM(); SEAM(); SEAM(); SEAM(); SEAM(); } ph_ln2(l); if (l + 1 < NL) SEAM(); } } while (0)
    RUN_LAYER(0); RUN_LAYER(1); RUN_LAYER(2); RUN_LAYER(3);
#undef RUN_LAYER
#undef IN
#undef SEAM
}

extern "C" void kernel_launch(void* const* d_in, const int* in_sizes, int n_in, void* d_out, int out_size, void* d_ws, size_t ws_size, hipStream_t stream) {
    static int grid = 0;
    if (grid == 0) {
        if (n_in != 38 || in_sizes[0] != T * D || out_size != T * D || ws_size < WS_END) { fprintf(stderr, "kernel_launch: unexpected shapes (n_in %d, in0 %d, out %d, ws %zu, need %zu); nothing launched\n", n_in, n_in > 0 ? in_sizes[0] : -1, out_size, ws_size, (size_t)WS_END); grid = -1; return; }
        int dev = 0, cus = 0, per_cu = 0;
        if (hipGetDevice(&dev) != hipSuccess || hipDeviceGetAttribute(&cus, hipDeviceAttributeMultiprocessorCount, dev) != hipSuccess) { grid = -1; return; }
        if (hipFuncSetAttribute((const void*)fwd_kernel, hipFuncAttributeMaxDynamicSharedMemorySize, LDS_BYTES) != hipSuccess) { fprintf(stderr, "kernel_launch: hipFuncSetAttribute failed\n"); grid = -1; return; }
        if (hipOccupancyMaxActiveBlocksPerMultiprocessor(&per_cu, (const void*)fwd_kernel, 512, LDS_BYTES) != hipSuccess || per_cu < 1) fprintf(stderr, "kernel_launch: occupancy query reports %d blocks per CU\n", per_cu);
        (void)hipGetLastError();
        grid = cus;
        if (grid != 256) { fprintf(stderr, "kernel_launch: built for a 256-CU device, found %d CUs; nothing launched\n", cus); grid = -1; return; }
    }
    if (grid < 0) return;
    (void)hipMemsetAsync((char*)d_ws + WS_CTL, 0, CTL_BYTES, stream);
    Params p{};
    for (int i = 0; i < 38; ++i) p.in[i] = (const float*)d_in[i];
    p.out = (float*)d_out; p.ws = (unsigned char*)d_ws; p.layer_lo = 0; p.layer_hi = NL;
#if ONE_LAUNCH
    p.phase_lo = 0; p.phase_hi = N_PHASES;
    hipLaunchKernelGGL(fwd_kernel, dim3(grid), dim3(512), LDS_BYTES, stream, p);
#else
    for (int ph = 0; ph < N_PHASES; ++ph) { p.phase_lo = ph; p.phase_hi = ph + 1; hipLaunchKernelGGL(fwd_kernel, dim3(grid), dim3(512), LDS_BYTES, stream, p); }
#endif
}
```

```cpp
#include <hip/hip_runtime.h>
#include <stdint.h>
#include <stdio.h>

#ifndef DEBUG_MODE
#define DEBUG_MODE 0
#endif
#ifndef REPEAT_K
#define REPEAT_K -1
#endif
#ifndef ONE_LAUNCH
#define ONE_LAUNCH 1
#endif

#define LAS __attribute__((address_space(3)))
typedef unsigned short bf16_t;
typedef short bf16x8 __attribute__((ext_vector_type(8)));
typedef float f32x4 __attribute__((ext_vector_type(4)));
typedef float f32x2 __attribute__((ext_vector_type(2)));
typedef unsigned u32x4 __attribute__((ext_vector_type(4)));
typedef unsigned u32x2 __attribute__((ext_vector_type(2)));

constexpr int T = 32768, SEQ = 2048, D = 1024, NL = 4;
constexpr int NIN = 5888;
constexpr int RKVW = 1792;
constexpr int NE = 32;
constexpr float ALPHA = 1.681792830507429f;
constexpr float LN_EPS = 1e-5f, GN_EPS = 64e-5f;

constexpr size_t MiB = 1u << 20;
constexpr size_t WS_CTL = 0;
constexpr size_t WS_WIN = 1 * MiB;
constexpr size_t WS_WBR = WS_WIN + 46 * MiB;
constexpr size_t WS_WOUT = WS_WBR + 8 * MiB;
constexpr size_t WS_WRT = WS_WOUT + 8 * MiB;
constexpr size_t WS_WMOE = WS_WRT + 1 * MiB;
constexpr size_t WS_X = WS_WMOE + 96 * MiB;
constexpr size_t WS_X1 = WS_X + 64 * MiB;
constexpr size_t WS_VFIRST = WS_X1 + 64 * MiB;
constexpr size_t WS_RKV = WS_VFIRST + 32 * MiB;
constexpr size_t WS_SGUZ = WS_RKV + 112 * MiB;
constexpr size_t WS_CONVH = WS_SGUZ + 32 * MiB;
constexpr size_t WS_GATES = WS_CONVH + 16 * MiB;
constexpr size_t WS_PHI = WS_GATES + 192 * MiB;
constexpr size_t WS_PSI = WS_PHI + 32 * MiB;
constexpr size_t WS_GT = WS_PSI + 32 * MiB;
constexpr size_t WS_Y0T = WS_GT + 32 * MiB;
constexpr size_t WS_VT = WS_Y0T + 32 * MiB;
constexpr size_t WS_MT = WS_VT + 32 * MiB;
constexpr size_t WS_RK = WS_MT + 32 * MiB;
constexpr size_t WS_LORA = WS_RK + 1 * MiB;
constexpr size_t WS_SGUW = WS_LORA + 1 * MiB;
constexpr size_t WS_OUTA = WS_SGUW + 1 * MiB;
constexpr size_t WS_HB = WS_OUTA + 32 * MiB;
constexpr size_t WS_HC = WS_HB + 16 * MiB;
constexpr size_t WS_XQ = WS_HC + 16 * MiB;
constexpr size_t WS_END = WS_XQ + 32 * MiB;
constexpr size_t WS_X1Q = WS_WMOE + 64 * MiB;
constexpr size_t WS_STATS = WS_Y0T;
constexpr size_t WS_WRG = WS_WBR + 4 * MiB;
constexpr size_t WS_RC = WS_SGUW + 512 * 1024;
constexpr size_t WS_MERGEDQ = WS_GT;
constexpr size_t WS_MERGED = WS_RKV;
constexpr size_t WS_PRE = WS_PHI;
constexpr size_t WS_H = WS_RKV;
constexpr size_t WS_Y = WS_GATES;
constexpr size_t WS_LIST = WS_SGUZ;
constexpr size_t WS_GATEV = WS_SGUZ + 16 * MiB;
static_assert(WS_END <= 1024 * MiB, "workspace map");
#if DEBUG_MODE
constexpr size_t WS_SV = WS_GATES, WS_SA = WS_SV + 32 * MiB, WS_SB = WS_SA + 32 * MiB, WS_SR = WS_SB + 32 * MiB, WS_SK = WS_SR + 32 * MiB, WS_SG = WS_SK + 32 * MiB;
constexpr size_t WS_SW = WS_X1;
constexpr size_t DBG_OUTAREF = WS_WMOE, DBG_MREF = WS_WMOE + 32 * MiB, DBG_YREF = WS_SGUZ, DBG_RKREF = WS_HB, DBG_YDBG = WS_HC;
#endif
constexpr int CW_BAR = 4096;
constexpr int CW_CNT = 16384;
constexpr size_t CTL_BYTES = 1 * MiB;

constexpr int LDS_STAGE = 131072;
constexpr int LDS_MISC = LDS_STAGE;
constexpr int LDS_RAW = LDS_STAGE + 4096;
constexpr int LDS_BYTES = 163840;

typedef __bf16 bf16x2_t __attribute__((ext_vector_type(2)));
__device__ __forceinline__ unsigned cvt_pk_bf16(float lo, float hi) { const f32x2 v = {lo, hi}; const bf16x2_t b = __builtin_convertvector(v, bf16x2_t); return __builtin_bit_cast(unsigned, b); }
__device__ __forceinline__ unsigned pack_fp8x4(float a, float b, float c, float d) { int w = 0; w = __builtin_amdgcn_cvt_pk_fp8_f32(a, b, w, false); w = __builtin_amdgcn_cvt_pk_fp8_f32(c, d, w, true); return (unsigned)w; }
__device__ __forceinline__ bf16_t f2bf(float f) { return (bf16_t)(cvt_pk_bf16(f, 0.f) & 0xffffu); }
__device__ __forceinline__ float bf2f(unsigned short b) { return __uint_as_float(((unsigned)b) << 16); }
__device__ __forceinline__ float bflo(unsigned w) { return __uint_as_float(w << 16); }
__device__ __forceinline__ float bfhi(unsigned w) { return __uint_as_float(w & 0xffff0000u); }
__device__ __forceinline__ float sigmoidf_(float x) { return __builtin_amdgcn_rcpf(1.0f + __expf(-x)); }
template <int CTRL> __device__ __forceinline__ float dpp_mov(float x) { return __builtin_bit_cast(float, __builtin_amdgcn_mov_dpp(__builtin_bit_cast(int, x), CTRL, 0xF, 0xF, true)); }
__device__ __forceinline__ float row16_sum(float v) { v += dpp_mov<0xB1>(v); v += dpp_mov<0x4E>(v); v += dpp_mov<0x141>(v); v += dpp_mov<0x140>(v); return v; }
__device__ __forceinline__ float wave_sum(float v) {
    v = row16_sum(v); const int vi = __builtin_bit_cast(int, v);
    return (__builtin_bit_cast(float, __builtin_amdgcn_readlane(vi, 0)) + __builtin_bit_cast(float, __builtin_amdgcn_readlane(vi, 16))) + (__builtin_bit_cast(float, __builtin_amdgcn_readlane(vi, 32)) + __builtin_bit_cast(float, __builtin_amdgcn_readlane(vi, 48)));
}
__device__ __forceinline__ float dpp_f(float x, const int ctrl_sel) {
    int xi = __builtin_bit_cast(int, x), r;
    if (ctrl_sel == 0) r = __builtin_amdgcn_update_dpp(0, xi, 0xB1, 0xF, 0xF, true);
    else if (ctrl_sel == 1) r = __builtin_amdgcn_update_dpp(0, xi, 0x4E, 0xF, 0xF, true);
    else r = __builtin_amdgcn_update_dpp(0, xi, 0x141, 0xF, 0xF, true);
    return __builtin_bit_cast(float, r);
}
__device__ __forceinline__ float reduce8(float x) { x += dpp_f(x, 0); x += dpp_f(x, 1); x += dpp_f(x, 2); return x; }
__device__ __forceinline__ float gelu_f(float v) {
    const float av = fabsf(v), t = __builtin_amdgcn_rcpf(av * 0.2316418882f + 1.0f);
    float q = t * 0.5307027145f + (-0.7265760135f); q = q * t + 0.7107068705f; q = q * t + (-0.142248368f); q = q * t + 0.127414796f; q = q * t;
    const float e = __builtin_amdgcn_exp2f((v * v) * (-0.72134752044f));
    const float m = v * (q * e);
    return v < 0.f ? m : v - m;
}

#define XB_TMO      128
#define XB_XCNT(j)  (256  + 64 * (j))
#define XB_XSUB(j)  (1280 + 64 * (j))
#define XB_XGEN(j)  (2304 + 64 * (j))
#define XB_TOP      3328
#define XB_TOPGEN   3392
#define XCD_BAR_WORDS 3456
#define XB_SPIN_CAP (1u << 22)
__device__ __forceinline__ unsigned xb_ld(unsigned* p)              { return __hip_atomic_load(p, __ATOMIC_RELAXED, __HIP_MEMORY_SCOPE_AGENT); }
__device__ __forceinline__ unsigned xb_add(unsigned* p, unsigned v) { return __hip_atomic_fetch_add(p, v, __ATOMIC_RELAXED, __HIP_MEMORY_SCOPE_AGENT); }
__device__ __forceinline__ unsigned xb_xcc_id() { return (unsigned)__builtin_amdgcn_s_getreg((3 << 11) | 20) & 0xFu; }
#define XB_SPIN(cond, bar) do { unsigned _sp = 0; while (cond) { __builtin_amdgcn_s_sleep(1); \
    if ((++_sp & 255u) == 0u) { if (xb_ld(&(bar)[XB_TMO])) break; if (_sp > XB_SPIN_CAP) { atomicAdd(&(bar)[XB_TMO], 1u); break; } } } } while (0)
struct XcdBarrier { unsigned* bar; unsigned x; volatile LAS unsigned* st; };
__device__ __forceinline__ XcdBarrier xcd_barrier_post(unsigned* bar, volatile LAS unsigned* st) {
    XcdBarrier b; b.bar = bar; b.x = xb_xcc_id(); b.st = st;
    if (threadIdx.x == 0) (void)xb_add(&bar[XB_XCNT(b.x)], 1u);
    return b;
}
__device__ __forceinline__ void xcd_barrier_complete(unsigned* bar, unsigned x, unsigned& nloc, unsigned& nx) {
    const unsigned G = gridDim.x * gridDim.y * gridDim.z;
    unsigned sum, cnt, mine, sp = 0u;
    for (;;) {
        sum = 0u; cnt = 0u; mine = 0u;
#pragma unroll
        for (unsigned j = 0; j < 16; ++j) { const unsigned c = xb_ld(&bar[XB_XCNT(j)]); sum += c; cnt += (c > 0u) ? 1u : 0u; mine = (j == x) ? c : mine; }
        if (sum == G) break;
        __builtin_amdgcn_s_sleep(1);
        if ((++sp & 255u) == 0u) { if (xb_ld(&bar[XB_TMO])) break; if (sp > XB_SPIN_CAP) { atomicAdd(&bar[XB_TMO], 1u); break; } }
    }
    nloc = mine > 0u ? mine : 1u; nx = cnt > 0u ? cnt : 1u;
}
__device__ __forceinline__ void xcd_barrier(const XcdBarrier& b) {
    asm volatile("s_waitcnt vmcnt(0)" ::: "memory");
    __syncthreads();
    if (threadIdx.x == 0) {
        unsigned* bar = b.bar;
        __builtin_amdgcn_s_waitcnt(0);
        unsigned nloc = b.st[0], nx = b.st[1];
        if (nloc == 0u) { xcd_barrier_complete(bar, b.x, nloc, nx); b.st[0] = nloc; b.st[1] = nx; }
        const unsigned old = xb_add(&bar[XB_XSUB(b.x)], 1u);
        const unsigned gen = old / nloc;
        if (old + 1u == (gen + 1u) * nloc) {
            __builtin_amdgcn_fence(__ATOMIC_RELEASE, "agent");
            asm volatile("s_waitcnt vmcnt(0)" ::: "memory");
            const unsigned og = xb_add(&bar[XB_TOP], 1u);
            const unsigned tg = og / nx;
            if (og + 1u == (tg + 1u) * nx) xb_add(&bar[XB_TOPGEN], 1u);
            else XB_SPIN(xb_ld(&bar[XB_TOPGEN]) == tg, bar);
            __builtin_amdgcn_fence(__ATOMIC_ACQUIRE, "agent");
            xb_add(&bar[XB_XGEN(b.x)], 1u);
            asm volatile("s_waitcnt vmcnt(0)" ::: "memory");
        } else {
            XB_SPIN(xb_ld(&bar[XB_XGEN(b.x)]) == gen, bar);
            __builtin_amdgcn_fence(__ATOMIC_ACQUIRE, "agent");
            asm volatile("s_waitcnt vmcnt(0)" ::: "memory");
        }
    }
    __syncthreads();
}

struct Params {
    const float* in[38];
    float* out;
    unsigned char* ws;
    int phase_lo, phase_hi;
    int layer_lo, layer_hi;
};

namespace ge {
constexpr int BM = 256, BK = 64, HALF = 128, HTB = HALF * BK * 2;
__device__ __forceinline__ int lds_byte(int r, int c) { const int st = (r >> 4) * 2 + (c >> 5), rr = r & 15, cc = c & 31, ob = rr * 64 + cc * 2; return st * 1024 + (ob ^ (((ob >> 9) & 1) << 5)); }
__device__ __forceinline__ void stage_rc(int b, int& R, int& C) { const int st = b / 1024, sb = b % 1024, swz = sb ^ (((sb >> 9) & 1) << 5); R = (st >> 1) * 16 + swz / 64; C = (st & 1) * 32 + (swz % 64) / 2; }
__device__ __forceinline__ int perm32(int rho) { const int n = rho >> 4, i = rho & 15; return 8 * (i >> 2) + 4 * n + (i & 3); }

struct NoPre { };
struct Unit {
    const char* A; const char* B;
    const int* gat;
    unsigned lda, ldb;
    int nt;
    int gshift, nvalid;
    int pm, pn, aux;
};
typedef f32x4 Acc[2][2][4][2];

typedef int i32x8 __attribute__((ext_vector_type(8)));
template <class Sched, class Epi, bool FP8 = false, int SCALE_W = 0x7A7A7A7A, int SCALE_A = 0x7F7F7F7F>
__device__ __forceinline__ void gemm_phase(LAS unsigned char* lds, const Sched& S, const Epi& E) {
    int tid = threadIdx.x; asm volatile("" : "+v"(tid));
    const int wid = __builtin_amdgcn_readfirstlane(tid >> 6), lane = tid & 63, wr = wid >> 2, wc = wid & 3, fr = lane & 15, fq = lane >> 4;
    const unsigned ldsw = (unsigned)wid * 1024u;
    const int aoff = FP8 ? lds_byte(wr * 64 + fr, fq * 16) : lds_byte(wr * 64 + fr, fq * 8), boff = FP8 ? lds_byte(wc * 32 + fr, fq * 16) : lds_byte(wc * 32 + fr, fq * 8);
    const int aoff1 = FP8 ? lds_byte(wr * 64 + fr, fq * 16 + 8) : aoff + 1024, boff1 = FP8 ? lds_byte(wc * 32 + fr, fq * 16 + 8) : boff + 1024;
#define GE_SA(b, h) (((b) * 2 + (h)) * HTB)
#define GE_SB(b, h) ((4 + (b) * 2 + (h)) * HTB)
#define GE_STAGE(bufoff, gbase, o0, o1) do { \
        __builtin_amdgcn_global_load_lds((const unsigned*)((gbase) + (o0)), (LAS unsigned*)(lds + (bufoff) + ldsw), 16, 0, 0); \
        __builtin_amdgcn_global_load_lds((const unsigned*)((gbase) + (o1)), (LAS unsigned*)(lds + (bufoff) + ldsw + 8192), 16, 0, 0); } while (0)
#define GE_LDA(dst, b, h) do { _Pragma("unroll") for (int m = 0; m < 4; ++m) { dst[m][0] = *(const LAS bf16x8*)(lds + GE_SA(b, h) + aoff + m * 2048); dst[m][1] = *(const LAS bf16x8*)(lds + GE_SA(b, h) + aoff1 + m * 2048); } } while (0)
#define GE_LDB(dst, b, h) do { _Pragma("unroll") for (int n = 0; n < 2; ++n) { dst[n][0] = *(const LAS bf16x8*)(lds + GE_SB(b, h) + boff + n * 2048); dst[n][1] = *(const LAS bf16x8*)(lds + GE_SB(b, h) + boff1 + n * 2048); } } while (0)
#define GE_CAT(x0, x1) __builtin_shufflevector(__builtin_bit_cast(u32x4, x0), __builtin_bit_cast(u32x4, x1), 0, 1, 2, 3, 4, 5, 6, 7)
#define GE_MMA(ai, bj, At, Bt) do { __builtin_amdgcn_s_setprio(1); _Pragma("unroll") for (int m = 0; m < 4; ++m) _Pragma("unroll") for (int n = 0; n < 2; ++n) { \
        if constexpr (FP8) acc[ai][bj][m][n] = __builtin_amdgcn_mfma_scale_f32_16x16x128_f8f6f4(__builtin_bit_cast(i32x8, GE_CAT(Bt[n][0], Bt[n][1])), __builtin_bit_cast(i32x8, GE_CAT(At[m][0], At[m][1])), acc[ai][bj][m][n], 0, 0, 0, SCALE_W, 0, SCALE_A); \
        else { _Pragma("unroll") for (int k = 0; k < 2; ++k) acc[ai][bj][m][n] = __builtin_amdgcn_mfma_f32_16x16x32_bf16(Bt[n][k], At[m][k], acc[ai][bj][m][n], 0, 0, 0); } } __builtin_amdgcn_s_setprio(0); } while (0)
#define GE_WAIT_V(n) asm volatile("s_waitcnt vmcnt(" #n ")" ::: "memory")
#define GE_WAIT_L(n) asm volatile("s_waitcnt lgkmcnt(" #n ")" ::: "memory")
#define GE_BAR __builtin_amdgcn_s_barrier()
#define GE_SCHED __builtin_amdgcn_sched_barrier(0)
#define GE_OFFS(u, oA00, oA01, oA10, oA11, oB0, oB1) do { \
        int tq_ = tid; asm volatile("" : "+v"(tq_)); int R0, C0, R1, C1; stage_rc(tq_ * 16, R0, C0); stage_rc(tq_ * 16 + 8192, R1, C1); \
        const int Rb0 = (R0 & ~31) + perm32(R0 & 31), Rb1 = (R1 & ~31) + perm32(R1 & 31); \
        int r00 = R0, r01 = R1, r10 = 128 + R0, r11 = 128 + R1; \
        if ((u).gat) { const int* g_ = (u).gat; const int nv_ = (u).nvalid, sh_ = (u).gshift; \
            r00 = (r00 < nv_) ? (g_[2 * r00] >> sh_) : 0; r01 = (r01 < nv_) ? (g_[2 * r01] >> sh_) : 0; r10 = (r10 < nv_) ? (g_[2 * r10] >> sh_) : 0; r11 = (r11 < nv_) ? (g_[2 * r11] >> sh_) : 0; } \
        oA00 = (unsigned)r00 * (u).lda + (unsigned)C0 * 2u; oA01 = (unsigned)r01 * (u).lda + (unsigned)C1 * 2u; \
        oA10 = (unsigned)r10 * (u).lda + (unsigned)C0 * 2u; oA11 = (unsigned)r11 * (u).lda + (unsigned)C1 * 2u; \
        oB0 = (unsigned)Rb0 * (u).ldb + (unsigned)C0 * 2u; oB1 = (unsigned)Rb1 * (u).ldb + (unsigned)C1 * 2u; } while (0)
    Unit cur, nxt; int ui = 0;
    if (!S.next(0, cur)) return;
    Acc acc;
#pragma unroll
    for (int a = 0; a < 2; ++a)
#pragma unroll
        for (int b = 0; b < 2; ++b)
#pragma unroll
            for (int m = 0; m < 4; ++m)
#pragma unroll
                for (int n = 0; n < 2; ++n) acc[a][b][m][n] = (f32x4){0.f, 0.f, 0.f, 0.f};
    bf16x8 At[4][2], B0[2][2], B1[2][2];
    unsigned oA00, oA01, oA10, oA11, oB0, oB1;
    GE_OFFS(cur, oA00, oA01, oA10, oA11, oB0, oB1);
    typename Epi::Pre pre = E.prefetch(cur, wr, wc, fr, fq);
    const char* cA = cur.A; const char* cB = cur.B; size_t chB = (size_t)128 * cur.ldb;
    const size_t kstep = 128;
    GE_STAGE(GE_SB(0, 0), cB, oB0, oB1); GE_STAGE(GE_SA(0, 0), cA, oA00, oA01); GE_STAGE(GE_SB(0, 1), cB + chB, oB0, oB1); GE_STAGE(GE_SA(0, 1), cA, oA10, oA11);
    if (wr == 1) GE_BAR;
    GE_WAIT_V(4); GE_BAR;
    GE_STAGE(GE_SB(1, 0), cB + kstep, oB0, oB1); GE_STAGE(GE_SA(1, 0), cA + kstep, oA00, oA01); GE_STAGE(GE_SB(1, 1), cB + chB + kstep, oB0, oB1);
    GE_WAIT_V(6); GE_BAR;
    for (;;) {
        const bool has_next = S.next(ui + 1, nxt);
        const char* nA = has_next ? nxt.A : cA; const char* nB = has_next ? nxt.B : cB; const size_t nhB = has_next ? (size_t)128 * nxt.ldb : chB;
        const int nt = cur.nt;
        for (int t = 0; t < nt; t += 2) {
            const bool last = (t == nt - 2);
            const char* a1 = cA + (size_t)(t + 1) * kstep;
            const char* a2 = last ? nA : cA + (size_t)(t + 2) * kstep; const char* b2 = last ? nB : cB + (size_t)(t + 2) * kstep;
            const size_t hB2 = last ? nhB : chB;
            const char* a3 = a2 + kstep; const char* b3 = b2 + kstep;
            GE_LDB(B0, 0, 0); GE_SCHED; GE_LDA(At, 0, 0); GE_STAGE(GE_SA(1, 1), a1, oA10, oA11);
            if (last && has_next) { GE_OFFS(nxt, oA00, oA01, oA10, oA11, oB0, oB1); }
            GE_WAIT_L(8); GE_BAR; GE_WAIT_L(0); GE_MMA(0, 0, At, B0); GE_BAR; GE_SCHED;
            GE_LDB(B1, 0, 1); GE_STAGE(GE_SB(0, 0), b2, oB0, oB1);
            GE_BAR; GE_WAIT_L(0); GE_MMA(0, 1, At, B1); GE_BAR;
            GE_LDA(At, 0, 1); GE_STAGE(GE_SA(0, 0), a2, oA00, oA01);
            GE_BAR; GE_WAIT_L(0); GE_MMA(1, 0, At, B0); GE_BAR; GE_SCHED;
            GE_STAGE(GE_SB(0, 1), b2 + hB2, oB0, oB1);
            GE_WAIT_V(6); GE_BAR; GE_MMA(1, 1, At, B1); GE_BAR;
            GE_LDB(B0, 1, 0); GE_SCHED; GE_LDA(At, 1, 0); GE_STAGE(GE_SA(0, 1), a2, oA10, oA11);
            GE_WAIT_L(8); GE_BAR; GE_WAIT_L(0); GE_MMA(0, 0, At, B0); GE_BAR; GE_SCHED;
            GE_LDB(B1, 1, 1); GE_STAGE(GE_SB(1, 0), b3, oB0, oB1);
            GE_BAR; GE_WAIT_L(0); GE_MMA(0, 1, At, B1); GE_BAR;
            GE_LDA(At, 1, 1); GE_STAGE(GE_SA(1, 0), a3, oA00, oA01);
            GE_BAR; GE_WAIT_L(0); GE_MMA(1, 0, At, B0); GE_BAR; GE_SCHED;
            GE_STAGE(GE_SB(1, 1), b3 + hB2, oB0, oB1);
            GE_WAIT_V(6); GE_BAR; GE_MMA(1, 1, At, B1); GE_BAR;
        }
        if constexpr (!Epi::AFTER_DRAIN) E(acc, cur, wr, wc, fr, fq, pre);
        if (!has_next) break;
#pragma unroll
        for (int a = 0; a < 2; ++a)
#pragma unroll
            for (int b = 0; b < 2; ++b)
#pragma unroll
                for (int m = 0; m < 4; ++m)
#pragma unroll
                    for (int n = 0; n < 2; ++n) acc[a][b][m][n] = (f32x4){0.f, 0.f, 0.f, 0.f};
        cur = nxt; cA = nA; cB = nB; chB = nhB; ++ui; pre = E.prefetch(cur, wr, wc, fr, fq);
    }
    GE_WAIT_V(0);
    if (wr == 0) GE_BAR;
    GE_BAR;
    if constexpr (Epi::AFTER_DRAIN) E.drained(acc, cur, wr, wc, fr, fq, lds);
#undef GE_SA
#undef GE_SB
#undef GE_STAGE
#undef GE_LDA
#undef GE_LDB
#undef GE_MMA
#undef GE_WAIT_V
#undef GE_WAIT_L
#undef GE_BAR
#undef GE_SCHED
#undef GE_OFFS
#undef GE_CAT
}
__device__ __forceinline__ bool static_tile(long L, int nM, int nN, int& pm, int& pn) {
    const int nwg = nM * nN; if (L >= nwg) return false;
    int wgid = (int)L; { const int q = nwg / 8, r = nwg % 8, xcd = wgid % 8, off = wgid / 8; wgid = (xcd < r ? xcd * (q + 1) : r * (q + 1) + (xcd - r) * q) + off; }
    const int nig = 8 * nN, gid = wgid / nig, fm = gid * 8, gsz = (nM - fm) < 8 ? (nM - fm) : 8;
    pm = fm + ((wgid % nig) % gsz); pn = (wgid % nig) / gsz; return true;
}
}

struct Frame {
    LAS unsigned char* lds;
    int tid, lane, wave, G, vcu;
    unsigned char* ws;
    float* out;
};
#define WSP(T_, off) ((T_*)(F.ws + (off)))

extern __shared__ __attribute__((aligned(16))) unsigned char lds_raw[];
__device__ __forceinline__ Params load_params() {
    typedef const __attribute__((address_space(4))) unsigned long long cu64;
    cu64* k = (cu64*)__builtin_amdgcn_kernarg_segment_ptr();
    asm volatile("" : "+s"(k));
    Params P;
#pragma unroll
    for (int i = 0; i < 38; ++i) P.in[i] = (const float*)(const __attribute__((address_space(1))) float*)k[i];
    P.out = (float*)(__attribute__((address_space(1))) float*)k[38]; P.ws = (unsigned char*)(__attribute__((address_space(1))) unsigned char*)k[39];
    P.phase_lo = 0; P.phase_hi = 0; P.layer_lo = 0; P.layer_hi = 0;
    return P;
}
#define KPARAMS() load_params()
__device__ __forceinline__ Frame make_frame(unsigned char* ws, float* out) {
    Frame F;
    F.lds = (LAS unsigned char*)lds_raw;
    int tz = threadIdx.x; asm volatile("" : "+v"(tz));
    F.tid = tz; F.lane = F.tid & 63; F.wave = __builtin_amdgcn_readfirstlane(F.tid >> 6);
    F.G = gridDim.x; { const int bx = blockIdx.x; F.vcu = (F.G % 8 == 0) ? (bx % 8) * (F.G / 8) + bx / 8 : bx; }
    F.ws = ws; F.out = out;
    return F;
}
template <bool FP8OUT, class ColMap>
__device__ __forceinline__ void transpose_item(const float* W, int ldw, int K, void* WTv, int nblk, LAS float* scr, int item, int lane, const ColMap& cm) {
    const int kb = item / nblk, nb = item % nblk, k0 = 64 * kb, n0 = 32 * nb;
    const int sc = cm(n0 + (lane & 31));
#pragma unroll 8
    for (int i = 0; i < 32; ++i) { const int kk = 2 * i + (lane >> 5); scr[kk * 33 + (lane & 31)] = (sc >= 0) ? W[(size_t)(k0 + kk) * ldw + sc] : 0.f; }
    asm volatile("s_waitcnt lgkmcnt(0)" ::: "memory");
    const int c = lane & 7;
#pragma unroll
    for (int j = 0; j < 4; ++j) { const int n = (lane >> 3) + 8 * j; const LAS float* s = scr + (8 * c) * 33 + n;
        if (FP8OUT) { u32x2 o; o.x = pack_fp8x4(32.f * s[0 * 33], 32.f * s[1 * 33], 32.f * s[2 * 33], 32.f * s[3 * 33]); o.y = pack_fp8x4(32.f * s[4 * 33], 32.f * s[5 * 33], 32.f * s[6 * 33], 32.f * s[7 * 33]);
            *(u32x2*)((unsigned char*)WTv + (size_t)(n0 + n) * K + k0 + 8 * c) = o; }
        else { u32x4 o; o.x = cvt_pk_bf16(s[0 * 33], s[1 * 33]); o.y = cvt_pk_bf16(s[2 * 33], s[3 * 33]); o.z = cvt_pk_bf16(s[4 * 33], s[5 * 33]); o.w = cvt_pk_bf16(s[6 * 33], s[7 * 33]);
            *(u32x4*)((bf16_t*)WTv + (size_t)(n0 + n) * K + k0 + 8 * c) = o; } }
    asm volatile("s_waitcnt lgkmcnt(0)" ::: "memory");
}
struct CmIdent { __device__ __forceinline__ int operator()(int n) const { return n; } };
struct CmInproj { int layer; __device__ __forceinline__ int operator()(int j) const {
    if (j < 1536) return j;
    if (j < 1792) { const int q = j - 1536; if (q < 160) return 1536 + q; if (q < 192) return layer > 0 ? 5792 + (q - 160) : -1; return -1; }
    if (j < 2304) return 1696 + (j - 1792);
    if (j < 2816) { const int jj = j - 2304, c = jj >> 1; return (jj & 1) ? 2208 + 256 + c : 2208 + c; }
    return 2720 + (j - 2816); } };
struct CmRouter { __device__ __forceinline__ int operator()(int n) const { return n < 32 ? n : -1; } };
struct CmGU { __device__ __forceinline__ int operator()(int n) const { return n; } };

template <bool FP8OUT> __device__ __forceinline__ void moe_item_store(void* WTv, int K, int k0, int n0, LAS float* scr, int lane) {
    asm volatile("s_waitcnt lgkmcnt(0)" ::: "memory");
    const int c = lane & 7;
#pragma unroll
    for (int j = 0; j < 4; ++j) { const int nn = (lane >> 3) + 8 * j; const LAS float* s = scr + (8 * c) * 33 + nn;
        if (FP8OUT) { u32x2 o; o.x = pack_fp8x4(32.f * s[0 * 33], 32.f * s[1 * 33], 32.f * s[2 * 33], 32.f * s[3 * 33]); o.y = pack_fp8x4(32.f * s[4 * 33], 32.f * s[5 * 33], 32.f * s[6 * 33], 32.f * s[7 * 33]);
            *(u32x2*)((unsigned char*)WTv + (size_t)(n0 + nn) * K + k0 + 8 * c) = o; }
        else { u32x4 o; o.x = cvt_pk_bf16(s[0 * 33], s[1 * 33]); o.y = cvt_pk_bf16(s[2 * 33], s[3 * 33]); o.z = cvt_pk_bf16(s[4 * 33], s[5 * 33]); o.w = cvt_pk_bf16(s[6 * 33], s[7 * 33]);
            *(u32x4*)((bf16_t*)WTv + (size_t)(n0 + nn) * K + k0 + 8 * c) = o; } }
    asm volatile("s_waitcnt lgkmcnt(0)" ::: "memory");
}
__device__ __forceinline__ void fast_item_plain(const float* W, int ldw, int K, unsigned char* WT, int nblk, LAS float* scr, int item, int lane) {
    const int kb = item / nblk, nb = item % nblk, k0 = 64 * kb, n0 = 32 * nb; const int c4 = (lane & 7) * 4; const float* Ws = W + n0 + c4;
    f32x4 v[8];
#pragma unroll
    for (int i = 0; i < 8; ++i) v[i] = *(const f32x4*)(Ws + (size_t)(k0 + 8 * i + (lane >> 3)) * ldw);
#pragma unroll
    for (int i = 0; i < 8; ++i) { LAS float* d = scr + (8 * i + (lane >> 3)) * 33 + c4; d[0] = v[i][0]; d[1] = v[i][1]; d[2] = v[i][2]; d[3] = v[i][3]; }
    moe_item_store<true>(WT, K, k0, n0, scr, lane);
}
__device__ __forceinline__ void phase_convert_static(Frame& F, const Params& P) {
    LAS float* scr = (LAS float*)(F.lds + F.wave * 8448);
    const int gw = F.vcu * 8 + F.wave, NGW = F.G * 8;
    constexpr int I_IN = 16 * (NIN / 32);
    for (int it = gw; it < NL * I_IN; it += NGW) { const int l = it / I_IN, r = it % I_IN; const int lane = F.lane;
        const float* W = (l == 0) ? P.in[1] : P.in[2] + (size_t)(l - 1) * 1024 * 5824; const int ldw = (l == 0) ? 5792 : 5824;
        const int kb = r / (NIN / 32), nb = r % (NIN / 32), k0 = 64 * kb, n0 = 32 * nb;
        f32x4 v[8];
        if (n0 >= 2304 && n0 < 2816) {
            const int m = (lane >> 2) & 1, c4 = (lane & 3) * 4; const float* Ws = W + 2208 + 256 * m + ((n0 - 2304) >> 1) + c4;
#pragma unroll
            for (int i = 0; i < 8; ++i) v[i] = *(const f32x4*)(Ws + (size_t)(k0 + 8 * i + (lane >> 3)) * ldw);
#pragma unroll
            for (int i = 0; i < 8; ++i) { LAS float* d = scr + (8 * i + (lane >> 3)) * 33 + 2 * c4 + m; d[0] = v[i][0]; d[2] = v[i][1]; d[4] = v[i][2]; d[6] = v[i][3]; }
        } else {
            int src = n0; bool zero = false;
            if (n0 >= 1696 && n0 < 1728) { src = 5792 + (n0 - 1696); zero = (l == 0); } else if (n0 >= 1728 && n0 < 1792) zero = true; else if (n0 >= 1792) src = n0 - 96;
            const int c4 = (lane & 7) * 4; const float* Ws = W + (zero ? 0 : src) + c4;
#pragma unroll
            for (int i = 0; i < 8; ++i) { v[i] = *(const f32x4*)(Ws + (size_t)(k0 + 8 * i + (lane >> 3)) * ldw); if (zero) v[i] = (f32x4){0.f, 0.f, 0.f, 0.f}; }
#pragma unroll
            for (int i = 0; i < 8; ++i) { LAS float* d = scr + (8 * i + (lane >> 3)) * 33 + c4; d[0] = v[i][0]; d[1] = v[i][1]; d[2] = v[i][2]; d[3] = v[i][3]; }
        }
        moe_item_store<true>(WSP(unsigned char, WS_WIN) + (size_t)l * NIN * 1024, 1024, k0, n0, scr, lane); }
    constexpr int I_A = 8 * 32, I_B = 4 * 32;
    for (int it = gw; it < NL * (I_A + 2 * I_B); it += NGW) { const int l = it / (I_A + 2 * I_B); int r = it % (I_A + 2 * I_B);
        unsigned char* base = WSP(unsigned char, WS_WBR) + (size_t)l * (1024 * 1024);
        if (r < I_A) { fast_item_plain(P.in[17] + (size_t)l * 512 * 1024, 1024, 512, base, 32, scr, r, F.lane); continue; } r -= I_A;
        if (r < I_B) { fast_item_plain(P.in[22] + (size_t)l * 256 * 1024, 1024, 256, base + 1024 * 512, 32, scr, r, F.lane); continue; } r -= I_B;
        fast_item_plain(P.in[27] + (size_t)l * 256 * 1024, 1024, 256, base + 1024 * 512 + 1024 * 256, 32, scr, r, F.lane); }
    constexpr int I_O = 16 * 32;
    for (int it = gw; it < NL * I_O; it += NGW) { const int l = it / I_O, r = it % I_O;
        fast_item_plain(P.in[28] + (size_t)l * 1024 * 1024, 1024, 1024, WSP(unsigned char, WS_WOUT) + (size_t)l * 1024 * 1024, 32, scr, r, F.lane); }
    for (int it = gw; it < 16 * 8; it += NGW) transpose_item<false>(P.in[31], 32, 1024, WSP(bf16_t, WS_WRT), 8, scr, it, F.lane, CmRouter{});
}
__device__ __forceinline__ unsigned char* moe_wbuf(Frame& F, int l) { return (l & 1) ? (unsigned char*)F.out : F.ws + WS_WMOE; }
__device__ __forceinline__ void phase_convert_moe(Frame& F, const Params& P, int l) {
    LAS float* scr = (LAS float*)(F.lds + F.wave * 8448);
    const int gw = F.vcu * 8 + F.wave, NGW = F.G * 8; const int lane = F.lane;
    constexpr int I_GU = 16 * 32;
    constexpr int I_DN = 8 * 32;
    for (int it = gw; it < NE * I_GU; it += NGW) { const int e = it / I_GU, item = it % I_GU;
        const int kb = item / 32, nb = item % 32, k0 = 64 * kb, n0 = 32 * nb;
        const int m = (lane >> 2) & 1, c4 = (lane & 3) * 4;
        const float* Ws = ((m ? P.in[34] : P.in[33]) + ((size_t)l * NE + e) * 1024 * 512) + (n0 >> 1) + c4;
        f32x4 v[8];
#pragma unroll
        for (int i = 0; i < 8; ++i) v[i] = *(const f32x4*)(Ws + (size_t)(k0 + 8 * i + (lane >> 3)) * 512);
#pragma unroll
        for (int i = 0; i < 8; ++i) { LAS float* d = scr + (8 * i + (lane >> 3)) * 33 + 2 * c4 + m; d[0] = v[i][0]; d[2] = v[i][1]; d[4] = v[i][2]; d[6] = v[i][3]; }
        moe_item_store<true>(moe_wbuf(F, l) + (size_t)e * 1024 * 1024, 1024, k0, n0, scr, lane); }
    for (int it = gw; it < NE * I_DN; it += NGW) { const int e = it / I_DN, item = it % I_DN;
        const int kb = item / 32, nb = item % 32, k0 = 64 * kb, n0 = 32 * nb; const int c4 = (lane & 7) * 4;
        const float* Ws = P.in[35] + ((size_t)l * NE + e) * 512 * 1024 + n0 + c4;
        f32x4 v[8];
#pragma unroll
        for (int i = 0; i < 8; ++i) v[i] = *(const f32x4*)(Ws + (size_t)(k0 + 8 * i + (lane >> 3)) * 1024);
#pragma unroll
        for (int i = 0; i < 8; ++i) { LAS float* d = scr + (8 * i + (lane >> 3)) * 33 + c4; d[0] = v[i][0]; d[1] = v[i][1]; d[2] = v[i][2]; d[3] = v[i][3]; }
        moe_item_store<true>(moe_wbuf(F, l) + (size_t)NE * 1024 * 1024 + (size_t)e * 1024 * 512, 512, k0, n0, scr, lane); }
}
__device__ __forceinline__ void phase_convert_lora(Frame& F, const Params& P) {
    bf16_t* dst = WSP(bf16_t, WS_LORA);
    for (int idx = (int)blockIdx.x * 512 + F.tid; idx < 11 * 512 * 32 + 4 * 512 * 96; idx += F.G * 512) {
        float val;
        if (idx < 11 * 512 * 32) { const int m = idx / (512 * 32), rem = idx % (512 * 32), ch = rem / 32, i = rem % 32;
            if (m < 4) val = P.in[6][((size_t)m * 32 + i) * 512 + ch]; else if (m < 8) val = P.in[8][((size_t)(m - 4) * 32 + i) * 512 + ch]; else val = P.in[11][((size_t)(m - 8) * 32 + i) * 512 + ch]; }
        else { const int r2 = idx - 11 * 512 * 32, m = r2 / (512 * 96), rem = r2 % (512 * 96), ch = rem / 96, i = rem % 96; val = P.in[9][((size_t)m * 96 + i) * 512 + ch]; }
        dst[idx] = f2bf(val); }
}
__device__ __forceinline__ void phase_convert_sgu(Frame& F, const Params& P) {
    bf16_t* dst = WSP(bf16_t, WS_SGUW);
    for (int idx = (int)blockIdx.x * 512 + F.tid; idx < NL * 4 * 128 * 128; idx += F.G * 512) { const int p = (idx >> 7) & 127, qq = idx & 127; dst[idx] = f2bf(qq <= p ? P.in[20][idx] : 0.f); }
}
__device__ __forceinline__ void phase_convert_router(Frame& F, const Params& P) {
    bf16_t* dst = WSP(bf16_t, WS_WRG); float* rc = WSP(float, WS_RC);
    for (int idx = (int)blockIdx.x * 512 + F.tid; idx < NL * 256 * 1024; idx += F.G * 512) { const int l = idx >> 18, n = (idx >> 10) & 255, k = idx & 1023;
        dst[idx] = f2bf(n < 32 ? P.in[29][(size_t)l * 1024 + k] * P.in[31][(size_t)k * 32 + n] : 0.f); }
    const int gwv = (int)blockIdx.x * 8 + F.wave;
    if (gwv < NL * 32) { const int l = gwv >> 5, e = gwv & 31; float c1 = 0.f, c0 = 0.f;
#pragma unroll
        for (int j = 0; j < 16; ++j) { const int k = F.lane + 64 * j; const float w = P.in[31][(size_t)k * 32 + e]; c1 += P.in[29][(size_t)l * 1024 + k] * w; c0 += P.in[30][(size_t)l * 1024 + k] * w; }
        c1 = wave_sum(c1); c0 = wave_sum(c0);
        if (F.lane == 0) { rc[l * 64 + e] = c1; rc[l * 64 + 32 + e] = c0; } }
}
__device__ __forceinline__ void phase_x_to_bf16(Frame& F, const Params& P) {
    const size_t n8 = (size_t)T * D / 8; const float* x = P.in[0]; bf16_t* xb = WSP(bf16_t, WS_X); unsigned char* xq = WSP(unsigned char, WS_XQ);
    for (size_t i = (size_t)blockIdx.x * 512 + F.tid; i < n8; i += (size_t)F.G * 512) {
        const f32x4 a = *(const f32x4*)(x + i * 8), b = *(const f32x4*)(x + i * 8 + 4);
        u32x4 o; o.x = cvt_pk_bf16(a[0], a[1]); o.y = cvt_pk_bf16(a[2], a[3]); o.z = cvt_pk_bf16(b[0], b[1]); o.w = cvt_pk_bf16(b[2], b[3]);
        *(u32x4*)(xb + i * 8) = o;
        u32x2 qv; qv.x = pack_fp8x4(a[0], a[1], a[2], a[3]); qv.y = pack_fp8x4(b[0], b[1], b[2], b[3]); *(u32x2*)(xq + i * 8) = qv; }
}

struct SchedInproj { const char* X; const char* W; int G, c;
    __device__ __forceinline__ bool next(int i, ge::Unit& u) const { int pm, pn; if (!ge::static_tile((long)i * G + c, T / 256, NIN / 256, pm, pn)) return false;
        u.A = X + (size_t)pm * 256 * 1024; u.B = W + (size_t)pn * 256 * 1024; u.gat = nullptr; u.lda = 1024; u.ldb = 1024; u.nt = 8; u.gshift = 0; u.nvalid = 256; u.pm = pm; u.pn = pn; u.aux = 0; return true; } };
struct EpiInproj { static constexpr bool AFTER_DRAIN = false; bf16_t* rkv; bf16_t* sguz; bf16_t* convh; unsigned char* gates;
    typedef ge::NoPre Pre; __device__ __forceinline__ Pre prefetch(const ge::Unit&, int, int, int, int) const { return Pre{}; }
    __device__ __forceinline__ void operator()(const ge::Acc& acc, const ge::Unit& u, int wr, int wc, int fr, int fq, const Pre&) const {
        const int pn = u.pn; const int row0 = u.pm * 256 + wr * 64 + fr;
        int kind, ld, colt; bf16_t* base;
        if (pn < 7) { kind = 0; base = rkv; ld = RKVW; colt = pn * 256; }
        else if (pn < 9) { kind = 1; base = sguz; ld = 512; colt = (pn - 7) * 256; }
        else if (pn < 11) { kind = 2; base = convh; ld = 256; colt = (pn - 9) * 128; }
        else { kind = 3; base = rkv; ld = 3072; colt = (pn - 11) * 256; }
#pragma unroll
        for (int ai = 0; ai < 2; ++ai)
#pragma unroll
            for (int m = 0; m < 4; ++m) { const size_t r = (size_t)(row0 + ai * 128 + m * 16);
#pragma unroll
                for (int bj = 0; bj < 2; ++bj) { const int c = 128 * bj + 32 * wc + 8 * fq; f32x4 v0 = acc[ai][bj][m][0], v1 = acc[ai][bj][m][1];
                    if (kind == 2) {
                        const float h0 = v0[0] * sigmoidf_(v0[1]), h1 = v0[2] * sigmoidf_(v0[3]), h2 = v1[0] * sigmoidf_(v1[1]), h3 = v1[2] * sigmoidf_(v1[3]);
                        u32x2 w; w.x = cvt_pk_bf16(h0, h1); w.y = cvt_pk_bf16(h2, h3);
                        *(u32x2*)(base + r * ld + colt + (c >> 1)) = w;
                    } else if (kind == 3) {
                        u32x2 w; unsigned w0 = 0, w1 = 0;
                        w0 = __builtin_amdgcn_cvt_pk_u8_f32(255.f * sigmoidf_(v0[0]) + 0.5f, 0, w0); w0 = __builtin_amdgcn_cvt_pk_u8_f32(255.f * sigmoidf_(v0[1]) + 0.5f, 1, w0);
                        w0 = __builtin_amdgcn_cvt_pk_u8_f32(255.f * sigmoidf_(v0[2]) + 0.5f, 2, w0); w0 = __builtin_amdgcn_cvt_pk_u8_f32(255.f * sigmoidf_(v0[3]) + 0.5f, 3, w0);
                        w1 = __builtin_amdgcn_cvt_pk_u8_f32(255.f * sigmoidf_(v1[0]) + 0.5f, 0, w1); w1 = __builtin_amdgcn_cvt_pk_u8_f32(255.f * sigmoidf_(v1[1]) + 0.5f, 1, w1);
                        w1 = __builtin_amdgcn_cvt_pk_u8_f32(255.f * sigmoidf_(v1[2]) + 0.5f, 2, w1); w1 = __builtin_amdgcn_cvt_pk_u8_f32(255.f * sigmoidf_(v1[3]) + 0.5f, 3, w1);
                        w.x = w0; w.y = w1; *(u32x2*)(gates + r * 3072 + colt + c) = w;
                    } else {
                        if (kind == 1) {
#pragma unroll
                            for (int j = 0; j < 4; ++j) { v0[j] = gelu_f(v0[j]); v1[j] = gelu_f(v1[j]); } }
                        u32x4 w; w.x = cvt_pk_bf16(v0[0], v0[1]); w.y = cvt_pk_bf16(v0[2], v0[3]); w.z = cvt_pk_bf16(v1[0], v1[1]); w.w = cvt_pk_bf16(v1[2], v1[3]);
                        *(u32x4*)(base + r * ld + colt + c) = w; } } }
    } };
struct EpiNull { static constexpr bool AFTER_DRAIN = false; bf16_t* sink;
    typedef ge::NoPre Pre; __device__ __forceinline__ Pre prefetch(const ge::Unit&, int, int, int, int) const { return Pre{}; }
    __device__ __forceinline__ void operator()(const ge::Acc& acc, const ge::Unit& u, int wr, int wc, int fr, int fq, const Pre&) const {
        float t = 0.f;
#pragma unroll
        for (int ai = 0; ai < 2; ++ai)
#pragma unroll
            for (int bj = 0; bj < 2; ++bj)
#pragma unroll
                for (int m = 0; m < 4; ++m)
#pragma unroll
                    for (int n = 0; n < 2; ++n) t += acc[ai][bj][m][n][0];
        if (t == 123456.789f) sink[0] = f2bf(t); } };
struct SchedBranch { const char* ws; size_t woff; int G, v;
    __device__ __forceinline__ bool next(int i, ge::Unit& u) const { const int tile = (i / 3) * G + v, br = i % 3, pm = tile >> 2, pn = tile & 3; if (tile >= 512) return false;
        const unsigned kb = (br == 0) ? 512u : 256u;
        size_t ao = WS_OUTA, wo = woff; if (br == 1) { ao = WS_HB; wo += (size_t)1024 * 512; } if (br == 2) { ao = WS_HC; wo += (size_t)1024 * 512 + (size_t)1024 * 256; }
        u.A = ws + ao + (size_t)pm * 256 * kb; u.lda = kb; u.nt = (int)(kb >> 7); u.B = ws + wo + (size_t)pn * 256 * kb; u.ldb = kb;
        u.gat = nullptr; u.gshift = 0; u.nvalid = 256; u.pm = pm; u.pn = pn; u.aux = br; return true; } };
struct EpiBranch { static constexpr bool AFTER_DRAIN = false; const unsigned char* gates; bf16_t* merged; unsigned char* mq;
    typedef ge::NoPre Pre; __device__ __forceinline__ Pre prefetch(const ge::Unit&, int, int, int, int) const { return Pre{}; }
    __device__ __forceinline__ void operator()(const ge::Acc& acc, const ge::Unit& u, int wr, int wc, int fr, int fq, const Pre&) const {
        const int br = u.aux; const int row0 = u.pm * 256 + wr * 64 + fr;
        u32x2 gall[16];
#pragma unroll
        for (int i = 0; i < 16; ++i) { const size_t r = (size_t)(row0 + (i >> 3) * 128 + ((i >> 1) & 3) * 16); const int c = u.pn * 256 + 128 * (i & 1) + 32 * wc + 8 * fq; gall[i] = *(const u32x2*)(gates + r * 3072 + br * 1024 + c); }
#pragma unroll
        for (int ai = 0; ai < 2; ++ai) {
            u32x2 g[8]; u32x4 p[8];
#pragma unroll
            for (int m = 0; m < 4; ++m)
#pragma unroll
                for (int bj = 0; bj < 2; ++bj) { const size_t r = (size_t)(row0 + ai * 128 + m * 16); const int c = u.pn * 256 + 128 * bj + 32 * wc + 8 * fq;
                    g[m * 2 + bj] = gall[ai * 8 + m * 2 + bj];
                    p[m * 2 + bj] = (br > 0) ? *(const u32x4*)(merged + r * 1024 + c) : (u32x4){0u, 0u, 0u, 0u}; }
#pragma unroll
            for (int m = 0; m < 4; ++m)
#pragma unroll
                for (int bj = 0; bj < 2; ++bj) { const size_t r = (size_t)(row0 + ai * 128 + m * 16); const int c = u.pn * 256 + 128 * bj + 32 * wc + 8 * fq;
                    const f32x4 v0 = acc[ai][bj][m][0], v1 = acc[ai][bj][m][1]; const u32x2 gg = g[m * 2 + bj]; const u32x4 pp = p[m * 2 + bj];
                    const float k = 1.f / 255.f;
                    const float g0 = k * (float)(gg.x & 0xffu), g1 = k * (float)((gg.x >> 8) & 0xffu), g2 = k * (float)((gg.x >> 16) & 0xffu), g3 = k * (float)(gg.x >> 24);
                    const float g4 = k * (float)(gg.y & 0xffu), g5 = k * (float)((gg.y >> 8) & 0xffu), g6 = k * (float)((gg.y >> 16) & 0xffu), g7 = k * (float)(gg.y >> 24);
                    u32x4 w; w.x = cvt_pk_bf16(v0[0] * g0 + bflo(pp.x), v0[1] * g1 + bfhi(pp.x)); w.y = cvt_pk_bf16(v0[2] * g2 + bflo(pp.y), v0[3] * g3 + bfhi(pp.y));
                    w.z = cvt_pk_bf16(v1[0] * g4 + bflo(pp.z), v1[1] * g5 + bfhi(pp.z)); w.w = cvt_pk_bf16(v1[2] * g6 + bflo(pp.w), v1[3] * g7 + bfhi(pp.w));
                    if (br == 2) { u32x2 wq; wq.x = pack_fp8x4(4.f * (v0[0] * g0 + bflo(pp.x)), 4.f * (v0[1] * g1 + bfhi(pp.x)), 4.f * (v0[2] * g2 + bflo(pp.y)), 4.f * (v0[3] * g3 + bfhi(pp.y)));
                        wq.y = pack_fp8x4(4.f * (v1[0] * g4 + bflo(pp.z)), 4.f * (v1[1] * g5 + bfhi(pp.z)), 4.f * (v1[2] * g6 + bflo(pp.w)), 4.f * (v1[3] * g7 + bfhi(pp.w))); *(u32x2*)(mq + r * 1024 + c) = wq; }
                    else *(u32x4*)(merged + r * 1024 + c) = w; }
            asm volatile("" ::: "memory"); }
    } };
struct SchedWout { const char* A; const char* W; int G, v;
    __device__ __forceinline__ bool next(int i, ge::Unit& u) const { const int tile = i * G + v, pm = tile >> 2, pn = tile & 3; if (tile >= 512) return false;
        u.A = A + (size_t)pm * 256 * 1024; u.B = W + (size_t)pn * 256 * 1024; u.gat = nullptr; u.lda = 1024; u.ldb = 1024; u.nt = 8; u.gshift = 0; u.nvalid = 256; u.pm = pm; u.pn = pn; u.aux = 0; return true; } };
struct EpiWout { static constexpr bool AFTER_DRAIN = false; const bf16_t* x; bf16_t* pre; float* stats;
    typedef ge::NoPre Pre; __device__ __forceinline__ Pre prefetch(const ge::Unit&, int, int, int, int) const { return Pre{}; }
    __device__ __forceinline__ void operator()(const ge::Acc& acc, const ge::Unit& u, int wr, int wc, int fr, int fq, const Pre&) const {
        const int row0 = u.pm * 256 + wr * 64 + fr;
#pragma unroll
        for (int ai = 0; ai < 2; ++ai) {
            u32x4 xr[8];
#pragma unroll
            for (int m = 0; m < 4; ++m)
#pragma unroll
                for (int bj = 0; bj < 2; ++bj) xr[m * 2 + bj] = *(const u32x4*)(x + (size_t)(row0 + ai * 128 + m * 16) * 1024 + u.pn * 256 + 128 * bj + 32 * wc + 8 * fq);
#pragma unroll
            for (int m = 0; m < 4; ++m) { const size_t r = (size_t)(row0 + ai * 128 + m * 16); float s1 = 0.f, s2 = 0.f;
#pragma unroll
                for (int bj = 0; bj < 2; ++bj) { const int c = u.pn * 256 + 128 * bj + 32 * wc + 8 * fq; const f32x4 v0 = acc[ai][bj][m][0], v1 = acc[ai][bj][m][1];
                    const u32x4 p = xr[m * 2 + bj];
                    u32x4 w; w.x = cvt_pk_bf16(v0[0] + ALPHA * bflo(p.x), v0[1] + ALPHA * bfhi(p.x)); w.y = cvt_pk_bf16(v0[2] + ALPHA * bflo(p.y), v0[3] + ALPHA * bfhi(p.y));
                    w.z = cvt_pk_bf16(v1[0] + ALPHA * bflo(p.z), v1[1] + ALPHA * bfhi(p.z)); w.w = cvt_pk_bf16(v1[2] + ALPHA * bflo(p.w), v1[3] + ALPHA * bfhi(p.w));
                    *(u32x4*)(pre + r * 1024 + c) = w;
                    const float q0 = bflo(w.x), q1 = bfhi(w.x), q2 = bflo(w.y), q3 = bfhi(w.y), q4 = bflo(w.z), q5 = bfhi(w.z), q6 = bflo(w.w), q7 = bfhi(w.w);
                    s1 += ((q0 + q1) + (q2 + q3)) + ((q4 + q5) + (q6 + q7)); s2 += ((q0 * q0 + q1 * q1) + (q2 * q2 + q3 * q3)) + ((q4 * q4 + q5 * q5) + (q6 * q6 + q7 * q7)); }
                s1 += __shfl_xor(s1, 16); s2 += __shfl_xor(s2, 16); s1 += __shfl_xor(s1, 32); s2 += __shfl_xor(s2, 32);
                if (fq == 0) *(f32x2*)(stats + (r * 16 + u.pn * 4 + wc) * 2) = (f32x2){s1, s2}; }
            asm volatile("" ::: "memory"); }
    } };
struct SchedRouter { const char* A; const char* W; int G, v;
    __device__ __forceinline__ bool next(int i, ge::Unit& u) const { const int pm = i * G + v; if (pm >= 128) return false;
        u.A = A + (size_t)pm * 256 * 2048; u.B = W; u.gat = nullptr; u.lda = 2048; u.ldb = 2048; u.nt = 16; u.gshift = 0; u.nvalid = 256; u.pm = pm; u.pn = 0; u.aux = 0; return true; } };
struct EpiRouter { static constexpr bool AFTER_DRAIN = true; const float* rbias; unsigned* cnt; int* list; const float* stats; const float* rc;
    typedef ge::NoPre Pre; __device__ __forceinline__ Pre prefetch(const ge::Unit&, int, int, int, int) const { return Pre{}; }
    __device__ __forceinline__ void drained(const ge::Acc& acc, const ge::Unit& u, int wr, int wc, int fr, int fq, LAS unsigned char* lds) const {
        LAS int* lcnt = (LAS int*)lds; LAS int* lbase = lcnt + 32;
        const bool t32 = (wr == 0 && wc == 0 && fq < 2); const int t = fq * 16 + fr;
        if (t32) lcnt[t] = 0;
        __syncthreads();
        int e1[8], e2[8], r1[8], r2[8]; float g1[8], g2[8];
        const int row0 = u.pm * 256 + wr * 64 + fr;
        if (wc == 0) {
            float bias[8], c1v[8], c0v[8];
#pragma unroll
            for (int j = 0; j < 8; ++j) { bias[j] = rbias[8 * fq + j]; c1v[j] = rc[8 * fq + j]; c0v[j] = rc[32 + 8 * fq + j]; }
            f32x4 sa0[8], sa1[8];
#pragma unroll
            for (int i8 = 0; i8 < 8; ++i8) { const size_t r = (size_t)(row0 + (i8 >> 2) * 128 + (i8 & 3) * 16); sa0[i8] = *(const f32x4*)(stats + (r * 16 + 4 * fq) * 2); sa1[i8] = *(const f32x4*)(stats + (r * 16 + 4 * fq + 2) * 2); }
#pragma unroll
            for (int ai = 0; ai < 2; ++ai)
#pragma unroll
                for (int m = 0; m < 4; ++m) { const int i8 = ai * 4 + m;
                    const f32x4 v0 = acc[ai][0][m][0], v1 = acc[ai][0][m][1];
                    float mean, rstd;
                    {   const f32x4 a0 = sa0[i8], a1 = sa1[i8];
                        float s1 = (a0[0] + a0[2]) + (a1[0] + a1[2]), s2 = (a0[1] + a0[3]) + (a1[1] + a1[3]);
                        s1 += __shfl_xor(s1, 16); s2 += __shfl_xor(s2, 16); s1 += __shfl_xor(s1, 32); s2 += __shfl_xor(s2, 32);
                        mean = s1 * (1.f / 1024.f); rstd = rsqrtf(fmaxf(s2 * (1.f / 1024.f) - mean * mean, 0.f) + LN_EPS); }
                    float s[8], sel[8];
#pragma unroll
                    for (int j = 0; j < 4; ++j) { s[j] = sigmoidf_(rstd * (v0[j] - mean * c1v[j]) + c0v[j]); s[4 + j] = sigmoidf_(rstd * (v1[j] - mean * c1v[4 + j]) + c0v[4 + j]); }
#pragma unroll
                    for (int j = 0; j < 8; ++j) sel[j] = s[j] + bias[j];
                    int i1 = 0; float m1 = sel[0];
#pragma unroll
                    for (int j = 1; j < 8; ++j) if (sel[j] > m1) { m1 = sel[j]; i1 = j; }
                    int i2 = (i1 == 0) ? 1 : 0; float m2 = (i1 == 0) ? sel[1] : sel[0];
#pragma unroll
                    for (int j = 0; j < 8; ++j) if (j != i1 && j != ((i1 == 0) ? 1 : 0) && sel[j] > m2) { m2 = sel[j]; i2 = j; }
                    float gs = m1 + m2; int gi = fq;
                    { const float os = __shfl_xor(gs, 16); const int oi = __shfl_xor(gi, 16); if (os > gs || (os == gs && oi < gi)) { gs = os; gi = oi; } }
                    { const float os = __shfl_xor(gs, 32); const int oi = __shfl_xor(gi, 32); if (os > gs || (os == gs && oi < gi)) { gs = os; gi = oi; } }
                    e1[i8] = -1; e2[i8] = -1; r1[i8] = 0; r2[i8] = 0; g1[i8] = 0.f; g2[i8] = 0.f;
                    if (gi == fq) {
                        float s1 = s[0], s2 = s[0];
#pragma unroll
                        for (int j = 0; j < 8; ++j) { s1 = (j == i1) ? s[j] : s1; s2 = (j == i2) ? s[j] : s2; }
                        const float inv = 1.0f / (s1 + s2);
                        e1[i8] = 8 * fq + i1; e2[i8] = 8 * fq + i2; g1[i8] = s1 * inv; g2[i8] = s2 * inv;
                        r1[i8] = __hip_atomic_fetch_add(lcnt + e1[i8], 1, __ATOMIC_RELAXED, __HIP_MEMORY_SCOPE_WORKGROUP);
                        r2[i8] = __hip_atomic_fetch_add(lcnt + e2[i8], 1, __ATOMIC_RELAXED, __HIP_MEMORY_SCOPE_WORKGROUP); } }
        }
        __syncthreads();
        if (t32) { const int c = lcnt[t]; lbase[t] = (c > 0) ? (int)atomicAdd(cnt + t, (unsigned)c) : 0; }
        __syncthreads();
        if (wc == 0) {
#pragma unroll
            for (int i8 = 0; i8 < 8; ++i8) if (e1[i8] >= 0) { const int r = row0 + (i8 >> 2) * 128 + (i8 & 3) * 16;
                u32x2 p1, p2; p1.x = (unsigned)(2 * r); p1.y = __float_as_uint(g1[i8]); p2.x = (unsigned)(2 * r + 1); p2.y = __float_as_uint(g2[i8]);
                *(u32x2*)(list + ((size_t)e1[i8] * T + lbase[e1[i8]] + r1[i8]) * 2) = p1; *(u32x2*)(list + ((size_t)e2[i8] * T + lbase[e2[i8]] + r2[i8]) * 2) = p2; } }
        __syncthreads();
    } };
__device__ __forceinline__ int build_tile_table(Frame& F, const unsigned* cnt) {
    volatile LAS int* tab = (volatile LAS int*)(F.lds + LDS_MISC + 64);
    __syncthreads();
    if (F.wave == 0) {
        const int e = F.lane & 31; const int c = (int)__hip_atomic_load(cnt + e, __ATOMIC_RELAXED, __HIP_MEMORY_SCOPE_AGENT); const int nt = (F.lane < 32) ? ((c + 255) >> 8) : 0;
        int incl = nt;
#pragma unroll
        for (int o = 1; o < 32; o <<= 1) { const int up = __shfl_up(incl, o); if ((F.lane & 31) >= o) incl += up; }
        const int base = incl - nt;
        if (F.lane < 32) for (int j = 0; j < nt; ++j) tab[1 + base + j] = (e << 16) | j;
        if (F.lane == 31) tab[0] = incl; }
    __syncthreads();
    return tab[0];
}
struct SchedMoe1 { const char* X1; const char* W; const int* list; const unsigned* cnt; LAS int* tab; int ntiles, G, v;
    __device__ __forceinline__ bool next(int i, ge::Unit& u) const { const int L = i * G + v, rt = L >> 2, pn = L & 3; if (rt >= ntiles) return false;
        const int ej = tab[1 + rt], e = ej >> 16, j = ej & 0xffff; const int c = (int)cnt[e];
        u.A = X1; u.gat = list + ((size_t)e * T + j * 256) * 2; u.gshift = 1; u.nvalid = (c - j * 256) < 256 ? (c - j * 256) : 256; u.lda = 1024; u.nt = 8;
        u.B = W + ((size_t)e * 1024 + (size_t)pn * 256) * 1024; u.ldb = 1024; u.pm = rt; u.pn = pn; u.aux = e; return true; } };
struct EpiMoe1 { static constexpr bool AFTER_DRAIN = false; unsigned char* H;
    typedef ge::NoPre Pre; __device__ __forceinline__ Pre prefetch(const ge::Unit&, int, int, int, int) const { return Pre{}; }
    __device__ __forceinline__ void operator()(const ge::Acc& acc, const ge::Unit& u, int wr, int wc, int fr, int fq, const Pre&) const {
        const int row0 = u.pm * 256 + wr * 64 + fr;
#pragma unroll
        for (int ai = 0; ai < 2; ++ai)
#pragma unroll
            for (int m = 0; m < 4; ++m) { const size_t r = (size_t)(row0 + ai * 128 + m * 16);
#pragma unroll
                for (int bj = 0; bj < 2; ++bj) { const int c = 128 * bj + 32 * wc + 8 * fq; const f32x4 v0 = acc[ai][bj][m][0], v1 = acc[ai][bj][m][1];
                    const float h0 = v0[0] * sigmoidf_(v0[0]) * v0[1], h1 = v0[2] * sigmoidf_(v0[2]) * v0[3], h2 = v1[0] * sigmoidf_(v1[0]) * v1[1], h3 = v1[2] * sigmoidf_(v1[2]) * v1[3];
                    *(unsigned*)(H + r * 512 + u.pn * 128 + (c >> 1)) = pack_fp8x4(h0, h1, h2, h3); }
                asm volatile("" ::: "memory"); }
    } };
struct SchedMoe2 { const char* H; const char* W; const int* list; const unsigned* cnt; LAS int* tab; int ntiles, G, v, ntk;
    __device__ __forceinline__ bool next(int i, ge::Unit& u) const { const int L = i * G + v, rt = L >> 2, pn = L & 3; if (rt >= ntiles) return false;
        const int ej = tab[1 + rt], e = ej >> 16, j = ej & 0xffff; const int c = (int)cnt[e];
        u.A = H + (size_t)rt * 256 * 512; u.gat = nullptr; u.gshift = 0; u.nvalid = (c - j * 256) < 256 ? (c - j * 256) : 256; u.lda = 512; u.nt = ntk;
        u.B = W + ((size_t)e * 1024 + (size_t)pn * 256) * 512; u.ldb = 512; u.pm = rt; u.pn = pn; u.aux = (e << 16) | j; return true; } };
template <int MODE> struct EpiMoe2T { static constexpr bool AFTER_DRAIN = false; const int* list; unsigned char* Y; int* inv;
    typedef ge::NoPre Pre; __device__ __forceinline__ Pre prefetch(const ge::Unit&, int, int, int, int) const { return Pre{}; }
    __device__ __forceinline__ void operator()(const ge::Acc& acc, const ge::Unit& u, int wr, int wc, int fr, int fq, const Pre&) const {
        const int e = u.aux >> 16, j = u.aux & 0xffff; const int* lst = list + ((size_t)e * T + j * 256) * 2;
        const unsigned row0 = (unsigned)u.pm * 256u + (unsigned)(wr * 64 + fr); const unsigned col0 = (unsigned)(u.pn * 256 + 32 * wc + 8 * fq);
        const bool invw = (u.pn == 0 && wc == 0 && fq == 0);
        u32x2 sgall[8];
#pragma unroll
        for (int i8 = 0; i8 < 8; ++i8) { const int rr = (i8 >> 2) * 128 + wr * 64 + (i8 & 3) * 16 + fr; const u32x2 v = *(const u32x2*)(lst + 2 * (rr < u.nvalid ? rr : 0)); sgall[i8].x = (rr < u.nvalid) ? v.x : 0xffffffffu; sgall[i8].y = v.y; }
#pragma unroll
        for (int ai = 0; ai < 2; ++ai) {
            u32x2 sg[4];
#pragma unroll
            for (int m = 0; m < 4; ++m) sg[m] = sgall[ai * 4 + m];
#pragma unroll
            for (int m = 0; m < 4; ++m) { const int sl = (int)sg[m].x; const float gg = __uint_as_float(sg[m].y);
                const unsigned yrow = row0 + (unsigned)(ai * 128 + m * 16);
                if (MODE == 1) { if (sl == 0x7ffffff0) Y[0] = (unsigned char)pack_fp8x4(acc[ai][0][m][0][0] * gg, 0.f, 0.f, 0.f); }
                else if (sl >= 0) {
                    if (invw) inv[sl] = (int)yrow;
#pragma unroll
                    for (int bj = 0; bj < 2; ++bj) { const f32x4 v0 = acc[ai][bj][m][0], v1 = acc[ai][bj][m][1];
                        const float g8 = 8.f * gg; u32x2 w; w.x = pack_fp8x4(g8 * v0[0], g8 * v0[1], g8 * v0[2], g8 * v0[3]); w.y = pack_fp8x4(g8 * v1[0], g8 * v1[1], g8 * v1[2], g8 * v1[3]);
                        *(u32x2*)(Y + (yrow * 1024u + col0 + 128u * bj)) = w; } } }
            asm volatile("" ::: "memory"); }
    } };
typedef EpiMoe2T<0> EpiMoe2;
typedef short bf16x4 __attribute__((ext_vector_type(4)));
#if DEBUG_MODE
#define DBGF(stage, val) do { const float v_ = (val); if (!(fabsf(v_) < 1e30f)) atomicOr((unsigned*)(F.ws + WS_CTL) + 12, 1u << (stage)); } while (0)
#else
#define DBGF(stage, val) do { } while (0)
#endif
#define MFMA16(a, b, c) __builtin_amdgcn_mfma_f32_16x16x16bf16_1k(a, b, c, 0, 0, 0)
#define MFMA32(a, b, c) __builtin_amdgcn_mfma_f32_16x16x32_bf16(a, b, c, 0, 0, 0)
__device__ __forceinline__ bf16x4 pack4(const f32x4 v) { u32x2 w; w.x = cvt_pk_bf16(v[0], v[1]); w.y = cvt_pk_bf16(v[2], v[3]); return __builtin_bit_cast(bf16x4, w); }
__device__ __forceinline__ f32x4 unpack4(const u32x2 w) { return (f32x4){bflo(w.x), bfhi(w.x), bflo(w.y), bfhi(w.y)}; }
constexpr int TP = 72;
constexpr int TILE_B = 64 * TP * 2;
constexpr int LA_ACT = 0;
constexpr int LA_AT = 13312, LA_RT = LA_AT + TILE_B, LA_BT = LA_RT + TILE_B, LA_KT = LA_BT + TILE_B;
constexpr int LA_BTT = LA_KT + TILE_B, LA_KTT = LA_BTT + TILE_B, LA_VT = LA_KTT + TILE_B;
constexpr int LA_AAB = LA_VT + TILE_B, LA_AAK = LA_AAB + TILE_B, LA_ARB = LA_AAK + TILE_B, LA_ARK = LA_ARB + TILE_B;
constexpr int LA_DIAG = LA_ARK + TILE_B;
constexpr int LA_TII = LA_DIAG + 4096;
constexpr int LA_SEG = LA_TII + 3072;
constexpr int LA_KSQ = LA_SEG + 4096;
constexpr int LA_RKP = LA_KSQ + 1024;
constexpr int LA_PC = LA_RKP + 1024;
static_assert(LA_PC + 256 <= LDS_STAGE, "pass A LDS map");

template <bool EONLY> __device__ __forceinline__ void phase_wkv_a(Frame& F, const Params& P, int l) {
    LAS unsigned char* lds = F.lds;
    const bf16_t* rkv = WSP(bf16_t, WS_RKV);
    const bf16_t* wupT = WSP(bf16_t, WS_LORA) + (size_t)l * 512 * 32;
    const bf16_t* aupT = WSP(bf16_t, WS_LORA) + (size_t)(4 + l) * 512 * 32;
    const bf16_t* vupT = WSP(bf16_t, WS_LORA) + (size_t)(8 + (l > 0 ? l - 1 : 0)) * 512 * 32;
    const float* mu = P.in[3] + (size_t)l * 1696; const float* muv = (l > 0) ? P.in[4] + (size_t)(l - 1) * 32 : nullptr;
    bf16_t* PHI = WSP(bf16_t, WS_PHI); bf16_t* PSI = WSP(bf16_t, WS_PSI); bf16_t* GT = WSP(bf16_t, WS_GT); bf16_t* Y0T = WSP(bf16_t, WS_Y0T); bf16_t* VT = WSP(bf16_t, WS_VT); bf16_t* VF = WSP(bf16_t, WS_VFIRST);
    float* RK = WSP(float, WS_RK);
    const int lane = F.lane, w = F.wave, cb = w & 3, th = w >> 2;
#define WKVA_RAW_LOAD(dst, hn) do { _Pragma("unroll") for (int i_ = 0; i_ < 4; ++i_) { const int p_ = F.tid + 512 * i_; const int pc_ = p_ < 1560 ? p_ : 1559; const int row_ = pc_ / 24, rem_ = pc_ % 24; \
        const int tok_ = (row_ == 0 && firstchunk) ? t0 : t0 - 1 + row_; dst[i_] = *(const u32x4*)(rkv + (size_t)tok_ * RKVW + (rem_ >> 3) * 512 + (hn) * 64 + (rem_ & 7) * 8); } } while (0)
#define WKVA_RAW_STORE(src) do { _Pragma("unroll") for (int i_ = 0; i_ < 4; ++i_) { const int p_ = F.tid + 512 * i_; if (p_ < 1560) { const int row_ = p_ / 24, rem_ = p_ % 24; \
        *(LAS u32x4*)(lds + LDS_RAW + (row_ * 192 + (rem_ >> 3) * 64 + (rem_ & 7) * 8) * 2) = src[i_]; } } } while (0)
    for (int unit = blockIdx.x; unit < T / 64; unit += F.G) {
        const int t0 = unit * 64; const bool firstchunk = (t0 & (SEQ - 1)) == 0;
        __syncthreads();
        { u32x4 r0_[4]; WKVA_RAW_LOAD(r0_, 0); WKVA_RAW_STORE(r0_); }
        for (int idx = F.tid; idx < 64 * 96; idx += 512) { const int tok = idx / 96, qq = idx % 96; const int col = (qq < 64) ? 1536 + qq : 1536 + 96 + qq;
            const int t = t0 + tok;
            const bool hp = (tok > 0 || !firstchunk); const float p = bf2f(rkv[(size_t)t * RKVW + col]); const float ppl = bf2f(rkv[(size_t)(hp ? t - 1 : t) * RKVW + col]); const float pp = hp ? ppl : 0.f;
            const float m_ = (qq < 64) ? mu[1536 + qq] : ((l > 0) ? P.in[4][(size_t)(l > 0 ? l - 1 : 0) * 32 + qq - 64] : 0.f);
            float val = p + (pp - p) * m_; if (qq < 32) val = tanhf(val);
            *(LAS bf16_t*)(lds + LA_ACT + (tok * 104 + qq) * 2) = f2bf(val); }
        __syncthreads();
        for (int h = 0; h < 8; ++h) {
            int lz = lane; asm volatile("" : "+v"(lz)); const int c = lz & 15, q = lz >> 4;
            const int chid = unit * 8 + h; const int ch = 16 * cb + c, chg = h * 64 + ch;
            f32x4 zw[2], za[2], zv[2];
            {   const bf16x8 bw = *(const bf16x8*)(wupT + (size_t)chg * 32 + 8 * q), ba = *(const bf16x8*)(aupT + (size_t)chg * 32 + 8 * q), bv = *(const bf16x8*)(vupT + (size_t)chg * 32 + 8 * q);
#pragma unroll
                for (int ii = 0; ii < 2; ++ii) { const int i = 2 * th + ii; const LAS unsigned char* ar = lds + LA_ACT + ((16 * i + c) * 104 + 8 * q) * 2;
                    const bf16x8 a0 = *(const LAS bf16x8*)(ar), a1 = *(const LAS bf16x8*)(ar + 64), a2 = *(const LAS bf16x8*)(ar + 128);
                    const f32x4 z = {0.f, 0.f, 0.f, 0.f};
                    zw[ii] = MFMA32(a0, bw, z); za[ii] = MFMA32(a1, ba, z); zv[ii] = MFMA32(a2, bv, z); } }
            const float mu_r = mu[chg], mu_k = mu[512 + chg], mu_v = mu[1024 + chg];
            const float w0 = P.in[5][(size_t)l * 512 + chg], a0_ = P.in[7][(size_t)l * 512 + chg], v0_ = (l > 0) ? P.in[10][(size_t)(l - 1) * 512 + chg] : 0.f;
            const float k_k = P.in[12][(size_t)l * 512 + chg], k_a = P.in[13][(size_t)l * 512 + chg], r_k = P.in[14][(size_t)l * 512 + chg];
            float rr[2][4], kh[2][4], vv[2][4], lw[2][4], ic[2][4], kkr[2][4];
#pragma unroll
            for (int ii = 0; ii < 2; ++ii) { const int i = 2 * th + ii; const int tl0 = 16 * i + 4 * q;
                const bool hasprev = (tl0 > 0) || !firstchunk;
                const LAS unsigned char* rb = lds + LDS_RAW + (tl0 * 192 + ch) * 2;
                const float lpr = bf2f(*(const LAS bf16_t*)(rb)), lpk = bf2f(*(const LAS bf16_t*)(rb + 128)), lpv = bf2f(*(const LAS bf16_t*)(rb + 256));
                float pr = hasprev ? lpr : 0.f, pk = hasprev ? lpk : 0.f, pv = hasprev ? lpv : 0.f;
                f32x4 vf = {0.f, 0.f, 0.f, 0.f};
                if (l > 0) vf = unpack4(*(const u32x2*)(VF + ((size_t)chid * 64 + ch) * 64 + tl0));
                float lsum = 0.f;
#pragma unroll
                for (int r = 0; r < 4; ++r) { const LAS unsigned char* rc_ = rb + (r + 1) * 384; const float cr = bf2f(*(const LAS bf16_t*)(rc_)), ck = bf2f(*(const LAS bf16_t*)(rc_ + 128)), cv = bf2f(*(const LAS bf16_t*)(rc_ + 256));
                    const float r_ = cr + (pr - cr) * mu_r, k_ = ck + (pk - ck) * mu_k; float v_ = cv + (pv - cv) * mu_v; pr = cr; pk = ck; pv = cv;
                    const float lw_ = -0.6065306597126334f * sigmoidf_(w0 + zw[ii][r]); const float icl = sigmoidf_(a0_ + za[ii][r]);
                    if (l > 0) v_ = v_ + (vf[r] - v_) * sigmoidf_(v0_ + zv[ii][r]);
                    const float kk_ = k_ * k_k, kh_ = k_ * (1.0f + (icl - 1.0f) * k_a);
                    rr[ii][r] = r_; kh[ii][r] = kh_; vv[ii][r] = v_; lw[ii][r] = lw_; ic[ii][r] = icl; kkr[ii][r] = kk_; lsum += lw_;
                    const float s1 = row16_sum(kk_ * kk_), s2 = row16_sum(r_ * kh_ * r_k);
                    *(LAS float*)(lds + LA_KSQ + (cb * 64 + tl0 + r) * 4) = s1; *(LAS float*)(lds + LA_RKP + (cb * 64 + tl0 + r) * 4) = s2; }
                *(LAS float*)(lds + LA_SEG + (ch * 16 + i * 4 + q) * 4) = lsum; }
            __syncthreads();
            u32x4 nraw[4]; if (h < 7) WKVA_RAW_LOAD(nraw, h + 1);
            {   float seg[16];
#pragma unroll
                for (int j4 = 0; j4 < 4; ++j4) { const f32x4 s4 = *(const LAS f32x4*)(lds + LA_SEG + (ch * 16 + 4 * j4) * 4); seg[4 * j4] = s4[0]; seg[4 * j4 + 1] = s4[1]; seg[4 * j4 + 2] = s4[2]; seg[4 * j4 + 3] = s4[3]; }
                float tot = 0.f;
#pragma unroll
                for (int j = 0; j < 16; ++j) tot += seg[j];
                if (th == 0) *(LAS float*)(lds + LA_PC + ch * 4) = __expf(tot);
                float mine[8];
#pragma unroll
                for (int j = 0; j < 8; ++j) mine[j] = th ? seg[8 + j] : seg[j];
                const float firsthalf = th ? (((seg[0] + seg[1]) + (seg[2] + seg[3])) + ((seg[4] + seg[5]) + (seg[6] + seg[7]))) : 0.f;
#pragma unroll
                for (int ii = 0; ii < 2; ++ii) { const int i = 2 * th + ii; const int tl0 = 16 * i + 4 * q; const int sidx = i * 4 + q;
                    float cum = firsthalf + (ii ? ((mine[0] + mine[1]) + (mine[2] + mine[3])) : 0.f);
                    { const float s0 = mine[4 * ii], s1 = mine[4 * ii + 1], s2 = mine[4 * ii + 2]; cum += (q > 0 ? s0 : 0.f) + (q > 1 ? s1 : 0.f) + (q > 2 ? s2 : 0.f); }
                    f32x4 at, rt, bt, kt;
#pragma unroll
                    for (int r = 0; r < 4; ++r) { const int tl = tl0 + r;
                        const float ks = (*(const LAS float*)(lds + LA_KSQ + tl * 4) + *(const LAS float*)(lds + LA_KSQ + (64 + tl) * 4)) + (*(const LAS float*)(lds + LA_KSQ + (128 + tl) * 4) + *(const LAS float*)(lds + LA_KSQ + (192 + tl) * 4));
                        const float kk_ = kkr[ii][r] * __builtin_amdgcn_rsqf(fmaxf(ks, 1e-24f));
                        const float cumx = cum; cum += lw[ii][r];
                        const float ex = __expf(cumx), ei = __expf(cum), en = __expf(-cum);
                        at[r] = -kk_ * ex; rt[r] = rr[ii][r] * ei; bt[r] = kk_ * ic[ii][r] * en; kt[r] = kh[ii][r] * en;
#if DEBUG_MODE
                        { bf16_t* dd = (bf16_t*)F.out; const size_t oo = (size_t)(t0 + tl) * 512 + chg; dd[oo] = f2bf(__expf(lw[ii][r])); dd[(size_t)T * 512 + oo] = f2bf(kk_ * ic[ii][r]); dd[(size_t)2 * T * 512 + oo] = f2bf(-kk_); }
#endif
                        DBGF(1, lw[ii][r]); DBGF(1, cum); DBGF(2, at[r]); DBGF(2, rt[r]); DBGF(2, bt[r]); DBGF(2, kt[r]);
                        *(LAS bf16_t*)(lds + LA_AT + (tl * TP + ch) * 2) = f2bf(at[r]); *(LAS bf16_t*)(lds + LA_RT + (tl * TP + ch) * 2) = f2bf(rt[r]);
                        *(LAS bf16_t*)(lds + LA_BT + (tl * TP + ch) * 2) = f2bf(bt[r]); *(LAS bf16_t*)(lds + LA_KT + (tl * TP + ch) * 2) = f2bf(kt[r]);
                        if (cb == 0) { const float rk = (*(const LAS float*)(lds + LA_RKP + tl * 4) + *(const LAS float*)(lds + LA_RKP + (64 + tl) * 4)) + (*(const LAS float*)(lds + LA_RKP + (128 + tl) * 4) + *(const LAS float*)(lds + LA_RKP + (192 + tl) * 4));
                            if (c == 0) RK[(size_t)(t0 + tl) * 8 + h] = rk; } }
                    const f32x4 v4 = {vv[ii][0], vv[ii][1], vv[ii][2], vv[ii][3]};
                    *(LAS bf16x4*)(lds + LA_BTT + (ch * TP + tl0) * 2) = pack4(bt); *(LAS bf16x4*)(lds + LA_KTT + (ch * TP + tl0) * 2) = pack4(kt); *(LAS bf16x4*)(lds + LA_VT + (ch * TP + tl0) * 2) = pack4(v4);
                    *(bf16x4*)(VT + ((size_t)chid * 64 + ch) * 64 + tl0) = pack4(v4);
                    if (l == 0) *(bf16x4*)(VF + ((size_t)chid * 64 + ch) * 64 + tl0) = pack4(v4); } }
            __syncthreads();
            if (EONLY) { if (h < 7) WKVA_RAW_STORE(nraw); __syncthreads(); continue; }
            {   const bool isR = w >= 4; const int i = w & 3;
                const LAS unsigned char* brow = lds + (isR ? LA_RT : LA_AT) + ((16 * i + c) * TP + 8 * q) * 2;
                const bf16x8 bf0 = *(const LAS bf16x8*)(brow), bf1 = *(const LAS bf16x8*)(brow + 64);
                LAS unsigned char* ob = lds + (isR ? LA_ARB : LA_AAB); LAS unsigned char* ok = lds + (isR ? LA_ARK : LA_AAK);
                const int tloc = 16 * i + c;
#pragma unroll
                for (int j = 0; j < 4; ++j) { f32x4 db = {0.f, 0.f, 0.f, 0.f}, dk = {0.f, 0.f, 0.f, 0.f};
                    if (j <= i) { const LAS unsigned char* arb = lds + LA_BT + ((16 * j + c) * TP + 8 * q) * 2; const LAS unsigned char* ark = lds + LA_KT + ((16 * j + c) * TP + 8 * q) * 2;
                        db = MFMA32(*(const LAS bf16x8*)(arb), bf0, db); db = MFMA32(*(const LAS bf16x8*)(arb + 64), bf1, db);
                        dk = MFMA32(*(const LAS bf16x8*)(ark), bf0, dk); dk = MFMA32(*(const LAS bf16x8*)(ark + 64), bf1, dk);
                        if (j == i) {
#pragma unroll
                            for (int r = 0; r < 4; ++r) { const int s = 16 * j + 4 * q + r; const bool keep = isR ? (s <= tloc) : (s < tloc); db[r] = keep ? db[r] : 0.f; dk[r] = keep ? dk[r] : 0.f; }
                            if (!isR) *(LAS f32x4*)(lds + LA_DIAG + ((i * 16 + c) * 16 + 4 * q) * 4) = db; } }
                    DBGF(3, db[0] + db[1] + db[2] + db[3]); DBGF(3, dk[0] + dk[1] + dk[2] + dk[3]);
                    *(LAS bf16x4*)(ob + (tloc * TP + 16 * j + 4 * q) * 2) = pack4(db); *(LAS bf16x4*)(ok + (tloc * TP + 16 * j + 4 * q) * 2) = pack4(dk); } }
            __syncthreads();
            f32x4 X[4];
            if (w == 0) { const int blk = q, jc = c; float tc[16];
                f32x4 Lr[15][4];
#pragma unroll
                for (int t = 1; t < 16; ++t)
#pragma unroll
                    for (int s4 = 0; s4 < 4; ++s4) if (4 * s4 < t) Lr[t - 1][s4] = *(const LAS f32x4*)(lds + LA_DIAG + ((blk * 16 + t) * 16 + 4 * s4) * 4);
                __builtin_amdgcn_sched_barrier(0);
#pragma unroll
                for (int s = 0; s < 16; ++s) tc[s] = (s == jc) ? 1.f : 0.f;
#pragma unroll
                for (int t = 1; t < 16; ++t) { float val = 0.f;
#pragma unroll
                    for (int s4 = 0; s4 < 4; ++s4) if (4 * s4 < t) { const f32x4 L = Lr[t - 1][s4];
#pragma unroll
                        for (int e = 0; e < 4; ++e) if (4 * s4 + e < t) val += L[e] * tc[4 * s4 + e]; }
                    tc[t] += val; }
#pragma unroll
                for (int t = 0; t < 16; ++t) { DBGF(4, tc[t]); *(LAS bf16_t*)(lds + LA_TII + ((blk * 16 + t) * 24 + jc) * 2) = f2bf(tc[t]); } }
            if (w < 4) {
#pragma unroll
                for (int i = 0; i < 4; ++i)
#pragma unroll
                    for (int r = 0; r < 4; ++r) X[i][r] = bf2f(*(const LAS bf16_t*)(lds + LA_AT + ((16 * i + 4 * q + r) * TP + 16 * w + c) * 2));
            } else { const int vb = w - 4; const LAS unsigned char* vrow = lds + LA_VT + ((16 * vb + c) * TP + 8 * q) * 2;
                const bf16x8 v0 = *(const LAS bf16x8*)(vrow), v1 = *(const LAS bf16x8*)(vrow + 64);
#pragma unroll
                for (int i = 0; i < 4; ++i) { const LAS unsigned char* arow = lds + LA_AAK + ((16 * i + c) * TP + 8 * q) * 2; f32x4 d = {0.f, 0.f, 0.f, 0.f};
                    d = MFMA32(*(const LAS bf16x8*)(arow), v0, d); d = MFMA32(*(const LAS bf16x8*)(arow + 64), v1, d); X[i] = d; } }
            DBGF(5, (X[0][0] + X[1][1]) + (X[2][2] + X[3][3]));
            __syncthreads();
            bf16x4 Xb[4];
            {   bf16x4 Af[6], Tf[4];
#pragma unroll
                for (int i = 1; i < 4; ++i)
#pragma unroll
                    for (int j = 0; j < 3; ++j) if (j < i) Af[(i * (i - 1)) / 2 + j] = *(const LAS bf16x4*)(lds + LA_AAB + ((16 * i + c) * TP + 16 * j + 4 * q) * 2);
#pragma unroll
                for (int i = 0; i < 4; ++i) Tf[i] = *(const LAS bf16x4*)(lds + LA_TII + ((i * 16 + c) * 24 + 4 * q) * 2);
                __builtin_amdgcn_sched_barrier(0);
#pragma unroll
                for (int i = 0; i < 4; ++i) { f32x4 y = X[i];
#pragma unroll
                    for (int j = 0; j < 3; ++j) if (j < i) y = MFMA16(Af[(i * (i - 1)) / 2 + j], Xb[j], y);
                    const f32x4 z = {0.f, 0.f, 0.f, 0.f};
                    X[i] = MFMA16(Tf[i], pack4(y), z); Xb[i] = pack4(X[i]); } }
            DBGF(6, (X[0][0] + X[1][1]) + (X[2][2] + X[3][3]));
            if (w < 4) {
                {   bf16x4 Bf[16]; float pcv[4];
#pragma unroll
                    for (int kb = 0; kb < 4; ++kb) { pcv[kb] = *(const LAS float*)(lds + LA_PC + (16 * kb + c) * 4);
#pragma unroll
                        for (int j = 0; j < 4; ++j) Bf[kb * 4 + j] = *(const LAS bf16x4*)(lds + LA_BTT + ((16 * kb + c) * TP + 16 * j + 4 * q) * 2); }
                    __builtin_amdgcn_sched_barrier(0);
#pragma unroll
                    for (int kb = 0; kb < 4; ++kb) { f32x4 d = {0.f, 0.f, 0.f, 0.f};
#pragma unroll
                        for (int j = 0; j < 4; ++j) d = MFMA16(Xb[j], Bf[kb * 4 + j], d);
                        const int ko = 16 * kb + c; const float pc = pcv[kb];
#pragma unroll
                        for (int r = 0; r < 4; ++r) d[r] = pc * (d[r] + ((16 * w + 4 * q + r) == ko ? 1.f : 0.f));
                        DBGF(7, d[0] + d[1] + d[2] + d[3]);
                        *(bf16x4*)(PHI + ((size_t)chid * 64 + ko) * 64 + 16 * w + 4 * q) = pack4(d); } }
                {   bf16x4 Rf[16]; u32x2 Rt[4];
#pragma unroll
                    for (int tb = 0; tb < 4; ++tb) { Rt[tb] = *(const LAS u32x2*)(lds + LA_RT + ((16 * tb + c) * TP + 16 * w + 4 * q) * 2);
#pragma unroll
                        for (int j = 0; j < 4; ++j) Rf[tb * 4 + j] = *(const LAS bf16x4*)(lds + LA_ARB + ((16 * tb + c) * TP + 16 * j + 4 * q) * 2); }
                    __builtin_amdgcn_sched_barrier(0);
#pragma unroll
                    for (int tb = 0; tb < 4; ++tb) { f32x4 d = unpack4(Rt[tb]);
#pragma unroll
                        for (int j = 0; j < 4; ++j) d = MFMA16(Xb[j], Rf[tb * 4 + j], d);
                        *(bf16x4*)(PSI + ((size_t)chid * 64 + 16 * tb + c) * 64 + 16 * w + 4 * q) = pack4(d); } }
            } else { const int vb = w - 4;
                bf16x4 Vb[4];
#pragma unroll
                for (int j = 0; j < 4; ++j) Vb[j] = *(const LAS bf16x4*)(lds + LA_VT + ((16 * vb + c) * TP + 16 * j + 4 * q) * 2);
                {   bf16x4 Bf[16], Kf[16]; f32x4 pcv[4];
#pragma unroll
                    for (int kb = 0; kb < 4; ++kb) { pcv[kb] = *(const LAS f32x4*)(lds + LA_PC + (16 * kb + 4 * q) * 4);
#pragma unroll
                        for (int j = 0; j < 4; ++j) { Bf[kb * 4 + j] = *(const LAS bf16x4*)(lds + LA_BTT + ((16 * kb + c) * TP + 16 * j + 4 * q) * 2); Kf[kb * 4 + j] = *(const LAS bf16x4*)(lds + LA_KTT + ((16 * kb + c) * TP + 16 * j + 4 * q) * 2); } }
                    __builtin_amdgcn_sched_barrier(0);
#pragma unroll
                    for (int kb = 0; kb < 4; ++kb) { f32x4 d = {0.f, 0.f, 0.f, 0.f};
#pragma unroll
                        for (int j = 0; j < 4; ++j) { d = MFMA16(Bf[kb * 4 + j], Xb[j], d); d = MFMA16(Kf[kb * 4 + j], Vb[j], d); }
                        *(bf16x4*)(GT + ((size_t)chid * 64 + 16 * vb + c) * 64 + 16 * kb + 4 * q) = pack4(d * pcv[kb]); } }
                {   bf16x4 Rf[16], Kf[16];
#pragma unroll
                    for (int tb = 0; tb < 4; ++tb)
#pragma unroll
                        for (int j = 0; j < 4; ++j) { Rf[tb * 4 + j] = *(const LAS bf16x4*)(lds + LA_ARB + ((16 * tb + c) * TP + 16 * j + 4 * q) * 2); Kf[tb * 4 + j] = *(const LAS bf16x4*)(lds + LA_ARK + ((16 * tb + c) * TP + 16 * j + 4 * q) * 2); }
                    __builtin_amdgcn_sched_barrier(0);
#pragma unroll
                    for (int tb = 0; tb < 4; ++tb) { f32x4 d = {0.f, 0.f, 0.f, 0.f};
#pragma unroll
                        for (int j = 0; j < 4; ++j) { d = MFMA16(Rf[tb * 4 + j], Xb[j], d); d = MFMA16(Kf[tb * 4 + j], Vb[j], d); }
                        *(bf16x4*)(Y0T + ((size_t)chid * 64 + 16 * vb + c) * 64 + 16 * tb + 4 * q) = pack4(d); } } }
            if (h < 7) WKVA_RAW_STORE(nraw);
            __syncthreads();
        }
    }
#undef WKVA_RAW_LOAD
#undef WKVA_RAW_STORE
}
__device__ __forceinline__ void phase_wkv_b(Frame& F, const Params& P) {
    const bf16_t* PHI = WSP(bf16_t, WS_PHI); const bf16_t* GT = WSP(bf16_t, WS_GT); bf16_t* MT = WSP(bf16_t, WS_MT);
    LAS unsigned char* lds = F.lds;
    const int lane = F.lane, c = lane & 15, q = lane >> 4, w = F.wave, tid = F.tid;
    const int pair = w >> 2, vb = w & 3; const int bh = (int)blockIdx.x * 2 + pair, b = bh >> 3, h = bh & 7;
    const int lrow = tid >> 3, lcol = (tid & 7) * 16;
    f32x4 M[4];
#pragma unroll
    for (int i = 0; i < 4; ++i) M[i] = (f32x4){0.f, 0.f, 0.f, 0.f};
    u32x4 rA[4], rB[4];
#define WKVB_LD(r_, ckk) do { const int ck_ = (ckk) < 32 ? (ckk) : 31; _Pragma("unroll") for (int ti = 0; ti < 4; ++ti) { const int bh_ = (int)blockIdx.x * 2 + (ti >> 1); \
        const size_t chl_ = (size_t)((bh_ >> 3) * 32 + ck_) * 8 + (bh_ & 7); r_[ti] = *(const u32x4*)(((ti & 1) ? GT : PHI) + chl_ * 4096 + (size_t)tid * 8); } } while (0)
#define WKVB_ST(r_, buf) do { _Pragma("unroll") for (int ti = 0; ti < 4; ++ti) *(LAS u32x4*)(lds + ((buf) * 4 + ti) * TILE_B + lrow * (TP * 2) + lcol) = r_[ti]; } while (0)
#define WKVB_STEP(buf, ckk) do { const size_t chs_ = (size_t)(b * 32 + (ckk)) * 8 + h; bf16x4 Mb[4]; \
        const LAS unsigned char* tp_ = lds + ((buf) * 4 + pair * 2) * TILE_B; const LAS unsigned char* tg_ = tp_ + TILE_B; \
        _Pragma("unroll") for (int i = 0; i < 4; ++i) { Mb[i] = pack4(M[i]); *(bf16x4*)(MT + (chs_ * 64 + 16 * vb + c) * 64 + 16 * i + 4 * q) = Mb[i]; } \
        _Pragma("unroll") for (int i = 0; i < 4; ++i) { f32x4 d = unpack4(*(const LAS u32x2*)(tg_ + (16 * vb + c) * (TP * 2) + (16 * i + 4 * q) * 2)); \
            _Pragma("unroll") for (int j = 0; j < 4; ++j) d = MFMA16(*(const LAS bf16x4*)(tp_ + (16 * i + c) * (TP * 2) + (16 * j + 4 * q) * 2), Mb[j], d); M[i] = d; } } while (0)
    WKVB_LD(rA, 0); WKVB_LD(rB, 1);
    __syncthreads();
    for (int ck = 0; ck < 32; ck += 2) {
        WKVB_ST(rA, 0); __syncthreads(); WKVB_LD(rA, ck + 2); WKVB_STEP(0, ck);
        WKVB_ST(rB, 1); __syncthreads(); WKVB_LD(rB, ck + 3); WKVB_STEP(1, ck + 1);
    }
    __syncthreads();
#undef WKVB_LD
#undef WKVB_ST
#undef WKVB_STEP
}
constexpr int LC_SGL = 0;
constexpr int LC_OT = 13312;
__device__ __forceinline__ void phase_wkv_c(Frame& F, const Params& P, int l) {
    LAS unsigned char* lds = F.lds;
    const bf16_t* rkv = WSP(bf16_t, WS_RKV);
    const bf16_t* gupT = WSP(bf16_t, WS_LORA) + (size_t)11 * 512 * 32 + (size_t)l * 512 * 96;
    const bf16_t* PSI = WSP(bf16_t, WS_PSI); const bf16_t* Y0T = WSP(bf16_t, WS_Y0T); const bf16_t* VT = WSP(bf16_t, WS_VT); const bf16_t* MT = WSP(bf16_t, WS_MT);
    const float* RK = WSP(float, WS_RK); unsigned char* outa = WSP(unsigned char, WS_OUTA);
    const float* mu = P.in[3] + (size_t)l * 1696;
    const int lane = F.lane, h = F.wave;
    LAS unsigned char* ot = lds + LC_OT + h * TILE_B;
    for (int unit = blockIdx.x; unit < T / 64; unit += F.G) {
        int lz = lane; asm volatile("" : "+v"(lz)); const int c = lz & 15, q = lz >> 4;
        float gng[4], gnb[4];
#pragma unroll
        for (int vb = 0; vb < 4; ++vb) { gng[vb] = P.in[15][(size_t)l * 512 + h * 64 + 16 * vb + c]; gnb[vb] = P.in[16][(size_t)l * 512 + h * 64 + 16 * vb + c]; }
        const int t0 = unit * 64; const bool firstchunk = (t0 & (SEQ - 1)) == 0; const size_t chid = (size_t)unit * 8 + h;
        __syncthreads();
        for (int idx = F.tid; idx < 64 * 96; idx += 512) { const int tok = idx / 96, qq = idx % 96; const int col = 1536 + 64 + qq; const int t = t0 + tok;
            const bool hp = (tok > 0 || !firstchunk); const float p = bf2f(rkv[(size_t)t * RKVW + col]); const float ppl = bf2f(rkv[(size_t)(hp ? t - 1 : t) * RKVW + col]); const float pp = hp ? ppl : 0.f;
            *(LAS bf16_t*)(lds + LC_SGL + (tok * 104 + qq) * 2) = f2bf(sigmoidf_(p + (pp - p) * mu[1536 + 64 + qq])); }
        __syncthreads();
        float rkv_[16];
#pragma unroll
        for (int i = 0; i < 16; ++i) rkv_[i] = RK[(size_t)(t0 + 16 * (i >> 2) + 4 * q + (i & 3)) * 8 + h];
        bf16x4 Mf[16];
#pragma unroll
        for (int j = 0; j < 4; ++j)
#pragma unroll
            for (int vb = 0; vb < 4; ++vb) Mf[j * 4 + vb] = *(const bf16x4*)(MT + (chid * 64 + 16 * vb + c) * 64 + 16 * j + 4 * q);
        bf16x8 Gf[12];
#pragma unroll
        for (int vb = 0; vb < 4; ++vb)
#pragma unroll
            for (int ks = 0; ks < 3; ++ks) Gf[vb * 3 + ks] = *(const bf16x8*)(gupT + (size_t)(h * 64 + 16 * vb + c) * 96 + 32 * ks + 8 * q);
#pragma unroll
        for (int tb = 0; tb < 4; ++tb) {
            bf16x4 Pf[4];
#pragma unroll
            for (int j = 0; j < 4; ++j) Pf[j] = *(const bf16x4*)(PSI + (chid * 64 + 16 * tb + c) * 64 + 16 * j + 4 * q);
            f32x4 y[4], gt[4], vv[4];
#pragma unroll
            for (int vb = 0; vb < 4; ++vb) { y[vb] = unpack4(*(const u32x2*)(Y0T + (chid * 64 + 16 * vb + c) * 64 + 16 * tb + 4 * q)); vv[vb] = unpack4(*(const u32x2*)(VT + (chid * 64 + 16 * vb + c) * 64 + 16 * tb + 4 * q));
#pragma unroll
                for (int j = 0; j < 4; ++j) y[vb] = MFMA16(Pf[j], Mf[j * 4 + vb], y[vb]); }
            {   const LAS unsigned char* ar = lds + LC_SGL + ((16 * tb + c) * 104 + 8 * q) * 2;
                const bf16x8 a0 = *(const LAS bf16x8*)(ar), a1 = *(const LAS bf16x8*)(ar + 64), a2 = *(const LAS bf16x8*)(ar + 128);
#pragma unroll
                for (int vb = 0; vb < 4; ++vb) { f32x4 d = {0.f, 0.f, 0.f, 0.f}; d = MFMA32(a0, Gf[vb * 3], d); d = MFMA32(a1, Gf[vb * 3 + 1], d); d = MFMA32(a2, Gf[vb * 3 + 2], d); gt[vb] = d; } }
#pragma unroll
            for (int r = 0; r < 4; ++r) { const int tl = 16 * tb + 4 * q + r;
#if DEBUG_MODE
                { bf16_t* yd = WSP(bf16_t, DBG_YDBG) + (size_t)(t0 + tl) * 512 + h * 64; yd[c] = f2bf(y[0][r]); yd[16 + c] = f2bf(y[1][r]); yd[32 + c] = f2bf(y[2][r]); yd[48 + c] = f2bf(y[3][r]); }
#endif
                const float s = row16_sum((y[0][r] + y[1][r]) + (y[2][r] + y[3][r])); const float mean = s * (1.f / 64.f);
                const float d0 = y[0][r] - mean, d1 = y[1][r] - mean, d2 = y[2][r] - mean, d3 = y[3][r] - mean;
                const float var = row16_sum((d0 * d0 + d1 * d1) + (d2 * d2 + d3 * d3)) * (1.f / 64.f); const float rstd = rsqrtf(var + GN_EPS);
                const float rk = rkv_[tb * 4 + r];
                const float o0 = (d0 * rstd * gng[0] + gnb[0] + rk * vv[0][r]) * gt[0][r], o1 = (d1 * rstd * gng[1] + gnb[1] + rk * vv[1][r]) * gt[1][r];
                const float o2 = (d2 * rstd * gng[2] + gnb[2] + rk * vv[2][r]) * gt[2][r], o3 = (d3 * rstd * gng[3] + gnb[3] + rk * vv[3][r]) * gt[3][r];
                const unsigned pq = pack_fp8x4(4.f * o0, 4.f * o1, 4.f * o2, 4.f * o3);
                *(LAS unsigned char*)(ot + tl * 80 + c) = (unsigned char)pq; *(LAS unsigned char*)(ot + tl * 80 + 16 + c) = (unsigned char)(pq >> 8);
                *(LAS unsigned char*)(ot + tl * 80 + 32 + c) = (unsigned char)(pq >> 16); *(LAS unsigned char*)(ot + tl * 80 + 48 + c) = (unsigned char)(pq >> 24); }
        }
        asm volatile("s_waitcnt lgkmcnt(0)" ::: "memory");
        {   const LAS unsigned char* rowp = ot + lane * 80; unsigned char* dst = outa + (size_t)(t0 + lane) * 512 + h * 64;
#pragma unroll
            for (int m4 = 0; m4 < 4; ++m4) *(u32x4*)(dst + 16 * m4) = *(const LAS u32x4*)(rowp + 16 * m4); }
    }
    __syncthreads();
}
#if DEBUG_MODE
__device__ __forceinline__ void dbg_prep(Frame& F, const Params& P, int l) {
    LAS float* lora = (LAS float*)F.lds;
    const bf16_t* rkv = WSP(bf16_t, WS_RKV);
    const int c = F.tid;
    const float* mu = P.in[3] + (size_t)l * 1696; const float* muv = (l > 0) ? P.in[4] + (size_t)(l - 1) * 32 : nullptr;
    bf16_t* sv = WSP(bf16_t, WS_SV); bf16_t* sa = WSP(bf16_t, WS_SA); bf16_t* sb = WSP(bf16_t, WS_SB); bf16_t* sr = WSP(bf16_t, WS_SR); bf16_t* sk = WSP(bf16_t, WS_SK); bf16_t* sg = WSP(bf16_t, WS_SG);
    float* sw = WSP(float, WS_SW); float* rkb = WSP(float, DBG_RKREF); bf16_t* vfirst = WSP(bf16_t, WS_VFIRST);
    for (int grp = blockIdx.x; grp < T / 64; grp += F.G) {
        const int t0 = grp * 64;
        __syncthreads();
        for (int idx = F.tid; idx < 64 * 192; idx += 512) { const int tok = idx / 192, q = idx % 192; const int t = t0 + tok;
            const float p = bf2f(rkv[(size_t)t * RKVW + 1536 + q]); const float pp = ((t & (SEQ - 1)) != 0) ? bf2f(rkv[(size_t)(t - 1) * RKVW + 1536 + q]) : 0.f;
            const float m_ = (q < 160) ? mu[1536 + q] : (muv ? muv[q - 160] : 0.f);
            float val = p + (pp - p) * m_;
            if (q < 32) val = tanhf(val); else if (q >= 64 && q < 160) val = sigmoidf_(val);
            lora[tok * 192 + q] = val; }
        __syncthreads();
        {
            unsigned cc = c; asm volatile("" : "+v"(cc));
            float col[32]; const float w0 = P.in[5][(size_t)l * 512 + c];
#pragma unroll
            for (int i = 0; i < 32; ++i) col[i] = (P.in[6] + (size_t)l * 32 * 512)[(unsigned)(i * 512) + cc];
            for (int tok = 0; tok < 64; ++tok) { const LAS float* lr = lora + tok * 192; float z = w0;
#pragma unroll
                for (int i = 0; i < 32; ++i) z += lr[i] * col[i];
                sw[(size_t)(t0 + tok) * 512 + c] = __expf(-0.6065306597126334f * sigmoidf_(z)); }
            asm volatile("" ::: "memory"); }
        {
            unsigned cc = c; asm volatile("" : "+v"(cc));
            float col[32]; const float a0 = P.in[7][(size_t)l * 512 + c];
            const float mu_r = mu[c], mu_k = mu[512 + c];
            const float k_k = P.in[12][(size_t)l * 512 + c], k_a = P.in[13][(size_t)l * 512 + c], r_k = P.in[14][(size_t)l * 512 + c];
#pragma unroll
            for (int i = 0; i < 32; ++i) col[i] = (P.in[8] + (size_t)l * 32 * 512)[(unsigned)(i * 512) + cc];
            for (int tok = 0; tok < 64; ++tok) { const int t = t0 + tok; const bool first = (t & (SEQ - 1)) == 0;
                const size_t ro = (size_t)t * RKVW, rp = (size_t)(t - 1) * RKVW;
                const float pr = bf2f(rkv[ro + c]), pk = bf2f(rkv[ro + 512 + c]);
                const float qr = first ? 0.f : bf2f(rkv[rp + c]), qk = first ? 0.f : bf2f(rkv[rp + 512 + c]);
                const float r = pr + (qr - pr) * mu_r, k = pk + (qk - pk) * mu_k;
                const LAS float* lr = lora + tok * 192 + 32; float z = a0;
#pragma unroll
                for (int i = 0; i < 32; ++i) z += lr[i] * col[i];
                const float iclr = sigmoidf_(z);
                float kk = k * k_k; const float ss = wave_sum(kk * kk); kk = kk / fmaxf(sqrtf(ss), 1e-12f);
                const float kh = k * (1.0f + (iclr - 1.0f) * k_a);
                const float rks = wave_sum(r * kh * r_k);
                const size_t o = (size_t)t * 512 + c;
                sr[o] = f2bf(r); sk[o] = f2bf(kh); sa[o] = f2bf(-kk); sb[o] = f2bf(kk * iclr);
                if (F.lane == 0) rkb[(size_t)t * 8 + F.wave] = rks; }
            asm volatile("" ::: "memory"); }
        {
            unsigned cc = c; asm volatile("" : "+v"(cc));
            float col[32]; const float v0 = (l > 0) ? P.in[10][(size_t)(l - 1) * 512 + c] : 0.f; const float mu_v = mu[1024 + c];
#pragma unroll
            for (int i = 0; i < 32; ++i) col[i] = (l > 0) ? (P.in[11] + (size_t)(l - 1) * 32 * 512)[(unsigned)(i * 512) + cc] : 0.f;
            for (int tok = 0; tok < 64; ++tok) { const int t = t0 + tok; const bool first = (t & (SEQ - 1)) == 0;
                const float pv = bf2f(rkv[(size_t)t * RKVW + 1024 + c]); const float qv = first ? 0.f : bf2f(rkv[(size_t)(t - 1) * RKVW + 1024 + c]);
                float v = pv + (qv - pv) * mu_v;
                const size_t o = (size_t)t * 512 + c;
                if (l == 0) vfirst[o] = f2bf(v);
                else { const LAS float* lr = lora + tok * 192 + 160; float z = v0;
#pragma unroll
                    for (int i = 0; i < 32; ++i) z += lr[i] * col[i];
                    v = v + (bf2f(vfirst[o]) - v) * sigmoidf_(z); }
                sv[o] = f2bf(v); }
            asm volatile("" ::: "memory"); }
        {
            unsigned cc = c; asm volatile("" : "+v"(cc));
            float col[96];
#pragma unroll
            for (int i = 0; i < 96; ++i) col[i] = (P.in[9] + (size_t)l * 96 * 512)[(unsigned)(i * 512) + cc];
            for (int tok = 0; tok < 64; ++tok) { const LAS float* lr = lora + tok * 192 + 64; float g = 0.f;
#pragma unroll
                for (int i = 0; i < 96; ++i) g += lr[i] * col[i];
                sg[(size_t)(t0 + tok) * 512 + c] = f2bf(g); }
            asm volatile("" ::: "memory"); }
    }
    __syncthreads();
}
__device__ __forceinline__ void dbg_scan(Frame& F, const Params& P, int l, int wg0, int nwg) {
    constexpr int CH = 32;
    LAS float* buf = (LAS float*)F.lds;
    LAS float* ybuf = (LAS float*)(F.lds + 2 * 6 * CH * 64 * 4);
    const bf16_t* sv = WSP(bf16_t, WS_SV); const bf16_t* sa = WSP(bf16_t, WS_SA); const bf16_t* sb = WSP(bf16_t, WS_SB); const bf16_t* sr = WSP(bf16_t, WS_SR); const bf16_t* sk = WSP(bf16_t, WS_SK); const bf16_t* sg = WSP(bf16_t, WS_SG);
    const float* sw = WSP(float, WS_SW); const float* rkb = WSP(float, DBG_RKREF); bf16_t* outa = WSP(bf16_t, DBG_OUTAREF);
    const float* gn_g = P.in[15] + (size_t)l * 512; const float* gn_b = P.in[16] + (size_t)l * 512;
    int bh0 = __builtin_amdgcn_readfirstlane((int)blockIdx.x - wg0);
    for (int bh = bh0; bh < 128; bh += nwg) {
        const int b = bh >> 3, h = bh & 7; const size_t tb = (size_t)b * SEQ;
        const int ltok = F.tid >> 4, lch = (F.tid & 15) * 4;
        float S[8];
#pragma unroll
        for (int j = 0; j < 8; ++j) S[j] = 0.f;
        const int i8 = F.lane >> 3, seg = F.lane & 7, vrow = 8 * F.wave + i8;
        u32x2 pre_b[5]; f32x4 pre_w;
        __syncthreads();
        {   const size_t o = (tb + ltok) * 512 + h * 64 + lch;
            pre_b[0] = *(const u32x2*)(sr + o); pre_b[1] = *(const u32x2*)(sk + o); pre_b[2] = *(const u32x2*)(sv + o); pre_b[3] = *(const u32x2*)(sa + o); pre_b[4] = *(const u32x2*)(sb + o); pre_w = *(const f32x4*)(sw + o);
            LAS float* d = buf + ltok * 64 + lch;
#pragma unroll
            for (int a = 0; a < 5; ++a) { *(LAS f32x4*)(d + a * CH * 64) = (f32x4){bflo(pre_b[a].x), bfhi(pre_b[a].x), bflo(pre_b[a].y), bfhi(pre_b[a].y)}; }
            *(LAS f32x4*)(d + 5 * CH * 64) = pre_w; }
        __syncthreads();
        for (int ck = 0; ck < SEQ / CH; ++ck) {
            const int cur = ck & 1; const LAS float* cb = buf + cur * 6 * CH * 64;
            if (ck + 1 < SEQ / CH) { const size_t o = (tb + (ck + 1) * CH + ltok) * 512 + h * 64 + lch;
                pre_b[0] = *(const u32x2*)(sr + o); pre_b[1] = *(const u32x2*)(sk + o); pre_b[2] = *(const u32x2*)(sv + o); pre_b[3] = *(const u32x2*)(sa + o); pre_b[4] = *(const u32x2*)(sb + o); pre_w = *(const f32x4*)(sw + o); }
            if ((ck & 1) == 0) { float* mr = WSP(float, DBG_MREF) + ((size_t)((b * 32 + (ck >> 1)) * 8 + h)) * 4096;
#pragma unroll
                for (int j = 0; j < 8; ++j) mr[(size_t)(8 * seg + j) * 64 + vrow] = S[j]; }
            for (int tok = 0; tok < CH; ++tok) {
                const LAS float* p = cb + tok * 64 + seg * 8;
                const f32x4 r0 = *(const LAS f32x4*)(p), r1 = *(const LAS f32x4*)(p + 4);
                const f32x4 k0 = *(const LAS f32x4*)(p + CH * 64), k1 = *(const LAS f32x4*)(p + CH * 64 + 4);
                const float vv = cb[2 * CH * 64 + tok * 64 + vrow];
                const f32x4 a0 = *(const LAS f32x4*)(p + 3 * CH * 64), a1 = *(const LAS f32x4*)(p + 3 * CH * 64 + 4);
                const f32x4 b0 = *(const LAS f32x4*)(p + 4 * CH * 64), b1 = *(const LAS f32x4*)(p + 4 * CH * 64 + 4);
                const f32x4 w0 = *(const LAS f32x4*)(p + 5 * CH * 64), w1 = *(const LAS f32x4*)(p + 5 * CH * 64 + 4);
                float sa_ = 0.f;
#pragma unroll
                for (int j = 0; j < 4; ++j) { sa_ += S[j] * a0[j]; sa_ += S[4 + j] * a1[j]; }
                sa_ = reduce8(sa_);
                float y = 0.f;
#pragma unroll
                for (int j = 0; j < 4; ++j) { S[j] = S[j] * w0[j] + (sa_ * b0[j] + vv * k0[j]); S[4 + j] = S[4 + j] * w1[j] + (sa_ * b1[j] + vv * k1[j]); y += S[j] * r0[j]; y += S[4 + j] * r1[j]; }
                y = reduce8(y);
                if (seg == 0) ybuf[tok * 64 + vrow] = y;
            }
            __syncthreads();
            {
                const int tok = F.tid >> 4, vq = (F.tid & 15) * 4; const size_t t = tb + (size_t)ck * CH + tok;
                const f32x4 yv = *(const LAS f32x4*)(ybuf + tok * 64 + vq);
                { u32x2 wy; wy.x = cvt_pk_bf16(yv[0], yv[1]); wy.y = cvt_pk_bf16(yv[2], yv[3]); *(u32x2*)(WSP(bf16_t, DBG_YREF) + t * 512 + h * 64 + vq) = wy; }
                float s = (yv[0] + yv[1]) + (yv[2] + yv[3]);
                s += __shfl_xor(s, 1); s += __shfl_xor(s, 2); s += __shfl_xor(s, 4); s += __shfl_xor(s, 8);
                const float mean = s * (1.f / 64.f);
                const f32x4 dv = yv - mean; float q = (dv[0] * dv[0] + dv[1] * dv[1]) + (dv[2] * dv[2] + dv[3] * dv[3]);
                q += __shfl_xor(q, 1); q += __shfl_xor(q, 2); q += __shfl_xor(q, 4); q += __shfl_xor(q, 8);
                const float rstd = rsqrtf(q * (1.f / 64.f) + GN_EPS);
                const float rk = rkb[t * 8 + h];
                const f32x4 vv = *(const LAS f32x4*)(cb + 2 * CH * 64 + tok * 64 + vq);
                const f32x4 gg = *(const f32x4*)(gn_g + h * 64 + vq), gb = *(const f32x4*)(gn_b + h * 64 + vq);
                const u32x2 gt = *(const u32x2*)(sg + t * 512 + h * 64 + vq);
                float o[4]; const float gtf[4] = {bflo(gt.x), bfhi(gt.x), bflo(gt.y), bfhi(gt.y)};
#pragma unroll
                for (int j = 0; j < 4; ++j) o[j] = (dv[j] * rstd * gg[j] + gb[j] + rk * vv[j]) * gtf[j];
                u32x2 w; w.x = cvt_pk_bf16(o[0], o[1]); w.y = cvt_pk_bf16(o[2], o[3]);
                *(u32x2*)(outa + t * 512 + h * 64 + vq) = w; }
            if (ck + 1 < SEQ / CH) { LAS float* d = buf + (cur ^ 1) * 6 * CH * 64 + ltok * 64 + lch;
#pragma unroll
                for (int a = 0; a < 5; ++a) { *(LAS f32x4*)(d + a * CH * 64) = (f32x4){bflo(pre_b[a].x), bfhi(pre_b[a].x), bflo(pre_b[a].y), bfhi(pre_b[a].y)}; }
                *(LAS f32x4*)(d + 5 * CH * 64) = pre_w; }
            __syncthreads();
        }
    }
}

template <class TA, class TB> __device__ __forceinline__ void dbg_compare(Frame& F, const TA* a, const TB* b, size_t n, unsigned* ctl, int mode_transpose64) {
    float num = 0.f, den = 0.f;
    for (size_t i = (size_t)blockIdx.x * 512 + F.tid; i < n; i += (size_t)F.G * 512) {
        size_t ia = i;
        if (mode_transpose64) { const size_t tile = i >> 12, rem = i & 4095, r = rem >> 6, c2 = rem & 63; ia = (tile << 12) + c2 * 64 + r; }
        float x, y;
        if (sizeof(TA) == 2) x = bf2f(((const bf16_t*)a)[ia]); else x = ((const float*)a)[ia];
        if (sizeof(TB) == 2) y = bf2f(((const bf16_t*)b)[i]); else y = ((const float*)b)[i];
        const float d = x - y; num += d * d; den += y * y; }
    num = wave_sum(num); den = wave_sum(den);
    LAS float* red = (LAS float*)F.lds;
    __syncthreads();
    if (F.lane == 0) { red[F.wave * 2] = num; red[F.wave * 2 + 1] = den; }
    __syncthreads();
    if (F.tid == 0) { float n2 = 0.f, d2 = 0.f; for (int w8 = 0; w8 < 8; ++w8) { n2 += red[w8 * 2]; d2 += red[w8 * 2 + 1]; }
        ((float*)ctl)[1024 + 2 * blockIdx.x] = n2; ((float*)ctl)[1025 + 2 * blockIdx.x] = d2; }
}

constexpr size_t DBG_BF = WS_CONVH;
__device__ __forceinline__ void dbg_bruteforce(Frame& F) {
    LAS float* Ph = (LAS float*)F.lds; LAS float* Gm = Ph + 64 * 65; LAS float* vec = Gm + 64 * 65; LAS float* s1 = vec + 6 * 64; LAS float* s2 = s1 + 64;
    const bf16_t* sv = WSP(bf16_t, WS_SV); const bf16_t* sa = WSP(bf16_t, WS_SA); const bf16_t* sb = WSP(bf16_t, WS_SB); const bf16_t* sr = WSP(bf16_t, WS_SR); const bf16_t* sk = WSP(bf16_t, WS_SK); const float* sw = WSP(float, WS_SW);
    float* out = WSP(float, DBG_BF);
    const int chid = blockIdx.x, unit = chid >> 3, h = chid & 7, t0 = unit * 64;
    const int k = F.tid >> 3, j0 = (F.tid & 7) * 8;
    for (int e = 0; e < 8; ++e) { Ph[k * 65 + j0 + e] = (k == j0 + e) ? 1.f : 0.f; Gm[k * 65 + j0 + e] = 0.f; }
    __syncthreads();
    for (int t = 0; t < 64; ++t) {
        if (F.tid < 384) { const int a = F.tid >> 6, ch = F.tid & 63; const size_t o = (size_t)(t0 + t) * 512 + h * 64 + ch;
            float x; if (a == 0) x = sw[o]; else if (a == 1) x = bf2f(sa[o]); else if (a == 2) x = bf2f(sb[o]); else if (a == 3) x = bf2f(sk[o]); else if (a == 4) x = bf2f(sv[o]); else x = bf2f(sr[o]);
            vec[a * 64 + ch] = x; }
        __syncthreads();
        if (F.tid < 64) { float s = 0.f; for (int kk = 0; kk < 64; ++kk) s += vec[64 + kk] * Ph[kk * 65 + F.tid]; s1[F.tid] = s; }
        else if (F.tid < 128) { const int j = F.tid - 64; float s = 0.f; for (int kk = 0; kk < 64; ++kk) s += vec[64 + kk] * Gm[kk * 65 + j]; s2[j] = s; }
        __syncthreads();
        for (int e = 0; e < 8; ++e) { const int j = j0 + e; Ph[k * 65 + j] = vec[k] * Ph[k * 65 + j] + vec[128 + k] * s1[j]; Gm[k * 65 + j] = vec[k] * Gm[k * 65 + j] + vec[128 + k] * s2[j] + vec[192 + k] * vec[256 + j]; }
        __syncthreads();
        if (F.tid < 64) { float s = 0.f; for (int kk = 0; kk < 64; ++kk) s += vec[320 + kk] * Ph[kk * 65 + F.tid]; out[((size_t)(2 * 256 + chid) * 64 + t) * 64 + F.tid] = s; }
        else if (F.tid < 128) { const int j = F.tid - 64; float s = 0.f; for (int kk = 0; kk < 64; ++kk) s += vec[320 + kk] * Gm[kk * 65 + j]; out[((size_t)(3 * 256 + chid) * 64 + t) * 64 + j] = s; }
    }
    __syncthreads();
    for (int e = 0; e < 8; ++e) { out[((size_t)(0 * 256 + chid) * 64 + k) * 64 + j0 + e] = Ph[k * 65 + j0 + e]; out[((size_t)(1 * 256 + chid) * 64 + k) * 64 + j0 + e] = Gm[k * 65 + j0 + e]; }
}
__device__ __forceinline__ void dbg_compare_vt(Frame& F, unsigned* ctl) {
    const bf16_t* VT = WSP(bf16_t, WS_VT); const bf16_t* sv = WSP(bf16_t, WS_SV); float num = 0.f, den = 0.f;
    for (size_t i = (size_t)blockIdx.x * 512 + F.tid; i < (size_t)T * 512; i += (size_t)F.G * 512) { const size_t t = i >> 9, cg = i & 511, hh = cg >> 6, ch = cg & 63; const size_t chid = (t >> 6) * 8 + hh;
        const float x = bf2f(VT[(chid * 64 + ch) * 64 + (t & 63)]), y = bf2f(sv[i]); const float d = x - y; num += d * d; den += y * y; }
    num = wave_sum(num); den = wave_sum(den);
    LAS float* red = (LAS float*)F.lds; __syncthreads(); if (F.lane == 0) { red[F.wave * 2] = num; red[F.wave * 2 + 1] = den; } __syncthreads();
    if (F.tid == 0) { float n2 = 0.f, d2 = 0.f; for (int w8 = 0; w8 < 8; ++w8) { n2 += red[w8 * 2]; d2 += red[w8 * 2 + 1]; } ((float*)ctl)[1024 + 2 * blockIdx.x] = n2; ((float*)ctl)[1025 + 2 * blockIdx.x] = d2; }
}
#endif
__device__ __forceinline__ void phase_sgu(Frame& F, const Params& P, int l, int wg0, int nwg) {
    LAS unsigned char* vt = F.lds;
    const bf16_t* z = WSP(bf16_t, WS_SGUZ); unsigned char* hb = WSP(unsigned char, WS_HB);
    const bf16_t* Wm = WSP(bf16_t, WS_SGUW) + (size_t)l * 4 * 128 * 128;
    const float* bs = P.in[21] + (size_t)l * 4 * 128;
    int u0 = __builtin_amdgcn_readfirstlane((int)blockIdx.x - wg0);
    for (int u = u0; u < T / 128; u += nwg) {
        int uu = u; asm volatile("" : "+v"(uu)); uu = __builtin_amdgcn_readfirstlane(uu);
        int lz = F.lane; asm volatile("" : "+v"(lz));
        const size_t t0 = (size_t)uu * 128;
        __syncthreads();
        {
            float lg[4], lb[4];
#pragma unroll
            for (int e = 0; e < 4; ++e) { lg[e] = P.in[18][(size_t)l * 256 + lz + 64 * e]; lb[e] = P.in[19][(size_t)l * 256 + lz + 64 * e]; }
            float vall[16][4];
#pragma unroll
            for (int i = 0; i < 16; ++i) { const bf16_t* zr = z + (t0 + F.wave * 16 + i) * 512 + 256 + lz;
#pragma unroll
                for (int e = 0; e < 4; ++e) vall[i][e] = bf2f(zr[64 * e]); }
#pragma unroll
            for (int i = 0; i < 16; ++i) { const int tok = F.wave * 16 + i;
                float v[4];
#pragma unroll
                for (int e = 0; e < 4; ++e) v[e] = vall[i][e];
                const float mean = wave_sum((v[0] + v[1]) + (v[2] + v[3])) * (1.f / 256.f);
#pragma unroll
                for (int e = 0; e < 4; ++e) v[e] -= mean;
                const float rstd = rsqrtf(wave_sum((v[0] * v[0] + v[1] * v[1]) + (v[2] * v[2] + v[3] * v[3])) * (1.f / 256.f) + LN_EPS);
#pragma unroll
                for (int e = 0; e < 4; ++e) { const int ch = lz + 64 * e; *(LAS bf16_t*)(vt + ch * 256 + ((((tok >> 3) ^ (ch & 15)) << 4) | ((tok & 7) << 1))) = f2bf(v[e] * rstd * lg[e] + lb[e]); } } }
        __syncthreads();
        {   const int c = lz & 15, qd = lz >> 4, g = F.wave >> 1, sel = F.wave & 1;
            const bf16_t* Wg = Wm + (size_t)g * 128 * 128;
            f32x4 acc[4][4];
#pragma unroll
            for (int pi = 0; pi < 4; ++pi)
#pragma unroll
                for (int db = 0; db < 4; ++db) acc[pi][db] = (f32x4){0.f, 0.f, 0.f, 0.f};
#pragma unroll
            for (int ks = 0; ks < 4; ++ks) {
                bf16x8 af[4];
#pragma unroll
                for (int db = 0; db < 4; ++db) { const int ch = 64 * g + 16 * db + c; af[db] = *(const LAS bf16x8*)(vt + ch * 256 + (((4 * ks + qd) ^ (ch & 15)) << 4)); }
#pragma unroll
                for (int pi = 0; pi < 4; ++pi) { const int pb = sel ? ((pi == 0) ? 1 : (pi == 1) ? 2 : (pi == 2) ? 5 : 6) : ((pi == 0) ? 0 : (pi == 1) ? 3 : (pi == 2) ? 4 : 7);
                    if (32 * ks <= 16 * pb + 15) { const bf16x8 bfr = *(const bf16x8*)(Wg + (size_t)(16 * pb + c) * 128 + 32 * ks + 8 * qd);
#pragma unroll
                        for (int db = 0; db < 4; ++db) acc[pi][db] = MFMA32(af[db], bfr, acc[pi][db]); } } }
            u32x2 uraw[4][4]; float biasv[4];
#pragma unroll
            for (int pi = 0; pi < 4; ++pi) { const int pb = sel ? ((pi == 0) ? 1 : (pi == 1) ? 2 : (pi == 2) ? 5 : 6) : ((pi == 0) ? 0 : (pi == 1) ? 3 : (pi == 2) ? 4 : 7);
                const int p = 16 * pb + c; biasv[pi] = bs[g * 128 + p];
#pragma unroll
                for (int db = 0; db < 4; ++db) uraw[pi][db] = *(const u32x2*)(z + (t0 + p) * 512 + 64 * g + 16 * db + 4 * qd); }
#pragma unroll
            for (int pi = 0; pi < 4; ++pi) { const int pb = sel ? ((pi == 0) ? 1 : (pi == 1) ? 2 : (pi == 2) ? 5 : 6) : ((pi == 0) ? 0 : (pi == 1) ? 3 : (pi == 2) ? 4 : 7);
                const size_t t = t0 + 16 * pb + c;
#pragma unroll
                for (int db = 0; db < 4; ++db) { const int ch = 64 * g + 16 * db + 4 * qd;
                    const f32x4 o = unpack4(uraw[pi][db]) * (acc[pi][db] + biasv[pi]) * 4.f; *(unsigned*)(hb + t * 256 + ch) = pack_fp8x4(o[0], o[1], o[2], o[3]); } } }
    }
    __syncthreads();
}
__device__ __forceinline__ void phase_conv(Frame& F, const Params& P, int l, int wg0, int nwg) {
    LAS float* cv = (LAS float*)F.lds;
    const bf16_t* hin = WSP(bf16_t, WS_CONVH); unsigned char* hc = WSP(unsigned char, WS_HC);
    const float* dw = P.in[23] + (size_t)l * 31 * 256; const float* db = P.in[24] + (size_t)l * 256;
    const float* lg = P.in[25] + (size_t)l * 256; const float* lb = P.in[26] + (size_t)l * 256;
    int u0 = __builtin_amdgcn_readfirstlane((int)blockIdx.x - wg0);
    for (int u = u0; u < T / 64; u += nwg) {
        int tz = F.tid; asm volatile("" : "+v"(tz)); const int ch = tz & 255, hf = tz >> 8, lz = tz & 63;
        float kw[31];
#pragma unroll
        for (int j = 0; j < 31; ++j) kw[j] = dw[j * 256 + ch];
        const float bias = db[ch];
        const int t0 = u * 64 + hf * 32; const int s0 = t0 & (SEQ - 1);
        __syncthreads();
        float x[38];
#pragma unroll
        for (int m = 0; m < 30; ++m) { const int s = s0 - 30 + m; const float ld = bf2f(hin[(size_t)(t0 - 30 + m + (s >= 0 ? 0 : 30)) * 256 + ch]); x[m] = (s >= 0) ? ld : 0.f; }
#pragma unroll
        for (int g8 = 0; g8 < 4; ++g8) {
#pragma unroll
            for (int m = 0; m < 8; ++m) x[30 + m] = bf2f(hin[(size_t)(t0 + 8 * g8 + m) * 256 + ch]);
#pragma unroll
            for (int i = 0; i < 8; ++i) { float a = bias;
#pragma unroll
                for (int j = 0; j < 31; ++j) a += kw[j] * x[i + j];
                cv[(hf * 32 + 8 * g8 + i) * 256 + ch] = a; }
#pragma unroll
            for (int m = 0; m < 30; ++m) x[m] = x[m + 8]; }
        __syncthreads();
        {   const f32x4 g = *(const f32x4*)(lg + lz * 4), bb = *(const f32x4*)(lb + lz * 4);
            for (int i = 0; i < 8; ++i) { const int tok = F.wave * 8 + i; f32x4 v = *(const LAS f32x4*)(cv + tok * 256 + lz * 4);
                const float mean = wave_sum((v[0] + v[1]) + (v[2] + v[3])) * (1.f / 256.f);
                v = v - mean; const float var = wave_sum((v[0] * v[0] + v[1] * v[1]) + (v[2] * v[2] + v[3] * v[3])) * (1.f / 256.f);
                const float rstd = rsqrtf(var + LN_EPS);
                v = v * rstd * g + bb;
                float o[4];
#pragma unroll
                for (int j = 0; j < 4; ++j) o[j] = v[j] * sigmoidf_(v[j]);
                *(unsigned*)(hc + (size_t)(u * 64 + tok) * 256 + lz * 4) = pack_fp8x4(4.f * o[0], 4.f * o[1], 4.f * o[2], 4.f * o[3]); } }
    }
    __syncthreads();
}
__device__ __forceinline__ void ln_load16(const bf16_t* p, float (&v)[16]) {
    const u32x4 a = *(const u32x4*)p, b = *(const u32x4*)(p + 8);
    v[0] = bflo(a.x); v[1] = bfhi(a.x); v[2] = bflo(a.y); v[3] = bfhi(a.y); v[4] = bflo(a.z); v[5] = bfhi(a.z); v[6] = bflo(a.w); v[7] = bfhi(a.w);
    v[8] = bflo(b.x); v[9] = bfhi(b.x); v[10] = bflo(b.y); v[11] = bfhi(b.y); v[12] = bflo(b.z); v[13] = bfhi(b.z); v[14] = bflo(b.w); v[15] = bfhi(b.w);
}
__device__ __forceinline__ void ln_norm16(float (&v)[16], const float* g, const float* b, int lane) {
    float s = 0.f;
#pragma unroll
    for (int j = 0; j < 16; ++j) s += v[j];
    const float mean = wave_sum(s) * (1.f / 1024.f); float q = 0.f;
#pragma unroll
    for (int j = 0; j < 16; ++j) { v[j] -= mean; q += v[j] * v[j]; }
    const float rstd = rsqrtf(wave_sum(q) * (1.f / 1024.f) + LN_EPS);
#pragma unroll
    for (int j4 = 0; j4 < 4; ++j4) { const f32x4 gg = *(const f32x4*)(g + lane * 16 + j4 * 4), bb = *(const f32x4*)(b + lane * 16 + j4 * 4);
#pragma unroll
        for (int j = 0; j < 4; ++j) v[j4 * 4 + j] = v[j4 * 4 + j] * rstd * gg[j] + bb[j]; }
}
__device__ __forceinline__ void ln_store16(bf16_t* p, const float (&v)[16]) {
    u32x4 a, b; a.x = cvt_pk_bf16(v[0], v[1]); a.y = cvt_pk_bf16(v[2], v[3]); a.z = cvt_pk_bf16(v[4], v[5]); a.w = cvt_pk_bf16(v[6], v[7]);
    b.x = cvt_pk_bf16(v[8], v[9]); b.y = cvt_pk_bf16(v[10], v[11]); b.z = cvt_pk_bf16(v[12], v[13]); b.w = cvt_pk_bf16(v[14], v[15]);
    *(u32x4*)p = a; *(u32x4*)(p + 8) = b;
}
__device__ __forceinline__ void ln_load16q(const unsigned char* p, float (&v)[16]) {
    const u32x4 a = *(const u32x4*)p; const unsigned w[4] = {a.x, a.y, a.z, a.w};
#pragma unroll
    for (int i = 0; i < 4; ++i) { const f32x2 lo = __builtin_amdgcn_cvt_pk_f32_fp8((int)w[i], false), hi = __builtin_amdgcn_cvt_pk_f32_fp8((int)w[i], true); v[4 * i] = lo[0]; v[4 * i + 1] = lo[1]; v[4 * i + 2] = hi[0]; v[4 * i + 3] = hi[1]; }
}
__device__ __forceinline__ void ln_store16q(unsigned char* p, const float (&v)[16]) {
    u32x4 a; a.x = pack_fp8x4(v[0], v[1], v[2], v[3]); a.y = pack_fp8x4(v[4], v[5], v[6], v[7]); a.z = pack_fp8x4(v[8], v[9], v[10], v[11]); a.w = pack_fp8x4(v[12], v[13], v[14], v[15]);
    *(u32x4*)p = a;
}
__device__ __forceinline__ void phase_ln1(Frame& F, const Params& P, int l, int wg0, int nwg, int row_lo, int row_hi) {
    const bf16_t* pre = WSP(bf16_t, WS_PRE); const float* stats = WSP(float, WS_STATS);
    const float* g = P.in[29] + (size_t)l * 1024; const float* b = P.in[30] + (size_t)l * 1024;
    const int gw = ((int)blockIdx.x - wg0) * 8 + F.wave, NGW = nwg * 8;
    float gg[16], bb[16];
#pragma unroll
    for (int j4 = 0; j4 < 4; ++j4) { const f32x4 g4 = *(const f32x4*)(g + F.lane * 16 + j4 * 4), b4 = *(const f32x4*)(b + F.lane * 16 + j4 * 4);
#pragma unroll
        for (int j = 0; j < 4; ++j) { gg[j4 * 4 + j] = g4[j]; bb[j4 * 4 + j] = b4[j]; } }
    for (int row = row_lo + gw; row < row_hi; row += NGW) { float v[16]; ln_load16(pre + (size_t)row * 1024 + F.lane * 16, v);
        const f32x2 sl = *(const f32x2*)(stats + ((size_t)row * 16 + (F.lane & 15)) * 2);
        const float mean = row16_sum(sl[0]) * (1.f / 1024.f), ex2 = row16_sum(sl[1]) * (1.f / 1024.f);
        const float rstd = rsqrtf(fmaxf(ex2 - mean * mean, 0.f) + LN_EPS);
#pragma unroll
        for (int j = 0; j < 16; ++j) v[j] = (v[j] - mean) * rstd * gg[j] + bb[j];
        ln_store16q(WSP(unsigned char, WS_X1Q) + (size_t)row * 1024 + F.lane * 16, v); }
}
__device__ __forceinline__ void phase_ln2(Frame& F, const Params& P, int l) {
    const bf16_t* pre = WSP(bf16_t, WS_PRE); const float* stats = WSP(float, WS_STATS); const unsigned char* Y = WSP(unsigned char, WS_Y); bf16_t* x = WSP(bf16_t, WS_X); const int* inv = WSP(int, WS_GATEV);
    const float* g = P.in[36] + (size_t)l * 1024; const float* b = P.in[37] + (size_t)l * 1024; const float* g1 = P.in[29] + (size_t)l * 1024; const float* b1 = P.in[30] + (size_t)l * 1024;
    const int gw = blockIdx.x * 8 + F.wave, NGW = F.G * 8;
    int n0 = inv[2 * gw], n1 = inv[2 * gw + 1];
#pragma unroll 1
    for (int row = gw; row < T; row += NGW) { float v[16], y0[16], y1[16];
        const int c0 = __builtin_amdgcn_readfirstlane(n0), c1 = __builtin_amdgcn_readfirstlane(n1);
        { const int rn = (row + NGW < T) ? row + NGW : row; n0 = inv[2 * rn]; n1 = inv[2 * rn + 1]; }
        ln_load16(pre + (size_t)row * 1024 + F.lane * 16, v); ln_load16q(Y + (size_t)c0 * 1024 + F.lane * 16, y0); ln_load16q(Y + (size_t)c1 * 1024 + F.lane * 16, y1);
        {   const f32x2 sl = *(const f32x2*)(stats + ((size_t)row * 16 + (F.lane & 15)) * 2);
            const float mean = row16_sum(sl[0]) * (1.f / 1024.f), ex2 = row16_sum(sl[1]) * (1.f / 1024.f); const float rstd = rsqrtf(fmaxf(ex2 - mean * mean, 0.f) + LN_EPS);
#pragma unroll
            for (int j4 = 0; j4 < 4; ++j4) { const f32x4 g4 = *(const f32x4*)(g1 + F.lane * 16 + j4 * 4), b4 = *(const f32x4*)(b1 + F.lane * 16 + j4 * 4);
#pragma unroll
                for (int j = 0; j < 4; ++j) v[j4 * 4 + j] = (v[j4 * 4 + j] - mean) * rstd * g4[j] + b4[j]; } }
#pragma unroll
        for (int j = 0; j < 16; ++j) v[j] = ALPHA * v[j] + 0.125f * (y0[j] + y1[j]);
        ln_norm16(v, g, b, F.lane);
        if (l == NL - 1) { float* o = F.out + (size_t)row * 1024 + F.lane * 16;
#pragma unroll
            for (int j4 = 0; j4 < 4; ++j4) *(f32x4*)(o + j4 * 4) = (f32x4){v[j4 * 4], v[j4 * 4 + 1], v[j4 * 4 + 2], v[j4 * 4 + 3]}; }
        else { ln_store16(x + (size_t)row * 1024 + F.lane * 16, v); ln_store16q(WSP(unsigned char, WS_XQ) + (size_t)row * 1024 + F.lane * 16, v); } }
}

#define PHASE_PROLOGUE() const Params P = KPARAMS(); Frame F = make_frame(P.ws, P.out); unsigned* ctl = (unsigned*)(F.ws + WS_CTL); (void)ctl
__device__ __forceinline__ void ph_prologue_a() { PHASE_PROLOGUE(); phase_convert_static(F, P); __syncthreads(); }
__device__ __forceinline__ void ph_prologue_b() { PHASE_PROLOGUE(); phase_convert_lora(F, P); phase_convert_sgu(F, P); phase_convert_router(F, P); __syncthreads(); }
__device__ __forceinline__ void ph_prologue_c() { PHASE_PROLOGUE(); phase_x_to_bf16(F, P); __syncthreads(); }
__device__ __forceinline__ void ph_prologue() { PHASE_PROLOGUE(); phase_convert_static(F, P); phase_convert_lora(F, P); phase_convert_sgu(F, P); phase_convert_router(F, P); phase_x_to_bf16(F, P); phase_convert_moe(F, P, 0); __syncthreads(); }
__device__ __forceinline__ void ph_inproj(int l) { PHASE_PROLOGUE();
    SchedInproj S{(const char*)WSP(unsigned char, WS_XQ), (const char*)(WSP(unsigned char, WS_WIN) + (size_t)l * NIN * 1024), F.G, (int)blockIdx.x};
    EpiInproj E{WSP(bf16_t, WS_RKV), WSP(bf16_t, WS_SGUZ), WSP(bf16_t, WS_CONVH), WSP(unsigned char, WS_GATES)};
    ge::gemm_phase<SchedInproj, EpiInproj, true>(F.lds, S, E); }
__device__ __forceinline__ void ph_inproj_null(int l) { PHASE_PROLOGUE();
    SchedInproj S{(const char*)WSP(unsigned char, WS_XQ), (const char*)(WSP(unsigned char, WS_WIN) + (size_t)l * NIN * 1024), F.G, (int)blockIdx.x};
    EpiNull E{WSP(bf16_t, WS_HB)};
    ge::gemm_phase<SchedInproj, EpiNull, true>(F.lds, S, E); }
__device__ __forceinline__ void ph_wkva(int l) { PHASE_PROLOGUE(); phase_wkv_a<false>(F, P, l); }
__device__ __forceinline__ void ph_wkva_e(int l) { PHASE_PROLOGUE(); phase_wkv_a<true>(F, P, l); }
__device__ __forceinline__ void ph_cvtmoe(int l) { PHASE_PROLOGUE(); phase_convert_moe(F, P, l); __syncthreads(); }
__device__ __forceinline__ void ph_wkvb() { PHASE_PROLOGUE(); phase_wkv_b(F, P); }
__device__ __forceinline__ void ph_wkvc(int l) { PHASE_PROLOGUE(); phase_wkv_c(F, P, l); }
__device__ __forceinline__ void ph_sguconv(int l) { PHASE_PROLOGUE();
    phase_sgu(F, P, l, 64, 192); phase_conv(F, P, l, 64, 192); }
__device__ __forceinline__ void ph_branch(int l) { PHASE_PROLOGUE();
    SchedBranch S{(const char*)F.ws, WS_WBR + (size_t)l * 1024 * 1024, F.G, F.vcu};
    EpiBranch E{WSP(unsigned char, WS_GATES), WSP(bf16_t, WS_MERGED), WSP(unsigned char, WS_MERGEDQ)};
    ge::gemm_phase<SchedBranch, EpiBranch, true, 0x7A7A7A7A, 0x7D7D7D7D>(F.lds, S, E); }
__device__ __forceinline__ void ph_wout(int l) { PHASE_PROLOGUE();
    SchedWout S{(const char*)WSP(unsigned char, WS_MERGEDQ), (const char*)(WSP(unsigned char, WS_WOUT) + (size_t)l * 1024 * 1024), F.G, F.vcu};
    EpiWout E{WSP(bf16_t, WS_X), WSP(bf16_t, WS_PRE), WSP(float, WS_STATS)};
    ge::gemm_phase<SchedWout, EpiWout, true, 0x7A7A7A7A, 0x7D7D7D7D>(F.lds, S, E); }
constexpr int LN1_SPLIT = 6144;
__device__ __forceinline__ void ph_ln1(int l) { PHASE_PROLOGUE(); if (blockIdx.x < 128) phase_ln1(F, P, l, 0, 128, 0, LN1_SPLIT); else phase_ln1(F, P, l, 128, 128, LN1_SPLIT, T); }
__device__ __forceinline__ void ph_router(int l) { PHASE_PROLOGUE();
    SchedRouter S{(const char*)WSP(bf16_t, WS_PRE), (const char*)(WSP(bf16_t, WS_WRG) + (size_t)l * 256 * 1024), 128, (int)blockIdx.x};
    EpiRouter E{P.in[32], ctl + CW_CNT + 64 * l, WSP(int, WS_LIST), WSP(float, WS_STATS), WSP(float, WS_RC) + l * 64};
    ge::gemm_phase(F.lds, S, E); }
__device__ __forceinline__ void ph_router_probe(int l) { PHASE_PROLOGUE();
    SchedRouter S{(const char*)WSP(bf16_t, WS_PRE), (const char*)(WSP(bf16_t, WS_WRG) + (size_t)l * 256 * 1024), 128, (int)blockIdx.x};
    EpiRouter E{P.in[32], ctl + CW_CNT + 64 * l + 32, WSP(int, WS_Y), WSP(float, WS_STATS), WSP(float, WS_RC) + l * 64};
    ge::gemm_phase(F.lds, S, E); }
__device__ __forceinline__ void ph_moe1(int l) { PHASE_PROLOGUE();
    const int ntiles = build_tile_table(F, ctl + CW_CNT + 64 * l);
    SchedMoe1 S{(const char*)WSP(unsigned char, WS_X1Q), (const char*)moe_wbuf(F, l), WSP(int, WS_LIST), ctl + CW_CNT + 64 * l, (LAS int*)(F.lds + LDS_MISC + 64), ntiles, F.G, F.vcu};
    EpiMoe1 E{WSP(unsigned char, WS_H)};
    ge::gemm_phase<SchedMoe1, EpiMoe1, true>(F.lds, S, E); }
__device__ __forceinline__ void ph_moe2(int l) { PHASE_PROLOGUE(); int ntk4 = 4; asm volatile("" : "+s"(ntk4));
    const int ntiles = build_tile_table(F, ctl + CW_CNT + 64 * l);
    SchedMoe2 S{(const char*)WSP(unsigned char, WS_H), (const char*)(moe_wbuf(F, l) + (size_t)NE * 1024 * 1024), WSP(int, WS_LIST), ctl + CW_CNT + 64 * l, (LAS int*)(F.lds + LDS_MISC + 64), ntiles, F.G, F.vcu, ntk4};
    EpiMoe2 E{WSP(int, WS_LIST), WSP(unsigned char, WS_Y), WSP(int, WS_GATEV)};
    ge::gemm_phase<SchedMoe2, EpiMoe2, true>(F.lds, S, E); }
__device__ __forceinline__ void ph_moe2_nostore(int l) { PHASE_PROLOGUE(); int ntk4 = 4; asm volatile("" : "+s"(ntk4));
    const int ntiles = build_tile_table(F, ctl + CW_CNT + 64 * l);
    SchedMoe2 S{(const char*)WSP(unsigned char, WS_H), (const char*)(moe_wbuf(F, l) + (size_t)NE * 1024 * 1024), WSP(int, WS_LIST), ctl + CW_CNT + 64 * l, (LAS int*)(F.lds + LDS_MISC + 64), ntiles, F.G, F.vcu, ntk4};
    EpiMoe2T<1> E{WSP(int, WS_LIST), WSP(unsigned char, WS_Y), WSP(int, WS_GATEV)};
    ge::gemm_phase<SchedMoe2, EpiMoe2T<1>, true>(F.lds, S, E); }
__device__ __forceinline__ void ph_ln2(int l) { PHASE_PROLOGUE(); phase_ln2(F, P, l); }

constexpr int PH_PER_LAYER = 11, N_PHASES = 1 + NL * PH_PER_LAYER;
__global__ void __launch_bounds__(512, 2) fwd_kernel(Params p) {
    for (int u = threadIdx.x; u < (LDS_BYTES - LDS_MISC) / 4; u += 512) ((LAS unsigned*)((LAS unsigned char*)lds_raw + LDS_MISC))[u] = 0u;
    __syncthreads();
#if ONE_LAUNCH
    XcdBarrier bar = xcd_barrier_post((unsigned*)(p.ws + WS_CTL) + CW_BAR, (volatile LAS unsigned*)((LAS unsigned char*)lds_raw + LDS_MISC));
#define SEAM() xcd_barrier(bar)
#else
#define SEAM() do { } while (0)
#endif
    const int lo = p.phase_lo, hi = p.phase_hi;
#ifdef ONLY_K
#define IN(k) ((k) == ONLY_K && lo <= pb + (k) && pb + (k) < hi)
#else
#define IN(k) (lo <= pb + (k) && pb + (k) < hi)
#endif
#ifndef ONLY_K
    { const int pb = 0; if (IN(0)) { ph_prologue(); SEAM(); if (REPEAT_K == 20) { ph_prologue(); SEAM(); } if (REPEAT_K == 21) { ph_prologue_a(); SEAM(); } if (REPEAT_K == 22) { ph_prologue_b(); SEAM(); } if (REPEAT_K == 23) { ph_prologue_c(); SEAM(); } } }
#endif
#if DEBUG_MODE
    {
        { ph_inproj(0); SEAM(); }
        { PHASE_PROLOGUE(); dbg_prep(F, P, 0); } SEAM();
        { PHASE_PROLOGUE(); if (blockIdx.x < 128) dbg_scan(F, P, 0, 0, 128); } SEAM();
        if (DEBUG_MODE >= 6) { PHASE_PROLOGUE(); dbg_bruteforce(F); SEAM(); }
        ph_wkva(0); SEAM();
        if (blockIdx.x < 64) ph_wkvb(); SEAM();
        ph_wkvc(0); SEAM();
        { PHASE_PROLOGUE();
          if (DEBUG_MODE == 1) dbg_compare(F, WSP(bf16_t, WS_OUTA), WSP(bf16_t, DBG_OUTAREF), (size_t)T * 512, ctl, 0);
          if (DEBUG_MODE == 2) dbg_compare(F, WSP(bf16_t, WS_MT), WSP(float, DBG_MREF), (size_t)4096 * 4096, ctl, 1);
          if (DEBUG_MODE == 3) dbg_compare(F, WSP(bf16_t, DBG_YDBG), WSP(bf16_t, DBG_YREF), (size_t)T * 512, ctl, 0);
          if (DEBUG_MODE == 4) dbg_compare(F, WSP(float, WS_RK), WSP(float, DBG_RKREF), (size_t)T * 8, ctl, 0);
          if (DEBUG_MODE == 5) dbg_compare_vt(F, ctl);
          if (DEBUG_MODE == 20 && blockIdx.x == 0 && F.tid == 0) { const unsigned bits = __hip_atomic_load(ctl + 12, __ATOMIC_RELAXED, __HIP_MEMORY_SCOPE_AGENT); float st = 0.f; for (int bb = 15; bb >= 1; --bb) if (bits & (1u << bb)) st = (float)bb; ((float*)ctl)[1024] = st * st * 1e-4f; ((float*)ctl)[1025] = 1.f; }
          if (DEBUG_MODE == 10) dbg_compare(F, (const bf16_t*)F.out, WSP(float, WS_SW), (size_t)T * 512, ctl, 0);
          if (DEBUG_MODE == 11) dbg_compare(F, (const bf16_t*)F.out + (size_t)T * 512, WSP(bf16_t, WS_SB), (size_t)T * 512, ctl, 0);
          if (DEBUG_MODE == 12) dbg_compare(F, (const bf16_t*)F.out + (size_t)2 * T * 512, WSP(bf16_t, WS_SA), (size_t)T * 512, ctl, 0);
          if (DEBUG_MODE == 6) dbg_compare(F, WSP(bf16_t, WS_PHI), WSP(float, DBG_BF), (size_t)256 * 4096, ctl, 0);
          if (DEBUG_MODE == 7) dbg_compare(F, WSP(bf16_t, WS_GT), WSP(float, DBG_BF) + (size_t)1 * 256 * 4096, (size_t)256 * 4096, ctl, 1);
          if (DEBUG_MODE == 8) dbg_compare(F, WSP(bf16_t, WS_PSI), WSP(float, DBG_BF) + (size_t)2 * 256 * 4096, (size_t)256 * 4096, ctl, 0);
          if (DEBUG_MODE == 9) dbg_compare(F, WSP(bf16_t, WS_Y0T), WSP(float, DBG_BF) + (size_t)3 * 256 * 4096, (size_t)256 * 4096, ctl, 1);
        } SEAM();
        { PHASE_PROLOGUE(); float num = 0.f, den = 0.f; for (int g2 = 0; g2 < 256; ++g2) { num += ((const float*)ctl)[1024 + 2 * g2]; den += ((const float*)ctl)[1025 + 2 * g2]; }
          float e = 1000.f * sqrtf(num / fmaxf(den, 1e-30f)); if (!(e == e)) e = 7.0e6f; else if (e > 5e6f) e = 5.0e6f; if (!(den == den)) e = 9.0e6f;
          for (size_t i = (size_t)blockIdx.x * 512 + F.tid; i < (size_t)T * D; i += (size_t)F.G * 512) F.out[i] = e; }
        return;
    }
#endif
#define RUN_LAYER(l) do { const int pb = 1 + (l) * PH_PER_LAYER;\
        if (IN(0)) { ph_inproj(l); SEAM(); if (REPEAT_K == 0) { ph_inproj(l); SEAM(); } if (REPEAT_K == 30) { ph_inproj_null(l); SEAM(); } }\
        if (IN(1)) { ph_wkva(l); SEAM(); if (REPEAT_K == 1) { ph_wkva(l); SEAM(); } if (REPEAT_K == 15) { ph_wkva_e(l); SEAM(); } if (REPEAT_K == 11) { ph_cvtmoe(l); SEAM(); } }\
        if (IN(2)) { if (blockIdx.x < 64) ph_wkvb(); else ph_sguconv(l); if ((l) + 1 < NL) ph_cvtmoe((l) + 1); SEAM(); if (REPEAT_K == 2) { if (blockIdx.x < 64) ph_wkvb(); else ph_sguconv(l); SEAM(); } if (REPEAT_K == 13) { if (blockIdx.x < 64) ph_wkvb(); SEAM(); } if (REPEAT_K == 14) { if (blockIdx.x >= 64) ph_sguconv(l); SEAM(); } }\
        if (IN(3)) { ph_wkvc(l); SEAM(); if (REPEAT_K == 3) { ph_wkvc(l); SEAM(); } }\
        if (IN(4)) { ph_branch(l); SEAM(); if (REPEAT_K == 4) { ph_branch(l); SEAM(); } }\
        if (IN(5)) { ph_wout(l); SEAM(); if (REPEAT_K == 5) { ph_wout(l); SEAM(); } }\
        if (IN(6)) { if (blockIdx.x < 128) ph_router(l); ph_ln1(l); SEAM(); if (REPEAT_K == 6) { if (blockIdx.x >= 128) ph_ln1(l); SEAM(); } if (REPEAT_K == 7) { if (blockIdx.x < 128) ph_router_probe(l); SEAM(); } }\
        if (IN(8)) { ph_moe1(l); SEAM(); if (REPEAT_K == 8) { ph_moe1(l); SEAM(); } }\
        if (IN(9)) { ph_moe2(l); SEAM(); if (REPEAT_K == 9) { ph_moe2(l); SEAM(); } if (REPEAT_K == 19) { ph_moe2_nostore(l); SEAM(); } }\
        if (IN(10)) { if (REPEAT_K == 10) { ph_ln2(l); SEAM(); } if (REPEAT_K == 12) { SEAM(); SEAM(); SEAM(); SEAM(); SEAM(); SEAM(); SEAM(); SEAM(); SEAM(); SEAM(); } ph_ln2(l); if (l + 1 < NL) SEAM(); } } while (0)
    RUN_LAYER(0); RUN_LAYER(1); RUN_LAYER(2); RUN_LAYER(3);
#undef RUN_LAYER
#undef IN
#undef SEAM
}

extern "C" void kernel_launch(void* const* d_in, const int* in_sizes, int n_in, void* d_out, int out_size, void* d_ws, size_t ws_size, hipStream_t stream) {
    static int grid = 0;
    if (grid == 0) {
        if (n_in != 38 || in_sizes[0] != T * D || out_size != T * D || ws_size < WS_END) { fprintf(stderr, "kernel_launch: unexpected shapes (n_in %d, in0 %d, out %d, ws %zu, need %zu); nothing launched\n", n_in, n_in > 0 ? in_sizes[0] : -1, out_size, ws_size, (size_t)WS_END); grid = -1; return; }
        int dev = 0, cus = 0, per_cu = 0;
        if (hipGetDevice(&dev) != hipSuccess || hipDeviceGetAttribute(&cus, hipDeviceAttributeMultiprocessorCount, dev) != hipSuccess) { grid = -1; return; }
        if (hipFuncSetAttribute((const void*)fwd_kernel, hipFuncAttributeMaxDynamicSharedMemorySize, LDS_BYTES) != hipSuccess) { fprintf(stderr, "kernel_launch: hipFuncSetAttribute failed\n"); grid = -1; return; }
        if (hipOccupancyMaxActiveBlocksPerMultiprocessor(&per_cu, (const void*)fwd_kernel, 512, LDS_BYTES) != hipSuccess || per_cu < 1) fprintf(stderr, "kernel_launch: occupancy query reports %d blocks per CU\n", per_cu);
        (void)hipGetLastError();
        grid = cus;
        if (grid != 256) { fprintf(stderr, "kernel_launch: built for a 256-CU device, found %d CUs; nothing launched\n", cus); grid = -1; return; }
    }
    if (grid < 0) return;
    (void)hipMemsetAsync((char*)d_ws + WS_CTL, 0, CTL_BYTES, stream);
    Params p{};
    for (int i = 0; i < 38; ++i) p.in[i] = (const float*)d_in[i];
    p.out = (float*)d_out; p.ws = (unsigned char*)d_ws; p.layer_lo = 0; p.layer_hi = NL;
#if ONE_LAUNCH
    p.phase_lo = 0; p.phase_hi = N_PHASES;
    hipLaunchKernelGGL(fwd_kernel, dim3(grid), dim3(512), LDS_BYTES, stream, p);
#else
    for (int ph = 0; ph < N_PHASES; ++ph) { p.phase_lo = ph; p.phase_hi = ph + 1; hipLaunchKernelGGL(fwd_kernel, dim3(grid), dim3(512), LDS_BYTES, stream, p); }
#endif
}
```

```cpp
#include <hip/hip_runtime.h>
#include <stdint.h>
#include <stdio.h>

#ifndef ONE_LAUNCH
#define ONE_LAUNCH 1
#endif

#define LAS __attribute__((address_space(3)))
typedef unsigned short bf16_t;
typedef short bf16x8 __attribute__((ext_vector_type(8)));
typedef float f32x4 __attribute__((ext_vector_type(4)));
typedef float f32x2 __attribute__((ext_vector_type(2)));
typedef unsigned u32x4 __attribute__((ext_vector_type(4)));
typedef unsigned u32x2 __attribute__((ext_vector_type(2)));

constexpr int T = 32768, SEQ = 2048, D = 1024, NL = 4;
constexpr int NIN = 5888;
constexpr int RKVW = 1792;
constexpr int NE = 32;
constexpr float ALPHA = 1.681792830507429f;
constexpr float LN_EPS = 1e-5f, GN_EPS = 64e-5f;

constexpr size_t MiB = 1u << 20;
constexpr size_t WS_CTL = 0;
constexpr size_t WS_WIN = 1 * MiB;
constexpr size_t WS_WBR = WS_WIN + 46 * MiB;
constexpr size_t WS_WOUT = WS_WBR + 8 * MiB;
constexpr size_t WS_WRT = WS_WOUT + 8 * MiB;
constexpr size_t WS_WMOE = WS_WRT + 1 * MiB;
constexpr size_t WS_X = WS_WMOE + 96 * MiB;
constexpr size_t WS_X1 = WS_X + 64 * MiB;
constexpr size_t WS_VFIRST = WS_X1 + 64 * MiB;
constexpr size_t WS_RKV = WS_VFIRST + 32 * MiB;
constexpr size_t WS_SGUZ = WS_RKV + 112 * MiB;
constexpr size_t WS_CONVH = WS_SGUZ + 32 * MiB;
constexpr size_t WS_GATES = WS_CONVH + 16 * MiB;
constexpr size_t WS_PHI = WS_GATES + 192 * MiB;
constexpr size_t WS_PSI = WS_PHI + 32 * MiB;
constexpr size_t WS_GT = WS_PSI + 32 * MiB;
constexpr size_t WS_Y0T = WS_GT + 32 * MiB;
constexpr size_t WS_VT = WS_Y0T + 32 * MiB;
constexpr size_t WS_MT = WS_VT + 32 * MiB;
constexpr size_t WS_RK = WS_MT + 32 * MiB;
constexpr size_t WS_LORA = WS_RK + 1 * MiB;
constexpr size_t WS_SGUW = WS_LORA + 1 * MiB;
constexpr size_t WS_OUTA = WS_SGUW + 1 * MiB;
constexpr size_t WS_HB = WS_OUTA + 32 * MiB;
constexpr size_t WS_HC = WS_HB + 16 * MiB;
constexpr size_t WS_XQ = WS_HC + 16 * MiB;
constexpr size_t WS_END = WS_XQ + 32 * MiB;
constexpr size_t WS_X1Q = WS_WMOE + 64 * MiB;
constexpr size_t WS_STATS = WS_Y0T;
constexpr size_t WS_WRG = WS_WBR + 4 * MiB;
constexpr size_t WS_RC = WS_SGUW + 512 * 1024;
constexpr size_t WS_MERGEDQ = WS_GT;
constexpr size_t WS_MERGED = WS_RKV;
constexpr size_t WS_PRE = WS_PHI;
constexpr size_t WS_H = WS_RKV;
constexpr size_t WS_Y = WS_GATES;
constexpr size_t WS_LIST = WS_SGUZ;
constexpr size_t WS_GATEV = WS_SGUZ + 16 * MiB;
static_assert(WS_END <= 1024 * MiB, "workspace map");
constexpr int CW_BAR = 4096;
constexpr int CW_CNT = 16384;
constexpr size_t CTL_BYTES = 1 * MiB;

constexpr int LDS_STAGE = 131072;
constexpr int LDS_MISC = LDS_STAGE;
constexpr int LDS_RAW = LDS_STAGE + 4096;
constexpr int LDS_BYTES = 163840;

typedef __bf16 bf16x2_t __attribute__((ext_vector_type(2)));
__device__ __forceinline__ unsigned cvt_pk_bf16(float lo, float hi) { const f32x2 v = {lo, hi}; const bf16x2_t b = __builtin_convertvector(v, bf16x2_t); return __builtin_bit_cast(unsigned, b); }
__device__ __forceinline__ unsigned pack_fp8x4(float a, float b, float c, float d) { int w = 0; w = __builtin_amdgcn_cvt_pk_fp8_f32(a, b, w, false); w = __builtin_amdgcn_cvt_pk_fp8_f32(c, d, w, true); return (unsigned)w; }
__device__ __forceinline__ bf16_t f2bf(float f) { return (bf16_t)(cvt_pk_bf16(f, 0.f) & 0xffffu); }
__device__ __forceinline__ float bf2f(unsigned short b) { return __uint_as_float(((unsigned)b) << 16); }
__device__ __forceinline__ float bflo(unsigned w) { return __uint_as_float(w << 16); }
__device__ __forceinline__ float bfhi(unsigned w) { return __uint_as_float(w & 0xffff0000u); }
__device__ __forceinline__ float sigmoidf_(float x) { return __builtin_amdgcn_rcpf(1.0f + __expf(-x)); }
template <int CTRL> __device__ __forceinline__ float dpp_mov(float x) { return __builtin_bit_cast(float, __builtin_amdgcn_mov_dpp(__builtin_bit_cast(int, x), CTRL, 0xF, 0xF, true)); }
__device__ __forceinline__ float row16_sum(float v) { v += dpp_mov<0xB1>(v); v += dpp_mov<0x4E>(v); v += dpp_mov<0x141>(v); v += dpp_mov<0x140>(v); return v; }
__device__ __forceinline__ float wave_sum(float v) {
    v = row16_sum(v); const int vi = __builtin_bit_cast(int, v);
    return (__builtin_bit_cast(float, __builtin_amdgcn_readlane(vi, 0)) + __builtin_bit_cast(float, __builtin_amdgcn_readlane(vi, 16))) + (__builtin_bit_cast(float, __builtin_amdgcn_readlane(vi, 32)) + __builtin_bit_cast(float, __builtin_amdgcn_readlane(vi, 48)));
}
__device__ __forceinline__ float dpp_f(float x, const int ctrl_sel) {
    int xi = __builtin_bit_cast(int, x), r;
    if (ctrl_sel == 0) r = __builtin_amdgcn_update_dpp(0, xi, 0xB1, 0xF, 0xF, true);
    else if (ctrl_sel == 1) r = __builtin_amdgcn_update_dpp(0, xi, 0x4E, 0xF, 0xF, true);
    else r = __builtin_amdgcn_update_dpp(0, xi, 0x141, 0xF, 0xF, true);
    return __builtin_bit_cast(float, r);
}
__device__ __forceinline__ float reduce8(float x) { x += dpp_f(x, 0); x += dpp_f(x, 1); x += dpp_f(x, 2); return x; }
__device__ __forceinline__ float gelu_f(float v) {
    const float av = fabsf(v), t = __builtin_amdgcn_rcpf(av * 0.2316418882f + 1.0f);
    float q = t * 0.5307027145f + (-0.7265760135f); q = q * t + 0.7107068705f; q = q * t + (-0.142248368f); q = q * t + 0.127414796f; q = q * t;
    const float e = __builtin_amdgcn_exp2f((v * v) * (-0.72134752044f));
    const float m = v * (q * e);
    return v < 0.f ? m : v - m;
}

#define XB_TMO      128
#define XB_XCNT(j)  (256  + 64 * (j))
#define XB_XSUB(j)  (1280 + 64 * (j))
#define XB_XGEN(j)  (2304 + 64 * (j))
#define XB_TOP      3328
#define XB_TOPGEN   3392
#define XCD_BAR_WORDS 3456
#define XB_SPIN_CAP (1u << 22)
__device__ __forceinline__ unsigned xb_ld(unsigned* p)              { return __hip_atomic_load(p, __ATOMIC_RELAXED, __HIP_MEMORY_SCOPE_AGENT); }
__device__ __forceinline__ unsigned xb_add(unsigned* p, unsigned v) { return __hip_atomic_fetch_add(p, v, __ATOMIC_RELAXED, __HIP_MEMORY_SCOPE_AGENT); }
__device__ __forceinline__ unsigned xb_xcc_id() { return (unsigned)__builtin_amdgcn_s_getreg((3 << 11) | 20) & 0xFu; }
#define XB_SPIN(cond, bar) do { unsigned _sp = 0; while (cond) { __builtin_amdgcn_s_sleep(1); \
    if ((++_sp & 255u) == 0u) { if (xb_ld(&(bar)[XB_TMO])) break; if (_sp > XB_SPIN_CAP) { atomicAdd(&(bar)[XB_TMO], 1u); break; } } } } while (0)
struct XcdBarrier { unsigned* bar; unsigned x; volatile LAS unsigned* st; };
__device__ __forceinline__ XcdBarrier xcd_barrier_post(unsigned* bar, volatile LAS unsigned* st) {
    XcdBarrier b; b.bar = bar; b.x = xb_xcc_id(); b.st = st;
    if (threadIdx.x == 0) (void)xb_add(&bar[XB_XCNT(b.x)], 1u);
    return b;
}
__device__ __forceinline__ void xcd_barrier_complete(unsigned* bar, unsigned x, unsigned& nloc, unsigned& nx) {
    const unsigned G = gridDim.x * gridDim.y * gridDim.z;
    unsigned sum, cnt, mine, sp = 0u;
    for (;;) {
        sum = 0u; cnt = 0u; mine = 0u;
#pragma unroll
        for (unsigned j = 0; j < 16; ++j) { const unsigned c = xb_ld(&bar[XB_XCNT(j)]); sum += c; cnt += (c > 0u) ? 1u : 0u; mine = (j == x) ? c : mine; }
        if (sum == G) break;
        __builtin_amdgcn_s_sleep(1);
        if ((++sp & 255u) == 0u) { if (xb_ld(&bar[XB_TMO])) break; if (sp > XB_SPIN_CAP) { atomicAdd(&bar[XB_TMO], 1u); break; } }
    }
    nloc = mine > 0u ? mine : 1u; nx = cnt > 0u ? cnt : 1u;
}
__device__ __forceinline__ void xcd_barrier(const XcdBarrier& b) {
    asm volatile("s_waitcnt vmcnt(0)" ::: "memory");
    __syncthreads();
    if (threadIdx.x == 0) {
        unsigned* bar = b.bar;
        __builtin_amdgcn_s_waitcnt(0);
        unsigned nloc = b.st[0], nx = b.st[1];
        if (nloc == 0u) { xcd_barrier_complete(bar, b.x, nloc, nx); b.st[0] = nloc; b.st[1] = nx; }
        const unsigned old = xb_add(&bar[XB_XSUB(b.x)], 1u);
        const unsigned gen = old / nloc;
        if (old + 1u == (gen + 1u) * nloc) {
            __builtin_amdgcn_fence(__ATOMIC_RELEASE, "agent");
            asm volatile("s_waitcnt vmcnt(0)" ::: "memory");
            const unsigned og = xb_add(&bar[XB_TOP], 1u);
            const unsigned tg = og / nx;
            if (og + 1u == (tg + 1u) * nx) xb_add(&bar[XB_TOPGEN], 1u);
            else XB_SPIN(xb_ld(&bar[XB_TOPGEN]) == tg, bar);
            __builtin_amdgcn_fence(__ATOMIC_ACQUIRE, "agent");
            xb_add(&bar[XB_XGEN(b.x)], 1u);
            asm volatile("s_waitcnt vmcnt(0)" ::: "memory");
        } else {
            XB_SPIN(xb_ld(&bar[XB_XGEN(b.x)]) == gen, bar);
            __builtin_amdgcn_fence(__ATOMIC_ACQUIRE, "agent");
            asm volatile("s_waitcnt vmcnt(0)" ::: "memory");
        }
    }
    __syncthreads();
}

struct Params {
    const float* in[38];
    float* out;
    unsigned char* ws;
    int phase_lo, phase_hi;
    int layer_lo, layer_hi;
};

namespace ge {
constexpr int BM = 256, BK = 64, HALF = 128, HTB = HALF * BK * 2;
__device__ __forceinline__ int lds_byte(int r, int c) { const int st = (r >> 4) * 2 + (c >> 5), rr = r & 15, cc = c & 31, ob = rr * 64 + cc * 2; return st * 1024 + (ob ^ (((ob >> 9) & 1) << 5)); }
__device__ __forceinline__ void stage_rc(int b, int& R, int& C) { const int st = b / 1024, sb = b % 1024, swz = sb ^ (((sb >> 9) & 1) << 5); R = (st >> 1) * 16 + swz / 64; C = (st & 1) * 32 + (swz % 64) / 2; }
__device__ __forceinline__ int perm32(int rho) { const int n = rho >> 4, i = rho & 15; return 8 * (i >> 2) + 4 * n + (i & 3); }

struct NoPre { };
struct Unit {
    const char* A; const char* B;
    const int* gat;
    unsigned lda, ldb;
    int nt;
    int gshift, nvalid;
    int pm, pn, aux;
};
typedef f32x4 Acc[2][2][4][2];

typedef int i32x8 __attribute__((ext_vector_type(8)));
template <class Sched, class Epi, bool FP8 = false, int SCALE_W = 0x7A7A7A7A, int SCALE_A = 0x7F7F7F7F>
__device__ __forceinline__ void gemm_phase(LAS unsigned char* lds, const Sched& S, const Epi& E) {
    int tid = threadIdx.x; asm volatile("" : "+v"(tid));
    const int wid = __builtin_amdgcn_readfirstlane(tid >> 6), lane = tid & 63, wr = wid >> 2, wc = wid & 3, fr = lane & 15, fq = lane >> 4;
    const unsigned ldsw = (unsigned)wid * 1024u;
    const int aoff = FP8 ? lds_byte(wr * 64 + fr, fq * 16) : lds_byte(wr * 64 + fr, fq * 8), boff = FP8 ? lds_byte(wc * 32 + fr, fq * 16) : lds_byte(wc * 32 + fr, fq * 8);
    const int aoff1 = FP8 ? lds_byte(wr * 64 + fr, fq * 16 + 8) : aoff + 1024, boff1 = FP8 ? lds_byte(wc * 32 + fr, fq * 16 + 8) : boff + 1024;
#define GE_SA(b, h) (((b) * 2 + (h)) * HTB)
#define GE_SB(b, h) ((4 + (b) * 2 + (h)) * HTB)
#define GE_STAGE(bufoff, gbase, o0, o1) do { \
        __builtin_amdgcn_global_load_lds((const unsigned*)((gbase) + (o0)), (LAS unsigned*)(lds + (bufoff) + ldsw), 16, 0, 0); \
        __builtin_amdgcn_global_load_lds((const unsigned*)((gbase) + (o1)), (LAS unsigned*)(lds + (bufoff) + ldsw + 8192), 16, 0, 0); } while (0)
#define GE_LDA(dst, b, h) do { _Pragma("unroll") for (int m = 0; m < 4; ++m) { dst[m][0] = *(const LAS bf16x8*)(lds + GE_SA(b, h) + aoff + m * 2048); dst[m][1] = *(const LAS bf16x8*)(lds + GE_SA(b, h) + aoff1 + m * 2048); } } while (0)
#define GE_LDB(dst, b, h) do { _Pragma("unroll") for (int n = 0; n < 2; ++n) { dst[n][0] = *(const LAS bf16x8*)(lds + GE_SB(b, h) + boff + n * 2048); dst[n][1] = *(const LAS bf16x8*)(lds + GE_SB(b, h) + boff1 + n * 2048); } } while (0)
#define GE_CAT(x0, x1) __builtin_shufflevector(__builtin_bit_cast(u32x4, x0), __builtin_bit_cast(u32x4, x1), 0, 1, 2, 3, 4, 5, 6, 7)
#define GE_MMA(ai, bj, At, Bt) do { __builtin_amdgcn_s_setprio(1); _Pragma("unroll") for (int m = 0; m < 4; ++m) _Pragma("unroll") for (int n = 0; n < 2; ++n) { \
        if constexpr (FP8) acc[ai][bj][m][n] = __builtin_amdgcn_mfma_scale_f32_16x16x128_f8f6f4(__builtin_bit_cast(i32x8, GE_CAT(Bt[n][0], Bt[n][1])), __builtin_bit_cast(i32x8, GE_CAT(At[m][0], At[m][1])), acc[ai][bj][m][n], 0, 0, 0, SCALE_W, 0, SCALE_A); \
        else { _Pragma("unroll") for (int k = 0; k < 2; ++k) acc[ai][bj][m][n] = __builtin_amdgcn_mfma_f32_16x16x32_bf16(Bt[n][k], At[m][k], acc[ai][bj][m][n], 0, 0, 0); } } __builtin_amdgcn_s_setprio(0); } while (0)
#define GE_WAIT_V(n) asm volatile("s_waitcnt vmcnt(" #n ")" ::: "memory")
#define GE_WAIT_L(n) asm volatile("s_waitcnt lgkmcnt(" #n ")" ::: "memory")
#define GE_BAR __builtin_amdgcn_s_barrier()
#define GE_SCHED __builtin_amdgcn_sched_barrier(0)
#define GE_OFFS(u, oA00, oA01, oA10, oA11, oB0, oB1) do { \
        int tq_ = tid; asm volatile("" : "+v"(tq_)); int R0, C0, R1, C1; stage_rc(tq_ * 16, R0, C0); stage_rc(tq_ * 16 + 8192, R1, C1); \
        const int Rb0 = (R0 & ~31) + perm32(R0 & 31), Rb1 = (R1 & ~31) + perm32(R1 & 31); \
        int r00 = R0, r01 = R1, r10 = 128 + R0, r11 = 128 + R1; \
        if ((u).gat) { const int* g_ = (u).gat; const int nv_ = (u).nvalid, sh_ = (u).gshift; \
            r00 = (r00 < nv_) ? (g_[2 * r00] >> sh_) : 0; r01 = (r01 < nv_) ? (g_[2 * r01] >> sh_) : 0; r10 = (r10 < nv_) ? (g_[2 * r10] >> sh_) : 0; r11 = (r11 < nv_) ? (g_[2 * r11] >> sh_) : 0; } \
        oA00 = (unsigned)r00 * (u).lda + (unsigned)C0 * 2u; oA01 = (unsigned)r01 * (u).lda + (unsigned)C1 * 2u; \
        oA10 = (unsigned)r10 * (u).lda + (unsigned)C0 * 2u; oA11 = (unsigned)r11 * (u).lda + (unsigned)C1 * 2u; \
        oB0 = (unsigned)Rb0 * (u).ldb + (unsigned)C0 * 2u; oB1 = (unsigned)Rb1 * (u).ldb + (unsigned)C1 * 2u; } while (0)
    Unit cur, nxt; int ui = 0;
    if (!S.next(0, cur)) return;
    Acc acc;
#pragma unroll
    for (int a = 0; a < 2; ++a)
#pragma unroll
        for (int b = 0; b < 2; ++b)
#pragma unroll
            for (int m = 0; m < 4; ++m)
#pragma unroll
                for (int n = 0; n < 2; ++n) acc[a][b][m][n] = (f32x4){0.f, 0.f, 0.f, 0.f};
    bf16x8 At[4][2], B0[2][2], B1[2][2];
    unsigned oA00, oA01, oA10, oA11, oB0, oB1;
    GE_OFFS(cur, oA00, oA01, oA10, oA11, oB0, oB1);
    typename Epi::Pre pre = E.prefetch(cur, wr, wc, fr, fq);
    const char* cA = cur.A; const char* cB = cur.B; size_t chB = (size_t)128 * cur.ldb;
    const size_t kstep = 128;
    GE_STAGE(GE_SB(0, 0), cB, oB0, oB1); GE_STAGE(GE_SA(0, 0), cA, oA00, oA01); GE_STAGE(GE_SB(0, 1), cB + chB, oB0, oB1); GE_STAGE(GE_SA(0, 1), cA, oA10, oA11);
    if (wr == 1) GE_BAR;
    GE_WAIT_V(4); GE_BAR;
    GE_STAGE(GE_SB(1, 0), cB + kstep, oB0, oB1); GE_STAGE(GE_SA(1, 0), cA + kstep, oA00, oA01); GE_STAGE(GE_SB(1, 1), cB + chB + kstep, oB0, oB1);
    GE_WAIT_V(6); GE_BAR;
    for (;;) {
        const bool has_next = S.next(ui + 1, nxt);
        const char* nA = has_next ? nxt.A : cA; const char* nB = has_next ? nxt.B : cB; const size_t nhB = has_next ? (size_t)128 * nxt.ldb : chB;
        const int nt = cur.nt;
        for (int t = 0; t < nt; t += 2) {
            const bool last = (t == nt - 2);
            const char* a1 = cA + (size_t)(t + 1) * kstep;
            const char* a2 = last ? nA : cA + (size_t)(t + 2) * kstep; const char* b2 = last ? nB : cB + (size_t)(t + 2) * kstep;
            const size_t hB2 = last ? nhB : chB;
            const char* a3 = a2 + kstep; const char* b3 = b2 + kstep;
            GE_LDB(B0, 0, 0); GE_SCHED; GE_LDA(At, 0, 0); GE_STAGE(GE_SA(1, 1), a1, oA10, oA11);
            if (last && has_next) { GE_OFFS(nxt, oA00, oA01, oA10, oA11, oB0, oB1); }
            GE_WAIT_L(8); GE_BAR; GE_WAIT_L(0); GE_MMA(0, 0, At, B0); GE_BAR; GE_SCHED;
            GE_LDB(B1, 0, 1); GE_STAGE(GE_SB(0, 0), b2, oB0, oB1);
            GE_BAR; GE_WAIT_L(0); GE_MMA(0, 1, At, B1); GE_BAR;
            GE_LDA(At, 0, 1); GE_STAGE(GE_SA(0, 0), a2, oA00, oA01);
            GE_BAR; GE_WAIT_L(0); GE_MMA(1, 0, At, B0); GE_BAR; GE_SCHED;
            GE_STAGE(GE_SB(0, 1), b2 + hB2, oB0, oB1);
            GE_WAIT_V(6); GE_BAR; GE_MMA(1, 1, At, B1); GE_BAR;
            GE_LDB(B0, 1, 0); GE_SCHED; GE_LDA(At, 1, 0); GE_STAGE(GE_SA(0, 1), a2, oA10, oA11);
            GE_WAIT_L(8); GE_BAR; GE_WAIT_L(0); GE_MMA(0, 0, At, B0); GE_BAR; GE_SCHED;
            GE_LDB(B1, 1, 1); GE_STAGE(GE_SB(1, 0), b3, oB0, oB1);
            GE_BAR; GE_WAIT_L(0); GE_MMA(0, 1, At, B1); GE_BAR;
            GE_LDA(At, 1, 1); GE_STAGE(GE_SA(1, 0), a3, oA00, oA01);
            GE_BAR; GE_WAIT_L(0); GE_MMA(1, 0, At, B0); GE_BAR; GE_SCHED;
            GE_STAGE(GE_SB(1, 1), b3 + hB2, oB0, oB1);
            GE_WAIT_V(6); GE_BAR; GE_MMA(1, 1, At, B1); GE_BAR;
        }
        if constexpr (!Epi::AFTER_DRAIN) E(acc, cur, wr, wc, fr, fq, pre);
        if (!has_next) break;
#pragma unroll
        for (int a = 0; a < 2; ++a)
#pragma unroll
            for (int b = 0; b < 2; ++b)
#pragma unroll
                for (int m = 0; m < 4; ++m)
#pragma unroll
                    for (int n = 0; n < 2; ++n) acc[a][b][m][n] = (f32x4){0.f, 0.f, 0.f, 0.f};
        cur = nxt; cA = nA; cB = nB; chB = nhB; ++ui; pre = E.prefetch(cur, wr, wc, fr, fq);
    }
    GE_WAIT_V(0);
    if (wr == 0) GE_BAR;
    GE_BAR;
    if constexpr (Epi::AFTER_DRAIN) E.drained(acc, cur, wr, wc, fr, fq, lds);
#undef GE_SA
#undef GE_SB
#undef GE_STAGE
#undef GE_LDA
#undef GE_LDB
#undef GE_MMA
#undef GE_WAIT_V
#undef GE_WAIT_L
#undef GE_BAR
#undef GE_SCHED
#undef GE_OFFS
#undef GE_CAT
}
__device__ __forceinline__ bool static_tile(long L, int nM, int nN, int& pm, int& pn) {
    const int nwg = nM * nN; if (L >= nwg) return false;
    int wgid = (int)L; { const int q = nwg / 8, r = nwg % 8, xcd = wgid % 8, off = wgid / 8; wgid = (xcd < r ? xcd * (q + 1) : r * (q + 1) + (xcd - r) * q) + off; }
    const int nig = 8 * nN, gid = wgid / nig, fm = gid * 8, gsz = (nM - fm) < 8 ? (nM - fm) : 8;
    pm = fm + ((wgid % nig) % gsz); pn = (wgid % nig) / gsz; return true;
}
}

struct Frame {
    LAS unsigned char* lds;
    int tid, lane, wave, G, vcu;
    unsigned char* ws;
    float* out;
};
#define WSP(T_, off) ((T_*)(F.ws + (off)))

extern __shared__ __attribute__((aligned(16))) unsigned char lds_raw[];
__device__ __forceinline__ Params load_params() {
    typedef const __attribute__((address_space(4))) unsigned long long cu64;
    cu64* k = (cu64*)__builtin_amdgcn_kernarg_segment_ptr();
    asm volatile("" : "+s"(k));
    Params P;
#pragma unroll
    for (int i = 0; i < 38; ++i) P.in[i] = (const float*)(const __attribute__((address_space(1))) float*)k[i];
    P.out = (float*)(__attribute__((address_space(1))) float*)k[38]; P.ws = (unsigned char*)(__attribute__((address_space(1))) unsigned char*)k[39];
    P.phase_lo = 0; P.phase_hi = 0; P.layer_lo = 0; P.layer_hi = 0;
    return P;
}
#define KPARAMS() load_params()
__device__ __forceinline__ Frame make_frame(unsigned char* ws, float* out) {
    Frame F;
    F.lds = (LAS unsigned char*)lds_raw;
    int tz = threadIdx.x; asm volatile("" : "+v"(tz));
    F.tid = tz; F.lane = F.tid & 63; F.wave = __builtin_amdgcn_readfirstlane(F.tid >> 6);
    F.G = gridDim.x; { const int bx = blockIdx.x; F.vcu = (F.G % 8 == 0) ? (bx % 8) * (F.G / 8) + bx / 8 : bx; }
    F.ws = ws; F.out = out;
    return F;
}
template <bool FP8OUT, class ColMap>
__device__ __forceinline__ void transpose_item(const float* W, int ldw, int K, void* WTv, int nblk, LAS float* scr, int item, int lane, const ColMap& cm) {
    const int kb = item / nblk, nb = item % nblk, k0 = 64 * kb, n0 = 32 * nb;
    const int sc = cm(n0 + (lane & 31));
#pragma unroll 8
    for (int i = 0; i < 32; ++i) { const int kk = 2 * i + (lane >> 5); scr[kk * 33 + (lane & 31)] = (sc >= 0) ? W[(size_t)(k0 + kk) * ldw + sc] : 0.f; }
    asm volatile("s_waitcnt lgkmcnt(0)" ::: "memory");
    const int c = lane & 7;
#pragma unroll
    for (int j = 0; j < 4; ++j) { const int n = (lane >> 3) + 8 * j; const LAS float* s = scr + (8 * c) * 33 + n;
        if (FP8OUT) { u32x2 o; o.x = pack_fp8x4(32.f * s[0 * 33], 32.f * s[1 * 33], 32.f * s[2 * 33], 32.f * s[3 * 33]); o.y = pack_fp8x4(32.f * s[4 * 33], 32.f * s[5 * 33], 32.f * s[6 * 33], 32.f * s[7 * 33]);
            *(u32x2*)((unsigned char*)WTv + (size_t)(n0 + n) * K + k0 + 8 * c) = o; }
        else { u32x4 o; o.x = cvt_pk_bf16(s[0 * 33], s[1 * 33]); o.y = cvt_pk_bf16(s[2 * 33], s[3 * 33]); o.z = cvt_pk_bf16(s[4 * 33], s[5 * 33]); o.w = cvt_pk_bf16(s[6 * 33], s[7 * 33]);
            *(u32x4*)((bf16_t*)WTv + (size_t)(n0 + n) * K + k0 + 8 * c) = o; } }
    asm volatile("s_waitcnt lgkmcnt(0)" ::: "memory");
}
struct CmIdent { __device__ __forceinline__ int operator()(int n) const { return n; } };
struct CmInproj { int layer; __device__ __forceinline__ int operator()(int j) const {
    if (j < 1536) return j;
    if (j < 1792) { const int q = j - 1536; if (q < 160) return 1536 + q; if (q < 192) return layer > 0 ? 5792 + (q - 160) : -1; return -1; }
    if (j < 2304) return 1696 + (j - 1792);
    if (j < 2816) { const int jj = j - 2304, c = jj >> 1; return (jj & 1) ? 2208 + 256 + c : 2208 + c; }
    return 2720 + (j - 2816); } };
struct CmRouter { __device__ __forceinline__ int operator()(int n) const { return n < 32 ? n : -1; } };
struct CmGU { __device__ __forceinline__ int operator()(int n) const { return n; } };

template <bool FP8OUT> __device__ __forceinline__ void moe_item_store(void* WTv, int K, int k0, int n0, LAS float* scr, int lane) {
    asm volatile("s_waitcnt lgkmcnt(0)" ::: "memory");
    const int c = lane & 7;
#pragma unroll
    for (int j = 0; j < 4; ++j) { const int nn = (lane >> 3) + 8 * j; const LAS float* s = scr + (8 * c) * 33 + nn;
        if (FP8OUT) { u32x2 o; o.x = pack_fp8x4(32.f * s[0 * 33], 32.f * s[1 * 33], 32.f * s[2 * 33], 32.f * s[3 * 33]); o.y = pack_fp8x4(32.f * s[4 * 33], 32.f * s[5 * 33], 32.f * s[6 * 33], 32.f * s[7 * 33]);
            *(u32x2*)((unsigned char*)WTv + (size_t)(n0 + nn) * K + k0 + 8 * c) = o; }
        else { u32x4 o; o.x = cvt_pk_bf16(s[0 * 33], s[1 * 33]); o.y = cvt_pk_bf16(s[2 * 33], s[3 * 33]); o.z = cvt_pk_bf16(s[4 * 33], s[5 * 33]); o.w = cvt_pk_bf16(s[6 * 33], s[7 * 33]);
            *(u32x4*)((bf16_t*)WTv + (size_t)(n0 + nn) * K + k0 + 8 * c) = o; } }
    asm volatile("s_waitcnt lgkmcnt(0)" ::: "memory");
}
__device__ __forceinline__ void fast_item_plain(const float* W, int ldw, int K, unsigned char* WT, int nblk, LAS float* scr, int item, int lane) {
    const int kb = item / nblk, nb = item % nblk, k0 = 64 * kb, n0 = 32 * nb; const int c4 = (lane & 7) * 4; const float* Ws = W + n0 + c4;
    f32x4 v[8];
#pragma unroll
    for (int i = 0; i < 8; ++i) v[i] = *(const f32x4*)(Ws + (size_t)(k0 + 8 * i + (lane >> 3)) * ldw);
#pragma unroll
    for (int i = 0; i < 8; ++i) { LAS float* d = scr + (8 * i + (lane >> 3)) * 33 + c4; d[0] = v[i][0]; d[1] = v[i][1]; d[2] = v[i][2]; d[3] = v[i][3]; }
    moe_item_store<true>(WT, K, k0, n0, scr, lane);
}
__device__ __forceinline__ void phase_convert_static(Frame& F, const Params& P) {
    LAS float* scr = (LAS float*)(F.lds + F.wave * 8448);
    const int gw = F.vcu * 8 + F.wave, NGW = F.G * 8;
    constexpr int I_IN = 16 * (NIN / 32);
    for (int it = gw; it < NL * I_IN; it += NGW) { const int l = it / I_IN, r = it % I_IN; const int lane = F.lane;
        const float* W = (l == 0) ? P.in[1] : P.in[2] + (size_t)(l - 1) * 1024 * 5824; const int ldw = (l == 0) ? 5792 : 5824;
        const int kb = r / (NIN / 32), nb = r % (NIN / 32), k0 = 64 * kb, n0 = 32 * nb;
        f32x4 v[8];
        if (n0 >= 2304 && n0 < 2816) {
            const int m = (lane >> 2) & 1, c4 = (lane & 3) * 4; const float* Ws = W + 2208 + 256 * m + ((n0 - 2304) >> 1) + c4;
#pragma unroll
            for (int i = 0; i < 8; ++i) v[i] = *(const f32x4*)(Ws + (size_t)(k0 + 8 * i + (lane >> 3)) * ldw);
#pragma unroll
            for (int i = 0; i < 8; ++i) { LAS float* d = scr + (8 * i + (lane >> 3)) * 33 + 2 * c4 + m; d[0] = v[i][0]; d[2] = v[i][1]; d[4] = v[i][2]; d[6] = v[i][3]; }
        } else {
            int src = n0; bool zero = false;
            if (n0 >= 1696 && n0 < 1728) { src = 5792 + (n0 - 1696); zero = (l == 0); } else if (n0 >= 1728 && n0 < 1792) zero = true; else if (n0 >= 1792) src = n0 - 96;
            const int c4 = (lane & 7) * 4; const float* Ws = W + (zero ? 0 : src) + c4;
#pragma unroll
            for (int i = 0; i < 8; ++i) { v[i] = *(const f32x4*)(Ws + (size_t)(k0 + 8 * i + (lane >> 3)) * ldw); if (zero) v[i] = (f32x4){0.f, 0.f, 0.f, 0.f}; }
#pragma unroll
            for (int i = 0; i < 8; ++i) { LAS float* d = scr + (8 * i + (lane >> 3)) * 33 + c4; d[0] = v[i][0]; d[1] = v[i][1]; d[2] = v[i][2]; d[3] = v[i][3]; }
        }
        moe_item_store<true>(WSP(unsigned char, WS_WIN) + (size_t)l * NIN * 1024, 1024, k0, n0, scr, lane); }
    constexpr int I_A = 8 * 32, I_B = 4 * 32;
    for (int it = gw; it < NL * (I_A + 2 * I_B); it += NGW) { const int l = it / (I_A + 2 * I_B); int r = it % (I_A + 2 * I_B);
        unsigned char* base = WSP(unsigned char, WS_WBR) + (size_t)l * (1024 * 1024);
        if (r < I_A) { fast_item_plain(P.in[17] + (size_t)l * 512 * 1024, 1024, 512, base, 32, scr, r, F.lane); continue; } r -= I_A;
        if (r < I_B) { fast_item_plain(P.in[22] + (size_t)l * 256 * 1024, 1024, 256, base + 1024 * 512, 32, scr, r, F.lane); continue; } r -= I_B;
        fast_item_plain(P.in[27] + (size_t)l * 256 * 1024, 1024, 256, base + 1024 * 512 + 1024 * 256, 32, scr, r, F.lane); }
    constexpr int I_O = 16 * 32;
    for (int it = gw; it < NL * I_O; it += NGW) { const int l = it / I_O, r = it % I_O;
        fast_item_plain(P.in[28] + (size_t)l * 1024 * 1024, 1024, 1024, WSP(unsigned char, WS_WOUT) + (size_t)l * 1024 * 1024, 32, scr, r, F.lane); }
    for (int it = gw; it < 16 * 8; it += NGW) transpose_item<false>(P.in[31], 32, 1024, WSP(bf16_t, WS_WRT), 8, scr, it, F.lane, CmRouter{});
}
__device__ __forceinline__ unsigned char* moe_wbuf(Frame& F, int l) { return (l & 1) ? (unsigned char*)F.out : F.ws + WS_WMOE; }
__device__ __forceinline__ void phase_convert_moe(Frame& F, const Params& P, int l) {
    LAS float* scr = (LAS float*)(F.lds + F.wave * 8448);
    const int gw = F.vcu * 8 + F.wave, NGW = F.G * 8; const int lane = F.lane;
    constexpr int I_GU = 16 * 32;
    constexpr int I_DN = 8 * 32;
    for (int it = gw; it < NE * I_GU; it += NGW) { const int e = it / I_GU, item = it % I_GU;
        const int kb = item / 32, nb = item % 32, k0 = 64 * kb, n0 = 32 * nb;
        const int m = (lane >> 2) & 1, c4 = (lane & 3) * 4;
        const float* Ws = ((m ? P.in[34] : P.in[33]) + ((size_t)l * NE + e) * 1024 * 512) + (n0 >> 1) + c4;
        f32x4 v[8];
#pragma unroll
        for (int i = 0; i < 8; ++i) v[i] = *(const f32x4*)(Ws + (size_t)(k0 + 8 * i + (lane >> 3)) * 512);
#pragma unroll
        for (int i = 0; i < 8; ++i) { LAS float* d = scr + (8 * i + (lane >> 3)) * 33 + 2 * c4 + m; d[0] = v[i][0]; d[2] = v[i][1]; d[4] = v[i][2]; d[6] = v[i][3]; }
        moe_item_store<true>(moe_wbuf(F, l) + (size_t)e * 1024 * 1024, 1024, k0, n0, scr, lane); }
    for (int it = gw; it < NE * I_DN; it += NGW) { const int e = it / I_DN, item = it % I_DN;
        const int kb = item / 32, nb = item % 32, k0 = 64 * kb, n0 = 32 * nb; const int c4 = (lane & 7) * 4;
        const float* Ws = P.in[35] + ((size_t)l * NE + e) * 512 * 1024 + n0 + c4;
        f32x4 v[8];
#pragma unroll
        for (int i = 0; i < 8; ++i) v[i] = *(const f32x4*)(Ws + (size_t)(k0 + 8 * i + (lane >> 3)) * 1024);
#pragma unroll
        for (int i = 0; i < 8; ++i) { LAS float* d = scr + (8 * i + (lane >> 3)) * 33 + c4; d[0] = v[i][0]; d[1] = v[i][1]; d[2] = v[i][2]; d[3] = v[i][3]; }
        moe_item_store<true>(moe_wbuf(F, l) + (size_t)NE * 1024 * 1024 + (size_t)e * 1024 * 512, 512, k0, n0, scr, lane); }
}
__device__ __forceinline__ void phase_convert_lora(Frame& F, const Params& P) {
    bf16_t* dst = WSP(bf16_t, WS_LORA);
    for (int idx = (int)blockIdx.x * 512 + F.tid; idx < 11 * 512 * 32 + 4 * 512 * 96; idx += F.G * 512) {
        float val;
        if (idx < 11 * 512 * 32) { const int m = idx / (512 * 32), rem = idx % (512 * 32), ch = rem / 32, i = rem % 32;
            if (m < 4) val = P.in[6][((size_t)m * 32 + i) * 512 + ch]; else if (m < 8) val = P.in[8][((size_t)(m - 4) * 32 + i) * 512 + ch]; else val = P.in[11][((size_t)(m - 8) * 32 + i) * 512 + ch]; }
        else { const int r2 = idx - 11 * 512 * 32, m = r2 / (512 * 96), rem = r2 % (512 * 96), ch = rem / 96, i = rem % 96; val = P.in[9][((size_t)m * 96 + i) * 512 + ch]; }
        dst[idx] = f2bf(val); }
}
__device__ __forceinline__ void phase_convert_sgu(Frame& F, const Params& P) {
    bf16_t* dst = WSP(bf16_t, WS_SGUW);
    for (int idx = (int)blockIdx.x * 512 + F.tid; idx < NL * 4 * 128 * 128; idx += F.G * 512) { const int p = (idx >> 7) & 127, qq = idx & 127; dst[idx] = f2bf(qq <= p ? P.in[20][idx] : 0.f); }
}
__device__ __forceinline__ void phase_convert_router(Frame& F, const Params& P) {
    bf16_t* dst = WSP(bf16_t, WS_WRG); float* rc = WSP(float, WS_RC);
    for (int idx = (int)blockIdx.x * 512 + F.tid; idx < NL * 256 * 1024; idx += F.G * 512) { const int l = idx >> 18, n = (idx >> 10) & 255, k = idx & 1023;
        dst[idx] = f2bf(n < 32 ? P.in[29][(size_t)l * 1024 + k] * P.in[31][(size_t)k * 32 + n] : 0.f); }
    const int gwv = (int)blockIdx.x * 8 + F.wave;
    if (gwv < NL * 32) { const int l = gwv >> 5, e = gwv & 31; float c1 = 0.f, c0 = 0.f;
#pragma unroll
        for (int j = 0; j < 16; ++j) { const int k = F.lane + 64 * j; const float w = P.in[31][(size_t)k * 32 + e]; c1 += P.in[29][(size_t)l * 1024 + k] * w; c0 += P.in[30][(size_t)l * 1024 + k] * w; }
        c1 = wave_sum(c1); c0 = wave_sum(c0);
        if (F.lane == 0) { rc[l * 64 + e] = c1; rc[l * 64 + 32 + e] = c0; } }
}
__device__ __forceinline__ void phase_x_to_bf16(Frame& F, const Params& P) {
    const size_t n8 = (size_t)T * D / 8; const float* x = P.in[0]; bf16_t* xb = WSP(bf16_t, WS_X); unsigned char* xq = WSP(unsigned char, WS_XQ);
    for (size_t i = (size_t)blockIdx.x * 512 + F.tid; i < n8; i += (size_t)F.G * 512) {
        const f32x4 a = *(const f32x4*)(x + i * 8), b = *(const f32x4*)(x + i * 8 + 4);
        u32x4 o; o.x = cvt_pk_bf16(a[0], a[1]); o.y = cvt_pk_bf16(a[2], a[3]); o.z = cvt_pk_bf16(b[0], b[1]); o.w = cvt_pk_bf16(b[2], b[3]);
        *(u32x4*)(xb + i * 8) = o;
        u32x2 qv; qv.x = pack_fp8x4(a[0], a[1], a[2], a[3]); qv.y = pack_fp8x4(b[0], b[1], b[2], b[3]); *(u32x2*)(xq + i * 8) = qv; }
}

struct SchedInproj { const char* X; const char* W; int G, c;
    __device__ __forceinline__ bool next(int i, ge::Unit& u) const { int pm, pn; if (!ge::static_tile((long)i * G + c, T / 256, NIN / 256, pm, pn)) return false;
        u.A = X + (size_t)pm * 256 * 1024; u.B = W + (size_t)pn * 256 * 1024; u.gat = nullptr; u.lda = 1024; u.ldb = 1024; u.nt = 8; u.gshift = 0; u.nvalid = 256; u.pm = pm; u.pn = pn; u.aux = 0; return true; } };
struct EpiInproj { static constexpr bool AFTER_DRAIN = false; bf16_t* rkv; bf16_t* sguz; bf16_t* convh; unsigned char* gates;
    typedef ge::NoPre Pre; __device__ __forceinline__ Pre prefetch(const ge::Unit&, int, int, int, int) const { return Pre{}; }
    __device__ __forceinline__ void operator()(const ge::Acc& acc, const ge::Unit& u, int wr, int wc, int fr, int fq, const Pre&) const {
        const int pn = u.pn; const int row0 = u.pm * 256 + wr * 64 + fr;
        int kind, ld, colt; bf16_t* base;
        if (pn < 7) { kind = 0; base = rkv; ld = RKVW; colt = pn * 256; }
        else if (pn < 9) { kind = 1; base = sguz; ld = 512; colt = (pn - 7) * 256; }
        else if (pn < 11) { kind = 2; base = convh; ld = 256; colt = (pn - 9) * 128; }
        else { kind = 3; base = rkv; ld = 3072; colt = (pn - 11) * 256; }
#pragma unroll
        for (int ai = 0; ai < 2; ++ai)
#pragma unroll
            for (int m = 0; m < 4; ++m) { const size_t r = (size_t)(row0 + ai * 128 + m * 16);
#pragma unroll
                for (int bj = 0; bj < 2; ++bj) { const int c = 128 * bj + 32 * wc + 8 * fq; f32x4 v0 = acc[ai][bj][m][0], v1 = acc[ai][bj][m][1];
                    if (kind == 2) {
                        const float h0 = v0[0] * sigmoidf_(v0[1]), h1 = v0[2] * sigmoidf_(v0[3]), h2 = v1[0] * sigmoidf_(v1[1]), h3 = v1[2] * sigmoidf_(v1[3]);
                        u32x2 w; w.x = cvt_pk_bf16(h0, h1); w.y = cvt_pk_bf16(h2, h3);
                        *(u32x2*)(base + r * ld + colt + (c >> 1)) = w;
                    } else if (kind == 3) {
                        u32x2 w; unsigned w0 = 0, w1 = 0;
                        w0 = __builtin_amdgcn_cvt_pk_u8_f32(255.f * sigmoidf_(v0[0]) + 0.5f, 0, w0); w0 = __builtin_amdgcn_cvt_pk_u8_f32(255.f * sigmoidf_(v0[1]) + 0.5f, 1, w0);
                        w0 = __builtin_amdgcn_cvt_pk_u8_f32(255.f * sigmoidf_(v0[2]) + 0.5f, 2, w0); w0 = __builtin_amdgcn_cvt_pk_u8_f32(255.f * sigmoidf_(v0[3]) + 0.5f, 3, w0);
                        w1 = __builtin_amdgcn_cvt_pk_u8_f32(255.f * sigmoidf_(v1[0]) + 0.5f, 0, w1); w1 = __builtin_amdgcn_cvt_pk_u8_f32(255.f * sigmoidf_(v1[1]) + 0.5f, 1, w1);
                        w1 = __builtin_amdgcn_cvt_pk_u8_f32(255.f * sigmoidf_(v1[2]) + 0.5f, 2, w1); w1 = __builtin_amdgcn_cvt_pk_u8_f32(255.f * sigmoidf_(v1[3]) + 0.5f, 3, w1);
                        w.x = w0; w.y = w1; *(u32x2*)(gates + r * 3072 + colt + c) = w;
                    } else {
                        if (kind == 1) {
#pragma unroll
                            for (int j = 0; j < 4; ++j) { v0[j] = gelu_f(v0[j]); v1[j] = gelu_f(v1[j]); } }
                        u32x4 w; w.x = cvt_pk_bf16(v0[0], v0[1]); w.y = cvt_pk_bf16(v0[2], v0[3]); w.z = cvt_pk_bf16(v1[0], v1[1]); w.w = cvt_pk_bf16(v1[2], v1[3]);
                        *(u32x4*)(base + r * ld + colt + c) = w; } } }
    } };
struct SchedBranch { const char* ws; size_t woff; int G, v;
    __device__ __forceinline__ bool next(int i, ge::Unit& u) const { const int tile = (i / 3) * G + v, br = i % 3, pm = tile >> 2, pn = tile & 3; if (tile >= 512) return false;
        const unsigned kb = (br == 0) ? 512u : 256u;
        size_t ao = WS_OUTA, wo = woff; if (br == 1) { ao = WS_HB; wo += (size_t)1024 * 512; } if (br == 2) { ao = WS_HC; wo += (size_t)1024 * 512 + (size_t)1024 * 256; }
        u.A = ws + ao + (size_t)pm * 256 * kb; u.lda = kb; u.nt = (int)(kb >> 7); u.B = ws + wo + (size_t)pn * 256 * kb; u.ldb = kb;
        u.gat = nullptr; u.gshift = 0; u.nvalid = 256; u.pm = pm; u.pn = pn; u.aux = br; return true; } };
struct EpiBranch { static constexpr bool AFTER_DRAIN = false; const unsigned char* gates; bf16_t* merged; unsigned char* mq;
    typedef ge::NoPre Pre; __device__ __forceinline__ Pre prefetch(const ge::Unit&, int, int, int, int) const { return Pre{}; }
    __device__ __forceinline__ void operator()(const ge::Acc& acc, const ge::Unit& u, int wr, int wc, int fr, int fq, const Pre&) const {
        const int br = u.aux; const int row0 = u.pm * 256 + wr * 64 + fr;
        u32x2 gall[16];
#pragma unroll
        for (int i = 0; i < 16; ++i) { const size_t r = (size_t)(row0 + (i >> 3) * 128 + ((i >> 1) & 3) * 16); const int c = u.pn * 256 + 128 * (i & 1) + 32 * wc + 8 * fq; gall[i] = *(const u32x2*)(gates + r * 3072 + br * 1024 + c); }
#pragma unroll
        for (int ai = 0; ai < 2; ++ai) {
            u32x2 g[8]; u32x4 p[8];
#pragma unroll
            for (int m = 0; m < 4; ++m)
#pragma unroll
                for (int bj = 0; bj < 2; ++bj) { const size_t r = (size_t)(row0 + ai * 128 + m * 16); const int c = u.pn * 256 + 128 * bj + 32 * wc + 8 * fq;
                    g[m * 2 + bj] = gall[ai * 8 + m * 2 + bj];
                    p[m * 2 + bj] = (br > 0) ? *(const u32x4*)(merged + r * 1024 + c) : (u32x4){0u, 0u, 0u, 0u}; }
#pragma unroll
            for (int m = 0; m < 4; ++m)
#pragma unroll
                for (int bj = 0; bj < 2; ++bj) { const size_t r = (size_t)(row0 + ai * 128 + m * 16); const int c = u.pn * 256 + 128 * bj + 32 * wc + 8 * fq;
                    const f32x4 v0 = acc[ai][bj][m][0], v1 = acc[ai][bj][m][1]; const u32x2 gg = g[m * 2 + bj]; const u32x4 pp = p[m * 2 + bj];
                    const float k = 1.f / 255.f;
                    const float g0 = k * (float)(gg.x & 0xffu), g1 = k * (float)((gg.x >> 8) & 0xffu), g2 = k * (float)((gg.x >> 16) & 0xffu), g3 = k * (float)(gg.x >> 24);
                    const float g4 = k * (float)(gg.y & 0xffu), g5 = k * (float)((gg.y >> 8) & 0xffu), g6 = k * (float)((gg.y >> 16) & 0xffu), g7 = k * (float)(gg.y >> 24);
                    u32x4 w; w.x = cvt_pk_bf16(v0[0] * g0 + bflo(pp.x), v0[1] * g1 + bfhi(pp.x)); w.y = cvt_pk_bf16(v0[2] * g2 + bflo(pp.y), v0[3] * g3 + bfhi(pp.y));
                    w.z = cvt_pk_bf16(v1[0] * g4 + bflo(pp.z), v1[1] * g5 + bfhi(pp.z)); w.w = cvt_pk_bf16(v1[2] * g6 + bflo(pp.w), v1[3] * g7 + bfhi(pp.w));
                    if (br == 2) { u32x2 wq; wq.x = pack_fp8x4(4.f * (v0[0] * g0 + bflo(pp.x)), 4.f * (v0[1] * g1 + bfhi(pp.x)), 4.f * (v0[2] * g2 + bflo(pp.y)), 4.f * (v0[3] * g3 + bfhi(pp.y)));
                        wq.y = pack_fp8x4(4.f * (v1[0] * g4 + bflo(pp.z)), 4.f * (v1[1] * g5 + bfhi(pp.z)), 4.f * (v1[2] * g6 + bflo(pp.w)), 4.f * (v1[3] * g7 + bfhi(pp.w))); *(u32x2*)(mq + r * 1024 + c) = wq; }
                    else *(u32x4*)(merged + r * 1024 + c) = w; }
            asm volatile("" ::: "memory"); }
    } };
struct SchedWout { const char* A; const char* W; int G, v;
    __device__ __forceinline__ bool next(int i, ge::Unit& u) const { const int tile = i * G + v, pm = tile >> 2, pn = tile & 3; if (tile >= 512) return false;
        u.A = A + (size_t)pm * 256 * 1024; u.B = W + (size_t)pn * 256 * 1024; u.gat = nullptr; u.lda = 1024; u.ldb = 1024; u.nt = 8; u.gshift = 0; u.nvalid = 256; u.pm = pm; u.pn = pn; u.aux = 0; return true; } };
struct EpiWout { static constexpr bool AFTER_DRAIN = false; const bf16_t* x; bf16_t* pre; float* stats;
    typedef ge::NoPre Pre; __device__ __forceinline__ Pre prefetch(const ge::Unit&, int, int, int, int) const { return Pre{}; }
    __device__ __forceinline__ void operator()(const ge::Acc& acc, const ge::Unit& u, int wr, int wc, int fr, int fq, const Pre&) const {
        const int row0 = u.pm * 256 + wr * 64 + fr;
#pragma unroll
        for (int ai = 0; ai < 2; ++ai) {
            u32x4 xr[8];
#pragma unroll
            for (int m = 0; m < 4; ++m)
#pragma unroll
                for (int bj = 0; bj < 2; ++bj) xr[m * 2 + bj] = *(const u32x4*)(x + (size_t)(row0 + ai * 128 + m * 16) * 1024 + u.pn * 256 + 128 * bj + 32 * wc + 8 * fq);
#pragma unroll
            for (int m = 0; m < 4; ++m) { const size_t r = (size_t)(row0 + ai * 128 + m * 16); float s1 = 0.f, s2 = 0.f;
#pragma unroll
                for (int bj = 0; bj < 2; ++bj) { const int c = u.pn * 256 + 128 * bj + 32 * wc + 8 * fq; const f32x4 v0 = acc[ai][bj][m][0], v1 = acc[ai][bj][m][1];
                    const u32x4 p = xr[m * 2 + bj];
                    u32x4 w; w.x = cvt_pk_bf16(v0[0] + ALPHA * bflo(p.x), v0[1] + ALPHA * bfhi(p.x)); w.y = cvt_pk_bf16(v0[2] + ALPHA * bflo(p.y), v0[3] + ALPHA * bfhi(p.y));
                    w.z = cvt_pk_bf16(v1[0] + ALPHA * bflo(p.z), v1[1] + ALPHA * bfhi(p.z)); w.w = cvt_pk_bf16(v1[2] + ALPHA * bflo(p.w), v1[3] + ALPHA * bfhi(p.w));
                    *(u32x4*)(pre + r * 1024 + c) = w;
                    const float q0 = bflo(w.x), q1 = bfhi(w.x), q2 = bflo(w.y), q3 = bfhi(w.y), q4 = bflo(w.z), q5 = bfhi(w.z), q6 = bflo(w.w), q7 = bfhi(w.w);
                    s1 += ((q0 + q1) + (q2 + q3)) + ((q4 + q5) + (q6 + q7)); s2 += ((q0 * q0 + q1 * q1) + (q2 * q2 + q3 * q3)) + ((q4 * q4 + q5 * q5) + (q6 * q6 + q7 * q7)); }
                s1 += __shfl_xor(s1, 16); s2 += __shfl_xor(s2, 16); s1 += __shfl_xor(s1, 32); s2 += __shfl_xor(s2, 32);
                if (fq == 0) *(f32x2*)(stats + (r * 16 + u.pn * 4 + wc) * 2) = (f32x2){s1, s2}; }
            asm volatile("" ::: "memory"); }
    } };
struct SchedRouter { const char* A; const char* W; int G, v;
    __device__ __forceinline__ bool next(int i, ge::Unit& u) const { const int pm = i * G + v; if (pm >= 128) return false;
        u.A = A + (size_t)pm * 256 * 2048; u.B = W; u.gat = nullptr; u.lda = 2048; u.ldb = 2048; u.nt = 16; u.gshift = 0; u.nvalid = 256; u.pm = pm; u.pn = 0; u.aux = 0; return true; } };
struct EpiRouter { static constexpr bool AFTER_DRAIN = true; const float* rbias; unsigned* cnt; int* list; const float* stats; const float* rc;
    typedef ge::NoPre Pre; __device__ __forceinline__ Pre prefetch(const ge::Unit&, int, int, int, int) const { return Pre{}; }
    __device__ __forceinline__ void drained(const ge::Acc& acc, const ge::Unit& u, int wr, int wc, int fr, int fq, LAS unsigned char* lds) const {
        LAS int* lcnt = (LAS int*)lds; LAS int* lbase = lcnt + 32;
        const bool t32 = (wr == 0 && wc == 0 && fq < 2); const int t = fq * 16 + fr;
        if (t32) lcnt[t] = 0;
        __syncthreads();
        int e1[8], e2[8], r1[8], r2[8]; float g1[8], g2[8];
        const int row0 = u.pm * 256 + wr * 64 + fr;
        if (wc == 0) {
            float bias[8], c1v[8], c0v[8];
#pragma unroll
            for (int j = 0; j < 8; ++j) { bias[j] = rbias[8 * fq + j]; c1v[j] = rc[8 * fq + j]; c0v[j] = rc[32 + 8 * fq + j]; }
            f32x4 sa0[8], sa1[8];
#pragma unroll
            for (int i8 = 0; i8 < 8; ++i8) { const size_t r = (size_t)(row0 + (i8 >> 2) * 128 + (i8 & 3) * 16); sa0[i8] = *(const f32x4*)(stats + (r * 16 + 4 * fq) * 2); sa1[i8] = *(const f32x4*)(stats + (r * 16 + 4 * fq + 2) * 2); }
#pragma unroll
            for (int ai = 0; ai < 2; ++ai)
#pragma unroll
                for (int m = 0; m < 4; ++m) { const int i8 = ai * 4 + m;
                    const f32x4 v0 = acc[ai][0][m][0], v1 = acc[ai][0][m][1];
                    float mean, rstd;
                    {   const f32x4 a0 = sa0[i8], a1 = sa1[i8];
                        float s1 = (a0[0] + a0[2]) + (a1[0] + a1[2]), s2 = (a0[1] + a0[3]) + (a1[1] + a1[3]);
                        s1 += __shfl_xor(s1, 16); s2 += __shfl_xor(s2, 16); s1 += __shfl_xor(s1, 32); s2 += __shfl_xor(s2, 32);
                        mean = s1 * (1.f / 1024.f); rstd = rsqrtf(fmaxf(s2 * (1.f / 1024.f) - mean * mean, 0.f) + LN_EPS); }
                    float s[8], sel[8];
#pragma unroll
                    for (int j = 0; j < 4; ++j) { s[j] = sigmoidf_(rstd * (v0[j] - mean * c1v[j]) + c0v[j]); s[4 + j] = sigmoidf_(rstd * (v1[j] - mean * c1v[4 + j]) + c0v[4 + j]); }
#pragma unroll
                    for (int j = 0; j < 8; ++j) sel[j] = s[j] + bias[j];
                    int i1 = 0; float m1 = sel[0];
#pragma unroll
                    for (int j = 1; j < 8; ++j) if (sel[j] > m1) { m1 = sel[j]; i1 = j; }
                    int i2 = (i1 == 0) ? 1 : 0; float m2 = (i1 == 0) ? sel[1] : sel[0];
#pragma unroll
                    for (int j = 0; j < 8; ++j) if (j != i1 && j != ((i1 == 0) ? 1 : 0) && sel[j] > m2) { m2 = sel[j]; i2 = j; }
                    float gs = m1 + m2; int gi = fq;
                    { const float os = __shfl_xor(gs, 16); const int oi = __shfl_xor(gi, 16); if (os > gs || (os == gs && oi < gi)) { gs = os; gi = oi; } }
                    { const float os = __shfl_xor(gs, 32); const int oi = __shfl_xor(gi, 32); if (os > gs || (os == gs && oi < gi)) { gs = os; gi = oi; } }
                    e1[i8] = -1; e2[i8] = -1; r1[i8] = 0; r2[i8] = 0; g1[i8] = 0.f; g2[i8] = 0.f;
                    if (gi == fq) {
                        float s1 = s[0], s2 = s[0];
#pragma unroll
                        for (int j = 0; j < 8; ++j) { s1 = (j == i1) ? s[j] : s1; s2 = (j == i2) ? s[j] : s2; }
                        const float inv = 1.0f / (s1 + s2);
                        e1[i8] = 8 * fq + i1; e2[i8] = 8 * fq + i2; g1[i8] = s1 * inv; g2[i8] = s2 * inv;
                        r1[i8] = __hip_atomic_fetch_add(lcnt + e1[i8], 1, __ATOMIC_RELAXED, __HIP_MEMORY_SCOPE_WORKGROUP);
                        r2[i8] = __hip_atomic_fetch_add(lcnt + e2[i8], 1, __ATOMIC_RELAXED, __HIP_MEMORY_SCOPE_WORKGROUP); } }
        }
        __syncthreads();
        if (t32) { const int c = lcnt[t]; lbase[t] = (c > 0) ? (int)atomicAdd(cnt + t, (unsigned)c) : 0; }
        __syncthreads();
        if (wc == 0) {
#pragma unroll
            for (int i8 = 0; i8 < 8; ++i8) if (e1[i8] >= 0) { const int r = row0 + (i8 >> 2) * 128 + (i8 & 3) * 16;
                u32x2 p1, p2; p1.x = (unsigned)(2 * r); p1.y = __float_as_uint(g1[i8]); p2.x = (unsigned)(2 * r + 1); p2.y = __float_as_uint(g2[i8]);
                *(u32x2*)(list + ((size_t)e1[i8] * T + lbase[e1[i8]] + r1[i8]) * 2) = p1; *(u32x2*)(list + ((size_t)e2[i8] * T + lbase[e2[i8]] + r2[i8]) * 2) = p2; } }
        __syncthreads();
    } };
__device__ __forceinline__ int build_tile_table(Frame& F, const unsigned* cnt) {
    volatile LAS int* tab = (volatile LAS int*)(F.lds + LDS_MISC + 64);
    __syncthreads();
    if (F.wave == 0) {
        const int e = F.lane & 31; const int c = (int)__hip_atomic_load(cnt + e, __ATOMIC_RELAXED, __HIP_MEMORY_SCOPE_AGENT); const int nt = (F.lane < 32) ? ((c + 255) >> 8) : 0;
        int incl = nt;
#pragma unroll
        for (int o = 1; o < 32; o <<= 1) { const int up = __shfl_up(incl, o); if ((F.lane & 31) >= o) incl += up; }
        const int base = incl - nt;
        if (F.lane < 32) for (int j = 0; j < nt; ++j) tab[1 + base + j] = (e << 16) | j;
        if (F.lane == 31) tab[0] = incl; }
    __syncthreads();
    return tab[0];
}
struct SchedMoe1 { const char* X1; const char* W; const int* list; const unsigned* cnt; LAS int* tab; int ntiles, G, v;
    __device__ __forceinline__ bool next(int i, ge::Unit& u) const { const int L = i * G + v, rt = L >> 2, pn = L & 3; if (rt >= ntiles) return false;
        const int ej = tab[1 + rt], e = ej >> 16, j = ej & 0xffff; const int c = (int)cnt[e];
        u.A = X1; u.gat = list + ((size_t)e * T + j * 256) * 2; u.gshift = 1; u.nvalid = (c - j * 256) < 256 ? (c - j * 256) : 256; u.lda = 1024; u.nt = 8;
        u.B = W + ((size_t)e * 1024 + (size_t)pn * 256) * 1024; u.ldb = 1024; u.pm = rt; u.pn = pn; u.aux = e; return true; } };
struct EpiMoe1 { static constexpr bool AFTER_DRAIN = false; unsigned char* H;
    typedef ge::NoPre Pre; __device__ __forceinline__ Pre prefetch(const ge::Unit&, int, int, int, int) const { return Pre{}; }
    __device__ __forceinline__ void operator()(const ge::Acc& acc, const ge::Unit& u, int wr, int wc, int fr, int fq, const Pre&) const {
        const int row0 = u.pm * 256 + wr * 64 + fr;
#pragma unroll
        for (int ai = 0; ai < 2; ++ai)
#pragma unroll
            for (int m = 0; m < 4; ++m) { const size_t r = (size_t)(row0 + ai * 128 + m * 16);
#pragma unroll
                for (int bj = 0; bj < 2; ++bj) { const int c = 128 * bj + 32 * wc + 8 * fq; const f32x4 v0 = acc[ai][bj][m][0], v1 = acc[ai][bj][m][1];
                    const float h0 = v0[0] * sigmoidf_(v0[0]) * v0[1], h1 = v0[2] * sigmoidf_(v0[2]) * v0[3], h2 = v1[0] * sigmoidf_(v1[0]) * v1[1], h3 = v1[2] * sigmoidf_(v1[2]) * v1[3];
                    *(unsigned*)(H + r * 512 + u.pn * 128 + (c >> 1)) = pack_fp8x4(h0, h1, h2, h3); }
                asm volatile("" ::: "memory"); }
    } };
struct SchedMoe2 { const char* H; const char* W; const int* list; const unsigned* cnt; LAS int* tab; int ntiles, G, v, ntk;
    __device__ __forceinline__ bool next(int i, ge::Unit& u) const { const int L = i * G + v, rt = L >> 2, pn = L & 3; if (rt >= ntiles) return false;
        const int ej = tab[1 + rt], e = ej >> 16, j = ej & 0xffff; const int c = (int)cnt[e];
        u.A = H + (size_t)rt * 256 * 512; u.gat = nullptr; u.gshift = 0; u.nvalid = (c - j * 256) < 256 ? (c - j * 256) : 256; u.lda = 512; u.nt = ntk;
        u.B = W + ((size_t)e * 1024 + (size_t)pn * 256) * 512; u.ldb = 512; u.pm = rt; u.pn = pn; u.aux = (e << 16) | j; return true; } };
template <int MODE> struct EpiMoe2T { static constexpr bool AFTER_DRAIN = false; const int* list; unsigned char* Y; int* inv;
    typedef ge::NoPre Pre; __device__ __forceinline__ Pre prefetch(const ge::Unit&, int, int, int, int) const { return Pre{}; }
    __device__ __forceinline__ void operator()(const ge::Acc& acc, const ge::Unit& u, int wr, int wc, int fr, int fq, const Pre&) const {
        const int e = u.aux >> 16, j = u.aux & 0xffff; const int* lst = list + ((size_t)e * T + j * 256) * 2;
        const unsigned row0 = (unsigned)u.pm * 256u + (unsigned)(wr * 64 + fr); const unsigned col0 = (unsigned)(u.pn * 256 + 32 * wc + 8 * fq);
        const bool invw = (u.pn == 0 && wc == 0 && fq == 0);
        u32x2 sgall[8];
#pragma unroll
        for (int i8 = 0; i8 < 8; ++i8) { const int rr = (i8 >> 2) * 128 + wr * 64 + (i8 & 3) * 16 + fr; const u32x2 v = *(const u32x2*)(lst + 2 * (rr < u.nvalid ? rr : 0)); sgall[i8].x = (rr < u.nvalid) ? v.x : 0xffffffffu; sgall[i8].y = v.y; }
#pragma unroll
        for (int ai = 0; ai < 2; ++ai) {
            u32x2 sg[4];
#pragma unroll
            for (int m = 0; m < 4; ++m) sg[m] = sgall[ai * 4 + m];
#pragma unroll
            for (int m = 0; m < 4; ++m) { const int sl = (int)sg[m].x; const float gg = __uint_as_float(sg[m].y);
                const unsigned yrow = row0 + (unsigned)(ai * 128 + m * 16);
                if (MODE == 1) { if (sl == 0x7ffffff0) Y[0] = (unsigned char)pack_fp8x4(acc[ai][0][m][0][0] * gg, 0.f, 0.f, 0.f); }
                else if (sl >= 0) {
                    if (invw) inv[sl] = (int)yrow;
#pragma unroll
                    for (int bj = 0; bj < 2; ++bj) { const f32x4 v0 = acc[ai][bj][m][0], v1 = acc[ai][bj][m][1];
                        const float g8 = 8.f * gg; u32x2 w; w.x = pack_fp8x4(g8 * v0[0], g8 * v0[1], g8 * v0[2], g8 * v0[3]); w.y = pack_fp8x4(g8 * v1[0], g8 * v1[1], g8 * v1[2], g8 * v1[3]);
                        *(u32x2*)(Y + (yrow * 1024u + col0 + 128u * bj)) = w; } } }
            asm volatile("" ::: "memory"); }
    } };
typedef EpiMoe2T<0> EpiMoe2;
typedef short bf16x4 __attribute__((ext_vector_type(4)));
#define MFMA16(a, b, c) __builtin_amdgcn_mfma_f32_16x16x16bf16_1k(a, b, c, 0, 0, 0)
#define MFMA32(a, b, c) __builtin_amdgcn_mfma_f32_16x16x32_bf16(a, b, c, 0, 0, 0)
__device__ __forceinline__ bf16x4 pack4(const f32x4 v) { u32x2 w; w.x = cvt_pk_bf16(v[0], v[1]); w.y = cvt_pk_bf16(v[2], v[3]); return __builtin_bit_cast(bf16x4, w); }
__device__ __forceinline__ f32x4 unpack4(const u32x2 w) { return (f32x4){bflo(w.x), bfhi(w.x), bflo(w.y), bfhi(w.y)}; }
constexpr int TP = 72;
constexpr int TILE_B = 64 * TP * 2;
constexpr int LA_ACT = 0;
constexpr int LA_AT = 13312, LA_RT = LA_AT + TILE_B, LA_BT = LA_RT + TILE_B, LA_KT = LA_BT + TILE_B;
constexpr int LA_BTT = LA_KT + TILE_B, LA_KTT = LA_BTT + TILE_B, LA_VT = LA_KTT + TILE_B;
constexpr int LA_AAB = LA_VT + TILE_B, LA_AAK = LA_AAB + TILE_B, LA_ARB = LA_AAK + TILE_B, LA_ARK = LA_ARB + TILE_B;
constexpr int LA_DIAG = LA_ARK + TILE_B;
constexpr int LA_TII = LA_DIAG + 4096;
constexpr int LA_SEG = LA_TII + 3072;
constexpr int LA_KSQ = LA_SEG + 4096;
constexpr int LA_RKP = LA_KSQ + 1024;
constexpr int LA_PC = LA_RKP + 1024;
static_assert(LA_PC + 256 <= LDS_STAGE, "pass A LDS map");

template <bool EONLY> __device__ __forceinline__ void phase_wkv_a(Frame& F, const Params& P, int l) {
    LAS unsigned char* lds = F.lds;
    const bf16_t* rkv = WSP(bf16_t, WS_RKV);
    const bf16_t* wupT = WSP(bf16_t, WS_LORA) + (size_t)l * 512 * 32;
    const bf16_t* aupT = WSP(bf16_t, WS_LORA) + (size_t)(4 + l) * 512 * 32;
    const bf16_t* vupT = WSP(bf16_t, WS_LORA) + (size_t)(8 + (l > 0 ? l - 1 : 0)) * 512 * 32;
    const float* mu = P.in[3] + (size_t)l * 1696; const float* muv = (l > 0) ? P.in[4] + (size_t)(l - 1) * 32 : nullptr;
    bf16_t* PHI = WSP(bf16_t, WS_PHI); bf16_t* PSI = WSP(bf16_t, WS_PSI); bf16_t* GT = WSP(bf16_t, WS_GT); bf16_t* Y0T = WSP(bf16_t, WS_Y0T); bf16_t* VT = WSP(bf16_t, WS_VT); bf16_t* VF = WSP(bf16_t, WS_VFIRST);
    float* RK = WSP(float, WS_RK);
    const int lane = F.lane, w = F.wave, cb = w & 3, th = w >> 2;
#define WKVA_RAW_LOAD(dst, hn) do { _Pragma("unroll") for (int i_ = 0; i_ < 4; ++i_) { const int p_ = F.tid + 512 * i_; const int pc_ = p_ < 1560 ? p_ : 1559; const int row_ = pc_ / 24, rem_ = pc_ % 24; \
        const int tok_ = (row_ == 0 && firstchunk) ? t0 : t0 - 1 + row_; dst[i_] = *(const u32x4*)(rkv + (size_t)tok_ * RKVW + (rem_ >> 3) * 512 + (hn) * 64 + (rem_ & 7) * 8); } } while (0)
#define WKVA_RAW_STORE(src) do { _Pragma("unroll") for (int i_ = 0; i_ < 4; ++i_) { const int p_ = F.tid + 512 * i_; if (p_ < 1560) { const int row_ = p_ / 24, rem_ = p_ % 24; \
        *(LAS u32x4*)(lds + LDS_RAW + (row_ * 192 + (rem_ >> 3) * 64 + (rem_ & 7) * 8) * 2) = src[i_]; } } } while (0)
    for (int unit = blockIdx.x; unit < T / 64; unit += F.G) {
        const int t0 = unit * 64; const bool firstchunk = (t0 & (SEQ - 1)) == 0;
        __syncthreads();
        { u32x4 r0_[4]; WKVA_RAW_LOAD(r0_, 0); WKVA_RAW_STORE(r0_); }
        for (int idx = F.tid; idx < 64 * 96; idx += 512) { const int tok = idx / 96, qq = idx % 96; const int col = (qq < 64) ? 1536 + qq : 1536 + 96 + qq;
            const int t = t0 + tok;
            const bool hp = (tok > 0 || !firstchunk); const float p = bf2f(rkv[(size_t)t * RKVW + col]); const float ppl = bf2f(rkv[(size_t)(hp ? t - 1 : t) * RKVW + col]); const float pp = hp ? ppl : 0.f;
            const float m_ = (qq < 64) ? mu[1536 + qq] : ((l > 0) ? P.in[4][(size_t)(l > 0 ? l - 1 : 0) * 32 + qq - 64] : 0.f);
            float val = p + (pp - p) * m_; if (qq < 32) val = tanhf(val);
            *(LAS bf16_t*)(lds + LA_ACT + (tok * 104 + qq) * 2) = f2bf(val); }
        __syncthreads();
        for (int h = 0; h < 8; ++h) {
            int lz = lane; asm volatile("" : "+v"(lz)); const int c = lz & 15, q = lz >> 4;
            const int chid = unit * 8 + h; const int ch = 16 * cb + c, chg = h * 64 + ch;
            f32x4 zw[2], za[2], zv[2];
            {   const bf16x8 bw = *(const bf16x8*)(wupT + (size_t)chg * 32 + 8 * q), ba = *(const bf16x8*)(aupT + (size_t)chg * 32 + 8 * q), bv = *(const bf16x8*)(vupT + (size_t)chg * 32 + 8 * q);
#pragma unroll
                for (int ii = 0; ii < 2; ++ii) { const int i = 2 * th + ii; const LAS unsigned char* ar = lds + LA_ACT + ((16 * i + c) * 104 + 8 * q) * 2;
                    const bf16x8 a0 = *(const LAS bf16x8*)(ar), a1 = *(const LAS bf16x8*)(ar + 64), a2 = *(const LAS bf16x8*)(ar + 128);
                    const f32x4 z = {0.f, 0.f, 0.f, 0.f};
                    zw[ii] = MFMA32(a0, bw, z); za[ii] = MFMA32(a1, ba, z); zv[ii] = MFMA32(a2, bv, z); } }
            const float mu_r = mu[chg], mu_k = mu[512 + chg], mu_v = mu[1024 + chg];
            const float w0 = P.in[5][(size_t)l * 512 + chg], a0_ = P.in[7][(size_t)l * 512 + chg], v0_ = (l > 0) ? P.in[10][(size_t)(l - 1) * 512 + chg] : 0.f;
            const float k_k = P.in[12][(size_t)l * 512 + chg], k_a = P.in[13][(size_t)l * 512 + chg], r_k = P.in[14][(size_t)l * 512 + chg];
            float rr[2][4], kh[2][4], vv[2][4], lw[2][4], ic[2][4], kkr[2][4];
#pragma unroll
            for (int ii = 0; ii < 2; ++ii) { const int i = 2 * th + ii; const int tl0 = 16 * i + 4 * q;
                const bool hasprev = (tl0 > 0) || !firstchunk;
                const LAS unsigned char* rb = lds + LDS_RAW + (tl0 * 192 + ch) * 2;
                const float lpr = bf2f(*(const LAS bf16_t*)(rb)), lpk = bf2f(*(const LAS bf16_t*)(rb + 128)), lpv = bf2f(*(const LAS bf16_t*)(rb + 256));
                float pr = hasprev ? lpr : 0.f, pk = hasprev ? lpk : 0.f, pv = hasprev ? lpv : 0.f;
                f32x4 vf = {0.f, 0.f, 0.f, 0.f};
                if (l > 0) vf = unpack4(*(const u32x2*)(VF + ((size_t)chid * 64 + ch) * 64 + tl0));
                float lsum = 0.f;
#pragma unroll
                for (int r = 0; r < 4; ++r) { const LAS unsigned char* rc_ = rb + (r + 1) * 384; const float cr = bf2f(*(const LAS bf16_t*)(rc_)), ck = bf2f(*(const LAS bf16_t*)(rc_ + 128)), cv = bf2f(*(const LAS bf16_t*)(rc_ + 256));
                    const float r_ = cr + (pr - cr) * mu_r, k_ = ck + (pk - ck) * mu_k; float v_ = cv + (pv - cv) * mu_v; pr = cr; pk = ck; pv = cv;
                    const float lw_ = -0.6065306597126334f * sigmoidf_(w0 + zw[ii][r]); const float icl = sigmoidf_(a0_ + za[ii][r]);
                    if (l > 0) v_ = v_ + (vf[r] - v_) * sigmoidf_(v0_ + zv[ii][r]);
                    const float kk_ = k_ * k_k, kh_ = k_ * (1.0f + (icl - 1.0f) * k_a);
                    rr[ii][r] = r_; kh[ii][r] = kh_; vv[ii][r] = v_; lw[ii][r] = lw_; ic[ii][r] = icl; kkr[ii][r] = kk_; lsum += lw_;
                    const float s1 = row16_sum(kk_ * kk_), s2 = row16_sum(r_ * kh_ * r_k);
                    *(LAS float*)(lds + LA_KSQ + (cb * 64 + tl0 + r) * 4) = s1; *(LAS float*)(lds + LA_RKP + (cb * 64 + tl0 + r) * 4) = s2; }
                *(LAS float*)(lds + LA_SEG + (ch * 16 + i * 4 + q) * 4) = lsum; }
            __syncthreads();
            u32x4 nraw[4]; if (h < 7) WKVA_RAW_LOAD(nraw, h + 1);
            {   float seg[16];
#pragma unroll
                for (int j4 = 0; j4 < 4; ++j4) { const f32x4 s4 = *(const LAS f32x4*)(lds + LA_SEG + (ch * 16 + 4 * j4) * 4); seg[4 * j4] = s4[0]; seg[4 * j4 + 1] = s4[1]; seg[4 * j4 + 2] = s4[2]; seg[4 * j4 + 3] = s4[3]; }
                float tot = 0.f;
#pragma unroll
                for (int j = 0; j < 16; ++j) tot += seg[j];
                if (th == 0) *(LAS float*)(lds + LA_PC + ch * 4) = __expf(tot);
                float mine[8];
#pragma unroll
                for (int j = 0; j < 8; ++j) mine[j] = th ? seg[8 + j] : seg[j];
                const float firsthalf = th ? (((seg[0] + seg[1]) + (seg[2] + seg[3])) + ((seg[4] + seg[5]) + (seg[6] + seg[7]))) : 0.f;
#pragma unroll
                for (int ii = 0; ii < 2; ++ii) { const int i = 2 * th + ii; const int tl0 = 16 * i + 4 * q; const int sidx = i * 4 + q;
                    float cum = firsthalf + (ii ? ((mine[0] + mine[1]) + (mine[2] + mine[3])) : 0.f);
                    { const float s0 = mine[4 * ii], s1 = mine[4 * ii + 1], s2 = mine[4 * ii + 2]; cum += (q > 0 ? s0 : 0.f) + (q > 1 ? s1 : 0.f) + (q > 2 ? s2 : 0.f); }
                    f32x4 at, rt, bt, kt;
#pragma unroll
                    for (int r = 0; r < 4; ++r) { const int tl = tl0 + r;
                        const float ks = (*(const LAS float*)(lds + LA_KSQ + tl * 4) + *(const LAS float*)(lds + LA_KSQ + (64 + tl) * 4)) + (*(const LAS float*)(lds + LA_KSQ + (128 + tl) * 4) + *(const LAS float*)(lds + LA_KSQ + (192 + tl) * 4));
                        const float kk_ = kkr[ii][r] * __builtin_amdgcn_rsqf(fmaxf(ks, 1e-24f));
                        const float cumx = cum; cum += lw[ii][r];
                        const float ex = __expf(cumx), ei = __expf(cum), en = __expf(-cum);
                        at[r] = -kk_ * ex; rt[r] = rr[ii][r] * ei; bt[r] = kk_ * ic[ii][r] * en; kt[r] = kh[ii][r] * en;

                        *(LAS bf16_t*)(lds + LA_AT + (tl * TP + ch) * 2) = f2bf(at[r]); *(LAS bf16_t*)(lds + LA_RT + (tl * TP + ch) * 2) = f2bf(rt[r]);
                        *(LAS bf16_t*)(lds + LA_BT + (tl * TP + ch) * 2) = f2bf(bt[r]); *(LAS bf16_t*)(lds + LA_KT + (tl * TP + ch) * 2) = f2bf(kt[r]);
                        if (cb == 0) { const float rk = (*(const LAS float*)(lds + LA_RKP + tl * 4) + *(const LAS float*)(lds + LA_RKP + (64 + tl) * 4)) + (*(const LAS float*)(lds + LA_RKP + (128 + tl) * 4) + *(const LAS float*)(lds + LA_RKP + (192 + tl) * 4));
                            if (c == 0) RK[(size_t)(t0 + tl) * 8 + h] = rk; } }
                    const f32x4 v4 = {vv[ii][0], vv[ii][1], vv[ii][2], vv[ii][3]};
                    *(LAS bf16x4*)(lds + LA_BTT + (ch * TP + tl0) * 2) = pack4(bt); *(LAS bf16x4*)(lds + LA_KTT + (ch * TP + tl0) * 2) = pack4(kt); *(LAS bf16x4*)(lds + LA_VT + (ch * TP + tl0) * 2) = pack4(v4);
                    *(bf16x4*)(VT + ((size_t)chid * 64 + ch) * 64 + tl0) = pack4(v4);
                    if (l == 0) *(bf16x4*)(VF + ((size_t)chid * 64 + ch) * 64 + tl0) = pack4(v4); } }
            __syncthreads();
            if (EONLY) { if (h < 7) WKVA_RAW_STORE(nraw); __syncthreads(); continue; }
            {   const bool isR = w >= 4; const int i = w & 3;
                const LAS unsigned char* brow = lds + (isR ? LA_RT : LA_AT) + ((16 * i + c) * TP + 8 * q) * 2;
                const bf16x8 bf0 = *(const LAS bf16x8*)(brow), bf1 = *(const LAS bf16x8*)(brow + 64);
                LAS unsigned char* ob = lds + (isR ? LA_ARB : LA_AAB); LAS unsigned char* ok = lds + (isR ? LA_ARK : LA_AAK);
                const int tloc = 16 * i + c;
#pragma unroll
                for (int j = 0; j < 4; ++j) { f32x4 db = {0.f, 0.f, 0.f, 0.f}, dk = {0.f, 0.f, 0.f, 0.f};
                    if (j <= i) { const LAS unsigned char* arb = lds + LA_BT + ((16 * j + c) * TP + 8 * q) * 2; const LAS unsigned char* ark = lds + LA_KT + ((16 * j + c) * TP + 8 * q) * 2;
                        db = MFMA32(*(const LAS bf16x8*)(arb), bf0, db); db = MFMA32(*(const LAS bf16x8*)(arb + 64), bf1, db);
                        dk = MFMA32(*(const LAS bf16x8*)(ark), bf0, dk); dk = MFMA32(*(const LAS bf16x8*)(ark + 64), bf1, dk);
                        if (j == i) {
#pragma unroll
                            for (int r = 0; r < 4; ++r) { const int s = 16 * j + 4 * q + r; const bool keep = isR ? (s <= tloc) : (s < tloc); db[r] = keep ? db[r] : 0.f; dk[r] = keep ? dk[r] : 0.f; }
                            if (!isR) *(LAS f32x4*)(lds + LA_DIAG + ((i * 16 + c) * 16 + 4 * q) * 4) = db; } }

                    *(LAS bf16x4*)(ob + (tloc * TP + 16 * j + 4 * q) * 2) = pack4(db); *(LAS bf16x4*)(ok + (tloc * TP + 16 * j + 4 * q) * 2) = pack4(dk); } }
            __syncthreads();
            f32x4 X[4];
            if (w == 0) { const int blk = q, jc = c; float tc[16];
                f32x4 Lr[15][4];
#pragma unroll
                for (int t = 1; t < 16; ++t)
#pragma unroll
                    for (int s4 = 0; s4 < 4; ++s4) if (4 * s4 < t) Lr[t - 1][s4] = *(const LAS f32x4*)(lds + LA_DIAG + ((blk * 16 + t) * 16 + 4 * s4) * 4);
                __builtin_amdgcn_sched_barrier(0);
#pragma unroll
                for (int s = 0; s < 16; ++s) tc[s] = (s == jc) ? 1.f : 0.f;
#pragma unroll
                for (int t = 1; t < 16; ++t) { float val = 0.f;
#pragma unroll
                    for (int s4 = 0; s4 < 4; ++s4) if (4 * s4 < t) { const f32x4 L = Lr[t - 1][s4];
#pragma unroll
                        for (int e = 0; e < 4; ++e) if (4 * s4 + e < t) val += L[e] * tc[4 * s4 + e]; }
                    tc[t] += val; }
#pragma unroll
                for (int t = 0; t < 16; ++t) { *(LAS bf16_t*)(lds + LA_TII + ((blk * 16 + t) * 24 + jc) * 2) = f2bf(tc[t]); } }
            if (w < 4) {
#pragma unroll
                for (int i = 0; i < 4; ++i)
#pragma unroll
                    for (int r = 0; r < 4; ++r) X[i][r] = bf2f(*(const LAS bf16_t*)(lds + LA_AT + ((16 * i + 4 * q + r) * TP + 16 * w + c) * 2));
            } else { const int vb = w - 4; const LAS unsigned char* vrow = lds + LA_VT + ((16 * vb + c) * TP + 8 * q) * 2;
                const bf16x8 v0 = *(const LAS bf16x8*)(vrow), v1 = *(const LAS bf16x8*)(vrow + 64);
#pragma unroll
                for (int i = 0; i < 4; ++i) { const LAS unsigned char* arow = lds + LA_AAK + ((16 * i + c) * TP + 8 * q) * 2; f32x4 d = {0.f, 0.f, 0.f, 0.f};
                    d = MFMA32(*(const LAS bf16x8*)(arow), v0, d); d = MFMA32(*(const LAS bf16x8*)(arow + 64), v1, d); X[i] = d; } }

            __syncthreads();
            bf16x4 Xb[4];
            {   bf16x4 Af[6], Tf[4];
#pragma unroll
                for (int i = 1; i < 4; ++i)
#pragma unroll
                    for (int j = 0; j < 3; ++j) if (j < i) Af[(i * (i - 1)) / 2 + j] = *(const LAS bf16x4*)(lds + LA_AAB + ((16 * i + c) * TP + 16 * j + 4 * q) * 2);
#pragma unroll
                for (int i = 0; i < 4; ++i) Tf[i] = *(const LAS bf16x4*)(lds + LA_TII + ((i * 16 + c) * 24 + 4 * q) * 2);
                __builtin_amdgcn_sched_barrier(0);
#pragma unroll
                for (int i = 0; i < 4; ++i) { f32x4 y = X[i];
#pragma unroll
                    for (int j = 0; j < 3; ++j) if (j < i) y = MFMA16(Af[(i * (i - 1)) / 2 + j], Xb[j], y);
                    const f32x4 z = {0.f, 0.f, 0.f, 0.f};
                    X[i] = MFMA16(Tf[i], pack4(y), z); Xb[i] = pack4(X[i]); } }

            if (w < 4) {
                {   bf16x4 Bf[16]; float pcv[4];
#pragma unroll
                    for (int kb = 0; kb < 4; ++kb) { pcv[kb] = *(const LAS float*)(lds + LA_PC + (16 * kb + c) * 4);
#pragma unroll
                        for (int j = 0; j < 4; ++j) Bf[kb * 4 + j] = *(const LAS bf16x4*)(lds + LA_BTT + ((16 * kb + c) * TP + 16 * j + 4 * q) * 2); }
                    __builtin_amdgcn_sched_barrier(0);
#pragma unroll
                    for (int kb = 0; kb < 4; ++kb) { f32x4 d = {0.f, 0.f, 0.f, 0.f};
#pragma unroll
                        for (int j = 0; j < 4; ++j) d = MFMA16(Xb[j], Bf[kb * 4 + j], d);
                        const int ko = 16 * kb + c; const float pc = pcv[kb];
#pragma unroll
                        for (int r = 0; r < 4; ++r) d[r] = pc * (d[r] + ((16 * w + 4 * q + r) == ko ? 1.f : 0.f));

                        *(bf16x4*)(PHI + ((size_t)chid * 64 + ko) * 64 + 16 * w + 4 * q) = pack4(d); } }
                {   bf16x4 Rf[16]; u32x2 Rt[4];
#pragma unroll
                    for (int tb = 0; tb < 4; ++tb) { Rt[tb] = *(const LAS u32x2*)(lds + LA_RT + ((16 * tb + c) * TP + 16 * w + 4 * q) * 2);
#pragma unroll
                        for (int j = 0; j < 4; ++j) Rf[tb * 4 + j] = *(const LAS bf16x4*)(lds + LA_ARB + ((16 * tb + c) * TP + 16 * j + 4 * q) * 2); }
                    __builtin_amdgcn_sched_barrier(0);
#pragma unroll
                    for (int tb = 0; tb < 4; ++tb) { f32x4 d = unpack4(Rt[tb]);
#pragma unroll
                        for (int j = 0; j < 4; ++j) d = MFMA16(Xb[j], Rf[tb * 4 + j], d);
                        *(bf16x4*)(PSI + ((size_t)chid * 64 + 16 * tb + c) * 64 + 16 * w + 4 * q) = pack4(d); } }
            } else { const int vb = w - 4;
                bf16x4 Vb[4];
#pragma unroll
                for (int j = 0; j < 4; ++j) Vb[j] = *(const LAS bf16x4*)(lds + LA_VT + ((16 * vb + c) * TP + 16 * j + 4 * q) * 2);
                {   bf16x4 Bf[16], Kf[16]; f32x4 pcv[4];
#pragma unroll
                    for (int kb = 0; kb < 4; ++kb) { pcv[kb] = *(const LAS f32x4*)(lds + LA_PC + (16 * kb + 4 * q) * 4);
#pragma unroll
                        for (int j = 0; j < 4; ++j) { Bf[kb * 4 + j] = *(const LAS bf16x4*)(lds + LA_BTT + ((16 * kb + c) * TP + 16 * j + 4 * q) * 2); Kf[kb * 4 + j] = *(const LAS bf16x4*)(lds + LA_KTT + ((16 * kb + c) * TP + 16 * j + 4 * q) * 2); } }
                    __builtin_amdgcn_sched_barrier(0);
#pragma unroll
                    for (int kb = 0; kb < 4; ++kb) { f32x4 d = {0.f, 0.f, 0.f, 0.f};
#pragma unroll
                        for (int j = 0; j < 4; ++j) { d = MFMA16(Bf[kb * 4 + j], Xb[j], d); d = MFMA16(Kf[kb * 4 + j], Vb[j], d); }
                        *(bf16x4*)(GT + ((size_t)chid * 64 + 16 * vb + c) * 64 + 16 * kb + 4 * q) = pack4(d * pcv[kb]); } }
                {   bf16x4 Rf[16], Kf[16];
#pragma unroll
                    for (int tb = 0; tb < 4; ++tb)
#pragma unroll
                        for (int j = 0; j < 4; ++j) { Rf[tb * 4 + j] = *(const LAS bf16x4*)(lds + LA_ARB + ((16 * tb + c) * TP + 16 * j + 4 * q) * 2); Kf[tb * 4 + j] = *(const LAS bf16x4*)(lds + LA_ARK + ((16 * tb + c) * TP + 16 * j + 4 * q) * 2); }
                    __builtin_amdgcn_sched_barrier(0);
#pragma unroll
                    for (int tb = 0; tb < 4; ++tb) { f32x4 d = {0.f, 0.f, 0.f, 0.f};
#pragma unroll
                        for (int j = 0; j < 4; ++j) { d = MFMA16(Rf[tb * 4 + j], Xb[j], d); d = MFMA16(Kf[tb * 4 + j], Vb[j], d); }
                        *(bf16x4*)(Y0T + ((size_t)chid * 64 + 16 * vb + c) * 64 + 16 * tb + 4 * q) = pack4(d); } } }
            if (h < 7) WKVA_RAW_STORE(nraw);
            __syncthreads();
        }
    }
#undef WKVA_RAW_LOAD
#undef WKVA_RAW_STORE
}
__device__ __forceinline__ void phase_wkv_b(Frame& F, const Params& P) {
    const bf16_t* PHI = WSP(bf16_t, WS_PHI); const bf16_t* GT = WSP(bf16_t, WS_GT); bf16_t* MT = WSP(bf16_t, WS_MT);
    LAS unsigned char* lds = F.lds;
    const int lane = F.lane, c = lane & 15, q = lane >> 4, w = F.wave, tid = F.tid;
    const int pair = w >> 2, vb = w & 3; const int bh = (int)blockIdx.x * 2 + pair, b = bh >> 3, h = bh & 7;
    const int lrow = tid >> 3, lcol = (tid & 7) * 16;
    f32x4 M[4];
#pragma unroll
    for (int i = 0; i < 4; ++i) M[i] = (f32x4){0.f, 0.f, 0.f, 0.f};
    u32x4 rA[4], rB[4];
#define WKVB_LD(r_, ckk) do { const int ck_ = (ckk) < 32 ? (ckk) : 31; _Pragma("unroll") for (int ti = 0; ti < 4; ++ti) { const int bh_ = (int)blockIdx.x * 2 + (ti >> 1); \
        const size_t chl_ = (size_t)((bh_ >> 3) * 32 + ck_) * 8 + (bh_ & 7); r_[ti] = *(const u32x4*)(((ti & 1) ? GT : PHI) + chl_ * 4096 + (size_t)tid * 8); } } while (0)
#define WKVB_ST(r_, buf) do { _Pragma("unroll") for (int ti = 0; ti < 4; ++ti) *(LAS u32x4*)(lds + ((buf) * 4 + ti) * TILE_B + lrow * (TP * 2) + lcol) = r_[ti]; } while (0)
#define WKVB_STEP(buf, ckk) do { const size_t chs_ = (size_t)(b * 32 + (ckk)) * 8 + h; bf16x4 Mb[4]; \
        const LAS unsigned char* tp_ = lds + ((buf) * 4 + pair * 2) * TILE_B; const LAS unsigned char* tg_ = tp_ + TILE_B; \
        _Pragma("unroll") for (int i = 0; i < 4; ++i) { Mb[i] = pack4(M[i]); *(bf16x4*)(MT + (chs_ * 64 + 16 * vb + c) * 64 + 16 * i + 4 * q) = Mb[i]; } \
        _Pragma("unroll") for (int i = 0; i < 4; ++i) { f32x4 d = unpack4(*(const LAS u32x2*)(tg_ + (16 * vb + c) * (TP * 2) + (16 * i + 4 * q) * 2)); \
            _Pragma("unroll") for (int j = 0; j < 4; ++j) d = MFMA16(*(const LAS bf16x4*)(tp_ + (16 * i + c) * (TP * 2) + (16 * j + 4 * q) * 2), Mb[j], d); M[i] = d; } } while (0)
    WKVB_LD(rA, 0); WKVB_LD(rB, 1);
    __syncthreads();
    for (int ck = 0; ck < 32; ck += 2) {
        WKVB_ST(rA, 0); __syncthreads(); WKVB_LD(rA, ck + 2); WKVB_STEP(0, ck);
        WKVB_ST(rB, 1); __syncthreads(); WKVB_LD(rB, ck + 3); WKVB_STEP(1, ck + 1);
    }
    __syncthreads();
#undef WKVB_LD
#undef WKVB_ST
#undef WKVB_STEP
}
constexpr int LC_SGL = 0;
constexpr int LC_OT = 13312;
__device__ __forceinline__ void phase_wkv_c(Frame& F, const Params& P, int l) {
    LAS unsigned char* lds = F.lds;
    const bf16_t* rkv = WSP(bf16_t, WS_RKV);
    const bf16_t* gupT = WSP(bf16_t, WS_LORA) + (size_t)11 * 512 * 32 + (size_t)l * 512 * 96;
    const bf16_t* PSI = WSP(bf16_t, WS_PSI); const bf16_t* Y0T = WSP(bf16_t, WS_Y0T); const bf16_t* VT = WSP(bf16_t, WS_VT); const bf16_t* MT = WSP(bf16_t, WS_MT);
    const float* RK = WSP(float, WS_RK); unsigned char* outa = WSP(unsigned char, WS_OUTA);
    const float* mu = P.in[3] + (size_t)l * 1696;
    const int lane = F.lane, h = F.wave;
    LAS unsigned char* ot = lds + LC_OT + h * TILE_B;
    for (int unit = blockIdx.x; unit < T / 64; unit += F.G) {
        int lz = lane; asm volatile("" : "+v"(lz)); const int c = lz & 15, q = lz >> 4;
        float gng[4], gnb[4];
#pragma unroll
        for (int vb = 0; vb < 4; ++vb) { gng[vb] = P.in[15][(size_t)l * 512 + h * 64 + 16 * vb + c]; gnb[vb] = P.in[16][(size_t)l * 512 + h * 64 + 16 * vb + c]; }
        const int t0 = unit * 64; const bool firstchunk = (t0 & (SEQ - 1)) == 0; const size_t chid = (size_t)unit * 8 + h;
        __syncthreads();
        for (int idx = F.tid; idx < 64 * 96; idx += 512) { const int tok = idx / 96, qq = idx % 96; const int col = 1536 + 64 + qq; const int t = t0 + tok;
            const bool hp = (tok > 0 || !firstchunk); const float p = bf2f(rkv[(size_t)t * RKVW + col]); const float ppl = bf2f(rkv[(size_t)(hp ? t - 1 : t) * RKVW + col]); const float pp = hp ? ppl : 0.f;
            *(LAS bf16_t*)(lds + LC_SGL + (tok * 104 + qq) * 2) = f2bf(sigmoidf_(p + (pp - p) * mu[1536 + 64 + qq])); }
        __syncthreads();
        float rkv_[16];
#pragma unroll
        for (int i = 0; i < 16; ++i) rkv_[i] = RK[(size_t)(t0 + 16 * (i >> 2) + 4 * q + (i & 3)) * 8 + h];
        bf16x4 Mf[16];
#pragma unroll
        for (int j = 0; j < 4; ++j)
#pragma unroll
            for (int vb = 0; vb < 4; ++vb) Mf[j * 4 + vb] = *(const bf16x4*)(MT + (chid * 64 + 16 * vb + c) * 64 + 16 * j + 4 * q);
        bf16x8 Gf[12];
#pragma unroll
        for (int vb = 0; vb < 4; ++vb)
#pragma unroll
            for (int ks = 0; ks < 3; ++ks) Gf[vb * 3 + ks] = *(const bf16x8*)(gupT + (size_t)(h * 64 + 16 * vb + c) * 96 + 32 * ks + 8 * q);
#pragma unroll
        for (int tb = 0; tb < 4; ++tb) {
            bf16x4 Pf[4];
#pragma unroll
            for (int j = 0; j < 4; ++j) Pf[j] = *(const bf16x4*)(PSI + (chid * 64 + 16 * tb + c) * 64 + 16 * j + 4 * q);
            f32x4 y[4], gt[4], vv[4];
#pragma unroll
            for (int vb = 0; vb < 4; ++vb) { y[vb] = unpack4(*(const u32x2*)(Y0T + (chid * 64 + 16 * vb + c) * 64 + 16 * tb + 4 * q)); vv[vb] = unpack4(*(const u32x2*)(VT + (chid * 64 + 16 * vb + c) * 64 + 16 * tb + 4 * q));
#pragma unroll
                for (int j = 0; j < 4; ++j) y[vb] = MFMA16(Pf[j], Mf[j * 4 + vb], y[vb]); }
            {   const LAS unsigned char* ar = lds + LC_SGL + ((16 * tb + c) * 104 + 8 * q) * 2;
                const bf16x8 a0 = *(const LAS bf16x8*)(ar), a1 = *(const LAS bf16x8*)(ar + 64), a2 = *(const LAS bf16x8*)(ar + 128);
#pragma unroll
                for (int vb = 0; vb < 4; ++vb) { f32x4 d = {0.f, 0.f, 0.f, 0.f}; d = MFMA32(a0, Gf[vb * 3], d); d = MFMA32(a1, Gf[vb * 3 + 1], d); d = MFMA32(a2, Gf[vb * 3 + 2], d); gt[vb] = d; } }
#pragma unroll
            for (int r = 0; r < 4; ++r) { const int tl = 16 * tb + 4 * q + r;
                const float s = row16_sum((y[0][r] + y[1][r]) + (y[2][r] + y[3][r])); const float mean = s * (1.f / 64.f);
                const float d0 = y[0][r] - mean, d1 = y[1][r] - mean, d2 = y[2][r] - mean, d3 = y[3][r] - mean;
                const float var = row16_sum((d0 * d0 + d1 * d1) + (d2 * d2 + d3 * d3)) * (1.f / 64.f); const float rstd = rsqrtf(var + GN_EPS);
                const float rk = rkv_[tb * 4 + r];
                const float o0 = (d0 * rstd * gng[0] + gnb[0] + rk * vv[0][r]) * gt[0][r], o1 = (d1 * rstd * gng[1] + gnb[1] + rk * vv[1][r]) * gt[1][r];
                const float o2 = (d2 * rstd * gng[2] + gnb[2] + rk * vv[2][r]) * gt[2][r], o3 = (d3 * rstd * gng[3] + gnb[3] + rk * vv[3][r]) * gt[3][r];
                const unsigned pq = pack_fp8x4(4.f * o0, 4.f * o1, 4.f * o2, 4.f * o3);
                *(LAS unsigned char*)(ot + tl * 80 + c) = (unsigned char)pq; *(LAS unsigned char*)(ot + tl * 80 + 16 + c) = (unsigned char)(pq >> 8);
                *(LAS unsigned char*)(ot + tl * 80 + 32 + c) = (unsigned char)(pq >> 16); *(LAS unsigned char*)(ot + tl * 80 + 48 + c) = (unsigned char)(pq >> 24); }
        }
        asm volatile("s_waitcnt lgkmcnt(0)" ::: "memory");
        {   const LAS unsigned char* rowp = ot + lane * 80; unsigned char* dst = outa + (size_t)(t0 + lane) * 512 + h * 64;
#pragma unroll
            for (int m4 = 0; m4 < 4; ++m4) *(u32x4*)(dst + 16 * m4) = *(const LAS u32x4*)(rowp + 16 * m4); }
    }
    __syncthreads();
}
__device__ __forceinline__ void phase_sgu(Frame& F, const Params& P, int l, int wg0, int nwg) {
    LAS unsigned char* vt = F.lds;
    const bf16_t* z = WSP(bf16_t, WS_SGUZ); unsigned char* hb = WSP(unsigned char, WS_HB);
    const bf16_t* Wm = WSP(bf16_t, WS_SGUW) + (size_t)l * 4 * 128 * 128;
    const float* bs = P.in[21] + (size_t)l * 4 * 128;
    int u0 = __builtin_amdgcn_readfirstlane((int)blockIdx.x - wg0);
    for (int u = u0; u < T / 128; u += nwg) {
        int uu = u; asm volatile("" : "+v"(uu)); uu = __builtin_amdgcn_readfirstlane(uu);
        int lz = F.lane; asm volatile("" : "+v"(lz));
        const size_t t0 = (size_t)uu * 128;
        __syncthreads();
        {
            float lg[4], lb[4];
#pragma unroll
            for (int e = 0; e < 4; ++e) { lg[e] = P.in[18][(size_t)l * 256 + lz + 64 * e]; lb[e] = P.in[19][(size_t)l * 256 + lz + 64 * e]; }
            float vall[16][4];
#pragma unroll
            for (int i = 0; i < 16; ++i) { const bf16_t* zr = z + (t0 + F.wave * 16 + i) * 512 + 256 + lz;
#pragma unroll
                for (int e = 0; e < 4; ++e) vall[i][e] = bf2f(zr[64 * e]); }
#pragma unroll
            for (int i = 0; i < 16; ++i) { const int tok = F.wave * 16 + i;
                float v[4];
#pragma unroll
                for (int e = 0; e < 4; ++e) v[e] = vall[i][e];
                const float mean = wave_sum((v[0] + v[1]) + (v[2] + v[3])) * (1.f / 256.f);
#pragma unroll
                for (int e = 0; e < 4; ++e) v[e] -= mean;
                const float rstd = rsqrtf(wave_sum((v[0] * v[0] + v[1] * v[1]) + (v[2] * v[2] + v[3] * v[3])) * (1.f / 256.f) + LN_EPS);
#pragma unroll
                for (int e = 0; e < 4; ++e) { const int ch = lz + 64 * e; *(LAS bf16_t*)(vt + ch * 256 + ((((tok >> 3) ^ (ch & 15)) << 4) | ((tok & 7) << 1))) = f2bf(v[e] * rstd * lg[e] + lb[e]); } } }
        __syncthreads();
        {   const int c = lz & 15, qd = lz >> 4, g = F.wave >> 1, sel = F.wave & 1;
            const bf16_t* Wg = Wm + (size_t)g * 128 * 128;
            f32x4 acc[4][4];
#pragma unroll
            for (int pi = 0; pi < 4; ++pi)
#pragma unroll
                for (int db = 0; db < 4; ++db) acc[pi][db] = (f32x4){0.f, 0.f, 0.f, 0.f};
#pragma unroll
            for (int ks = 0; ks < 4; ++ks) {
                bf16x8 af[4];
#pragma unroll
                for (int db = 0; db < 4; ++db) { const int ch = 64 * g + 16 * db + c; af[db] = *(const LAS bf16x8*)(vt + ch * 256 + (((4 * ks + qd) ^ (ch & 15)) << 4)); }
#pragma unroll
                for (int pi = 0; pi < 4; ++pi) { const int pb = sel ? ((pi == 0) ? 1 : (pi == 1) ? 2 : (pi == 2) ? 5 : 6) : ((pi == 0) ? 0 : (pi == 1) ? 3 : (pi == 2) ? 4 : 7);
                    if (32 * ks <= 16 * pb + 15) { const bf16x8 bfr = *(const bf16x8*)(Wg + (size_t)(16 * pb + c) * 128 + 32 * ks + 8 * qd);
#pragma unroll
                        for (int db = 0; db < 4; ++db) acc[pi][db] = MFMA32(af[db], bfr, acc[pi][db]); } } }
            u32x2 uraw[4][4]; float biasv[4];
#pragma unroll
            for (int pi = 0; pi < 4; ++pi) { const int pb = sel ? ((pi == 0) ? 1 : (pi == 1) ? 2 : (pi == 2) ? 5 : 6) : ((pi == 0) ? 0 : (pi == 1) ? 3 : (pi == 2) ? 4 : 7);
                const int p = 16 * pb + c; biasv[pi] = bs[g * 128 + p];
#pragma unroll
                for (int db = 0; db < 4; ++db) uraw[pi][db] = *(const u32x2*)(z + (t0 + p) * 512 + 64 * g + 16 * db + 4 * qd); }
#pragma unroll
            for (int pi = 0; pi < 4; ++pi) { const int pb = sel ? ((pi == 0) ? 1 : (pi == 1) ? 2 : (pi == 2) ? 5 : 6) : ((pi == 0) ? 0 : (pi == 1) ? 3 : (pi == 2) ? 4 : 7);
                const size_t t = t0 + 16 * pb + c;
#pragma unroll
                for (int db = 0; db < 4; ++db) { const int ch = 64 * g + 16 * db + 4 * qd;
                    const f32x4 o = unpack4(uraw[pi][db]) * (acc[pi][db] + biasv[pi]) * 4.f; *(unsigned*)(hb + t * 256 + ch) = pack_fp8x4(o[0], o[1], o[2], o[3]); } } }
    }
    __syncthreads();
}
__device__ __forceinline__ void phase_conv(Frame& F, const Params& P, int l, int wg0, int nwg) {
    LAS float* cv = (LAS float*)F.lds;
    const bf16_t* hin = WSP(bf16_t, WS_CONVH); unsigned char* hc = WSP(unsigned char, WS_HC);
    const float* dw = P.in[23] + (size_t)l * 31 * 256; const float* db = P.in[24] + (size_t)l * 256;
    const float* lg = P.in[25] + (size_t)l * 256; const float* lb = P.in[26] + (size_t)l * 256;
    int u0 = __builtin_amdgcn_readfirstlane((int)blockIdx.x - wg0);
    for (int u = u0; u < T / 64; u += nwg) {
        int tz = F.tid; asm volatile("" : "+v"(tz)); const int ch = tz & 255, hf = tz >> 8, lz = tz & 63;
        float kw[31];
#pragma unroll
        for (int j = 0; j < 31; ++j) kw[j] = dw[j * 256 + ch];
        const float bias = db[ch];
        const int t0 = u * 64 + hf * 32; const int s0 = t0 & (SEQ - 1);
        __syncthreads();
        float x[38];
#pragma unroll
        for (int m = 0; m < 30; ++m) { const int s = s0 - 30 + m; const float ld = bf2f(hin[(size_t)(t0 - 30 + m + (s >= 0 ? 0 : 30)) * 256 + ch]); x[m] = (s >= 0) ? ld : 0.f; }
#pragma unroll
        for (int g8 = 0; g8 < 4; ++g8) {
#pragma unroll
            for (int m = 0; m < 8; ++m) x[30 + m] = bf2f(hin[(size_t)(t0 + 8 * g8 + m) * 256 + ch]);
#pragma unroll
            for (int i = 0; i < 8; ++i) { float a = bias;
#pragma unroll
                for (int j = 0; j < 31; ++j) a += kw[j] * x[i + j];
                cv[(hf * 32 + 8 * g8 + i) * 256 + ch] = a; }
#pragma unroll
            for (int m = 0; m < 30; ++m) x[m] = x[m + 8]; }
        __syncthreads();
        {   const f32x4 g = *(const f32x4*)(lg + lz * 4), bb = *(const f32x4*)(lb + lz * 4);
            for (int i = 0; i < 8; ++i) { const int tok = F.wave * 8 + i; f32x4 v = *(const LAS f32x4*)(cv + tok * 256 + lz * 4);
                const float mean = wave_sum((v[0] + v[1]) + (v[2] + v[3])) * (1.f / 256.f);
                v = v - mean; const float var = wave_sum((v[0] * v[0] + v[1] * v[1]) + (v[2] * v[2] + v[3] * v[3])) * (1.f / 256.f);
                const float rstd = rsqrtf(var + LN_EPS);
                v = v * rstd * g + bb;
                float o[4];
#pragma unroll
                for (int j = 0; j < 4; ++j) o[j] = v[j] * sigmoidf_(v[j]);
                *(unsigned*)(hc + (size_t)(u * 64 + tok) * 256 + lz * 4) = pack_fp8x4(4.f * o[0], 4.f * o[1], 4.f * o[2], 4.f * o[3]); } }
    }
    __syncthreads();
}
__device__ __forceinline__ void ln_load16(const bf16_t* p, float (&v)[16]) {
    const u32x4 a = *(const u32x4*)p, b = *(const u32x4*)(p + 8);
    v[0] = bflo(a.x); v[1] = bfhi(a.x); v[2] = bflo(a.y); v[3] = bfhi(a.y); v[4] = bflo(a.z); v[5] = bfhi(a.z); v[6] = bflo(a.w); v[7] = bfhi(a.w);
    v[8] = bflo(b.x); v[9] = bfhi(b.x); v[10] = bflo(b.y); v[11] = bfhi(b.y); v[12] = bflo(b.z); v[13] = bfhi(b.z); v[14] = bflo(b.w); v[15] = bfhi(b.w);
}
__device__ __forceinline__ void ln_norm16(float (&v)[16], const float* g, const float* b, int lane) {
    float s = 0.f;
#pragma unroll
    for (int j = 0; j < 16; ++j) s += v[j];
    const float mean = wave_sum(s) * (1.f / 1024.f); float q = 0.f;
#pragma unroll
    for (int j = 0; j < 16; ++j) { v[j] -= mean; q += v[j] * v[j]; }
    const float rstd = rsqrtf(wave_sum(q) * (1.f / 1024.f) + LN_EPS);
#pragma unroll
    for (int j4 = 0; j4 < 4; ++j4) { const f32x4 gg = *(const f32x4*)(g + lane * 16 + j4 * 4), bb = *(const f32x4*)(b + lane * 16 + j4 * 4);
#pragma unroll
        for (int j = 0; j < 4; ++j) v[j4 * 4 + j] = v[j4 * 4 + j] * rstd * gg[j] + bb[j]; }
}
__device__ __forceinline__ void ln_store16(bf16_t* p, const float (&v)[16]) {
    u32x4 a, b; a.x = cvt_pk_bf16(v[0], v[1]); a.y = cvt_pk_bf16(v[2], v[3]); a.z = cvt_pk_bf16(v[4], v[5]); a.w = cvt_pk_bf16(v[6], v[7]);
    b.x = cvt_pk_bf16(v[8], v[9]); b.y = cvt_pk_bf16(v[10], v[11]); b.z = cvt_pk_bf16(v[12], v[13]); b.w = cvt_pk_bf16(v[14], v[15]);
    *(u32x4*)p = a; *(u32x4*)(p + 8) = b;
}
__device__ __forceinline__ void ln_load16q(const unsigned char* p, float (&v)[16]) {
    const u32x4 a = *(const u32x4*)p; const unsigned w[4] = {a.x, a.y, a.z, a.w};
#pragma unroll
    for (int i = 0; i < 4; ++i) { const f32x2 lo = __builtin_amdgcn_cvt_pk_f32_fp8((int)w[i], false), hi = __builtin_amdgcn_cvt_pk_f32_fp8((int)w[i], true); v[4 * i] = lo[0]; v[4 * i + 1] = lo[1]; v[4 * i + 2] = hi[0]; v[4 * i + 3] = hi[1]; }
}
__device__ __forceinline__ void ln_store16q(unsigned char* p, const float (&v)[16]) {
    u32x4 a; a.x = pack_fp8x4(v[0], v[1], v[2], v[3]); a.y = pack_fp8x4(v[4], v[5], v[6], v[7]); a.z = pack_fp8x4(v[8], v[9], v[10], v[11]); a.w = pack_fp8x4(v[12], v[13], v[14], v[15]);
    *(u32x4*)p = a;
}
__device__ __forceinline__ void phase_ln1(Frame& F, const Params& P, int l, int wg0, int nwg, int row_lo, int row_hi) {
    const bf16_t* pre = WSP(bf16_t, WS_PRE); const float* stats = WSP(float, WS_STATS);
    const float* g = P.in[29] + (size_t)l * 1024; const float* b = P.in[30] + (size_t)l * 1024;
    const int gw = ((int)blockIdx.x - wg0) * 8 + F.wave, NGW = nwg * 8;
    float gg[16], bb[16];
#pragma unroll
    for (int j4 = 0; j4 < 4; ++j4) { const f32x4 g4 = *(const f32x4*)(g + F.lane * 16 + j4 * 4), b4 = *(const f32x4*)(b + F.lane * 16 + j4 * 4);
#pragma unroll
        for (int j = 0; j < 4; ++j) { gg[j4 * 4 + j] = g4[j]; bb[j4 * 4 + j] = b4[j]; } }
    for (int row = row_lo + gw; row < row_hi; row += NGW) { float v[16]; ln_load16(pre + (size_t)row * 1024 + F.lane * 16, v);
        const f32x2 sl = *(const f32x2*)(stats + ((size_t)row * 16 + (F.lane & 15)) * 2);
        const float mean = row16_sum(sl[0]) * (1.f / 1024.f), ex2 = row16_sum(sl[1]) * (1.f / 1024.f);
        const float rstd = rsqrtf(fmaxf(ex2 - mean * mean, 0.f) + LN_EPS);
#pragma unroll
        for (int j = 0; j < 16; ++j) v[j] = (v[j] - mean) * rstd * gg[j] + bb[j];
        ln_store16q(WSP(unsigned char, WS_X1Q) + (size_t)row * 1024 + F.lane * 16, v); }
}
__device__ __forceinline__ void phase_ln2(Frame& F, const Params& P, int l) {
    const bf16_t* pre = WSP(bf16_t, WS_PRE); const float* stats = WSP(float, WS_STATS); const unsigned char* Y = WSP(unsigned char, WS_Y); bf16_t* x = WSP(bf16_t, WS_X); const int* inv = WSP(int, WS_GATEV);
    const float* g = P.in[36] + (size_t)l * 1024; const float* b = P.in[37] + (size_t)l * 1024; const float* g1 = P.in[29] + (size_t)l * 1024; const float* b1 = P.in[30] + (size_t)l * 1024;
    const int gw = blockIdx.x * 8 + F.wave, NGW = F.G * 8;
    int n0 = inv[2 * gw], n1 = inv[2 * gw + 1];
#pragma unroll 1
    for (int row = gw; row < T; row += NGW) { float v[16], y0[16], y1[16];
        const int c0 = __builtin_amdgcn_readfirstlane(n0), c1 = __builtin_amdgcn_readfirstlane(n1);
        { const int rn = (row + NGW < T) ? row + NGW : row; n0 = inv[2 * rn]; n1 = inv[2 * rn + 1]; }
        ln_load16(pre + (size_t)row * 1024 + F.lane * 16, v); ln_load16q(Y + (size_t)c0 * 1024 + F.lane * 16, y0); ln_load16q(Y + (size_t)c1 * 1024 + F.lane * 16, y1);
        {   const f32x2 sl = *(const f32x2*)(stats + ((size_t)row * 16 + (F.lane & 15)) * 2);
            const float mean = row16_sum(sl[0]) * (1.f / 1024.f), ex2 = row16_sum(sl[1]) * (1.f / 1024.f); const float rstd = rsqrtf(fmaxf(ex2 - mean * mean, 0.f) + LN_EPS);
#pragma unroll
            for (int j4 = 0; j4 < 4; ++j4) { const f32x4 g4 = *(const f32x4*)(g1 + F.lane * 16 + j4 * 4), b4 = *(const f32x4*)(b1 + F.lane * 16 + j4 * 4);
#pragma unroll
                for (int j = 0; j < 4; ++j) v[j4 * 4 + j] = (v[j4 * 4 + j] - mean) * rstd * g4[j] + b4[j]; } }
#pragma unroll
        for (int j = 0; j < 16; ++j) v[j] = ALPHA * v[j] + 0.125f * (y0[j] + y1[j]);
        ln_norm16(v, g, b, F.lane);
        if (l == NL - 1) { float* o = F.out + (size_t)row * 1024 + F.lane * 16;
#pragma unroll
            for (int j4 = 0; j4 < 4; ++j4) *(f32x4*)(o + j4 * 4) = (f32x4){v[j4 * 4], v[j4 * 4 + 1], v[j4 * 4 + 2], v[j4 * 4 + 3]}; }
        else { ln_store16(x + (size_t)row * 1024 + F.lane * 16, v); ln_store16q(WSP(unsigned char, WS_XQ) + (size_t)row * 1024 + F.lane * 16, v); } }
}

#define PHASE_PROLOGUE() const Params P = KPARAMS(); Frame F = make_frame(P.ws, P.out); unsigned* ctl = (unsigned*)(F.ws + WS_CTL); (void)ctl
__device__ __forceinline__ void ph_prologue() { PHASE_PROLOGUE(); phase_convert_static(F, P); phase_convert_lora(F, P); phase_convert_sgu(F, P); phase_convert_router(F, P); phase_x_to_bf16(F, P); phase_convert_moe(F, P, 0); __syncthreads(); }
__device__ __forceinline__ void ph_inproj(int l) { PHASE_PROLOGUE();
    SchedInproj S{(const char*)WSP(unsigned char, WS_XQ), (const char*)(WSP(unsigned char, WS_WIN) + (size_t)l * NIN * 1024), F.G, (int)blockIdx.x};
    EpiInproj E{WSP(bf16_t, WS_RKV), WSP(bf16_t, WS_SGUZ), WSP(bf16_t, WS_CONVH), WSP(unsigned char, WS_GATES)};
    ge::gemm_phase<SchedInproj, EpiInproj, true>(F.lds, S, E); }
__device__ __forceinline__ void ph_wkva(int l) { PHASE_PROLOGUE(); phase_wkv_a<false>(F, P, l); }
__device__ __forceinline__ void ph_cvtmoe(int l) { PHASE_PROLOGUE(); phase_convert_moe(F, P, l); __syncthreads(); }
__device__ __forceinline__ void ph_wkvb() { PHASE_PROLOGUE(); phase_wkv_b(F, P); }
__device__ __forceinline__ void ph_wkvc(int l) { PHASE_PROLOGUE(); phase_wkv_c(F, P, l); }
__device__ __forceinline__ void ph_sguconv(int l) { PHASE_PROLOGUE();
    phase_sgu(F, P, l, 64, 192); phase_conv(F, P, l, 64, 192); }
__device__ __forceinline__ void ph_branch(int l) { PHASE_PROLOGUE();
    SchedBranch S{(const char*)F.ws, WS_WBR + (size_t)l * 1024 * 1024, F.G, F.vcu};
    EpiBranch E{WSP(unsigned char, WS_GATES), WSP(bf16_t, WS_MERGED), WSP(unsigned char, WS_MERGEDQ)};
    ge::gemm_phase<SchedBranch, EpiBranch, true, 0x7A7A7A7A, 0x7D7D7D7D>(F.lds, S, E); }
__device__ __forceinline__ void ph_wout(int l) { PHASE_PROLOGUE();
    SchedWout S{(const char*)WSP(unsigned char, WS_MERGEDQ), (const char*)(WSP(unsigned char, WS_WOUT) + (size_t)l * 1024 * 1024), F.G, F.vcu};
    EpiWout E{WSP(bf16_t, WS_X), WSP(bf16_t, WS_PRE), WSP(float, WS_STATS)};
    ge::gemm_phase<SchedWout, EpiWout, true, 0x7A7A7A7A, 0x7D7D7D7D>(F.lds, S, E); }
constexpr int LN1_SPLIT = 6144;
__device__ __forceinline__ void ph_ln1(int l) { PHASE_PROLOGUE(); if (blockIdx.x < 128) phase_ln1(F, P, l, 0, 128, 0, LN1_SPLIT); else phase_ln1(F, P, l, 128, 128, LN1_SPLIT, T); }
__device__ __forceinline__ void ph_router(int l) { PHASE_PROLOGUE();
    SchedRouter S{(const char*)WSP(bf16_t, WS_PRE), (const char*)(WSP(bf16_t, WS_WRG) + (size_t)l * 256 * 1024), 128, (int)blockIdx.x};
    EpiRouter E{P.in[32], ctl + CW_CNT + 64 * l, WSP(int, WS_LIST), WSP(float, WS_STATS), WSP(float, WS_RC) + l * 64};
    ge::gemm_phase(F.lds, S, E); }
__device__ __forceinline__ void ph_moe1(int l) { PHASE_PROLOGUE();
    const int ntiles = build_tile_table(F, ctl + CW_CNT + 64 * l);
    SchedMoe1 S{(const char*)WSP(unsigned char, WS_X1Q), (const char*)moe_wbuf(F, l), WSP(int, WS_LIST), ctl + CW_CNT + 64 * l, (LAS int*)(F.lds + LDS_MISC + 64), ntiles, F.G, F.vcu};
    EpiMoe1 E{WSP(unsigned char, WS_H)};
    ge::gemm_phase<SchedMoe1, EpiMoe1, true>(F.lds, S, E); }
__device__ __forceinline__ void ph_moe2(int l) { PHASE_PROLOGUE(); int ntk4 = 4; asm volatile("" : "+s"(ntk4));
    const int ntiles = build_tile_table(F, ctl + CW_CNT + 64 * l);
    SchedMoe2 S{(const char*)WSP(unsigned char, WS_H), (const char*)(moe_wbuf(F, l) + (size_t)NE * 1024 * 1024), WSP(int, WS_LIST), ctl + CW_CNT + 64 * l, (LAS int*)(F.lds + LDS_MISC + 64), ntiles, F.G, F.vcu, ntk4};
    EpiMoe2 E{WSP(int, WS_LIST), WSP(unsigned char, WS_Y), WSP(int, WS_GATEV)};
    ge::gemm_phase<SchedMoe2, EpiMoe2, true>(F.lds, S, E); }
__device__ __forceinline__ void ph_ln2(int l) { PHASE_PROLOGUE(); phase_ln2(F, P, l); }

constexpr int PH_PER_LAYER = 11, N_PHASES = 1 + NL * PH_PER_LAYER;
__global__ void __launch_bounds__(512, 2) fwd_kernel(Params p) {
    for (int u = threadIdx.x; u < (LDS_BYTES - LDS_MISC) / 4; u += 512) ((LAS unsigned*)((LAS unsigned char*)lds_raw + LDS_MISC))[u] = 0u;
    __syncthreads();
#if ONE_LAUNCH
    XcdBarrier bar = xcd_barrier_post((unsigned*)(p.ws + WS_CTL) + CW_BAR, (volatile LAS unsigned*)((LAS unsigned char*)lds_raw + LDS_MISC));
#define SEAM() xcd_barrier(bar)
#else
#define SEAM() do { } while (0)
#endif
    const int lo = p.phase_lo, hi = p.phase_hi;
#ifdef ONLY_K
#define IN(k) ((k) == ONLY_K && lo <= pb + (k) && pb + (k) < hi)
#else
#define IN(k) (lo <= pb + (k) && pb + (k) < hi)
#endif
#ifndef ONLY_K
    { const int pb = 0; if (IN(0)) { ph_prologue(); SEAM(); } }
#endif
#define RUN_LAYER(l) do { const int pb = 1 + (l) * PH_PER_LAYER;\
        if (IN(0)) { ph_inproj(l); SEAM(); }\
        if (IN(1)) { ph_wkva(l); SEAM(); }\
        if (IN(2)) { if (blockIdx.x < 64) ph_wkvb(); else ph_sguconv(l); if ((l) + 1 < NL) ph_cvtmoe((l) + 1); SEAM(); }\
        if (IN(3)) { ph_wkvc(l); SEAM(); }\
        if (IN(4)) { ph_branch(l); SEAM(); }\
        if (IN(5)) { ph_wout(l); SEAM(); }\
        if (IN(6)) { if (blockIdx.x < 128) ph_router(l); ph_ln1(l); SEAM(); }\
        if (IN(8)) { ph_moe1(l); SEAM(); }\
        if (IN(9)) { ph_moe2(l); SEAM(); }\
        if (IN(10)) { ph_ln2(l); if (l + 1 < NL) SEAM(); } } while (0)
    RUN_LAYER(0); RUN_LAYER(1); RUN_LAYER(2); RUN_LAYER(3);
#undef RUN_LAYER
#undef IN
#undef SEAM
}

extern "C" void kernel_launch(void* const* d_in, const int* in_sizes, int n_in, void* d_out, int out_size, void* d_ws, size_t ws_size, hipStream_t stream) {
    static int grid = 0;
    if (grid == 0) {
        if (n_in != 38 || in_sizes[0] != T * D || out_size != T * D || ws_size < WS_END) { fprintf(stderr, "kernel_launch: unexpected shapes (n_in %d, in0 %d, out %d, ws %zu, need %zu); nothing launched\n", n_in, n_in > 0 ? in_sizes[0] : -1, out_size, ws_size, (size_t)WS_END); grid = -1; return; }
        int dev = 0, cus = 0, per_cu = 0;
        if (hipGetDevice(&dev) != hipSuccess || hipDeviceGetAttribute(&cus, hipDeviceAttributeMultiprocessorCount, dev) != hipSuccess) { grid = -1; return; }
        if (hipFuncSetAttribute((const void*)fwd_kernel, hipFuncAttributeMaxDynamicSharedMemorySize, LDS_BYTES) != hipSuccess) { fprintf(stderr, "kernel_launch: hipFuncSetAttribute failed\n"); grid = -1; return; }
        if (hipOccupancyMaxActiveBlocksPerMultiprocessor(&per_cu, (const void*)fwd_kernel, 512, LDS_BYTES) != hipSuccess || per_cu < 1) fprintf(stderr, "kernel_launch: occupancy query reports %d blocks per CU\n", per_cu);
        (void)hipGetLastError();
        grid = cus;
        if (grid != 256) { fprintf(stderr, "kernel_launch: built for a 256-CU device, found %d CUs; nothing launched\n", cus); grid = -1; return; }
    }
    if (grid < 0) return;
    (void)hipMemsetAsync((char*)d_ws + WS_CTL, 0, CTL_BYTES, stream);
    Params p{};
    for (int i = 0; i < 38; ++i) p.in[i] = (const float*)d_in[i];
    p.out = (float*)d_out; p.ws = (unsigned char*)d_ws; p.layer_lo = 0; p.layer_hi = NL;
#if ONE_LAUNCH
    p.phase_lo = 0; p.phase_hi = N_PHASES;
    hipLaunchKernelGGL(fwd_kernel, dim3(grid), dim3(512), LDS_BYTES, stream, p);
#else
    for (int ph = 0; ph < N_PHASES; ++ph) { p.phase_lo = ph; p.phase_hi = ph + 1; hipLaunchKernelGGL(fwd_kernel, dim3(grid), dim3(512), LDS_BYTES, stream, p); }
#endif
}
```

```cpp
#include <hip/hip_runtime.h>
#include <stdint.h>
#include <stdio.h>

#ifndef ONE_LAUNCH
#define ONE_LAUNCH 1
#endif

#define LAS __attribute__((address_space(3)))
typedef unsigned short bf16_t;
typedef short bf16x8 __attribute__((ext_vector_type(8)));
typedef float f32x4 __attribute__((ext_vector_type(4)));
typedef float f32x2 __attribute__((ext_vector_type(2)));
typedef unsigned u32x4 __attribute__((ext_vector_type(4)));
typedef unsigned u32x2 __attribute__((ext_vector_type(2)));

constexpr int T = 32768, SEQ = 2048, D = 1024, NL = 4;
constexpr int NIN = 5888;
constexpr int RKVW = 1792;
constexpr int NE = 32;
constexpr float ALPHA = 1.681792830507429f;
constexpr float LN_EPS = 1e-5f, GN_EPS = 64e-5f;

constexpr size_t MiB = 1u << 20;
constexpr size_t WS_CTL = 0;
constexpr size_t WS_WIN = 1 * MiB;
constexpr size_t WS_WBR = WS_WIN + 46 * MiB;
constexpr size_t WS_WOUT = WS_WBR + 8 * MiB;
constexpr size_t WS_WRT = WS_WOUT + 8 * MiB;
constexpr size_t WS_WMOE = WS_WRT + 1 * MiB;
constexpr size_t WS_X = WS_WMOE + 96 * MiB;
constexpr size_t WS_X1 = WS_X + 64 * MiB;
constexpr size_t WS_VFIRST = WS_X1 + 64 * MiB;
constexpr size_t WS_RKV = WS_VFIRST + 32 * MiB;
constexpr size_t WS_SGUZ = WS_RKV + 112 * MiB;
constexpr size_t WS_CONVH = WS_SGUZ + 32 * MiB;
constexpr size_t WS_GATES = WS_CONVH + 16 * MiB;
constexpr size_t WS_PHI = WS_GATES + 192 * MiB;
constexpr size_t WS_PSI = WS_PHI + 32 * MiB;
constexpr size_t WS_GT = WS_PSI + 32 * MiB;
constexpr size_t WS_Y0T = WS_GT + 32 * MiB;
constexpr size_t WS_VT = WS_Y0T + 32 * MiB;
constexpr size_t WS_MT = WS_VT + 32 * MiB;
constexpr size_t WS_RK = WS_MT + 32 * MiB;
constexpr size_t WS_LORA = WS_RK + 1 * MiB;
constexpr size_t WS_SGUW = WS_LORA + 1 * MiB;
constexpr size_t WS_OUTA = WS_SGUW + 1 * MiB;
constexpr size_t WS_HB = WS_OUTA + 32 * MiB;
constexpr size_t WS_HC = WS_HB + 16 * MiB;
constexpr size_t WS_XQ = WS_HC + 16 * MiB;
constexpr size_t WS_END = WS_XQ + 32 * MiB;
constexpr size_t WS_X1Q = WS_WMOE + 64 * MiB;
constexpr size_t WS_STATS = WS_Y0T;
constexpr size_t WS_WRG = WS_WBR + 4 * MiB;
constexpr size_t WS_RC = WS_SGUW + 512 * 1024;
constexpr size_t WS_MERGEDQ = WS_GT;
constexpr size_t WS_MERGED = WS_RKV;
constexpr size_t WS_PRE = WS_PHI;
constexpr size_t WS_H = WS_RKV;
constexpr size_t WS_Y = WS_GATES;
constexpr size_t WS_LIST = WS_SGUZ;
constexpr size_t WS_GATEV = WS_SGUZ + 16 * MiB;
static_assert(WS_END <= 1024 * MiB, "workspace map");
constexpr int CW_BAR = 4096;
constexpr int CW_CNT = 16384;
constexpr size_t CTL_BYTES = 1 * MiB;

constexpr int LDS_STAGE = 131072;
constexpr int LDS_MISC = LDS_STAGE;
constexpr int LDS_RAW = LDS_STAGE + 4096;
constexpr int LDS_BYTES = 163840;

typedef __bf16 bf16x2_t __attribute__((ext_vector_type(2)));
__device__ __forceinline__ unsigned cvt_pk_bf16(float lo, float hi) { const f32x2 v = {lo, hi}; const bf16x2_t b = __builtin_convertvector(v, bf16x2_t); return __builtin_bit_cast(unsigned, b); }
__device__ __forceinline__ unsigned pack_fp8x4(float a, float b, float c, float d) { int w = 0; w = __builtin_amdgcn_cvt_pk_fp8_f32(a, b, w, false); w = __builtin_amdgcn_cvt_pk_fp8_f32(c, d, w, true); return (unsigned)w; }
__device__ __forceinline__ bf16_t f2bf(float f) { return (bf16_t)(cvt_pk_bf16(f, 0.f) & 0xffffu); }
__device__ __forceinline__ float bf2f(unsigned short b) { return __uint_as_float(((unsigned)b) << 16); }
__device__ __forceinline__ float bflo(unsigned w) { return __uint_as_float(w << 16); }
__device__ __forceinline__ float bfhi(unsigned w) { return __uint_as_float(w & 0xffff0000u); }
__device__ __forceinline__ float sigmoidf_(float x) { return __builtin_amdgcn_rcpf(1.0f + __expf(-x)); }
template <int CTRL> __device__ __forceinline__ float dpp_mov(float x) { return __builtin_bit_cast(float, __builtin_amdgcn_mov_dpp(__builtin_bit_cast(int, x), CTRL, 0xF, 0xF, true)); }
__device__ __forceinline__ float row16_sum(float v) { v += dpp_mov<0xB1>(v); v += dpp_mov<0x4E>(v); v += dpp_mov<0x141>(v); v += dpp_mov<0x140>(v); return v; }
__device__ __forceinline__ float wave_sum(float v) {
    v = row16_sum(v); const int vi = __builtin_bit_cast(int, v);
    return (__builtin_bit_cast(float, __builtin_amdgcn_readlane(vi, 0)) + __builtin_bit_cast(float, __builtin_amdgcn_readlane(vi, 16))) + (__builtin_bit_cast(float, __builtin_amdgcn_readlane(vi, 32)) + __builtin_bit_cast(float, __builtin_amdgcn_readlane(vi, 48)));
}
__device__ __forceinline__ float dpp_f(float x, const int ctrl_sel) {
    int xi = __builtin_bit_cast(int, x), r;
    if (ctrl_sel == 0) r = __builtin_amdgcn_update_dpp(0, xi, 0xB1, 0xF, 0xF, true);
    else if (ctrl_sel == 1) r = __builtin_amdgcn_update_dpp(0, xi, 0x4E, 0xF, 0xF, true);
    else r = __builtin_amdgcn_update_dpp(0, xi, 0x141, 0xF, 0xF, true);
    return __builtin_bit_cast(float, r);
}
__device__ __forceinline__ float reduce8(float x) { x += dpp_f(x, 0); x += dpp_f(x, 1); x += dpp_f(x, 2); return x; }
__device__ __forceinline__ float gelu_f(float v) {
    const float av = fabsf(v), t = __builtin_amdgcn_rcpf(av * 0.2316418882f + 1.0f);
    float q = t * 0.5307027145f + (-0.7265760135f); q = q * t + 0.7107068705f; q = q * t + (-0.142248368f); q = q * t + 0.127414796f; q = q * t;
    const float e = __builtin_amdgcn_exp2f((v * v) * (-0.72134752044f));
    const float m = v * (q * e);
    return v < 0.f ? m : v - m;
}

#define XB_TMO      128
#define XB_XCNT(j)  (256  + 64 * (j))
#define XB_XSUB(j)  (1280 + 64 * (j))
#define XB_XGEN(j)  (2304 + 64 * (j))
#define XB_TOP      3328
#define XB_TOPGEN   3392
#define XCD_BAR_WORDS 3456
#define XB_SPIN_CAP (1u << 22)
__device__ __forceinline__ unsigned xb_ld(unsigned* p)              { return __hip_atomic_load(p, __ATOMIC_RELAXED, __HIP_MEMORY_SCOPE_AGENT); }
__device__ __forceinline__ unsigned xb_add(unsigned* p, unsigned v) { return __hip_atomic_fetch_add(p, v, __ATOMIC_RELAXED, __HIP_MEMORY_SCOPE_AGENT); }
__device__ __forceinline__ unsigned xb_xcc_id() { return (unsigned)__builtin_amdgcn_s_getreg((3 << 11) | 20) & 0xFu; }
#define XB_SPIN(cond, bar) do { unsigned _sp = 0; while (cond) { __builtin_amdgcn_s_sleep(1); \
    if ((++_sp & 255u) == 0u) { if (xb_ld(&(bar)[XB_TMO])) break; if (_sp > XB_SPIN_CAP) { atomicAdd(&(bar)[XB_TMO], 1u); break; } } } } while (0)
struct XcdBarrier { unsigned* bar; unsigned x; volatile LAS unsigned* st; };
__device__ __forceinline__ XcdBarrier xcd_barrier_post(unsigned* bar, volatile LAS unsigned* st) {
    XcdBarrier b; b.bar = bar; b.x = xb_xcc_id(); b.st = st;
    if (threadIdx.x == 0) (void)xb_add(&bar[XB_XCNT(b.x)], 1u);
    return b;
}
__device__ __forceinline__ void xcd_barrier_complete(unsigned* bar, unsigned x, unsigned& nloc, unsigned& nx) {
    const unsigned G = gridDim.x * gridDim.y * gridDim.z;
    unsigned sum, cnt, mine, sp = 0u;
    for (;;) {
        sum = 0u; cnt = 0u; mine = 0u;
#pragma unroll
        for (unsigned j = 0; j < 16; ++j) { const unsigned c = xb_ld(&bar[XB_XCNT(j)]); sum += c; cnt += (c > 0u) ? 1u : 0u; mine = (j == x) ? c : mine; }
        if (sum == G) break;
        __builtin_amdgcn_s_sleep(1);
        if ((++sp & 255u) == 0u) { if (xb_ld(&bar[XB_TMO])) break; if (sp > XB_SPIN_CAP) { atomicAdd(&bar[XB_TMO], 1u); break; } }
    }
    nloc = mine > 0u ? mine : 1u; nx = cnt > 0u ? cnt : 1u;
}
__device__ __forceinline__ void xcd_barrier(const XcdBarrier& b) {
    asm volatile("s_waitcnt vmcnt(0)" ::: "memory");
    __syncthreads();
    if (threadIdx.x == 0) {
        unsigned* bar = b.bar;
        __builtin_amdgcn_s_waitcnt(0);
        unsigned nloc = b.st[0], nx = b.st[1];
        if (nloc == 0u) { xcd_barrier_complete(bar, b.x, nloc, nx); b.st[0] = nloc; b.st[1] = nx; }
        const unsigned old = xb_add(&bar[XB_XSUB(b.x)], 1u);
        const unsigned gen = old / nloc;
        if (old + 1u == (gen + 1u) * nloc) {
            __builtin_amdgcn_fence(__ATOMIC_RELEASE, "agent");
            asm volatile("s_waitcnt vmcnt(0)" ::: "memory");
            const unsigned og = xb_add(&bar[XB_TOP], 1u);
            const unsigned tg = og / nx;
            if (og + 1u == (tg + 1u) * nx) xb_add(&bar[XB_TOPGEN], 1u);
            else XB_SPIN(xb_ld(&bar[XB_TOPGEN]) == tg, bar);
            __builtin_amdgcn_fence(__ATOMIC_ACQUIRE, "agent");
            xb_add(&bar[XB_XGEN(b.x)], 1u);
            asm volatile("s_waitcnt vmcnt(0)" ::: "memory");
        } else {
            XB_SPIN(xb_ld(&bar[XB_XGEN(b.x)]) == gen, bar);
            __builtin_amdgcn_fence(__ATOMIC_ACQUIRE, "agent");
            asm volatile("s_waitcnt vmcnt(0)" ::: "memory");
        }
    }
    __syncthreads();
}

struct Params {
    const float* in[38];
    float* out;
    unsigned char* ws;
    int phase_lo, phase_hi;
    int layer_lo, layer_hi;
};

namespace ge {
constexpr int BM = 256, BK = 64, HALF = 128, HTB = HALF * BK * 2;
__device__ __forceinline__ int lds_byte(int r, int c) { const int st = (r >> 4) * 2 + (c >> 5), rr = r & 15, cc = c & 31, ob = rr * 64 + cc * 2; return st * 1024 + (ob ^ (((ob >> 9) & 1) << 5)); }
__device__ __forceinline__ void stage_rc(int b, int& R, int& C) { const int st = b / 1024, sb = b % 1024, swz = sb ^ (((sb >> 9) & 1) << 5); R = (st >> 1) * 16 + swz / 64; C = (st & 1) * 32 + (swz % 64) / 2; }
__device__ __forceinline__ int perm32(int rho) { const int n = rho >> 4, i = rho & 15; return 8 * (i >> 2) + 4 * n + (i & 3); }

struct NoPre { };
struct Unit {
    const char* A; const char* B;
    const int* gat;
    unsigned lda, ldb;
    int nt;
    int gshift, nvalid;
    int pm, pn, aux;
};
typedef f32x4 Acc[2][2][4][2];

typedef int i32x8 __attribute__((ext_vector_type(8)));
template <class Sched, class Epi, bool FP8 = false, int SCALE_W = 0x7A7A7A7A, int SCALE_A = 0x7F7F7F7F>
__device__ __forceinline__ void gemm_phase(LAS unsigned char* lds, const Sched& S, const Epi& E) {
    int tid = threadIdx.x; asm volatile("" : "+v"(tid));
    const int wid = __builtin_amdgcn_readfirstlane(tid >> 6), lane = tid & 63, wr = wid >> 2, wc = wid & 3, fr = lane & 15, fq = lane >> 4;
    const unsigned ldsw = (unsigned)wid * 1024u;
    const int aoff = FP8 ? lds_byte(wr * 64 + fr, fq * 16) : lds_byte(wr * 64 + fr, fq * 8), boff = FP8 ? lds_byte(wc * 32 + fr, fq * 16) : lds_byte(wc * 32 + fr, fq * 8);
    const int aoff1 = FP8 ? lds_byte(wr * 64 + fr, fq * 16 + 8) : aoff + 1024, boff1 = FP8 ? lds_byte(wc * 32 + fr, fq * 16 + 8) : boff + 1024;
#define GE_SA(b, h) (((b) * 2 + (h)) * HTB)
#define GE_SB(b, h) ((4 + (b) * 2 + (h)) * HTB)
#define GE_STAGE(bufoff, gbase, o0, o1) do { \
        __builtin_amdgcn_global_load_lds((const unsigned*)((gbase) + (o0)), (LAS unsigned*)(lds + (bufoff) + ldsw), 16, 0, 0); \
        __builtin_amdgcn_global_load_lds((const unsigned*)((gbase) + (o1)), (LAS unsigned*)(lds + (bufoff) + ldsw + 8192), 16, 0, 0); } while (0)
#define GE_LDA(dst, b, h) do { _Pragma("unroll") for (int m = 0; m < 4; ++m) { dst[m][0] = *(const LAS bf16x8*)(lds + GE_SA(b, h) + aoff + m * 2048); dst[m][1] = *(const LAS bf16x8*)(lds + GE_SA(b, h) + aoff1 + m * 2048); } } while (0)
#define GE_LDB(dst, b, h) do { _Pragma("unroll") for (int n = 0; n < 2; ++n) { dst[n][0] = *(const LAS bf16x8*)(lds + GE_SB(b, h) + boff + n * 2048); dst[n][1] = *(const LAS bf16x8*)(lds + GE_SB(b, h) + boff1 + n * 2048); } } while (0)
#define GE_CAT(x0, x1) __builtin_shufflevector(__builtin_bit_cast(u32x4, x0), __builtin_bit_cast(u32x4, x1), 0, 1, 2, 3, 4, 5, 6, 7)
#define GE_MMA(ai, bj, At, Bt) do { __builtin_amdgcn_s_setprio(1); _Pragma("unroll") for (int m = 0; m < 4; ++m) _Pragma("unroll") for (int n = 0; n < 2; ++n) { \
        if constexpr (FP8) acc[ai][bj][m][n] = __builtin_amdgcn_mfma_scale_f32_16x16x128_f8f6f4(__builtin_bit_cast(i32x8, GE_CAT(Bt[n][0], Bt[n][1])), __builtin_bit_cast(i32x8, GE_CAT(At[m][0], At[m][1])), acc[ai][bj][m][n], 0, 0, 0, SCALE_W, 0, SCALE_A); \
        else { _Pragma("unroll") for (int k = 0; k < 2; ++k) acc[ai][bj][m][n] = __builtin_amdgcn_mfma_f32_16x16x32_bf16(Bt[n][k], At[m][k], acc[ai][bj][m][n], 0, 0, 0); } } __builtin_amdgcn_s_setprio(0); } while (0)
#define GE_WAIT_V(n) asm volatile("s_waitcnt vmcnt(" #n ")" ::: "memory")
#define GE_WAIT_L(n) asm volatile("s_waitcnt lgkmcnt(" #n ")" ::: "memory")
#define GE_BAR __builtin_amdgcn_s_barrier()
#define GE_SCHED __builtin_amdgcn_sched_barrier(0)
#define GE_OFFS(u, oA00, oA01, oA10, oA11, oB0, oB1) do { \
        int tq_ = tid; asm volatile("" : "+v"(tq_)); int R0, C0, R1, C1; stage_rc(tq_ * 16, R0, C0); stage_rc(tq_ * 16 + 8192, R1, C1); \
        const int Rb0 = (R0 & ~31) + perm32(R0 & 31), Rb1 = (R1 & ~31) + perm32(R1 & 31); \
        int r00 = R0, r01 = R1, r10 = 128 + R0, r11 = 128 + R1; \
        if ((u).gat) { const int* g_ = (u).gat; const int nv_ = (u).nvalid, sh_ = (u).gshift; \
            r00 = (r00 < nv_) ? (g_[2 * r00] >> sh_) : 0; r01 = (r01 < nv_) ? (g_[2 * r01] >> sh_) : 0; r10 = (r10 < nv_) ? (g_[2 * r10] >> sh_) : 0; r11 = (r11 < nv_) ? (g_[2 * r11] >> sh_) : 0; } \
        oA00 = (unsigned)r00 * (u).lda + (unsigned)C0 * 2u; oA01 = (unsigned)r01 * (u).lda + (unsigned)C1 * 2u; \
        oA10 = (unsigned)r10 * (u).lda + (unsigned)C0 * 2u; oA11 = (unsigned)r11 * (u).lda + (unsigned)C1 * 2u; \
        oB0 = (unsigned)Rb0 * (u).ldb + (unsigned)C0 * 2u; oB1 = (unsigned)Rb1 * (u).ldb + (unsigned)C1 * 2u; } while (0)
    Unit cur, nxt; int ui = 0;
    if (!S.next(0, cur)) return;
    Acc acc;
#pragma unroll
    for (int a = 0; a < 2; ++a)
#pragma unroll
        for (int b = 0; b < 2; ++b)
#pragma unroll
            for (int m = 0; m < 4; ++m)
#pragma unroll
                for (int n = 0; n < 2; ++n) acc[a][b][m][n] = (f32x4){0.f, 0.f, 0.f, 0.f};
    bf16x8 At[4][2], B0[2][2], B1[2][2];
    unsigned oA00, oA01, oA10, oA11, oB0, oB1;
    GE_OFFS(cur, oA00, oA01, oA10, oA11, oB0, oB1);
    typename Epi::Pre pre = E.prefetch(cur, wr, wc, fr, fq);
    const char* cA = cur.A; const char* cB = cur.B; size_t chB = (size_t)128 * cur.ldb;
    const size_t kstep = 128;
    GE_STAGE(GE_SB(0, 0), cB, oB0, oB1); GE_STAGE(GE_SA(0, 0), cA, oA00, oA01); GE_STAGE(GE_SB(0, 1), cB + chB, oB0, oB1); GE_STAGE(GE_SA(0, 1), cA, oA10, oA11);
    if (wr == 1) GE_BAR;
    GE_WAIT_V(4); GE_BAR;
    GE_STAGE(GE_SB(1, 0), cB + kstep, oB0, oB1); GE_STAGE(GE_SA(1, 0), cA + kstep, oA00, oA01); GE_STAGE(GE_SB(1, 1), cB + chB + kstep, oB0, oB1);
    GE_WAIT_V(6); GE_BAR;
    for (;;) {
        const bool has_next = S.next(ui + 1, nxt);
        const char* nA = has_next ? nxt.A : cA; const char* nB = has_next ? nxt.B : cB; const size_t nhB = has_next ? (size_t)128 * nxt.ldb : chB;
        const int nt = cur.nt;
        for (int t = 0; t < nt; t += 2) {
            const bool last = (t == nt - 2);
            const char* a1 = cA + (size_t)(t + 1) * kstep;
            const char* a2 = last ? nA : cA + (size_t)(t + 2) * kstep; const char* b2 = last ? nB : cB + (size_t)(t + 2) * kstep;
            const size_t hB2 = last ? nhB : chB;
            const char* a3 = a2 + kstep; const char* b3 = b2 + kstep;
            GE_LDB(B0, 0, 0); GE_SCHED; GE_LDA(At, 0, 0); GE_STAGE(GE_SA(1, 1), a1, oA10, oA11);
            if (last && has_next) { GE_OFFS(nxt, oA00, oA01, oA10, oA11, oB0, oB1); }
            GE_WAIT_L(8); GE_BAR; GE_WAIT_L(0); GE_MMA(0, 0, At, B0); GE_BAR; GE_SCHED;
            GE_LDB(B1, 0, 1); GE_STAGE(GE_SB(0, 0), b2, oB0, oB1);
            GE_BAR; GE_WAIT_L(0); GE_MMA(0, 1, At, B1); GE_BAR;
            GE_LDA(At, 0, 1); GE_STAGE(GE_SA(0, 0), a2, oA00, oA01);
            GE_BAR; GE_WAIT_L(0); GE_MMA(1, 0, At, B0); GE_BAR; GE_SCHED;
            GE_STAGE(GE_SB(0, 1), b2 + hB2, oB0, oB1);
            GE_WAIT_V(6); GE_BAR; GE_MMA(1, 1, At, B1); GE_BAR;
            GE_LDB(B0, 1, 0); GE_SCHED; GE_LDA(At, 1, 0); GE_STAGE(GE_SA(0, 1), a2, oA10, oA11);
            GE_WAIT_L(8); GE_BAR; GE_WAIT_L(0); GE_MMA(0, 0, At, B0); GE_BAR; GE_SCHED;
            GE_LDB(B1, 1, 1); GE_STAGE(GE_SB(1, 0), b3, oB0, oB1);
            GE_BAR; GE_WAIT_L(0); GE_MMA(0, 1, At, B1); GE_BAR;
            GE_LDA(At, 1, 1); GE_STAGE(GE_SA(1, 0), a3, oA00, oA01);
            GE_BAR; GE_WAIT_L(0); GE_MMA(1, 0, At, B0); GE_BAR; GE_SCHED;
            GE_STAGE(GE_SB(1, 1), b3 + hB2, oB0, oB1);
            GE_WAIT_V(6); GE_BAR; GE_MMA(1, 1, At, B1); GE_BAR;
        }
        if constexpr (!Epi::AFTER_DRAIN) E(acc, cur, wr, wc, fr, fq, pre);
        if (!has_next) break;
#pragma unroll
        for (int a = 0; a < 2; ++a)
#pragma unroll
            for (int b = 0; b < 2; ++b)
#pragma unroll
                for (int m = 0; m < 4; ++m)
#pragma unroll
                    for (int n = 0; n < 2; ++n) acc[a][b][m][n] = (f32x4){0.f, 0.f, 0.f, 0.f};
        cur = nxt; cA = nA; cB = nB; chB = nhB; ++ui; pre = E.prefetch(cur, wr, wc, fr, fq);
    }
    GE_WAIT_V(0);
    if (wr == 0) GE_BAR;
    GE_BAR;
    if constexpr (Epi::AFTER_DRAIN) E.drained(acc, cur, wr, wc, fr, fq, lds);
#undef GE_SA
#undef GE_SB
#undef GE_STAGE
#undef GE_LDA
#undef GE_LDB
#undef GE_MMA
#undef GE_WAIT_V
#undef GE_WAIT_L
#undef GE_BAR
#undef GE_SCHED
#undef GE_OFFS
#undef GE_CAT
}
__device__ __forceinline__ bool static_tile(long L, int nM, int nN, int& pm, int& pn) {
    const int nwg = nM * nN; if (L >= nwg) return false;
    int wgid = (int)L; { const int q = nwg / 8, r = nwg % 8, xcd = wgid % 8, off = wgid / 8; wgid = (xcd < r ? xcd * (q + 1) : r * (q + 1) + (xcd - r) * q) + off; }
    const int nig = 8 * nN, gid = wgid / nig, fm = gid * 8, gsz = (nM - fm) < 8 ? (nM - fm) : 8;
    pm = fm + ((wgid % nig) % gsz); pn = (wgid % nig) / gsz; return true;
}
}

struct Frame {
    LAS unsigned char* lds;
    int tid, lane, wave, G, vcu;
    unsigned char* ws;
    float* out;
};
#define WSP(T_, off) ((T_*)(F.ws + (off)))

extern __shared__ __attribute__((aligned(16))) unsigned char lds_raw[];
__device__ __forceinline__ Params load_params() {
    typedef const __attribute__((address_space(4))) unsigned long long cu64;
    cu64* k = (cu64*)__builtin_amdgcn_kernarg_segment_ptr();
    asm volatile("" : "+s"(k));
    Params P;
#pragma unroll
    for (int i = 0; i < 38; ++i) P.in[i] = (const float*)(const __attribute__((address_space(1))) float*)k[i];
    P.out = (float*)(__attribute__((address_space(1))) float*)k[38]; P.ws = (unsigned char*)(__attribute__((address_space(1))) unsigned char*)k[39];
    P.phase_lo = 0; P.phase_hi = 0; P.layer_lo = 0; P.layer_hi = 0;
    return P;
}
#define KPARAMS() load_params()
__device__ __forceinline__ Frame make_frame(unsigned char* ws, float* out) {
    Frame F;
    F.lds = (LAS unsigned char*)lds_raw;
    int tz = threadIdx.x; asm volatile("" : "+v"(tz));
    F.tid = tz; F.lane = F.tid & 63; F.wave = __builtin_amdgcn_readfirstlane(F.tid >> 6);
    F.G = gridDim.x; { const int bx = blockIdx.x; F.vcu = (F.G % 8 == 0) ? (bx % 8) * (F.G / 8) + bx / 8 : bx; }
    F.ws = ws; F.out = out;
    return F;
}
template <bool FP8OUT, class ColMap>
__device__ __forceinline__ void transpose_item(const float* W, int ldw, int K, void* WTv, int nblk, LAS float* scr, int item, int lane, const ColMap& cm) {
    const int kb = item / nblk, nb = item % nblk, k0 = 64 * kb, n0 = 32 * nb;
    const int sc = cm(n0 + (lane & 31));
#pragma unroll 8
    for (int i = 0; i < 32; ++i) { const int kk = 2 * i + (lane >> 5); scr[kk * 33 + (lane & 31)] = (sc >= 0) ? W[(size_t)(k0 + kk) * ldw + sc] : 0.f; }
    asm volatile("s_waitcnt lgkmcnt(0)" ::: "memory");
    const int c = lane & 7;
#pragma unroll
    for (int j = 0; j < 4; ++j) { const int n = (lane >> 3) + 8 * j; const LAS float* s = scr + (8 * c) * 33 + n;
        if (FP8OUT) { u32x2 o; o.x = pack_fp8x4(32.f * s[0 * 33], 32.f * s[1 * 33], 32.f * s[2 * 33], 32.f * s[3 * 33]); o.y = pack_fp8x4(32.f * s[4 * 33], 32.f * s[5 * 33], 32.f * s[6 * 33], 32.f * s[7 * 33]);
            *(u32x2*)((unsigned char*)WTv + (size_t)(n0 + n) * K + k0 + 8 * c) = o; }
        else { u32x4 o; o.x = cvt_pk_bf16(s[0 * 33], s[1 * 33]); o.y = cvt_pk_bf16(s[2 * 33], s[3 * 33]); o.z = cvt_pk_bf16(s[4 * 33], s[5 * 33]); o.w = cvt_pk_bf16(s[6 * 33], s[7 * 33]);
            *(u32x4*)((bf16_t*)WTv + (size_t)(n0 + n) * K + k0 + 8 * c) = o; } }
    asm volatile("s_waitcnt lgkmcnt(0)" ::: "memory");
}
struct CmIdent { __device__ __forceinline__ int operator()(int n) const { return n; } };
struct CmInproj { int layer; __device__ __forceinline__ int operator()(int j) const {
    if (j < 1536) return j;
    if (j < 1792) { const int q = j - 1536; if (q < 160) return 1536 + q; if (q < 192) return layer > 0 ? 5792 + (q - 160) : -1; return -1; }
    if (j < 2304) return 1696 + (j - 1792);
    if (j < 2816) { const int jj = j - 2304, c = jj >> 1; return (jj & 1) ? 2208 + 256 + c : 2208 + c; }
    return 2720 + (j - 2816); } };
struct CmRouter { __device__ __forceinline__ int operator()(int n) const { return n < 32 ? n : -1; } };
struct CmGU { __device__ __forceinline__ int operator()(int n) const { return n; } };

template <bool FP8OUT> __device__ __forceinline__ void moe_item_store(void* WTv, int K, int k0, int n0, LAS float* scr, int lane) {
    asm volatile("s_waitcnt lgkmcnt(0)" ::: "memory");
    const int c = lane & 7;
#pragma unroll
    for (int j = 0; j < 4; ++j) { const int nn = (lane >> 3) + 8 * j; const LAS float* s = scr + (8 * c) * 33 + nn;
        if (FP8OUT) { u32x2 o; o.x = pack_fp8x4(32.f * s[0 * 33], 32.f * s[1 * 33], 32.f * s[2 * 33], 32.f * s[3 * 33]); o.y = pack_fp8x4(32.f * s[4 * 33], 32.f * s[5 * 33], 32.f * s[6 * 33], 32.f * s[7 * 33]);
            *(u32x2*)((unsigned char*)WTv + (size_t)(n0 + nn) * K + k0 + 8 * c) = o; }
        else { u32x4 o; o.x = cvt_pk_bf16(s[0 * 33], s[1 * 33]); o.y = cvt_pk_bf16(s[2 * 33], s[3 * 33]); o.z = cvt_pk_bf16(s[4 * 33], s[5 * 33]); o.w = cvt_pk_bf16(s[6 * 33], s[7 * 33]);
            *(u32x4*)((bf16_t*)WTv + (size_t)(n0 + nn) * K + k0 + 8 * c) = o; } }
    asm volatile("s_waitcnt lgkmcnt(0)" ::: "memory");
}
__device__ __forceinline__ void fast_item_plain(const float* W, int ldw, int K, unsigned char* WT, int nblk, LAS float* scr, int item, int lane) {
    const int kb = item / nblk, nb = item % nblk, k0 = 64 * kb, n0 = 32 * nb; const int c4 = (lane & 7) * 4; const float* Ws = W + n0 + c4;
    f32x4 v[8];
#pragma unroll
    for (int i = 0; i < 8; ++i) v[i] = *(const f32x4*)(Ws + (size_t)(k0 + 8 * i + (lane >> 3)) * ldw);
#pragma unroll
    for (int i = 0; i < 8; ++i) { LAS float* d = scr + (8 * i + (lane >> 3)) * 33 + c4; d[0] = v[i][0]; d[1] = v[i][1]; d[2] = v[i][2]; d[3] = v[i][3]; }
    moe_item_store<true>(WT, K, k0, n0, scr, lane);
}
__device__ __forceinline__ void phase_convert_static(Frame& F, const Params& P) {
    LAS float* scr = (LAS float*)(F.lds + F.wave * 8448);
    const int gw = F.vcu * 8 + F.wave, NGW = F.G * 8;
    constexpr int I_IN = 16 * (NIN / 32);
    for (int it = gw; it < NL * I_IN; it += NGW) { const int l = it / I_IN, r = it % I_IN; const int lane = F.lane;
        const float* W = (l == 0) ? P.in[1] : P.in[2] + (size_t)(l - 1) * 1024 * 5824; const int ldw = (l == 0) ? 5792 : 5824;
        const int kb = r / (NIN / 32), nb = r % (NIN / 32), k0 = 64 * kb, n0 = 32 * nb;
        f32x4 v[8];
        if (n0 >= 2304 && n0 < 2816) {
            const int m = (lane >> 2) & 1, c4 = (lane & 3) * 4; const float* Ws = W + 2208 + 256 * m + ((n0 - 2304) >> 1) + c4;
#pragma unroll
            for (int i = 0; i < 8; ++i) v[i] = *(const f32x4*)(Ws + (size_t)(k0 + 8 * i + (lane >> 3)) * ldw);
#pragma unroll
            for (int i = 0; i < 8; ++i) { LAS float* d = scr + (8 * i + (lane >> 3)) * 33 + 2 * c4 + m; d[0] = v[i][0]; d[2] = v[i][1]; d[4] = v[i][2]; d[6] = v[i][3]; }
        } else {
            int src = n0; bool zero = false;
            if (n0 >= 1696 && n0 < 1728) { src = 5792 + (n0 - 1696); zero = (l == 0); } else if (n0 >= 1728 && n0 < 1792) zero = true; else if (n0 >= 1792) src = n0 - 96;
            const int c4 = (lane & 7) * 4; const float* Ws = W + (zero ? 0 : src) + c4;
#pragma unroll
            for (int i = 0; i < 8; ++i) { v[i] = *(const f32x4*)(Ws + (size_t)(k0 + 8 * i + (lane >> 3)) * ldw); if (zero) v[i] = (f32x4){0.f, 0.f, 0.f, 0.f}; }
#pragma unroll
            for (int i = 0; i < 8; ++i) { LAS float* d = scr + (8 * i + (lane >> 3)) * 33 + c4; d[0] = v[i][0]; d[1] = v[i][1]; d[2] = v[i][2]; d[3] = v[i][3]; }
        }
        moe_item_store<true>(WSP(unsigned char, WS_WIN) + (size_t)l * NIN * 1024, 1024, k0, n0, scr, lane); }
    constexpr int I_A = 8 * 32, I_B = 4 * 32;
    for (int it = gw; it < NL * (I_A + 2 * I_B); it += NGW) { const int l = it / (I_A + 2 * I_B); int r = it % (I_A + 2 * I_B);
        unsigned char* base = WSP(unsigned char, WS_WBR) + (size_t)l * (1024 * 1024);
        if (r < I_A) { fast_item_plain(P.in[17] + (size_t)l * 512 * 1024, 1024, 512, base, 32, scr, r, F.lane); continue; } r -= I_A;
        if (r < I_B) { fast_item_plain(P.in[22] + (size_t)l * 256 * 1024, 1024, 256, base + 1024 * 512, 32, scr, r, F.lane); continue; } r -= I_B;
        fast_item_plain(P.in[27] + (size_t)l * 256 * 1024, 1024, 256, base + 1024 * 512 + 1024 * 256, 32, scr, r, F.lane); }
    constexpr int I_O = 16 * 32;
    for (int it = gw; it < NL * I_O; it += NGW) { const int l = it / I_O, r = it % I_O;
        fast_item_plain(P.in[28] + (size_t)l * 1024 * 1024, 1024, 1024, WSP(unsigned char, WS_WOUT) + (size_t)l * 1024 * 1024, 32, scr, r, F.lane); }
    for (int it = gw; it < 16 * 8; it += NGW) transpose_item<false>(P.in[31], 32, 1024, WSP(bf16_t, WS_WRT), 8, scr, it, F.lane, CmRouter{});
}
__device__ __forceinline__ unsigned char* moe_wbuf(Frame& F, int l) { return (l & 1) ? (unsigned char*)F.out : F.ws + WS_WMOE; }
__device__ __forceinline__ void phase_convert_moe(Frame& F, const Params& P, int l) {
    LAS float* scr = (LAS float*)(F.lds + F.wave * 8448);
    const int gw = F.vcu * 8 + F.wave, NGW = F.G * 8; const int lane = F.lane;
    constexpr int I_GU = 16 * 32;
    constexpr int I_DN = 8 * 32;
    for (int it = gw; it < NE * I_GU; it += NGW) { const int e = it / I_GU, item = it % I_GU;
        const int kb = item / 32, nb = item % 32, k0 = 64 * kb, n0 = 32 * nb;
        const int m = (lane >> 2) & 1, c4 = (lane & 3) * 4;
        const float* Ws = ((m ? P.in[34] : P.in[33]) + ((size_t)l * NE + e) * 1024 * 512) + (n0 >> 1) + c4;
        f32x4 v[8];
#pragma unroll
        for (int i = 0; i < 8; ++i) v[i] = *(const f32x4*)(Ws + (size_t)(k0 + 8 * i + (lane >> 3)) * 512);
#pragma unroll
        for (int i = 0; i < 8; ++i) { LAS float* d = scr + (8 * i + (lane >> 3)) * 33 + 2 * c4 + m; d[0] = v[i][0]; d[2] = v[i][1]; d[4] = v[i][2]; d[6] = v[i][3]; }
        moe_item_store<true>(moe_wbuf(F, l) + (size_t)e * 1024 * 1024, 1024, k0, n0, scr, lane); }
    for (int it = gw; it < NE * I_DN; it += NGW) { const int e = it / I_DN, item = it % I_DN;
        const int kb = item / 32, nb = item % 32, k0 = 64 * kb, n0 = 32 * nb; const int c4 = (lane & 7) * 4;
        const float* Ws = P.in[35] + ((size_t)l * NE + e) * 512 * 1024 + n0 + c4;
        f32x4 v[8];
#pragma unroll
        for (int i = 0; i < 8; ++i) v[i] = *(const f32x4*)(Ws + (size_t)(k0 + 8 * i + (lane >> 3)) * 1024);
#pragma unroll
        for (int i = 0; i < 8; ++i) { LAS float* d = scr + (8 * i + (lane >> 3)) * 33 + c4; d[0] = v[i][0]; d[1] = v[i][1]; d[2] = v[i][2]; d[3] = v[i][3]; }
        moe_item_store<true>(moe_wbuf(F, l) + (size_t)NE * 1024 * 1024 + (size_t)e * 1024 * 512, 512, k0, n0, scr, lane); }
}
__device__ __forceinline__ void phase_convert_lora(Frame& F, const Params& P) {
    bf16_t* dst = WSP(bf16_t, WS_LORA);
    for (int idx = (int)blockIdx.x * 512 + F.tid; idx < 11 * 512 * 32 + 4 * 512 * 96; idx += F.G * 512) {
        float val;
        if (idx < 11 * 512 * 32) { const int m = idx / (512 * 32), rem = idx % (512 * 32), ch = rem / 32, i = rem % 32;
            if (m < 4) val = P.in[6][((size_t)m * 32 + i) * 512 + ch]; else if (m < 8) val = P.in[8][((size_t)(m - 4) * 32 + i) * 512 + ch]; else val = P.in[11][((size_t)(m - 8) * 32 + i) * 512 + ch]; }
        else { const int r2 = idx - 11 * 512 * 32, m = r2 / (512 * 96), rem = r2 % (512 * 96), ch = rem / 96, i = rem % 96; val = P.in[9][((size_t)m * 96 + i) * 512 + ch]; }
        dst[idx] = f2bf(val); }
}
__device__ __forceinline__ void phase_convert_sgu(Frame& F, const Params& P) {
    bf16_t* dst = WSP(bf16_t, WS_SGUW);
    for (int idx = (int)blockIdx.x * 512 + F.tid; idx < NL * 4 * 128 * 128; idx += F.G * 512) { const int p = (idx >> 7) & 127, qq = idx & 127; dst[idx] = f2bf(qq <= p ? P.in[20][idx] : 0.f); }
}
__device__ __forceinline__ void phase_convert_router(Frame& F, const Params& P) {
    bf16_t* dst = WSP(bf16_t, WS_WRG); float* rc = WSP(float, WS_RC);
    for (int idx = (int)blockIdx.x * 512 + F.tid; idx < NL * 256 * 1024; idx += F.G * 512) { const int l = idx >> 18, n = (idx >> 10) & 255, k = idx & 1023;
        dst[idx] = f2bf(n < 32 ? P.in[29][(size_t)l * 1024 + k] * P.in[31][(size_t)k * 32 + n] : 0.f); }
    const int gwv = (int)blockIdx.x * 8 + F.wave;
    if (gwv < NL * 32) { const int l = gwv >> 5, e = gwv & 31; float c1 = 0.f, c0 = 0.f;
#pragma unroll
        for (int j = 0; j < 16; ++j) { const int k = F.lane + 64 * j; const float w = P.in[31][(size_t)k * 32 + e]; c1 += P.in[29][(size_t)l * 1024 + k] * w; c0 += P.in[30][(size_t)l * 1024 + k] * w; }
        c1 = wave_sum(c1); c0 = wave_sum(c0);
        if (F.lane == 0) { rc[l * 64 + e] = c1; rc[l * 64 + 32 + e] = c0; } }
}
__device__ __forceinline__ void phase_x_to_bf16(Frame& F, const Params& P) {
    const size_t n8 = (size_t)T * D / 8; const float* x = P.in[0]; bf16_t* xb = WSP(bf16_t, WS_X); unsigned char* xq = WSP(unsigned char, WS_XQ);
    for (size_t i = (size_t)blockIdx.x * 512 + F.tid; i < n8; i += (size_t)F.G * 512) {
        const f32x4 a = *(const f32x4*)(x + i * 8), b = *(const f32x4*)(x + i * 8 + 4);
        u32x4 o; o.x = cvt_pk_bf16(a[0], a[1]); o.y = cvt_pk_bf16(a[2], a[3]); o.z = cvt_pk_bf16(b[0], b[1]); o.w = cvt_pk_bf16(b[2], b[3]);
        *(u32x4*)(xb + i * 8) = o;
        u32x2 qv; qv.x = pack_fp8x4(a[0], a[1], a[2], a[3]); qv.y = pack_fp8x4(b[0], b[1], b[2], b[3]); *(u32x2*)(xq + i * 8) = qv; }
}

struct SchedInproj { const char* X; const char* W; int G, c;
    __device__ __forceinline__ bool next(int i, ge::Unit& u) const { int pm, pn; if (!ge::static_tile((long)i * G + c, T / 256, NIN / 256, pm, pn)) return false;
        u.A = X + (size_t)pm * 256 * 1024; u.B = W + (size_t)pn * 256 * 1024; u.gat = nullptr; u.lda = 1024; u.ldb = 1024; u.nt = 8; u.gshift = 0; u.nvalid = 256; u.pm = pm; u.pn = pn; u.aux = 0; return true; } };
struct EpiInproj { static constexpr bool AFTER_DRAIN = false; bf16_t* rkv; bf16_t* sguz; bf16_t* convh; unsigned char* gates;
    typedef ge::NoPre Pre; __device__ __forceinline__ Pre prefetch(const ge::Unit&, int, int, int, int) const { return Pre{}; }
    __device__ __forceinline__ void operator()(const ge::Acc& acc, const ge::Unit& u, int wr, int wc, int fr, int fq, const Pre&) const {
        const int pn = u.pn; const int row0 = u.pm * 256 + wr * 64 + fr;
        int kind, ld, colt; bf16_t* base;
        if (pn < 7) { kind = 0; base = rkv; ld = RKVW; colt = pn * 256; }
        else if (pn < 9) { kind = 1; base = sguz; ld = 512; colt = (pn - 7) * 256; }
        else if (pn < 11) { kind = 2; base = convh; ld = 256; colt = (pn - 9) * 128; }
        else { kind = 3; base = rkv; ld = 3072; colt = (pn - 11) * 256; }
#pragma unroll
        for (int ai = 0; ai < 2; ++ai)
#pragma unroll
            for (int m = 0; m < 4; ++m) { const size_t r = (size_t)(row0 + ai * 128 + m * 16);
#pragma unroll
                for (int bj = 0; bj < 2; ++bj) { const int c = 128 * bj + 32 * wc + 8 * fq; f32x4 v0 = acc[ai][bj][m][0], v1 = acc[ai][bj][m][1];
                    if (kind == 2) {
                        const float h0 = v0[0] * sigmoidf_(v0[1]), h1 = v0[2] * sigmoidf_(v0[3]), h2 = v1[0] * sigmoidf_(v1[1]), h3 = v1[2] * sigmoidf_(v1[3]);
                        u32x2 w; w.x = cvt_pk_bf16(h0, h1); w.y = cvt_pk_bf16(h2, h3);
                        *(u32x2*)(base + r * ld + colt + (c >> 1)) = w;
                    } else if (kind == 3) {
                        u32x2 w; unsigned w0 = 0, w1 = 0;
                        w0 = __builtin_amdgcn_cvt_pk_u8_f32(255.f * sigmoidf_(v0[0]) + 0.5f, 0, w0); w0 = __builtin_amdgcn_cvt_pk_u8_f32(255.f * sigmoidf_(v0[1]) + 0.5f, 1, w0);
                        w0 = __builtin_amdgcn_cvt_pk_u8_f32(255.f * sigmoidf_(v0[2]) + 0.5f, 2, w0); w0 = __builtin_amdgcn_cvt_pk_u8_f32(255.f * sigmoidf_(v0[3]) + 0.5f, 3, w0);
                        w1 = __builtin_amdgcn_cvt_pk_u8_f32(255.f * sigmoidf_(v1[0]) + 0.5f, 0, w1); w1 = __builtin_amdgcn_cvt_pk_u8_f32(255.f * sigmoidf_(v1[1]) + 0.5f, 1, w1);
                        w1 = __builtin_amdgcn_cvt_pk_u8_f32(255.f * sigmoidf_(v1[2]) + 0.5f, 2, w1); w1 = __builtin_amdgcn_cvt_pk_u8_f32(255.f * sigmoidf_(v1[3]) + 0.5f, 3, w1);
                        w.x = w0; w.y = w1; *(u32x2*)(gates + r * 3072 + colt + c) = w;
                    } else {
                        if (kind == 1) {
#pragma unroll
                            for (int j = 0; j < 4; ++j) { v0[j] = gelu_f(v0[j]); v1[j] = gelu_f(v1[j]); } }
                        u32x4 w; w.x = cvt_pk_bf16(v0[0], v0[1]); w.y = cvt_pk_bf16(v0[2], v0[3]); w.z = cvt_pk_bf16(v1[0], v1[1]); w.w = cvt_pk_bf16(v1[2], v1[3]);
                        *(u32x4*)(base + r * ld + colt + c) = w; } } }
    } };
struct SchedBranch { const char* ws; size_t woff; int G, v;
    __device__ __forceinline__ bool next(int i, ge::Unit& u) const { const int tile = (i / 3) * G + v, br = i % 3, pm = tile >> 2, pn = tile & 3; if (tile >= 512) return false;
        const unsigned kb = (br == 0) ? 512u : 256u;
        size_t ao = WS_OUTA, wo = woff; if (br == 1) { ao = WS_HB; wo += (size_t)1024 * 512; } if (br == 2) { ao = WS_HC; wo += (size_t)1024 * 512 + (size_t)1024 * 256; }
        u.A = ws + ao + (size_t)pm * 256 * kb; u.lda = kb; u.nt = (int)(kb >> 7); u.B = ws + wo + (size_t)pn * 256 * kb; u.ldb = kb;
        u.gat = nullptr; u.gshift = 0; u.nvalid = 256; u.pm = pm; u.pn = pn; u.aux = br; return true; } };
struct EpiBranch { static constexpr bool AFTER_DRAIN = false; const unsigned char* gates; bf16_t* merged; unsigned char* mq;
    typedef ge::NoPre Pre; __device__ __forceinline__ Pre prefetch(const ge::Unit&, int, int, int, int) const { return Pre{}; }
    __device__ __forceinline__ void operator()(const ge::Acc& acc, const ge::Unit& u, int wr, int wc, int fr, int fq, const Pre&) const {
        const int br = u.aux; const int row0 = u.pm * 256 + wr * 64 + fr;
        u32x2 gall[16];
#pragma unroll
        for (int i = 0; i < 16; ++i) { const size_t r = (size_t)(row0 + (i >> 3) * 128 + ((i >> 1) & 3) * 16); const int c = u.pn * 256 + 128 * (i & 1) + 32 * wc + 8 * fq; gall[i] = *(const u32x2*)(gates + r * 3072 + br * 1024 + c); }
#pragma unroll
        for (int ai = 0; ai < 2; ++ai) {
            u32x2 g[8]; u32x4 p[8];
#pragma unroll
            for (int m = 0; m < 4; ++m)
#pragma unroll
                for (int bj = 0; bj < 2; ++bj) { const size_t r = (size_t)(row0 + ai * 128 + m * 16); const int c = u.pn * 256 + 128 * bj + 32 * wc + 8 * fq;
                    g[m * 2 + bj] = gall[ai * 8 + m * 2 + bj];
                    p[m * 2 + bj] = (br > 0) ? *(const u32x4*)(merged + r * 1024 + c) : (u32x4){0u, 0u, 0u, 0u}; }
#pragma unroll
            for (int m = 0; m < 4; ++m)
#pragma unroll
                for (int bj = 0; bj < 2; ++bj) { const size_t r = (size_t)(row0 + ai * 128 + m * 16); const int c = u.pn * 256 + 128 * bj + 32 * wc + 8 * fq;
                    const f32x4 v0 = acc[ai][bj][m][0], v1 = acc[ai][bj][m][1]; const u32x2 gg = g[m * 2 + bj]; const u32x4 pp = p[m * 2 + bj];
                    const float k = 1.f / 255.f;
                    const float g0 = k * (float)(gg.x & 0xffu), g1 = k * (float)((gg.x >> 8) & 0xffu), g2 = k * (float)((gg.x >> 16) & 0xffu), g3 = k * (float)(gg.x >> 24);
                    const float g4 = k * (float)(gg.y & 0xffu), g5 = k * (float)((gg.y >> 8) & 0xffu), g6 = k * (float)((gg.y >> 16) & 0xffu), g7 = k * (float)(gg.y >> 24);
                    u32x4 w; w.x = cvt_pk_bf16(v0[0] * g0 + bflo(pp.x), v0[1] * g1 + bfhi(pp.x)); w.y = cvt_pk_bf16(v0[2] * g2 + bflo(pp.y), v0[3] * g3 + bfhi(pp.y));
                    w.z = cvt_pk_bf16(v1[0] * g4 + bflo(pp.z), v1[1] * g5 + bfhi(pp.z)); w.w = cvt_pk_bf16(v1[2] * g6 + bflo(pp.w), v1[3] * g7 + bfhi(pp.w));
                    if (br == 2) { u32x2 wq; wq.x = pack_fp8x4(4.f * (v0[0] * g0 + bflo(pp.x)), 4.f * (v0[1] * g1 + bfhi(pp.x)), 4.f * (v0[2] * g2 + bflo(pp.y)), 4.f * (v0[3] * g3 + bfhi(pp.y)));
                        wq.y = pack_fp8x4(4.f * (v1[0] * g4 + bflo(pp.z)), 4.f * (v1[1] * g5 + bfhi(pp.z)), 4.f * (v1[2] * g6 + bflo(pp.w)), 4.f * (v1[3] * g7 + bfhi(pp.w))); *(u32x2*)(mq + r * 1024 + c) = wq; }
                    else *(u32x4*)(merged + r * 1024 + c) = w; }
            asm volatile("" ::: "memory"); }
    } };
struct SchedWout { const char* A; const char* W; int G, v;
    __device__ __forceinline__ bool next(int i, ge::Unit& u) const { const int tile = i * G + v, pm = tile >> 2, pn = tile & 3; if (tile >= 512) return false;
        u.A = A + (size_t)pm * 256 * 1024; u.B = W + (size_t)pn * 256 * 1024; u.gat = nullptr; u.lda = 1024; u.ldb = 1024; u.nt = 8; u.gshift = 0; u.nvalid = 256; u.pm = pm; u.pn = pn; u.aux = 0; return true; } };
struct EpiWout { static constexpr bool AFTER_DRAIN = false; const bf16_t* x; bf16_t* pre; float* stats;
    typedef ge::NoPre Pre; __device__ __forceinline__ Pre prefetch(const ge::Unit&, int, int, int, int) const { return Pre{}; }
    __device__ __forceinline__ void operator()(const ge::Acc& acc, const ge::Unit& u, int wr, int wc, int fr, int fq, const Pre&) const {
        const int row0 = u.pm * 256 + wr * 64 + fr;
#pragma unroll
        for (int ai = 0; ai < 2; ++ai) {
            u32x4 xr[8];
#pragma unroll
            for (int m = 0; m < 4; ++m)
#pragma unroll
                for (int bj = 0; bj < 2; ++bj) xr[m * 2 + bj] = *(const u32x4*)(x + (size_t)(row0 + ai * 128 + m * 16) * 1024 + u.pn * 256 + 128 * bj + 32 * wc + 8 * fq);
#pragma unroll
            for (int m = 0; m < 4; ++m) { const size_t r = (size_t)(row0 + ai * 128 + m * 16); float s1 = 0.f, s2 = 0.f;
#pragma unroll
                for (int bj = 0; bj < 2; ++bj) { const int c = u.pn * 256 + 128 * bj + 32 * wc + 8 * fq; const f32x4 v0 = acc[ai][bj][m][0], v1 = acc[ai][bj][m][1];
                    const u32x4 p = xr[m * 2 + bj];
                    u32x4 w; w.x = cvt_pk_bf16(v0[0] + ALPHA * bflo(p.x), v0[1] + ALPHA * bfhi(p.x)); w.y = cvt_pk_bf16(v0[2] + ALPHA * bflo(p.y), v0[3] + ALPHA * bfhi(p.y));
                    w.z = cvt_pk_bf16(v1[0] + ALPHA * bflo(p.z), v1[1] + ALPHA * bfhi(p.z)); w.w = cvt_pk_bf16(v1[2] + ALPHA * bflo(p.w), v1[3] + ALPHA * bfhi(p.w));
                    *(u32x4*)(pre + r * 1024 + c) = w;
                    const float q0 = bflo(w.x), q1 = bfhi(w.x), q2 = bflo(w.y), q3 = bfhi(w.y), q4 = bflo(w.z), q5 = bfhi(w.z), q6 = bflo(w.w), q7 = bfhi(w.w);
                    s1 += ((q0 + q1) + (q2 + q3)) + ((q4 + q5) + (q6 + q7)); s2 += ((q0 * q0 + q1 * q1) + (q2 * q2 + q3 * q3)) + ((q4 * q4 + q5 * q5) + (q6 * q6 + q7 * q7)); }
                s1 += __shfl_xor(s1, 16); s2 += __shfl_xor(s2, 16); s1 += __shfl_xor(s1, 32); s2 += __shfl_xor(s2, 32);
                if (fq == 0) *(f32x2*)(stats + (r * 16 + u.pn * 4 + wc) * 2) = (f32x2){s1, s2}; }
            asm volatile("" ::: "memory"); }
    } };
struct SchedRouter { const char* A; const char* W; int G, v;
    __device__ __forceinline__ bool next(int i, ge::Unit& u) const { const int pm = i * G + v; if (pm >= 128) return false;
        u.A = A + (size_t)pm * 256 * 2048; u.B = W; u.gat = nullptr; u.lda = 2048; u.ldb = 2048; u.nt = 16; u.gshift = 0; u.nvalid = 256; u.pm = pm; u.pn = 0; u.aux = 0; return true; } };
struct EpiRouter { static constexpr bool AFTER_DRAIN = true; const float* rbias; unsigned* cnt; int* list; const float* stats; const float* rc;
    typedef ge::NoPre Pre; __device__ __forceinline__ Pre prefetch(const ge::Unit&, int, int, int, int) const { return Pre{}; }
    __device__ __forceinline__ void drained(const ge::Acc& acc, const ge::Unit& u, int wr, int wc, int fr, int fq, LAS unsigned char* lds) const {
        LAS int* lcnt = (LAS int*)lds; LAS int* lbase = lcnt + 32;
        const bool t32 = (wr == 0 && wc == 0 && fq < 2); const int t = fq * 16 + fr;
        if (t32) lcnt[t] = 0;
        __syncthreads();
        int e1[8], e2[8], r1[8], r2[8]; float g1[8], g2[8];
        const int row0 = u.pm * 256 + wr * 64 + fr;
        if (wc == 0) {
            float bias[8], c1v[8], c0v[8];
#pragma unroll
            for (int j = 0; j < 8; ++j) { bias[j] = rbias[8 * fq + j]; c1v[j] = rc[8 * fq + j]; c0v[j] = rc[32 + 8 * fq + j]; }
            f32x4 sa0[8], sa1[8];
#pragma unroll
            for (int i8 = 0; i8 < 8; ++i8) { const size_t r = (size_t)(row0 + (i8 >> 2) * 128 + (i8 & 3) * 16); sa0[i8] = *(const f32x4*)(stats + (r * 16 + 4 * fq) * 2); sa1[i8] = *(const f32x4*)(stats + (r * 16 + 4 * fq + 2) * 2); }
#pragma unroll
            for (int ai = 0; ai < 2; ++ai)
#pragma unroll
                for (int m = 0; m < 4; ++m) { const int i8 = ai * 4 + m;
                    const f32x4 v0 = acc[ai][0][m][0], v1 = acc[ai][0][m][1];
                    float mean, rstd;
                    {   const f32x4 a0 = sa0[i8], a1 = sa1[i8];
                        float s1 = (a0[0] + a0[2]) + (a1[0] + a1[2]), s2 = (a0[1] + a0[3]) + (a1[1] + a1[3]);
                        s1 += __shfl_xor(s1, 16); s2 += __shfl_xor(s2, 16); s1 += __shfl_xor(s1, 32); s2 += __shfl_xor(s2, 32);
                        mean = s1 * (1.f / 1024.f); rstd = rsqrtf(fmaxf(s2 * (1.f / 1024.f) - mean * mean, 0.f) + LN_EPS); }
                    float s[8], sel[8];
#pragma unroll
                    for (int j = 0; j < 4; ++j) { s[j] = sigmoidf_(rstd * (v0[j] - mean * c1v[j]) + c0v[j]); s[4 + j] = sigmoidf_(rstd * (v1[j] - mean * c1v[4 + j]) + c0v[4 + j]); }
#pragma unroll
                    for (int j = 0; j < 8; ++j) sel[j] = s[j] + bias[j];
                    int i1 = 0; float m1 = sel[0];
#pragma unroll
                    for (int j = 1; j < 8; ++j) if (sel[j] > m1) { m1 = sel[j]; i1 = j; }
                    int i2 = (i1 == 0) ? 1 : 0; float m2 = (i1 == 0) ? sel[1] : sel[0];
#pragma unroll
                    for (int j = 0; j < 8; ++j) if (j != i1 && j != ((i1 == 0) ? 1 : 0) && sel[j] > m2) { m2 = sel[j]; i2 = j; }
                    float gs = m1 + m2; int gi = fq;
                    { const float os = __shfl_xor(gs, 16); const int oi = __shfl_xor(gi, 16); if (os > gs || (os == gs && oi < gi)) { gs = os; gi = oi; } }
                    { const float os = __shfl_xor(gs, 32); const int oi = __shfl_xor(gi, 32); if (os > gs || (os == gs && oi < gi)) { gs = os; gi = oi; } }
                    e1[i8] = -1; e2[i8] = -1; r1[i8] = 0; r2[i8] = 0; g1[i8] = 0.f; g2[i8] = 0.f;
                    if (gi == fq) {
                        float s1 = s[0], s2 = s[0];
#pragma unroll
                        for (int j = 0; j < 8; ++j) { s1 = (j == i1) ? s[j] : s1; s2 = (j == i2) ? s[j] : s2; }
                        const float inv = 1.0f / (s1 + s2);
                        e1[i8] = 8 * fq + i1; e2[i8] = 8 * fq + i2; g1[i8] = s1 * inv; g2[i8] = s2 * inv;
                        r1[i8] = __hip_atomic_fetch_add(lcnt + e1[i8], 1, __ATOMIC_RELAXED, __HIP_MEMORY_SCOPE_WORKGROUP);
                        r2[i8] = __hip_atomic_fetch_add(lcnt + e2[i8], 1, __ATOMIC_RELAXED, __HIP_MEMORY_SCOPE_WORKGROUP); } }
        }
        __syncthreads();
        if (t32) { const int c = lcnt[t]; lbase[t] = (c > 0) ? (int)atomicAdd(cnt + t, (unsigned)c) : 0; }
        __syncthreads();
        if (wc == 0) {
#pragma unroll
            for (int i8 = 0; i8 < 8; ++i8) if (e1[i8] >= 0) { const int r = row0 + (i8 >> 2) * 128 + (i8 & 3) * 16;
                u32x2 p1, p2; p1.x = (unsigned)(2 * r); p1.y = __float_as_uint(g1[i8]); p2.x = (unsigned)(2 * r + 1); p2.y = __float_as_uint(g2[i8]);
                *(u32x2*)(list + ((size_t)e1[i8] * T + lbase[e1[i8]] + r1[i8]) * 2) = p1; *(u32x2*)(list + ((size_t)e2[i8] * T + lbase[e2[i8]] + r2[i8]) * 2) = p2; } }
        __syncthreads();
    } };
__device__ __forceinline__ int build_tile_table(Frame& F, const unsigned* cnt) {
    volatile LAS int* tab = (volatile LAS int*)(F.lds + LDS_MISC + 64);
    __syncthreads();
    if (F.wave == 0) {
        const int e = F.lane & 31; const int c = (int)__hip_atomic_load(cnt + e, __ATOMIC_RELAXED, __HIP_MEMORY_SCOPE_AGENT); const int nt = (F.lane < 32) ? ((c + 255) >> 8) : 0;
        int incl = nt;
#pragma unroll
        for (int o = 1; o < 32; o <<= 1) { const int up = __shfl_up(incl, o); if ((F.lane & 31) >= o) incl += up; }
        const int base = incl - nt;
        if (F.lane < 32) for (int j = 0; j < nt; ++j) tab[1 + base + j] = (e << 16) | j;
        if (F.lane == 31) tab[0] = incl; }
    __syncthreads();
    return tab[0];
}
struct SchedMoe1 { const char* X1; const char* W; const int* list; const unsigned* cnt; LAS int* tab; int ntiles, G, v;
    __device__ __forceinline__ bool next(int i, ge::Unit& u) const { const int L = i * G + v, rt = L >> 2, pn = L & 3; if (rt >= ntiles) return false;
        const int ej = tab[1 + rt], e = ej >> 16, j = ej & 0xffff; const int c = (int)cnt[e];
        u.A = X1; u.gat = list + ((size_t)e * T + j * 256) * 2; u.gshift = 1; u.nvalid = (c - j * 256) < 256 ? (c - j * 256) : 256; u.lda = 1024; u.nt = 8;
        u.B = W + ((size_t)e * 1024 + (size_t)pn * 256) * 1024; u.ldb = 1024; u.pm = rt; u.pn = pn; u.aux = e; return true; } };
struct EpiMoe1 { static constexpr bool AFTER_DRAIN = false; unsigned char* H;
    typedef ge::NoPre Pre; __device__ __forceinline__ Pre prefetch(const ge::Unit&, int, int, int, int) const { return Pre{}; }
    __device__ __forceinline__ void operator()(const ge::Acc& acc, const ge::Unit& u, int wr, int wc, int fr, int fq, const Pre&) const {
        const int row0 = u.pm * 256 + wr * 64 + fr;
#pragma unroll
        for (int ai = 0; ai < 2; ++ai)
#pragma unroll
            for (int m = 0; m < 4; ++m) { const size_t r = (size_t)(row0 + ai * 128 + m * 16);
#pragma unroll
                for (int bj = 0; bj < 2; ++bj) { const int c = 128 * bj + 32 * wc + 8 * fq; const f32x4 v0 = acc[ai][bj][m][0], v1 = acc[ai][bj][m][1];
                    const float h0 = v0[0] * sigmoidf_(v0[0]) * v0[1], h1 = v0[2] * sigmoidf_(v0[2]) * v0[3], h2 = v1[0] * sigmoidf_(v1[0]) * v1[1], h3 = v1[2] * sigmoidf_(v1[2]) * v1[3];
                    *(unsigned*)(H + r * 512 + u.pn * 128 + (c >> 1)) = pack_fp8x4(h0, h1, h2, h3); }
                asm volatile("" ::: "memory"); }
    } };
struct SchedMoe2 { const char* H; const char* W; const int* list; const unsigned* cnt; LAS int* tab; int ntiles, G, v, ntk;
    __device__ __forceinline__ bool next(int i, ge::Unit& u) const { const int L = i * G + v, rt = L >> 2, pn = L & 3; if (rt >= ntiles) return false;
        const int ej = tab[1 + rt], e = ej >> 16, j = ej & 0xffff; const int c = (int)cnt[e];
        u.A = H + (size_t)rt * 256 * 512; u.gat = nullptr; u.gshift = 0; u.nvalid = (c - j * 256) < 256 ? (c - j * 256) : 256; u.lda = 512; u.nt = ntk;
        u.B = W + ((size_t)e * 1024 + (size_t)pn * 256) * 512; u.ldb = 512; u.pm = rt; u.pn = pn; u.aux = (e << 16) | j; return true; } };
template <int MODE> struct EpiMoe2T { static constexpr bool AFTER_DRAIN = false; const int* list; unsigned char* Y; int* inv;
    typedef ge::NoPre Pre; __device__ __forceinline__ Pre prefetch(const ge::Unit&, int, int, int, int) const { return Pre{}; }
    __device__ __forceinline__ void operator()(const ge::Acc& acc, const ge::Unit& u, int wr, int wc, int fr, int fq, const Pre&) const {
        const int e = u.aux >> 16, j = u.aux & 0xffff; const int* lst = list + ((size_t)e * T + j * 256) * 2;
        const unsigned row0 = (unsigned)u.pm * 256u + (unsigned)(wr * 64 + fr); const unsigned col0 = (unsigned)(u.pn * 256 + 32 * wc + 8 * fq);
        const bool invw = (u.pn == 0 && wc == 0 && fq == 0);
        u32x2 sgall[8];
#pragma unroll
        for (int i8 = 0; i8 < 8; ++i8) { const int rr = (i8 >> 2) * 128 + wr * 64 + (i8 & 3) * 16 + fr; const u32x2 v = *(const u32x2*)(lst + 2 * (rr < u.nvalid ? rr : 0)); sgall[i8].x = (rr < u.nvalid) ? v.x : 0xffffffffu; sgall[i8].y = v.y; }
#pragma unroll
        for (int ai = 0; ai < 2; ++ai) {
            u32x2 sg[4];
#pragma unroll
            for (int m = 0; m < 4; ++m) sg[m] = sgall[ai * 4 + m];
#pragma unroll
            for (int m = 0; m < 4; ++m) { const int sl = (int)sg[m].x; const float gg = __uint_as_float(sg[m].y);
                const unsigned yrow = row0 + (unsigned)(ai * 128 + m * 16);
                if (MODE == 1) { if (sl == 0x7ffffff0) Y[0] = (unsigned char)pack_fp8x4(acc[ai][0][m][0][0] * gg, 0.f, 0.f, 0.f); }
                else if (sl >= 0) {
                    if (invw) inv[sl] = (int)yrow;
#pragma unroll
                    for (int bj = 0; bj < 2; ++bj) { const f32x4 v0 = acc[ai][bj][m][0], v1 = acc[ai][bj][m][1];
                        const float g8 = 8.f * gg; u32x2 w; w.x = pack_fp8x4(g8 * v0[0], g8 * v0[1], g8 * v0[2], g8 * v0[3]); w.y = pack_fp8x4(g8 * v1[0], g8 * v1[1], g8 * v1[2], g8 * v1[3]);
                        *(u32x2*)(Y + (yrow * 1024u + col0 + 128u * bj)) = w; } } }
            asm volatile("" ::: "memory"); }
    } };
typedef EpiMoe2T<0> EpiMoe2;
typedef short bf16x4 __attribute__((ext_vector_type(4)));
#define MFMA16(a, b, c) __builtin_amdgcn_mfma_f32_16x16x16bf16_1k(a, b, c, 0, 0, 0)
#define MFMA32(a, b, c) __builtin_amdgcn_mfma_f32_16x16x32_bf16(a, b, c, 0, 0, 0)
__device__ __forceinline__ bf16x4 pack4(const f32x4 v) { u32x2 w; w.x = cvt_pk_bf16(v[0], v[1]); w.y = cvt_pk_bf16(v[2], v[3]); return __builtin_bit_cast(bf16x4, w); }
__device__ __forceinline__ f32x4 unpack4(const u32x2 w) { return (f32x4){bflo(w.x), bfhi(w.x), bflo(w.y), bfhi(w.y)}; }
constexpr int TP = 72;
constexpr int TILE_B = 64 * TP * 2;
constexpr int LA_ACT = 0;
constexpr int LA_AT = 13312, LA_RT = LA_AT + TILE_B, LA_BT = LA_RT + TILE_B, LA_KT = LA_BT + TILE_B;
constexpr int LA_BTT = LA_KT + TILE_B, LA_KTT = LA_BTT + TILE_B, LA_VT = LA_KTT + TILE_B;
constexpr int LA_AAB = LA_VT + TILE_B, LA_AAK = LA_AAB + TILE_B, LA_ARB = LA_AAK + TILE_B, LA_ARK = LA_ARB + TILE_B;
constexpr int LA_DIAG = LA_ARK + TILE_B;
constexpr int LA_TII = LA_DIAG + 4096;
constexpr int LA_SEG = LA_TII + 3072;
constexpr int LA_KSQ = LA_SEG + 4096;
constexpr int LA_RKP = LA_KSQ + 1024;
constexpr int LA_PC = LA_RKP + 1024;
static_assert(LA_PC + 256 <= LDS_STAGE, "pass A LDS map");

template <bool EONLY> __device__ __forceinline__ void phase_wkv_a(Frame& F, const Params& P, int l) {
    LAS unsigned char* lds = F.lds;
    const bf16_t* rkv = WSP(bf16_t, WS_RKV);
    const bf16_t* wupT = WSP(bf16_t, WS_LORA) + (size_t)l * 512 * 32;
    const bf16_t* aupT = WSP(bf16_t, WS_LORA) + (size_t)(4 + l) * 512 * 32;
    const bf16_t* vupT = WSP(bf16_t, WS_LORA) + (size_t)(8 + (l > 0 ? l - 1 : 0)) * 512 * 32;
    const float* mu = P.in[3] + (size_t)l * 1696; const float* muv = (l > 0) ? P.in[4] + (size_t)(l - 1) * 32 : nullptr;
    bf16_t* PHI = WSP(bf16_t, WS_PHI); bf16_t* PSI = WSP(bf16_t, WS_PSI); bf16_t* GT = WSP(bf16_t, WS_GT); bf16_t* Y0T = WSP(bf16_t, WS_Y0T); bf16_t* VT = WSP(bf16_t, WS_VT); bf16_t* VF = WSP(bf16_t, WS_VFIRST);
    float* RK = WSP(float, WS_RK);
    const int lane = F.lane, w = F.wave, cb = w & 3, th = w >> 2;
#define WKVA_RAW_LOAD(dst, hn) do { _Pragma("unroll") for (int i_ = 0; i_ < 4; ++i_) { const int p_ = F.tid + 512 * i_; const int pc_ = p_ < 1560 ? p_ : 1559; const int row_ = pc_ / 24, rem_ = pc_ % 24; \
        const int tok_ = (row_ == 0 && firstchunk) ? t0 : t0 - 1 + row_; dst[i_] = *(const u32x4*)(rkv + (size_t)tok_ * RKVW + (rem_ >> 3) * 512 + (hn) * 64 + (rem_ & 7) * 8); } } while (0)
#define WKVA_RAW_STORE(src) do { _Pragma("unroll") for (int i_ = 0; i_ < 4; ++i_) { const int p_ = F.tid + 512 * i_; if (p_ < 1560) { const int row_ = p_ / 24, rem_ = p_ % 24; \
        *(LAS u32x4*)(lds + LDS_RAW + (row_ * 192 + (rem_ >> 3) * 64 + (rem_ & 7) * 8) * 2) = src[i_]; } } } while (0)
    for (int unit = blockIdx.x; unit < T / 64; unit += F.G) {
        const int t0 = unit * 64; const bool firstchunk = (t0 & (SEQ - 1)) == 0;
        __syncthreads();
        { u32x4 r0_[4]; WKVA_RAW_LOAD(r0_, 0); WKVA_RAW_STORE(r0_); }
        for (int idx = F.tid; idx < 64 * 96; idx += 512) { const int tok = idx / 96, qq = idx % 96; const int col = (qq < 64) ? 1536 + qq : 1536 + 96 + qq;
            const int t = t0 + tok;
            const bool hp = (tok > 0 || !firstchunk); const float p = bf2f(rkv[(size_t)t * RKVW + col]); const float ppl = bf2f(rkv[(size_t)(hp ? t - 1 : t) * RKVW + col]); const float pp = hp ? ppl : 0.f;
            const float m_ = (qq < 64) ? mu[1536 + qq] : ((l > 0) ? P.in[4][(size_t)(l > 0 ? l - 1 : 0) * 32 + qq - 64] : 0.f);
            float val = p + (pp - p) * m_; if (qq < 32) val = tanhf(val);
            *(LAS bf16_t*)(lds + LA_ACT + (tok * 104 + qq) * 2) = f2bf(val); }
        __syncthreads();
        for (int h = 0; h < 8; ++h) {
            int lz = lane; asm volatile("" : "+v"(lz)); const int c = lz & 15, q = lz >> 4;
            const int chid = unit * 8 + h; const int ch = 16 * cb + c, chg = h * 64 + ch;
            f32x4 zw[2], za[2], zv[2];
            {   const bf16x8 bw = *(const bf16x8*)(wupT + (size_t)chg * 32 + 8 * q), ba = *(const bf16x8*)(aupT + (size_t)chg * 32 + 8 * q), bv = *(const bf16x8*)(vupT + (size_t)chg * 32 + 8 * q);
#pragma unroll
                for (int ii = 0; ii < 2; ++ii) { const int i = 2 * th + ii; const LAS unsigned char* ar = lds + LA_ACT + ((16 * i + c) * 104 + 8 * q) * 2;
                    const bf16x8 a0 = *(const LAS bf16x8*)(ar), a1 = *(const LAS bf16x8*)(ar + 64), a2 = *(const LAS bf16x8*)(ar + 128);
                    const f32x4 z = {0.f, 0.f, 0.f, 0.f};
                    zw[ii] = MFMA32(a0, bw, z); za[ii] = MFMA32(a1, ba, z); zv[ii] = MFMA32(a2, bv, z); } }
            const float mu_r = mu[chg], mu_k = mu[512 + chg], mu_v = mu[1024 + chg];
            const float w0 = P.in[5][(size_t)l * 512 + chg], a0_ = P.in[7][(size_t)l * 512 + chg], v0_ = (l > 0) ? P.in[10][(size_t)(l - 1) * 512 + chg] : 0.f;
            const float k_k = P.in[12][(size_t)l * 512 + chg], k_a = P.in[13][(size_t)l * 512 + chg], r_k = P.in[14][(size_t)l * 512 + chg];
            float rr[2][4], kh[2][4], vv[2][4], lw[2][4], ic[2][4], kkr[2][4];
#pragma unroll
            for (int ii = 0; ii < 2; ++ii) { const int i = 2 * th + ii; const int tl0 = 16 * i + 4 * q;
                const bool hasprev = (tl0 > 0) || !firstchunk;
                const LAS unsigned char* rb = lds + LDS_RAW + (tl0 * 192 + ch) * 2;
                const float lpr = bf2f(*(const LAS bf16_t*)(rb)), lpk = bf2f(*(const LAS bf16_t*)(rb + 128)), lpv = bf2f(*(const LAS bf16_t*)(rb + 256));
                float pr = hasprev ? lpr : 0.f, pk = hasprev ? lpk : 0.f, pv = hasprev ? lpv : 0.f;
                f32x4 vf = {0.f, 0.f, 0.f, 0.f};
                if (l > 0) vf = unpack4(*(const u32x2*)(VF + ((size_t)chid * 64 + ch) * 64 + tl0));
                float lsum = 0.f;
#pragma unroll
                for (int r = 0; r < 4; ++r) { const LAS unsigned char* rc_ = rb + (r + 1) * 384; const float cr = bf2f(*(const LAS bf16_t*)(rc_)), ck = bf2f(*(const LAS bf16_t*)(rc_ + 128)), cv = bf2f(*(const LAS bf16_t*)(rc_ + 256));
                    const float r_ = cr + (pr - cr) * mu_r, k_ = ck + (pk - ck) * mu_k; float v_ = cv + (pv - cv) * mu_v; pr = cr; pk = ck; pv = cv;
                    const float lw_ = -0.6065306597126334f * sigmoidf_(w0 + zw[ii][r]); const float icl = sigmoidf_(a0_ + za[ii][r]);
                    if (l > 0) v_ = v_ + (vf[r] - v_) * sigmoidf_(v0_ + zv[ii][r]);
                    const float kk_ = k_ * k_k, kh_ = k_ * (1.0f + (icl - 1.0f) * k_a);
                    rr[ii][r] = r_; kh[ii][r] = kh_; vv[ii][r] = v_; lw[ii][r] = lw_; ic[ii][r] = icl; kkr[ii][r] = kk_; lsum += lw_;
                    const float s1 = row16_sum(kk_ * kk_), s2 = row16_sum(r_ * kh_ * r_k);
                    *(LAS float*)(lds + LA_KSQ + (cb * 64 + tl0 + r) * 4) = s1; *(LAS float*)(lds + LA_RKP + (cb * 64 + tl0 + r) * 4) = s2; }
                *(LAS float*)(lds + LA_SEG + (ch * 16 + i * 4 + q) * 4) = lsum; }
            __syncthreads();
            u32x4 nraw[4]; if (h < 7) WKVA_RAW_LOAD(nraw, h + 1);
            {   float seg[16];
#pragma unroll
                for (int j4 = 0; j4 < 4; ++j4) { const f32x4 s4 = *(const LAS f32x4*)(lds + LA_SEG + (ch * 16 + 4 * j4) * 4); seg[4 * j4] = s4[0]; seg[4 * j4 + 1] = s4[1]; seg[4 * j4 + 2] = s4[2]; seg[4 * j4 + 3] = s4[3]; }
                float tot = 0.f;
#pragma unroll
                for (int j = 0; j < 16; ++j) tot += seg[j];
                if (th == 0) *(LAS float*)(lds + LA_PC + ch * 4) = __expf(tot);
                float mine[8];
#pragma unroll
                for (int j = 0; j < 8; ++j) mine[j] = th ? seg[8 + j] : seg[j];
                const float firsthalf = th ? (((seg[0] + seg[1]) + (seg[2] + seg[3])) + ((seg[4] + seg[5]) + (seg[6] + seg[7]))) : 0.f;
#pragma unroll
                for (int ii = 0; ii < 2; ++ii) { const int i = 2 * th + ii; const int tl0 = 16 * i + 4 * q; const int sidx = i * 4 + q;
                    float cum = firsthalf + (ii ? ((mine[0] + mine[1]) + (mine[2] + mine[3])) : 0.f);
                    { const float s0 = mine[4 * ii], s1 = mine[4 * ii + 1], s2 = mine[4 * ii + 2]; cum += (q > 0 ? s0 : 0.f) + (q > 1 ? s1 : 0.f) + (q > 2 ? s2 : 0.f); }
                    f32x4 at, rt, bt, kt;
#pragma unroll
                    for (int r = 0; r < 4; ++r) { const int tl = tl0 + r;
                        const float ks = (*(const LAS float*)(lds + LA_KSQ + tl * 4) + *(const LAS float*)(lds + LA_KSQ + (64 + tl) * 4)) + (*(const LAS float*)(lds + LA_KSQ + (128 + tl) * 4) + *(const LAS float*)(lds + LA_KSQ + (192 + tl) * 4));
                        const float kk_ = kkr[ii][r] * __builtin_amdgcn_rsqf(fmaxf(ks, 1e-24f));
                        const float cumx = cum; cum += lw[ii][r];
                        const float ex = __expf(cumx), ei = __expf(cum), en = __expf(-cum);
                        at[r] = -kk_ * ex; rt[r] = rr[ii][r] * ei; bt[r] = kk_ * ic[ii][r] * en; kt[r] = kh[ii][r] * en;

                        *(LAS bf16_t*)(lds + LA_AT + (tl * TP + ch) * 2) = f2bf(at[r]); *(LAS bf16_t*)(lds + LA_RT + (tl * TP + ch) * 2) = f2bf(rt[r]);
                        *(LAS bf16_t*)(lds + LA_BT + (tl * TP + ch) * 2) = f2bf(bt[r]); *(LAS bf16_t*)(lds + LA_KT + (tl * TP + ch) * 2) = f2bf(kt[r]);
                        if (cb == 0) { const float rk = (*(const LAS float*)(lds + LA_RKP + tl * 4) + *(const LAS float*)(lds + LA_RKP + (64 + tl) * 4)) + (*(const LAS float*)(lds + LA_RKP + (128 + tl) * 4) + *(const LAS float*)(lds + LA_RKP + (192 + tl) * 4));
                            if (c == 0) RK[(size_t)(t0 + tl) * 8 + h] = rk; } }
                    const f32x4 v4 = {vv[ii][0], vv[ii][1], vv[ii][2], vv[ii][3]};
                    *(LAS bf16x4*)(lds + LA_BTT + (ch * TP + tl0) * 2) = pack4(bt); *(LAS bf16x4*)(lds + LA_KTT + (ch * TP + tl0) * 2) = pack4(kt); *(LAS bf16x4*)(lds + LA_VT + (ch * TP + tl0) * 2) = pack4(v4);
                    *(bf16x4*)(VT + ((size_t)chid * 64 + ch) * 64 + tl0) = pack4(v4);
                    if (l == 0) *(bf16x4*)(VF + ((size_t)chid * 64 + ch) * 64 + tl0) = pack4(v4); } }
            __syncthreads();
            if (EONLY) { if (h < 7) WKVA_RAW_STORE(nraw); __syncthreads(); continue; }
            {   const bool isR = w >= 4; const int i = w & 3;
                const LAS unsigned char* brow = lds + (isR ? LA_RT : LA_AT) + ((16 * i + c) * TP + 8 * q) * 2;
                const bf16x8 bf0 = *(const LAS bf16x8*)(brow), bf1 = *(const LAS bf16x8*)(brow + 64);
                LAS unsigned char* ob = lds + (isR ? LA_ARB : LA_AAB); LAS unsigned char* ok = lds + (isR ? LA_ARK : LA_AAK);
                const int tloc = 16 * i + c;
#pragma unroll
                for (int j = 0; j < 4; ++j) { f32x4 db = {0.f, 0.f, 0.f, 0.f}, dk = {0.f, 0.f, 0.f, 0.f};
                    if (j <= i) { const LAS unsigned char* arb = lds + LA_BT + ((16 * j + c) * TP + 8 * q) * 2; const LAS unsigned char* ark = lds + LA_KT + ((16 * j + c) * TP + 8 * q) * 2;
                        db = MFMA32(*(const LAS bf16x8*)(arb), bf0, db); db = MFMA32(*(const LAS bf16x8*)(arb + 64), bf1, db);
                        dk = MFMA32(*(const LAS bf16x8*)(ark), bf0, dk); dk = MFMA32(*(const LAS bf16x8*)(ark + 64), bf1, dk);
                        if (j == i) {
#pragma unroll
                            for (int r = 0; r < 4; ++r) { const int s = 16 * j + 4 * q + r; const bool keep = isR ? (s <= tloc) : (s < tloc); db[r] = keep ? db[r] : 0.f; dk[r] = keep ? dk[r] : 0.f; }
                            if (!isR) *(LAS f32x4*)(lds + LA_DIAG + ((i * 16 + c) * 16 + 4 * q) * 4) = db; } }

                    *(LAS bf16x4*)(ob + (tloc * TP + 16 * j + 4 * q) * 2) = pack4(db); *(LAS bf16x4*)(ok + (tloc * TP + 16 * j + 4 * q) * 2) = pack4(dk); } }
            __syncthreads();
            f32x4 X[4];
            if (w == 0) { const int blk = q, jc = c; float tc[16];
                f32x4 Lr[15][4];
#pragma unroll
                for (int t = 1; t < 16; ++t)
#pragma unroll
                    for (int s4 = 0; s4 < 4; ++s4) if (4 * s4 < t) Lr[t - 1][s4] = *(const LAS f32x4*)(lds + LA_DIAG + ((blk * 16 + t) * 16 + 4 * s4) * 4);
                __builtin_amdgcn_sched_barrier(0);
#pragma unroll
                for (int s = 0; s < 16; ++s) tc[s] = (s == jc) ? 1.f : 0.f;
#pragma unroll
                for (int t = 1; t < 16; ++t) { float val = 0.f;
#pragma unroll
                    for (int s4 = 0; s4 < 4; ++s4) if (4 * s4 < t) { const f32x4 L = Lr[t - 1][s4];
#pragma unroll
                        for (int e = 0; e < 4; ++e) if (4 * s4 + e < t) val += L[e] * tc[4 * s4 + e]; }
                    tc[t] += val; }
#pragma unroll
                for (int t = 0; t < 16; ++t) { *(LAS bf16_t*)(lds + LA_TII + ((blk * 16 + t) * 24 + jc) * 2) = f2bf(tc[t]); } }
            if (w < 4) {
#pragma unroll
                for (int i = 0; i < 4; ++i)
#pragma unroll
                    for (int r = 0; r < 4; ++r) X[i][r] = bf2f(*(const LAS bf16_t*)(lds + LA_AT + ((16 * i + 4 * q + r) * TP + 16 * w + c) * 2));
            } else { const int vb = w - 4; const LAS unsigned char* vrow = lds + LA_VT + ((16 * vb + c) * TP + 8 * q) * 2;
                const bf16x8 v0 = *(const LAS bf16x8*)(vrow), v1 = *(const LAS bf16x8*)(vrow + 64);
#pragma unroll
                for (int i = 0; i < 4; ++i) { const LAS unsigned char* arow = lds + LA_AAK + ((16 * i + c) * TP + 8 * q) * 2; f32x4 d = {0.f, 0.f, 0.f, 0.f};
                    d = MFMA32(*(const LAS bf16x8*)(arow), v0, d); d = MFMA32(*(const LAS bf16x8*)(arow + 64), v1, d); X[i] = d; } }

            __syncthreads();
            bf16x4 Xb[4];
            {   bf16x4 Af[6], Tf[4];
#pragma unroll
                for (int i = 1; i < 4; ++i)
#pragma unroll
                    for (int j = 0; j < 3; ++j) if (j < i) Af[(i * (i - 1)) / 2 + j] = *(const LAS bf16x4*)(lds + LA_AAB + ((16 * i + c) * TP + 16 * j + 4 * q) * 2);
#pragma unroll
                for (int i = 0; i < 4; ++i) Tf[i] = *(const LAS bf16x4*)(lds + LA_TII + ((i * 16 + c) * 24 + 4 * q) * 2);
                __builtin_amdgcn_sched_barrier(0);
#pragma unroll
                for (int i = 0; i < 4; ++i) { f32x4 y = X[i];
#pragma unroll
                    for (int j = 0; j < 3; ++j) if (j < i) y = MFMA16(Af[(i * (i - 1)) / 2 + j], Xb[j], y);
                    const f32x4 z = {0.f, 0.f, 0.f, 0.f};
                    X[i] = MFMA16(Tf[i], pack4(y), z); Xb[i] = pack4(X[i]); } }

            if (w < 4) {
                {   bf16x4 Bf[16]; float pcv[4];
#pragma unroll
                    for (int kb = 0; kb < 4; ++kb) { pcv[kb] = *(const LAS float*)(lds + LA_PC + (16 * kb + c) * 4);
#pragma unroll
                        for (int j = 0; j < 4; ++j) Bf[kb * 4 + j] = *(const LAS bf16x4*)(lds + LA_BTT + ((16 * kb + c) * TP + 16 * j + 4 * q) * 2); }
                    __builtin_amdgcn_sched_barrier(0);
#pragma unroll
                    for (int kb = 0; kb < 4; ++kb) { f32x4 d = {0.f, 0.f, 0.f, 0.f};
#pragma unroll
                        for (int j = 0; j < 4; ++j) d = MFMA16(Xb[j], Bf[kb * 4 + j], d);
                        const int ko = 16 * kb + c; const float pc = pcv[kb];
#pragma unroll
                        for (int r = 0; r < 4; ++r) d[r] = pc * (d[r] + ((16 * w + 4 * q + r) == ko ? 1.f : 0.f));

                        *(bf16x4*)(PHI + ((size_t)chid * 64 + ko) * 64 + 16 * w + 4 * q) = pack4(d); } }
                {   bf16x4 Rf[16]; u32x2 Rt[4];
#pragma unroll
                    for (int tb = 0; tb < 4; ++tb) { Rt[tb] = *(const LAS u32x2*)(lds + LA_RT + ((16 * tb + c) * TP + 16 * w + 4 * q) * 2);
#pragma unroll
                        for (int j = 0; j < 4; ++j) Rf[tb * 4 + j] = *(const LAS bf16x4*)(lds + LA_ARB + ((16 * tb + c) * TP + 16 * j + 4 * q) * 2); }
                    __builtin_amdgcn_sched_barrier(0);
#pragma unroll
                    for (int tb = 0; tb < 4; ++tb) { f32x4 d = unpack4(Rt[tb]);
#pragma unroll
                        for (int j = 0; j < 4; ++j) d = MFMA16(Xb[j], Rf[tb * 4 + j], d);
                        *(bf16x4*)(PSI + ((size_t)chid * 64 + 16 * tb + c) * 64 + 16 * w + 4 * q) = pack4(d); } }
            } else { const int vb = w - 4;
                bf16x4 Vb[4];
#pragma unroll
                for (int j = 0; j < 4; ++j) Vb[j] = *(const LAS bf16x4*)(lds + LA_VT + ((16 * vb + c) * TP + 16 * j + 4 * q) * 2);
                {   bf16x4 Bf[16], Kf[16]; f32x4 pcv[4];
#pragma unroll
                    for (int kb = 0; kb < 4; ++kb) { pcv[kb] = *(const LAS f32x4*)(lds + LA_PC + (16 * kb + 4 * q) * 4);
#pragma unroll
                        for (int j = 0; j < 4; ++j) { Bf[kb * 4 + j] = *(const LAS bf16x4*)(lds + LA_BTT + ((16 * kb + c) * TP + 16 * j + 4 * q) * 2); Kf[kb * 4 + j] = *(const LAS bf16x4*)(lds + LA_KTT + ((16 * kb + c) * TP + 16 * j + 4 * q) * 2); } }
                    __builtin_amdgcn_sched_barrier(0);
#pragma unroll
                    for (int kb = 0; kb < 4; ++kb) { f32x4 d = {0.f, 0.f, 0.f, 0.f};
#pragma unroll
                        for (int j = 0; j < 4; ++j) { d = MFMA16(Bf[kb * 4 + j], Xb[j], d); d = MFMA16(Kf[kb * 4 + j], Vb[j], d); }
                        *(bf16x4*)(GT + ((size_t)chid * 64 + 16 * vb + c) * 64 + 16 * kb + 4 * q) = pack4(d * pcv[kb]); } }
                {   bf16x4 Rf[16], Kf[16];
#pragma unroll
                    for (int tb = 0; tb < 4; ++tb)
#pragma unroll
                        for (int j = 0; j < 4; ++j) { Rf[tb * 4 + j] = *(const LAS bf16x4*)(lds + LA_ARB + ((16 * tb + c) * TP + 16 * j + 4 * q) * 2); Kf[tb * 4 + j] = *(const LAS bf16x4*)(lds + LA_ARK + ((16 * tb + c) * TP + 16 * j + 4 * q) * 2); }
                    __builtin_amdgcn_sched_barrier(0);
#pragma unroll
                    for (int tb = 0; tb < 4; ++tb) { f32x4 d = {0.f, 0.f, 0.f, 0.f};
#pragma unroll
                        for (int j = 0; j < 4; ++j) { d = MFMA16(Rf[tb * 4 + j], Xb[j], d); d = MFMA16(Kf[tb * 4 + j], Vb[j], d); }
                        *(bf16x4*)(Y0T + ((size_t)chid * 64 + 16 * vb + c) * 64 + 16 * tb + 4 * q) = pack4(d); } } }
            if (h < 7) WKVA_RAW_STORE(nraw);
            __syncthreads();
        }
    }
#undef WKVA_RAW_LOAD
#undef WKVA_RAW_STORE
}
__device__ __forceinline__ void phase_wkv_b(Frame& F, const Params& P) {
    const bf16_t* PHI = WSP(bf16_t, WS_PHI); const bf16_t* GT = WSP(bf16_t, WS_GT); bf16_t* MT = WSP(bf16_t, WS_MT);
    LAS unsigned char* lds = F.lds;
    const int lane = F.lane, c = lane & 15, q = lane >> 4, w = F.wave, tid = F.tid;
    const int pair = w >> 2, vb = w & 3; const int bh = (int)blockIdx.x * 2 + pair, b = bh >> 3, h = bh & 7;
    const int lrow = tid >> 3, lcol = (tid & 7) * 16;
    f32x4 M[4];
#pragma unroll
    for (int i = 0; i < 4; ++i) M[i] = (f32x4){0.f, 0.f, 0.f, 0.f};
    u32x4 rA[4], rB[4];
#define WKVB_LD(r_, ckk) do { const int ck_ = (ckk) < 32 ? (ckk) : 31; _Pragma("unroll") for (int ti = 0; ti < 4; ++ti) { const int bh_ = (int)blockIdx.x * 2 + (ti >> 1); \
        const size_t chl_ = (size_t)((bh_ >> 3) * 32 + ck_) * 8 + (bh_ & 7); r_[ti] = *(const u32x4*)(((ti & 1) ? GT : PHI) + chl_ * 4096 + (size_t)tid * 8); } } while (0)
#define WKVB_ST(r_, buf) do { _Pragma("unroll") for (int ti = 0; ti < 4; ++ti) *(LAS u32x4*)(lds + ((buf) * 4 + ti) * TILE_B + lrow * (TP * 2) + lcol) = r_[ti]; } while (0)
#define WKVB_STEP(buf, ckk) do { const size_t chs_ = (size_t)(b * 32 + (ckk)) * 8 + h; bf16x4 Mb[4]; \
        const LAS unsigned char* tp_ = lds + ((buf) * 4 + pair * 2) * TILE_B; const LAS unsigned char* tg_ = tp_ + TILE_B; \
        _Pragma("unroll") for (int i = 0; i < 4; ++i) { Mb[i] = pack4(M[i]); *(bf16x4*)(MT + (chs_ * 64 + 16 * vb + c) * 64 + 16 * i + 4 * q) = Mb[i]; } \
        _Pragma("unroll") for (int i = 0; i < 4; ++i) { f32x4 d = unpack4(*(const LAS u32x2*)(tg_ + (16 * vb + c) * (TP * 2) + (16 * i + 4 * q) * 2)); \
            _Pragma("unroll") for (int j = 0; j < 4; ++j) d = MFMA16(*(const LAS bf16x4*)(tp_ + (16 * i + c) * (TP * 2) + (16 * j + 4 * q) * 2), Mb[j], d); M[i] = d; } } while (0)
    WKVB_LD(rA, 0); WKVB_LD(rB, 1);
    __syncthreads();
    for (int ck = 0; ck < 32; ck += 2) {
        WKVB_ST(rA, 0); __syncthreads(); WKVB_LD(rA, ck + 2); WKVB_STEP(0, ck);
        WKVB_ST(rB, 1); __syncthreads(); WKVB_LD(rB, ck + 3); WKVB_STEP(1, ck + 1);
    }
    __syncthreads();
#undef WKVB_LD
#undef WKVB_ST
#undef WKVB_STEP
}
constexpr int LC_SGL = 0;
constexpr int LC_OT = 13312;
__device__ __forceinline__ void phase_wkv_c(Frame& F, const Params& P, int l) {
    LAS unsigned char* lds = F.lds;
    const bf16_t* rkv = WSP(bf16_t, WS_RKV);
    const bf16_t* gupT = WSP(bf16_t, WS_LORA) + (size_t)11 * 512 * 32 + (size_t)l * 512 * 96;
    const bf16_t* PSI = WSP(bf16_t, WS_PSI); const bf16_t* Y0T = WSP(bf16_t, WS_Y0T); const bf16_t* VT = WSP(bf16_t, WS_VT); const bf16_t* MT = WSP(bf16_t, WS_MT);
    const float* RK = WSP(float, WS_RK); unsigned char* outa = WSP(unsigned char, WS_OUTA);
    const float* mu = P.in[3] + (size_t)l * 1696;
    const int lane = F.lane, h = F.wave;
    LAS unsigned char* ot = lds + LC_OT + h * TILE_B;
    for (int unit = blockIdx.x; unit < T / 64; unit += F.G) {
        int lz = lane; asm volatile("" : "+v"(lz)); const int c = lz & 15, q = lz >> 4;
        float gng[4], gnb[4];
#pragma unroll
        for (int vb = 0; vb < 4; ++vb) { gng[vb] = P.in[15][(size_t)l * 512 + h * 64 + 16 * vb + c]; gnb[vb] = P.in[16][(size_t)l * 512 + h * 64 + 16 * vb + c]; }
        const int t0 = unit * 64; const bool firstchunk = (t0 & (SEQ - 1)) == 0; const size_t chid = (size_t)unit * 8 + h;
        __syncthreads();
        for (int idx = F.tid; idx < 64 * 96; idx += 512) { const int tok = idx / 96, qq = idx % 96; const int col = 1536 + 64 + qq; const int t = t0 + tok;
            const bool hp = (tok > 0 || !firstchunk); const float p = bf2f(rkv[(size_t)t * RKVW + col]); const float ppl = bf2f(rkv[(size_t)(hp ? t - 1 : t) * RKVW + col]); const float pp = hp ? ppl : 0.f;
            *(LAS bf16_t*)(lds + LC_SGL + (tok * 104 + qq) * 2) = f2bf(sigmoidf_(p + (pp - p) * mu[1536 + 64 + qq])); }
        __syncthreads();
        float rkv_[16];
#pragma unroll
        for (int i = 0; i < 16; ++i) rkv_[i] = RK[(size_t)(t0 + 16 * (i >> 2) + 4 * q + (i & 3)) * 8 + h];
        bf16x4 Mf[16];
#pragma unroll
        for (int j = 0; j < 4; ++j)
#pragma unroll
            for (int vb = 0; vb < 4; ++vb) Mf[j * 4 + vb] = *(const bf16x4*)(MT + (chid * 64 + 16 * vb + c) * 64 + 16 * j + 4 * q);
        bf16x8 Gf[12];
#pragma unroll
        for (int vb = 0; vb < 4; ++vb)
#pragma unroll
            for (int ks = 0; ks < 3; ++ks) Gf[vb * 3 + ks] = *(const bf16x8*)(gupT + (size_t)(h * 64 + 16 * vb + c) * 96 + 32 * ks + 8 * q);
#pragma unroll
        for (int tb = 0; tb < 4; ++tb) {
            bf16x4 Pf[4];
#pragma unroll
            for (int j = 0; j < 4; ++j) Pf[j] = *(const bf16x4*)(PSI + (chid * 64 + 16 * tb + c) * 64 + 16 * j + 4 * q);
            f32x4 y[4], gt[4], vv[4];
#pragma unroll
            for (int vb = 0; vb < 4; ++vb) { y[vb] = unpack4(*(const u32x2*)(Y0T + (chid * 64 + 16 * vb + c) * 64 + 16 * tb + 4 * q)); vv[vb] = unpack4(*(const u32x2*)(VT + (chid * 64 + 16 * vb + c) * 64 + 16 * tb + 4 * q));
#pragma unroll
                for (int j = 0; j < 4; ++j) y[vb] = MFMA16(Pf[j], Mf[j * 4 + vb], y[vb]); }
            {   const LAS unsigned char* ar = lds + LC_SGL + ((16 * tb + c) * 104 + 8 * q) * 2;
                const bf16x8 a0 = *(const LAS bf16x8*)(ar), a1 = *(const LAS bf16x8*)(ar + 64), a2 = *(const LAS bf16x8*)(ar + 128);
#pragma unroll
                for (int vb = 0; vb < 4; ++vb) { f32x4 d = {0.f, 0.f, 0.f, 0.f}; d = MFMA32(a0, Gf[vb * 3], d); d = MFMA32(a1, Gf[vb * 3 + 1], d); d = MFMA32(a2, Gf[vb * 3 + 2], d); gt[vb] = d; } }
#pragma unroll
            for (int r = 0; r < 4; ++r) { const int tl = 16 * tb + 4 * q + r;
                const float s = row16_sum((y[0][r] + y[1][r]) + (y[2][r] + y[3][r])); const float mean = s * (1.f / 64.f);
                const float d0 = y[0][r] - mean, d1 = y[1][r] - mean, d2 = y[2][r] - mean, d3 = y[3][r] - mean;
                const float var = row16_sum((d0 * d0 + d1 * d1) + (d2 * d2 + d3 * d3)) * (1.f / 64.f); const float rstd = rsqrtf(var + GN_EPS);
                const float rk = rkv_[tb * 4 + r];
                const float o0 = (d0 * rstd * gng[0] + gnb[0] + rk * vv[0][r]) * gt[0][r], o1 = (d1 * rstd * gng[1] + gnb[1] + rk * vv[1][r]) * gt[1][r];
                const float o2 = (d2 * rstd * gng[2] + gnb[2] + rk * vv[2][r]) * gt[2][r], o3 = (d3 * rstd * gng[3] + gnb[3] + rk * vv[3][r]) * gt[3][r];
                const unsigned pq = pack_fp8x4(4.f * o0, 4.f * o1, 4.f * o2, 4.f * o3);
                *(LAS unsigned char*)(ot + tl * 80 + c) = (unsigned char)pq; *(LAS unsigned char*)(ot + tl * 80 + 16 + c) = (unsigned char)(pq >> 8);
                *(LAS unsigned char*)(ot + tl * 80 + 32 + c) = (unsigned char)(pq >> 16); *(LAS unsigned char*)(ot + tl * 80 + 48 + c) = (unsigned char)(pq >> 24); }
        }
        asm volatile("s_waitcnt lgkmcnt(0)" ::: "memory");
        {   const LAS unsigned char* rowp = ot + lane * 80; unsigned char* dst = outa + (size_t)(t0 + lane) * 512 + h * 64;
#pragma unroll
            for (int m4 = 0; m4 < 4; ++m4) *(u32x4*)(dst + 16 * m4) = *(const LAS u32x4*)(rowp + 16 * m4); }
    }
    __syncthreads();
}
__device__ __forceinline__ void phase_sgu(Frame& F, const Params& P, int l, int wg0, int nwg) {
    LAS unsigned char* vt = F.lds;
    const bf16_t* z = WSP(bf16_t, WS_SGUZ); unsigned char* hb = WSP(unsigned char, WS_HB);
    const bf16_t* Wm = WSP(bf16_t, WS_SGUW) + (size_t)l * 4 * 128 * 128;
    const float* bs = P.in[21] + (size_t)l * 4 * 128;
    int u0 = __builtin_amdgcn_readfirstlane((int)blockIdx.x - wg0);
    for (int u = u0; u < T / 128; u += nwg) {
        int uu = u; asm volatile("" : "+v"(uu)); uu = __builtin_amdgcn_readfirstlane(uu);
        int lz = F.lane; asm volatile("" : "+v"(lz));
        const size_t t0 = (size_t)uu * 128;
        __syncthreads();
        {
            float lg[4], lb[4];
#pragma unroll
            for (int e = 0; e < 4; ++e) { lg[e] = P.in[18][(size_t)l * 256 + lz + 64 * e]; lb[e] = P.in[19][(size_t)l * 256 + lz + 64 * e]; }
            float vall[16][4];
#pragma unroll
            for (int i = 0; i < 16; ++i) { const bf16_t* zr = z + (t0 + F.wave * 16 + i) * 512 + 256 + lz;
#pragma unroll
                for (int e = 0; e < 4; ++e) vall[i][e] = bf2f(zr[64 * e]); }
#pragma unroll
            for (int i = 0; i < 16; ++i) { const int tok = F.wave * 16 + i;
                float v[4];
#pragma unroll
                for (int e = 0; e < 4; ++e) v[e] = vall[i][e];
                const float mean = wave_sum((v[0] + v[1]) + (v[2] + v[3])) * (1.f / 256.f);
#pragma unroll
                for (int e = 0; e < 4; ++e) v[e] -= mean;
                const float rstd = rsqrtf(wave_sum((v[0] * v[0] + v[1] * v[1]) + (v[2] * v[2] + v[3] * v[3])) * (1.f / 256.f) + LN_EPS);
#pragma unroll
                for (int e = 0; e < 4; ++e) { const int ch = lz + 64 * e; *(LAS bf16_t*)(vt + ch * 256 + ((((tok >> 3) ^ (ch & 15)) << 4) | ((tok & 7) << 1))) = f2bf(v[e] * rstd * lg[e] + lb[e]); } } }
        __syncthreads();
        {   const int c = lz & 15, qd = lz >> 4, g = F.wave >> 1, sel = F.wave & 1;
            const bf16_t* Wg = Wm + (size_t)g * 128 * 128;
            f32x4 acc[4][4];
#pragma unroll
            for (int pi = 0; pi < 4; ++pi)
#pragma unroll
                for (int db = 0; db < 4; ++db) acc[pi][db] = (f32x4){0.f, 0.f, 0.f, 0.f};
#pragma unroll
            for (int ks = 0; ks < 4; ++ks) {
                bf16x8 af[4];
#pragma unroll
                for (int db = 0; db < 4; ++db) { const int ch = 64 * g + 16 * db + c; af[db] = *(const LAS bf16x8*)(vt + ch * 256 + (((4 * ks + qd) ^ (ch & 15)) << 4)); }
#pragma unroll
                for (int pi = 0; pi < 4; ++pi) { const int pb = sel ? ((pi == 0) ? 1 : (pi == 1) ? 2 : (pi == 2) ? 5 : 6) : ((pi == 0) ? 0 : (pi == 1) ? 3 : (pi == 2) ? 4 : 7);
                    if (32 * ks <= 16 * pb + 15) { const bf16x8 bfr = *(const bf16x8*)(Wg + (size_t)(16 * pb + c) * 128 + 32 * ks + 8 * qd);
#pragma unroll
                        for (int db = 0; db < 4; ++db) acc[pi][db] = MFMA32(af[db], bfr, acc[pi][db]); } } }
            u32x2 uraw[4][4]; float biasv[4];
#pragma unroll
            for (int pi = 0; pi < 4; ++pi) { const int pb = sel ? ((pi == 0) ? 1 : (pi == 1) ? 2 : (pi == 2) ? 5 : 6) : ((pi == 0) ? 0 : (pi == 1) ? 3 : (pi == 2) ? 4 : 7);
                const int p = 16 * pb + c; biasv[pi] = bs[g * 128 + p];
#pragma unroll
                for (int db = 0; db < 4; ++db) uraw[pi][db] = *(const u32x2*)(z + (t0 + p) * 512 + 64 * g + 16 * db + 4 * qd); }
#pragma unroll
            for (int pi = 0; pi < 4; ++pi) { const int pb = sel ? ((pi == 0) ? 1 : (pi == 1) ? 2 : (pi == 2) ? 5 : 6) : ((pi == 0) ? 0 : (pi == 1) ? 3 : (pi == 2) ? 4 : 7);
                const size_t t = t0 + 16 * pb + c;
#pragma unroll
                for (int db = 0; db < 4; ++db) { const int ch = 64 * g + 16 * db + 4 * qd;
                    const f32x4 o = unpack4(uraw[pi][db]) * (acc[pi][db] + biasv[pi]) * 4.f; *(unsigned*)(hb + t * 256 + ch) = pack_fp8x4(o[0], o[1], o[2], o[3]); } } }
    }
    __syncthreads();
}
__device__ __forceinline__ void phase_conv(Frame& F, const Params& P, int l, int wg0, int nwg) {
    LAS float* cv = (LAS float*)F.lds;
    const bf16_t* hin = WSP(bf16_t, WS_CONVH); unsigned char* hc = WSP(unsigned char, WS_HC);
    const float* dw = P.in[23] + (size_t)l * 31 * 256; const float* db = P.in[24] + (size_t)l * 256;
    const float* lg = P.in[25] + (size_t)l * 256; const float* lb = P.in[26] + (size_t)l * 256;
    int u0 = __builtin_amdgcn_readfirstlane((int)blockIdx.x - wg0);
    for (int u = u0; u < T / 64; u += nwg) {
        int tz = F.tid; asm volatile("" : "+v"(tz)); const int ch = tz & 255, hf = tz >> 8, lz = tz & 63;
        float kw[31];
#pragma unroll
        for (int j = 0; j < 31; ++j) kw[j] = dw[j * 256 + ch];
        const float bias = db[ch];
        const int t0 = u * 64 + hf * 32; const int s0 = t0 & (SEQ - 1);
        __syncthreads();
        float x[38];
#pragma unroll
        for (int m = 0; m < 30; ++m) { const int s = s0 - 30 + m; const float ld = bf2f(hin[(size_t)(t0 - 30 + m + (s >= 0 ? 0 : 30)) * 256 + ch]); x[m] = (s >= 0) ? ld : 0.f; }
#pragma unroll
        for (int g8 = 0; g8 < 4; ++g8) {
#pragma unroll
            for (int m = 0; m < 8; ++m) x[30 + m] = bf2f(hin[(size_t)(t0 + 8 * g8 + m) * 256 + ch]);
#pragma unroll
            for (int i = 0; i < 8; ++i) { float a = bias;
#pragma unroll
                for (int j = 0; j < 31; ++j) a += kw[j] * x[i + j];
                cv[(hf * 32 + 8 * g8 + i) * 256 + ch] = a; }
#pragma unroll
            for (int m = 0; m < 30; ++m) x[m] = x[m + 8]; }
        __syncthreads();
        {   const f32x4 g = *(const f32x4*)(lg + lz * 4), bb = *(const f32x4*)(lb + lz * 4);
            for (int i = 0; i < 8; ++i) { const int tok = F.wave * 8 + i; f32x4 v = *(const LAS f32x4*)(cv + tok * 256 + lz * 4);
                const float mean = wave_sum((v[0] + v[1]) + (v[2] + v[3])) * (1.f / 256.f);
                v = v - mean; const float var = wave_sum((v[0] * v[0] + v[1] * v[1]) + (v[2] * v[2] + v[3] * v[3])) * (1.f / 256.f);
                const float rstd = rsqrtf(var + LN_EPS);
                v = v * rstd * g + bb;
                float o[4];
#pragma unroll
                for (int j = 0; j < 4; ++j) o[j] = v[j] * sigmoidf_(v[j]);
                *(unsigned*)(hc + (size_t)(u * 64 + tok) * 256 + lz * 4) = pack_fp8x4(4.f * o[0], 4.f * o[1], 4.f * o[2], 4.f * o[3]); } }
    }
    __syncthreads();
}
__device__ __forceinline__ void ln_load16(const bf16_t* p, float (&v)[16]) {
    const u32x4 a = *(const u32x4*)p, b = *(const u32x4*)(p + 8);
    v[0] = bflo(a.x); v[1] = bfhi(a.x); v[2] = bflo(a.y); v[3] = bfhi(a.y); v[4] = bflo(a.z); v[5] = bfhi(a.z); v[6] = bflo(a.w); v[7] = bfhi(a.w);
    v[8] = bflo(b.x); v[9] = bfhi(b.x); v[10] = bflo(b.y); v[11] = bfhi(b.y); v[12] = bflo(b.z); v[13] = bfhi(b.z); v[14] = bflo(b.w); v[15] = bfhi(b.w);
}
__device__ __forceinline__ void ln_norm16(float (&v)[16], const float* g, const float* b, int lane) {
    float s = 0.f;
#pragma unroll
    for (int j = 0; j < 16; ++j) s += v[j];
    const float mean = wave_sum(s) * (1.f / 1024.f); float q = 0.f;
#pragma unroll
    for (int j = 0; j < 16; ++j) { v[j] -= mean; q += v[j] * v[j]; }
    const float rstd = rsqrtf(wave_sum(q) * (1.f / 1024.f) + LN_EPS);
#pragma unroll
    for (int j4 = 0; j4 < 4; ++j4) { const f32x4 gg = *(const f32x4*)(g + lane * 16 + j4 * 4), bb = *(const f32x4*)(b + lane * 16 + j4 * 4);
#pragma unroll
        for (int j = 0; j < 4; ++j) v[j4 * 4 + j] = v[j4 * 4 + j] * rstd * gg[j] + bb[j]; }
}
__device__ __forceinline__ void ln_store16(bf16_t* p, const float (&v)[16]) {
    u32x4 a, b; a.x = cvt_pk_bf16(v[0], v[1]); a.y = cvt_pk_bf16(v[2], v[3]); a.z = cvt_pk_bf16(v[4], v[5]); a.w = cvt_pk_bf16(v[6], v[7]);
    b.x = cvt_pk_bf16(v[8], v[9]); b.y = cvt_pk_bf16(v[10], v[11]); b.z = cvt_pk_bf16(v[12], v[13]); b.w = cvt_pk_bf16(v[14], v[15]);
    *(u32x4*)p = a; *(u32x4*)(p + 8) = b;
}
__device__ __forceinline__ void ln_load16q(const unsigned char* p, float (&v)[16]) {
    const u32x4 a = *(const u32x4*)p; const unsigned w[4] = {a.x, a.y, a.z, a.w};
#pragma unroll
    for (int i = 0; i < 4; ++i) { const f32x2 lo = __builtin_amdgcn_cvt_pk_f32_fp8((int)w[i], false), hi = __builtin_amdgcn_cvt_pk_f32_fp8((int)w[i], true); v[4 * i] = lo[0]; v[4 * i + 1] = lo[1]; v[4 * i + 2] = hi[0]; v[4 * i + 3] = hi[1]; }
}
__device__ __forceinline__ void ln_store16q(unsigned char* p, const float (&v)[16]) {
    u32x4 a; a.x = pack_fp8x4(v[0], v[1], v[2], v[3]); a.y = pack_fp8x4(v[4], v[5], v[6], v[7]); a.z = pack_fp8x4(v[8], v[9], v[10], v[11]); a.w = pack_fp8x4(v[12], v[13], v[14], v[15]);
    *(u32x4*)p = a;
}
__device__ __forceinline__ void phase_ln1(Frame& F, const Params& P, int l, int wg0, int nwg, int row_lo, int row_hi) {
    const bf16_t* pre = WSP(bf16_t, WS_PRE); const float* stats = WSP(float, WS_STATS);
    const float* g = P.in[29] + (size_t)l * 1024; const float* b = P.in[30] + (size_t)l * 1024;
    const int gw = ((int)blockIdx.x - wg0) * 8 + F.wave, NGW = nwg * 8;
    float gg[16], bb[16];
#pragma unroll
    for (int j4 = 0; j4 < 4; ++j4) { const f32x4 g4 = *(const f32x4*)(g + F.lane * 16 + j4 * 4), b4 = *(const f32x4*)(b + F.lane * 16 + j4 * 4);
#pragma unroll
        for (int j = 0; j < 4; ++j) { gg[j4 * 4 + j] = g4[j]; bb[j4 * 4 + j] = b4[j]; } }
    for (int row = row_lo + gw; row < row_hi; row += NGW) { float v[16]; ln_load16(pre + (size_t)row * 1024 + F.lane * 16, v);
        const f32x2 sl = *(const f32x2*)(stats + ((size_t)row * 16 + (F.lane & 15)) * 2);
        const float mean = row16_sum(sl[0]) * (1.f / 1024.f), ex2 = row16_sum(sl[1]) * (1.f / 1024.f);
        const float rstd = rsqrtf(fmaxf(ex2 - mean * mean, 0.f) + LN_EPS);
#pragma unroll
        for (int j = 0; j < 16; ++j) v[j] = (v[j] - mean) * rstd * gg[j] + bb[j];
        ln_store16q(WSP(unsigned char, WS_X1Q) + (size_t)row * 1024 + F.lane * 16, v); }
}
__device__ __forceinline__ void phase_ln2(Frame& F, const Params& P, int l) {
    const bf16_t* pre = WSP(bf16_t, WS_PRE); const float* stats = WSP(float, WS_STATS); const unsigned char* Y = WSP(unsigned char, WS_Y); bf16_t* x = WSP(bf16_t, WS_X); const int* inv = WSP(int, WS_GATEV);
    const float* g = P.in[36] + (size_t)l * 1024; const float* b = P.in[37] + (size_t)l * 1024; const float* g1 = P.in[29] + (size_t)l * 1024; const float* b1 = P.in[30] + (size_t)l * 1024;
    const int gw = blockIdx.x * 8 + F.wave, NGW = F.G * 8;
    float g1v[16], b1v[16], gv[16], bv[16];
#pragma unroll
    for (int j4 = 0; j4 < 4; ++j4) { const f32x4 a4 = *(const f32x4*)(g1 + F.lane * 16 + j4 * 4), c4 = *(const f32x4*)(b1 + F.lane * 16 + j4 * 4), d4 = *(const f32x4*)(g + F.lane * 16 + j4 * 4), e4 = *(const f32x4*)(b + F.lane * 16 + j4 * 4);
#pragma unroll
        for (int j = 0; j < 4; ++j) { g1v[j4 * 4 + j] = a4[j]; b1v[j4 * 4 + j] = c4[j]; gv[j4 * 4 + j] = d4[j]; bv[j4 * 4 + j] = e4[j]; } }
    int n0 = inv[2 * gw], n1 = inv[2 * gw + 1];
#pragma unroll 1
    for (int row = gw; row < T; row += NGW) { float v[16], y0[16], y1[16];
        const int c0 = __builtin_amdgcn_readfirstlane(n0), c1 = __builtin_amdgcn_readfirstlane(n1);
        { const int rn = (row + NGW < T) ? row + NGW : row; n0 = inv[2 * rn]; n1 = inv[2 * rn + 1]; }
        ln_load16(pre + (size_t)row * 1024 + F.lane * 16, v); ln_load16q(Y + (size_t)c0 * 1024 + F.lane * 16, y0); ln_load16q(Y + (size_t)c1 * 1024 + F.lane * 16, y1);
        {   const f32x2 sl = *(const f32x2*)(stats + ((size_t)row * 16 + (F.lane & 15)) * 2);
            const float mean = row16_sum(sl[0]) * (1.f / 1024.f), ex2 = row16_sum(sl[1]) * (1.f / 1024.f); const float rstd = rsqrtf(fmaxf(ex2 - mean * mean, 0.f) + LN_EPS);
#pragma unroll
            for (int j = 0; j < 16; ++j) v[j] = (v[j] - mean) * rstd * g1v[j] + b1v[j]; }
#pragma unroll
        for (int j = 0; j < 16; ++j) v[j] = ALPHA * v[j] + 0.125f * (y0[j] + y1[j]);
        {   float s = 0.f;
#pragma unroll
            for (int j = 0; j < 16; ++j) s += v[j];
            const float mean = wave_sum(s) * (1.f / 1024.f); float qq = 0.f;
#pragma unroll
            for (int j = 0; j < 16; ++j) { v[j] -= mean; qq += v[j] * v[j]; }
            const float rstd = rsqrtf(wave_sum(qq) * (1.f / 1024.f) + LN_EPS);
#pragma unroll
            for (int j = 0; j < 16; ++j) v[j] = v[j] * rstd * gv[j] + bv[j]; }
        if (l == NL - 1) { float* o = F.out + (size_t)row * 1024 + F.lane * 16;
#pragma unroll
            for (int j4 = 0; j4 < 4; ++j4) *(f32x4*)(o + j4 * 4) = (f32x4){v[j4 * 4], v[j4 * 4 + 1], v[j4 * 4 + 2], v[j4 * 4 + 3]}; }
        else { ln_store16(x + (size_t)row * 1024 + F.lane * 16, v); ln_store16q(WSP(unsigned char, WS_XQ) + (size_t)row * 1024 + F.lane * 16, v); } }
}

#define PHASE_PROLOGUE() const Params P = KPARAMS(); Frame F = make_frame(P.ws, P.out); unsigned* ctl = (unsigned*)(F.ws + WS_CTL); (void)ctl
__device__ __forceinline__ void ph_prologue() { PHASE_PROLOGUE(); phase_convert_static(F, P); phase_convert_lora(F, P); phase_convert_sgu(F, P); phase_convert_router(F, P); phase_x_to_bf16(F, P); phase_convert_moe(F, P, 0); __syncthreads(); }
__device__ __forceinline__ void ph_inproj(int l) { PHASE_PROLOGUE();
    SchedInproj S{(const char*)WSP(unsigned char, WS_XQ), (const char*)(WSP(unsigned char, WS_WIN) + (size_t)l * NIN * 1024), F.G, (int)blockIdx.x};
    EpiInproj E{WSP(bf16_t, WS_RKV), WSP(bf16_t, WS_SGUZ), WSP(bf16_t, WS_CONVH), WSP(unsigned char, WS_GATES)};
    ge::gemm_phase<SchedInproj, EpiInproj, true>(F.lds, S, E); }
__device__ __forceinline__ void ph_wkva(int l) { PHASE_PROLOGUE(); phase_wkv_a<false>(F, P, l); }
__device__ __forceinline__ void ph_cvtmoe(int l) { PHASE_PROLOGUE(); phase_convert_moe(F, P, l); __syncthreads(); }
__device__ __forceinline__ void ph_wkvb() { PHASE_PROLOGUE(); phase_wkv_b(F, P); }
__device__ __forceinline__ void ph_wkvc(int l) { PHASE_PROLOGUE(); phase_wkv_c(F, P, l); }
__device__ __forceinline__ void ph_sguconv(int l) { PHASE_PROLOGUE();
    phase_sgu(F, P, l, 64, 192); phase_conv(F, P, l, 64, 192); }
__device__ __forceinline__ void ph_branch(int l) { PHASE_PROLOGUE();
    SchedBranch S{(const char*)F.ws, WS_WBR + (size_t)l * 1024 * 1024, F.G, F.vcu};
    EpiBranch E{WSP(unsigned char, WS_GATES), WSP(bf16_t, WS_MERGED), WSP(unsigned char, WS_MERGEDQ)};
    ge::gemm_phase<SchedBranch, EpiBranch, true, 0x7A7A7A7A, 0x7D7D7D7D>(F.lds, S, E); }
__device__ __forceinline__ void ph_wout(int l) { PHASE_PROLOGUE();
    SchedWout S{(const char*)WSP(unsigned char, WS_MERGEDQ), (const char*)(WSP(unsigned char, WS_WOUT) + (size_t)l * 1024 * 1024), F.G, F.vcu};
    EpiWout E{WSP(bf16_t, WS_X), WSP(bf16_t, WS_PRE), WSP(float, WS_STATS)};
    ge::gemm_phase<SchedWout, EpiWout, true, 0x7A7A7A7A, 0x7D7D7D7D>(F.lds, S, E); }
constexpr int LN1_SPLIT = 6144;
__device__ __forceinline__ void ph_ln1(int l) { PHASE_PROLOGUE(); if (blockIdx.x < 128) phase_ln1(F, P, l, 0, 128, 0, LN1_SPLIT); else phase_ln1(F, P, l, 128, 128, LN1_SPLIT, T); }
__device__ __forceinline__ void ph_router(int l) { PHASE_PROLOGUE();
    SchedRouter S{(const char*)WSP(bf16_t, WS_PRE), (const char*)(WSP(bf16_t, WS_WRG) + (size_t)l * 256 * 1024), 128, (int)blockIdx.x};
    EpiRouter E{P.in[32], ctl + CW_CNT + 64 * l, WSP(int, WS_LIST), WSP(float, WS_STATS), WSP(float, WS_RC) + l * 64};
    ge::gemm_phase(F.lds, S, E); }
__device__ __forceinline__ void ph_moe1(int l) { PHASE_PROLOGUE();
    const int ntiles = build_tile_table(F, ctl + CW_CNT + 64 * l);
    SchedMoe1 S{(const char*)WSP(unsigned char, WS_X1Q), (const char*)moe_wbuf(F, l), WSP(int, WS_LIST), ctl + CW_CNT + 64 * l, (LAS int*)(F.lds + LDS_MISC + 64), ntiles, F.G, F.vcu};
    EpiMoe1 E{WSP(unsigned char, WS_H)};
    ge::gemm_phase<SchedMoe1, EpiMoe1, true>(F.lds, S, E); }
__device__ __forceinline__ void ph_moe2(int l) { PHASE_PROLOGUE(); int ntk4 = 4; asm volatile("" : "+s"(ntk4));
    const int ntiles = build_tile_table(F, ctl + CW_CNT + 64 * l);
    SchedMoe2 S{(const char*)WSP(unsigned char, WS_H), (const char*)(moe_wbuf(F, l) + (size_t)NE * 1024 * 1024), WSP(int, WS_LIST), ctl + CW_CNT + 64 * l, (LAS int*)(F.lds + LDS_MISC + 64), ntiles, F.G, F.vcu, ntk4};
    EpiMoe2 E{WSP(int, WS_LIST), WSP(unsigned char, WS_Y), WSP(int, WS_GATEV)};
    ge::gemm_phase<SchedMoe2, EpiMoe2, true>(F.lds, S, E); }
__device__ __forceinline__ void ph_ln2(int l) { PHASE_PROLOGUE(); phase_ln2(F, P, l); }

constexpr int PH_PER_LAYER = 11, N_PHASES = 1 + NL * PH_PER_LAYER;
__global__ void __launch_bounds__(512, 2) fwd_kernel(Params p) {
    for (int u = threadIdx.x; u < (LDS_BYTES - LDS_MISC) / 4; u += 512) ((LAS unsigned*)((LAS unsigned char*)lds_raw + LDS_MISC))[u] = 0u;
    __syncthreads();
#if ONE_LAUNCH
    XcdBarrier bar = xcd_barrier_post((unsigned*)(p.ws + WS_CTL) + CW_BAR, (volatile LAS unsigned*)((LAS unsigned char*)lds_raw + LDS_MISC));
#define SEAM() xcd_barrier(bar)
#else
#define SEAM() do { } while (0)
#endif
    const int lo = p.phase_lo, hi = p.phase_hi;
#ifdef ONLY_K
#define IN(k) ((k) == ONLY_K && lo <= pb + (k) && pb + (k) < hi)
#else
#define IN(k) (lo <= pb + (k) && pb + (k) < hi)
#endif
#ifndef ONLY_K
    { const int pb = 0; if (IN(0)) { ph_prologue(); SEAM(); } }
#endif
#define RUN_LAYER(l) do { const int pb = 1 + (l) * PH_PER_LAYER;\
        if (IN(0)) { ph_inproj(l); SEAM(); }\
        if (IN(1)) { ph_wkva(l); SEAM(); }\
        if (IN(2)) { if (blockIdx.x < 64) ph_wkvb(); else ph_sguconv(l); if ((l) + 1 < NL) ph_cvtmoe((l) + 1); SEAM(); }\
        if (IN(3)) { ph_wkvc(l); SEAM(); }\
        if (IN(4)) { ph_branch(l); SEAM(); }\
        if (IN(5)) { ph_wout(l); SEAM(); }\
        if (IN(6)) { if (blockIdx.x < 128) ph_router(l); ph_ln1(l); SEAM(); }\
        if (IN(8)) { ph_moe1(l); SEAM(); }\
        if (IN(9)) { ph_moe2(l); SEAM(); }\
        if (IN(10)) { ph_ln2(l); if (l + 1 < NL) SEAM(); } } while (0)
    RUN_LAYER(0); RUN_LAYER(1); RUN_LAYER(2); RUN_LAYER(3);
#undef RUN_LAYER
#undef IN
#undef SEAM
}

extern "C" void kernel_launch(void* const* d_in, const int* in_sizes, int n_in, void* d_out, int out_size, void* d_ws, size_t ws_size, hipStream_t stream) {
    static int grid = 0;
    if (grid == 0) {
        if (n_in != 38 || in_sizes[0] != T * D || out_size != T * D || ws_size < WS_END) { fprintf(stderr, "kernel_launch: unexpected shapes (n_in %d, in0 %d, out %d, ws %zu, need %zu); nothing launched\n", n_in, n_in > 0 ? in_sizes[0] : -1, out_size, ws_size, (size_t)WS_END); grid = -1; return; }
        int dev = 0, cus = 0, per_cu = 0;
        if (hipGetDevice(&dev) != hipSuccess || hipDeviceGetAttribute(&cus, hipDeviceAttributeMultiprocessorCount, dev) != hipSuccess) { grid = -1; return; }
        if (hipFuncSetAttribute((const void*)fwd_kernel, hipFuncAttributeMaxDynamicSharedMemorySize, LDS_BYTES) != hipSuccess) { fprintf(stderr, "kernel_launch: hipFuncSetAttribute failed\n"); grid = -1; return; }
        if (hipOccupancyMaxActiveBlocksPerMultiprocessor(&per_cu, (const void*)fwd_kernel, 512, LDS_BYTES) != hipSuccess || per_cu < 1) fprintf(stderr, "kernel_launch: occupancy query reports %d blocks per CU\n", per_cu);
        (void)hipGetLastError();
        grid = cus;
        if (grid != 256) { fprintf(stderr, "kernel_launch: built for a 256-CU device, found %d CUs; nothing launched\n", cus); grid = -1; return; }
    }
    if (grid < 0) return;
    (void)hipMemsetAsync((char*)d_ws + WS_CTL, 0, CTL_BYTES, stream);
    Params p{};
    for (int i = 0; i < 38; ++i) p.in[i] = (const float*)d_in[i];
    p.out = (float*)d_out; p.ws = (unsigned char*)d_ws; p.layer_lo = 0; p.layer_hi = NL;
#if ONE_LAUNCH
    p.phase_lo = 0; p.phase_hi = N_PHASES;
    hipLaunchKernelGGL(fwd_kernel, dim3(grid), dim3(512), LDS_BYTES, stream, p);
#else
    for (int ph = 0; ph < N_PHASES; ++ph) { p.phase_lo = ph; p.phase_hi = ph + 1; hipLaunchKernelGGL(fwd_kernel, dim3(grid), dim3(512), LDS_BYTES, stream, p); }
#endif
}
```

```cpp
#include <hip/hip_runtime.h>
#include <stdint.h>
#include <stdio.h>

#ifndef ONE_LAUNCH
#define ONE_LAUNCH 1
#endif

#define LAS __attribute__((address_space(3)))
typedef unsigned short bf16_t;
typedef short bf16x8 __attribute__((ext_vector_type(8)));
typedef float f32x4 __attribute__((ext_vector_type(4)));
typedef float f32x2 __attribute__((ext_vector_type(2)));
typedef unsigned u32x4 __attribute__((ext_vector_type(4)));
typedef unsigned u32x2 __attribute__((ext_vector_type(2)));

constexpr int T = 32768, SEQ = 2048, D = 1024, NL = 4;
constexpr int NIN = 5888;
constexpr int RKVW = 1792;
constexpr int NE = 32;
constexpr float ALPHA = 1.681792830507429f;
constexpr float LN_EPS = 1e-5f, GN_EPS = 64e-5f;

constexpr size_t MiB = 1u << 20;
constexpr size_t WS_CTL = 0;
constexpr size_t WS_WIN = 1 * MiB;
constexpr size_t WS_WBR = WS_WIN + 46 * MiB;
constexpr size_t WS_WOUT = WS_WBR + 8 * MiB;
constexpr size_t WS_WRT = WS_WOUT + 8 * MiB;
constexpr size_t WS_WMOE = WS_WRT + 1 * MiB;
constexpr size_t WS_X = WS_WMOE + 96 * MiB;
constexpr size_t WS_X1 = WS_X + 64 * MiB;
constexpr size_t WS_VFIRST = WS_X1 + 64 * MiB;
constexpr size_t WS_RKV = WS_VFIRST + 32 * MiB;
constexpr size_t WS_SGUZ = WS_RKV + 112 * MiB;
constexpr size_t WS_CONVH = WS_SGUZ + 32 * MiB;
constexpr size_t WS_GATES = WS_CONVH + 16 * MiB;
constexpr size_t WS_PHI = WS_GATES + 192 * MiB;
constexpr size_t WS_PSI = WS_PHI + 32 * MiB;
constexpr size_t WS_GT = WS_PSI + 32 * MiB;
constexpr size_t WS_Y0T = WS_GT + 32 * MiB;
constexpr size_t WS_VT = WS_Y0T + 32 * MiB;
constexpr size_t WS_MT = WS_VT + 32 * MiB;
constexpr size_t WS_RK = WS_MT + 32 * MiB;
constexpr size_t WS_LORA = WS_RK + 1 * MiB;
constexpr size_t WS_SGUW = WS_LORA + 1 * MiB;
constexpr size_t WS_OUTA = WS_SGUW + 1 * MiB;
constexpr size_t WS_HB = WS_OUTA + 32 * MiB;
constexpr size_t WS_HC = WS_HB + 16 * MiB;
constexpr size_t WS_XQ = WS_HC + 16 * MiB;
constexpr size_t WS_END = WS_XQ + 32 * MiB;
constexpr size_t WS_X1Q = WS_WMOE + 64 * MiB;
constexpr size_t WS_STATS = WS_Y0T;
constexpr size_t WS_WRG = WS_WBR + 4 * MiB;
constexpr size_t WS_RC = WS_SGUW + 512 * 1024;
constexpr size_t WS_WKVPAR = WS_SGUW + 768 * 1024;
constexpr size_t WS_MERGEDQ = WS_GT;
constexpr size_t WS_MERGED = WS_RKV;
constexpr size_t WS_PRE = WS_PHI;
constexpr size_t WS_H = WS_RKV;
constexpr size_t WS_Y = WS_GATES;
constexpr size_t WS_LIST = WS_SGUZ;
constexpr size_t WS_GATEV = WS_SGUZ + 16 * MiB;
static_assert(WS_END <= 1024 * MiB, "workspace map");
constexpr int CW_BAR = 4096;
constexpr int CW_CNT = 16384;
constexpr size_t CTL_BYTES = 1 * MiB;

constexpr int LDS_STAGE = 131072;
constexpr int LDS_MISC = LDS_STAGE;
constexpr int LDS_RAW = LDS_STAGE + 4096;
constexpr int LDS_BYTES = 163840;

typedef __bf16 bf16x2_t __attribute__((ext_vector_type(2)));
__device__ __forceinline__ unsigned cvt_pk_bf16(float lo, float hi) { const f32x2 v = {lo, hi}; const bf16x2_t b = __builtin_convertvector(v, bf16x2_t); return __builtin_bit_cast(unsigned, b); }
__device__ __forceinline__ unsigned pack_fp8x4(float a, float b, float c, float d) { int w = 0; w = __builtin_amdgcn_cvt_pk_fp8_f32(a, b, w, false); w = __builtin_amdgcn_cvt_pk_fp8_f32(c, d, w, true); return (unsigned)w; }
__device__ __forceinline__ bf16_t f2bf(float f) { return (bf16_t)(cvt_pk_bf16(f, 0.f) & 0xffffu); }
__device__ __forceinline__ float bf2f(unsigned short b) { return __uint_as_float(((unsigned)b) << 16); }
__device__ __forceinline__ float bflo(unsigned w) { return __uint_as_float(w << 16); }
__device__ __forceinline__ float bfhi(unsigned w) { return __uint_as_float(w & 0xffff0000u); }
__device__ __forceinline__ float sigmoidf_(float x) { return __builtin_amdgcn_rcpf(1.0f + __expf(-x)); }
template <int CTRL> __device__ __forceinline__ float dpp_mov(float x) { return __builtin_bit_cast(float, __builtin_amdgcn_mov_dpp(__builtin_bit_cast(int, x), CTRL, 0xF, 0xF, true)); }
__device__ __forceinline__ float row16_sum(float v) { v += dpp_mov<0xB1>(v); v += dpp_mov<0x4E>(v); v += dpp_mov<0x141>(v); v += dpp_mov<0x140>(v); return v; }
__device__ __forceinline__ float wave_sum(float v) {
    v = row16_sum(v); const int vi = __builtin_bit_cast(int, v);
    return (__builtin_bit_cast(float, __builtin_amdgcn_readlane(vi, 0)) + __builtin_bit_cast(float, __builtin_amdgcn_readlane(vi, 16))) + (__builtin_bit_cast(float, __builtin_amdgcn_readlane(vi, 32)) + __builtin_bit_cast(float, __builtin_amdgcn_readlane(vi, 48)));
}
__device__ __forceinline__ float dpp_f(float x, const int ctrl_sel) {
    int xi = __builtin_bit_cast(int, x), r;
    if (ctrl_sel == 0) r = __builtin_amdgcn_update_dpp(0, xi, 0xB1, 0xF, 0xF, true);
    else if (ctrl_sel == 1) r = __builtin_amdgcn_update_dpp(0, xi, 0x4E, 0xF, 0xF, true);
    else r = __builtin_amdgcn_update_dpp(0, xi, 0x141, 0xF, 0xF, true);
    return __builtin_bit_cast(float, r);
}
__device__ __forceinline__ float reduce8(float x) { x += dpp_f(x, 0); x += dpp_f(x, 1); x += dpp_f(x, 2); return x; }
__device__ __forceinline__ float gelu_f(float v) {
    const float av = fabsf(v), t = __builtin_amdgcn_rcpf(av * 0.2316418882f + 1.0f);
    float q = t * 0.5307027145f + (-0.7265760135f); q = q * t + 0.7107068705f; q = q * t + (-0.142248368f); q = q * t + 0.127414796f; q = q * t;
    const float e = __builtin_amdgcn_exp2f((v * v) * (-0.72134752044f));
    const float m = v * (q * e);
    return v < 0.f ? m : v - m;
}

#define XB_TMO      128
#define XB_XCNT(j)  (256  + 64 * (j))
#define XB_XSUB(j)  (1280 + 64 * (j))
#define XB_XGEN(j)  (2304 + 64 * (j))
#define XB_TOP      3328
#define XB_TOPGEN   3392
#define XCD_BAR_WORDS 3456
#define XB_SPIN_CAP (1u << 22)
__device__ __forceinline__ unsigned xb_ld(unsigned* p)              { return __hip_atomic_load(p, __ATOMIC_RELAXED, __HIP_MEMORY_SCOPE_AGENT); }
__device__ __forceinline__ unsigned xb_add(unsigned* p, unsigned v) { return __hip_atomic_fetch_add(p, v, __ATOMIC_RELAXED, __HIP_MEMORY_SCOPE_AGENT); }
__device__ __forceinline__ unsigned xb_xcc_id() { return (unsigned)__builtin_amdgcn_s_getreg((3 << 11) | 20) & 0xFu; }
#define XB_SPIN(cond, bar) do { unsigned _sp = 0; while (cond) { __builtin_amdgcn_s_sleep(1); \
    if ((++_sp & 255u) == 0u) { if (xb_ld(&(bar)[XB_TMO])) break; if (_sp > XB_SPIN_CAP) { atomicAdd(&(bar)[XB_TMO], 1u); break; } } } } while (0)
struct XcdBarrier { unsigned* bar; unsigned x; volatile LAS unsigned* st; };
__device__ __forceinline__ XcdBarrier xcd_barrier_post(unsigned* bar, volatile LAS unsigned* st) {
    XcdBarrier b; b.bar = bar; b.x = xb_xcc_id(); b.st = st;
    if (threadIdx.x == 0) (void)xb_add(&bar[XB_XCNT(b.x)], 1u);
    return b;
}
__device__ __forceinline__ void xcd_barrier_complete(unsigned* bar, unsigned x, unsigned& nloc, unsigned& nx) {
    const unsigned G = gridDim.x * gridDim.y * gridDim.z;
    unsigned sum, cnt, mine, sp = 0u;
    for (;;) {
        sum = 0u; cnt = 0u; mine = 0u;
#pragma unroll
        for (unsigned j = 0; j < 16; ++j) { const unsigned c = xb_ld(&bar[XB_XCNT(j)]); sum += c; cnt += (c > 0u) ? 1u : 0u; mine = (j == x) ? c : mine; }
        if (sum == G) break;
        __builtin_amdgcn_s_sleep(1);
        if ((++sp & 255u) == 0u) { if (xb_ld(&bar[XB_TMO])) break; if (sp > XB_SPIN_CAP) { atomicAdd(&bar[XB_TMO], 1u); break; } }
    }
    nloc = mine > 0u ? mine : 1u; nx = cnt > 0u ? cnt : 1u;
}
template <class Fill> __device__ __forceinline__ void xcd_barrier(const XcdBarrier& b, const Fill& fill) {
    asm volatile("s_waitcnt vmcnt(0)" ::: "memory");
    __syncthreads();
    if (threadIdx.x >= 64) fill();
    if (threadIdx.x == 0) {
        unsigned* bar = b.bar;
        __builtin_amdgcn_s_waitcnt(0);
        unsigned nloc = b.st[0], nx = b.st[1];
        if (nloc == 0u) { xcd_barrier_complete(bar, b.x, nloc, nx); b.st[0] = nloc; b.st[1] = nx; }
        const unsigned old = xb_add(&bar[XB_XSUB(b.x)], 1u);
        const unsigned gen = old / nloc;
        if (old + 1u == (gen + 1u) * nloc) {
            __builtin_amdgcn_fence(__ATOMIC_RELEASE, "agent");
            asm volatile("s_waitcnt vmcnt(0)" ::: "memory");
            const unsigned og = xb_add(&bar[XB_TOP], 1u);
            const unsigned tg = og / nx;
            if (og + 1u == (tg + 1u) * nx) xb_add(&bar[XB_TOPGEN], 1u);
            else XB_SPIN(xb_ld(&bar[XB_TOPGEN]) == tg, bar);
            __builtin_amdgcn_fence(__ATOMIC_ACQUIRE, "agent");
            xb_add(&bar[XB_XGEN(b.x)], 1u);
            asm volatile("s_waitcnt vmcnt(0)" ::: "memory");
        } else {
            XB_SPIN(xb_ld(&bar[XB_XGEN(b.x)]) == gen, bar);
            __builtin_amdgcn_fence(__ATOMIC_ACQUIRE, "agent");
            asm volatile("s_waitcnt vmcnt(0)" ::: "memory");
        }
    }
    __syncthreads();
}

struct Params {
    const float* in[38];
    float* out;
    unsigned char* ws;
    int phase_lo, phase_hi;
    int layer_lo, layer_hi;
};

namespace ge {
constexpr int BM = 256, BK = 64, HALF = 128, HTB = HALF * BK * 2;
constexpr int GE_GIDX = LDS_MISC + 2048;
__device__ __forceinline__ int lds_byte(int r, int c) { const int st = (r >> 4) * 2 + (c >> 5), rr = r & 15, cc = c & 31, ob = rr * 64 + cc * 2; return st * 1024 + (ob ^ (((ob >> 9) & 1) << 5)); }
__device__ __forceinline__ void stage_rc(int b, int& R, int& C) { const int st = b / 1024, sb = b % 1024, swz = sb ^ (((sb >> 9) & 1) << 5); R = (st >> 1) * 16 + swz / 64; C = (st & 1) * 32 + (swz % 64) / 2; }
__device__ __forceinline__ int perm32(int rho) { const int n = rho >> 4, i = rho & 15; return 8 * (i >> 2) + 4 * n + (i & 3); }

struct NoPre { };
struct Unit {
    const char* A; const char* B;
    const int* gat;
    unsigned lda, ldb;
    int nt;
    int gshift, nvalid;
    int pm, pn, aux;
};
typedef f32x4 Acc[2][2][4][2];

typedef int i32x8 __attribute__((ext_vector_type(8)));
template <class Sched, class Epi, bool FP8 = false, int SCALE_W = 0x7A7A7A7A, int SCALE_A = 0x7F7F7F7F, bool NEWPERM = false, bool HALFN = false>
__device__ __forceinline__ void gemm_phase(LAS unsigned char* lds, const Sched& S, const Epi& E) {
    int tid = threadIdx.x; asm volatile("" : "+v"(tid));
    const int wid = __builtin_amdgcn_readfirstlane(tid >> 6), lane = tid & 63, wr = wid >> 2, wc = wid & 3, fr = lane & 15, fq = lane >> 4;
    const unsigned ldsw = (unsigned)wid * 1024u;
    const int aoff = lds_byte(wr * 64 + fr, fq * 8), boff = lds_byte(wc * 32 + fr, fq * 8);
    const int aoff1 = aoff + 1024, boff1 = boff + 1024;
#define GE_SA(b, h) (((b) * 2 + (h)) * HTB)
#define GE_SB(b, h) ((4 + (b) * 2 + (h)) * HTB)
#define GE_STAGE(bufoff, gbase, o0, o1) do { \
        __builtin_amdgcn_global_load_lds((const unsigned*)((gbase) + (o0)), (LAS unsigned*)(lds + (bufoff) + ldsw), 16, 0, 0); \
        __builtin_amdgcn_global_load_lds((const unsigned*)((gbase) + (o1)), (LAS unsigned*)(lds + (bufoff) + ldsw + 8192), 16, 0, 0); } while (0)
#define GE_LDA(dst, b, h) do { _Pragma("unroll") for (int m = 0; m < 4; ++m) { dst[m][0] = *(const LAS bf16x8*)(lds + GE_SA(b, h) + aoff + m * 2048); dst[m][1] = *(const LAS bf16x8*)(lds + GE_SA(b, h) + aoff1 + m * 2048); } } while (0)
#define GE_LDB(dst, b, h) do { _Pragma("unroll") for (int n = 0; n < 2; ++n) { dst[n][0] = *(const LAS bf16x8*)(lds + GE_SB(b, h) + boff + n * 2048); dst[n][1] = *(const LAS bf16x8*)(lds + GE_SB(b, h) + boff1 + n * 2048); } } while (0)
#define GE_CAT(x0, x1) __builtin_shufflevector(__builtin_bit_cast(u32x4, x0), __builtin_bit_cast(u32x4, x1), 0, 1, 2, 3, 4, 5, 6, 7)
#define GE_MMA(ai, bj, At, Bt) do { __builtin_amdgcn_s_setprio(1); _Pragma("unroll") for (int m = 0; m < 4; ++m) _Pragma("unroll") for (int n = 0; n < 2; ++n) { \
        if constexpr (FP8) acc[ai][bj][m][n] = __builtin_amdgcn_mfma_scale_f32_16x16x128_f8f6f4(__builtin_bit_cast(i32x8, GE_CAT(Bt[n][0], Bt[n][1])), __builtin_bit_cast(i32x8, GE_CAT(At[m][0], At[m][1])), acc[ai][bj][m][n], 0, 0, 0, SCALE_W, 0, SCALE_A); \
        else { _Pragma("unroll") for (int k = 0; k < 2; ++k) acc[ai][bj][m][n] = __builtin_amdgcn_mfma_f32_16x16x32_bf16(Bt[n][k], At[m][k], acc[ai][bj][m][n], 0, 0, 0); } } __builtin_amdgcn_s_setprio(0); } while (0)
#define GE_WAIT_V(n) asm volatile("s_waitcnt vmcnt(" #n ")" ::: "memory")
#define GE_WAIT_L(n) asm volatile("s_waitcnt lgkmcnt(" #n ")" ::: "memory")
#define GE_BAR __builtin_amdgcn_s_barrier()
#define GE_SCHED __builtin_amdgcn_sched_barrier(0)
#define GE_OFFS(u, FROM_LDS, oA00, oA01, oA10, oA11, oB0, oB1) do { \
        int tq_ = tid; asm volatile("" : "+v"(tq_)); int R0, C0, R1, C1; stage_rc(tq_ * 16, R0, C0); stage_rc(tq_ * 16 + 8192, R1, C1); \
        const int Rb0 = NEWPERM ? 64 * (R0 >> 5) + 16 * ((R0 & 15) >> 2) + 4 * ((R0 >> 4) & 1) + (R0 & 3) : (R0 & ~31) + perm32(R0 & 31), Rb1 = NEWPERM ? 64 * (R1 >> 5) + 16 * ((R1 & 15) >> 2) + 4 * ((R1 >> 4) & 1) + (R1 & 3) : (R1 & ~31) + perm32(R1 & 31); \
        int r00 = R0, r01 = R1, r10 = 128 + R0, r11 = 128 + R1; \
        if ((u).gat) { if (FROM_LDS) { const LAS int* ix_ = (const LAS int*)(lds + GE_GIDX); r00 = ix_[r00]; r01 = ix_[r01]; r10 = ix_[r10]; r11 = ix_[r11]; } else { \
            const int* g_ = (u).gat; const int nv_ = (u).nvalid, sh_ = (u).gshift, lr_ = nv_ - 1; \
            const int g0_ = g_[2 * (r00 < nv_ ? r00 : lr_)], g1_ = g_[2 * (r01 < nv_ ? r01 : lr_)], g2_ = g_[2 * (r10 < nv_ ? r10 : lr_)], g3_ = g_[2 * (r11 < nv_ ? r11 : lr_)]; \
            r00 = (r00 < nv_) ? (g0_ >> sh_) : 0; r01 = (r01 < nv_) ? (g1_ >> sh_) : 0; r10 = (r10 < nv_) ? (g2_ >> sh_) : 0; r11 = (r11 < nv_) ? (g3_ >> sh_) : 0; } } \
        oA00 = (unsigned)r00 * (u).lda + (unsigned)C0 * 2u; oA01 = (unsigned)r01 * (u).lda + (unsigned)C1 * 2u; \
        oA10 = (unsigned)r10 * (u).lda + (unsigned)C0 * 2u; oA11 = (unsigned)r11 * (u).lda + (unsigned)C1 * 2u; \
        oB0 = (unsigned)Rb0 * (u).ldb + (unsigned)C0 * 2u; oB1 = (unsigned)Rb1 * (u).ldb + (unsigned)C1 * 2u; } while (0)
    Unit cur, nxt; int ui = 0;
    if (!S.next(0, cur)) return;
    Acc acc;
#pragma unroll
    for (int a = 0; a < 2; ++a)
#pragma unroll
        for (int b = 0; b < 2; ++b)
#pragma unroll
            for (int m = 0; m < 4; ++m)
#pragma unroll
                for (int n = 0; n < 2; ++n) acc[a][b][m][n] = (f32x4){0.f, 0.f, 0.f, 0.f};
    bf16x8 At[4][2], B0[2][2], B1[2][2];
    unsigned oA00, oA01, oA10, oA11, oB0, oB1;
    GE_OFFS(cur, false, oA00, oA01, oA10, oA11, oB0, oB1);
    typename Epi::Pre pre = E.prefetch(cur, wr, wc, fr, fq);
    constexpr int HB_ROWS = NEWPERM ? 8 : 128;
    const char* cA = cur.A; const char* cB = cur.B; size_t chB = (size_t)HB_ROWS * cur.ldb;
    const size_t kstep = 128;
    GE_STAGE(GE_SB(0, 0), cB, oB0, oB1); GE_STAGE(GE_SA(0, 0), cA, oA00, oA01); if constexpr (!HALFN) GE_STAGE(GE_SB(0, 1), cB + chB, oB0, oB1); GE_STAGE(GE_SA(0, 1), cA, oA10, oA11);
    if (wr == 1) GE_BAR;
    if constexpr (HALFN) GE_WAIT_V(2); else GE_WAIT_V(4);
    GE_BAR;
    GE_STAGE(GE_SB(1, 0), cB + kstep, oB0, oB1); GE_STAGE(GE_SA(1, 0), cA + kstep, oA00, oA01); if constexpr (!HALFN) GE_STAGE(GE_SB(1, 1), cB + chB + kstep, oB0, oB1);
    if constexpr (HALFN) GE_WAIT_V(4); else GE_WAIT_V(6);
    GE_BAR;
    for (;;) {
        const bool has_next = S.next(ui + 1, nxt);
        const char* nA = has_next ? nxt.A : cA; const char* nB = has_next ? nxt.B : cB; const size_t nhB = has_next ? (size_t)HB_ROWS * nxt.ldb : chB;
        const int nt = cur.nt;
        if (has_next && nxt.gat) { int tg_ = tid; asm volatile("" : "+v"(tg_));
            if (tg_ < 256) { const int nv_ = nxt.nvalid; const int gv_ = nxt.gat[2 * (tg_ < nv_ ? tg_ : nv_ - 1)] >> nxt.gshift; ((LAS int*)(lds + GE_GIDX))[tg_] = (tg_ < nv_) ? gv_ : 0; } }
        for (int t = 0; t < nt; t += 2) {
            const bool last = (t == nt - 2);
            const char* a1 = cA + (size_t)(t + 1) * kstep;
            const char* a2 = last ? nA : cA + (size_t)(t + 2) * kstep; const char* b2 = last ? nB : cB + (size_t)(t + 2) * kstep;
            const size_t hB2 = last ? nhB : chB;
            const char* a3 = a2 + kstep; const char* b3 = b2 + kstep;
            GE_LDB(B0, 0, 0); GE_SCHED; GE_LDA(At, 0, 0); GE_STAGE(GE_SA(1, 1), a1, oA10, oA11);
            if (last && has_next) { GE_OFFS(nxt, true, oA00, oA01, oA10, oA11, oB0, oB1); }
            GE_WAIT_L(8); GE_BAR; GE_WAIT_L(0); GE_MMA(0, 0, At, B0); GE_BAR; GE_SCHED;
            if constexpr (!HALFN) GE_LDB(B1, 0, 1);
            GE_STAGE(GE_SB(0, 0), b2, oB0, oB1);
            GE_BAR; if constexpr (!HALFN) { GE_WAIT_L(0); GE_MMA(0, 1, At, B1); } GE_BAR;
            GE_LDA(At, 0, 1); GE_STAGE(GE_SA(0, 0), a2, oA00, oA01);
            GE_BAR; GE_WAIT_L(0); GE_MMA(1, 0, At, B0); GE_BAR; GE_SCHED;
            if constexpr (!HALFN) { GE_STAGE(GE_SB(0, 1), b2 + hB2, oB0, oB1); GE_WAIT_V(6); } else GE_WAIT_V(4);
            GE_BAR; if constexpr (!HALFN) GE_MMA(1, 1, At, B1);
            GE_BAR;
            GE_LDB(B0, 1, 0); GE_SCHED; GE_LDA(At, 1, 0); GE_STAGE(GE_SA(0, 1), a2, oA10, oA11);
            GE_WAIT_L(8); GE_BAR; GE_WAIT_L(0); GE_MMA(0, 0, At, B0); GE_BAR; GE_SCHED;
            if constexpr (!HALFN) GE_LDB(B1, 1, 1);
            GE_STAGE(GE_SB(1, 0), b3, oB0, oB1);
            GE_BAR; if constexpr (!HALFN) { GE_WAIT_L(0); GE_MMA(0, 1, At, B1); } GE_BAR;
            GE_LDA(At, 1, 1); GE_STAGE(GE_SA(1, 0), a3, oA00, oA01);
            GE_BAR; GE_WAIT_L(0); GE_MMA(1, 0, At, B0); GE_BAR; GE_SCHED;
            if constexpr (!HALFN) { GE_STAGE(GE_SB(1, 1), b3 + hB2, oB0, oB1); GE_WAIT_V(6); } else GE_WAIT_V(4);
            GE_BAR; if constexpr (!HALFN) GE_MMA(1, 1, At, B1);
            GE_BAR;
        }
        if constexpr (!Epi::AFTER_DRAIN) E(acc, cur, wr, wc, fr, fq, pre);
        if (!has_next) break;
#pragma unroll
        for (int a = 0; a < 2; ++a)
#pragma unroll
            for (int b = 0; b < 2; ++b)
#pragma unroll
                for (int m = 0; m < 4; ++m)
#pragma unroll
                    for (int n = 0; n < 2; ++n) acc[a][b][m][n] = (f32x4){0.f, 0.f, 0.f, 0.f};
        cur = nxt; cA = nA; cB = nB; chB = nhB; ++ui; pre = E.prefetch(cur, wr, wc, fr, fq);
    }
    GE_WAIT_V(0);
    if (wr == 0) GE_BAR;
    GE_BAR;
    if constexpr (Epi::AFTER_DRAIN) E.drained(acc, cur, wr, wc, fr, fq, lds);
#undef GE_SA
#undef GE_SB
#undef GE_STAGE
#undef GE_LDA
#undef GE_LDB
#undef GE_MMA
#undef GE_WAIT_V
#undef GE_WAIT_L
#undef GE_BAR
#undef GE_SCHED
#undef GE_OFFS
#undef GE_CAT
}
__device__ __forceinline__ bool static_tile(long L, int nM, int nN, int& pm, int& pn) {
    const int nwg = nM * nN; if (L >= nwg) return false;
    int wgid = (int)L; { const int q = nwg / 8, r = nwg % 8, xcd = wgid % 8, off = wgid / 8; wgid = (xcd < r ? xcd * (q + 1) : r * (q + 1) + (xcd - r) * q) + off; }
    const int nig = 8 * nN, gid = wgid / nig, fm = gid * 8, gsz = (nM - fm) < 8 ? (nM - fm) : 8;
    pm = fm + ((wgid % nig) % gsz); pn = (wgid % nig) / gsz; return true;
}
}

struct Frame {
    LAS unsigned char* lds;
    int tid, lane, wave, G, vcu;
    unsigned char* ws;
    float* out;
};
#define WSP(T_, off) ((T_*)(F.ws + (off)))

extern __shared__ __attribute__((aligned(16))) unsigned char lds_raw[];
__device__ __forceinline__ Params load_params() {
    typedef const __attribute__((address_space(4))) unsigned long long cu64;
    cu64* k = (cu64*)__builtin_amdgcn_kernarg_segment_ptr();
    asm volatile("" : "+s"(k));
    Params P;
#pragma unroll
    for (int i = 0; i < 38; ++i) P.in[i] = (const float*)(const __attribute__((address_space(1))) float*)k[i];
    P.out = (float*)(__attribute__((address_space(1))) float*)k[38]; P.ws = (unsigned char*)(__attribute__((address_space(1))) unsigned char*)k[39];
    P.phase_lo = 0; P.phase_hi = 0; P.layer_lo = 0; P.layer_hi = 0;
    return P;
}
#define KPARAMS() load_params()
__device__ __forceinline__ Frame make_frame(unsigned char* ws, float* out) {
    Frame F;
    F.lds = (LAS unsigned char*)lds_raw;
    int tz = threadIdx.x; asm volatile("" : "+v"(tz));
    F.tid = tz; F.lane = F.tid & 63; F.wave = __builtin_amdgcn_readfirstlane(F.tid >> 6);
    F.G = gridDim.x; { const int bx = blockIdx.x; F.vcu = (F.G % 8 == 0) ? (bx % 8) * (F.G / 8) + bx / 8 : bx; }
    F.ws = ws; F.out = out;
    return F;
}
template <bool FP8OUT, class ColMap>
__device__ __forceinline__ void transpose_item(const float* W, int ldw, int K, void* WTv, int nblk, LAS float* scr, int item, int lane, const ColMap& cm) {
    const int kb = item / nblk, nb = item % nblk, k0 = 64 * kb, n0 = 32 * nb;
    const int sc = cm(n0 + (lane & 31));
#pragma unroll 8
    for (int i = 0; i < 32; ++i) { const int kk = 2 * i + (lane >> 5); scr[kk * 33 + (lane & 31)] = (sc >= 0) ? W[(size_t)(k0 + kk) * ldw + sc] : 0.f; }
    asm volatile("s_waitcnt lgkmcnt(0)" ::: "memory");
    const int c = lane & 7;
#pragma unroll
    for (int j = 0; j < 4; ++j) { const int n = (lane >> 3) + 8 * j; const LAS float* s = scr + (8 * c) * 33 + n;
        if (FP8OUT) { u32x2 o; o.x = pack_fp8x4(32.f * s[0 * 33], 32.f * s[1 * 33], 32.f * s[2 * 33], 32.f * s[3 * 33]); o.y = pack_fp8x4(32.f * s[4 * 33], 32.f * s[5 * 33], 32.f * s[6 * 33], 32.f * s[7 * 33]);
            *(u32x2*)((unsigned char*)WTv + (size_t)(n0 + n) * K + k0 + 8 * c) = o; }
        else { u32x4 o; o.x = cvt_pk_bf16(s[0 * 33], s[1 * 33]); o.y = cvt_pk_bf16(s[2 * 33], s[3 * 33]); o.z = cvt_pk_bf16(s[4 * 33], s[5 * 33]); o.w = cvt_pk_bf16(s[6 * 33], s[7 * 33]);
            *(u32x4*)((bf16_t*)WTv + (size_t)(n0 + n) * K + k0 + 8 * c) = o; } }
    asm volatile("s_waitcnt lgkmcnt(0)" ::: "memory");
}
struct CmIdent { __device__ __forceinline__ int operator()(int n) const { return n; } };
struct CmInproj { int layer; __device__ __forceinline__ int operator()(int j) const {
    if (j < 1536) return j;
    if (j < 1792) { const int q = j - 1536; if (q < 160) return 1536 + q; if (q < 192) return layer > 0 ? 5792 + (q - 160) : -1; return -1; }
    if (j < 2304) return 1696 + (j - 1792);
    if (j < 2816) { const int jj = j - 2304, c = jj >> 1; return (jj & 1) ? 2208 + 256 + c : 2208 + c; }
    return 2720 + (j - 2816); } };
struct CmRouter { __device__ __forceinline__ int operator()(int n) const { return n < 32 ? n : -1; } };
struct CmGU { __device__ __forceinline__ int operator()(int n) const { return n; } };

template <bool FP8OUT> __device__ __forceinline__ void moe_item_store(void* WTv, int K, int k0, int n0, LAS float* scr, int lane) {
    asm volatile("s_waitcnt lgkmcnt(0)" ::: "memory");
    const int c = lane & 7;
#pragma unroll
    for (int j = 0; j < 4; ++j) { const int nn = (lane >> 3) + 8 * j; const LAS float* s = scr + (8 * c) * 33 + nn;
        if (FP8OUT) { u32x2 o; o.x = pack_fp8x4(32.f * s[0 * 33], 32.f * s[1 * 33], 32.f * s[2 * 33], 32.f * s[3 * 33]); o.y = pack_fp8x4(32.f * s[4 * 33], 32.f * s[5 * 33], 32.f * s[6 * 33], 32.f * s[7 * 33]);
            *(u32x2*)((unsigned char*)WTv + (size_t)(n0 + nn) * K + k0 + 8 * c) = o; }
        else { u32x4 o; o.x = cvt_pk_bf16(s[0 * 33], s[1 * 33]); o.y = cvt_pk_bf16(s[2 * 33], s[3 * 33]); o.z = cvt_pk_bf16(s[4 * 33], s[5 * 33]); o.w = cvt_pk_bf16(s[6 * 33], s[7 * 33]);
            *(u32x4*)((bf16_t*)WTv + (size_t)(n0 + nn) * K + k0 + 8 * c) = o; } }
    asm volatile("s_waitcnt lgkmcnt(0)" ::: "memory");
}
__device__ __forceinline__ void fast_item_plain(const float* W, int ldw, int K, unsigned char* WT, int nblk, LAS float* scr, int item, int lane) {
    const int kb = item / nblk, nb = item % nblk, k0 = 64 * kb, n0 = 32 * nb; const int c4 = (lane & 7) * 4; const float* Ws = W + n0 + c4;
    f32x4 v[8];
#pragma unroll
    for (int i = 0; i < 8; ++i) v[i] = *(const f32x4*)(Ws + (size_t)(k0 + 8 * i + (lane >> 3)) * ldw);
#pragma unroll
    for (int i = 0; i < 8; ++i) { LAS float* d = scr + (8 * i + (lane >> 3)) * 33 + c4; d[0] = v[i][0]; d[1] = v[i][1]; d[2] = v[i][2]; d[3] = v[i][3]; }
    moe_item_store<true>(WT, K, k0, n0, scr, lane);
}
__device__ __forceinline__ void phase_convert_static(Frame& F, const Params& P) {
    LAS float* scr = (LAS float*)(F.lds + F.wave * 8448);
    const int gw = F.vcu * 8 + F.wave, NGW = F.G * 8;
    constexpr int I_IN = 16 * (NIN / 32);
    for (int it = gw; it < NL * I_IN; it += NGW) { const int l = it / I_IN, r = it % I_IN; const int lane = F.lane;
        const float* W = (l == 0) ? P.in[1] : P.in[2] + (size_t)(l - 1) * 1024 * 5824; const int ldw = (l == 0) ? 5792 : 5824;
        const int kb = r / (NIN / 32), nb = r % (NIN / 32), k0 = 64 * kb, n0 = 32 * nb;
        f32x4 v[8];
        if (n0 >= 2304 && n0 < 2816) {
            const int m = (lane >> 2) & 1, c4 = (lane & 3) * 4; const float* Ws = W + 2208 + 256 * m + ((n0 - 2304) >> 1) + c4;
#pragma unroll
            for (int i = 0; i < 8; ++i) v[i] = *(const f32x4*)(Ws + (size_t)(k0 + 8 * i + (lane >> 3)) * ldw);
#pragma unroll
            for (int i = 0; i < 8; ++i) { LAS float* d = scr + (8 * i + (lane >> 3)) * 33 + 2 * c4 + m; d[0] = v[i][0]; d[2] = v[i][1]; d[4] = v[i][2]; d[6] = v[i][3]; }
        } else {
            int src = n0; bool zero = false;
            if (n0 >= 1696 && n0 < 1728) { src = 5792 + (n0 - 1696); zero = (l == 0); } else if (n0 >= 1728 && n0 < 1792) zero = true; else if (n0 >= 1792) src = n0 - 96;
            const int c4 = (lane & 7) * 4; const float* Ws = W + (zero ? 0 : src) + c4;
#pragma unroll
            for (int i = 0; i < 8; ++i) { v[i] = *(const f32x4*)(Ws + (size_t)(k0 + 8 * i + (lane >> 3)) * ldw); if (zero) v[i] = (f32x4){0.f, 0.f, 0.f, 0.f}; }
#pragma unroll
            for (int i = 0; i < 8; ++i) { LAS float* d = scr + (8 * i + (lane >> 3)) * 33 + c4; d[0] = v[i][0]; d[1] = v[i][1]; d[2] = v[i][2]; d[3] = v[i][3]; }
        }
        moe_item_store<true>(WSP(unsigned char, WS_WIN) + (size_t)l * NIN * 1024, 1024, k0, n0, scr, lane); }
    constexpr int I_A = 8 * 32, I_B = 4 * 32;
    for (int it = gw; it < NL * (I_A + 2 * I_B); it += NGW) { const int l = it / (I_A + 2 * I_B); int r = it % (I_A + 2 * I_B);
        unsigned char* base = WSP(unsigned char, WS_WBR) + (size_t)l * (1024 * 1024);
        if (r < I_A) { fast_item_plain(P.in[17] + (size_t)l * 512 * 1024, 1024, 512, base, 32, scr, r, F.lane); continue; } r -= I_A;
        if (r < I_B) { fast_item_plain(P.in[22] + (size_t)l * 256 * 1024, 1024, 256, base + 1024 * 512, 32, scr, r, F.lane); continue; } r -= I_B;
        fast_item_plain(P.in[27] + (size_t)l * 256 * 1024, 1024, 256, base + 1024 * 512 + 1024 * 256, 32, scr, r, F.lane); }
    constexpr int I_O = 16 * 32;
    for (int it = gw; it < NL * I_O; it += NGW) { const int l = it / I_O, r = it % I_O;
        fast_item_plain(P.in[28] + (size_t)l * 1024 * 1024, 1024, 1024, WSP(unsigned char, WS_WOUT) + (size_t)l * 1024 * 1024, 32, scr, r, F.lane); }
    for (int it = gw; it < 16 * 8; it += NGW) transpose_item<false>(P.in[31], 32, 1024, WSP(bf16_t, WS_WRT), 8, scr, it, F.lane, CmRouter{});
}
__device__ __forceinline__ unsigned char* moe_wbuf(Frame& F, int l) { return (l & 1) ? (unsigned char*)F.out : F.ws + WS_WMOE; }
__device__ __forceinline__ void phase_convert_moe(Frame& F, const Params& P, int l, int it0, int it1, int step) {
    LAS float* scr = (LAS float*)(F.lds + F.wave * 8448);
    const int lane = F.lane;
    constexpr int I_GU = 16 * 32;
    constexpr int I_DN = 8 * 32;
    for (int it = it0; it < it1; it += step) {
        f32x4 v[8];
        if (it < NE * I_GU) { const int e = it / I_GU, item = it % I_GU;
            const int kb = item / 32, nb = item % 32, k0 = 64 * kb, n0 = 32 * nb;
            const int m = (lane >> 2) & 1, c4 = (lane & 3) * 4;
            const float* Ws = ((m ? P.in[34] : P.in[33]) + ((size_t)l * NE + e) * 1024 * 512) + (n0 >> 1) + c4;
#pragma unroll
            for (int i = 0; i < 8; ++i) v[i] = *(const f32x4*)(Ws + (size_t)(k0 + 8 * i + (lane >> 3)) * 512);
#pragma unroll
            for (int i = 0; i < 8; ++i) { LAS float* d = scr + (8 * i + (lane >> 3)) * 33 + 2 * c4 + m; d[0] = v[i][0]; d[2] = v[i][1]; d[4] = v[i][2]; d[6] = v[i][3]; }
            moe_item_store<true>(moe_wbuf(F, l) + (size_t)e * 1024 * 1024, 1024, k0, n0, scr, lane);
        } else { const int id = it - NE * I_GU; const int e = id / I_DN, item = id % I_DN;
            const int kb = item / 32, nb = item % 32, k0 = 64 * kb, n0 = 32 * nb; const int c4 = (lane & 7) * 4;
            const float* Ws = P.in[35] + ((size_t)l * NE + e) * 512 * 1024 + n0 + c4;
#pragma unroll
            for (int i = 0; i < 8; ++i) v[i] = *(const f32x4*)(Ws + (size_t)(k0 + 8 * i + (lane >> 3)) * 1024);
#pragma unroll
            for (int i = 0; i < 8; ++i) { LAS float* d = scr + (8 * i + (lane >> 3)) * 33 + c4; d[0] = v[i][0]; d[1] = v[i][1]; d[2] = v[i][2]; d[3] = v[i][3]; }
            moe_item_store<true>(moe_wbuf(F, l) + (size_t)NE * 1024 * 1024 + (size_t)e * 1024 * 512, 512, k0, n0, scr, lane); } }
}
constexpr int MOE_ITEMS = NE * (16 * 32 + 8 * 32);
__device__ __forceinline__ void phase_convert_wkvpar(Frame& F, const Params& P) {
    float* dst = WSP(float, WS_WKVPAR);
    for (int idx = (int)blockIdx.x * 512 + F.tid; idx < NL * 512; idx += F.G * 512) { const int l = idx / 512, ch = idx % 512;
        const float* mu = P.in[3] + (size_t)l * 1696; float* d = dst + (size_t)idx * 12;
        d[0] = mu[ch]; d[1] = mu[512 + ch]; d[2] = mu[1024 + ch]; d[3] = P.in[5][idx]; d[4] = P.in[7][idx]; d[5] = (l > 0) ? P.in[10][idx - 512] : 0.f;
        d[6] = P.in[12][idx]; d[7] = P.in[13][idx]; d[8] = P.in[14][idx]; d[9] = 0.f; d[10] = 0.f; d[11] = 0.f; }
}
__device__ __forceinline__ void phase_convert_lora(Frame& F, const Params& P) {
    bf16_t* dst = WSP(bf16_t, WS_LORA);
    for (int idx = (int)blockIdx.x * 512 + F.tid; idx < 11 * 512 * 32 + 4 * 512 * 96; idx += F.G * 512) {
        float val;
        if (idx < 11 * 512 * 32) { const int m = idx / (512 * 32), rem = idx % (512 * 32), ch = rem / 32, i = rem % 32;
            if (m < 4) val = P.in[6][((size_t)m * 32 + i) * 512 + ch]; else if (m < 8) val = P.in[8][((size_t)(m - 4) * 32 + i) * 512 + ch]; else val = P.in[11][((size_t)(m - 8) * 32 + i) * 512 + ch]; }
        else { const int r2 = idx - 11 * 512 * 32, m = r2 / (512 * 96), rem = r2 % (512 * 96), ch = rem / 96, i = rem % 96; val = P.in[9][((size_t)m * 96 + i) * 512 + ch]; }
        dst[idx] = f2bf(val); }
}
__device__ __forceinline__ void phase_convert_sgu(Frame& F, const Params& P) {
    bf16_t* dst = WSP(bf16_t, WS_SGUW);
    for (int idx = (int)blockIdx.x * 512 + F.tid; idx < NL * 4 * 128 * 128; idx += F.G * 512) { const int p = (idx >> 7) & 127, qq = idx & 127; dst[idx] = f2bf(qq <= p ? P.in[20][idx] : 0.f); }
}
__device__ __forceinline__ void phase_convert_router(Frame& F, const Params& P) {
    bf16_t* dst = WSP(bf16_t, WS_WRG); float* rc = WSP(float, WS_RC);
    for (int idx = (int)blockIdx.x * 512 + F.tid; idx < NL * 256 * 1024; idx += F.G * 512) { const int l = idx >> 18, n = (idx >> 10) & 255, k = idx & 1023;
        dst[idx] = f2bf(n < 32 ? P.in[29][(size_t)l * 1024 + k] * P.in[31][(size_t)k * 32 + n] : 0.f); }
    const int gwv = (int)blockIdx.x * 8 + F.wave;
    if (gwv < NL * 32) { const int l = gwv >> 5, e = gwv & 31; float c1 = 0.f, c0 = 0.f;
#pragma unroll
        for (int j = 0; j < 16; ++j) { const int k = F.lane + 64 * j; const float w = P.in[31][(size_t)k * 32 + e]; c1 += P.in[29][(size_t)l * 1024 + k] * w; c0 += P.in[30][(size_t)l * 1024 + k] * w; }
        c1 = wave_sum(c1); c0 = wave_sum(c0);
        if (F.lane == 0) { rc[l * 64 + e] = c1; rc[l * 64 + 32 + e] = c0; } }
}
__device__ __forceinline__ void phase_x_to_bf16(Frame& F, const Params& P) {
    const size_t n8 = (size_t)T * D / 8; const float* x = P.in[0]; bf16_t* xb = WSP(bf16_t, WS_X); unsigned char* xq = WSP(unsigned char, WS_XQ);
    const size_t st = (size_t)F.G * 512;
    for (size_t i = (size_t)blockIdx.x * 512 + F.tid; i < n8; i += 4 * st) { f32x4 a[4], b[4];
#pragma unroll
        for (int u = 0; u < 4; ++u) { const size_t j = (i + u * st < n8) ? i + u * st : i; a[u] = *(const f32x4*)(x + j * 8); b[u] = *(const f32x4*)(x + j * 8 + 4); }
#pragma unroll
        for (int u = 0; u < 4; ++u) { const size_t j = i + u * st; if (j < n8) {
            u32x4 o; o.x = cvt_pk_bf16(a[u][0], a[u][1]); o.y = cvt_pk_bf16(a[u][2], a[u][3]); o.z = cvt_pk_bf16(b[u][0], b[u][1]); o.w = cvt_pk_bf16(b[u][2], b[u][3]);
            *(u32x4*)(xb + j * 8) = o;
            u32x2 qv; qv.x = pack_fp8x4(a[u][0], a[u][1], a[u][2], a[u][3]); qv.y = pack_fp8x4(b[u][0], b[u][1], b[u][2], b[u][3]); *(u32x2*)(xq + j * 8) = qv; } } }
}

__device__ __forceinline__ u32x4 dpp_swap1(const u32x4 v) { u32x4 o;
    o.x = (unsigned)__builtin_amdgcn_mov_dpp((int)v.x, 0xB1, 0xF, 0xF, true); o.y = (unsigned)__builtin_amdgcn_mov_dpp((int)v.y, 0xB1, 0xF, 0xF, true);
    o.z = (unsigned)__builtin_amdgcn_mov_dpp((int)v.z, 0xB1, 0xF, 0xF, true); o.w = (unsigned)__builtin_amdgcn_mov_dpp((int)v.w, 0xB1, 0xF, 0xF, true); return o; }
__device__ __forceinline__ void pair_rows(const u32x4 P0, const u32x4 P1, const bool odd, u32x4& A, u32x4& B) {
    const u32x4 snd = odd ? P0 : P1; const u32x4 rcv = dpp_swap1(snd);
    A = odd ? rcv : P0; B = odd ? P1 : rcv; }
__device__ __forceinline__ unsigned sig_u8x4(const f32x4 v) { unsigned w = 0;
    w = __builtin_amdgcn_cvt_pk_u8_f32(255.f * sigmoidf_(v[0]) + 0.5f, 0, w); w = __builtin_amdgcn_cvt_pk_u8_f32(255.f * sigmoidf_(v[1]) + 0.5f, 1, w);
    w = __builtin_amdgcn_cvt_pk_u8_f32(255.f * sigmoidf_(v[2]) + 0.5f, 2, w); w = __builtin_amdgcn_cvt_pk_u8_f32(255.f * sigmoidf_(v[3]) + 0.5f, 3, w); return w; }
struct SchedInproj { const char* X; const char* W; int G, c;
    __device__ __forceinline__ bool next(int i, ge::Unit& u) const { int pm, pn; if (!ge::static_tile((long)i * G + c, T / 256, NIN / 256, pm, pn)) return false;
        u.A = X + (size_t)pm * 256 * 1024; u.B = W + (size_t)pn * 256 * 1024; u.gat = nullptr; u.lda = 1024; u.ldb = 1024; u.nt = 8; u.gshift = 0; u.nvalid = 256; u.pm = pm; u.pn = pn; u.aux = 0; return true; } };
struct EpiInproj { static constexpr bool AFTER_DRAIN = false; bf16_t* rkv; bf16_t* sguz; bf16_t* convh; unsigned char* gates;
    typedef ge::NoPre Pre; __device__ __forceinline__ Pre prefetch(const ge::Unit&, int, int, int, int) const { return Pre{}; }
    __device__ __forceinline__ void operator()(const ge::Acc& acc, const ge::Unit& u, int wr, int wc, int fr, int fq, const Pre&) const {
        const int pn = u.pn; const int row0 = u.pm * 256 + wr * 64 + fr;
        if (pn >= 11) {
            unsigned char* gb = gates + ((size_t)((u.pm * 12 + pn - 11) * 8 + wr * 4 + wc) * 8) * 1024 + (size_t)(fq * 16 + fr) * 16;
#pragma unroll
            for (int ai = 0; ai < 2; ++ai)
#pragma unroll
                for (int m = 0; m < 4; ++m) { u32x4 w;
                    w.x = sig_u8x4(acc[ai][0][m][0]); w.y = sig_u8x4(acc[ai][0][m][1]); w.z = sig_u8x4(acc[ai][1][m][0]); w.w = sig_u8x4(acc[ai][1][m][1]);
                    *(u32x4*)(gb + (ai * 4 + m) * 1024) = w; }
            return; }
        const int cb = 64 * wc + 16 * fq; const bool odd = (fr & 1) != 0;
        if (pn >= 9) {
            bf16_t* hb = convh + (size_t)row0 * 256 + (pn - 9) * 128 + (cb >> 1);
#pragma unroll
            for (int ai = 0; ai < 2; ++ai)
#pragma unroll
                for (int m = 0; m < 4; ++m) { u32x4 w; const f32x4 v0 = acc[ai][0][m][0], v1 = acc[ai][0][m][1], v2 = acc[ai][1][m][0], v3 = acc[ai][1][m][1];
                    w.x = cvt_pk_bf16(v0[0] * sigmoidf_(v0[1]), v0[2] * sigmoidf_(v0[3])); w.y = cvt_pk_bf16(v1[0] * sigmoidf_(v1[1]), v1[2] * sigmoidf_(v1[3]));
                    w.z = cvt_pk_bf16(v2[0] * sigmoidf_(v2[1]), v2[2] * sigmoidf_(v2[3])); w.w = cvt_pk_bf16(v3[0] * sigmoidf_(v3[1]), v3[2] * sigmoidf_(v3[3]));
                    *(u32x4*)(hb + (size_t)(ai * 128 + m * 16) * 256) = w; }
            return; }
        const bool gel = (pn >= 7); const int ld = gel ? 512 : RKVW;
        bf16_t* ob = (gel ? sguz + (pn - 7) * 256 : rkv + pn * 256) + (size_t)(row0 - (odd ? 1 : 0)) * ld + cb + (odd ? 8 : 0);
#pragma unroll
        for (int ai = 0; ai < 2; ++ai)
#pragma unroll
            for (int m = 0; m < 4; ++m) { f32x4 v0 = acc[ai][0][m][0], v1 = acc[ai][0][m][1], v2 = acc[ai][1][m][0], v3 = acc[ai][1][m][1];
                if (gel) {
#pragma unroll
                    for (int j = 0; j < 4; ++j) { v0[j] = gelu_f(v0[j]); v1[j] = gelu_f(v1[j]); v2[j] = gelu_f(v2[j]); v3[j] = gelu_f(v3[j]); } }
                u32x4 P0, P1, A, B; P0.x = cvt_pk_bf16(v0[0], v0[1]); P0.y = cvt_pk_bf16(v0[2], v0[3]); P0.z = cvt_pk_bf16(v1[0], v1[1]); P0.w = cvt_pk_bf16(v1[2], v1[3]);
                P1.x = cvt_pk_bf16(v2[0], v2[1]); P1.y = cvt_pk_bf16(v2[2], v2[3]); P1.z = cvt_pk_bf16(v3[0], v3[1]); P1.w = cvt_pk_bf16(v3[2], v3[3]);
                pair_rows(P0, P1, odd, A, B);
                bf16_t* p = ob + (size_t)(ai * 128 + m * 16) * ld; *(u32x4*)p = A; *(u32x4*)(p + ld) = B; }
    } };
struct SchedBranch { const char* ws; size_t woff; int G, v;
    __device__ __forceinline__ bool next(int i, ge::Unit& u) const { const int tile = (i / 3) * G + v, br = i % 3, pm = tile >> 2, pn = tile & 3; if (tile >= 512) return false;
        const unsigned kb = (br == 0) ? 512u : 256u;
        size_t ao = WS_OUTA, wo = woff; if (br == 1) { ao = WS_HB; wo += (size_t)1024 * 512; } if (br == 2) { ao = WS_HC; wo += (size_t)1024 * 512 + (size_t)1024 * 256; }
        u.A = ws + ao + (size_t)pm * 256 * kb; u.lda = kb; u.nt = (int)(kb >> 7); u.B = ws + wo + (size_t)pn * 256 * kb; u.ldb = kb;
        u.gat = nullptr; u.gshift = 0; u.nvalid = 256; u.pm = pm; u.pn = pn; u.aux = br; return true; } };
struct EpiBranch { static constexpr bool AFTER_DRAIN = false; const unsigned char* gates; bf16_t* merged; unsigned char* mq;
    typedef ge::NoPre Pre; __device__ __forceinline__ Pre prefetch(const ge::Unit&, int, int, int, int) const { return Pre{}; }
    __device__ __forceinline__ void operator()(const ge::Acc& acc, const ge::Unit& u, int wr, int wc, int fr, int fq, const Pre&) const {
        const int br = u.aux; const int row0 = u.pm * 256 + wr * 64 + fr;
        bf16_t* mb = merged + ((size_t)((u.pm * 4 + u.pn) * 8 + wr * 4 + wc) * 16) * 512 + (size_t)(fq * 16 + fr) * 8;
        u32x2 gall[16];
        {   const unsigned char* gb = gates + ((size_t)((u.pm * 12 + br * 4 + u.pn) * 8 + wr * 4 + wc) * 8) * 1024 + (size_t)(fq * 16 + fr) * 16;
#pragma unroll
            for (int k = 0; k < 8; ++k) { const u32x4 t = *(const u32x4*)(gb + k * 1024); gall[2 * k] = (u32x2){t.x, t.y}; gall[2 * k + 1] = (u32x2){t.z, t.w}; } }
#pragma unroll
        for (int ai = 0; ai < 2; ++ai) {
            u32x2 g[8]; u32x4 p[8];
#pragma unroll
            for (int m = 0; m < 4; ++m)
#pragma unroll
                for (int bj = 0; bj < 2; ++bj) {
                    g[m * 2 + bj] = gall[ai * 8 + m * 2 + bj];
                    p[m * 2 + bj] = (br > 0) ? *(const u32x4*)(mb + (size_t)((ai * 4 + m) * 2 + bj) * 512) : (u32x4){0u, 0u, 0u, 0u}; }
#pragma unroll
            for (int m = 0; m < 4; ++m) { const size_t r = (size_t)(row0 + ai * 128 + m * 16); u32x4 wq;
#pragma unroll
                for (int bj = 0; bj < 2; ++bj) {
                    const f32x4 v0 = acc[ai][bj][m][0], v1 = acc[ai][bj][m][1]; const u32x2 gg = g[m * 2 + bj]; const u32x4 pp = p[m * 2 + bj];
                    const float k = 1.f / 255.f;
                    const float g0 = k * (float)(gg.x & 0xffu), g1 = k * (float)((gg.x >> 8) & 0xffu), g2 = k * (float)((gg.x >> 16) & 0xffu), g3 = k * (float)(gg.x >> 24);
                    const float g4 = k * (float)(gg.y & 0xffu), g5 = k * (float)((gg.y >> 8) & 0xffu), g6 = k * (float)((gg.y >> 16) & 0xffu), g7 = k * (float)(gg.y >> 24);
                    const float o0 = v0[0] * g0 + bflo(pp.x), o1 = v0[1] * g1 + bfhi(pp.x), o2 = v0[2] * g2 + bflo(pp.y), o3 = v0[3] * g3 + bfhi(pp.y);
                    const float o4 = v1[0] * g4 + bflo(pp.z), o5 = v1[1] * g5 + bfhi(pp.z), o6 = v1[2] * g6 + bflo(pp.w), o7 = v1[3] * g7 + bfhi(pp.w);
                    if (br == 2) { const unsigned q0 = pack_fp8x4(4.f * o0, 4.f * o1, 4.f * o2, 4.f * o3), q1 = pack_fp8x4(4.f * o4, 4.f * o5, 4.f * o6, 4.f * o7); if (bj == 0) { wq.x = q0; wq.y = q1; } else { wq.z = q0; wq.w = q1; } }
                    else { u32x4 w; w.x = cvt_pk_bf16(o0, o1); w.y = cvt_pk_bf16(o2, o3); w.z = cvt_pk_bf16(o4, o5); w.w = cvt_pk_bf16(o6, o7); *(u32x4*)(mb + (size_t)((ai * 4 + m) * 2 + bj) * 512) = w; } }
                if (br == 2) *(u32x4*)(mq + r * 1024 + u.pn * 256 + 64 * wc + 16 * fq) = wq; }
            asm volatile("" ::: "memory"); }
    } };
struct SchedWout { const char* A; const char* W; int G, v;
    __device__ __forceinline__ bool next(int i, ge::Unit& u) const { const int tile = i * G + v, pm = tile >> 2, pn = tile & 3; if (tile >= 512) return false;
        u.A = A + (size_t)pm * 256 * 1024; u.B = W + (size_t)pn * 256 * 1024; u.gat = nullptr; u.lda = 1024; u.ldb = 1024; u.nt = 8; u.gshift = 0; u.nvalid = 256; u.pm = pm; u.pn = pn; u.aux = 0; return true; } };
struct EpiWout { static constexpr bool AFTER_DRAIN = false; const bf16_t* x; bf16_t* pre; float* stats;
    typedef ge::NoPre Pre; __device__ __forceinline__ Pre prefetch(const ge::Unit&, int, int, int, int) const { return Pre{}; }
    __device__ __forceinline__ void operator()(const ge::Acc& acc, const ge::Unit& u, int wr, int wc, int fr, int fq, const Pre&) const {
        const int row0 = u.pm * 256 + wr * 64 + fr; const int cb = u.pn * 256 + 64 * wc + 16 * fq; const bool odd = (fr & 1) != 0;
#pragma unroll
        for (int ai = 0; ai < 2; ++ai) {
            u32x4 xr[8];
#pragma unroll
            for (int m = 0; m < 4; ++m)
#pragma unroll
                for (int bj = 0; bj < 2; ++bj) xr[m * 2 + bj] = *(const u32x4*)(x + (size_t)(row0 + ai * 128 + m * 16) * 1024 + cb + 8 * bj);
#pragma unroll
            for (int m = 0; m < 4; ++m) { const size_t r = (size_t)(row0 + ai * 128 + m * 16); float s1 = 0.f, s2 = 0.f; u32x4 P[2];
#pragma unroll
                for (int bj = 0; bj < 2; ++bj) { const f32x4 v0 = acc[ai][bj][m][0], v1 = acc[ai][bj][m][1];
                    const u32x4 p = xr[m * 2 + bj];
                    u32x4 w; w.x = cvt_pk_bf16(v0[0] + ALPHA * bflo(p.x), v0[1] + ALPHA * bfhi(p.x)); w.y = cvt_pk_bf16(v0[2] + ALPHA * bflo(p.y), v0[3] + ALPHA * bfhi(p.y));
                    w.z = cvt_pk_bf16(v1[0] + ALPHA * bflo(p.z), v1[1] + ALPHA * bfhi(p.z)); w.w = cvt_pk_bf16(v1[2] + ALPHA * bflo(p.w), v1[3] + ALPHA * bfhi(p.w));
                    P[bj] = w;
                    const float q0 = bflo(w.x), q1 = bfhi(w.x), q2 = bflo(w.y), q3 = bfhi(w.y), q4 = bflo(w.z), q5 = bfhi(w.z), q6 = bflo(w.w), q7 = bfhi(w.w);
                    s1 += ((q0 + q1) + (q2 + q3)) + ((q4 + q5) + (q6 + q7)); s2 += ((q0 * q0 + q1 * q1) + (q2 * q2 + q3 * q3)) + ((q4 * q4 + q5 * q5) + (q6 * q6 + q7 * q7)); }
                {   u32x4 A, B; pair_rows(P[0], P[1], odd, A, B);
                    bf16_t* pp = pre + (r - (odd ? 1 : 0)) * 1024 + cb + (odd ? 8 : 0); *(u32x4*)pp = A; *(u32x4*)(pp + 1024) = B; }
                s1 += __shfl_xor(s1, 16); s2 += __shfl_xor(s2, 16); s1 += __shfl_xor(s1, 32); s2 += __shfl_xor(s2, 32);
                if (fq == 0) *(f32x2*)(stats + (r * 16 + u.pn * 4 + wc) * 2) = (f32x2){s1, s2}; }
            asm volatile("" ::: "memory"); }
    } };
struct SchedRouter { const char* A; const char* W; int G, v;
    __device__ __forceinline__ bool next(int i, ge::Unit& u) const { const int pm = i * G + v; if (pm >= 128) return false;
        u.A = A + (size_t)pm * 256 * 2048; u.B = W; u.gat = nullptr; u.lda = 2048; u.ldb = 2048; u.nt = 16; u.gshift = 0; u.nvalid = 256; u.pm = pm; u.pn = 0; u.aux = 0; return true; } };
struct EpiRouter { static constexpr bool AFTER_DRAIN = true; const float* rbias; unsigned* cnt; int* list; const float* stats; const float* rc;
    typedef ge::NoPre Pre; __device__ __forceinline__ Pre prefetch(const ge::Unit&, int, int, int, int) const { return Pre{}; }
    __device__ __forceinline__ void drained(const ge::Acc& acc, const ge::Unit& u, int wr, int wc, int fr, int fq, LAS unsigned char* lds) const {
        LAS int* lcnt = (LAS int*)lds; LAS int* lbase = lcnt + 32;
        const bool t32 = (wr == 0 && wc == 0 && fq < 2); const int t = fq * 16 + fr;
        if (t32) lcnt[t] = 0;
        __syncthreads();
        int e1[8], e2[8], r1[8], r2[8]; float g1[8], g2[8];
        const int row0 = u.pm * 256 + wr * 64 + fr;
        if (wc == 0) {
            float bias[8], c1v[8], c0v[8];
#pragma unroll
            for (int j = 0; j < 8; ++j) { bias[j] = rbias[8 * fq + j]; c1v[j] = rc[8 * fq + j]; c0v[j] = rc[32 + 8 * fq + j]; }
            f32x4 sa0[8], sa1[8];
#pragma unroll
            for (int i8 = 0; i8 < 8; ++i8) { const size_t r = (size_t)(row0 + (i8 >> 2) * 128 + (i8 & 3) * 16); sa0[i8] = *(const f32x4*)(stats + (r * 16 + 4 * fq) * 2); sa1[i8] = *(const f32x4*)(stats + (r * 16 + 4 * fq + 2) * 2); }
#pragma unroll
            for (int ai = 0; ai < 2; ++ai)
#pragma unroll
                for (int m = 0; m < 4; ++m) { const int i8 = ai * 4 + m;
                    const f32x4 v0 = acc[ai][0][m][0], v1 = acc[ai][0][m][1];
                    float mean, rstd;
                    {   const f32x4 a0 = sa0[i8], a1 = sa1[i8];
                        float s1 = (a0[0] + a0[2]) + (a1[0] + a1[2]), s2 = (a0[1] + a0[3]) + (a1[1] + a1[3]);
                        s1 += __shfl_xor(s1, 16); s2 += __shfl_xor(s2, 16); s1 += __shfl_xor(s1, 32); s2 += __shfl_xor(s2, 32);
                        mean = s1 * (1.f / 1024.f); rstd = rsqrtf(fmaxf(s2 * (1.f / 1024.f) - mean * mean, 0.f) + LN_EPS); }
                    float s[8], sel[8];
#pragma unroll
                    for (int j = 0; j < 4; ++j) { s[j] = sigmoidf_(rstd * (v0[j] - mean * c1v[j]) + c0v[j]); s[4 + j] = sigmoidf_(rstd * (v1[j] - mean * c1v[4 + j]) + c0v[4 + j]); }
#pragma unroll
                    for (int j = 0; j < 8; ++j) sel[j] = s[j] + bias[j];
                    int i1 = 0; float m1 = sel[0];
#pragma unroll
                    for (int j = 1; j < 8; ++j) if (sel[j] > m1) { m1 = sel[j]; i1 = j; }
                    int i2 = (i1 == 0) ? 1 : 0; float m2 = (i1 == 0) ? sel[1] : sel[0];
#pragma unroll
                    for (int j = 0; j < 8; ++j) if (j != i1 && j != ((i1 == 0) ? 1 : 0) && sel[j] > m2) { m2 = sel[j]; i2 = j; }
                    float gs = m1 + m2; int gi = fq;
                    { const float os = __shfl_xor(gs, 16); const int oi = __shfl_xor(gi, 16); if (os > gs || (os == gs && oi < gi)) { gs = os; gi = oi; } }
                    { const float os = __shfl_xor(gs, 32); const int oi = __shfl_xor(gi, 32); if (os > gs || (os == gs && oi < gi)) { gs = os; gi = oi; } }
                    e1[i8] = -1; e2[i8] = -1; r1[i8] = 0; r2[i8] = 0; g1[i8] = 0.f; g2[i8] = 0.f;
                    if (gi == fq) {
                        float s1 = s[0], s2 = s[0];
#pragma unroll
                        for (int j = 0; j < 8; ++j) { s1 = (j == i1) ? s[j] : s1; s2 = (j == i2) ? s[j] : s2; }
                        const float inv = 1.0f / (s1 + s2);
                        e1[i8] = 8 * fq + i1; e2[i8] = 8 * fq + i2; g1[i8] = s1 * inv; g2[i8] = s2 * inv;
                        r1[i8] = __hip_atomic_fetch_add(lcnt + e1[i8], 1, __ATOMIC_RELAXED, __HIP_MEMORY_SCOPE_WORKGROUP);
                        r2[i8] = __hip_atomic_fetch_add(lcnt + e2[i8], 1, __ATOMIC_RELAXED, __HIP_MEMORY_SCOPE_WORKGROUP); } }
        }
        __syncthreads();
        if (t32) { const int c = lcnt[t]; lbase[t] = (c > 0) ? (int)atomicAdd(cnt + t, (unsigned)c) : 0; }
        __syncthreads();
        if (wc == 0) {
#pragma unroll
            for (int i8 = 0; i8 < 8; ++i8) if (e1[i8] >= 0) { const int r = row0 + (i8 >> 2) * 128 + (i8 & 3) * 16;
                u32x2 p1, p2; p1.x = (unsigned)(2 * r); p1.y = __float_as_uint(g1[i8]); p2.x = (unsigned)(2 * r + 1); p2.y = __float_as_uint(g2[i8]);
                *(u32x2*)(list + ((size_t)e1[i8] * T + lbase[e1[i8]] + r1[i8]) * 2) = p1; *(u32x2*)(list + ((size_t)e2[i8] * T + lbase[e2[i8]] + r2[i8]) * 2) = p2; } }
        __syncthreads();
    } };
__device__ __forceinline__ int build_tile_table(Frame& F, const unsigned* cnt) {
    volatile LAS int* tab = (volatile LAS int*)(F.lds + LDS_MISC + 64);
    __syncthreads();
    if (F.wave == 0) {
        const int e = F.lane & 31; const int c = (int)__hip_atomic_load(cnt + e, __ATOMIC_RELAXED, __HIP_MEMORY_SCOPE_AGENT); const int nt = (F.lane < 32) ? ((c + 255) >> 8) : 0;
        int incl = nt;
#pragma unroll
        for (int o = 1; o < 32; o <<= 1) { const int up = __shfl_up(incl, o); if ((F.lane & 31) >= o) incl += up; }
        const int base = incl - nt;
        if (F.lane < 32) { for (int j = 0; j < nt; ++j) tab[1 + base + j] = (e << 16) | j; tab[320 + e] = c; }
        if (F.lane == 31) tab[0] = incl; }
    __syncthreads();
    return tab[0];
}
struct SchedMoe1 { const char* X1; const char* W; const int* list; const unsigned* cnt; LAS int* tab; int ntiles, G, v;
    __device__ __forceinline__ bool next(int i, ge::Unit& u) const { const int L = i * G + v, rt = L >> 2, pn = L & 3; if (rt >= ntiles) return false;
        const int ej = tab[1 + rt], e = ej >> 16, j = ej & 0xffff; const int c = tab[320 + e];
        u.A = X1; u.gat = list + ((size_t)e * T + j * 256) * 2; u.gshift = 1; u.nvalid = (c - j * 256) < 256 ? (c - j * 256) : 256; u.lda = 1024; u.nt = 8;
        u.B = W + ((size_t)e * 1024 + (size_t)pn * 256) * 1024; u.ldb = 1024; u.pm = rt; u.pn = pn; u.aux = e; return true; } };
struct EpiMoe1 { static constexpr bool AFTER_DRAIN = false; unsigned char* H;
    typedef ge::NoPre Pre; __device__ __forceinline__ Pre prefetch(const ge::Unit&, int, int, int, int) const { return Pre{}; }
    __device__ __forceinline__ void operator()(const ge::Acc& acc, const ge::Unit& u, int wr, int wc, int fr, int fq, const Pre&) const {
        const int row0 = u.pm * 256 + wr * 64 + fr;
#pragma unroll
        for (int ai = 0; ai < 2; ++ai)
#pragma unroll
            for (int m = 0; m < 4; ++m) { const size_t r = (size_t)(row0 + ai * 128 + m * 16);
                u32x2 hw;
#pragma unroll
                for (int bj = 0; bj < 2; ++bj) { const f32x4 v0 = acc[ai][bj][m][0], v1 = acc[ai][bj][m][1];
                    const float h0 = v0[0] * sigmoidf_(v0[0]) * v0[1], h1 = v0[2] * sigmoidf_(v0[2]) * v0[3], h2 = v1[0] * sigmoidf_(v1[0]) * v1[1], h3 = v1[2] * sigmoidf_(v1[2]) * v1[3];
                    const unsigned q = pack_fp8x4(h0, h1, h2, h3); if (bj == 0) hw.x = q; else hw.y = q; }
                *(u32x2*)(H + r * 512 + u.pn * 128 + 32 * wc + 8 * fq) = hw;
                asm volatile("" ::: "memory"); }
    } };
struct SchedMoe2 { const char* H; const char* W; const int* list; const unsigned* cnt; LAS int* tab; int ntiles, G, v, ntk;
    __device__ __forceinline__ bool next(int i, ge::Unit& u) const { const int L = i * G + v, rt = L >> 2, pn = L & 3; if (rt >= ntiles) return false;
        const int ej = tab[1 + rt], e = ej >> 16, j = ej & 0xffff; const int c = tab[320 + e];
        u.A = H + (size_t)rt * 256 * 512; u.gat = nullptr; u.gshift = 0; u.nvalid = (c - j * 256) < 256 ? (c - j * 256) : 256; u.lda = 512; u.nt = ntk;
        u.B = W + ((size_t)e * 1024 + (size_t)pn * 256) * 512; u.ldb = 512; u.pm = rt; u.pn = pn; u.aux = (e << 16) | j; return true; } };
template <int MODE> struct EpiMoe2T { static constexpr bool AFTER_DRAIN = false; const int* list; unsigned char* Y; int* inv;
    typedef ge::NoPre Pre; __device__ __forceinline__ Pre prefetch(const ge::Unit&, int, int, int, int) const { return Pre{}; }
    __device__ __forceinline__ void operator()(const ge::Acc& acc, const ge::Unit& u, int wr, int wc, int fr, int fq, const Pre&) const {
        const int e = u.aux >> 16, j = u.aux & 0xffff; const int* lst = list + ((size_t)e * T + j * 256) * 2;
        const unsigned row0 = (unsigned)u.pm * 256u + (unsigned)(wr * 64 + fr); const unsigned col0 = (unsigned)(u.pn * 256 + 64 * wc + 16 * fq);
        const bool invw = (u.pn == 0 && wc == 0 && fq == 0);
        u32x2 sgall[8];
#pragma unroll
        for (int i8 = 0; i8 < 8; ++i8) { const int rr = (i8 >> 2) * 128 + wr * 64 + (i8 & 3) * 16 + fr; const u32x2 v = *(const u32x2*)(lst + 2 * (rr < u.nvalid ? rr : 0)); sgall[i8].x = (rr < u.nvalid) ? v.x : 0xffffffffu; sgall[i8].y = v.y; }
#pragma unroll
        for (int ai = 0; ai < 2; ++ai) {
            u32x2 sg[4];
#pragma unroll
            for (int m = 0; m < 4; ++m) sg[m] = sgall[ai * 4 + m];
#pragma unroll
            for (int m = 0; m < 4; ++m) { const int sl = (int)sg[m].x; const float gg = __uint_as_float(sg[m].y);
                const unsigned yrow = row0 + (unsigned)(ai * 128 + m * 16);
                if (MODE == 1) { if (sl == 0x7ffffff0) Y[0] = (unsigned char)pack_fp8x4(acc[ai][0][m][0][0] * gg, 0.f, 0.f, 0.f); }
                else if (sl >= 0) {
                    if (invw) inv[sl] = (int)yrow;
                    const float g8 = 8.f * gg; u32x4 w;
                    {   const f32x4 v0 = acc[ai][0][m][0], v1 = acc[ai][0][m][1], v2 = acc[ai][1][m][0], v3 = acc[ai][1][m][1];
                        w.x = pack_fp8x4(g8 * v0[0], g8 * v0[1], g8 * v0[2], g8 * v0[3]); w.y = pack_fp8x4(g8 * v1[0], g8 * v1[1], g8 * v1[2], g8 * v1[3]);
                        w.z = pack_fp8x4(g8 * v2[0], g8 * v2[1], g8 * v2[2], g8 * v2[3]); w.w = pack_fp8x4(g8 * v3[0], g8 * v3[1], g8 * v3[2], g8 * v3[3]); }
                    *(u32x4*)(Y + (yrow * 1024u + col0)) = w; } }
            asm volatile("" ::: "memory"); }
    } };
typedef EpiMoe2T<0> EpiMoe2;
typedef short bf16x4 __attribute__((ext_vector_type(4)));
#define MFMA16(a, b, c) __builtin_amdgcn_mfma_f32_16x16x16bf16_1k(a, b, c, 0, 0, 0)
#define MFMA32(a, b, c) __builtin_amdgcn_mfma_f32_16x16x32_bf16(a, b, c, 0, 0, 0)
__device__ __forceinline__ bf16x4 pack4(const f32x4 v) { u32x2 w; w.x = cvt_pk_bf16(v[0], v[1]); w.y = cvt_pk_bf16(v[2], v[3]); return __builtin_bit_cast(bf16x4, w); }
__device__ __forceinline__ f32x4 unpack4(const u32x2 w) { return (f32x4){bflo(w.x), bfhi(w.x), bflo(w.y), bfhi(w.y)}; }
constexpr int TP = 72;
constexpr int TILE_B = 64 * TP * 2;
constexpr int LA_ACT = 0;
constexpr int LA_AT = 13312, LA_RT = LA_AT + TILE_B, LA_BT = LA_RT + TILE_B, LA_KT = LA_BT + TILE_B;
constexpr int LA_BTT = LA_KT + TILE_B, LA_KTT = LA_BTT + TILE_B, LA_VT = LA_KTT + TILE_B;
constexpr int LA_AAB = LA_VT + TILE_B, LA_AAK = LA_AAB + TILE_B, LA_ARB = LA_AAK + TILE_B, LA_ARK = LA_ARB + TILE_B;
constexpr int LA_DIAG = LA_ARK + TILE_B;
constexpr int LA_TII = LA_DIAG + 4096;
constexpr int LA_SEG = LA_TII + 3072;
constexpr int LA_KSQ = LA_SEG + 4096;
constexpr int LA_RKP = LA_KSQ + 1024;
constexpr int LA_PC = LA_RKP + 1024;
static_assert(LA_PC + 256 <= LDS_STAGE, "pass A LDS map");

template <bool EONLY> __device__ __forceinline__ void phase_wkv_a(Frame& F, const Params& P, int l) {
    LAS unsigned char* lds = F.lds;
    const bf16_t* rkv = WSP(bf16_t, WS_RKV);
    const bf16_t* wupT = WSP(bf16_t, WS_LORA) + (size_t)l * 512 * 32;
    const bf16_t* aupT = WSP(bf16_t, WS_LORA) + (size_t)(4 + l) * 512 * 32;
    const bf16_t* vupT = WSP(bf16_t, WS_LORA) + (size_t)(8 + (l > 0 ? l - 1 : 0)) * 512 * 32;
    const float* mu = P.in[3] + (size_t)l * 1696; const float* muv = (l > 0) ? P.in[4] + (size_t)(l - 1) * 32 : nullptr;
    bf16_t* PHI = WSP(bf16_t, WS_PHI); bf16_t* PSI = WSP(bf16_t, WS_PSI); bf16_t* GT = WSP(bf16_t, WS_GT); bf16_t* Y0T = WSP(bf16_t, WS_Y0T); bf16_t* VT = WSP(bf16_t, WS_VT); bf16_t* VF = WSP(bf16_t, WS_VFIRST);
    float* RK = WSP(float, WS_RK);
    const int lane = F.lane, w = F.wave, cb = w & 3, th = w >> 2;
#define WKVA_RAW_LOAD(dst, hn) do { _Pragma("unroll") for (int i_ = 0; i_ < 4; ++i_) { const int p_ = F.tid + 512 * i_; const int pc_ = p_ < 1560 ? p_ : 1559; const int row_ = pc_ / 24, rem_ = pc_ % 24; \
        const int tok_ = (row_ == 0 && firstchunk) ? t0 : t0 - 1 + row_; dst[i_] = *(const u32x4*)(rkv + (size_t)tok_ * RKVW + (rem_ >> 3) * 512 + (hn) * 64 + (rem_ & 7) * 8); } } while (0)
#define WKVA_RAW_STORE(src) do { _Pragma("unroll") for (int i_ = 0; i_ < 4; ++i_) { const int p_ = F.tid + 512 * i_; if (p_ < 1560) { const int row_ = p_ / 24, rem_ = p_ % 24; \
        *(LAS u32x4*)(lds + LDS_RAW + (row_ * 192 + (rem_ >> 3) * 64 + (rem_ & 7) * 8) * 2) = src[i_]; } } } while (0)
    for (int unit = blockIdx.x; unit < T / 64; unit += F.G) {
        const int t0 = unit * 64; const bool firstchunk = (t0 & (SEQ - 1)) == 0;
        __syncthreads();
        { u32x4 r0_[4]; WKVA_RAW_LOAD(r0_, 0); WKVA_RAW_STORE(r0_); }
        {   int tz_ = F.tid; asm volatile("" : "+v"(tz_)); const int qq = tz_ % 96, g = tz_ / 96;
            if (g < 5) {
                const int col = (qq < 64) ? 1536 + qq : 1536 + 96 + qq;
                const float m_ = (qq < 64) ? mu[1536 + qq] : ((l > 0) ? P.in[4][(size_t)(l > 0 ? l - 1 : 0) * 32 + qq - 64] : 0.f);
                const int lo_ = firstchunk ? 0 : -1; bf16_t raw_[14];
#pragma unroll
                for (int j = 0; j < 14; ++j) { int tok = 13 * g - 1 + j; tok = tok < lo_ ? lo_ : (tok > 63 ? 63 : tok); raw_[j] = rkv[(size_t)(t0 + tok) * RKVW + col]; }
#pragma unroll
                for (int j = 1; j < 14; ++j) { const int tok = 13 * g - 1 + j;
                    if (tok < 64) { const float p = bf2f(raw_[j]); const float pp = (tok > 0 || !firstchunk) ? bf2f(raw_[j - 1]) : 0.f;
                        float val = p + (pp - p) * m_; if (qq < 32) val = tanhf(val);
                        *(LAS bf16_t*)(lds + LA_ACT + (tok * 104 + qq) * 2) = f2bf(val); } } } }
        __syncthreads();
        for (int h = 0; h < 8; ++h) {
            int lz = lane; asm volatile("" : "+v"(lz)); const int c = lz & 15, q = lz >> 4;
            const int chid = unit * 8 + h; const int ch = 16 * cb + c, chg = h * 64 + ch;
            f32x4 zw[2], za[2], zv[2];
            {   const bf16x8 bw = *(const bf16x8*)(wupT + (size_t)chg * 32 + 8 * q), ba = *(const bf16x8*)(aupT + (size_t)chg * 32 + 8 * q), bv = *(const bf16x8*)(vupT + (size_t)chg * 32 + 8 * q);
#pragma unroll
                for (int ii = 0; ii < 2; ++ii) { const int i = 2 * th + ii; const LAS unsigned char* ar = lds + LA_ACT + ((16 * i + c) * 104 + 8 * q) * 2;
                    const bf16x8 a0 = *(const LAS bf16x8*)(ar), a1 = *(const LAS bf16x8*)(ar + 64), a2 = *(const LAS bf16x8*)(ar + 128);
                    const f32x4 z = {0.f, 0.f, 0.f, 0.f};
                    zw[ii] = MFMA32(a0, bw, z); za[ii] = MFMA32(a1, ba, z); zv[ii] = MFMA32(a2, bv, z); } }
            const float* pp_ = WSP(float, WS_WKVPAR) + ((size_t)l * 512 + chg) * 12;
            const f32x4 pa_ = *(const f32x4*)pp_, pb_ = *(const f32x4*)(pp_ + 4); const float r_k = pp_[8];
            const float mu_r = pa_[0], mu_k = pa_[1], mu_v = pa_[2], w0 = pa_[3], a0_ = pb_[0], v0_ = pb_[1], k_k = pb_[2], k_a = pb_[3];
            float rr[2][4], kh[2][4], vv[2][4], lw[2][4], ic[2][4], kkr[2][4];
#pragma unroll
            for (int ii = 0; ii < 2; ++ii) { const int i = 2 * th + ii; const int tl0 = 16 * i + 4 * q;
                const bool hasprev = (tl0 > 0) || !firstchunk;
                const LAS unsigned char* rb = lds + LDS_RAW + (tl0 * 192 + ch) * 2;
                const float lpr = bf2f(*(const LAS bf16_t*)(rb)), lpk = bf2f(*(const LAS bf16_t*)(rb + 128)), lpv = bf2f(*(const LAS bf16_t*)(rb + 256));
                float pr = hasprev ? lpr : 0.f, pk = hasprev ? lpk : 0.f, pv = hasprev ? lpv : 0.f;
                f32x4 vf = {0.f, 0.f, 0.f, 0.f};
                if (l > 0) vf = unpack4(*(const u32x2*)(VF + (size_t)chid * 4096 + ((cb * 4 + i) * 64 + lz) * 4));
                float lsum = 0.f;
#pragma unroll
                for (int r = 0; r < 4; ++r) { const LAS unsigned char* rc_ = rb + (r + 1) * 384; const float cr = bf2f(*(const LAS bf16_t*)(rc_)), ck = bf2f(*(const LAS bf16_t*)(rc_ + 128)), cv = bf2f(*(const LAS bf16_t*)(rc_ + 256));
                    const float r_ = cr + (pr - cr) * mu_r, k_ = ck + (pk - ck) * mu_k; float v_ = cv + (pv - cv) * mu_v; pr = cr; pk = ck; pv = cv;
                    const float lw_ = -0.6065306597126334f * sigmoidf_(w0 + zw[ii][r]); const float icl = sigmoidf_(a0_ + za[ii][r]);
                    if (l > 0) v_ = v_ + (vf[r] - v_) * sigmoidf_(v0_ + zv[ii][r]);
                    const float kk_ = k_ * k_k, kh_ = k_ * (1.0f + (icl - 1.0f) * k_a);
                    rr[ii][r] = r_; kh[ii][r] = kh_; vv[ii][r] = v_; lw[ii][r] = lw_; ic[ii][r] = icl; kkr[ii][r] = kk_; lsum += lw_;
                    const float s1 = row16_sum(kk_ * kk_), s2 = row16_sum(r_ * kh_ * r_k);
                    *(LAS float*)(lds + LA_KSQ + (cb * 64 + tl0 + r) * 4) = s1; *(LAS float*)(lds + LA_RKP + (cb * 64 + tl0 + r) * 4) = s2; }
                *(LAS float*)(lds + LA_SEG + (ch * 16 + i * 4 + q) * 4) = lsum; }
            __syncthreads();
            u32x4 nraw[4]; if (h < 7) WKVA_RAW_LOAD(nraw, h + 1);
            {   float seg[16];
#pragma unroll
                for (int j4 = 0; j4 < 4; ++j4) { const f32x4 s4 = *(const LAS f32x4*)(lds + LA_SEG + (ch * 16 + 4 * j4) * 4); seg[4 * j4] = s4[0]; seg[4 * j4 + 1] = s4[1]; seg[4 * j4 + 2] = s4[2]; seg[4 * j4 + 3] = s4[3]; }
                float tot = 0.f;
#pragma unroll
                for (int j = 0; j < 16; ++j) tot += seg[j];
                if (th == 0) *(LAS float*)(lds + LA_PC + ch * 4) = __expf(tot);
                float mine[8];
#pragma unroll
                for (int j = 0; j < 8; ++j) mine[j] = th ? seg[8 + j] : seg[j];
                const float firsthalf = th ? (((seg[0] + seg[1]) + (seg[2] + seg[3])) + ((seg[4] + seg[5]) + (seg[6] + seg[7]))) : 0.f;
#pragma unroll
                for (int ii = 0; ii < 2; ++ii) { const int i = 2 * th + ii; const int tl0 = 16 * i + 4 * q; const int sidx = i * 4 + q;
                    float cum = firsthalf + (ii ? ((mine[0] + mine[1]) + (mine[2] + mine[3])) : 0.f);
                    { const float s0 = mine[4 * ii], s1 = mine[4 * ii + 1], s2 = mine[4 * ii + 2]; cum += (q > 0 ? s0 : 0.f) + (q > 1 ? s1 : 0.f) + (q > 2 ? s2 : 0.f); }
                    f32x4 at, rt, bt, kt;
#pragma unroll
                    for (int r = 0; r < 4; ++r) { const int tl = tl0 + r;
                        const float ks = (*(const LAS float*)(lds + LA_KSQ + tl * 4) + *(const LAS float*)(lds + LA_KSQ + (64 + tl) * 4)) + (*(const LAS float*)(lds + LA_KSQ + (128 + tl) * 4) + *(const LAS float*)(lds + LA_KSQ + (192 + tl) * 4));
                        const float kk_ = kkr[ii][r] * __builtin_amdgcn_rsqf(fmaxf(ks, 1e-24f));
                        const float cumx = cum; cum += lw[ii][r];
                        const float ex = __expf(cumx), ei = __expf(cum), en = __expf(-cum);
                        at[r] = -kk_ * ex; rt[r] = rr[ii][r] * ei; bt[r] = kk_ * ic[ii][r] * en; kt[r] = kh[ii][r] * en;

                        *(LAS bf16_t*)(lds + LA_AT + (tl * TP + ch) * 2) = f2bf(at[r]); *(LAS bf16_t*)(lds + LA_RT + (tl * TP + ch) * 2) = f2bf(rt[r]);
                        *(LAS bf16_t*)(lds + LA_BT + (tl * TP + ch) * 2) = f2bf(bt[r]); *(LAS bf16_t*)(lds + LA_KT + (tl * TP + ch) * 2) = f2bf(kt[r]);
                        if (cb == 0) { const float rk = (*(const LAS float*)(lds + LA_RKP + tl * 4) + *(const LAS float*)(lds + LA_RKP + (64 + tl) * 4)) + (*(const LAS float*)(lds + LA_RKP + (128 + tl) * 4) + *(const LAS float*)(lds + LA_RKP + (192 + tl) * 4));
                            if (c == 0) RK[(size_t)(t0 + tl) * 8 + h] = rk; } }
                    const f32x4 v4 = {vv[ii][0], vv[ii][1], vv[ii][2], vv[ii][3]};
                    *(LAS bf16x4*)(lds + LA_BTT + (ch * TP + tl0) * 2) = pack4(bt); *(LAS bf16x4*)(lds + LA_KTT + (ch * TP + tl0) * 2) = pack4(kt); *(LAS bf16x4*)(lds + LA_VT + (ch * TP + tl0) * 2) = pack4(v4);
                    *(bf16x4*)(VT + (size_t)chid * 4096 + ((cb * 4 + i) * 64 + lz) * 4) = pack4(v4);
                    if (l == 0) *(bf16x4*)(VF + (size_t)chid * 4096 + ((cb * 4 + i) * 64 + lz) * 4) = pack4(v4); } }
            __syncthreads();
            if (EONLY) { if (h < 7) WKVA_RAW_STORE(nraw); __syncthreads(); continue; }
            {   const bool isR = w >= 4; const int i = w & 3;
                const LAS unsigned char* brow = lds + (isR ? LA_RT : LA_AT) + ((16 * i + c) * TP + 8 * q) * 2;
                const bf16x8 bf0 = *(const LAS bf16x8*)(brow), bf1 = *(const LAS bf16x8*)(brow + 64);
                LAS unsigned char* ob = lds + (isR ? LA_ARB : LA_AAB); LAS unsigned char* ok = lds + (isR ? LA_ARK : LA_AAK);
                const int tloc = 16 * i + c;
#pragma unroll
                for (int j = 0; j < 4; ++j) { f32x4 db = {0.f, 0.f, 0.f, 0.f}, dk = {0.f, 0.f, 0.f, 0.f};
                    if (j <= i) { const LAS unsigned char* arb = lds + LA_BT + ((16 * j + c) * TP + 8 * q) * 2; const LAS unsigned char* ark = lds + LA_KT + ((16 * j + c) * TP + 8 * q) * 2;
                        db = MFMA32(*(const LAS bf16x8*)(arb), bf0, db); db = MFMA32(*(const LAS bf16x8*)(arb + 64), bf1, db);
                        dk = MFMA32(*(const LAS bf16x8*)(ark), bf0, dk); dk = MFMA32(*(const LAS bf16x8*)(ark + 64), bf1, dk);
                        if (j == i) {
#pragma unroll
                            for (int r = 0; r < 4; ++r) { const int s = 16 * j + 4 * q + r; const bool keep = isR ? (s <= tloc) : (s < tloc); db[r] = keep ? db[r] : 0.f; dk[r] = keep ? dk[r] : 0.f; }
                            if (!isR) *(LAS f32x4*)(lds + LA_DIAG + ((i * 16 + c) * 16 + 4 * q) * 4) = db; } }

                    *(LAS bf16x4*)(ob + (tloc * TP + 16 * j + 4 * q) * 2) = pack4(db); *(LAS bf16x4*)(ok + (tloc * TP + 16 * j + 4 * q) * 2) = pack4(dk); } }
            __syncthreads();
            f32x4 X[4];
            if (w == 0) { const int blk = q, jc = c; float tc[16];
                f32x4 Lr[15][4];
#pragma unroll
                for (int t = 1; t < 16; ++t)
#pragma unroll
                    for (int s4 = 0; s4 < 4; ++s4) if (4 * s4 < t) Lr[t - 1][s4] = *(const LAS f32x4*)(lds + LA_DIAG + ((blk * 16 + t) * 16 + 4 * s4) * 4);
                __builtin_amdgcn_sched_barrier(0);
#pragma unroll
                for (int s = 0; s < 16; ++s) tc[s] = (s == jc) ? 1.f : 0.f;
#pragma unroll
                for (int t = 1; t < 16; ++t) { float val = 0.f;
#pragma unroll
                    for (int s4 = 0; s4 < 4; ++s4) if (4 * s4 < t) { const f32x4 L = Lr[t - 1][s4];
#pragma unroll
                        for (int e = 0; e < 4; ++e) if (4 * s4 + e < t) val += L[e] * tc[4 * s4 + e]; }
                    tc[t] += val; }
#pragma unroll
                for (int t = 0; t < 16; ++t) { *(LAS bf16_t*)(lds + LA_TII + ((blk * 16 + t) * 24 + jc) * 2) = f2bf(tc[t]); } }
            if (w < 4) {
#pragma unroll
                for (int i = 0; i < 4; ++i)
#pragma unroll
                    for (int r = 0; r < 4; ++r) X[i][r] = bf2f(*(const LAS bf16_t*)(lds + LA_AT + ((16 * i + 4 * q + r) * TP + 16 * w + c) * 2));
            } else { const int vb = w - 4; const LAS unsigned char* vrow = lds + LA_VT + ((16 * vb + c) * TP + 8 * q) * 2;
                const bf16x8 v0 = *(const LAS bf16x8*)(vrow), v1 = *(const LAS bf16x8*)(vrow + 64);
#pragma unroll
                for (int i = 0; i < 4; ++i) { const LAS unsigned char* arow = lds + LA_AAK + ((16 * i + c) * TP + 8 * q) * 2; f32x4 d = {0.f, 0.f, 0.f, 0.f};
                    d = MFMA32(*(const LAS bf16x8*)(arow), v0, d); d = MFMA32(*(const LAS bf16x8*)(arow + 64), v1, d); X[i] = d; } }

            __syncthreads();
            bf16x4 Xb[4];
            {   bf16x4 Af[6], Tf[4];
#pragma unroll
                for (int i = 1; i < 4; ++i)
#pragma unroll
                    for (int j = 0; j < 3; ++j) if (j < i) Af[(i * (i - 1)) / 2 + j] = *(const LAS bf16x4*)(lds + LA_AAB + ((16 * i + c) * TP + 16 * j + 4 * q) * 2);
#pragma unroll
                for (int i = 0; i < 4; ++i) Tf[i] = *(const LAS bf16x4*)(lds + LA_TII + ((i * 16 + c) * 24 + 4 * q) * 2);
                __builtin_amdgcn_sched_barrier(0);
#pragma unroll
                for (int i = 0; i < 4; ++i) { f32x4 y = X[i];
#pragma unroll
                    for (int j = 0; j < 3; ++j) if (j < i) y = MFMA16(Af[(i * (i - 1)) / 2 + j], Xb[j], y);
                    const f32x4 z = {0.f, 0.f, 0.f, 0.f};
                    X[i] = MFMA16(Tf[i], pack4(y), z); Xb[i] = pack4(X[i]); } }

            if (w < 4) {
                {   bf16x4 Bf[16]; float pcv[4];
#pragma unroll
                    for (int kb = 0; kb < 4; ++kb) { pcv[kb] = *(const LAS float*)(lds + LA_PC + (16 * kb + c) * 4);
#pragma unroll
                        for (int j = 0; j < 4; ++j) Bf[kb * 4 + j] = *(const LAS bf16x4*)(lds + LA_BTT + ((16 * kb + c) * TP + 16 * j + 4 * q) * 2); }
                    __builtin_amdgcn_sched_barrier(0);
#pragma unroll
                    for (int kb = 0; kb < 4; ++kb) { f32x4 d = {0.f, 0.f, 0.f, 0.f};
#pragma unroll
                        for (int j = 0; j < 4; ++j) d = MFMA16(Xb[j], Bf[kb * 4 + j], d);
                        const int ko = 16 * kb + c; const float pc = pcv[kb];
#pragma unroll
                        for (int r = 0; r < 4; ++r) d[r] = pc * (d[r] + ((16 * w + 4 * q + r) == ko ? 1.f : 0.f));

                        *(bf16x4*)(PHI + (size_t)chid * 4096 + ((kb * 4 + w) * 64 + lz) * 4) = pack4(d); } }
                {   bf16x4 Rf[16]; u32x2 Rt[4];
#pragma unroll
                    for (int tb = 0; tb < 4; ++tb) { Rt[tb] = *(const LAS u32x2*)(lds + LA_RT + ((16 * tb + c) * TP + 16 * w + 4 * q) * 2);
#pragma unroll
                        for (int j = 0; j < 4; ++j) Rf[tb * 4 + j] = *(const LAS bf16x4*)(lds + LA_ARB + ((16 * tb + c) * TP + 16 * j + 4 * q) * 2); }
                    __builtin_amdgcn_sched_barrier(0);
#pragma unroll
                    for (int tb = 0; tb < 4; ++tb) { f32x4 d = unpack4(Rt[tb]);
#pragma unroll
                        for (int j = 0; j < 4; ++j) d = MFMA16(Xb[j], Rf[tb * 4 + j], d);
                        *(bf16x4*)(PSI + (size_t)chid * 4096 + ((tb * 4 + w) * 64 + lz) * 4) = pack4(d); } }
            } else { const int vb = w - 4;
                bf16x4 Vb[4];
#pragma unroll
                for (int j = 0; j < 4; ++j) Vb[j] = *(const LAS bf16x4*)(lds + LA_VT + ((16 * vb + c) * TP + 16 * j + 4 * q) * 2);
                {   bf16x4 Bf[16], Kf[16]; f32x4 pcv[4];
#pragma unroll
                    for (int kb = 0; kb < 4; ++kb) { pcv[kb] = *(const LAS f32x4*)(lds + LA_PC + (16 * kb + 4 * q) * 4);
#pragma unroll
                        for (int j = 0; j < 4; ++j) { Bf[kb * 4 + j] = *(const LAS bf16x4*)(lds + LA_BTT + ((16 * kb + c) * TP + 16 * j + 4 * q) * 2); Kf[kb * 4 + j] = *(const LAS bf16x4*)(lds + LA_KTT + ((16 * kb + c) * TP + 16 * j + 4 * q) * 2); } }
                    __builtin_amdgcn_sched_barrier(0);
#pragma unroll
                    for (int kb = 0; kb < 4; ++kb) { f32x4 d = {0.f, 0.f, 0.f, 0.f};
#pragma unroll
                        for (int j = 0; j < 4; ++j) { d = MFMA16(Bf[kb * 4 + j], Xb[j], d); d = MFMA16(Kf[kb * 4 + j], Vb[j], d); }
                        *(bf16x4*)(GT + (size_t)chid * 4096 + ((vb * 4 + kb) * 64 + lz) * 4) = pack4(d * pcv[kb]); } }
                {   bf16x4 Rf[16], Kf[16];
#pragma unroll
                    for (int tb = 0; tb < 4; ++tb)
#pragma unroll
                        for (int j = 0; j < 4; ++j) { Rf[tb * 4 + j] = *(const LAS bf16x4*)(lds + LA_ARB + ((16 * tb + c) * TP + 16 * j + 4 * q) * 2); Kf[tb * 4 + j] = *(const LAS bf16x4*)(lds + LA_ARK + ((16 * tb + c) * TP + 16 * j + 4 * q) * 2); }
                    __builtin_amdgcn_sched_barrier(0);
#pragma unroll
                    for (int tb = 0; tb < 4; ++tb) { f32x4 d = {0.f, 0.f, 0.f, 0.f};
#pragma unroll
                        for (int j = 0; j < 4; ++j) { d = MFMA16(Rf[tb * 4 + j], Xb[j], d); d = MFMA16(Kf[tb * 4 + j], Vb[j], d); }
                        *(bf16x4*)(Y0T + (size_t)chid * 4096 + ((vb * 4 + tb) * 64 + lz) * 4) = pack4(d); } } }
            if (h < 7) WKVA_RAW_STORE(nraw);
            __syncthreads();
        }
    }
#undef WKVA_RAW_LOAD
#undef WKVA_RAW_STORE
}
__device__ __forceinline__ void phase_wkv_b(Frame& F, const Params& P) {
    const bf16_t* PHI = WSP(bf16_t, WS_PHI); const bf16_t* GT = WSP(bf16_t, WS_GT); bf16_t* MT = WSP(bf16_t, WS_MT);
    LAS unsigned char* lds = F.lds;
    const int lane = F.lane, c = lane & 15, q = lane >> 4, w = F.wave, tid = F.tid;
    const int pair = w >> 2, vb = w & 3; const int bh = (int)blockIdx.x * 2 + pair, b = bh >> 3, h = bh & 7;
    f32x4 M[4];
#pragma unroll
    for (int i = 0; i < 4; ++i) M[i] = (f32x4){0.f, 0.f, 0.f, 0.f};
    u32x4 rA[4], rB[4], rC[4], rD[4];
#define WKVB_LD(r_, ckk) do { const int ck_ = (ckk) < 32 ? (ckk) : 31; _Pragma("unroll") for (int ti = 0; ti < 4; ++ti) { const int bh_ = (int)blockIdx.x * 2 + (ti >> 1); \
        const size_t chl_ = (size_t)((bh_ >> 3) * 32 + ck_) * 8 + (bh_ & 7); r_[ti] = *(const u32x4*)(((ti & 1) ? GT : PHI) + chl_ * 4096 + (size_t)tid * 8); } } while (0)
#define WKVB_ST(r_, buf) do { _Pragma("unroll") for (int ti = 0; ti < 4; ++ti) *(LAS u32x4*)(lds + ((buf) * 4 + ti) * TILE_B + tid * 16) = r_[ti]; } while (0)
#define WKVB_STEP(buf, ckk) do { const size_t chs_ = (size_t)(b * 32 + (ckk)) * 8 + h; bf16x4 Mb[4]; \
        const LAS unsigned char* tp_ = lds + ((buf) * 4 + pair * 2) * TILE_B; const LAS unsigned char* tg_ = tp_ + TILE_B; \
        _Pragma("unroll") for (int i = 0; i < 4; ++i) { Mb[i] = pack4(M[i]); *(bf16x4*)(MT + chs_ * 4096 + ((vb * 4 + i) * 64 + lane) * 4) = Mb[i]; } \
        _Pragma("unroll") for (int i = 0; i < 4; ++i) { f32x4 d = unpack4(*(const LAS u32x2*)(tg_ + ((vb * 4 + i) * 64 + lane) * 8)); \
            _Pragma("unroll") for (int j = 0; j < 4; ++j) d = MFMA16(*(const LAS bf16x4*)(tp_ + ((i * 4 + j) * 64 + lane) * 8), Mb[j], d); M[i] = d; } } while (0)
    WKVB_LD(rA, 0); WKVB_LD(rB, 1); WKVB_LD(rC, 2); WKVB_LD(rD, 3);
    __builtin_amdgcn_s_waitcnt(0x0F70);
    __syncthreads();
    for (int ck = 0; ck < 32; ck += 4) {
        WKVB_ST(rA, 0); __syncthreads(); WKVB_LD(rA, ck + 4); WKVB_STEP(0, ck);
        WKVB_ST(rB, 1); __syncthreads(); WKVB_LD(rB, ck + 5); WKVB_STEP(1, ck + 1);
        WKVB_ST(rC, 0); __syncthreads(); WKVB_LD(rC, ck + 6); WKVB_STEP(0, ck + 2);
        WKVB_ST(rD, 1); __syncthreads(); WKVB_LD(rD, ck + 7); WKVB_STEP(1, ck + 3);
    }
    __syncthreads();
#undef WKVB_LD
#undef WKVB_ST
#undef WKVB_STEP
}
constexpr int LC_SGL = 0;
constexpr int LC_OT = 13312;
__device__ __forceinline__ void phase_wkv_c(Frame& F, const Params& P, int l) {
    LAS unsigned char* lds = F.lds;
    const bf16_t* rkv = WSP(bf16_t, WS_RKV);
    const bf16_t* gupT = WSP(bf16_t, WS_LORA) + (size_t)11 * 512 * 32 + (size_t)l * 512 * 96;
    const bf16_t* PSI = WSP(bf16_t, WS_PSI); const bf16_t* Y0T = WSP(bf16_t, WS_Y0T); const bf16_t* VT = WSP(bf16_t, WS_VT); const bf16_t* MT = WSP(bf16_t, WS_MT);
    const float* RK = WSP(float, WS_RK); unsigned char* outa = WSP(unsigned char, WS_OUTA);
    const float* mu = P.in[3] + (size_t)l * 1696;
    const int lane = F.lane, h = F.wave;
    LAS unsigned char* ot = lds + LC_OT + h * TILE_B;
    for (int unit = blockIdx.x; unit < T / 64; unit += F.G) {
        int lz = lane; asm volatile("" : "+v"(lz)); const int c = lz & 15, q = lz >> 4;
        float gng[4], gnb[4];
#pragma unroll
        for (int vb = 0; vb < 4; ++vb) { gng[vb] = P.in[15][(size_t)l * 512 + h * 64 + 16 * vb + c]; gnb[vb] = P.in[16][(size_t)l * 512 + h * 64 + 16 * vb + c]; }
        const int t0 = unit * 64; const bool firstchunk = (t0 & (SEQ - 1)) == 0; const size_t chid = (size_t)unit * 8 + h;
        __syncthreads();
        float rkv_[16];
#pragma unroll
        for (int i = 0; i < 16; ++i) rkv_[i] = RK[(size_t)(t0 + 16 * (i >> 2) + 4 * q + (i & 3)) * 8 + h];
        bf16x4 Mf[16];
#pragma unroll
        for (int j = 0; j < 4; ++j)
#pragma unroll
            for (int vb = 0; vb < 4; ++vb) Mf[j * 4 + vb] = *(const bf16x4*)(MT + chid * 4096 + ((vb * 4 + j) * 64 + lz) * 4);
        bf16x8 Gf[12];
#pragma unroll
        for (int vb = 0; vb < 4; ++vb)
#pragma unroll
            for (int ks = 0; ks < 3; ++ks) Gf[vb * 3 + ks] = *(const bf16x8*)(gupT + (size_t)(h * 64 + 16 * vb + c) * 96 + 32 * ks + 8 * q);
        {   int tz_ = F.tid; asm volatile("" : "+v"(tz_)); const int qq = tz_ % 96, g = tz_ / 96;
            if (g < 5) { const int col = 1536 + 64 + qq; const float m_ = mu[1536 + 64 + qq];
                const int lo_ = firstchunk ? 0 : -1; bf16_t raw_[14];
#pragma unroll
                for (int j = 0; j < 14; ++j) { int tok = 13 * g - 1 + j; tok = tok < lo_ ? lo_ : (tok > 63 ? 63 : tok); raw_[j] = rkv[(size_t)(t0 + tok) * RKVW + col]; }
#pragma unroll
                for (int j = 1; j < 14; ++j) { const int tok = 13 * g - 1 + j;
                    if (tok < 64) { const float p = bf2f(raw_[j]); const float pp = (tok > 0 || !firstchunk) ? bf2f(raw_[j - 1]) : 0.f;
                        *(LAS bf16_t*)(lds + LC_SGL + (tok * 104 + qq) * 2) = f2bf(sigmoidf_(p + (pp - p) * m_)); } } } }
        __syncthreads();
#pragma unroll
        for (int tb = 0; tb < 4; ++tb) {
            bf16x4 Pf[4];
#pragma unroll
            for (int j = 0; j < 4; ++j) Pf[j] = *(const bf16x4*)(PSI + chid * 4096 + ((tb * 4 + j) * 64 + lz) * 4);
            f32x4 y[4], gt[4], vv[4];
#pragma unroll
            for (int vb = 0; vb < 4; ++vb) { y[vb] = unpack4(*(const u32x2*)(Y0T + chid * 4096 + ((vb * 4 + tb) * 64 + lz) * 4)); vv[vb] = unpack4(*(const u32x2*)(VT + chid * 4096 + ((vb * 4 + tb) * 64 + lz) * 4));
#pragma unroll
                for (int j = 0; j < 4; ++j) y[vb] = MFMA16(Pf[j], Mf[j * 4 + vb], y[vb]); }
            {   const LAS unsigned char* ar = lds + LC_SGL + ((16 * tb + c) * 104 + 8 * q) * 2;
                const bf16x8 a0 = *(const LAS bf16x8*)(ar), a1 = *(const LAS bf16x8*)(ar + 64), a2 = *(const LAS bf16x8*)(ar + 128);
#pragma unroll
                for (int vb = 0; vb < 4; ++vb) { f32x4 d = {0.f, 0.f, 0.f, 0.f}; d = MFMA32(a0, Gf[vb * 3], d); d = MFMA32(a1, Gf[vb * 3 + 1], d); d = MFMA32(a2, Gf[vb * 3 + 2], d); gt[vb] = d; } }
#pragma unroll
            for (int r = 0; r < 4; ++r) { const int tl = 16 * tb + 4 * q + r;
                const float s = row16_sum((y[0][r] + y[1][r]) + (y[2][r] + y[3][r])); const float mean = s * (1.f / 64.f);
                const float d0 = y[0][r] - mean, d1 = y[1][r] - mean, d2 = y[2][r] - mean, d3 = y[3][r] - mean;
                const float var = row16_sum((d0 * d0 + d1 * d1) + (d2 * d2 + d3 * d3)) * (1.f / 64.f); const float rstd = rsqrtf(var + GN_EPS);
                const float rk = rkv_[tb * 4 + r];
                const float o0 = (d0 * rstd * gng[0] + gnb[0] + rk * vv[0][r]) * gt[0][r], o1 = (d1 * rstd * gng[1] + gnb[1] + rk * vv[1][r]) * gt[1][r];
                const float o2 = (d2 * rstd * gng[2] + gnb[2] + rk * vv[2][r]) * gt[2][r], o3 = (d3 * rstd * gng[3] + gnb[3] + rk * vv[3][r]) * gt[3][r];
                const unsigned pq = pack_fp8x4(4.f * o0, 4.f * o1, 4.f * o2, 4.f * o3);
                *(LAS unsigned char*)(ot + tl * 80 + c) = (unsigned char)pq; *(LAS unsigned char*)(ot + tl * 80 + 16 + c) = (unsigned char)(pq >> 8);
                *(LAS unsigned char*)(ot + tl * 80 + 32 + c) = (unsigned char)(pq >> 16); *(LAS unsigned char*)(ot + tl * 80 + 48 + c) = (unsigned char)(pq >> 24); }
        }
        asm volatile("s_waitcnt lgkmcnt(0)" ::: "memory");
        {   const int rw = lane >> 2, pc = (lane & 3) * 16;
#pragma unroll
            for (int m4 = 0; m4 < 4; ++m4) *(u32x4*)(outa + (size_t)(t0 + rw + 16 * m4) * 512 + h * 64 + pc) = *(const LAS u32x4*)(ot + (rw + 16 * m4) * 80 + pc); }
    }
    __syncthreads();
}
__device__ __forceinline__ void phase_sgu(Frame& F, const Params& P, int l, int wg0, int nwg) {
    LAS unsigned char* vt = F.lds;
    const bf16_t* z = WSP(bf16_t, WS_SGUZ); unsigned char* hb = WSP(unsigned char, WS_HB);
    const bf16_t* Wm = WSP(bf16_t, WS_SGUW) + (size_t)l * 4 * 128 * 128;
    const float* bs = P.in[21] + (size_t)l * 4 * 128;
    int u0 = __builtin_amdgcn_readfirstlane((int)blockIdx.x - wg0);
    for (int u = u0; u < T / 128; u += nwg) {
        int uu = u; asm volatile("" : "+v"(uu)); uu = __builtin_amdgcn_readfirstlane(uu);
        int lz = F.lane; asm volatile("" : "+v"(lz));
        const size_t t0 = (size_t)uu * 128;
        __syncthreads();
        {
            float lg[4], lb[4];
#pragma unroll
            for (int e = 0; e < 4; ++e) { lg[e] = P.in[18][(size_t)l * 256 + lz + 64 * e]; lb[e] = P.in[19][(size_t)l * 256 + lz + 64 * e]; }
            float vall[16][4];
#pragma unroll
            for (int i = 0; i < 16; ++i) { const bf16_t* zr = z + (t0 + F.wave * 16 + i) * 512 + 256 + lz;
#pragma unroll
                for (int e = 0; e < 4; ++e) vall[i][e] = bf2f(zr[64 * e]); }
#pragma unroll
            for (int i = 0; i < 16; ++i) { const int tok = F.wave * 16 + i;
                float v[4];
#pragma unroll
                for (int e = 0; e < 4; ++e) v[e] = vall[i][e];
                const float mean = wave_sum((v[0] + v[1]) + (v[2] + v[3])) * (1.f / 256.f);
#pragma unroll
                for (int e = 0; e < 4; ++e) v[e] -= mean;
                const float rstd = rsqrtf(wave_sum((v[0] * v[0] + v[1] * v[1]) + (v[2] * v[2] + v[3] * v[3])) * (1.f / 256.f) + LN_EPS);
#pragma unroll
                for (int e = 0; e < 4; ++e) { const int ch = lz + 64 * e; *(LAS bf16_t*)(vt + ch * 256 + ((((tok >> 3) ^ (ch & 15)) << 4) | ((tok & 7) << 1))) = f2bf(v[e] * rstd * lg[e] + lb[e]); } } }
        __syncthreads();
        {   const int c = lz & 15, qd = lz >> 4, g = F.wave >> 1, sel = F.wave & 1;
            const bf16_t* Wg = Wm + (size_t)g * 128 * 128;
            f32x4 acc[4][4];
#pragma unroll
            for (int pi = 0; pi < 4; ++pi)
#pragma unroll
                for (int db = 0; db < 4; ++db) acc[pi][db] = (f32x4){0.f, 0.f, 0.f, 0.f};
#pragma unroll
            for (int ks = 0; ks < 4; ++ks) {
                bf16x8 af[4];
#pragma unroll
                for (int db = 0; db < 4; ++db) { const int ch = 64 * g + 16 * db + c; af[db] = *(const LAS bf16x8*)(vt + ch * 256 + (((4 * ks + qd) ^ (ch & 15)) << 4)); }
#pragma unroll
                for (int pi = 0; pi < 4; ++pi) { const int pb = sel ? ((pi == 0) ? 1 : (pi == 1) ? 2 : (pi == 2) ? 5 : 6) : ((pi == 0) ? 0 : (pi == 1) ? 3 : (pi == 2) ? 4 : 7);
                    if (32 * ks <= 16 * pb + 15) { const bf16x8 bfr = *(const bf16x8*)(Wg + (size_t)(16 * pb + c) * 128 + 32 * ks + 8 * qd);
#pragma unroll
                        for (int db = 0; db < 4; ++db) acc[pi][db] = MFMA32(af[db], bfr, acc[pi][db]); } } }
            u32x2 uraw[4][4]; float biasv[4];
#pragma unroll
            for (int pi = 0; pi < 4; ++pi) { const int pb = sel ? ((pi == 0) ? 1 : (pi == 1) ? 2 : (pi == 2) ? 5 : 6) : ((pi == 0) ? 0 : (pi == 1) ? 3 : (pi == 2) ? 4 : 7);
                const int p = 16 * pb + c; biasv[pi] = bs[g * 128 + p];
#pragma unroll
                for (int db = 0; db < 4; ++db) uraw[pi][db] = *(const u32x2*)(z + (t0 + p) * 512 + 64 * g + 16 * db + 4 * qd); }
#pragma unroll
            for (int pi = 0; pi < 4; ++pi) { const int pb = sel ? ((pi == 0) ? 1 : (pi == 1) ? 2 : (pi == 2) ? 5 : 6) : ((pi == 0) ? 0 : (pi == 1) ? 3 : (pi == 2) ? 4 : 7);
                const size_t t = t0 + 16 * pb + c;
#pragma unroll
                for (int db = 0; db < 4; ++db) { const int ch = 64 * g + 16 * db + 4 * qd;
                    const f32x4 o = unpack4(uraw[pi][db]) * (acc[pi][db] + biasv[pi]) * 4.f; *(unsigned*)(hb + t * 256 + ch) = pack_fp8x4(o[0], o[1], o[2], o[3]); } } }
    }
    __syncthreads();
}
__device__ __forceinline__ void phase_conv(Frame& F, const Params& P, int l, int wg0, int nwg) {
    LAS float* cv = (LAS float*)F.lds;
    const bf16_t* hin = WSP(bf16_t, WS_CONVH); unsigned char* hc = WSP(unsigned char, WS_HC);
    const float* dw = P.in[23] + (size_t)l * 31 * 256; const float* db = P.in[24] + (size_t)l * 256;
    const float* lg = P.in[25] + (size_t)l * 256; const float* lb = P.in[26] + (size_t)l * 256;
    int u0 = __builtin_amdgcn_readfirstlane((int)blockIdx.x - wg0);
    for (int u = u0; u < T / 64; u += nwg) {
        int tz = F.tid; asm volatile("" : "+v"(tz)); const int ch = tz & 255, hf = tz >> 8, lz = tz & 63;
        float kw[31];
#pragma unroll
        for (int j = 0; j < 31; ++j) kw[j] = dw[j * 256 + ch];
        const float bias = db[ch];
        const int t0 = u * 64 + hf * 32; const int s0 = t0 & (SEQ - 1);
        __syncthreads();
        float x[38];
#pragma unroll
        for (int m = 0; m < 30; ++m) { const int s = s0 - 30 + m; const float ld = bf2f(hin[(size_t)(t0 - 30 + m + (s >= 0 ? 0 : 30)) * 256 + ch]); x[m] = (s >= 0) ? ld : 0.f; }
#pragma unroll
        for (int g8 = 0; g8 < 4; ++g8) {
#pragma unroll
            for (int m = 0; m < 8; ++m) x[30 + m] = bf2f(hin[(size_t)(t0 + 8 * g8 + m) * 256 + ch]);
#pragma unroll
            for (int i = 0; i < 8; ++i) { float a = bias;
#pragma unroll
                for (int j = 0; j < 31; ++j) a += kw[j] * x[i + j];
                cv[(hf * 32 + 8 * g8 + i) * 256 + ch] = a; }
#pragma unroll
            for (int m = 0; m < 30; ++m) x[m] = x[m + 8]; }
        __syncthreads();
        {   const f32x4 g = *(const f32x4*)(lg + lz * 4), bb = *(const f32x4*)(lb + lz * 4);
            for (int i = 0; i < 8; ++i) { const int tok = F.wave * 8 + i; f32x4 v = *(const LAS f32x4*)(cv + tok * 256 + lz * 4);
                const float mean = wave_sum((v[0] + v[1]) + (v[2] + v[3])) * (1.f / 256.f);
                v = v - mean; const float var = wave_sum((v[0] * v[0] + v[1] * v[1]) + (v[2] * v[2] + v[3] * v[3])) * (1.f / 256.f);
                const float rstd = rsqrtf(var + LN_EPS);
                v = v * rstd * g + bb;
                float o[4];
#pragma unroll
                for (int j = 0; j < 4; ++j) o[j] = v[j] * sigmoidf_(v[j]);
                *(unsigned*)(hc + (size_t)(u * 64 + tok) * 256 + lz * 4) = pack_fp8x4(4.f * o[0], 4.f * o[1], 4.f * o[2], 4.f * o[3]); } }
    }
    __syncthreads();
}
__device__ __forceinline__ void ln_unpack16(const u32x4 a, const u32x4 b, float (&v)[16]) {
    v[0] = bflo(a.x); v[1] = bfhi(a.x); v[2] = bflo(a.y); v[3] = bfhi(a.y); v[4] = bflo(a.z); v[5] = bfhi(a.z); v[6] = bflo(a.w); v[7] = bfhi(a.w);
    v[8] = bflo(b.x); v[9] = bfhi(b.x); v[10] = bflo(b.y); v[11] = bfhi(b.y); v[12] = bflo(b.z); v[13] = bfhi(b.z); v[14] = bflo(b.w); v[15] = bfhi(b.w);
}
__device__ __forceinline__ void ln_load16(const bf16_t* p, float (&v)[16]) { ln_unpack16(*(const u32x4*)p, *(const u32x4*)(p + 8), v); }
__device__ __forceinline__ void ln_norm16(float (&v)[16], const float* g, const float* b, int lane) {
    float s = 0.f;
#pragma unroll
    for (int j = 0; j < 16; ++j) s += v[j];
    const float mean = wave_sum(s) * (1.f / 1024.f); float q = 0.f;
#pragma unroll
    for (int j = 0; j < 16; ++j) { v[j] -= mean; q += v[j] * v[j]; }
    const float rstd = rsqrtf(wave_sum(q) * (1.f / 1024.f) + LN_EPS);
#pragma unroll
    for (int j4 = 0; j4 < 4; ++j4) { const f32x4 gg = *(const f32x4*)(g + lane * 16 + j4 * 4), bb = *(const f32x4*)(b + lane * 16 + j4 * 4);
#pragma unroll
        for (int j = 0; j < 4; ++j) v[j4 * 4 + j] = v[j4 * 4 + j] * rstd * gg[j] + bb[j]; }
}
__device__ __forceinline__ void ln_store16(bf16_t* p, const float (&v)[16]) {
    u32x4 a, b; a.x = cvt_pk_bf16(v[0], v[1]); a.y = cvt_pk_bf16(v[2], v[3]); a.z = cvt_pk_bf16(v[4], v[5]); a.w = cvt_pk_bf16(v[6], v[7]);
    b.x = cvt_pk_bf16(v[8], v[9]); b.y = cvt_pk_bf16(v[10], v[11]); b.z = cvt_pk_bf16(v[12], v[13]); b.w = cvt_pk_bf16(v[14], v[15]);
    *(u32x4*)p = a; *(u32x4*)(p + 8) = b;
}
__device__ __forceinline__ void ln_unpack16q(const u32x4 a, float (&v)[16]) {
    const unsigned w[4] = {a.x, a.y, a.z, a.w};
#pragma unroll
    for (int i = 0; i < 4; ++i) { const f32x2 lo = __builtin_amdgcn_cvt_pk_f32_fp8((int)w[i], false), hi = __builtin_amdgcn_cvt_pk_f32_fp8((int)w[i], true); v[4 * i] = lo[0]; v[4 * i + 1] = lo[1]; v[4 * i + 2] = hi[0]; v[4 * i + 3] = hi[1]; }
}
__device__ __forceinline__ void ln_load16q(const unsigned char* p, float (&v)[16]) { ln_unpack16q(*(const u32x4*)p, v); }
__device__ __forceinline__ void ln_store16q(unsigned char* p, const float (&v)[16]) {
    u32x4 a; a.x = pack_fp8x4(v[0], v[1], v[2], v[3]); a.y = pack_fp8x4(v[4], v[5], v[6], v[7]); a.z = pack_fp8x4(v[8], v[9], v[10], v[11]); a.w = pack_fp8x4(v[12], v[13], v[14], v[15]);
    *(u32x4*)p = a;
}
__device__ __forceinline__ void phase_ln1(Frame& F, const Params& P, int l, int wg0, int nwg, int row_lo, int row_hi) {
    const bf16_t* pre = WSP(bf16_t, WS_PRE); const float* stats = WSP(float, WS_STATS);
    const float* g = P.in[29] + (size_t)l * 1024; const float* b = P.in[30] + (size_t)l * 1024;
    const int gw = ((int)blockIdx.x - wg0) * 8 + F.wave, NGW = nwg * 8;
    float gg[16], bb[16];
#pragma unroll
    for (int j4 = 0; j4 < 4; ++j4) { const f32x4 g4 = *(const f32x4*)(g + F.lane * 16 + j4 * 4), b4 = *(const f32x4*)(b + F.lane * 16 + j4 * 4);
#pragma unroll
        for (int j = 0; j < 4; ++j) { gg[j4 * 4 + j] = g4[j]; bb[j4 * 4 + j] = b4[j]; } }
    for (int row = row_lo + gw; row < row_hi; row += NGW) { float v[16]; ln_load16(pre + (size_t)row * 1024 + F.lane * 16, v);
        const f32x2 sl = *(const f32x2*)(stats + ((size_t)row * 16 + (F.lane & 15)) * 2);
        const float mean = row16_sum(sl[0]) * (1.f / 1024.f), ex2 = row16_sum(sl[1]) * (1.f / 1024.f);
        const float rstd = rsqrtf(fmaxf(ex2 - mean * mean, 0.f) + LN_EPS);
#pragma unroll
        for (int j = 0; j < 16; ++j) v[j] = (v[j] - mean) * rstd * gg[j] + bb[j];
        ln_store16q(WSP(unsigned char, WS_X1Q) + (size_t)row * 1024 + F.lane * 16, v); }
}
__device__ __forceinline__ void phase_ln2(Frame& F, const Params& P, int l) {
    const bf16_t* pre = WSP(bf16_t, WS_PRE); const float* stats = WSP(float, WS_STATS); const unsigned char* Y = WSP(unsigned char, WS_Y); bf16_t* x = WSP(bf16_t, WS_X); const int* inv = WSP(int, WS_GATEV);
    const float* g = P.in[36] + (size_t)l * 1024; const float* b = P.in[37] + (size_t)l * 1024; const float* g1 = P.in[29] + (size_t)l * 1024; const float* b1 = P.in[30] + (size_t)l * 1024;
    const int gw = blockIdx.x * 8 + F.wave, NGW = F.G * 8;
    float g1v[16], b1v[16], gv[16], bv[16];
#pragma unroll
    for (int j4 = 0; j4 < 4; ++j4) { const f32x4 a4 = *(const f32x4*)(g1 + F.lane * 16 + j4 * 4), c4 = *(const f32x4*)(b1 + F.lane * 16 + j4 * 4), d4 = *(const f32x4*)(g + F.lane * 16 + j4 * 4), e4 = *(const f32x4*)(b + F.lane * 16 + j4 * 4);
#pragma unroll
        for (int j = 0; j < 4; ++j) { g1v[j4 * 4 + j] = a4[j]; b1v[j4 * 4 + j] = c4[j]; gv[j4 * 4 + j] = d4[j]; bv[j4 * 4 + j] = e4[j]; } }
    int n0 = inv[2 * gw], n1 = inv[2 * gw + 1];
    int c0 = __builtin_amdgcn_readfirstlane(n0), c1 = __builtin_amdgcn_readfirstlane(n1);
    { const int rn = (gw + NGW < T) ? gw + NGW : gw; n0 = inv[2 * rn]; n1 = inv[2 * rn + 1]; }
    u32x4 pa = *(const u32x4*)(pre + (size_t)gw * 1024 + F.lane * 16), pb = *(const u32x4*)(pre + (size_t)gw * 1024 + F.lane * 16 + 8);
    u32x4 qa = *(const u32x4*)(Y + (size_t)c0 * 1024 + F.lane * 16), qb = *(const u32x4*)(Y + (size_t)c1 * 1024 + F.lane * 16);
    f32x2 sn = *(const f32x2*)(stats + ((size_t)gw * 16 + (F.lane & 15)) * 2);
#pragma unroll 1
    for (int row = gw; row < T; row += NGW) { float v[16], y0[16], y1[16];
        const u32x4 ca = pa, cb = pb, cqa = qa, cqb = qb; const f32x2 sl = sn;
        {   const int rn = (row + NGW < T) ? row + NGW : row, r2 = (rn + NGW < T) ? rn + NGW : rn;
            c0 = __builtin_amdgcn_readfirstlane(n0); c1 = __builtin_amdgcn_readfirstlane(n1); n0 = inv[2 * r2]; n1 = inv[2 * r2 + 1];
            pa = *(const u32x4*)(pre + (size_t)rn * 1024 + F.lane * 16); pb = *(const u32x4*)(pre + (size_t)rn * 1024 + F.lane * 16 + 8);
            qa = *(const u32x4*)(Y + (size_t)c0 * 1024 + F.lane * 16); qb = *(const u32x4*)(Y + (size_t)c1 * 1024 + F.lane * 16);
            sn = *(const f32x2*)(stats + ((size_t)rn * 16 + (F.lane & 15)) * 2); }
        ln_unpack16(ca, cb, v); ln_unpack16q(cqa, y0); ln_unpack16q(cqb, y1);
        {   const float mean = row16_sum(sl[0]) * (1.f / 1024.f), ex2 = row16_sum(sl[1]) * (1.f / 1024.f); const float rstd = rsqrtf(fmaxf(ex2 - mean * mean, 0.f) + LN_EPS);
#pragma unroll
            for (int j = 0; j < 16; ++j) v[j] = (v[j] - mean) * rstd * g1v[j] + b1v[j]; }
#pragma unroll
        for (int j = 0; j < 16; ++j) v[j] = ALPHA * v[j] + 0.125f * (y0[j] + y1[j]);
        {   float s = 0.f;
#pragma unroll
            for (int j = 0; j < 16; ++j) s += v[j];
            const float mean = wave_sum(s) * (1.f / 1024.f); float qq = 0.f;
#pragma unroll
            for (int j = 0; j < 16; ++j) { v[j] -= mean; qq += v[j] * v[j]; }
            const float rstd = rsqrtf(wave_sum(qq) * (1.f / 1024.f) + LN_EPS);
#pragma unroll
            for (int j = 0; j < 16; ++j) v[j] = v[j] * rstd * gv[j] + bv[j]; }
        if (l == NL - 1) { float* o = F.out + (size_t)row * 1024 + F.lane * 16;
#pragma unroll
            for (int j4 = 0; j4 < 4; ++j4) *(f32x4*)(o + j4 * 4) = (f32x4){v[j4 * 4], v[j4 * 4 + 1], v[j4 * 4 + 2], v[j4 * 4 + 3]}; }
        else { ln_store16(x + (size_t)row * 1024 + F.lane * 16, v); ln_store16q(WSP(unsigned char, WS_XQ) + (size_t)row * 1024 + F.lane * 16, v); } }
}

#define PHASE_PROLOGUE() const Params P = KPARAMS(); Frame F = make_frame(P.ws, P.out); unsigned* ctl = (unsigned*)(F.ws + WS_CTL); (void)ctl
__device__ __forceinline__ void ph_prologue() { PHASE_PROLOGUE(); phase_convert_static(F, P); phase_convert_lora(F, P); phase_convert_wkvpar(F, P); phase_convert_sgu(F, P); phase_convert_router(F, P); phase_x_to_bf16(F, P); phase_convert_moe(F, P, 0, F.vcu * 8 + F.wave, MOE_ITEMS, F.G * 8); __syncthreads(); }
__device__ __forceinline__ void ph_inproj(int l) { PHASE_PROLOGUE();
    SchedInproj S{(const char*)WSP(unsigned char, WS_XQ), (const char*)(WSP(unsigned char, WS_WIN) + (size_t)l * NIN * 1024), F.G, (int)blockIdx.x};
    EpiInproj E{WSP(bf16_t, WS_RKV), WSP(bf16_t, WS_SGUZ), WSP(bf16_t, WS_CONVH), WSP(unsigned char, WS_GATES)};
    ge::gemm_phase<SchedInproj, EpiInproj, true, 0x7A7A7A7A, 0x7F7F7F7F, true>(F.lds, S, E); }
__device__ __forceinline__ void ph_wkva(int l) { PHASE_PROLOGUE(); phase_wkv_a<false>(F, P, l); }
constexpr int CVT_FILL_SEAMS = 11, CVT_NFILL = CVT_FILL_SEAMS * 256 * 7;
constexpr int CVT_B_PER_WAVE = 1;
__device__ __forceinline__ void ph_cvtmoe(int l) { PHASE_PROLOGUE();
    constexpr int NB = 64 * 8 * CVT_B_PER_WAVE;
    if (blockIdx.x < 64) phase_convert_moe(F, P, l, CVT_NFILL + (int)blockIdx.x * 8 + F.wave, CVT_NFILL + NB, 64 * 8);
    else phase_convert_moe(F, P, l, CVT_NFILL + NB + ((int)blockIdx.x - 64) * 8 + F.wave, MOE_ITEMS, 192 * 8);
    __syncthreads(); }
__device__ __forceinline__ void seam_fill(int l, int k) {
    const int lt = (k >= 3) ? l + 1 : l;
    if (lt < 1 || lt >= NL) return;
    PHASE_PROLOGUE();
    constexpr int SL = 256 * 7;
    if (k == 0) {
        if (blockIdx.x < 128) return;
        const int base = 7 * SL + (((int)blockIdx.x - 128) * 7 + (F.wave - 1)) * 4;
        phase_convert_moe(F, P, lt, base, base + 4, 1); return; }
    const int slot = (k >= 3) ? k - 3 : 8 + k;
    const int item = slot * SL + (int)blockIdx.x * 7 + (F.wave - 1);
    if (item < CVT_NFILL) phase_convert_moe(F, P, lt, item, item + 1, 1);
}
__device__ __forceinline__ void ph_wkvb() { PHASE_PROLOGUE(); phase_wkv_b(F, P); }
__device__ __forceinline__ void ph_wkvc(int l) { PHASE_PROLOGUE(); phase_wkv_c(F, P, l); }
__device__ __forceinline__ void ph_sguconv(int l) { PHASE_PROLOGUE();
    phase_sgu(F, P, l, 64, 192); phase_conv(F, P, l, 64, 192); }
__device__ __forceinline__ void ph_branch(int l) { PHASE_PROLOGUE();
    SchedBranch S{(const char*)F.ws, WS_WBR + (size_t)l * 1024 * 1024, F.G, F.vcu};
    EpiBranch E{WSP(unsigned char, WS_GATES), WSP(bf16_t, WS_MERGED), WSP(unsigned char, WS_MERGEDQ)};
    ge::gemm_phase<SchedBranch, EpiBranch, true, 0x7A7A7A7A, 0x7D7D7D7D, true>(F.lds, S, E); }
__device__ __forceinline__ void ph_wout(int l) { PHASE_PROLOGUE();
    SchedWout S{(const char*)WSP(unsigned char, WS_MERGEDQ), (const char*)(WSP(unsigned char, WS_WOUT) + (size_t)l * 1024 * 1024), F.G, F.vcu};
    EpiWout E{WSP(bf16_t, WS_X), WSP(bf16_t, WS_PRE), WSP(float, WS_STATS)};
    ge::gemm_phase<SchedWout, EpiWout, true, 0x7A7A7A7A, 0x7D7D7D7D, true>(F.lds, S, E); }
constexpr int LN1_SPLIT = 3072;
__device__ __forceinline__ void ph_ln1(int l) { PHASE_PROLOGUE(); if (blockIdx.x < 128) phase_ln1(F, P, l, 0, 128, 0, LN1_SPLIT); else phase_ln1(F, P, l, 128, 128, LN1_SPLIT, T); }
__device__ __forceinline__ void ph_router(int l) { PHASE_PROLOGUE();
    SchedRouter S{(const char*)WSP(bf16_t, WS_PRE), (const char*)(WSP(bf16_t, WS_WRG) + (size_t)l * 256 * 1024), 128, (int)blockIdx.x};
    EpiRouter E{P.in[32], ctl + CW_CNT + 64 * l, WSP(int, WS_LIST), WSP(float, WS_STATS), WSP(float, WS_RC) + l * 64};
    ge::gemm_phase<SchedRouter, EpiRouter, false, 0x7A7A7A7A, 0x7F7F7F7F, false, true>(F.lds, S, E); }
__device__ __forceinline__ void ph_moe1(int l) { PHASE_PROLOGUE();
    const int ntiles = build_tile_table(F, ctl + CW_CNT + 64 * l);
    SchedMoe1 S{(const char*)WSP(unsigned char, WS_X1Q), (const char*)moe_wbuf(F, l), WSP(int, WS_LIST), ctl + CW_CNT + 64 * l, (LAS int*)(F.lds + LDS_MISC + 64), ntiles, F.G, F.vcu};
    EpiMoe1 E{WSP(unsigned char, WS_H)};
    ge::gemm_phase<SchedMoe1, EpiMoe1, true, 0x7A7A7A7A, 0x7F7F7F7F, true>(F.lds, S, E); }
__device__ __forceinline__ void ph_moe2(int l) { PHASE_PROLOGUE(); int ntk4 = 4; asm volatile("" : "+s"(ntk4));
    __syncthreads(); const int ntiles = ((volatile LAS int*)(F.lds + LDS_MISC + 64))[0];
    SchedMoe2 S{(const char*)WSP(unsigned char, WS_H), (const char*)(moe_wbuf(F, l) + (size_t)NE * 1024 * 1024), WSP(int, WS_LIST), ctl + CW_CNT + 64 * l, (LAS int*)(F.lds + LDS_MISC + 64), ntiles, F.G, F.vcu, ntk4};
    EpiMoe2 E{WSP(int, WS_LIST), WSP(unsigned char, WS_Y), WSP(int, WS_GATEV)};
    ge::gemm_phase<SchedMoe2, EpiMoe2, true, 0x7A7A7A7A, 0x7F7F7F7F, true>(F.lds, S, E); }
__device__ __forceinline__ void ph_ln2(int l) { PHASE_PROLOGUE(); phase_ln2(F, P, l); }

constexpr int PH_PER_LAYER = 11, N_PHASES = 1 + NL * PH_PER_LAYER;
__global__ void __launch_bounds__(512, 2) fwd_kernel(Params p) {
    for (int u = threadIdx.x; u < (LDS_BYTES - LDS_MISC) / 4; u += 512) ((LAS unsigned*)((LAS unsigned char*)lds_raw + LDS_MISC))[u] = 0u;
    __syncthreads();
#if ONE_LAUNCH
    XcdBarrier bar = xcd_barrier_post((unsigned*)(p.ws + WS_CTL) + CW_BAR, (volatile LAS unsigned*)((LAS unsigned char*)lds_raw + LDS_MISC));
#define SEAM() xcd_barrier(bar, [] {})
#define SEAMF(l, k) xcd_barrier(bar, [] { seam_fill(l, k); })
#else
#define SEAM() do { } while (0)
#define SEAMF(l, k) do { } while (0)
#endif
    const int lo = p.phase_lo, hi = p.phase_hi;
#ifdef ONLY_K
#define IN(k) ((k) == ONLY_K && lo <= pb + (k) && pb + (k) < hi)
#else
#define IN(k) (lo <= pb + (k) && pb + (k) < hi)
#endif
#ifndef ONLY_K
    { const int pb = 0; if (IN(0)) { ph_prologue(); SEAM(); } }
#endif
#define RUN_LAYER(l) do { const int pb = 1 + (l) * PH_PER_LAYER;\
        if (IN(0)) { ph_inproj(l); SEAMF(l, 0); }\
        if (IN(1)) { ph_wkva(l); SEAMF(l, 1); }\
        if (IN(2)) { if (blockIdx.x < 64) ph_wkvb(); else ph_sguconv(l); if ((l) + 1 < NL) ph_cvtmoe((l) + 1); SEAMF(l, 2); }\
        if (IN(3)) { ph_wkvc(l); SEAMF(l, 3); }\
        if (IN(4)) { ph_branch(l); SEAMF(l, 4); }\
        if (IN(5)) { ph_wout(l); SEAMF(l, 5); }\
        if (IN(6)) { if (blockIdx.x < 128) ph_router(l); ph_ln1(l); SEAMF(l, 6); }\
        if (IN(8)) { ph_moe1(l); SEAMF(l, 7); }\
        if (IN(9)) { ph_moe2(l); SEAMF(l, 8); }\
        if (IN(10)) { ph_ln2(l); if (l + 1 < NL) SEAMF(l, 9); } } while (0)
    RUN_LAYER(0); RUN_LAYER(1); RUN_LAYER(2); RUN_LAYER(3);
#undef RUN_LAYER
#undef IN
#undef SEAM
#undef SEAMF
}

extern "C" void kernel_launch(void* const* d_in, const int* in_sizes, int n_in, void* d_out, int out_size, void* d_ws, size_t ws_size, hipStream_t stream) {
    static int grid = 0;
    if (grid == 0) {
        if (n_in != 38 || in_sizes[0] != T * D || out_size != T * D || ws_size < WS_END) { fprintf(stderr, "kernel_launch: unexpected shapes (n_in %d, in0 %d, out %d, ws %zu, need %zu); nothing launched\n", n_in, n_in > 0 ? in_sizes[0] : -1, out_size, ws_size, (size_t)WS_END); grid = -1; return; }
        int dev = 0, cus = 0, per_cu = 0;
        if (hipGetDevice(&dev) != hipSuccess || hipDeviceGetAttribute(&cus, hipDeviceAttributeMultiprocessorCount, dev) != hipSuccess) { grid = -1; return; }
        if (hipFuncSetAttribute((const void*)fwd_kernel, hipFuncAttributeMaxDynamicSharedMemorySize, LDS_BYTES) != hipSuccess) { fprintf(stderr, "kernel_launch: hipFuncSetAttribute failed\n"); grid = -1; return; }
        if (hipOccupancyMaxActiveBlocksPerMultiprocessor(&per_cu, (const void*)fwd_kernel, 512, LDS_BYTES) != hipSuccess || per_cu < 1) fprintf(stderr, "kernel_launch: occupancy query reports %d blocks per CU\n", per_cu);
        (void)hipGetLastError();
        grid = cus;
        if (grid != 256) { fprintf(stderr, "kernel_launch: built for a 256-CU device, found %d CUs; nothing launched\n", cus); grid = -1; return; }
    }
    if (grid < 0) return;
    (void)hipMemsetAsync((char*)d_ws + WS_CTL, 0, CTL_BYTES, stream);
    Params p{};
    for (int i = 0; i < 38; ++i) p.in[i] = (const float*)d_in[i];
    p.out = (float*)d_out; p.ws = (unsigned char*)d_ws; p.layer_lo = 0; p.layer_hi = NL;
#if ONE_LAUNCH
    p.phase_lo = 0; p.phase_hi = N_PHASES;
    hipLaunchKernelGGL(fwd_kernel, dim3(grid), dim3(512), LDS_BYTES, stream, p);
#else
    for (int ph = 0; ph < N_PHASES; ++ph) { p.phase_lo = ph; p.phase_hi = ph + 1; hipLaunchKernelGGL(fwd_kernel, dim3(grid), dim3(512), LDS_BYTES, stream, p); }
#endif
}
```
